# Optimizing an MI355X kernel written in HIP

```python
import jax
import jax.numpy as jnp
from jax import lax
import numpy as np


D_MODEL = 1024
BATCH = 1
SEQ = 16384
DEPTH = 4

GRID_W = 64
CTX_LEN = 256
MIX_WIDTH = D_MODEL
MLSTM_WIDTH = MIX_WIDTH // 4
MLSTM_DH = 64
MLSTM_HEADS = MLSTM_WIDTH // MLSTM_DH
MLSTM_GATE_COLS = 2 * 2 * MLSTM_HEADS
HEAD_DIM = 64
ATTN_Q_WIDTH = MIX_WIDTH // 2
ATTN_HEADS = ATTN_Q_WIDTH // HEAD_DIM
ATTN_KV_HEADS = 2
ATTN_GROUP = ATTN_HEADS // ATTN_KV_HEADS
ATTN_KV_WIDTH = ATTN_KV_HEADS * HEAD_DIM
WINDOW = 128
WIN_BLOCK = 128
ROPE_BASE = 10000.0
ROPE_PAIRS = HEAD_DIM // 4
GLA_WIDTH = MIX_WIDTH // 4
GLA_DV = 64
GLA_HEADS = GLA_WIDTH // GLA_DV
GLA_DK = GLA_DV // 2
GLA_KEY_WIDTH = GLA_HEADS * GLA_DK
GLA_RANK = 16
GLA_TAU = 16.0
GLA_GATE_COLS = 2 * GLA_RANK
SCAN_CHUNK = 64
COL_SIZES = (MLSTM_WIDTH, MLSTM_WIDTH, MLSTM_WIDTH, MLSTM_WIDTH, MLSTM_GATE_COLS,
             ATTN_Q_WIDTH, ATTN_KV_WIDTH, ATTN_KV_WIDTH,
             GLA_KEY_WIDTH, GLA_KEY_WIDTH, GLA_WIDTH, GLA_WIDTH, GLA_GATE_COLS)
COL_OFFSETS = tuple(int(o) for o in np.cumsum(COL_SIZES)[:-1])
IN_COLS = sum(COL_SIZES)
D_FF = 2816
N_EXPERTS = 8
TOP_K = 2
D_EXPERT = 3584
MOE_BLOCK = 128
N_DENSE = (DEPTH + 1) // 2
N_MOE = DEPTH // 2
DEEPNORM_ALPHA = (2 * DEPTH) ** 0.25
DEEPNORM_BETA = (8 * DEPTH) ** -0.25
ADA_INIT = 0.5
LN_EPS = 1e-5

kernel_name = 'hymba_mlstm_swa_gla_moe_dit'


def layer_norm(x, w, b):
    xf = x.astype(jnp.float32)
    mu = jnp.mean(xf, -1, keepdims=True)
    var = jnp.mean(jnp.square(xf - mu), -1, keepdims=True)
    return ((xf - mu) * lax.rsqrt(var + LN_EPS) * w + b).astype(x.dtype)


def head_norm(h, w, n_heads):
    hh = h.reshape(h.shape[:-1] + (n_heads, -1))
    mu = jnp.mean(hh, -1, keepdims=True)
    var = jnp.mean(jnp.square(hh - mu), -1, keepdims=True)
    return ((hh - mu) * lax.rsqrt(var + LN_EPS)).reshape(h.shape) * w


def to_heads(a, n):
    b, t, w = a.shape
    return a.reshape(b, t, n, w // n).transpose(0, 2, 1, 3)


def from_heads(a):
    b, n, t, d = a.shape
    return a.transpose(0, 2, 1, 3).reshape(b, t, n * d)


def axial_rope(x, row, col):
    inv = ROPE_BASE ** (-jnp.arange(ROPE_PAIRS, dtype=jnp.float32) / ROPE_PAIRS)

    def rot(xa, pos):
        ang = pos.astype(jnp.float32)[:, None] * inv
        cos, sin = jnp.cos(ang).astype(x.dtype), jnp.sin(ang).astype(x.dtype)
        x1, x2 = xa[..., :ROPE_PAIRS], xa[..., ROPE_PAIRS:]
        return jnp.concatenate([x1 * cos - x2 * sin, x2 * cos + x1 * sin], -1)

    half = HEAD_DIM // 2
    return jnp.concatenate([rot(x[..., :half], row), rot(x[..., half:], col)], -1)


def _chunks(a):
    nc = a.shape[2] // SCAN_CHUNK
    return jnp.moveaxis(a.reshape(a.shape[:2] + (nc, SCAN_CHUNK) + a.shape[3:]), 2, 0)


def _unchunk(hs):
    nc, b, h, l, d = hs.shape
    return jnp.moveaxis(hs, 0, 2).reshape(b, h, nc * l, d)


def mlstm_scan(state, q, k, v, ig, lf):
    tri = jnp.tril(jnp.ones((SCAN_CHUNK, SCAN_CHUNK), bool))

    def step(carry, inp):
        cmat, nvec, m = carry
        qc, kc, vc, ic, fc = inp
        b = jnp.cumsum(fc, axis=-1)
        log_d = jnp.where(tri, b[..., :, None] - b[..., None, :] + ic[..., None, :], -jnp.inf)
        log_inter = b + m[..., None]
        m_t = jnp.maximum(log_inter, jnp.max(log_d, axis=-1))
        d = jnp.exp(log_d - m_t[..., None])
        w_inter = jnp.exp(log_inter - m_t)
        s = jnp.einsum('bhtd,bhsd->bhts', qc, kc) * d
        num = jnp.einsum('bhts,bhsv->bhtv', s, vc) + w_inter[..., None] * jnp.einsum('bhtd,bhdv->bhtv', qc, cmat)
        den = jnp.sum(s, -1) + w_inter * jnp.einsum('bhtd,bhd->bht', qc, nvec)
        h = num / jnp.maximum(jnp.abs(den), jnp.exp(-m_t))[..., None]
        m_new = m_t[..., -1]
        w_state = jnp.exp(b[..., -1:] - b + ic - m_new[..., None])
        decay = jnp.exp(b[..., -1] + m - m_new)
        cmat = decay[..., None, None] * cmat + jnp.einsum('bhs,bhsd,bhsv->bhdv', w_state, kc, vc)
        nvec = decay[..., None] * nvec + jnp.einsum('bhs,bhsd->bhd', w_state, kc)
        return (cmat, nvec, m_new), h

    state, hs = lax.scan(step, state, tuple(_chunks(a) for a in (q, k, v, ig, lf)))
    return _unchunk(hs), state


def gla_scan(state, q, k, v, lg):
    tri = jnp.tril(jnp.ones((SCAN_CHUNK, SCAN_CHUNK), bool))

    def step(smat, inp):
        qc, kc, vc, gc = inp
        b = jnp.cumsum(gc, axis=2)
        q_t = qc * jnp.exp(b)
        k_t = kc * jnp.exp(-b)
        a = jnp.where(tri, jnp.einsum('bhtd,bhsd->bhts', q_t, k_t), 0.0)
        o = jnp.einsum('bhts,bhsv->bhtv', a, vc) + jnp.einsum('bhtd,bhdv->bhtv', q_t, smat)
        b_last = b[:, :, -1:, :]
        smat = jnp.exp(b_last[:, :, 0])[..., None] * smat + jnp.einsum('bhsd,bhsv->bhdv', kc * jnp.exp(b_last - b), vc)
        return smat, o

    state, os_ = lax.scan(step, state, tuple(_chunks(a) for a in (q, k, v, lg)))
    return _unchunk(os_), state


def bidirectional(scan, init, ctx_fwd, ctx_bwd, lat_fwd, lat_bwd):
    flip = lambda ts: tuple(jnp.flip(t, axis=2) for t in ts)
    c_f, s_f = scan(init, *ctx_fwd)
    l_f, _ = scan(s_f, *lat_fwd)
    c_b, s_b = scan(init, *flip(ctx_bwd))
    l_b, _ = scan(s_b, *flip(lat_bwd))
    return c_f + jnp.flip(c_b, 2), l_f + jnp.flip(l_b, 2)


def window_attention(q, k, v, kc, vc, sink):
    b_, _, s_, hd = q.shape
    nb = s_ // WIN_BLOCK
    qg = (q * hd ** -0.5).reshape(b_, ATTN_KV_HEADS, ATTN_GROUP, nb, WIN_BLOCK, hd)

    def band(a):
        ap = jnp.pad(a, ((0, 0), (0, 0), (WIN_BLOCK, WIN_BLOCK), (0, 0))).reshape(b_, ATTN_KV_HEADS, nb + 2, WIN_BLOCK, hd)
        return jnp.concatenate([ap[:, :, :-2], ap[:, :, 1:-1], ap[:, :, 2:]], axis=3)

    kb, vb = band(k), band(v)
    qpos = jnp.arange(nb)[:, None, None] * WIN_BLOCK + jnp.arange(WIN_BLOCK)[None, :, None]
    kpos = jnp.arange(nb)[:, None, None] * WIN_BLOCK - WIN_BLOCK + jnp.arange(3 * WIN_BLOCK)[None, None, :]
    valid = (jnp.abs(kpos - qpos) <= WINDOW) & (kpos >= 0) & (kpos < s_)
    s_loc = jnp.where(valid, jnp.einsum('bkgnqd,bknjd->bkgnqj', qg, kb).astype(jnp.float32), -jnp.inf)
    s_ctx = jnp.einsum('bkgnqd,bkcd->bkgnqc', qg, kc).astype(jnp.float32)
    s_sink = jnp.broadcast_to(sink.astype(jnp.float32).reshape(ATTN_KV_HEADS, ATTN_GROUP, 1, 1, 1), s_ctx.shape[:-1] + (1,))
    p = jax.nn.softmax(jnp.concatenate([s_loc, s_ctx, s_sink], -1), axis=-1).astype(v.dtype)
    n_loc, n_ctx = 3 * WIN_BLOCK, kc.shape[2]
    out = (jnp.einsum('bkgnqj,bknjd->bkgnqd', p[..., :n_loc], vb)
           + jnp.einsum('bkgnqc,bkcd->bkgnqd', p[..., n_loc:n_loc + n_ctx], vc))
    return out.reshape(b_, ATTN_HEADS, s_, hd)


def context_attention(qc, kc, vc, sink):
    b_, _, n_ctx, hd = qc.shape
    qg = (qc * hd ** -0.5).reshape(b_, ATTN_KV_HEADS, ATTN_GROUP, n_ctx, hd)
    s = jnp.einsum('bkgqd,bkcd->bkgqc', qg, kc).astype(jnp.float32)
    s_sink = jnp.broadcast_to(sink.astype(jnp.float32).reshape(ATTN_KV_HEADS, ATTN_GROUP, 1, 1), s.shape[:-1] + (1,))
    p = jax.nn.softmax(jnp.concatenate([s, s_sink], -1), axis=-1).astype(vc.dtype)
    out = jnp.einsum('bkgqc,bkcd->bkgqd', p[..., :n_ctx], vc)
    return out.reshape(b_, ATTN_HEADS, n_ctx, hd)


def mixer(h, hc, w_in, gate_b, mnorm_w, sink, g_up, g_b, gnorm_w, w_out, row, col, with_ctx_out):
    f32 = jnp.float32
    pl = jnp.split(h @ w_in, COL_OFFSETS, axis=-1)
    pc = jnp.split(hc @ w_in, COL_OFFSETS, axis=-1)
    b_ = h.shape[0]

    def mlstm_in(p):
        t_ = p[0].shape[1]
        q = to_heads(p[0], MLSTM_HEADS).astype(f32)
        k = to_heads(p[1], MLSTM_HEADS).astype(f32) * MLSTM_DH ** -0.5
        v = to_heads(p[2], MLSTM_HEADS).astype(f32)
        g = p[4].astype(f32).reshape(b_, t_, 2, 2, MLSTM_HEADS) + gate_b.astype(f32)
        g = jnp.transpose(g, (2, 3, 0, 4, 1))
        ig, lf = g[:, 0], jax.nn.log_sigmoid(g[:, 1])
        return [(q, k, v, ig[d], lf[d]) for d in range(2)]

    mc, ml = mlstm_in(pc), mlstm_in(pl)
    m_init = (jnp.zeros((b_, MLSTM_HEADS, MLSTM_DH, MLSTM_DH), f32),
              jnp.zeros((b_, MLSTM_HEADS, MLSTM_DH), f32),
              jnp.zeros((b_, MLSTM_HEADS), f32))
    m_ctx, m_lat = bidirectional(mlstm_scan, m_init, mc[0], mc[1], ml[0], ml[1])
    mlstm_out = lambda hs, p: (head_norm(from_heads(hs), mnorm_w, MLSTM_HEADS) * jax.nn.sigmoid(p[3].astype(f32))).astype(h.dtype)

    ql = axial_rope(to_heads(pl[5], ATTN_HEADS), row, col)
    kl = axial_rope(to_heads(pl[6], ATTN_KV_HEADS), row, col)
    vl = to_heads(pl[7], ATTN_KV_HEADS)
    kc, vc = to_heads(pc[6], ATTN_KV_HEADS), to_heads(pc[7], ATTN_KV_HEADS)
    a_lat = from_heads(window_attention(ql, kl, vl, kc, vc, sink))

    def gla_in(p):
        t_ = p[8].shape[1]
        q = to_heads(p[8], GLA_HEADS).astype(f32) * GLA_DK ** -0.5
        k = to_heads(p[9], GLA_HEADS).astype(f32)
        v = to_heads(p[10], GLA_HEADS).astype(f32)
        z = jnp.einsum('btzr,zrk->zbtk', p[12].astype(f32).reshape(b_, t_, 2, GLA_RANK), g_up.astype(f32)) + g_b.astype(f32)[:, None, None, :]
        lg = jax.nn.log_sigmoid(z) / GLA_TAU
        lg = jnp.transpose(lg.reshape(2, b_, t_, GLA_HEADS, GLA_DK), (0, 1, 3, 2, 4))
        return [(q, k, v, lg[d]) for d in range(2)]

    gc, gl = gla_in(pc), gla_in(pl)
    g_init = jnp.zeros((b_, GLA_HEADS, GLA_DK, GLA_DV), f32)
    g_ctx, g_lat = bidirectional(gla_scan, g_init, gc[0], gc[1], gl[0], gl[1])
    gla_out = lambda o, p: (head_norm(from_heads(o), gnorm_w, GLA_HEADS) * jax.nn.silu(p[11].astype(f32))).astype(h.dtype)

    lat = jnp.concatenate([mlstm_out(m_lat, pl), a_lat, gla_out(g_lat, pl)], -1) @ w_out
    if not with_ctx_out:
        return lat, None
    a_ctx = from_heads(context_attention(to_heads(pc[5], ATTN_HEADS), kc, vc, sink))
    ctx_o = jnp.concatenate([mlstm_out(m_ctx, pc), a_ctx, gla_out(g_ctx, pc)], -1) @ w_out
    return lat, ctx_o


def swiglu(h, w_gu, w_down):
    g, u = jnp.split(h @ w_gu, 2, axis=-1)
    return (jax.nn.silu(g) * u) @ w_down


def moe_swiglu(h, w_router, b_router, w_gu, w_down):
    n, d = h.shape
    logits = jnp.dot(h, w_router).astype(jnp.float32) + b_router.astype(jnp.float32)
    top_logits, top_e = lax.top_k(logits, TOP_K)
    top_w = jax.nn.softmax(top_logits, axis=-1)
    n_assign = n * TOP_K
    e_flat = top_e.reshape(-1)
    tok_flat = jnp.repeat(jnp.arange(n, dtype=jnp.int32), TOP_K)
    w_flat = top_w.reshape(-1)
    order = jnp.argsort(e_flat)
    e_sorted = e_flat[order]
    counts = jnp.bincount(e_flat, length=N_EXPERTS)
    padded = (counts + MOE_BLOCK - 1) // MOE_BLOCK * MOE_BLOCK
    start = jnp.cumsum(counts) - counts
    pend = jnp.cumsum(padded)
    pstart = pend - padded
    slot = pstart[e_sorted] + jnp.arange(n_assign) - start[e_sorted]
    n_blocks = -(-n_assign // MOE_BLOCK) + N_EXPERTS
    slot_tok = jnp.full((n_blocks * MOE_BLOCK,), n, jnp.int32).at[slot].set(tok_flat[order])
    slot_w = jnp.zeros((n_blocks * MOE_BLOCK,), jnp.float32).at[slot].set(w_flat[order])
    block_e = jnp.minimum(jnp.searchsorted(pend, jnp.arange(n_blocks) * MOE_BLOCK, side='right'), N_EXPERTS - 1)
    h_pad = jnp.concatenate([h, jnp.zeros((1, d), h.dtype)], 0)
    xb = h_pad[slot_tok].reshape(n_blocks, MOE_BLOCK, d)

    def expert_block(args):
        xblk, e = args
        g, u = jnp.split(xblk @ w_gu[e], 2, axis=-1)
        return (jax.nn.silu(g) * u) @ w_down[e]

    yb = lax.map(expert_block, (xb, block_e))
    y = jnp.zeros((n + 1, d), jnp.float32).at[slot_tok].add(yb.reshape(-1, d).astype(jnp.float32) * slot_w[:, None])
    return y[:n].astype(h.dtype)


def setup_inputs(seed: int = 0) -> dict:
    key = jax.random.key(seed)
    ks = jax.random.split(key, 24)
    nrm = lambda k, shape, s=1.0: jax.random.normal(k, shape, jnp.float32) * s
    D = D_MODEL
    gate_base = jnp.stack([jnp.zeros((MLSTM_HEADS,), jnp.float32), jnp.linspace(3.0, 6.0, MLSTM_HEADS)])
    return {
        'x': nrm(ks[0], (BATCH, SEQ, D)),
        'c': nrm(ks[1], (BATCH, D)),
        'ctx': nrm(ks[2], (BATCH, CTX_LEN, D)),
        'c_ctx': nrm(ks[3], (D,)),
        'w_ada': nrm(ks[4], (DEPTH, D, 6 * D), ADA_INIT * D ** -0.5),
        'b_ada': nrm(ks[5], (DEPTH, 6 * D), 0.02),
        'w_in': nrm(ks[6], (DEPTH, D, IN_COLS), D ** -0.5),
        'mlstm_gate_b': gate_base[None, None] + nrm(ks[7], (DEPTH, 2, 2, MLSTM_HEADS), 0.1),
        'mlstm_norm_w': 1.0 + nrm(ks[8], (DEPTH, MLSTM_WIDTH), 0.02),
        'attn_sink': nrm(ks[9], (DEPTH, ATTN_HEADS), 0.5),
        'gla_gate_up': nrm(ks[10], (DEPTH, 2, GLA_RANK, GLA_KEY_WIDTH), GLA_RANK ** -0.5),
        'gla_gate_b': nrm(ks[11], (DEPTH, 2, GLA_KEY_WIDTH), 0.1),
        'gla_norm_w': 1.0 + nrm(ks[12], (DEPTH, GLA_WIDTH), 0.02),
        'w_out': nrm(ks[13], (DEPTH, MIX_WIDTH, D), DEEPNORM_BETA * MIX_WIDTH ** -0.5),
        'ln_w': 1.0 + nrm(ks[14], (DEPTH, 2, D), 0.02),
        'ln_b': nrm(ks[15], (DEPTH, 2, D), 0.02),
        'ffn_w_gu': nrm(ks[16], (N_DENSE, D, 2 * D_FF), D ** -0.5),
        'ffn_w_down': nrm(ks[17], (N_DENSE, D_FF, D), DEEPNORM_BETA * D_FF ** -0.5),
        'router_w': nrm(ks[18], (N_MOE, D, N_EXPERTS), D ** -0.5),
        'router_b': nrm(ks[19], (N_MOE, N_EXPERTS), 0.01),
        'moe_w_gu': nrm(ks[20], (N_MOE, N_EXPERTS, D, 2 * D_EXPERT), D ** -0.5),
        'moe_w_down': nrm(ks[21], (N_MOE, N_EXPERTS, D_EXPERT, D), DEEPNORM_BETA * D_EXPERT ** -0.5),
    }


def reference(x, c, ctx, c_ctx, w_ada, b_ada, w_in, mlstm_gate_b, mlstm_norm_w, attn_sink,
              gla_gate_up, gla_gate_b, gla_norm_w, w_out, ln_w, ln_b, ffn_w_gu, ffn_w_down,
              router_w, router_b, moe_w_gu, moe_w_down):
    b_, seq, d = x.shape
    n_ctx = ctx.shape[1]
    rows = seq // GRID_W
    row = jnp.repeat(jnp.arange(rows), GRID_W)
    col = jnp.tile(jnp.arange(GRID_W), rows)
    sc, scc = jax.nn.silu(c), jax.nn.silu(c_ctx)
    xc = ctx
    for l in range(DEPTH):
        last = l == DEPTH - 1
        mod = (sc @ w_ada[l] + b_ada[l]).reshape(b_, 6, d)[:, :, None, :]
        modc = (scc @ w_ada[l] + b_ada[l]).reshape(6, d)
        h = x * (1.0 + mod[:, 1]) + mod[:, 0]
        hc = xc * (1.0 + modc[1]) + modc[0]
        mix, mix_c = mixer(h, hc, w_in[l], mlstm_gate_b[l], mlstm_norm_w[l], attn_sink[l],
                           gla_gate_up[l], gla_gate_b[l], gla_norm_w[l], w_out[l], row, col, not last)
        x = layer_norm(DEEPNORM_ALPHA * x + mod[:, 2] * mix, ln_w[l, 0], ln_b[l, 0])
        h = x * (1.0 + mod[:, 4]) + mod[:, 3]
        if last:
            tokens = h
        else:
            xc = layer_norm(DEEPNORM_ALPHA * xc + modc[2] * mix_c, ln_w[l, 0], ln_b[l, 0])
            hc = xc * (1.0 + modc[4]) + modc[3]
            tokens = jnp.concatenate([hc, h], axis=1)
        if l % 2 == 0:
            y = swiglu(tokens, ffn_w_gu[l // 2], ffn_w_down[l // 2])
        else:
            y = moe_swiglu(tokens.reshape(-1, d), router_w[l // 2], router_b[l // 2],
                           moe_w_gu[l // 2], moe_w_down[l // 2]).reshape(tokens.shape)
        if not last:
            y_c, y = y[:, :n_ctx], y[:, n_ctx:]
            xc = layer_norm(DEEPNORM_ALPHA * xc + modc[5] * y_c, ln_w[l, 1], ln_b[l, 1])
        x = layer_norm(DEEPNORM_ALPHA * x + mod[:, 5] * y, ln_w[l, 1], ln_b[l, 1])
    return x
```

```cpp
#include <hip/hip_runtime.h>
#include <cstdio>
#include <cstdint>

#ifndef MK_ONE_LAUNCH
#define MK_ONE_LAUNCH 0
#endif

#define LAS __attribute__((address_space(3)))
#define GAS __attribute__((address_space(1)))
typedef unsigned short bf16_t;
typedef short bf16x8 __attribute__((ext_vector_type(8)));
typedef float f32x4 __attribute__((ext_vector_type(4)));
typedef unsigned u32x4 __attribute__((ext_vector_type(4)));

constexpr int DM = 1024, SEQ = 16384, NCTX = 256, TT = SEQ + NCTX, DEPTH = 4;
constexpr int IN_COLS = 2608, NPIN = 2816, LDP = 2816;
constexpr int C_MQ = 0, C_MK = 256, C_MV = 512, C_MO = 768, C_AQ = 1024, C_AK = 1536, C_AV = 1664, C_GQ = 1792, C_GK = 1920, C_GV = 2048, C_GG = 2304, C_MG = 2560, C_GGT = 2576, C_END = 2608;
constexpr int DFF = 2816, DEXP = 3584, NEXP = 8;
constexpr int NCH = 260;
constexpr int NSLOT = 138 * 256;
constexpr float ALPHA = 1.6817928305074290f;
constexpr float LN_EPS = 1e-5f;
constexpr int NPH = 2 + 10 * DEPTH;

constexpr size_t al256(size_t x) { return (x + 255) & ~size_t(255); }
constexpr size_t WS_CTL = 0, CTL_BYTES = 2u << 20;
constexpr size_t WS_MODS = 1u << 20;
constexpr size_t WS_ROPE = CTL_BYTES;
constexpr size_t WS_TOKE = WS_ROPE + 32768;
constexpr size_t WS_TOKP = WS_TOKE + al256((size_t)TT * 8);
constexpr size_t WS_TOKW = WS_TOKP + al256((size_t)TT * 8);
constexpr size_t WS_TOKS = WS_TOKW + al256((size_t)TT * 8);
constexpr size_t WS_WIN = WS_TOKS + al256((size_t)TT * 8);
constexpr size_t WS_WOUT = WS_WIN + (size_t)DEPTH * NPIN * DM * 2;
constexpr size_t WS_FGU = WS_WOUT + (size_t)DEPTH * DM * DM * 2;
constexpr size_t WS_FDN = WS_FGU + (size_t)2 * 2 * DFF * DM * 2;
constexpr size_t WS_MGU = WS_FDN + (size_t)2 * DM * DFF * 2;
constexpr size_t WS_MDN = WS_MGU + (size_t)16 * 2 * DEXP * DM * 2;
constexpr size_t WS_X = WS_MDN + (size_t)16 * DM * DEXP * 2;
constexpr size_t WS_H = WS_X + (size_t)TT * DM * 4;
constexpr size_t WS_P = WS_H + (size_t)TT * DM * 2;
constexpr size_t WS_G = WS_P + (size_t)TT * LDP * 2;
constexpr size_t WS_CAT = WS_G + al256((size_t)TT * 48 * 4);
constexpr size_t WS_Y = WS_CAT + (size_t)TT * DM * 2;
constexpr size_t WS_ACT = WS_Y + (size_t)TT * DM * 4;
constexpr size_t WS_XB = WS_ACT + (size_t)NSLOT * DEXP * 2;
constexpr size_t WS_YS = WS_XB + (size_t)NSLOT * DM * 2;
constexpr size_t WS_MU = WS_YS + (size_t)NSLOT * DM * 4;
constexpr size_t WS_MC = WS_MU + (size_t)8 * NCH * 4096 * 4;
constexpr size_t WS_MNU = WS_MC + (size_t)8 * NCH * 4096 * 4;
constexpr size_t WS_MNS = WS_MNU + (size_t)8 * NCH * 64 * 4;
constexpr size_t WS_MSC = WS_MNS + (size_t)8 * NCH * 64 * 4;
constexpr size_t WS_GU = WS_MSC + al256((size_t)8 * NCH * 4 * 4);
constexpr size_t WS_GS = WS_GU + (size_t)8 * NCH * 2048 * 4;
constexpr size_t WS_GDEC = WS_GS + (size_t)8 * NCH * 2048 * 4;
constexpr size_t WS_END = WS_GDEC + (size_t)8 * NCH * 32 * 4;

constexpr int CW_BAR = 4096;
constexpr int CW_MOE = 16384;

constexpr int LDS_BYTES = 147456, MISC_OFF = 147200;

__device__ __forceinline__ float bf2f(unsigned v) { return __uint_as_float(v << 16); }
__device__ __forceinline__ unsigned f2bf(float f) { unsigned u = __float_as_uint(f); return (u + 0x7fffu + ((u >> 16) & 1u)) >> 16; }
__device__ __forceinline__ unsigned pk2(float lo, float hi) { return f2bf(lo) | (f2bf(hi) << 16); }
__device__ __forceinline__ void load8bf(const bf16_t* p, float* o) {
    const uint4 v = *(const uint4*)p;
    o[0] = __uint_as_float(v.x << 16); o[1] = __uint_as_float(v.x & 0xffff0000u); o[2] = __uint_as_float(v.y << 16); o[3] = __uint_as_float(v.y & 0xffff0000u);
    o[4] = __uint_as_float(v.z << 16); o[5] = __uint_as_float(v.z & 0xffff0000u); o[6] = __uint_as_float(v.w << 16); o[7] = __uint_as_float(v.w & 0xffff0000u);
}
__device__ __forceinline__ float wave_sum(float v) {
#pragma unroll
    for (int o = 1; o < 64; o <<= 1) v += __shfl_xor(v, o);
    return v;
}
__device__ __forceinline__ float wave_max(float v) {
#pragma unroll
    for (int o = 1; o < 64; o <<= 1) v = fmaxf(v, __shfl_xor(v, o));
    return v;
}
__device__ __forceinline__ float scan_add(float v, int lane) {
#pragma unroll
    for (int o = 1; o < 64; o <<= 1) { const float t = __shfl_up(v, o); if (lane >= o) v += t; }
    return v;
}
__device__ __forceinline__ float scan_max(float v, int lane) {
#pragma unroll
    for (int o = 1; o < 64; o <<= 1) { const float t = __shfl_up(v, o); if (lane >= o) v = fmaxf(v, t); }
    return v;
}
__device__ __forceinline__ float siluf(float x) { return x / (1.f + __expf(-x)); }
__device__ __forceinline__ float sigmoidf_(float x) { return 1.f / (1.f + __expf(-x)); }
__device__ __forceinline__ float log_sigmoidf_(float x) { return fminf(x, 0.f) - log1pf(__expf(-fabsf(x))); }
#define LDS_WAIT() asm volatile("s_waitcnt lgkmcnt(0)" ::: "memory")

namespace pg8 {
constexpr int BM = 256, BK = 64, HALF = 128, HTB = HALF * BK * 2, STAGE_BYTES = 8 * HTB, NXCD = 8, WGM = 8;
__host__ __device__ __forceinline__ int lds_byte(int r, int c) { const int st = (r >> 4) * 2 + (c >> 5), rr = r & 15, cc = c & 31, ob = rr * 64 + cc * 2; return st * 1024 + (ob ^ (((ob >> 9) & 1) << 5)); }
__host__ __device__ __forceinline__ void stage_rc(int b, int& R, int& C) { const int st = b / 1024, sb = b % 1024, swz = sb ^ (((sb >> 9) & 1) << 5); R = (st >> 1) * 16 + swz / 64; C = (st & 1) * 32 + (swz % 64) / 2; }
__host__ __device__ __forceinline__ int perm32(int rho) { const int n = rho >> 4, i = rho & 15; return 8 * (i >> 2) + 4 * n + (i & 3); }
struct Unit { int pm, pn; };

struct StaticOrder {
    const char* A; const char* Bt; int K;
    int nM, nN, nwg, G, c;
    __device__ void init(const void* A_, const void* Bt_, int K_, int M, int N, int G_, int c_) { A = (const char*)A_; Bt = (const char*)Bt_; K = K_; nM = M / BM; nN = N / BM; nwg = nM * nN; G = G_; c = c_; }
    __device__ bool next(int i, Unit& u) const {
        const long L = (long)i * G + c; if (L >= nwg) return false;
        int wgid = (int)L; { const int q = nwg / NXCD, r = nwg % NXCD, xcd = wgid % NXCD, off = wgid / NXCD; wgid = (xcd < r ? xcd * (q + 1) : r * (q + 1) + (xcd - r) * q) + off; }
        const int nig = WGM * nN, gid = wgid / nig, fm = gid * WGM, gsz = (nM - fm) < WGM ? (nM - fm) : WGM;
        u.pm = fm + ((wgid % nig) % gsz); u.pn = (wgid % nig) / gsz; return true;
    }
    __device__ __forceinline__ const char* aptr(const Unit& u) const { return A + (size_t)u.pm * BM * K * 2; }
    __device__ __forceinline__ const char* bptr(const Unit& u) const { return Bt + (size_t)u.pn * BM * K * 2; }
};
struct MoeOrder {
    const char* A; const char* Bt; int K, N, nN, ntile, G, c;
    int ts1, ts2, ts3, ts4, ts5, ts6, ts7;
    __device__ bool next(int i, Unit& u) const {
        const long L = (long)i * G + c; if (L >= (long)ntile * nN) return false;
        u.pm = (int)(L / nN); u.pn = (int)(L % nN); return true;
    }
    __device__ __forceinline__ int expert(int pm) const { return (pm >= ts1) + (pm >= ts2) + (pm >= ts3) + (pm >= ts4) + (pm >= ts5) + (pm >= ts6) + (pm >= ts7); }
    __device__ __forceinline__ const char* aptr(const Unit& u) const { return A + (size_t)u.pm * BM * K * 2; }
    __device__ __forceinline__ const char* bptr(const Unit& u) const { return Bt + ((size_t)expert(u.pm) * N + (size_t)u.pn * BM) * K * 2; }
};

template <class Epi, class Sched>
__device__ __forceinline__ void gemm_phase(LAS unsigned char* lds, const int K, const Sched& S, const Epi& E, const int tid) {
    const int wid = __builtin_amdgcn_readfirstlane(tid >> 6), lane = tid & 63, wr = wid >> 2, wc = wid & 3, fr = lane & 15, fq = lane >> 4;
    const int nt = K / BK;
    unsigned voffA[2], voffB[2];
#pragma unroll
    for (int i = 0; i < 2; ++i) { int R, C; stage_rc(tid * 16 + i * 8192, R, C); const int Rb = Epi::PERM ? ((R & ~31) + perm32(R & 31)) : R;
        voffA[i] = (unsigned)(R * K + C) * 2u; voffB[i] = (unsigned)(Rb * K + C) * 2u; }
    const size_t kstep = (size_t)(BK * 2);
    const size_t hstep = (size_t)HALF * K * 2;
    const unsigned ldsw = (unsigned)wid * 1024u;
    const int aoff = lds_byte(wr * 64 + fr, fq * 8), boff = lds_byte(wc * 32 + fr, fq * 8);
#define PG8_SA(b, h) (((b) * 2 + (h)) * HTB)
#define PG8_SB(b, h) ((4 + (b) * 2 + (h)) * HTB)
#define PG8_STAGE(bufoff, gbase, voff) do { _Pragma("unroll") for (int _i = 0; _i < 2; ++_i) \
        __builtin_amdgcn_global_load_lds((const unsigned*)((const char*)(gbase) + (voff)[_i]), (LAS unsigned*)(lds + (bufoff) + ldsw + _i * 8192), 16, 0, 0); } while (0)
#define PG8_LDA(dst, b, h) do { _Pragma("unroll") for (int m = 0; m < 4; ++m) _Pragma("unroll") for (int k = 0; k < 2; ++k) dst[m][k] = *(const LAS bf16x8*)(lds + PG8_SA(b, h) + aoff + m * 2048 + k * 1024); } while (0)
#define PG8_LDB(dst, b, h) do { _Pragma("unroll") for (int n = 0; n < 2; ++n) _Pragma("unroll") for (int k = 0; k < 2; ++k) dst[n][k] = *(const LAS bf16x8*)(lds + PG8_SB(b, h) + boff + n * 2048 + k * 1024); } while (0)
#define PG8_MMA(ai, bj, At, Bt) do { __builtin_amdgcn_s_setprio(1); _Pragma("unroll") for (int m = 0; m < 4; ++m) _Pragma("unroll") for (int n = 0; n < 2; ++n) _Pragma("unroll") for (int k = 0; k < 2; ++k) \
        acc[ai][bj][m][n] = __builtin_amdgcn_mfma_f32_16x16x32_bf16(Bt[n][k], At[m][k], acc[ai][bj][m][n], 0, 0, 0); __builtin_amdgcn_s_setprio(0); } while (0)
#define PG8_WAIT_V(n) asm volatile("s_waitcnt vmcnt(" #n ")" ::: "memory")
#define PG8_WAIT_L(n) asm volatile("s_waitcnt lgkmcnt(" #n ")" ::: "memory")
#define PG8_BAR __builtin_amdgcn_s_barrier()
#define PG8_SCHED __builtin_amdgcn_sched_barrier(0)
    Unit cur, nxt; int ui = 0;
    if (!S.next(0, cur)) return;
    f32x4 acc[2][2][4][2];
#pragma unroll
    for (int a = 0; a < 2; ++a)
#pragma unroll
        for (int b = 0; b < 2; ++b)
#pragma unroll
            for (int m = 0; m < 4; ++m)
#pragma unroll
                for (int n = 0; n < 2; ++n) acc[a][b][m][n] = (f32x4){0.f, 0.f, 0.f, 0.f};
    bf16x8 At[4][2], B0[2][2], B1[2][2];
    const char* cA = S.aptr(cur); const char* cB = S.bptr(cur);
    PG8_STAGE(PG8_SB(0, 0), cB, voffB); PG8_STAGE(PG8_SB(0, 1), cB + hstep, voffB); PG8_STAGE(PG8_SA(0, 0), cA, voffA); PG8_STAGE(PG8_SA(0, 1), cA + hstep, voffA);
    if (wr == 1) PG8_BAR;
    PG8_WAIT_V(2); PG8_BAR;
    PG8_STAGE(PG8_SB(1, 0), cB + kstep, voffB); PG8_STAGE(PG8_SA(1, 0), cA + kstep, voffA); PG8_STAGE(PG8_SB(1, 1), cB + hstep + kstep, voffB);
    PG8_WAIT_V(6); PG8_BAR;
    for (;;) {
        const bool has_next = S.next(ui + 1, nxt);
        const char* nA = has_next ? S.aptr(nxt) : cA; const char* nB = has_next ? S.bptr(nxt) : cB;
        for (int t = 0; t < nt; t += 2) {
            const bool last = (t == nt - 2);
            const char* a1 = cA + (size_t)(t + 1) * kstep;
            const char* a2 = last ? nA : cA + (size_t)(t + 2) * kstep; const char* b2 = last ? nB : cB + (size_t)(t + 2) * kstep;
            const char* a3 = a2 + kstep; const char* b3 = b2 + kstep;
            PG8_LDB(B0, 0, 0); PG8_LDB(B1, 0, 1); PG8_SCHED; PG8_LDA(At, 0, 0); PG8_STAGE(PG8_SA(1, 1), a1 + hstep, voffA);
            PG8_WAIT_V(8); PG8_WAIT_L(0); PG8_BAR; PG8_MMA(0, 0, At, B0); PG8_MMA(0, 1, At, B1); PG8_BAR; PG8_SCHED;
            PG8_LDA(At, 0, 1); PG8_STAGE(PG8_SB(0, 0), b2, voffB); PG8_STAGE(PG8_SB(0, 1), b2 + hstep, voffB); PG8_STAGE(PG8_SA(0, 0), a2, voffA);
            PG8_WAIT_V(8); PG8_WAIT_L(0); PG8_BAR; PG8_MMA(1, 0, At, B0); PG8_MMA(1, 1, At, B1); PG8_BAR; PG8_SCHED;
            PG8_LDB(B0, 1, 0); PG8_LDB(B1, 1, 1); PG8_SCHED; PG8_LDA(At, 1, 0); PG8_STAGE(PG8_SA(0, 1), a2 + hstep, voffA);
            PG8_WAIT_V(8); PG8_WAIT_L(0); PG8_BAR; PG8_MMA(0, 0, At, B0); PG8_MMA(0, 1, At, B1); PG8_BAR; PG8_SCHED;
            PG8_LDA(At, 1, 1); PG8_STAGE(PG8_SB(1, 0), b3, voffB); PG8_STAGE(PG8_SB(1, 1), b3 + hstep, voffB); PG8_STAGE(PG8_SA(1, 0), a3, voffA);
            PG8_WAIT_V(8); PG8_WAIT_L(0); PG8_BAR; PG8_MMA(1, 0, At, B0); PG8_MMA(1, 1, At, B1); PG8_BAR; PG8_SCHED;
        }
        if (wr == 0) PG8_BAR;
        { int fr_ = fr, fq_ = fq; asm volatile("" : "+v"(fr_), "+v"(fq_));
          E(acc, cur, wr, wc, fr_, fq_); }
        if (!has_next) break;
#pragma unroll
        for (int a = 0; a < 2; ++a)
#pragma unroll
            for (int b = 0; b < 2; ++b)
#pragma unroll
                for (int m = 0; m < 4; ++m)
#pragma unroll
                    for (int n = 0; n < 2; ++n) acc[a][b][m][n] = (f32x4){0.f, 0.f, 0.f, 0.f};
        cur = nxt; cA = nA; cB = nB; ++ui;
        if (wr == 1) PG8_BAR;
    }
    PG8_WAIT_V(0);
    PG8_BAR;
#undef PG8_SA
#undef PG8_SB
#undef PG8_STAGE
#undef PG8_LDA
#undef PG8_LDB
#undef PG8_MMA
#undef PG8_WAIT_V
#undef PG8_WAIT_L
#undef PG8_BAR
#undef PG8_SCHED
}


struct EpiInProj {
    static constexpr bool PERM = true;
    bf16_t* P; float* Gt; const float* ropeC; const float* ropeS;
    __device__ __forceinline__ void operator()(const f32x4 (&acc)[2][2][4][2], const Unit& u, int wr, int wc, int fr, int fq) const {
        const int row0 = u.pm * BM + wr * 64 + fr;
        const bool latent = u.pm < (SEQ / BM);
#pragma unroll
        for (int bj = 0; bj < 2; ++bj) {
            const int colg = u.pn * BM + bj * HALF + wc * 32;
            const bool rope = latent && colg >= C_AQ && colg < C_AV;
            const bool gate = colg >= C_MG && colg < C_END;
            const int col0 = colg + 8 * fq;
#pragma unroll
            for (int ai = 0; ai < 2; ++ai)
#pragma unroll
                for (int m = 0; m < 4; ++m) {
                    const int row = row0 + ai * HALF + m * 16;
                    f32x4 v0 = acc[ai][bj][m][0], v1 = acc[ai][bj][m][1];
                    if (rope) {
                        const int pos = ((colg >> 5) & 1) ? (row & 63) : (row >> 6);
                        const f32x4 c0 = *(const f32x4*)(ropeC + pos * 16 + 8 * (fq & 1)), c1 = *(const f32x4*)(ropeC + pos * 16 + 8 * (fq & 1) + 4);
                        const f32x4 s0 = *(const f32x4*)(ropeS + pos * 16 + 8 * (fq & 1)), s1 = *(const f32x4*)(ropeS + pos * 16 + 8 * (fq & 1) + 4);
                        const float sg = (fq < 2) ? -1.f : 1.f;
                        f32x4 p0, p1;
#pragma unroll
                        for (int i = 0; i < 4; ++i) { p0[i] = __shfl_xor(v0[i], 32); p1[i] = __shfl_xor(v1[i], 32); }
#pragma unroll
                        for (int i = 0; i < 4; ++i) { v0[i] = v0[i] * c0[i] + sg * p0[i] * s0[i]; v1[i] = v1[i] * c1[i] + sg * p1[i] * s1[i]; }
                    }
                    u32x4 w; w.x = pk2(v0[0], v0[1]); w.y = pk2(v0[2], v0[3]); w.z = pk2(v1[0], v1[1]); w.w = pk2(v1[2], v1[3]);
                    *(u32x4*)(P + (size_t)row * LDP + col0) = w;
                    if (gate && col0 < C_END) { float* g = Gt + (size_t)row * 48 + (col0 - C_MG); *(f32x4*)g = v0; *(f32x4*)(g + 4) = v1; }
                    asm volatile("" ::: "memory");
                }
        }
    }
};
struct EpiResid {
    static constexpr bool PERM = false;
    const float* X; float* Y; const float* modl; const float* modc;
    __device__ __forceinline__ void operator()(const f32x4 (&acc)[2][2][4][2], const Unit& u, int wr, int wc, int fr, int fq) const {
        const int row0 = u.pm * BM + wr * 64 + fr, col0 = u.pn * BM + wc * 32 + 4 * fq;
        const float* md = (u.pm < SEQ / BM) ? modl : modc;
        f32x4 mv[2][2];
#pragma unroll
        for (int bj = 0; bj < 2; ++bj)
#pragma unroll
            for (int n = 0; n < 2; ++n) mv[bj][n] = *(const f32x4*)(md + col0 + bj * HALF + n * 16);
#pragma unroll
        for (int ai = 0; ai < 2; ++ai)
#pragma unroll
            for (int m = 0; m < 4; ++m) { const size_t off = (size_t)(row0 + ai * HALF + m * 16) * DM + col0;
#pragma unroll
                for (int bj = 0; bj < 2; ++bj)
#pragma unroll
                    for (int n = 0; n < 2; ++n) { const f32x4 xv = *(const f32x4*)(X + off + bj * HALF + n * 16);
                        *(f32x4*)(Y + off + bj * HALF + n * 16) = xv * ALPHA + mv[bj][n] * acc[ai][bj][m][n]; }
                asm volatile("" ::: "memory"); }
    }
};
struct EpiSwiglu {
    static constexpr bool PERM = true;
    bf16_t* O; int ld;
    __device__ __forceinline__ void operator()(const f32x4 (&acc)[2][2][4][2], const Unit& u, int wr, int wc, int fr, int fq) const {
        const int row0 = u.pm * BM + wr * 64 + fr, col0 = u.pn * HALF + wc * 32 + 8 * fq;
#pragma unroll
        for (int ai = 0; ai < 2; ++ai)
#pragma unroll
            for (int m = 0; m < 4; ++m) {
                const f32x4 g0 = acc[ai][0][m][0], g1 = acc[ai][0][m][1], u0 = acc[ai][1][m][0], u1 = acc[ai][1][m][1];
                float r[8];
#pragma unroll
                for (int i = 0; i < 4; ++i) { r[i] = siluf(g0[i]) * u0[i]; r[4 + i] = siluf(g1[i]) * u1[i]; }
                u32x4 w; w.x = pk2(r[0], r[1]); w.y = pk2(r[2], r[3]); w.z = pk2(r[4], r[5]); w.w = pk2(r[6], r[7]);
                *(u32x4*)(O + (size_t)(row0 + ai * HALF + m * 16) * ld + col0) = w;
            }
    }
};
struct EpiF32 {
    static constexpr bool PERM = false;
    float* C;
    __device__ __forceinline__ void operator()(const f32x4 (&acc)[2][2][4][2], const Unit& u, int wr, int wc, int fr, int fq) const {
        const int row0 = u.pm * BM + wr * 64 + fr, col0 = u.pn * BM + wc * 32 + 4 * fq;
#pragma unroll
        for (int ai = 0; ai < 2; ++ai)
#pragma unroll
            for (int m = 0; m < 4; ++m) { float* rowp = C + (size_t)(row0 + ai * HALF + m * 16) * DM + col0;
#pragma unroll
                for (int bj = 0; bj < 2; ++bj)
#pragma unroll
                    for (int n = 0; n < 2; ++n) *(f32x4*)(rowp + bj * HALF + n * 16) = acc[ai][bj][m][n]; }
    }
};
}

#define XB_TMO      128
#define XB_XCNT(j)  (256  + 64 * (j))
#define XB_XSUB(j)  (1280 + 64 * (j))
#define XB_XGEN(j)  (2304 + 64 * (j))
#define XB_TOP      3328
#define XB_TOPGEN   3392
#define XCD_BAR_WORDS 3456
#define XB_SPIN_CAP (1u << 18)
__device__ __forceinline__ unsigned xb_ld(unsigned* p)              { return __hip_atomic_load(p, __ATOMIC_RELAXED, __HIP_MEMORY_SCOPE_AGENT); }
__device__ __forceinline__ unsigned xb_add(unsigned* p, unsigned v) { return __hip_atomic_fetch_add(p, v, __ATOMIC_RELAXED, __HIP_MEMORY_SCOPE_AGENT); }
__device__ __forceinline__ unsigned xb_xcc_id() { return (unsigned)__builtin_amdgcn_s_getreg((3 << 11) | 20) & 0xFu; }
#define XB_SPIN(cond, bar) do { unsigned _sp = 0; while (cond) { __builtin_amdgcn_s_sleep(1); \
    if ((++_sp & 255u) == 0u) { if (xb_ld(&(bar)[XB_TMO])) break; if (_sp > XB_SPIN_CAP) { atomicAdd(&(bar)[XB_TMO], 1u); break; } } } } while (0)
struct XcdBarrier { unsigned* bar; unsigned x; volatile LAS unsigned* st; };
__device__ __forceinline__ XcdBarrier xcd_barrier_post(unsigned* bar, volatile LAS unsigned* st) {
    XcdBarrier b; b.bar = bar; b.x = xb_xcc_id(); b.st = st;
    if (threadIdx.x == 0) (void)xb_add(&bar[XB_XCNT(b.x)], 1u);
    return b;
}
__device__ __forceinline__ void xcd_barrier_complete(unsigned* bar, unsigned x, unsigned& nloc, unsigned& nx) {
    const unsigned G = gridDim.x * gridDim.y * gridDim.z;
    unsigned sum, cnt, mine, sp = 0u;
    for (;;) {
        sum = 0u; cnt = 0u; mine = 0u;
#pragma unroll
        for (unsigned j = 0; j < 16; ++j) { const unsigned c = xb_ld(&bar[XB_XCNT(j)]); sum += c; cnt += (c > 0u) ? 1u : 0u; mine = (j == x) ? c : mine; }
        if (sum == G) break;
        __builtin_amdgcn_s_sleep(1);
        if ((++sp & 255u) == 0u) { if (xb_ld(&bar[XB_TMO])) break; if (sp > XB_SPIN_CAP) { atomicAdd(&bar[XB_TMO], 1u); break; } }
    }
    nloc = mine > 0u ? mine : 1u; nx = cnt > 0u ? cnt : 1u;
}
__device__ __forceinline__ void xcd_barrier(const XcdBarrier& b) {
    asm volatile("s_waitcnt vmcnt(0)" ::: "memory");
    __syncthreads();
    if (threadIdx.x == 0) {
        unsigned* bar = b.bar;
        __builtin_amdgcn_s_waitcnt(0);
        unsigned nloc = b.st[0], nx = b.st[1];
        if (nloc == 0u) { xcd_barrier_complete(bar, b.x, nloc, nx); b.st[0] = nloc; b.st[1] = nx; }
        const unsigned old = xb_add(&bar[XB_XSUB(b.x)], 1u);
        const unsigned gen = old / nloc;
        if (old + 1u == (gen + 1u) * nloc) {
            __builtin_amdgcn_fence(__ATOMIC_RELEASE, "agent");
            asm volatile("s_waitcnt vmcnt(0)" ::: "memory");
            const unsigned og = xb_add(&bar[XB_TOP], 1u);
            const unsigned tg = og / nx;
            if (og + 1u == (tg + 1u) * nx) xb_add(&bar[XB_TOPGEN], 1u);
            else XB_SPIN(xb_ld(&bar[XB_TOPGEN]) == tg, bar);
            __builtin_amdgcn_fence(__ATOMIC_ACQUIRE, "agent");
            xb_add(&bar[XB_XGEN(b.x)], 1u);
            asm volatile("s_waitcnt vmcnt(0)" ::: "memory");
        } else {
            XB_SPIN(xb_ld(&bar[XB_XGEN(b.x)]) == gen, bar);
            __builtin_amdgcn_fence(__ATOMIC_ACQUIRE, "agent");
            asm volatile("s_waitcnt vmcnt(0)" ::: "memory");
        }
    }
    __syncthreads();
}

struct Args { const float* in[22]; float* out; unsigned char* ws; int ph_lo, ph_hi; };

__device__ __forceinline__ int in_srccol(int r, float& sc) {
    sc = 1.f;
    if (r < 1024) { if (r >= C_MK && r < C_MV) sc = 0.125f; return r; }
    if (r < C_MG) { if (r < C_AK) sc = 0.125f; else if (r >= C_GQ && r < C_GK) sc = 0.17677669529663687f; return r + 16; }
    if (r < C_GGT) return r - C_MG + 1024;
    if (r < C_END) return r;
    return -1;
}
__device__ __forceinline__ void tr_item(const float* W, int K, int N, int NP, bf16_t* WT, int mode, int half, LAS float* scr, int item, int lane) {
    const int nblk = NP >> 6, kb = item / nblk, nb = item - kb * nblk, k0 = kb << 6, n0 = nb << 6;
    const int r = n0 + lane; float sc = 1.f; int src;
    if (mode == 0) src = r; else if (mode == 1) src = in_srccol(r, sc); else { const int pn = r >> 8, w = r & 255; src = (w < 128) ? (pn * 128 + w) : (half + pn * 128 + w - 128); }
    const float* wp = W + (size_t)k0 * N + (src < 0 ? 0 : src);
#pragma unroll 16
    for (int i = 0; i < 64; ++i) { const float v = wp[(size_t)i * N]; scr[i * 65 + lane] = (src < 0) ? 0.f : v * sc; }
    LDS_WAIT();
    const int c = lane & 7;
#pragma unroll
    for (int j = 0; j < 8; ++j) { const int n = (lane >> 3) + 8 * j; const LAS float* s = scr + (8 * c) * 65 + n;
        uint4 o; o.x = pk2(s[0], s[65]); o.y = pk2(s[130], s[195]); o.z = pk2(s[260], s[325]); o.w = pk2(s[390], s[455]);
        *(uint4*)(WT + (size_t)(n0 + n) * K + k0 + 8 * c) = o; }
    LDS_WAIT();
}

__device__ __forceinline__ void chunk_rows(int d, int jc, int& base, int& step) {
    int oc;
    if (d == 0) oc = (jc < 4) ? 256 + jc : jc - 4; else oc = (jc < 4) ? 256 + (3 - jc) : 255 - (jc - 4);
    const int b0 = (oc < 256) ? oc * 64 : SEQ + (oc - 256) * 64;
    if (d == 0) { base = b0; step = 1; } else { base = b0 + 63; step = -1; }
}
__device__ __forceinline__ int oc_to_jc(int d, int oc) { if (d == 0) return oc < 256 ? oc + 4 : oc - 256; return oc < 256 ? 4 + (255 - oc) : 3 - (oc - 256); }

__device__ __forceinline__ void attn_unit(LAS unsigned char* lds, const bf16_t* P, bf16_t* CAT, int qrow0, int hq, float sinkv, bool is_ctx, int qb, int tid) {
    LAS float* Qs = (LAS float*)lds; LAS float* Ks = Qs + 128 * 68; LAS float* Vs = Ks + 64 * 68; LAS float* Ps = Vs + 64 * 68;
    const int kvh = hq >> 2;
    __syncthreads();
    for (int i = tid; i < 128 * 8; i += 512) { const int r = i >> 3, c8 = i & 7; float f[8]; load8bf(P + (size_t)(qrow0 + r) * LDP + C_AQ + hq * 64 + c8 * 8, f);
        *(LAS f32x4*)(Qs + r * 68 + c8 * 8) = (f32x4){f[0], f[1], f[2], f[3]}; *(LAS f32x4*)(Qs + r * 68 + c8 * 8 + 4) = (f32x4){f[4], f[5], f[6], f[7]}; }
    const int q = tid >> 2, part = tid & 3;
    float m = sinkv, l = 1.f, O[16];
#pragma unroll
    for (int i = 0; i < 16; ++i) O[i] = 0.f;
    const int ntile = is_ctx ? 4 : 10;
    for (int kt = 0; kt < ntile; ++kt) {
        int krow0; bool masked;
        if (!is_ctx && kt < 6) { const int ks = (qb - 1) * 128 + kt * 64; if (ks < 0 || ks >= SEQ) continue; krow0 = ks; masked = true; }
        else { const int ct = is_ctx ? kt : kt - 6; krow0 = SEQ + ct * 64; masked = false; }
        __syncthreads();
        { const int r = tid >> 3, c8 = tid & 7; float f[8];
          load8bf(P + (size_t)(krow0 + r) * LDP + C_AK + kvh * 64 + c8 * 8, f);
          *(LAS f32x4*)(Ks + r * 68 + c8 * 8) = (f32x4){f[0], f[1], f[2], f[3]}; *(LAS f32x4*)(Ks + r * 68 + c8 * 8 + 4) = (f32x4){f[4], f[5], f[6], f[7]};
          load8bf(P + (size_t)(krow0 + r) * LDP + C_AV + kvh * 64 + c8 * 8, f);
          *(LAS f32x4*)(Vs + r * 68 + c8 * 8) = (f32x4){f[0], f[1], f[2], f[3]}; *(LAS f32x4*)(Vs + r * 68 + c8 * 8 + 4) = (f32x4){f[4], f[5], f[6], f[7]}; }
        __syncthreads();
        float s[16];
#pragma unroll
        for (int j = 0; j < 16; ++j) s[j] = 0.f;
#pragma unroll 4
        for (int d4 = 0; d4 < 16; ++d4) { const f32x4 qv = *(const LAS f32x4*)(Qs + q * 68 + 4 * d4);
#pragma unroll
            for (int j = 0; j < 16; ++j) { const f32x4 kv = *(const LAS f32x4*)(Ks + (part * 16 + j) * 68 + 4 * d4); s[j] += qv[0] * kv[0] + qv[1] * kv[1] + qv[2] * kv[2] + qv[3] * kv[3]; } }
        if (masked) { const int qi = qb * 128 + q;
#pragma unroll
            for (int j = 0; j < 16; ++j) { const int kj = krow0 + part * 16 + j; const int dd = qi - kj; if (dd > 128 || dd < -128) s[j] = -INFINITY; } }
        float tmax = s[0];
#pragma unroll
        for (int j = 1; j < 16; ++j) tmax = fmaxf(tmax, s[j]);
        tmax = fmaxf(tmax, __shfl_xor(tmax, 1)); tmax = fmaxf(tmax, __shfl_xor(tmax, 2));
        const float mn = fmaxf(m, tmax), alpha = __expf(m - mn); float psum = 0.f;
#pragma unroll
        for (int j = 0; j < 16; ++j) { const float p = __expf(s[j] - mn); Ps[q * 68 + part * 16 + j] = p; psum += p; }
        psum += __shfl_xor(psum, 1); psum += __shfl_xor(psum, 2);
        l = l * alpha + psum; m = mn;
        __syncthreads();
#pragma unroll
        for (int i = 0; i < 16; ++i) O[i] *= alpha;
#pragma unroll 4
        for (int j = 0; j < 64; ++j) { const float p = Ps[q * 68 + j];
#pragma unroll
            for (int d4 = 0; d4 < 4; ++d4) { const f32x4 vv = *(const LAS f32x4*)(Vs + j * 68 + part * 16 + 4 * d4); O[4 * d4] += p * vv[0]; O[4 * d4 + 1] += p * vv[1]; O[4 * d4 + 2] += p * vv[2]; O[4 * d4 + 3] += p * vv[3]; } }
    }
    const float inv = 1.f / l;
    uint4 o0, o1;
    o0.x = pk2(O[0] * inv, O[1] * inv); o0.y = pk2(O[2] * inv, O[3] * inv); o0.z = pk2(O[4] * inv, O[5] * inv); o0.w = pk2(O[6] * inv, O[7] * inv);
    o1.x = pk2(O[8] * inv, O[9] * inv); o1.y = pk2(O[10] * inv, O[11] * inv); o1.z = pk2(O[12] * inv, O[13] * inv); o1.w = pk2(O[14] * inv, O[15] * inv);
    bf16_t* dst = CAT + (size_t)(qrow0 + q) * DM + 256 + hq * 64 + part * 16;
    *(uint4*)dst = o0; *(uint4*)(dst + 8) = o1;
}

__device__ __forceinline__ void mlstm_summary(LAS unsigned char* lds, const bf16_t* P, const float* Gt, const float* gate_b  , float* MU, float* MNU, float* MSC, int h, int d, int jc, int tid, int lane, int wave) {
    LAS float* kf = (LAS float*)lds; LAS float* vf = kf + 64 * 65; LAS float* wv = vf + 64 * 65;
    int base, step; chunk_rows(d, jc, base, step);
    const int hd = h * 2 + d;
    __syncthreads();
    { const int s = tid >> 3, c8 = tid & 7; const int row = base + step * s; float f[8];
      load8bf(P + (size_t)row * LDP + C_MK + h * 64 + c8 * 8, f);
#pragma unroll
      for (int i = 0; i < 8; ++i) kf[s * 65 + c8 * 8 + i] = f[i];
      load8bf(P + (size_t)row * LDP + C_MV + h * 64 + c8 * 8, f);
#pragma unroll
      for (int i = 0; i < 8; ++i) vf[s * 65 + c8 * 8 + i] = f[i]; }
    if (wave == 0) {
        const int row = base + step * lane;
        const float ig = Gt[(size_t)row * 48 + d * 8 + h] + gate_b[d * 8 + h];
        const float fg = Gt[(size_t)row * 48 + d * 8 + 4 + h] + gate_b[d * 8 + 4 + h];
        const float lf = log_sigmoidf_(fg);
        const float b = scan_add(lf, lane);
        const float a = ig - b;
        const float cm = wave_max(a);
        const float B = __shfl(b, 63);
        wv[lane] = __expf(a - cm);
        if (lane == 0) { MSC[(size_t)(hd * NCH + jc) * 4 + 0] = cm; MSC[(size_t)(hd * NCH + jc) * 4 + 1] = B; }
    }
    __syncthreads();
    { const int dk = tid >> 3, dv0 = (tid & 7) * 8; float acc[8];
#pragma unroll
      for (int j = 0; j < 8; ++j) acc[j] = 0.f;
#pragma unroll 4
      for (int s = 0; s < 64; ++s) { const float kw = kf[s * 65 + dk] * wv[s];
#pragma unroll
          for (int j = 0; j < 8; ++j) acc[j] += kw * vf[s * 65 + dv0 + j]; }
      float* dst = MU + ((size_t)(hd * NCH + jc) * 4096) + dk * 64 + dv0;
      *(f32x4*)dst = (f32x4){acc[0], acc[1], acc[2], acc[3]}; *(f32x4*)(dst + 4) = (f32x4){acc[4], acc[5], acc[6], acc[7]}; }
    if (tid < 64) { float a = 0.f;
#pragma unroll 4
        for (int s = 0; s < 64; ++s) a += wv[s] * kf[s * 65 + tid];
        MNU[(size_t)(hd * NCH + jc) * 64 + tid] = a; }
}

__device__ __forceinline__ void gla_gates(LAS float* bc, LAS float* gsrc, LAS float* gup, const float* Gt, const float* g_up  , const float* g_b  , int h, int d, int base, int step, int tid) {
    for (int i = tid; i < 64 * 16; i += 512) { const int s = i >> 4, r = i & 15; gsrc[s * 17 + r] = Gt[(size_t)(base + step * s) * 48 + 16 + d * 16 + r]; }
    { const int r = tid >> 5, dk = tid & 31; gup[r * 33 + dk] = g_up[(d * 16 + r) * 128 + h * 32 + dk]; }
    __syncthreads();
#pragma unroll
    for (int i = 0; i < 4; ++i) { const int idx = tid + i * 512, s = idx >> 5, dk = idx & 31; float z = g_b[d * 128 + h * 32 + dk];
#pragma unroll
        for (int r = 0; r < 16; ++r) z += gsrc[s * 17 + r] * gup[r * 33 + dk];
        bc[s * 33 + dk] = log_sigmoidf_(z) * (1.f / 16.f); }
    __syncthreads();
    if (tid < 32) { float run = 0.f; for (int s = 0; s < 64; ++s) { run += bc[s * 33 + tid]; bc[s * 33 + tid] = run; } }
    __syncthreads();
}
__device__ __forceinline__ void gla_summary(LAS unsigned char* lds, const bf16_t* P, const float* Gt, const float* g_up, const float* g_b, float* GU, float* GDEC, int h, int d, int jc, int tid) {
    LAS float* kf = (LAS float*)lds; LAS float* vf = kf + 64 * 33; LAS float* bc = vf + 64 * 65; LAS float* gsrc = bc + 64 * 33; LAS float* gup = gsrc + 64 * 17;
    int base, step; chunk_rows(d, jc, base, step);
    const int hd = h * 2 + d;
    __syncthreads();
    if (tid < 256) { const int s = tid >> 2, c8 = tid & 3; float f[8]; load8bf(P + (size_t)(base + step * s) * LDP + C_GK + h * 32 + c8 * 8, f);
#pragma unroll
        for (int i = 0; i < 8; ++i) kf[s * 33 + c8 * 8 + i] = f[i]; }
    { const int s = tid >> 3, c8 = tid & 7; float f[8]; load8bf(P + (size_t)(base + step * s) * LDP + C_GV + h * 64 + c8 * 8, f);
#pragma unroll
      for (int i = 0; i < 8; ++i) vf[s * 65 + c8 * 8 + i] = f[i]; }
    gla_gates(bc, gsrc, gup, Gt, g_up, g_b, h, d, base, step, tid);
#pragma unroll
    for (int i = 0; i < 4; ++i) { const int idx = tid + i * 512, s = idx >> 5, dk = idx & 31; kf[s * 33 + dk] *= __expf(bc[63 * 33 + dk] - bc[s * 33 + dk]); }
    __syncthreads();
    { const int dk = tid >> 4, dv0 = (tid & 15) * 4; float acc[4] = {0.f, 0.f, 0.f, 0.f};
#pragma unroll 4
      for (int s = 0; s < 64; ++s) { const float kw = kf[s * 33 + dk];
#pragma unroll
          for (int j = 0; j < 4; ++j) acc[j] += kw * vf[s * 65 + dv0 + j]; }
      *(f32x4*)(GU + (size_t)(hd * NCH + jc) * 2048 + dk * 64 + dv0) = (f32x4){acc[0], acc[1], acc[2], acc[3]}; }
    if (tid < 32) GDEC[(size_t)(hd * NCH + jc) * 32 + tid] = __expf(bc[63 * 33 + tid]);
}

__device__ __forceinline__ void mlstm_out(LAS unsigned char* lds, const bf16_t* P, const float* Gt, const float* gate_b, const float* MC, const float* MNS, const float* MSC, const float* normw  , bf16_t* CAT, int h, int oc, int tid, int lane, int wave) {
    LAS float* qf = (LAS float*)lds; LAS float* kf = qf + 64 * 65; LAS float* vf = kf + 64 * 65; LAS float* Sm = vf + 64 * 65; LAS float* Cs = Sm + 64 * 65; LAS float* hs = Cs + 64 * 65;
    LAS float* av = hs + 64 * 65; LAS float* mxv = av + 64; LAS float* wiv = mxv + 64; LAS float* emv = wiv + 64; LAS float* nv = emv + 64; LAS float* dnv = nv + 64;
    const int b0 = (oc < 256) ? oc * 64 : SEQ + (oc - 256) * 64;
    const int t = tid >> 3, dv0 = (tid & 7) * 8;
    for (int d = 0; d < 2; ++d) {
        const int jc = oc_to_jc(d, oc), hd = h * 2 + d;
        const int base = d ? b0 + 63 : b0, step = d ? -1 : 1;
        __syncthreads();
        { const int s = tid >> 3, c8 = tid & 7; const size_t ro = (size_t)(base + step * s) * LDP + h * 64 + c8 * 8; float f[8];
          load8bf(P + ro + C_MQ, f);
#pragma unroll
          for (int i = 0; i < 8; ++i) qf[s * 65 + c8 * 8 + i] = f[i];
          load8bf(P + ro + C_MK, f);
#pragma unroll
          for (int i = 0; i < 8; ++i) kf[s * 65 + c8 * 8 + i] = f[i];
          load8bf(P + ro + C_MV, f);
#pragma unroll
          for (int i = 0; i < 8; ++i) vf[s * 65 + c8 * 8 + i] = f[i];
          const f32x4 c0 = *(const f32x4*)(MC + (size_t)(hd * NCH + jc) * 4096 + s * 64 + c8 * 8), c1 = *(const f32x4*)(MC + (size_t)(hd * NCH + jc) * 4096 + s * 64 + c8 * 8 + 4);
#pragma unroll
          for (int i = 0; i < 4; ++i) { Cs[s * 65 + c8 * 8 + i] = c0[i]; Cs[s * 65 + c8 * 8 + 4 + i] = c1[i]; } }
        if (tid < 64) nv[tid] = MNS[(size_t)(hd * NCH + jc) * 64 + tid];
        if (wave == 1) {
            const int row = base + step * lane;
            const float ig = Gt[(size_t)row * 48 + d * 8 + h] + gate_b[d * 8 + h];
            const float fg = Gt[(size_t)row * 48 + d * 8 + 4 + h] + gate_b[d * 8 + 4 + h];
            const float lf = log_sigmoidf_(fg);
            const float b = scan_add(lf, lane);
            const float a = ig - b;
            const float cm = scan_max(a, lane);
            const float mst = MSC[(size_t)(hd * NCH + jc) * 4 + 2];
            const float mx = fmaxf(mst, cm);
            av[lane] = a; mxv[lane] = mx; wiv[lane] = __expf(mst - mx); emv[lane] = __expf(-(b + mx));
        }
        __syncthreads();
        { const int s0 = (tid & 7) * 8; float acc[8];
#pragma unroll
          for (int j = 0; j < 8; ++j) acc[j] = 0.f;
#pragma unroll 4
          for (int dk = 0; dk < 64; ++dk) { const float qv = qf[t * 65 + dk];
#pragma unroll
              for (int j = 0; j < 8; ++j) acc[j] += qv * kf[(s0 + j) * 65 + dk]; }
          const float mxt = mxv[t];
#pragma unroll
          for (int j = 0; j < 8; ++j) { const int s = s0 + j; Sm[t * 65 + s] = (s <= t) ? acc[j] * __expf(av[s] - mxt) : 0.f; } }
        __syncthreads();
        if (tid < 64) { float dsum = 0.f, qn = 0.f;
#pragma unroll 4
            for (int s = 0; s < 64; ++s) { dsum += Sm[tid * 65 + s]; qn += qf[tid * 65 + s] * nv[s]; }
            dnv[tid] = dsum + wiv[tid] * qn; }
        float num[8], qc[8];
#pragma unroll
        for (int j = 0; j < 8; ++j) { num[j] = 0.f; qc[j] = 0.f; }
#pragma unroll 4
        for (int s = 0; s < 64; ++s) { const float sv = Sm[t * 65 + s], qv = qf[t * 65 + s];
#pragma unroll
            for (int j = 0; j < 8; ++j) { num[j] += sv * vf[s * 65 + dv0 + j]; qc[j] += qv * Cs[s * 65 + dv0 + j]; } }
        __syncthreads();
        { const float wi = wiv[t], den = fmaxf(fabsf(dnv[t]), emv[t]), inv = 1.f / den; const int to = d ? 63 - t : t;
#pragma unroll
          for (int j = 0; j < 8; ++j) { const float hv = (num[j] + wi * qc[j]) * inv; if (d == 0) hs[to * 65 + dv0 + j] = hv; else hs[to * 65 + dv0 + j] += hv; } }
    }
    __syncthreads();
    { float x[8]; float s1 = 0.f;
#pragma unroll
      for (int j = 0; j < 8; ++j) { x[j] = hs[t * 65 + dv0 + j]; s1 += x[j]; }
      s1 += __shfl_xor(s1, 1); s1 += __shfl_xor(s1, 2); s1 += __shfl_xor(s1, 4);
      const float mu = s1 * (1.f / 64.f); float s2 = 0.f;
#pragma unroll
      for (int j = 0; j < 8; ++j) { x[j] -= mu; s2 += x[j] * x[j]; }
      s2 += __shfl_xor(s2, 1); s2 += __shfl_xor(s2, 2); s2 += __shfl_xor(s2, 4);
      const float rstd = rsqrtf(s2 * (1.f / 64.f) + LN_EPS);
      const int row = b0 + t; float og[8]; load8bf(P + (size_t)row * LDP + C_MO + h * 64 + dv0, og);
      float r[8];
#pragma unroll
      for (int j = 0; j < 8; ++j) r[j] = x[j] * rstd * normw[h * 64 + dv0 + j] * sigmoidf_(og[j]);
      uint4 o; o.x = pk2(r[0], r[1]); o.y = pk2(r[2], r[3]); o.z = pk2(r[4], r[5]); o.w = pk2(r[6], r[7]);
      *(uint4*)(CAT + (size_t)row * DM + h * 64 + dv0) = o; }
}

__device__ __forceinline__ void gla_out(LAS unsigned char* lds, const bf16_t* P, const float* Gt, const float* g_up, const float* g_b, const float* GS, const float* normw, bf16_t* CAT, int h, int oc, int tid) {
    LAS float* qf = (LAS float*)lds; LAS float* kf = qf + 64 * 33; LAS float* vf = kf + 64 * 33; LAS float* bc = vf + 64 * 65; LAS float* Sm = bc + 64 * 33; LAS float* Ss = Sm + 64 * 65; LAS float* hs = Ss + 32 * 65;
    LAS float* gsrc = hs + 64 * 65; LAS float* gup = gsrc + 64 * 17;
    const int b0 = (oc < 256) ? oc * 64 : SEQ + (oc - 256) * 64;
    const int t = tid >> 3, dv0 = (tid & 7) * 8;
    for (int d = 0; d < 2; ++d) {
        const int jc = oc_to_jc(d, oc), hd = h * 2 + d;
        const int base = d ? b0 + 63 : b0, step = d ? -1 : 1;
        __syncthreads();
        { const int s = tid >> 3, c8 = tid & 7; const size_t ro = (size_t)(base + step * s) * LDP; float f[8];
          if (c8 < 4) { load8bf(P + ro + C_GQ + h * 32 + c8 * 8, f);
#pragma unroll
              for (int i = 0; i < 8; ++i) qf[s * 33 + c8 * 8 + i] = f[i]; }
          else { load8bf(P + ro + C_GK + h * 32 + (c8 - 4) * 8, f);
#pragma unroll
              for (int i = 0; i < 8; ++i) kf[s * 33 + (c8 - 4) * 8 + i] = f[i]; }
          load8bf(P + ro + C_GV + h * 64 + c8 * 8, f);
#pragma unroll
          for (int i = 0; i < 8; ++i) vf[s * 65 + c8 * 8 + i] = f[i]; }
        { const int dk = tid >> 4, c4 = (tid & 15) * 4; const f32x4 sv = *(const f32x4*)(GS + (size_t)(hd * NCH + jc) * 2048 + dk * 64 + c4);
#pragma unroll
          for (int i = 0; i < 4; ++i) Ss[dk * 65 + c4 + i] = sv[i]; }
        gla_gates(bc, gsrc, gup, Gt, g_up, g_b, h, d, base, step, tid);
#pragma unroll
        for (int i = 0; i < 4; ++i) { const int idx = tid + i * 512, s = idx >> 5, dk = idx & 31; const float b = bc[s * 33 + dk]; qf[s * 33 + dk] *= __expf(b); kf[s * 33 + dk] *= __expf(-b); }
        __syncthreads();
        { const int s0 = (tid & 7) * 8; float acc[8];
#pragma unroll
          for (int j = 0; j < 8; ++j) acc[j] = 0.f;
#pragma unroll 4
          for (int dk = 0; dk < 32; ++dk) { const float qv = qf[t * 33 + dk];
#pragma unroll
              for (int j = 0; j < 8; ++j) acc[j] += qv * kf[(s0 + j) * 33 + dk]; }
#pragma unroll
          for (int j = 0; j < 8; ++j) { const int s = s0 + j; Sm[t * 65 + s] = (s <= t) ? acc[j] : 0.f; } }
        __syncthreads();
        float num[8];
#pragma unroll
        for (int j = 0; j < 8; ++j) num[j] = 0.f;
#pragma unroll 4
        for (int s = 0; s < 64; ++s) { const float sv = Sm[t * 65 + s];
#pragma unroll
            for (int j = 0; j < 8; ++j) num[j] += sv * vf[s * 65 + dv0 + j]; }
#pragma unroll 4
        for (int dk = 0; dk < 32; ++dk) { const float qv = qf[t * 33 + dk];
#pragma unroll
            for (int j = 0; j < 8; ++j) num[j] += qv * Ss[dk * 65 + dv0 + j]; }
        { const int to = d ? 63 - t : t;
#pragma unroll
          for (int j = 0; j < 8; ++j) { if (d == 0) hs[to * 65 + dv0 + j] = num[j]; else hs[to * 65 + dv0 + j] += num[j]; } }
    }
    __syncthreads();
    { float x[8]; float s1 = 0.f;
#pragma unroll
      for (int j = 0; j < 8; ++j) { x[j] = hs[t * 65 + dv0 + j]; s1 += x[j]; }
      s1 += __shfl_xor(s1, 1); s1 += __shfl_xor(s1, 2); s1 += __shfl_xor(s1, 4);
      const float mu = s1 * (1.f / 64.f); float s2 = 0.f;
#pragma unroll
      for (int j = 0; j < 8; ++j) { x[j] -= mu; s2 += x[j] * x[j]; }
      s2 += __shfl_xor(s2, 1); s2 += __shfl_xor(s2, 2); s2 += __shfl_xor(s2, 4);
      const float rstd = rsqrtf(s2 * (1.f / 64.f) + LN_EPS);
      const int row = b0 + t; float gg[8]; load8bf(P + (size_t)row * LDP + C_GG + h * 64 + dv0, gg);
      float r[8];
#pragma unroll
      for (int j = 0; j < 8; ++j) r[j] = x[j] * rstd * normw[h * 64 + dv0 + j] * siluf(gg[j]);
      uint4 o; o.x = pk2(r[0], r[1]); o.y = pk2(r[2], r[3]); o.z = pk2(r[4], r[5]); o.w = pk2(r[6], r[7]);
      *(uint4*)(CAT + (size_t)row * DM + 768 + h * 64 + dv0) = o; }
}

__device__ __forceinline__ void ln16(f32x4 (&v)[4], const float* w, const float* b, int lane) {
    float s = 0.f;
#pragma unroll
    for (int j = 0; j < 4; ++j) s += (v[j][0] + v[j][1]) + (v[j][2] + v[j][3]);
    const float mean = wave_sum(s) * (1.f / DM); float s2 = 0.f;
#pragma unroll
    for (int j = 0; j < 4; ++j) { v[j] = v[j] - mean; s2 += (v[j][0] * v[j][0] + v[j][1] * v[j][1]) + (v[j][2] * v[j][2] + v[j][3] * v[j][3]); }
    const float rstd = rsqrtf(wave_sum(s2) * (1.f / DM) + LN_EPS);
#pragma unroll
    for (int j = 0; j < 4; ++j) { const f32x4 wv = *(const f32x4*)(w + 4 * lane + 256 * j), bv = *(const f32x4*)(b + 4 * lane + 256 * j); v[j] = v[j] * rstd * wv + bv; }
}
__device__ __forceinline__ void mod_store(f32x4 (&v)[4], const float* shift, const float* scale, bf16_t* hrow, int lane) {
#pragma unroll
    for (int j = 0; j < 4; ++j) { const f32x4 sh = *(const f32x4*)(shift + 4 * lane + 256 * j), sc = *(const f32x4*)(scale + 4 * lane + 256 * j);
        v[j] = v[j] * (sc + 1.f) + sh;
        uint2 o; o.x = pk2(v[j][0], v[j][1]); o.y = pk2(v[j][2], v[j][3]); *(uint2*)(hrow + 4 * lane + 256 * j) = o; }
}

__global__ void __launch_bounds__(512, 2) fwd(Args a_unused) {
    extern __shared__ __attribute__((aligned(16))) unsigned char lds_raw[];
    LAS unsigned char* lds = (LAS unsigned char*)lds_raw;
    const int wave0 = __builtin_amdgcn_readfirstlane(threadIdx.x >> 6);
    const int G = gridDim.x, bid = blockIdx.x;
    const Args* ap0 = (const Args*)__builtin_amdgcn_kernarg_segment_ptr();
#define PH_CTX() int wave = wave0; asm volatile("" : "+s"(wave)); unsigned ones_ = ~0u; asm volatile("" : "+s"(ones_)); const int lane = (int)__builtin_amdgcn_mbcnt_hi(ones_, __builtin_amdgcn_mbcnt_lo(ones_, 0u)); const int tid = wave * 64 + lane; \
    const Args* ap = ap0; asm volatile("" : "+s"(ap)); unsigned char* ws = ap->ws; const int gw = bid * 8 + wave, NGW = G * 8; (void)lane; (void)gw; (void)NGW; (void)ws
#define WSP(T, off) ((T*)(ws + (off)))
    volatile LAS unsigned* MISC = (volatile LAS unsigned*)(lds + MISC_OFF);
    if (threadIdx.x < 32) MISC[threadIdx.x] = 0u;
    __syncthreads();
    XcdBarrier bar; bar.bar = (unsigned*)(ap0->ws + WS_CTL) + CW_BAR; bar.x = 0; bar.st = MISC + 8;
    if (MK_ONE_LAUNCH) bar = xcd_barrier_post(bar.bar, MISC + 8);
    const int lo = ap0->ph_lo, hi = ap0->ph_hi;
#define IN(k) (lo <= (k) && (k) < hi)
#define SEAM(k) do { if (MK_ONE_LAUNCH && (k) + 1 < hi) xcd_barrier(bar); } while (0)

    if (IN(0)) {
        PH_CTX();
        float* MODS = WSP(float, WS_MODS);
        LAS float* scs = (LAS float*)lds;
        for (int i = tid; i < 2048; i += 512) scs[i] = siluf(i < 1024 ? ap->in[1][i] : ap->in[3][i - 1024]);
        __syncthreads();
        for (int u = bid; u < 4 * 8 * 12; u += G) {
            const int l = u / 96, rem = u % 96, kc = rem / 12, ng = rem % 12, n = ng * 512 + tid;
            const float* w = ap->in[4] + ((size_t)l * 1024 + kc * 128) * 6144 + n;
            float a0 = 0.f, a1 = 0.f;
#pragma unroll 8
            for (int k = 0; k < 128; ++k) { const float wv = w[(size_t)k * 6144]; a0 += scs[kc * 128 + k] * wv; a1 += scs[1024 + kc * 128 + k] * wv; }
            if (kc == 0) { const float bb = ap->in[5][l * 6144 + n]; a0 += bb; a1 += bb; }
            atomicAdd(MODS + (size_t)(l * 2 + 0) * 6144 + n, a0); atomicAdd(MODS + (size_t)(l * 2 + 1) * 6144 + n, a1);
        }
        if (bid < 8) { float* ropeC = WSP(float, WS_ROPE); float* ropeS = ropeC + 256 * 16;
            const int i = bid * 512 + tid, pos = i >> 4, fi = i & 15; const float inv = powf(10000.f, -(float)fi / 16.f); const float ang = (float)pos * inv; float sn, cs; sincosf(ang, &sn, &cs); ropeC[i] = cs; ropeS[i] = sn; }
        __syncthreads();
        LAS float* scr = (LAS float*)(lds + wave * 16640);
        constexpr int I_A = 16 * 44, I_B = 16 * 16, I_C = 16 * 88, I_D = 44 * 16, I_E = 16 * 112, I_F = 56 * 16;
        constexpr int N_A = 4 * I_A, N_B = 4 * I_B, N_C = 2 * I_C, N_D = 2 * I_D, N_E = 16 * I_E, N_F = 16 * I_F;
        for (int it = gw; it < N_A + N_B + N_C + N_D + N_E + N_F; it += NGW) {
            int r = it;
            if (r < N_E) { const int mi = r / I_E; tr_item(ap->in[20] + (size_t)mi * DM * 2 * DEXP, DM, 2 * DEXP, 2 * DEXP, WSP(bf16_t, WS_MGU) + (size_t)mi * 2 * DEXP * DM, 2, DEXP, scr, r % I_E, lane); continue; } r -= N_E;
            if (r < N_F) { const int mi = r / I_F; tr_item(ap->in[21] + (size_t)mi * DEXP * DM, DEXP, DM, DM, WSP(bf16_t, WS_MDN) + (size_t)mi * DM * DEXP, 0, 0, scr, r % I_F, lane); continue; } r -= N_F;
            if (r < N_A) { const int mi = r / I_A; tr_item(ap->in[6] + (size_t)mi * DM * IN_COLS, DM, IN_COLS, NPIN, WSP(bf16_t, WS_WIN) + (size_t)mi * NPIN * DM, 1, 0, scr, r % I_A, lane); continue; } r -= N_A;
            if (r < N_B) { const int mi = r / I_B; tr_item(ap->in[13] + (size_t)mi * DM * DM, DM, DM, DM, WSP(bf16_t, WS_WOUT) + (size_t)mi * DM * DM, 0, 0, scr, r % I_B, lane); continue; } r -= N_B;
            if (r < N_C) { const int mi = r / I_C; tr_item(ap->in[16] + (size_t)mi * DM * 2 * DFF, DM, 2 * DFF, 2 * DFF, WSP(bf16_t, WS_FGU) + (size_t)mi * 2 * DFF * DM, 2, DFF, scr, r % I_C, lane); continue; } r -= N_C;
            { const int mi = r / I_D; tr_item(ap->in[17] + (size_t)mi * DFF * DM, DFF, DM, DM, WSP(bf16_t, WS_FDN) + (size_t)mi * DM * DFF, 0, 0, scr, r % I_D, lane); }
        }
        SEAM(0);
    }
    if (IN(1)) {
        PH_CTX();
        float* X = WSP(float, WS_X); bf16_t* H = WSP(bf16_t, WS_H); const float* MODS = WSP(float, WS_MODS);
        for (int r = gw; r < TT; r += NGW) {
            const int wch = r >= SEQ; const float* src = wch ? ap->in[2] + (size_t)(r - SEQ) * DM : ap->in[0] + (size_t)r * DM;
            f32x4 v[4];
#pragma unroll
            for (int j = 0; j < 4; ++j) { v[j] = *(const f32x4*)(src + 4 * lane + 256 * j); *(f32x4*)(X + (size_t)r * DM + 4 * lane + 256 * j) = v[j]; }
            const float* md = MODS + (size_t)(0 * 2 + wch) * 6144;
            mod_store(v, md, md + 1024, H + (size_t)r * DM, lane);
        }
        SEAM(1);
    }

    for (int l = 0; l < DEPTH; ++l) {
        const int pb = 2 + 10 * l;
        const bool lastl = (l == DEPTH - 1), moe = (l & 1);
        const int nrows = lastl ? SEQ : TT;

        if (IN(pb + 0)) {
            PH_CTX();
            pg8::StaticOrder S; S.init(WSP(bf16_t, WS_H), WSP(bf16_t, WS_WIN) + (size_t)l * NPIN * DM, DM, TT, NPIN, G, bid);
            pg8::EpiInProj E{WSP(bf16_t, WS_P), WSP(float, WS_G), WSP(float, WS_ROPE), WSP(float, WS_ROPE) + 256 * 16};
            pg8::gemm_phase<pg8::EpiInProj, pg8::StaticOrder>(lds, DM, S, E, tid);
            SEAM(pb + 0);
        }
        if (IN(pb + 1)) {
            PH_CTX();
            const bf16_t* P = WSP(bf16_t, WS_P); const float* Gt = WSP(float, WS_G);
            const float* gate_b = ap->in[7] + l * 16;
            const float* g_up = ap->in[10] + (size_t)l * 2 * 16 * 128; const float* g_b = ap->in[11] + l * 256;
            for (int u = bid; u < 2 * 8 * NCH; u += G) {
                const int kind = u / (8 * NCH), r = u % (8 * NCH), hd = r / NCH, jc = r % NCH, h = hd >> 1, d = hd & 1;
                if (kind == 0) mlstm_summary(lds, P, Gt, gate_b, WSP(float, WS_MU), WSP(float, WS_MNU), WSP(float, WS_MSC), h, d, jc, tid, lane, wave);
                else gla_summary(lds, P, Gt, g_up, g_b, WSP(float, WS_GU), WSP(float, WS_GDEC), h, d, jc, tid);
            }
            SEAM(pb + 1);
        }
        if (IN(pb + 2)) {
            PH_CTX();
            float* MSC = WSP(float, WS_MSC);
            const int wi = wave * G + bid;
            const int e0 = wi * 64;
            if (e0 < 32768 + 512) {
                const bool isC = e0 < 32768;
                const int hd = isC ? e0 / 4096 : (e0 - 32768) / 64, idx = isC ? (e0 % 4096) + lane : lane;
                const float* U = isC ? WSP(float, WS_MU) + (size_t)hd * NCH * 4096 + idx : WSP(float, WS_MNU) + (size_t)hd * NCH * 64 + idx;
                float* St = isC ? WSP(float, WS_MC) + (size_t)hd * NCH * 4096 + idx : WSP(float, WS_MNS) + (size_t)hd * NCH * 64 + idx;
                const int str = isC ? 4096 : 64;
                const bool wr_m = isC && (e0 % 4096) == 0 && lane == 0;
                float m = 0.f, cval = 0.f;
                for (int n0 = 0; n0 < NCH; n0 += 4) {
                    float uu[4], cm[4], BB[4];
#pragma unroll
                    for (int j = 0; j < 4; ++j) { uu[j] = U[(size_t)(n0 + j) * str]; cm[j] = MSC[(size_t)(hd * NCH + n0 + j) * 4]; BB[j] = MSC[(size_t)(hd * NCH + n0 + j) * 4 + 1]; }
#pragma unroll
                    for (int j = 0; j < 4; ++j) {
                        St[(size_t)(n0 + j) * str] = cval;
                        if (wr_m) MSC[(size_t)(hd * NCH + n0 + j) * 4 + 2] = m;
                        const float mx = fmaxf(m, cm[j]);
                        cval = __expf(m - mx) * cval + __expf(cm[j] - mx) * uu[j];
                        m = BB[j] + mx;
                    }
                }
            } else if (e0 < 32768 + 512 + 16384) {
                const int e2 = e0 - 33280, hd = e2 / 2048, idx = (e2 % 2048) + lane, dk = idx >> 6;
                const float* U = WSP(float, WS_GU) + (size_t)hd * NCH * 2048 + idx; float* St = WSP(float, WS_GS) + (size_t)hd * NCH * 2048 + idx; const float* DC = WSP(float, WS_GDEC) + (size_t)hd * NCH * 32 + dk;
                float sval = 0.f;
                for (int n0 = 0; n0 < NCH; n0 += 4) {
                    float uu[4], dc[4];
#pragma unroll
                    for (int j = 0; j < 4; ++j) { uu[j] = U[(size_t)(n0 + j) * 2048]; dc[j] = DC[(size_t)(n0 + j) * 32]; }
#pragma unroll
                    for (int j = 0; j < 4; ++j) { St[(size_t)(n0 + j) * 2048] = sval; sval = dc[j] * sval + uu[j]; }
                }
            }
            SEAM(pb + 2);
        }
        if (IN(pb + 3)) {
            PH_CTX();
            const bf16_t* P = WSP(bf16_t, WS_P); const float* Gt = WSP(float, WS_G); bf16_t* CAT = WSP(bf16_t, WS_CAT);
            const int n_att = 1024 + (lastl ? 0 : 16), noc = lastl ? 256 : 260;
            const int NU = n_att + 8 * noc;
            for (int u = bid; u < NU; u += G) {
                if (u < 1024) { const int qb = u >> 3, hq = u & 7; attn_unit(lds, P, CAT, qb * 128, hq, ap->in[9][l * 8 + hq], false, qb, tid); }
                else if (u < n_att) { const int v = u - 1024, cq = v >> 3, hq = v & 7; attn_unit(lds, P, CAT, SEQ + cq * 128, hq, ap->in[9][l * 8 + hq], true, 0, tid); }
                else { const int v = u - n_att, kind = v / (4 * noc), r = v % (4 * noc), h = r / noc, oc = r % noc;
                    if (kind == 0) mlstm_out(lds, P, Gt, ap->in[7] + l * 16, WSP(float, WS_MC), WSP(float, WS_MNS), WSP(float, WS_MSC), ap->in[8] + l * 256, CAT, h, oc, tid, lane, wave);
                    else gla_out(lds, P, Gt, ap->in[10] + (size_t)l * 2 * 16 * 128, ap->in[11] + l * 256, WSP(float, WS_GS), ap->in[12] + l * 256, CAT, h, oc, tid); }
            }
            SEAM(pb + 3);
        }
        if (IN(pb + 4)) {
            PH_CTX();
            const float* modl = WSP(float, WS_MODS) + (size_t)(l * 2 + 0) * 6144;
            pg8::StaticOrder S; S.init(WSP(bf16_t, WS_CAT), WSP(bf16_t, WS_WOUT) + (size_t)l * DM * DM, DM, nrows, DM, G, bid);
            pg8::EpiResid E{WSP(float, WS_X), WSP(float, WS_Y), modl + 2 * 1024, modl + 6144 + 2 * 1024};
            pg8::gemm_phase<pg8::EpiResid, pg8::StaticOrder>(lds, DM, S, E, tid);
            SEAM(pb + 4);
        }
        if (IN(pb + 5)) {
            PH_CTX();
            float* X = WSP(float, WS_X); bf16_t* H = WSP(bf16_t, WS_H); const float* Y = WSP(float, WS_Y);
            const float* modl = WSP(float, WS_MODS) + (size_t)(l * 2 + 0) * 6144;
            unsigned* mcnt = WSP(unsigned, WS_CTL) + CW_MOE + 64 * 8 * (l >> 1);
            LAS float* RW = (LAS float*)lds;
            if (moe) { const float* rw = ap->in[18] + (size_t)(l >> 1) * DM * 8; for (int i = tid; i < 8192; i += 512) { const int e = i >> 10, c = i & 1023; RW[i] = rw[c * 8 + e]; } __syncthreads(); }
            const float* lw = ap->in[14] + (size_t)(l * 2 + 0) * DM; const float* lb = ap->in[15] + (size_t)(l * 2 + 0) * DM;
            for (int r = gw; r < nrows; r += NGW) {
                const int wch = r >= SEQ; const float* md = modl + wch * 6144;
                f32x4 v[4];
#pragma unroll
                for (int j = 0; j < 4; ++j) v[j] = *(const f32x4*)(Y + (size_t)r * DM + 4 * lane + 256 * j);
                ln16(v, lw, lb, lane);
#pragma unroll
                for (int j = 0; j < 4; ++j) *(f32x4*)(X + (size_t)r * DM + 4 * lane + 256 * j) = v[j];
                mod_store(v, md + 3 * 1024, md + 4 * 1024, H + (size_t)r * DM, lane);
                if (moe) {
                    float lg[8];
#pragma unroll
                    for (int e = 0; e < 8; ++e) { float s = 0.f;
#pragma unroll
                        for (int j = 0; j < 4; ++j) { const f32x4 w = *(const LAS f32x4*)(RW + e * 1024 + 4 * lane + 256 * j); s += v[j][0] * w[0] + v[j][1] * w[1] + v[j][2] * w[2] + v[j][3] * w[3]; }
                        lg[e] = wave_sum(s) + ap->in[19][(l >> 1) * 8 + e]; }
                    int e0 = 0; float l0 = lg[0];
#pragma unroll
                    for (int e = 1; e < 8; ++e) if (lg[e] > l0) { l0 = lg[e]; e0 = e; }
                    int e1 = -1; float l1 = -INFINITY;
#pragma unroll
                    for (int e = 0; e < 8; ++e) if (e != e0 && lg[e] > l1) { l1 = lg[e]; e1 = e; }
                    if (lane == 0) {
                        const float w0 = 1.f / (1.f + __expf(l1 - l0));
                        const int p0 = (int)atomicAdd(mcnt + 64 * e0, 1u), p1 = (int)atomicAdd(mcnt + 64 * e1, 1u);
                        WSP(int2, WS_TOKE)[r] = make_int2(e0, e1); WSP(int2, WS_TOKP)[r] = make_int2(p0, p1); WSP(float2, WS_TOKW)[r] = make_float2(w0, 1.f - w0);
                    }
                }
            }
            SEAM(pb + 5);
        }
#define MOE_TS() int ts0 = 0, ts1, ts2, ts3, ts4, ts5, ts6, ts7, ts8; { const unsigned* mcnt = WSP(unsigned, WS_CTL) + CW_MOE + 64 * 8 * (l >> 1); \
            ts1 = ts0 + (int)((__hip_atomic_load(mcnt + 64 * 0, __ATOMIC_RELAXED, __HIP_MEMORY_SCOPE_AGENT) + 255u) >> 8); ts2 = ts1 + (int)((__hip_atomic_load(mcnt + 64 * 1, __ATOMIC_RELAXED, __HIP_MEMORY_SCOPE_AGENT) + 255u) >> 8); \
            ts3 = ts2 + (int)((__hip_atomic_load(mcnt + 64 * 2, __ATOMIC_RELAXED, __HIP_MEMORY_SCOPE_AGENT) + 255u) >> 8); ts4 = ts3 + (int)((__hip_atomic_load(mcnt + 64 * 3, __ATOMIC_RELAXED, __HIP_MEMORY_SCOPE_AGENT) + 255u) >> 8); \
            ts5 = ts4 + (int)((__hip_atomic_load(mcnt + 64 * 4, __ATOMIC_RELAXED, __HIP_MEMORY_SCOPE_AGENT) + 255u) >> 8); ts6 = ts5 + (int)((__hip_atomic_load(mcnt + 64 * 5, __ATOMIC_RELAXED, __HIP_MEMORY_SCOPE_AGENT) + 255u) >> 8); \
            ts7 = ts6 + (int)((__hip_atomic_load(mcnt + 64 * 6, __ATOMIC_RELAXED, __HIP_MEMORY_SCOPE_AGENT) + 255u) >> 8); ts8 = ts7 + (int)((__hip_atomic_load(mcnt + 64 * 7, __ATOMIC_RELAXED, __HIP_MEMORY_SCOPE_AGENT) + 255u) >> 8); \
            ts1 = __builtin_amdgcn_readfirstlane(ts1); ts2 = __builtin_amdgcn_readfirstlane(ts2); ts3 = __builtin_amdgcn_readfirstlane(ts3); ts4 = __builtin_amdgcn_readfirstlane(ts4); \
            ts5 = __builtin_amdgcn_readfirstlane(ts5); ts6 = __builtin_amdgcn_readfirstlane(ts6); ts7 = __builtin_amdgcn_readfirstlane(ts7); ts8 = __builtin_amdgcn_readfirstlane(ts8); } (void)ts0; (void)ts8
        if (IN(pb + 6) && moe) {
            PH_CTX();
            MOE_TS();
            const bf16_t* H = WSP(bf16_t, WS_H); bf16_t* XB = WSP(bf16_t, WS_XB);
            for (int r = gw; r < nrows; r += NGW) {
                const int2 ee = WSP(int2, WS_TOKE)[r], pp = WSP(int2, WS_TOKP)[r];
                const int b0 = ee.x == 0 ? ts0 : ee.x == 1 ? ts1 : ee.x == 2 ? ts2 : ee.x == 3 ? ts3 : ee.x == 4 ? ts4 : ee.x == 5 ? ts5 : ee.x == 6 ? ts6 : ts7;
                const int b1 = ee.y == 0 ? ts0 : ee.y == 1 ? ts1 : ee.y == 2 ? ts2 : ee.y == 3 ? ts3 : ee.y == 4 ? ts4 : ee.y == 5 ? ts5 : ee.y == 6 ? ts6 : ts7;
                const int s0 = b0 * 256 + pp.x, s1 = b1 * 256 + pp.y;
                const uint4 h0 = *(const uint4*)(H + (size_t)r * DM + 8 * lane), h1 = *(const uint4*)(H + (size_t)r * DM + 512 + 8 * lane);
                *(uint4*)(XB + (size_t)s0 * DM + 8 * lane) = h0; *(uint4*)(XB + (size_t)s0 * DM + 512 + 8 * lane) = h1;
                *(uint4*)(XB + (size_t)s1 * DM + 8 * lane) = h0; *(uint4*)(XB + (size_t)s1 * DM + 512 + 8 * lane) = h1;
                if (lane == 0) WSP(int2, WS_TOKS)[r] = make_int2(s0, s1);
            }
            SEAM(pb + 6);
        }
        if (IN(pb + 7)) {
            PH_CTX();
            if (!moe) {
                pg8::StaticOrder S; S.init(WSP(bf16_t, WS_H), WSP(bf16_t, WS_FGU) + (size_t)(l >> 1) * 2 * DFF * DM, DM, nrows, 2 * DFF, G, bid);
                pg8::EpiSwiglu E{WSP(bf16_t, WS_ACT), DFF};
                pg8::gemm_phase<pg8::EpiSwiglu, pg8::StaticOrder>(lds, DM, S, E, tid);
            } else {
                MOE_TS();
                pg8::MoeOrder S; S.A = (const char*)WSP(bf16_t, WS_XB); S.Bt = (const char*)(WSP(bf16_t, WS_MGU) + (size_t)(l >> 1) * 8 * 2 * DEXP * DM); S.K = DM; S.N = 2 * DEXP; S.nN = 2 * DEXP / 256; S.ntile = ts8; S.G = G; S.c = bid;
                S.ts1 = ts1; S.ts2 = ts2; S.ts3 = ts3; S.ts4 = ts4; S.ts5 = ts5; S.ts6 = ts6; S.ts7 = ts7;
                pg8::EpiSwiglu E{WSP(bf16_t, WS_ACT), DEXP};
                pg8::gemm_phase<pg8::EpiSwiglu, pg8::MoeOrder>(lds, DM, S, E, tid);
            }
            SEAM(pb + 7);
        }
        if (IN(pb + 8)) {
            PH_CTX();
            if (!moe) {
                const float* modl = WSP(float, WS_MODS) + (size_t)(l * 2 + 0) * 6144;
                pg8::StaticOrder S; S.init(WSP(bf16_t, WS_ACT), WSP(bf16_t, WS_FDN) + (size_t)(l >> 1) * DM * DFF, DFF, nrows, DM, G, bid);
                pg8::EpiResid E{WSP(float, WS_X), WSP(float, WS_Y), modl + 5 * 1024, modl + 6144 + 5 * 1024};
                pg8::gemm_phase<pg8::EpiResid, pg8::StaticOrder>(lds, DFF, S, E, tid);
            } else {
                MOE_TS();
                pg8::MoeOrder S; S.A = (const char*)WSP(bf16_t, WS_ACT); S.Bt = (const char*)(WSP(bf16_t, WS_MDN) + (size_t)(l >> 1) * 8 * DM * DEXP); S.K = DEXP; S.N = DM; S.nN = DM / 256; S.ntile = ts8; S.G = G; S.c = bid;
                S.ts1 = ts1; S.ts2 = ts2; S.ts3 = ts3; S.ts4 = ts4; S.ts5 = ts5; S.ts6 = ts6; S.ts7 = ts7;
                pg8::EpiF32 E{WSP(float, WS_YS)};
                pg8::gemm_phase<pg8::EpiF32, pg8::MoeOrder>(lds, DEXP, S, E, tid);
            }
            SEAM(pb + 8);
        }
        if (IN(pb + 9)) {
            PH_CTX();
            float* X = WSP(float, WS_X); bf16_t* H = WSP(bf16_t, WS_H); const float* Y = WSP(float, WS_Y); const float* YS = WSP(float, WS_YS);
            const float* modl = WSP(float, WS_MODS) + (size_t)(l * 2 + 0) * 6144;
            const float* lw = ap->in[14] + (size_t)(l * 2 + 1) * DM; const float* lb = ap->in[15] + (size_t)(l * 2 + 1) * DM;
            for (int r = gw; r < nrows; r += NGW) {
                const int wch = r >= SEQ; const float* md = modl + wch * 6144;
                f32x4 v[4];
                if (!moe) {
#pragma unroll
                    for (int j = 0; j < 4; ++j) v[j] = *(const f32x4*)(Y + (size_t)r * DM + 4 * lane + 256 * j);
                } else {
                    const int2 ss = WSP(int2, WS_TOKS)[r]; const float2 ww = WSP(float2, WS_TOKW)[r];
#pragma unroll
                    for (int j = 0; j < 4; ++j) { const int c = 4 * lane + 256 * j;
                        const f32x4 y0 = *(const f32x4*)(YS + (size_t)ss.x * DM + c), y1 = *(const f32x4*)(YS + (size_t)ss.y * DM + c), xv = *(const f32x4*)(X + (size_t)r * DM + c), g5 = *(const f32x4*)(md + 5 * 1024 + c);
                        v[j] = xv * ALPHA + g5 * (y0 * ww.x + y1 * ww.y); }
                }
                ln16(v, lw, lb, lane);
                if (lastl) {
#pragma unroll
                    for (int j = 0; j < 4; ++j) *(f32x4*)(ap->out + (size_t)r * DM + 4 * lane + 256 * j) = v[j];
                } else {
#pragma unroll
                    for (int j = 0; j < 4; ++j) *(f32x4*)(X + (size_t)r * DM + 4 * lane + 256 * j) = v[j];
                    const float* mdn = modl + 2 * 6144 + wch * 6144;
                    mod_store(v, mdn, mdn + 1024, H + (size_t)r * DM, lane);
                }
            }
            SEAM(pb + 9);
        }
    }
#undef IN
#undef SEAM
}

extern "C" void kernel_launch(void* const* d_in, const int* in_sizes, int n_in, void* d_out, int out_size, void* d_ws, size_t ws_size, hipStream_t stream) {
    static int grid = 0;
    if (grid == 0) {
        if (n_in != 22 || ws_size < WS_END) { fprintf(stderr, "kernel_launch: unexpected n_in %d / ws %zu (need %zu)\n", n_in, ws_size, (size_t)WS_END); grid = -1; return; }
        int dev = 0, cus = 0;
        if (hipGetDevice(&dev) != hipSuccess || hipDeviceGetAttribute(&cus, hipDeviceAttributeMultiprocessorCount, dev) != hipSuccess) { grid = -1; return; }
        if (hipFuncSetAttribute((const void*)fwd, hipFuncAttributeMaxDynamicSharedMemorySize, LDS_BYTES) != hipSuccess) { fprintf(stderr, "kernel_launch: hipFuncSetAttribute failed\n"); grid = -1; return; }
        int per_cu = 0;
        if (hipOccupancyMaxActiveBlocksPerMultiprocessor(&per_cu, (const void*)fwd, 512, LDS_BYTES) != hipSuccess || per_cu < 1) fprintf(stderr, "kernel_launch: occupancy query reports %d\n", per_cu);
        (void)hipGetLastError();
        grid = cus;
    }
    if (grid < 0) return;
    (void)hipMemsetAsync((char*)d_ws + WS_CTL, 0, CTL_BYTES, stream);
    Args a{};
    for (int i = 0; i < 22; ++i) a.in[i] = (const float*)d_in[i];
    a.out = (float*)d_out; a.ws = (unsigned char*)d_ws;
#if MK_ONE_LAUNCH
    a.ph_lo = 0; a.ph_hi = NPH;
    hipLaunchKernelGGL(fwd, dim3(grid), dim3(512), LDS_BYTES, stream, a);
#else
    for (int p = 0; p < NPH; ++p) {
        if (p >= 2 && ((p - 2) % 10) == 6 && ((((p - 2) / 10) & 1) == 0)) continue;
        a.ph_lo = p; a.ph_hi = p + 1;
        hipLaunchKernelGGL(fwd, dim3(grid), dim3(512), LDS_BYTES, stream, a);
    }
#endif
}
```

```cpp
#include <hip/hip_runtime.h>
#include <cstdio>
#include <cstdint>

#ifndef MK_ONE_LAUNCH
#define MK_ONE_LAUNCH 1
#endif

#define LAS __attribute__((address_space(3)))
#define GAS __attribute__((address_space(1)))
typedef unsigned short bf16_t;
typedef short bf16x8 __attribute__((ext_vector_type(8)));
typedef float f32x4 __attribute__((ext_vector_type(4)));
typedef unsigned u32x4 __attribute__((ext_vector_type(4)));

constexpr int DM = 1024, SEQ = 16384, NCTX = 256, TT = SEQ + NCTX, DEPTH = 4;
constexpr int IN_COLS = 2608, NPIN = 2816, LDP = 2816;
constexpr int C_MQ = 0, C_MK = 256, C_MV = 512, C_MO = 768, C_AQ = 1024, C_AK = 1536, C_AV = 1664, C_GQ = 1792, C_GK = 1920, C_GV = 2048, C_GG = 2304, C_MG = 2560, C_GGT = 2576, C_END = 2608;
constexpr int DFF = 2816, DEXP = 3584, NEXP = 8;
constexpr int NCH = 260;
constexpr int NSLOT = 138 * 256;
constexpr float ALPHA = 1.6817928305074290f;
constexpr float LN_EPS = 1e-5f;
constexpr int NPH = 2 + 10 * DEPTH;

constexpr size_t al256(size_t x) { return (x + 255) & ~size_t(255); }
constexpr size_t WS_CTL = 0, CTL_BYTES = 2u << 20;
constexpr size_t WS_MODS = 1u << 20;
constexpr size_t WS_ROPE = CTL_BYTES;
constexpr size_t WS_TOKE = WS_ROPE + 32768;
constexpr size_t WS_TOKP = WS_TOKE + al256((size_t)TT * 8);
constexpr size_t WS_TOKW = WS_TOKP + al256((size_t)TT * 8);
constexpr size_t WS_TOKS = WS_TOKW + al256((size_t)TT * 8);
constexpr size_t WS_WIN = WS_TOKS + al256((size_t)TT * 8);
constexpr size_t WS_WOUT = WS_WIN + (size_t)DEPTH * NPIN * DM * 2;
constexpr size_t WS_FGU = WS_WOUT + (size_t)DEPTH * DM * DM * 2;
constexpr size_t WS_FDN = WS_FGU + (size_t)2 * 2 * DFF * DM * 2;
constexpr size_t WS_MGU = WS_FDN + (size_t)2 * DM * DFF * 2;
constexpr size_t WS_MDN = WS_MGU + (size_t)16 * 2 * DEXP * DM * 2;
constexpr size_t WS_X = WS_MDN + (size_t)16 * DM * DEXP * 2;
constexpr size_t WS_H = WS_X + (size_t)TT * DM * 4;
constexpr size_t WS_P = WS_H + (size_t)TT * DM * 2;
constexpr size_t WS_G = WS_P + (size_t)TT * LDP * 2;
constexpr size_t WS_CAT = WS_G + al256((size_t)TT * 48 * 4);
constexpr size_t WS_Y = WS_CAT + (size_t)TT * DM * 2;
constexpr size_t WS_ACT = WS_Y + (size_t)TT * DM * 4;
constexpr size_t WS_XB = WS_ACT + (size_t)NSLOT * DEXP * 2;
constexpr size_t WS_YS = WS_XB + (size_t)NSLOT * DM * 2;
constexpr size_t WS_MU = WS_YS + (size_t)NSLOT * DM * 4;
constexpr size_t WS_MC = WS_MU + (size_t)8 * NCH * 4096 * 4;
constexpr size_t WS_MNU = WS_MC + (size_t)8 * NCH * 4096 * 4;
constexpr size_t WS_MNS = WS_MNU + (size_t)8 * NCH * 64 * 4;
constexpr size_t WS_MSC = WS_MNS + (size_t)8 * NCH * 64 * 4;
constexpr size_t WS_GU = WS_MSC + al256((size_t)8 * NCH * 4 * 4);
constexpr size_t WS_GS = WS_GU + (size_t)8 * NCH * 2048 * 4;
constexpr size_t WS_GDEC = WS_GS + (size_t)8 * NCH * 2048 * 4;
constexpr size_t WS_END = WS_GDEC + (size_t)8 * NCH * 32 * 4;

constexpr int CW_BAR = 4096;
constexpr int CW_MOE = 16384;

constexpr int LDS_BYTES = 147456, MISC_OFF = 147200;

__device__ __forceinline__ float bf2f(unsigned v) { return __uint_as_float(v << 16); }
__device__ __forceinline__ unsigned f2bf(float f) { unsigned u = __float_as_uint(f); return (u + 0x7fffu + ((u >> 16) & 1u)) >> 16; }
__device__ __forceinline__ unsigned pk2(float lo, float hi) { return f2bf(lo) | (f2bf(hi) << 16); }
__device__ __forceinline__ void load8bf(const bf16_t* p, float* o) {
    const uint4 v = *(const uint4*)p;
    o[0] = __uint_as_float(v.x << 16); o[1] = __uint_as_float(v.x & 0xffff0000u); o[2] = __uint_as_float(v.y << 16); o[3] = __uint_as_float(v.y & 0xffff0000u);
    o[4] = __uint_as_float(v.z << 16); o[5] = __uint_as_float(v.z & 0xffff0000u); o[6] = __uint_as_float(v.w << 16); o[7] = __uint_as_float(v.w & 0xffff0000u);
}
__device__ __forceinline__ float wave_sum(float v) {
#pragma unroll
    for (int o = 1; o < 64; o <<= 1) v += __shfl_xor(v, o);
    return v;
}
__device__ __forceinline__ float wave_max(float v) {
#pragma unroll
    for (int o = 1; o < 64; o <<= 1) v = fmaxf(v, __shfl_xor(v, o));
    return v;
}
__device__ __forceinline__ float scan_add(float v, int lane) {
#pragma unroll
    for (int o = 1; o < 64; o <<= 1) { const float t = __shfl_up(v, o); if (lane >= o) v += t; }
    return v;
}
__device__ __forceinline__ float scan_max(float v, int lane) {
#pragma unroll
    for (int o = 1; o < 64; o <<= 1) { const float t = __shfl_up(v, o); if (lane >= o) v = fmaxf(v, t); }
    return v;
}
__device__ __forceinline__ float siluf(float x) { return x / (1.f + __expf(-x)); }
__device__ __forceinline__ float sigmoidf_(float x) { return 1.f / (1.f + __expf(-x)); }
__device__ __forceinline__ float log_sigmoidf_(float x) { return fminf(x, 0.f) - log1pf(__expf(-fabsf(x))); }
#define LDS_WAIT() asm volatile("s_waitcnt lgkmcnt(0)" ::: "memory")

namespace pg8 {
constexpr int BM = 256, BK = 64, HALF = 128, HTB = HALF * BK * 2, STAGE_BYTES = 8 * HTB, NXCD = 8, WGM = 8;
__host__ __device__ __forceinline__ int lds_byte(int r, int c) { const int st = (r >> 4) * 2 + (c >> 5), rr = r & 15, cc = c & 31, ob = rr * 64 + cc * 2; return st * 1024 + (ob ^ (((ob >> 9) & 1) << 5)); }
__host__ __device__ __forceinline__ void stage_rc(int b, int& R, int& C) { const int st = b / 1024, sb = b % 1024, swz = sb ^ (((sb >> 9) & 1) << 5); R = (st >> 1) * 16 + swz / 64; C = (st & 1) * 32 + (swz % 64) / 2; }
__host__ __device__ __forceinline__ int perm32(int rho) { const int n = rho >> 4, i = rho & 15; return 8 * (i >> 2) + 4 * n + (i & 3); }
struct Unit { int pm, pn; };

struct StaticOrder {
    const char* A; const char* Bt; int K;
    int nM, nN, nwg, G, c;
    __device__ void init(const void* A_, const void* Bt_, int K_, int M, int N, int G_, int c_) { A = (const char*)A_; Bt = (const char*)Bt_; K = K_; nM = M / BM; nN = N / BM; nwg = nM * nN; G = G_; c = c_; }
    __device__ bool next(int i, Unit& u) const {
        const long L = (long)i * G + c; if (L >= nwg) return false;
        int wgid = (int)L; { const int q = nwg / NXCD, r = nwg % NXCD, xcd = wgid % NXCD, off = wgid / NXCD; wgid = (xcd < r ? xcd * (q + 1) : r * (q + 1) + (xcd - r) * q) + off; }
        const int nig = WGM * nN, gid = wgid / nig, fm = gid * WGM, gsz = (nM - fm) < WGM ? (nM - fm) : WGM;
        u.pm = fm + ((wgid % nig) % gsz); u.pn = (wgid % nig) / gsz; return true;
    }
    __device__ __forceinline__ const char* aptr(const Unit& u) const { return A + (size_t)u.pm * BM * K * 2; }
    __device__ __forceinline__ const char* bptr(const Unit& u) const { return Bt + (size_t)u.pn * BM * K * 2; }
};
struct MoeOrder {
    const char* A; const char* Bt; int K, N, nN, ntile, G, c;
    int ts1, ts2, ts3, ts4, ts5, ts6, ts7;
    __device__ bool next(int i, Unit& u) const {
        const long L = (long)i * G + c; if (L >= (long)ntile * nN) return false;
        u.pm = (int)(L / nN); u.pn = (int)(L % nN); return true;
    }
    __device__ __forceinline__ int expert(int pm) const { return (pm >= ts1) + (pm >= ts2) + (pm >= ts3) + (pm >= ts4) + (pm >= ts5) + (pm >= ts6) + (pm >= ts7); }
    __device__ __forceinline__ const char* aptr(const Unit& u) const { return A + (size_t)u.pm * BM * K * 2; }
    __device__ __forceinline__ const char* bptr(const Unit& u) const { return Bt + ((size_t)expert(u.pm) * N + (size_t)u.pn * BM) * K * 2; }
};

template <class Epi, class Sched>
__device__ __forceinline__ void gemm_phase(LAS unsigned char* lds, const int K, const Sched& S, const Epi& E, const int tid) {
    const int wid = __builtin_amdgcn_readfirstlane(tid >> 6), lane = tid & 63, wr = wid >> 2, wc = wid & 3, fr = lane & 15, fq = lane >> 4;
    const int nt = K / BK;
    unsigned voffA[2], voffB[2];
#pragma unroll
    for (int i = 0; i < 2; ++i) { int R, C; stage_rc(tid * 16 + i * 8192, R, C); const int Rb = Epi::PERM ? ((R & ~31) + perm32(R & 31)) : R;
        voffA[i] = (unsigned)(R * K + C) * 2u; voffB[i] = (unsigned)(Rb * K + C) * 2u; }
    const size_t kstep = (size_t)(BK * 2);
    const size_t hstep = (size_t)HALF * K * 2;
    const unsigned ldsw = (unsigned)wid * 1024u;
    const int aoff = lds_byte(wr * 64 + fr, fq * 8), boff = lds_byte(wc * 32 + fr, fq * 8);
#define PG8_SA(b, h) (((b) * 2 + (h)) * HTB)
#define PG8_SB(b, h) ((4 + (b) * 2 + (h)) * HTB)
#define PG8_STAGE(bufoff, gbase, voff) do { _Pragma("unroll") for (int _i = 0; _i < 2; ++_i) \
        __builtin_amdgcn_global_load_lds((const GAS unsigned*)((const GAS char*)(gbase) + (voff)[_i]), (LAS unsigned*)(lds + (bufoff) + ldsw + _i * 8192), 16, 0, 0); } while (0)
#define PG8_LDA(dst, b, h) do { _Pragma("unroll") for (int m = 0; m < 4; ++m) _Pragma("unroll") for (int k = 0; k < 2; ++k) dst[m][k] = *(const LAS bf16x8*)(lds + PG8_SA(b, h) + aoff + m * 2048 + k * 1024); } while (0)
#define PG8_LDB(dst, b, h) do { _Pragma("unroll") for (int n = 0; n < 2; ++n) _Pragma("unroll") for (int k = 0; k < 2; ++k) dst[n][k] = *(const LAS bf16x8*)(lds + PG8_SB(b, h) + boff + n * 2048 + k * 1024); } while (0)
#define PG8_MMA(ai, bj, At, Bt) do { __builtin_amdgcn_s_setprio(1); _Pragma("unroll") for (int m = 0; m < 4; ++m) _Pragma("unroll") for (int n = 0; n < 2; ++n) _Pragma("unroll") for (int k = 0; k < 2; ++k) \
        acc[ai][bj][m][n] = __builtin_amdgcn_mfma_f32_16x16x32_bf16(Bt[n][k], At[m][k], acc[ai][bj][m][n], 0, 0, 0); __builtin_amdgcn_s_setprio(0); } while (0)
#define PG8_WAIT_V(n) asm volatile("s_waitcnt vmcnt(" #n ")" ::: "memory")
#define PG8_WAIT_L(n) asm volatile("s_waitcnt lgkmcnt(" #n ")" ::: "memory")
#define PG8_BAR __builtin_amdgcn_s_barrier()
#define PG8_SCHED __builtin_amdgcn_sched_barrier(0)
    Unit cur, nxt; int ui = 0;
    if (!S.next(0, cur)) return;
    f32x4 acc[2][2][4][2];
#pragma unroll
    for (int a = 0; a < 2; ++a)
#pragma unroll
        for (int b = 0; b < 2; ++b)
#pragma unroll
            for (int m = 0; m < 4; ++m)
#pragma unroll
                for (int n = 0; n < 2; ++n) acc[a][b][m][n] = (f32x4){0.f, 0.f, 0.f, 0.f};
    bf16x8 At[4][2], B0[2][2], B1[2][2];
    const char* cA = S.aptr(cur); const char* cB = S.bptr(cur);
    PG8_STAGE(PG8_SB(0, 0), cB, voffB); PG8_STAGE(PG8_SB(0, 1), cB + hstep, voffB); PG8_STAGE(PG8_SA(0, 0), cA, voffA); PG8_STAGE(PG8_SA(0, 1), cA + hstep, voffA);
    if (wr == 1) PG8_BAR;
    PG8_WAIT_V(2); PG8_BAR;
    PG8_STAGE(PG8_SB(1, 0), cB + kstep, voffB); PG8_STAGE(PG8_SA(1, 0), cA + kstep, voffA); PG8_STAGE(PG8_SB(1, 1), cB + hstep + kstep, voffB);
    PG8_WAIT_V(6); PG8_BAR;
    for (;;) {
        const bool has_next = S.next(ui + 1, nxt);
        const char* nA = has_next ? S.aptr(nxt) : cA; const char* nB = has_next ? S.bptr(nxt) : cB;
        for (int t = 0; t < nt; t += 2) {
            const bool last = (t == nt - 2);
            const char* a1 = cA + (size_t)(t + 1) * kstep;
            const char* a2 = last ? nA : cA + (size_t)(t + 2) * kstep; const char* b2 = last ? nB : cB + (size_t)(t + 2) * kstep;
            const char* a3 = a2 + kstep; const char* b3 = b2 + kstep;
            PG8_LDB(B0, 0, 0); PG8_LDB(B1, 0, 1); PG8_SCHED; PG8_LDA(At, 0, 0); PG8_STAGE(PG8_SA(1, 1), a1 + hstep, voffA);
            PG8_WAIT_V(8); PG8_WAIT_L(0); PG8_BAR; PG8_MMA(0, 0, At, B0); PG8_MMA(0, 1, At, B1); PG8_BAR; PG8_SCHED;
            PG8_LDA(At, 0, 1); PG8_STAGE(PG8_SB(0, 0), b2, voffB); PG8_STAGE(PG8_SB(0, 1), b2 + hstep, voffB); PG8_STAGE(PG8_SA(0, 0), a2, voffA);
            PG8_WAIT_V(8); PG8_WAIT_L(0); PG8_BAR; PG8_MMA(1, 0, At, B0); PG8_MMA(1, 1, At, B1); PG8_BAR; PG8_SCHED;
            PG8_LDB(B0, 1, 0); PG8_LDB(B1, 1, 1); PG8_SCHED; PG8_LDA(At, 1, 0); PG8_STAGE(PG8_SA(0, 1), a2 + hstep, voffA);
            PG8_WAIT_V(8); PG8_WAIT_L(0); PG8_BAR; PG8_MMA(0, 0, At, B0); PG8_MMA(0, 1, At, B1); PG8_BAR; PG8_SCHED;
            PG8_LDA(At, 1, 1); PG8_STAGE(PG8_SB(1, 0), b3, voffB); PG8_STAGE(PG8_SB(1, 1), b3 + hstep, voffB); PG8_STAGE(PG8_SA(1, 0), a3, voffA);
            PG8_WAIT_V(8); PG8_WAIT_L(0); PG8_BAR; PG8_MMA(1, 0, At, B0); PG8_MMA(1, 1, At, B1); PG8_BAR; PG8_SCHED;
        }
        if (wr == 0) PG8_BAR;
        { int fr_ = fr, fq_ = fq; asm volatile("" : "+v"(fr_), "+v"(fq_));
          E(acc, cur, wr, wc, fr_, fq_); }
        if (!has_next) break;
#pragma unroll
        for (int a = 0; a < 2; ++a)
#pragma unroll
            for (int b = 0; b < 2; ++b)
#pragma unroll
                for (int m = 0; m < 4; ++m)
#pragma unroll
                    for (int n = 0; n < 2; ++n) acc[a][b][m][n] = (f32x4){0.f, 0.f, 0.f, 0.f};
        cur = nxt; cA = nA; cB = nB; ++ui;
        if (wr == 1) PG8_BAR;
    }
    PG8_WAIT_V(0);
    PG8_BAR;
#undef PG8_SA
#undef PG8_SB
#undef PG8_STAGE
#undef PG8_LDA
#undef PG8_LDB
#undef PG8_MMA
#undef PG8_WAIT_V
#undef PG8_WAIT_L
#undef PG8_BAR
#undef PG8_SCHED
}


struct EpiInProj {
    static constexpr bool PERM = true;
    bf16_t* P; float* Gt; const float* ropeC; const float* ropeS;
    __device__ __forceinline__ void operator()(const f32x4 (&acc)[2][2][4][2], const Unit& u, int wr, int wc, int fr, int fq) const {
        const int row0 = u.pm * BM + wr * 64 + fr;
        const bool latent = u.pm < (SEQ / BM);
#pragma unroll
        for (int bj = 0; bj < 2; ++bj) {
            const int colg = u.pn * BM + bj * HALF + wc * 32;
            const bool rope = latent && colg >= C_AQ && colg < C_AV;
            const bool gate = colg >= C_MG && colg < C_END;
            const int col0 = colg + 8 * fq;
#pragma unroll
            for (int ai = 0; ai < 2; ++ai)
#pragma unroll
                for (int m = 0; m < 4; ++m) {
                    const int row = row0 + ai * HALF + m * 16;
                    f32x4 v0 = acc[ai][bj][m][0], v1 = acc[ai][bj][m][1];
                    if (rope) {
                        const int pos = ((colg >> 5) & 1) ? (row & 63) : (row >> 6);
                        const f32x4 c0 = *(const f32x4*)(ropeC + pos * 16 + 8 * (fq & 1)), c1 = *(const f32x4*)(ropeC + pos * 16 + 8 * (fq & 1) + 4);
                        const f32x4 s0 = *(const f32x4*)(ropeS + pos * 16 + 8 * (fq & 1)), s1 = *(const f32x4*)(ropeS + pos * 16 + 8 * (fq & 1) + 4);
                        const float sg = (fq < 2) ? -1.f : 1.f;
                        f32x4 p0, p1;
#pragma unroll
                        for (int i = 0; i < 4; ++i) { p0[i] = __shfl_xor(v0[i], 32); p1[i] = __shfl_xor(v1[i], 32); }
#pragma unroll
                        for (int i = 0; i < 4; ++i) { v0[i] = v0[i] * c0[i] + sg * p0[i] * s0[i]; v1[i] = v1[i] * c1[i] + sg * p1[i] * s1[i]; }
                    }
                    u32x4 w; w.x = pk2(v0[0], v0[1]); w.y = pk2(v0[2], v0[3]); w.z = pk2(v1[0], v1[1]); w.w = pk2(v1[2], v1[3]);
                    *(u32x4*)(P + (size_t)row * LDP + col0) = w;
                    if (gate && col0 < C_END) { float* g = Gt + (size_t)row * 48 + (col0 - C_MG); *(f32x4*)g = v0; *(f32x4*)(g + 4) = v1; }
                    asm volatile("" ::: "memory");
                }
        }
    }
};
struct EpiResid {
    static constexpr bool PERM = false;
    const float* X; float* Y; const float* modl; const float* modc;
    __device__ __forceinline__ void operator()(const f32x4 (&acc)[2][2][4][2], const Unit& u, int wr, int wc, int fr, int fq) const {
        const int row0 = u.pm * BM + wr * 64 + fr, col0 = u.pn * BM + wc * 32 + 4 * fq;
        const float* md = (u.pm < SEQ / BM) ? modl : modc;
        f32x4 mv[2][2];
#pragma unroll
        for (int bj = 0; bj < 2; ++bj)
#pragma unroll
            for (int n = 0; n < 2; ++n) mv[bj][n] = *(const f32x4*)(md + col0 + bj * HALF + n * 16);
#pragma unroll
        for (int ai = 0; ai < 2; ++ai)
#pragma unroll
            for (int m = 0; m < 4; ++m) { const size_t off = (size_t)(row0 + ai * HALF + m * 16) * DM + col0;
#pragma unroll
                for (int bj = 0; bj < 2; ++bj)
#pragma unroll
                    for (int n = 0; n < 2; ++n) { const f32x4 xv = *(const f32x4*)(X + off + bj * HALF + n * 16);
                        *(f32x4*)(Y + off + bj * HALF + n * 16) = xv * ALPHA + mv[bj][n] * acc[ai][bj][m][n]; }
                asm volatile("" ::: "memory"); }
    }
};
struct EpiSwiglu {
    static constexpr bool PERM = true;
    bf16_t* O; int ld;
    __device__ __forceinline__ void operator()(const f32x4 (&acc)[2][2][4][2], const Unit& u, int wr, int wc, int fr, int fq) const {
        const int row0 = u.pm * BM + wr * 64 + fr, col0 = u.pn * HALF + wc * 32 + 8 * fq;
#pragma unroll
        for (int ai = 0; ai < 2; ++ai)
#pragma unroll
            for (int m = 0; m < 4; ++m) {
                const f32x4 g0 = acc[ai][0][m][0], g1 = acc[ai][0][m][1], u0 = acc[ai][1][m][0], u1 = acc[ai][1][m][1];
                float r[8];
#pragma unroll
                for (int i = 0; i < 4; ++i) { r[i] = siluf(g0[i]) * u0[i]; r[4 + i] = siluf(g1[i]) * u1[i]; }
                u32x4 w; w.x = pk2(r[0], r[1]); w.y = pk2(r[2], r[3]); w.z = pk2(r[4], r[5]); w.w = pk2(r[6], r[7]);
                *(u32x4*)(O + (size_t)(row0 + ai * HALF + m * 16) * ld + col0) = w;
            }
    }
};
struct EpiF32 {
    static constexpr bool PERM = false;
    float* C;
    __device__ __forceinline__ void operator()(const f32x4 (&acc)[2][2][4][2], const Unit& u, int wr, int wc, int fr, int fq) const {
        const int row0 = u.pm * BM + wr * 64 + fr, col0 = u.pn * BM + wc * 32 + 4 * fq;
#pragma unroll
        for (int ai = 0; ai < 2; ++ai)
#pragma unroll
            for (int m = 0; m < 4; ++m) { float* rowp = C + (size_t)(row0 + ai * HALF + m * 16) * DM + col0;
#pragma unroll
                for (int bj = 0; bj < 2; ++bj)
#pragma unroll
                    for (int n = 0; n < 2; ++n) *(f32x4*)(rowp + bj * HALF + n * 16) = acc[ai][bj][m][n]; }
    }
};
}

#define XB_TMO      128
#define XB_XCNT(j)  (256  + 64 * (j))
#define XB_XSUB(j)  (1280 + 64 * (j))
#define XB_XGEN(j)  (2304 + 64 * (j))
#define XB_TOP      3328
#define XB_TOPGEN   3392
#define XCD_BAR_WORDS 3456
#define XB_SPIN_CAP (1u << 18)
__device__ __forceinline__ unsigned xb_ld(unsigned* p)              { return __hip_atomic_load(p, __ATOMIC_RELAXED, __HIP_MEMORY_SCOPE_AGENT); }
__device__ __forceinline__ unsigned xb_add(unsigned* p, unsigned v) { return __hip_atomic_fetch_add(p, v, __ATOMIC_RELAXED, __HIP_MEMORY_SCOPE_AGENT); }
__device__ __forceinline__ unsigned xb_xcc_id() { return (unsigned)__builtin_amdgcn_s_getreg((3 << 11) | 20) & 0xFu; }
#define XB_SPIN(cond, bar) do { unsigned _sp = 0; while (cond) { __builtin_amdgcn_s_sleep(1); \
    if ((++_sp & 255u) == 0u) { if (xb_ld(&(bar)[XB_TMO])) break; if (_sp > XB_SPIN_CAP) { atomicAdd(&(bar)[XB_TMO], 1u); break; } } } } while (0)
struct XcdBarrier { unsigned* bar; unsigned x; volatile LAS unsigned* st; };
__device__ __forceinline__ XcdBarrier xcd_barrier_post(unsigned* bar, volatile LAS unsigned* st) {
    XcdBarrier b; b.bar = bar; b.x = xb_xcc_id(); b.st = st;
    if (threadIdx.x == 0) (void)xb_add(&bar[XB_XCNT(b.x)], 1u);
    return b;
}
__device__ __forceinline__ void xcd_barrier_complete(unsigned* bar, unsigned x, unsigned& nloc, unsigned& nx) {
    const unsigned G = gridDim.x * gridDim.y * gridDim.z;
    unsigned sum, cnt, mine, sp = 0u;
    for (;;) {
        sum = 0u; cnt = 0u; mine = 0u;
#pragma unroll
        for (unsigned j = 0; j < 16; ++j) { const unsigned c = xb_ld(&bar[XB_XCNT(j)]); sum += c; cnt += (c > 0u) ? 1u : 0u; mine = (j == x) ? c : mine; }
        if (sum == G) break;
        __builtin_amdgcn_s_sleep(1);
        if ((++sp & 255u) == 0u) { if (xb_ld(&bar[XB_TMO])) break; if (sp > XB_SPIN_CAP) { atomicAdd(&bar[XB_TMO], 1u); break; } }
    }
    nloc = mine > 0u ? mine : 1u; nx = cnt > 0u ? cnt : 1u;
}
__device__ __forceinline__ void xcd_barrier(const XcdBarrier& b) {
    asm volatile("s_waitcnt vmcnt(0)" ::: "memory");
    __syncthreads();
    if (threadIdx.x == 0) {
        unsigned* bar = b.bar;
        __builtin_amdgcn_s_waitcnt(0);
        unsigned nloc = b.st[0], nx = b.st[1];
        if (nloc == 0u) { xcd_barrier_complete(bar, b.x, nloc, nx); b.st[0] = nloc; b.st[1] = nx; }
        const unsigned old = xb_add(&bar[XB_XSUB(b.x)], 1u);
        const unsigned gen = old / nloc;
        if (old + 1u == (gen + 1u) * nloc) {
            __builtin_amdgcn_fence(__ATOMIC_RELEASE, "agent");
            asm volatile("s_waitcnt vmcnt(0)" ::: "memory");
            const unsigned og = xb_add(&bar[XB_TOP], 1u);
            const unsigned tg = og / nx;
            if (og + 1u == (tg + 1u) * nx) xb_add(&bar[XB_TOPGEN], 1u);
            else XB_SPIN(xb_ld(&bar[XB_TOPGEN]) == tg, bar);
            __builtin_amdgcn_fence(__ATOMIC_ACQUIRE, "agent");
            xb_add(&bar[XB_XGEN(b.x)], 1u);
            asm volatile("s_waitcnt vmcnt(0)" ::: "memory");
        } else {
            XB_SPIN(xb_ld(&bar[XB_XGEN(b.x)]) == gen, bar);
            __builtin_amdgcn_fence(__ATOMIC_ACQUIRE, "agent");
            asm volatile("s_waitcnt vmcnt(0)" ::: "memory");
        }
    }
    __syncthreads();
}

struct Args { const float* in[22]; float* out; unsigned char* ws; int ph_lo, ph_hi; };

__device__ __forceinline__ int in_srccol(int r, float& sc) {
    sc = 1.f;
    if (r < 1024) { if (r >= C_MK && r < C_MV) sc = 0.125f; return r; }
    if (r < C_MG) { if (r < C_AK) sc = 0.125f; else if (r >= C_GQ && r < C_GK) sc = 0.17677669529663687f; return r + 16; }
    if (r < C_GGT) return r - C_MG + 1024;
    if (r < C_END) return r;
    return -1;
}
__device__ __forceinline__ void tr_item(const float* W, int K, int N, int NP, bf16_t* WT, int mode, int half, LAS float* scr, int item, int lane) {
    const int nblk = NP >> 6, kb = item / nblk, nb = item - kb * nblk, k0 = kb << 6, n0 = nb << 6;
    const int r = n0 + lane; float sc = 1.f; int src;
    if (mode == 0) src = r; else if (mode == 1) src = in_srccol(r, sc); else { const int pn = r >> 8, w = r & 255; src = (w < 128) ? (pn * 128 + w) : (half + pn * 128 + w - 128); }
    const float* wp = W + (size_t)k0 * N + (src < 0 ? 0 : src);
#pragma unroll 16
    for (int i = 0; i < 64; ++i) { const float v = wp[(size_t)i * N]; scr[i * 65 + lane] = (src < 0) ? 0.f : v * sc; }
    LDS_WAIT();
    const int c = lane & 7;
#pragma unroll
    for (int j = 0; j < 8; ++j) { const int n = (lane >> 3) + 8 * j; const LAS float* s = scr + (8 * c) * 65 + n;
        uint4 o; o.x = pk2(s[0], s[65]); o.y = pk2(s[130], s[195]); o.z = pk2(s[260], s[325]); o.w = pk2(s[390], s[455]);
        *(uint4*)(WT + (size_t)(n0 + n) * K + k0 + 8 * c) = o; }
    LDS_WAIT();
}

__device__ __forceinline__ void chunk_rows(int d, int jc, int& base, int& step) {
    int oc;
    if (d == 0) oc = (jc < 4) ? 256 + jc : jc - 4; else oc = (jc < 4) ? 256 + (3 - jc) : 255 - (jc - 4);
    const int b0 = (oc < 256) ? oc * 64 : SEQ + (oc - 256) * 64;
    if (d == 0) { base = b0; step = 1; } else { base = b0 + 63; step = -1; }
}
__device__ __forceinline__ int oc_to_jc(int d, int oc) { if (d == 0) return oc < 256 ? oc + 4 : oc - 256; return oc < 256 ? 4 + (255 - oc) : 3 - (oc - 256); }

__device__ __forceinline__ void attn_unit(LAS unsigned char* lds, const bf16_t* P, bf16_t* CAT, int qrow0, int hq, float sinkv, bool is_ctx, int qb, int tid) {
    LAS float* Qs = (LAS float*)lds; LAS float* Ks = Qs + 128 * 68; LAS float* Vs = Ks + 64 * 68; LAS float* Ps = Vs + 64 * 68;
    const int kvh = hq >> 2;
    __syncthreads();
    for (int i = tid; i < 128 * 8; i += 512) { const int r = i >> 3, c8 = i & 7; float f[8]; load8bf(P + (size_t)(qrow0 + r) * LDP + C_AQ + hq * 64 + c8 * 8, f);
        *(LAS f32x4*)(Qs + r * 68 + c8 * 8) = (f32x4){f[0], f[1], f[2], f[3]}; *(LAS f32x4*)(Qs + r * 68 + c8 * 8 + 4) = (f32x4){f[4], f[5], f[6], f[7]}; }
    const int q = tid >> 2, part = tid & 3;
    float m = sinkv, l = 1.f, O[16];
#pragma unroll
    for (int i = 0; i < 16; ++i) O[i] = 0.f;
    const int ntile = is_ctx ? 4 : 10;
    for (int kt = 0; kt < ntile; ++kt) {
        int krow0; bool masked;
        if (!is_ctx && kt < 6) { const int ks = (qb - 1) * 128 + kt * 64; if (ks < 0 || ks >= SEQ) continue; krow0 = ks; masked = true; }
        else { const int ct = is_ctx ? kt : kt - 6; krow0 = SEQ + ct * 64; masked = false; }
        __syncthreads();
        { const int r = tid >> 3, c8 = tid & 7; float f[8];
          load8bf(P + (size_t)(krow0 + r) * LDP + C_AK + kvh * 64 + c8 * 8, f);
          *(LAS f32x4*)(Ks + r * 68 + c8 * 8) = (f32x4){f[0], f[1], f[2], f[3]}; *(LAS f32x4*)(Ks + r * 68 + c8 * 8 + 4) = (f32x4){f[4], f[5], f[6], f[7]};
          load8bf(P + (size_t)(krow0 + r) * LDP + C_AV + kvh * 64 + c8 * 8, f);
          *(LAS f32x4*)(Vs + r * 68 + c8 * 8) = (f32x4){f[0], f[1], f[2], f[3]}; *(LAS f32x4*)(Vs + r * 68 + c8 * 8 + 4) = (f32x4){f[4], f[5], f[6], f[7]}; }
        __syncthreads();
        float s[16];
#pragma unroll
        for (int j = 0; j < 16; ++j) s[j] = 0.f;
#pragma unroll 4
        for (int d4 = 0; d4 < 16; ++d4) { const f32x4 qv = *(const LAS f32x4*)(Qs + q * 68 + 4 * d4);
#pragma unroll
            for (int j = 0; j < 16; ++j) { const f32x4 kv = *(const LAS f32x4*)(Ks + (part * 16 + j) * 68 + 4 * d4); s[j] += qv[0] * kv[0] + qv[1] * kv[1] + qv[2] * kv[2] + qv[3] * kv[3]; } }
        if (masked) { const int qi = qb * 128 + q;
#pragma unroll
            for (int j = 0; j < 16; ++j) { const int kj = krow0 + part * 16 + j; const int dd = qi - kj; if (dd > 128 || dd < -128) s[j] = -INFINITY; } }
        float tmax = s[0];
#pragma unroll
        for (int j = 1; j < 16; ++j) tmax = fmaxf(tmax, s[j]);
        tmax = fmaxf(tmax, __shfl_xor(tmax, 1)); tmax = fmaxf(tmax, __shfl_xor(tmax, 2));
        const float mn = fmaxf(m, tmax), alpha = __expf(m - mn); float psum = 0.f;
#pragma unroll
        for (int j = 0; j < 16; ++j) { const float p = __expf(s[j] - mn); Ps[q * 68 + part * 16 + j] = p; psum += p; }
        psum += __shfl_xor(psum, 1); psum += __shfl_xor(psum, 2);
        l = l * alpha + psum; m = mn;
        __syncthreads();
#pragma unroll
        for (int i = 0; i < 16; ++i) O[i] *= alpha;
#pragma unroll 4
        for (int j = 0; j < 64; ++j) { const float p = Ps[q * 68 + j];
#pragma unroll
            for (int d4 = 0; d4 < 4; ++d4) { const f32x4 vv = *(const LAS f32x4*)(Vs + j * 68 + part * 16 + 4 * d4); O[4 * d4] += p * vv[0]; O[4 * d4 + 1] += p * vv[1]; O[4 * d4 + 2] += p * vv[2]; O[4 * d4 + 3] += p * vv[3]; } }
    }
    const float inv = 1.f / l;
    uint4 o0, o1;
    o0.x = pk2(O[0] * inv, O[1] * inv); o0.y = pk2(O[2] * inv, O[3] * inv); o0.z = pk2(O[4] * inv, O[5] * inv); o0.w = pk2(O[6] * inv, O[7] * inv);
    o1.x = pk2(O[8] * inv, O[9] * inv); o1.y = pk2(O[10] * inv, O[11] * inv); o1.z = pk2(O[12] * inv, O[13] * inv); o1.w = pk2(O[14] * inv, O[15] * inv);
    bf16_t* dst = CAT + (size_t)(qrow0 + q) * DM + 256 + hq * 64 + part * 16;
    *(uint4*)dst = o0; *(uint4*)(dst + 8) = o1;
}

__device__ __forceinline__ void mlstm_summary(LAS unsigned char* lds, const bf16_t* P, const float* Gt, const float* gate_b  , float* MU, float* MNU, float* MSC, int h, int d, int jc, int tid, int lane, int wave) {
    LAS float* kf = (LAS float*)lds; LAS float* vf = kf + 64 * 65; LAS float* wv = vf + 64 * 65;
    int base, step; chunk_rows(d, jc, base, step);
    const int hd = h * 2 + d;
    __syncthreads();
    { const int s = tid >> 3, c8 = tid & 7; const int row = base + step * s; float f[8];
      load8bf(P + (size_t)row * LDP + C_MK + h * 64 + c8 * 8, f);
#pragma unroll
      for (int i = 0; i < 8; ++i) kf[s * 65 + c8 * 8 + i] = f[i];
      load8bf(P + (size_t)row * LDP + C_MV + h * 64 + c8 * 8, f);
#pragma unroll
      for (int i = 0; i < 8; ++i) vf[s * 65 + c8 * 8 + i] = f[i]; }
    if (wave == 0) {
        const int row = base + step * lane;
        const float ig = Gt[(size_t)row * 48 + d * 8 + h] + gate_b[d * 8 + h];
        const float fg = Gt[(size_t)row * 48 + d * 8 + 4 + h] + gate_b[d * 8 + 4 + h];
        const float lf = log_sigmoidf_(fg);
        const float b = scan_add(lf, lane);
        const float a = ig - b;
        const float cm = wave_max(a);
        const float B = __shfl(b, 63);
        wv[lane] = __expf(a - cm);
        if (lane == 0) { MSC[(size_t)(hd * NCH + jc) * 4 + 0] = cm; MSC[(size_t)(hd * NCH + jc) * 4 + 1] = B; }
    }
    __syncthreads();
    { const int dk = tid >> 3, dv0 = (tid & 7) * 8; float acc[8];
#pragma unroll
      for (int j = 0; j < 8; ++j) acc[j] = 0.f;
#pragma unroll 4
      for (int s = 0; s < 64; ++s) { const float kw = kf[s * 65 + dk] * wv[s];
#pragma unroll
          for (int j = 0; j < 8; ++j) acc[j] += kw * vf[s * 65 + dv0 + j]; }
      float* dst = MU + ((size_t)(hd * NCH + jc) * 4096) + dk * 64 + dv0;
      *(f32x4*)dst = (f32x4){acc[0], acc[1], acc[2], acc[3]}; *(f32x4*)(dst + 4) = (f32x4){acc[4], acc[5], acc[6], acc[7]}; }
    if (tid < 64) { float a = 0.f;
#pragma unroll 4
        for (int s = 0; s < 64; ++s) a += wv[s] * kf[s * 65 + tid];
        MNU[(size_t)(hd * NCH + jc) * 64 + tid] = a; }
}

__device__ __forceinline__ void gla_gates(LAS float* bc, LAS float* gsrc, LAS float* gup, const float* Gt, const float* g_up  , const float* g_b  , int h, int d, int base, int step, int tid) {
    for (int i = tid; i < 64 * 16; i += 512) { const int s = i >> 4, r = i & 15; gsrc[s * 17 + r] = Gt[(size_t)(base + step * s) * 48 + 16 + d * 16 + r]; }
    { const int r = tid >> 5, dk = tid & 31; gup[r * 33 + dk] = g_up[(d * 16 + r) * 128 + h * 32 + dk]; }
    __syncthreads();
#pragma unroll
    for (int i = 0; i < 4; ++i) { const int idx = tid + i * 512, s = idx >> 5, dk = idx & 31; float z = g_b[d * 128 + h * 32 + dk];
#pragma unroll
        for (int r = 0; r < 16; ++r) z += gsrc[s * 17 + r] * gup[r * 33 + dk];
        bc[s * 33 + dk] = log_sigmoidf_(z) * (1.f / 16.f); }
    __syncthreads();
    if (tid < 32) { float run = 0.f; for (int s = 0; s < 64; ++s) { run += bc[s * 33 + tid]; bc[s * 33 + tid] = run; } }
    __syncthreads();
}
__device__ __forceinline__ void gla_summary(LAS unsigned char* lds, const bf16_t* P, const float* Gt, const float* g_up, const float* g_b, float* GU, float* GDEC, int h, int d, int jc, int tid) {
    LAS float* kf = (LAS float*)lds; LAS float* vf = kf + 64 * 33; LAS float* bc = vf + 64 * 65; LAS float* gsrc = bc + 64 * 33; LAS float* gup = gsrc + 64 * 17;
    int base, step; chunk_rows(d, jc, base, step);
    const int hd = h * 2 + d;
    __syncthreads();
    if (tid < 256) { const int s = tid >> 2, c8 = tid & 3; float f[8]; load8bf(P + (size_t)(base + step * s) * LDP + C_GK + h * 32 + c8 * 8, f);
#pragma unroll
        for (int i = 0; i < 8; ++i) kf[s * 33 + c8 * 8 + i] = f[i]; }
    { const int s = tid >> 3, c8 = tid & 7; float f[8]; load8bf(P + (size_t)(base + step * s) * LDP + C_GV + h * 64 + c8 * 8, f);
#pragma unroll
      for (int i = 0; i < 8; ++i) vf[s * 65 + c8 * 8 + i] = f[i]; }
    gla_gates(bc, gsrc, gup, Gt, g_up, g_b, h, d, base, step, tid);
#pragma unroll
    for (int i = 0; i < 4; ++i) { const int idx = tid + i * 512, s = idx >> 5, dk = idx & 31; kf[s * 33 + dk] *= __expf(bc[63 * 33 + dk] - bc[s * 33 + dk]); }
    __syncthreads();
    { const int dk = tid >> 4, dv0 = (tid & 15) * 4; float acc[4] = {0.f, 0.f, 0.f, 0.f};
#pragma unroll 4
      for (int s = 0; s < 64; ++s) { const float kw = kf[s * 33 + dk];
#pragma unroll
          for (int j = 0; j < 4; ++j) acc[j] += kw * vf[s * 65 + dv0 + j]; }
      *(f32x4*)(GU + (size_t)(hd * NCH + jc) * 2048 + dk * 64 + dv0) = (f32x4){acc[0], acc[1], acc[2], acc[3]}; }
    if (tid < 32) GDEC[(size_t)(hd * NCH + jc) * 32 + tid] = __expf(bc[63 * 33 + tid]);
}

__device__ __forceinline__ void mlstm_out(LAS unsigned char* lds, const bf16_t* P, const float* Gt, const float* gate_b, const float* MC, const float* MNS, const float* MSC, const float* normw  , bf16_t* CAT, int h, int oc, int tid, int lane, int wave) {
    LAS float* qf = (LAS float*)lds; LAS float* kf = qf + 64 * 65; LAS float* vf = kf + 64 * 65; LAS float* Sm = vf + 64 * 65; LAS float* Cs = Sm + 64 * 65; LAS float* hs = Cs + 64 * 65;
    LAS float* av = hs + 64 * 65; LAS float* mxv = av + 64; LAS float* wiv = mxv + 64; LAS float* emv = wiv + 64; LAS float* nv = emv + 64; LAS float* dnv = nv + 64;
    const int b0 = (oc < 256) ? oc * 64 : SEQ + (oc - 256) * 64;
    const int t = tid >> 3, dv0 = (tid & 7) * 8;
    for (int d = 0; d < 2; ++d) {
        const int jc = oc_to_jc(d, oc), hd = h * 2 + d;
        const int base = d ? b0 + 63 : b0, step = d ? -1 : 1;
        __syncthreads();
        { const int s = tid >> 3, c8 = tid & 7; const size_t ro = (size_t)(base + step * s) * LDP + h * 64 + c8 * 8; float f[8];
          load8bf(P + ro + C_MQ, f);
#pragma unroll
          for (int i = 0; i < 8; ++i) qf[s * 65 + c8 * 8 + i] = f[i];
          load8bf(P + ro + C_MK, f);
#pragma unroll
          for (int i = 0; i < 8; ++i) kf[s * 65 + c8 * 8 + i] = f[i];
          load8bf(P + ro + C_MV, f);
#pragma unroll
          for (int i = 0; i < 8; ++i) vf[s * 65 + c8 * 8 + i] = f[i];
          const f32x4 c0 = *(const f32x4*)(MC + (size_t)(hd * NCH + jc) * 4096 + s * 64 + c8 * 8), c1 = *(const f32x4*)(MC + (size_t)(hd * NCH + jc) * 4096 + s * 64 + c8 * 8 + 4);
#pragma unroll
          for (int i = 0; i < 4; ++i) { Cs[s * 65 + c8 * 8 + i] = c0[i]; Cs[s * 65 + c8 * 8 + 4 + i] = c1[i]; } }
        if (tid < 64) nv[tid] = MNS[(size_t)(hd * NCH + jc) * 64 + tid];
        if (wave == 1) {
            const int row = base + step * lane;
            const float ig = Gt[(size_t)row * 48 + d * 8 + h] + gate_b[d * 8 + h];
            const float fg = Gt[(size_t)row * 48 + d * 8 + 4 + h] + gate_b[d * 8 + 4 + h];
            const float lf = log_sigmoidf_(fg);
            const float b = scan_add(lf, lane);
            const float a = ig - b;
            const float cm = scan_max(a, lane);
            const float mst = MSC[(size_t)(hd * NCH + jc) * 4 + 2];
            const float mx = fmaxf(mst, cm);
            av[lane] = a; mxv[lane] = mx; wiv[lane] = __expf(mst - mx); emv[lane] = __expf(-(b + mx));
        }
        __syncthreads();
        { const int s0 = (tid & 7) * 8; float acc[8];
#pragma unroll
          for (int j = 0; j < 8; ++j) acc[j] = 0.f;
#pragma unroll 4
          for (int dk = 0; dk < 64; ++dk) { const float qv = qf[t * 65 + dk];
#pragma unroll
              for (int j = 0; j < 8; ++j) acc[j] += qv * kf[(s0 + j) * 65 + dk]; }
          const float mxt = mxv[t];
#pragma unroll
          for (int j = 0; j < 8; ++j) { const int s = s0 + j; Sm[t * 65 + s] = (s <= t) ? acc[j] * __expf(av[s] - mxt) : 0.f; } }
        __syncthreads();
        if (tid < 64) { float dsum = 0.f, qn = 0.f;
#pragma unroll 4
            for (int s = 0; s < 64; ++s) { dsum += Sm[tid * 65 + s]; qn += qf[tid * 65 + s] * nv[s]; }
            dnv[tid] = dsum + wiv[tid] * qn; }
        float num[8], qc[8];
#pragma unroll
        for (int j = 0; j < 8; ++j) { num[j] = 0.f; qc[j] = 0.f; }
#pragma unroll 4
        for (int s = 0; s < 64; ++s) { const float sv = Sm[t * 65 + s], qv = qf[t * 65 + s];
#pragma unroll
            for (int j = 0; j < 8; ++j) { num[j] += sv * vf[s * 65 + dv0 + j]; qc[j] += qv * Cs[s * 65 + dv0 + j]; } }
        __syncthreads();
        { const float wi = wiv[t], den = fmaxf(fabsf(dnv[t]), emv[t]), inv = 1.f / den; const int to = d ? 63 - t : t;
#pragma unroll
          for (int j = 0; j < 8; ++j) { const float hv = (num[j] + wi * qc[j]) * inv; if (d == 0) hs[to * 65 + dv0 + j] = hv; else hs[to * 65 + dv0 + j] += hv; } }
    }
    __syncthreads();
    { float x[8]; float s1 = 0.f;
#pragma unroll
      for (int j = 0; j < 8; ++j) { x[j] = hs[t * 65 + dv0 + j]; s1 += x[j]; }
      s1 += __shfl_xor(s1, 1); s1 += __shfl_xor(s1, 2); s1 += __shfl_xor(s1, 4);
      const float mu = s1 * (1.f / 64.f); float s2 = 0.f;
#pragma unroll
      for (int j = 0; j < 8; ++j) { x[j] -= mu; s2 += x[j] * x[j]; }
      s2 += __shfl_xor(s2, 1); s2 += __shfl_xor(s2, 2); s2 += __shfl_xor(s2, 4);
      const float rstd = rsqrtf(s2 * (1.f / 64.f) + LN_EPS);
      const int row = b0 + t; float og[8]; load8bf(P + (size_t)row * LDP + C_MO + h * 64 + dv0, og);
      float r[8];
#pragma unroll
      for (int j = 0; j < 8; ++j) r[j] = x[j] * rstd * normw[h * 64 + dv0 + j] * sigmoidf_(og[j]);
      uint4 o; o.x = pk2(r[0], r[1]); o.y = pk2(r[2], r[3]); o.z = pk2(r[4], r[5]); o.w = pk2(r[6], r[7]);
      *(uint4*)(CAT + (size_t)row * DM + h * 64 + dv0) = o; }
}

__device__ __forceinline__ void gla_out(LAS unsigned char* lds, const bf16_t* P, const float* Gt, const float* g_up, const float* g_b, const float* GS, const float* normw, bf16_t* CAT, int h, int oc, int tid) {
    LAS float* qf = (LAS float*)lds; LAS float* kf = qf + 64 * 33; LAS float* vf = kf + 64 * 33; LAS float* bc = vf + 64 * 65; LAS float* Sm = bc + 64 * 33; LAS float* Ss = Sm + 64 * 65; LAS float* hs = Ss + 32 * 65;
    LAS float* gsrc = hs + 64 * 65; LAS float* gup = gsrc + 64 * 17;
    const int b0 = (oc < 256) ? oc * 64 : SEQ + (oc - 256) * 64;
    const int t = tid >> 3, dv0 = (tid & 7) * 8;
    for (int d = 0; d < 2; ++d) {
        const int jc = oc_to_jc(d, oc), hd = h * 2 + d;
        const int base = d ? b0 + 63 : b0, step = d ? -1 : 1;
        __syncthreads();
        { const int s = tid >> 3, c8 = tid & 7; const size_t ro = (size_t)(base + step * s) * LDP; float f[8];
          if (c8 < 4) { load8bf(P + ro + C_GQ + h * 32 + c8 * 8, f);
#pragma unroll
              for (int i = 0; i < 8; ++i) qf[s * 33 + c8 * 8 + i] = f[i]; }
          else { load8bf(P + ro + C_GK + h * 32 + (c8 - 4) * 8, f);
#pragma unroll
              for (int i = 0; i < 8; ++i) kf[s * 33 + (c8 - 4) * 8 + i] = f[i]; }
          load8bf(P + ro + C_GV + h * 64 + c8 * 8, f);
#pragma unroll
          for (int i = 0; i < 8; ++i) vf[s * 65 + c8 * 8 + i] = f[i]; }
        { const int dk = tid >> 4, c4 = (tid & 15) * 4; const f32x4 sv = *(const f32x4*)(GS + (size_t)(hd * NCH + jc) * 2048 + dk * 64 + c4);
#pragma unroll
          for (int i = 0; i < 4; ++i) Ss[dk * 65 + c4 + i] = sv[i]; }
        gla_gates(bc, gsrc, gup, Gt, g_up, g_b, h, d, base, step, tid);
#pragma unroll
        for (int i = 0; i < 4; ++i) { const int idx = tid + i * 512, s = idx >> 5, dk = idx & 31; const float b = bc[s * 33 + dk]; qf[s * 33 + dk] *= __expf(b); kf[s * 33 + dk] *= __expf(-b); }
        __syncthreads();
        { const int s0 = (tid & 7) * 8; float acc[8];
#pragma unroll
          for (int j = 0; j < 8; ++j) acc[j] = 0.f;
#pragma unroll 4
          for (int dk = 0; dk < 32; ++dk) { const float qv = qf[t * 33 + dk];
#pragma unroll
              for (int j = 0; j < 8; ++j) acc[j] += qv * kf[(s0 + j) * 33 + dk]; }
#pragma unroll
          for (int j = 0; j < 8; ++j) { const int s = s0 + j; Sm[t * 65 + s] = (s <= t) ? acc[j] : 0.f; } }
        __syncthreads();
        float num[8];
#pragma unroll
        for (int j = 0; j < 8; ++j) num[j] = 0.f;
#pragma unroll 4
        for (int s = 0; s < 64; ++s) { const float sv = Sm[t * 65 + s];
#pragma unroll
            for (int j = 0; j < 8; ++j) num[j] += sv * vf[s * 65 + dv0 + j]; }
#pragma unroll 4
        for (int dk = 0; dk < 32; ++dk) { const float qv = qf[t * 33 + dk];
#pragma unroll
            for (int j = 0; j < 8; ++j) num[j] += qv * Ss[dk * 65 + dv0 + j]; }
        { const int to = d ? 63 - t : t;
#pragma unroll
          for (int j = 0; j < 8; ++j) { if (d == 0) hs[to * 65 + dv0 + j] = num[j]; else hs[to * 65 + dv0 + j] += num[j]; } }
    }
    __syncthreads();
    { float x[8]; float s1 = 0.f;
#pragma unroll
      for (int j = 0; j < 8; ++j) { x[j] = hs[t * 65 + dv0 + j]; s1 += x[j]; }
      s1 += __shfl_xor(s1, 1); s1 += __shfl_xor(s1, 2); s1 += __shfl_xor(s1, 4);
      const float mu = s1 * (1.f / 64.f); float s2 = 0.f;
#pragma unroll
      for (int j = 0; j < 8; ++j) { x[j] -= mu; s2 += x[j] * x[j]; }
      s2 += __shfl_xor(s2, 1); s2 += __shfl_xor(s2, 2); s2 += __shfl_xor(s2, 4);
      const float rstd = rsqrtf(s2 * (1.f / 64.f) + LN_EPS);
      const int row = b0 + t; float gg[8]; load8bf(P + (size_t)row * LDP + C_GG + h * 64 + dv0, gg);
      float r[8];
#pragma unroll
      for (int j = 0; j < 8; ++j) r[j] = x[j] * rstd * normw[h * 64 + dv0 + j] * siluf(gg[j]);
      uint4 o; o.x = pk2(r[0], r[1]); o.y = pk2(r[2], r[3]); o.z = pk2(r[4], r[5]); o.w = pk2(r[6], r[7]);
      *(uint4*)(CAT + (size_t)row * DM + 768 + h * 64 + dv0) = o; }
}

__device__ __forceinline__ void ln16(f32x4 (&v)[4], const float* w, const float* b, int lane) {
    float s = 0.f;
#pragma unroll
    for (int j = 0; j < 4; ++j) s += (v[j][0] + v[j][1]) + (v[j][2] + v[j][3]);
    const float mean = wave_sum(s) * (1.f / DM); float s2 = 0.f;
#pragma unroll
    for (int j = 0; j < 4; ++j) { v[j] = v[j] - mean; s2 += (v[j][0] * v[j][0] + v[j][1] * v[j][1]) + (v[j][2] * v[j][2] + v[j][3] * v[j][3]); }
    const float rstd = rsqrtf(wave_sum(s2) * (1.f / DM) + LN_EPS);
#pragma unroll
    for (int j = 0; j < 4; ++j) { const f32x4 wv = *(const f32x4*)(w + 4 * lane + 256 * j), bv = *(const f32x4*)(b + 4 * lane + 256 * j); v[j] = v[j] * rstd * wv + bv; }
}
__device__ __forceinline__ void mod_store(f32x4 (&v)[4], const float* shift, const float* scale, bf16_t* hrow, int lane) {
#pragma unroll
    for (int j = 0; j < 4; ++j) { const f32x4 sh = *(const f32x4*)(shift + 4 * lane + 256 * j), sc = *(const f32x4*)(scale + 4 * lane + 256 * j);
        v[j] = v[j] * (sc + 1.f) + sh;
        uint2 o; o.x = pk2(v[j][0], v[j][1]); o.y = pk2(v[j][2], v[j][3]); *(uint2*)(hrow + 4 * lane + 256 * j) = o; }
}

__global__ void __launch_bounds__(512, 2) fwd(Args a_unused) {
    extern __shared__ __attribute__((aligned(16))) unsigned char lds_raw[];
    LAS unsigned char* lds = (LAS unsigned char*)lds_raw;
    const int wave0 = __builtin_amdgcn_readfirstlane(threadIdx.x >> 6);
    const int G = gridDim.x, bid = blockIdx.x;
    typedef const __attribute__((address_space(4))) Args* ArgsP;
    ArgsP ap0 = (ArgsP)__builtin_amdgcn_kernarg_segment_ptr();
#define PH_CTX() int wave = wave0; asm volatile("" : "+s"(wave)); unsigned ones_ = ~0u; asm volatile("" : "+s"(ones_)); const int lane = (int)__builtin_amdgcn_mbcnt_hi(ones_, __builtin_amdgcn_mbcnt_lo(ones_, 0u)); const int tid = wave * 64 + lane; \
    ArgsP ap = ap0; asm volatile("" : "+s"(ap)); unsigned char* ws = ap->ws; const int gw = bid * 8 + wave, NGW = G * 8; (void)lane; (void)gw; (void)NGW; (void)ws
#define WSP(T, off) ((T*)(ws + (off)))
    volatile LAS unsigned* MISC = (volatile LAS unsigned*)(lds + MISC_OFF);
    if (threadIdx.x < 32) MISC[threadIdx.x] = 0u;
    __syncthreads();
    XcdBarrier bar; bar.bar = (unsigned*)(ap0->ws + WS_CTL) + CW_BAR; bar.x = 0; bar.st = MISC + 8;
    if (MK_ONE_LAUNCH) bar = xcd_barrier_post(bar.bar, MISC + 8);
    const int lo = ap0->ph_lo, hi = ap0->ph_hi;
#define IN(k) (lo <= (k) && (k) < hi)
#define SEAM(k) do { if (MK_ONE_LAUNCH && (k) + 1 < hi) xcd_barrier(bar); } while (0)

    if (IN(0)) {
        PH_CTX();
        float* MODS = WSP(float, WS_MODS);
        LAS float* scs = (LAS float*)lds;
        for (int i = tid; i < 2048; i += 512) scs[i] = siluf(i < 1024 ? ap->in[1][i] : ap->in[3][i - 1024]);
        __syncthreads();
        for (int u = bid; u < 4 * 8 * 12; u += G) {
            const int l = u / 96, rem = u % 96, kc = rem / 12, ng = rem % 12, n = ng * 512 + tid;
            const float* w = ap->in[4] + ((size_t)l * 1024 + kc * 128) * 6144 + n;
            float a0 = 0.f, a1 = 0.f;
#pragma unroll 8
            for (int k = 0; k < 128; ++k) { const float wv = w[(size_t)k * 6144]; a0 += scs[kc * 128 + k] * wv; a1 += scs[1024 + kc * 128 + k] * wv; }
            if (kc == 0) { const float bb = ap->in[5][l * 6144 + n]; a0 += bb; a1 += bb; }
            atomicAdd(MODS + (size_t)(l * 2 + 0) * 6144 + n, a0); atomicAdd(MODS + (size_t)(l * 2 + 1) * 6144 + n, a1);
        }
        if (bid < 8) { float* ropeC = WSP(float, WS_ROPE); float* ropeS = ropeC + 256 * 16;
            const int i = bid * 512 + tid, pos = i >> 4, fi = i & 15; const float inv = powf(10000.f, -(float)fi / 16.f); const float ang = (float)pos * inv; float sn, cs; sincosf(ang, &sn, &cs); ropeC[i] = cs; ropeS[i] = sn; }
        __syncthreads();
        LAS float* scr = (LAS float*)(lds + wave * 16640);
        constexpr int I_A = 16 * 44, I_B = 16 * 16, I_C = 16 * 88, I_D = 44 * 16, I_E = 16 * 112, I_F = 56 * 16;
        constexpr int N_A = 4 * I_A, N_B = 4 * I_B, N_C = 2 * I_C, N_D = 2 * I_D, N_E = 16 * I_E, N_F = 16 * I_F;
        for (int it = gw; it < N_A + N_B + N_C + N_D + N_E + N_F; it += NGW) {
            int r = it;
            if (r < N_E) { const int mi = r / I_E; tr_item(ap->in[20] + (size_t)mi * DM * 2 * DEXP, DM, 2 * DEXP, 2 * DEXP, WSP(bf16_t, WS_MGU) + (size_t)mi * 2 * DEXP * DM, 2, DEXP, scr, r % I_E, lane); continue; } r -= N_E;
            if (r < N_F) { const int mi = r / I_F; tr_item(ap->in[21] + (size_t)mi * DEXP * DM, DEXP, DM, DM, WSP(bf16_t, WS_MDN) + (size_t)mi * DM * DEXP, 0, 0, scr, r % I_F, lane); continue; } r -= N_F;
            if (r < N_A) { const int mi = r / I_A; tr_item(ap->in[6] + (size_t)mi * DM * IN_COLS, DM, IN_COLS, NPIN, WSP(bf16_t, WS_WIN) + (size_t)mi * NPIN * DM, 1, 0, scr, r % I_A, lane); continue; } r -= N_A;
            if (r < N_B) { const int mi = r / I_B; tr_item(ap->in[13] + (size_t)mi * DM * DM, DM, DM, DM, WSP(bf16_t, WS_WOUT) + (size_t)mi * DM * DM, 0, 0, scr, r % I_B, lane); continue; } r -= N_B;
            if (r < N_C) { const int mi = r / I_C; tr_item(ap->in[16] + (size_t)mi * DM * 2 * DFF, DM, 2 * DFF, 2 * DFF, WSP(bf16_t, WS_FGU) + (size_t)mi * 2 * DFF * DM, 2, DFF, scr, r % I_C, lane); continue; } r -= N_C;
            { const int mi = r / I_D; tr_item(ap->in[17] + (size_t)mi * DFF * DM, DFF, DM, DM, WSP(bf16_t, WS_FDN) + (size_t)mi * DM * DFF, 0, 0, scr, r % I_D, lane); }
        }
        SEAM(0);
    }
    if (IN(1)) {
        PH_CTX();
        float* X = WSP(float, WS_X); bf16_t* H = WSP(bf16_t, WS_H); const float* MODS = WSP(float, WS_MODS);
        for (int r = gw; r < TT; r += NGW) {
            const int wch = r >= SEQ; const float* src = wch ? ap->in[2] + (size_t)(r - SEQ) * DM : ap->in[0] + (size_t)r * DM;
            f32x4 v[4];
#pragma unroll
            for (int j = 0; j < 4; ++j) { v[j] = *(const f32x4*)(src + 4 * lane + 256 * j); *(f32x4*)(X + (size_t)r * DM + 4 * lane + 256 * j) = v[j]; }
            const float* md = MODS + (size_t)(0 * 2 + wch) * 6144;
            mod_store(v, md, md + 1024, H + (size_t)r * DM, lane);
        }
        SEAM(1);
    }

    for (int l = 0; l < DEPTH; ++l) {
        const int pb = 2 + 10 * l;
        const bool lastl = (l == DEPTH - 1), moe = (l & 1);
        const int nrows = lastl ? SEQ : TT;

        if (IN(pb + 0)) {
            PH_CTX();
            pg8::StaticOrder S; S.init(WSP(bf16_t, WS_H), WSP(bf16_t, WS_WIN) + (size_t)l * NPIN * DM, DM, TT, NPIN, G, bid);
            pg8::EpiInProj E{WSP(bf16_t, WS_P), WSP(float, WS_G), WSP(float, WS_ROPE), WSP(float, WS_ROPE) + 256 * 16};
            pg8::gemm_phase<pg8::EpiInProj, pg8::StaticOrder>(lds, DM, S, E, tid);
            SEAM(pb + 0);
        }
        if (IN(pb + 1)) {
            PH_CTX();
            const bf16_t* P = WSP(bf16_t, WS_P); const float* Gt = WSP(float, WS_G);
            const float* gate_b = ap->in[7] + l * 16;
            const float* g_up = ap->in[10] + (size_t)l * 2 * 16 * 128; const float* g_b = ap->in[11] + l * 256;
            for (int u = bid; u < 2 * 8 * NCH; u += G) {
                const int kind = u / (8 * NCH), r = u % (8 * NCH), hd = r / NCH, jc = r % NCH, h = hd >> 1, d = hd & 1;
                if (kind == 0) mlstm_summary(lds, P, Gt, gate_b, WSP(float, WS_MU), WSP(float, WS_MNU), WSP(float, WS_MSC), h, d, jc, tid, lane, wave);
                else gla_summary(lds, P, Gt, g_up, g_b, WSP(float, WS_GU), WSP(float, WS_GDEC), h, d, jc, tid);
            }
            SEAM(pb + 1);
        }
        if (IN(pb + 2)) {
            PH_CTX();
            float* MSC = WSP(float, WS_MSC);
            const int wi = wave * G + bid;
            const int e0 = wi * 64;
            if (e0 < 32768 + 512) {
                const bool isC = e0 < 32768;
                const int hd = isC ? e0 / 4096 : (e0 - 32768) / 64, idx = isC ? (e0 % 4096) + lane : lane;
                const float* U = isC ? WSP(float, WS_MU) + (size_t)hd * NCH * 4096 + idx : WSP(float, WS_MNU) + (size_t)hd * NCH * 64 + idx;
                float* St = isC ? WSP(float, WS_MC) + (size_t)hd * NCH * 4096 + idx : WSP(float, WS_MNS) + (size_t)hd * NCH * 64 + idx;
                const int str = isC ? 4096 : 64;
                const bool wr_m = isC && (e0 % 4096) == 0 && lane == 0;
                float m = 0.f, cval = 0.f;
                for (int n0 = 0; n0 < NCH; n0 += 4) {
                    float uu[4], cm[4], BB[4];
#pragma unroll
                    for (int j = 0; j < 4; ++j) { uu[j] = U[(size_t)(n0 + j) * str]; cm[j] = MSC[(size_t)(hd * NCH + n0 + j) * 4]; BB[j] = MSC[(size_t)(hd * NCH + n0 + j) * 4 + 1]; }
#pragma unroll
                    for (int j = 0; j < 4; ++j) {
                        St[(size_t)(n0 + j) * str] = cval;
                        if (wr_m) MSC[(size_t)(hd * NCH + n0 + j) * 4 + 2] = m;
                        const float mx = fmaxf(m, cm[j]);
                        cval = __expf(m - mx) * cval + __expf(cm[j] - mx) * uu[j];
                        m = BB[j] + mx;
                    }
                }
            } else if (e0 < 32768 + 512 + 16384) {
                const int e2 = e0 - 33280, hd = e2 / 2048, idx = (e2 % 2048) + lane, dk = idx >> 6;
                const float* U = WSP(float, WS_GU) + (size_t)hd * NCH * 2048 + idx; float* St = WSP(float, WS_GS) + (size_t)hd * NCH * 2048 + idx; const float* DC = WSP(float, WS_GDEC) + (size_t)hd * NCH * 32 + dk;
                float sval = 0.f;
                for (int n0 = 0; n0 < NCH; n0 += 4) {
                    float uu[4], dc[4];
#pragma unroll
                    for (int j = 0; j < 4; ++j) { uu[j] = U[(size_t)(n0 + j) * 2048]; dc[j] = DC[(size_t)(n0 + j) * 32]; }
#pragma unroll
                    for (int j = 0; j < 4; ++j) { St[(size_t)(n0 + j) * 2048] = sval; sval = dc[j] * sval + uu[j]; }
                }
            }
            SEAM(pb + 2);
        }
        if (IN(pb + 3)) {
            PH_CTX();
            const bf16_t* P = WSP(bf16_t, WS_P); const float* Gt = WSP(float, WS_G); bf16_t* CAT = WSP(bf16_t, WS_CAT);
            const int n_att = 1024 + (lastl ? 0 : 16), noc = lastl ? 256 : 260;
            const int NU = n_att + 8 * noc;
            for (int u = bid; u < NU; u += G) {
                if (u < 1024) { const int qb = u >> 3, hq = u & 7; attn_unit(lds, P, CAT, qb * 128, hq, ap->in[9][l * 8 + hq], false, qb, tid); }
                else if (u < n_att) { const int v = u - 1024, cq = v >> 3, hq = v & 7; attn_unit(lds, P, CAT, SEQ + cq * 128, hq, ap->in[9][l * 8 + hq], true, 0, tid); }
                else { const int v = u - n_att, kind = v / (4 * noc), r = v % (4 * noc), h = r / noc, oc = r % noc;
                    if (kind == 0) mlstm_out(lds, P, Gt, ap->in[7] + l * 16, WSP(float, WS_MC), WSP(float, WS_MNS), WSP(float, WS_MSC), ap->in[8] + l * 256, CAT, h, oc, tid, lane, wave);
                    else gla_out(lds, P, Gt, ap->in[10] + (size_t)l * 2 * 16 * 128, ap->in[11] + l * 256, WSP(float, WS_GS), ap->in[12] + l * 256, CAT, h, oc, tid); }
            }
            SEAM(pb + 3);
        }
        if (IN(pb + 4)) {
            PH_CTX();
            const float* modl = WSP(float, WS_MODS) + (size_t)(l * 2 + 0) * 6144;
            pg8::StaticOrder S; S.init(WSP(bf16_t, WS_CAT), WSP(bf16_t, WS_WOUT) + (size_t)l * DM * DM, DM, nrows, DM, G, bid);
            pg8::EpiResid E{WSP(float, WS_X), WSP(float, WS_Y), modl + 2 * 1024, modl + 6144 + 2 * 1024};
            pg8::gemm_phase<pg8::EpiResid, pg8::StaticOrder>(lds, DM, S, E, tid);
            SEAM(pb + 4);
        }
        if (IN(pb + 5)) {
            PH_CTX();
            float* X = WSP(float, WS_X); bf16_t* H = WSP(bf16_t, WS_H); const float* Y = WSP(float, WS_Y);
            const float* modl = WSP(float, WS_MODS) + (size_t)(l * 2 + 0) * 6144;
            unsigned* mcnt = WSP(unsigned, WS_CTL) + CW_MOE + 64 * 8 * (l >> 1);
            LAS float* RW = (LAS float*)lds;
            if (moe) { const float* rw = ap->in[18] + (size_t)(l >> 1) * DM * 8; for (int i = tid; i < 8192; i += 512) { const int e = i >> 10, c = i & 1023; RW[i] = rw[c * 8 + e]; } __syncthreads(); }
            const float* lw = ap->in[14] + (size_t)(l * 2 + 0) * DM; const float* lb = ap->in[15] + (size_t)(l * 2 + 0) * DM;
            for (int r = gw; r < nrows; r += NGW) {
                const int wch = r >= SEQ; const float* md = modl + wch * 6144;
                f32x4 v[4];
#pragma unroll
                for (int j = 0; j < 4; ++j) v[j] = *(const f32x4*)(Y + (size_t)r * DM + 4 * lane + 256 * j);
                ln16(v, lw, lb, lane);
#pragma unroll
                for (int j = 0; j < 4; ++j) *(f32x4*)(X + (size_t)r * DM + 4 * lane + 256 * j) = v[j];
                mod_store(v, md + 3 * 1024, md + 4 * 1024, H + (size_t)r * DM, lane);
                if (moe) {
                    float lg[8];
#pragma unroll
                    for (int e = 0; e < 8; ++e) { float s = 0.f;
#pragma unroll
                        for (int j = 0; j < 4; ++j) { const f32x4 w = *(const LAS f32x4*)(RW + e * 1024 + 4 * lane + 256 * j); s += v[j][0] * w[0] + v[j][1] * w[1] + v[j][2] * w[2] + v[j][3] * w[3]; }
                        lg[e] = wave_sum(s) + ap->in[19][(l >> 1) * 8 + e]; }
                    int e0 = 0; float l0 = lg[0];
#pragma unroll
                    for (int e = 1; e < 8; ++e) if (lg[e] > l0) { l0 = lg[e]; e0 = e; }
                    int e1 = -1; float l1 = -INFINITY;
#pragma unroll
                    for (int e = 0; e < 8; ++e) if (e != e0 && lg[e] > l1) { l1 = lg[e]; e1 = e; }
                    if (lane == 0) {
                        const float w0 = 1.f / (1.f + __expf(l1 - l0));
                        const int p0 = (int)atomicAdd(mcnt + 64 * e0, 1u), p1 = (int)atomicAdd(mcnt + 64 * e1, 1u);
                        WSP(int2, WS_TOKE)[r] = make_int2(e0, e1); WSP(int2, WS_TOKP)[r] = make_int2(p0, p1); WSP(float2, WS_TOKW)[r] = make_float2(w0, 1.f - w0);
                    }
                }
            }
            SEAM(pb + 5);
        }
#define MOE_TS() int ts0 = 0, ts1, ts2, ts3, ts4, ts5, ts6, ts7, ts8; { const unsigned* mcnt = WSP(unsigned, WS_CTL) + CW_MOE + 64 * 8 * (l >> 1); \
            ts1 = ts0 + (int)((__hip_atomic_load(mcnt + 64 * 0, __ATOMIC_RELAXED, __HIP_MEMORY_SCOPE_AGENT) + 255u) >> 8); ts2 = ts1 + (int)((__hip_atomic_load(mcnt + 64 * 1, __ATOMIC_RELAXED, __HIP_MEMORY_SCOPE_AGENT) + 255u) >> 8); \
            ts3 = ts2 + (int)((__hip_atomic_load(mcnt + 64 * 2, __ATOMIC_RELAXED, __HIP_MEMORY_SCOPE_AGENT) + 255u) >> 8); ts4 = ts3 + (int)((__hip_atomic_load(mcnt + 64 * 3, __ATOMIC_RELAXED, __HIP_MEMORY_SCOPE_AGENT) + 255u) >> 8); \
            ts5 = ts4 + (int)((__hip_atomic_load(mcnt + 64 * 4, __ATOMIC_RELAXED, __HIP_MEMORY_SCOPE_AGENT) + 255u) >> 8); ts6 = ts5 + (int)((__hip_atomic_load(mcnt + 64 * 5, __ATOMIC_RELAXED, __HIP_MEMORY_SCOPE_AGENT) + 255u) >> 8); \
            ts7 = ts6 + (int)((__hip_atomic_load(mcnt + 64 * 6, __ATOMIC_RELAXED, __HIP_MEMORY_SCOPE_AGENT) + 255u) >> 8); ts8 = ts7 + (int)((__hip_atomic_load(mcnt + 64 * 7, __ATOMIC_RELAXED, __HIP_MEMORY_SCOPE_AGENT) + 255u) >> 8); \
            ts1 = __builtin_amdgcn_readfirstlane(ts1); ts2 = __builtin_amdgcn_readfirstlane(ts2); ts3 = __builtin_amdgcn_readfirstlane(ts3); ts4 = __builtin_amdgcn_readfirstlane(ts4); \
            ts5 = __builtin_amdgcn_readfirstlane(ts5); ts6 = __builtin_amdgcn_readfirstlane(ts6); ts7 = __builtin_amdgcn_readfirstlane(ts7); ts8 = __builtin_amdgcn_readfirstlane(ts8); } (void)ts0; (void)ts8
        if (IN(pb + 6) && moe) {
            PH_CTX();
            MOE_TS();
            const bf16_t* H = WSP(bf16_t, WS_H); bf16_t* XB = WSP(bf16_t, WS_XB);
            for (int r = gw; r < nrows; r += NGW) {
                const int2 ee = WSP(int2, WS_TOKE)[r], pp = WSP(int2, WS_TOKP)[r];
                const int b0 = ee.x == 0 ? ts0 : ee.x == 1 ? ts1 : ee.x == 2 ? ts2 : ee.x == 3 ? ts3 : ee.x == 4 ? ts4 : ee.x == 5 ? ts5 : ee.x == 6 ? ts6 : ts7;
                const int b1 = ee.y == 0 ? ts0 : ee.y == 1 ? ts1 : ee.y == 2 ? ts2 : ee.y == 3 ? ts3 : ee.y == 4 ? ts4 : ee.y == 5 ? ts5 : ee.y == 6 ? ts6 : ts7;
                const int s0 = b0 * 256 + pp.x, s1 = b1 * 256 + pp.y;
                const uint4 h0 = *(const uint4*)(H + (size_t)r * DM + 8 * lane), h1 = *(const uint4*)(H + (size_t)r * DM + 512 + 8 * lane);
                *(uint4*)(XB + (size_t)s0 * DM + 8 * lane) = h0; *(uint4*)(XB + (size_t)s0 * DM + 512 + 8 * lane) = h1;
                *(uint4*)(XB + (size_t)s1 * DM + 8 * lane) = h0; *(uint4*)(XB + (size_t)s1 * DM + 512 + 8 * lane) = h1;
                if (lane == 0) WSP(int2, WS_TOKS)[r] = make_int2(s0, s1);
            }
            SEAM(pb + 6);
        }
        if (IN(pb + 7)) {
            PH_CTX();
            if (!moe) {
                pg8::StaticOrder S; S.init(WSP(bf16_t, WS_H), WSP(bf16_t, WS_FGU) + (size_t)(l >> 1) * 2 * DFF * DM, DM, nrows, 2 * DFF, G, bid);
                pg8::EpiSwiglu E{WSP(bf16_t, WS_ACT), DFF};
                pg8::gemm_phase<pg8::EpiSwiglu, pg8::StaticOrder>(lds, DM, S, E, tid);
            } else {
                MOE_TS();
                pg8::MoeOrder S; S.A = (const char*)WSP(bf16_t, WS_XB); S.Bt = (const char*)(WSP(bf16_t, WS_MGU) + (size_t)(l >> 1) * 8 * 2 * DEXP * DM); S.K = DM; S.N = 2 * DEXP; S.nN = 2 * DEXP / 256; S.ntile = ts8; S.G = G; S.c = bid;
                S.ts1 = ts1; S.ts2 = ts2; S.ts3 = ts3; S.ts4 = ts4; S.ts5 = ts5; S.ts6 = ts6; S.ts7 = ts7;
                pg8::EpiSwiglu E{WSP(bf16_t, WS_ACT), DEXP};
                pg8::gemm_phase<pg8::EpiSwiglu, pg8::MoeOrder>(lds, DM, S, E, tid);
            }
            SEAM(pb + 7);
        }
        if (IN(pb + 8)) {
            PH_CTX();
            if (!moe) {
                const float* modl = WSP(float, WS_MODS) + (size_t)(l * 2 + 0) * 6144;
                pg8::StaticOrder S; S.init(WSP(bf16_t, WS_ACT), WSP(bf16_t, WS_FDN) + (size_t)(l >> 1) * DM * DFF, DFF, nrows, DM, G, bid);
                pg8::EpiResid E{WSP(float, WS_X), WSP(float, WS_Y), modl + 5 * 1024, modl + 6144 + 5 * 1024};
                pg8::gemm_phase<pg8::EpiResid, pg8::StaticOrder>(lds, DFF, S, E, tid);
            } else {
                MOE_TS();
                pg8::MoeOrder S; S.A = (const char*)WSP(bf16_t, WS_ACT); S.Bt = (const char*)(WSP(bf16_t, WS_MDN) + (size_t)(l >> 1) * 8 * DM * DEXP); S.K = DEXP; S.N = DM; S.nN = DM / 256; S.ntile = ts8; S.G = G; S.c = bid;
                S.ts1 = ts1; S.ts2 = ts2; S.ts3 = ts3; S.ts4 = ts4; S.ts5 = ts5; S.ts6 = ts6; S.ts7 = ts7;
                pg8::EpiF32 E{WSP(float, WS_YS)};
                pg8::gemm_phase<pg8::EpiF32, pg8::MoeOrder>(lds, DEXP, S, E, tid);
            }
            SEAM(pb + 8);
        }
        if (IN(pb + 9)) {
            PH_CTX();
            float* X = WSP(float, WS_X); bf16_t* H = WSP(bf16_t, WS_H); const float* Y = WSP(float, WS_Y); const float* YS = WSP(float, WS_YS);
            const float* modl = WSP(float, WS_MODS) + (size_t)(l * 2 + 0) * 6144;
            const float* lw = ap->in[14] + (size_t)(l * 2 + 1) * DM; const float* lb = ap->in[15] + (size_t)(l * 2 + 1) * DM;
            for (int r = gw; r < nrows; r += NGW) {
                const int wch = r >= SEQ; const float* md = modl + wch * 6144;
                f32x4 v[4];
                if (!moe) {
#pragma unroll
                    for (int j = 0; j < 4; ++j) v[j] = *(const f32x4*)(Y + (size_t)r * DM + 4 * lane + 256 * j);
                } else {
                    const int2 ss = WSP(int2, WS_TOKS)[r]; const float2 ww = WSP(float2, WS_TOKW)[r];
#pragma unroll
                    for (int j = 0; j < 4; ++j) { const int c = 4 * lane + 256 * j;
                        const f32x4 y0 = *(const f32x4*)(YS + (size_t)ss.x * DM + c), y1 = *(const f32x4*)(YS + (size_t)ss.y * DM + c), xv = *(const f32x4*)(X + (size_t)r * DM + c), g5 = *(const f32x4*)(md + 5 * 1024 + c);
                        v[j] = xv * ALPHA + g5 * (y0 * ww.x + y1 * ww.y); }
                }
                ln16(v, lw, lb, lane);
                if (lastl) {
#pragma unroll
                    for (int j = 0; j < 4; ++j) *(f32x4*)(ap->out + (size_t)r * DM + 4 * lane + 256 * j) = v[j];
                } else {
#pragma unroll
                    for (int j = 0; j < 4; ++j) *(f32x4*)(X + (size_t)r * DM + 4 * lane + 256 * j) = v[j];
                    const float* mdn = modl + 2 * 6144 + wch * 6144;
                    mod_store(v, mdn, mdn + 1024, H + (size_t)r * DM, lane);
                }
            }
            SEAM(pb + 9);
        }
    }
#undef IN
#undef SEAM
}

extern "C" void kernel_launch(void* const* d_in, const int* in_sizes, int n_in, void* d_out, int out_size, void* d_ws, size_t ws_size, hipStream_t stream) {
    static int grid = 0;
    if (grid == 0) {
        if (n_in != 22 || ws_size < WS_END) { fprintf(stderr, "kernel_launch: unexpected n_in %d / ws %zu (need %zu)\n", n_in, ws_size, (size_t)WS_END); grid = -1; return; }
        int dev = 0, cus = 0;
        if (hipGetDevice(&dev) != hipSuccess || hipDeviceGetAttribute(&cus, hipDeviceAttributeMultiprocessorCount, dev) != hipSuccess) { grid = -1; return; }
        if (hipFuncSetAttribute((const void*)fwd, hipFuncAttributeMaxDynamicSharedMemorySize, LDS_BYTES) != hipSuccess) { fprintf(stderr, "kernel_launch: hipFuncSetAttribute failed\n"); grid = -1; return; }
        int per_cu = 0;
        if (hipOccupancyMaxActiveBlocksPerMultiprocessor(&per_cu, (const void*)fwd, 512, LDS_BYTES) != hipSuccess || per_cu < 1) fprintf(stderr, "kernel_launch: occupancy query reports %d\n", per_cu);
        (void)hipGetLastError();
        grid = cus;
    }
    if (grid < 0) return;
    (void)hipMemsetAsync((char*)d_ws + WS_CTL, 0, CTL_BYTES, stream);
    Args a{};
    for (int i = 0; i < 22; ++i) a.in[i] = (const float*)d_in[i];
    a.out = (float*)d_out; a.ws = (unsigned char*)d_ws;
#if MK_ONE_LAUNCH
    a.ph_lo = 0; a.ph_hi = NPH;
    hipLaunchKernelGGL(fwd, dim3(grid), dim3(512), LDS_BYTES, stream, a);
#else
    for (int p = 0; p < NPH; ++p) {
        if (p >= 2 && ((p - 2) % 10) == 6 && ((((p - 2) / 10) & 1) == 0)) continue;
        a.ph_lo = p; a.ph_hi = p + 1;
        hipLaunchKernelGGL(fwd, dim3(grid), dim3(512), LDS_BYTES, stream, a);
    }
#endif
}
```

```cpp
#include <hip/hip_runtime.h>
#include <cstdio>
#include <cstdint>

#ifndef MK_ONE_LAUNCH
#define MK_ONE_LAUNCH 1
#endif

#define LAS __attribute__((address_space(3)))
#define GAS __attribute__((address_space(1)))
typedef unsigned short bf16_t;
typedef short bf16x8 __attribute__((ext_vector_type(8)));
typedef float f32x4 __attribute__((ext_vector_type(4)));
typedef unsigned u32x4 __attribute__((ext_vector_type(4)));

constexpr int DM = 1024, SEQ = 16384, NCTX = 256, TT = SEQ + NCTX, DEPTH = 4;
constexpr int IN_COLS = 2608, NPIN = 2816, LDP = 2816;
constexpr int C_MQ = 0, C_MK = 256, C_MV = 512, C_MO = 768, C_AQ = 1024, C_AK = 1536, C_AV = 1664, C_GQ = 1792, C_GK = 1920, C_GV = 2048, C_GG = 2304, C_MG = 2560, C_GGT = 2576, C_END = 2608;
constexpr int DFF = 2816, DEXP = 3584, NEXP = 8;
constexpr int NCH = 260;
constexpr int NSLOT = 138 * 256;
constexpr float ALPHA = 1.6817928305074290f;
constexpr float LN_EPS = 1e-5f;
constexpr int NPH = 2 + 10 * DEPTH;

constexpr size_t al256(size_t x) { return (x + 255) & ~size_t(255); }
constexpr size_t WS_CTL = 0, CTL_BYTES = 2u << 20;
constexpr size_t WS_MODS = 1u << 20;
constexpr size_t WS_ROPE = CTL_BYTES;
constexpr size_t WS_TOKE = WS_ROPE + 32768;
constexpr size_t WS_TOKP = WS_TOKE + al256((size_t)TT * 8);
constexpr size_t WS_TOKW = WS_TOKP + al256((size_t)TT * 8);
constexpr size_t WS_TOKS = WS_TOKW + al256((size_t)TT * 8);
constexpr size_t WS_WIN = WS_TOKS + al256((size_t)TT * 8);
constexpr size_t WS_WOUT = WS_WIN + (size_t)DEPTH * NPIN * DM * 2;
constexpr size_t WS_FGU = WS_WOUT + (size_t)DEPTH * DM * DM * 2;
constexpr size_t WS_FDN = WS_FGU + (size_t)2 * 2 * DFF * DM * 2;
constexpr size_t WS_MGU = WS_FDN + (size_t)2 * DM * DFF * 2;
constexpr size_t WS_MDN = WS_MGU + (size_t)16 * 2 * DEXP * DM * 2;
constexpr size_t WS_X = WS_MDN + (size_t)16 * DM * DEXP * 2;
constexpr size_t WS_H = WS_X + (size_t)TT * DM * 4;
constexpr size_t WS_P = WS_H + (size_t)TT * DM * 2;
constexpr size_t WS_G = WS_P + (size_t)TT * LDP * 2;
constexpr size_t WS_CAT = WS_G + al256((size_t)TT * 48 * 4);
constexpr size_t WS_Y = WS_CAT + (size_t)TT * DM * 2;
constexpr size_t WS_ACT = WS_Y + (size_t)TT * DM * 4;
constexpr size_t WS_XB = WS_ACT + (size_t)NSLOT * DEXP * 2;
constexpr size_t WS_YS = WS_XB + (size_t)NSLOT * DM * 2;
constexpr size_t WS_MU = WS_YS + (size_t)NSLOT * DM * 4;
constexpr size_t WS_MC = WS_MU + (size_t)8 * NCH * 4096 * 4;
constexpr size_t WS_MNU = WS_MC + (size_t)8 * NCH * 4096 * 4;
constexpr size_t WS_MNS = WS_MNU + (size_t)8 * NCH * 64 * 4;
constexpr size_t WS_MSC = WS_MNS + (size_t)8 * NCH * 64 * 4;
constexpr size_t WS_GU = WS_MSC + al256((size_t)8 * NCH * 4 * 4);
constexpr size_t WS_GS = WS_GU + (size_t)8 * NCH * 2048 * 4;
constexpr size_t WS_GDEC = WS_GS + (size_t)8 * NCH * 2048 * 4;
constexpr size_t WS_END = WS_GDEC + (size_t)8 * NCH * 32 * 4;

constexpr int CW_BAR = 4096;
constexpr int CW_MOE = 16384;

constexpr int LDS_BYTES = 147456, MISC_OFF = 147200;

__device__ __forceinline__ float bf2f(unsigned v) { return __uint_as_float(v << 16); }
__device__ __forceinline__ unsigned f2bf(float f) { unsigned u = __float_as_uint(f); return (u + 0x7fffu + ((u >> 16) & 1u)) >> 16; }
__device__ __forceinline__ unsigned pk2(float lo, float hi) { return f2bf(lo) | (f2bf(hi) << 16); }
__device__ __forceinline__ void load8bf(const bf16_t* p, float* o) {
    const uint4 v = *(const uint4*)p;
    o[0] = __uint_as_float(v.x << 16); o[1] = __uint_as_float(v.x & 0xffff0000u); o[2] = __uint_as_float(v.y << 16); o[3] = __uint_as_float(v.y & 0xffff0000u);
    o[4] = __uint_as_float(v.z << 16); o[5] = __uint_as_float(v.z & 0xffff0000u); o[6] = __uint_as_float(v.w << 16); o[7] = __uint_as_float(v.w & 0xffff0000u);
}
__device__ __forceinline__ float wave_sum(float v) {
#pragma unroll
    for (int o = 1; o < 64; o <<= 1) v += __shfl_xor(v, o);
    return v;
}
__device__ __forceinline__ float wave_max(float v) {
#pragma unroll
    for (int o = 1; o < 64; o <<= 1) v = fmaxf(v, __shfl_xor(v, o));
    return v;
}
__device__ __forceinline__ float scan_add(float v, int lane) {
#pragma unroll
    for (int o = 1; o < 64; o <<= 1) { const float t = __shfl_up(v, o); if (lane >= o) v += t; }
    return v;
}
__device__ __forceinline__ float scan_max(float v, int lane) {
#pragma unroll
    for (int o = 1; o < 64; o <<= 1) { const float t = __shfl_up(v, o); if (lane >= o) v = fmaxf(v, t); }
    return v;
}
__device__ __forceinline__ float siluf(float x) { return x / (1.f + __expf(-x)); }
__device__ __forceinline__ float sigmoidf_(float x) { return 1.f / (1.f + __expf(-x)); }
__device__ __forceinline__ float log_sigmoidf_(float x) { return fminf(x, 0.f) - log1pf(__expf(-fabsf(x))); }
#define LDS_WAIT() asm volatile("s_waitcnt lgkmcnt(0)" ::: "memory")

namespace pg8 {
constexpr int BM = 256, BK = 64, HALF = 128, HTB = HALF * BK * 2, STAGE_BYTES = 8 * HTB, NXCD = 8, WGM = 8;
__host__ __device__ __forceinline__ int lds_byte(int r, int c) { const int st = (r >> 4) * 2 + (c >> 5), rr = r & 15, cc = c & 31, ob = rr * 64 + cc * 2; return st * 1024 + (ob ^ (((ob >> 9) & 1) << 5)); }
__host__ __device__ __forceinline__ void stage_rc(int b, int& R, int& C) { const int st = b / 1024, sb = b % 1024, swz = sb ^ (((sb >> 9) & 1) << 5); R = (st >> 1) * 16 + swz / 64; C = (st & 1) * 32 + (swz % 64) / 2; }
__host__ __device__ __forceinline__ int perm32(int rho) { const int n = rho >> 4, i = rho & 15; return 8 * (i >> 2) + 4 * n + (i & 3); }
struct Unit { int pm, pn; };

struct StaticOrder {
    const char* A; const char* Bt; int K;
    int nM, nN, nwg, G, c;
    __device__ void init(const void* A_, const void* Bt_, int K_, int M, int N, int G_, int c_) { A = (const char*)A_; Bt = (const char*)Bt_; K = K_; nM = M / BM; nN = N / BM; nwg = nM * nN; G = G_; c = c_; }
    __device__ bool next(int i, Unit& u) const {
        const long L = (long)i * G + c; if (L >= nwg) return false;
        int wgid = (int)L; { const int q = nwg / NXCD, r = nwg % NXCD, xcd = wgid % NXCD, off = wgid / NXCD; wgid = (xcd < r ? xcd * (q + 1) : r * (q + 1) + (xcd - r) * q) + off; }
        const int nig = WGM * nN, gid = wgid / nig, fm = gid * WGM, gsz = (nM - fm) < WGM ? (nM - fm) : WGM;
        u.pm = fm + ((wgid % nig) % gsz); u.pn = (wgid % nig) / gsz; return true;
    }
    __device__ __forceinline__ const char* aptr(const Unit& u) const { return A + (size_t)u.pm * BM * K * 2; }
    __device__ __forceinline__ const char* bptr(const Unit& u) const { return Bt + (size_t)u.pn * BM * K * 2; }
};
struct MoeOrder {
    const char* A; const char* Bt; int K, N, nN, ntile, G, c;
    int ts1, ts2, ts3, ts4, ts5, ts6, ts7;
    __device__ bool next(int i, Unit& u) const {
        const long L = (long)i * G + c; if (L >= (long)ntile * nN) return false;
        u.pm = (int)(L / nN); u.pn = (int)(L % nN); return true;
    }
    __device__ __forceinline__ int expert(int pm) const { return (pm >= ts1) + (pm >= ts2) + (pm >= ts3) + (pm >= ts4) + (pm >= ts5) + (pm >= ts6) + (pm >= ts7); }
    __device__ __forceinline__ const char* aptr(const Unit& u) const { return A + (size_t)u.pm * BM * K * 2; }
    __device__ __forceinline__ const char* bptr(const Unit& u) const { return Bt + ((size_t)expert(u.pm) * N + (size_t)u.pn * BM) * K * 2; }
};

template <class Epi, class Sched>
__device__ __forceinline__ void gemm_phase(LAS unsigned char* lds, const int K, const Sched& S, const Epi& E, const int tid) {
    const int wid = __builtin_amdgcn_readfirstlane(tid >> 6), lane = tid & 63, wr = wid >> 2, wc = wid & 3, fr = lane & 15, fq = lane >> 4;
    const int nt = K / BK;
    unsigned voffA[2], voffB[2];
#pragma unroll
    for (int i = 0; i < 2; ++i) { int R, C; stage_rc(tid * 16 + i * 8192, R, C); const int Rb = Epi::PERM ? ((R & ~31) + perm32(R & 31)) : R;
        voffA[i] = (unsigned)(R * K + C) * 2u; voffB[i] = (unsigned)(Rb * K + C) * 2u; }
    const size_t kstep = (size_t)(BK * 2);
    const size_t hstep = (size_t)HALF * K * 2;
    const unsigned ldsw = (unsigned)wid * 1024u;
    const int aoff = lds_byte(wr * 64 + fr, fq * 8), boff = lds_byte(wc * 32 + fr, fq * 8);
#define PG8_SA(b, h) (((b) * 2 + (h)) * HTB)
#define PG8_SB(b, h) ((4 + (b) * 2 + (h)) * HTB)
#define PG8_STAGE(bufoff, gbase, voff) do { _Pragma("unroll") for (int _i = 0; _i < 2; ++_i) \
        __builtin_amdgcn_global_load_lds((const GAS unsigned*)((const GAS char*)(gbase) + (voff)[_i]), (LAS unsigned*)(lds + (bufoff) + ldsw + _i * 8192), 16, 0, 0); } while (0)
#define PG8_LDA(dst, b, h) do { _Pragma("unroll") for (int m = 0; m < 4; ++m) _Pragma("unroll") for (int k = 0; k < 2; ++k) dst[m][k] = *(const LAS bf16x8*)(lds + PG8_SA(b, h) + aoff + m * 2048 + k * 1024); } while (0)
#define PG8_LDB(dst, b, h) do { _Pragma("unroll") for (int n = 0; n < 2; ++n) _Pragma("unroll") for (int k = 0; k < 2; ++k) dst[n][k] = *(const LAS bf16x8*)(lds + PG8_SB(b, h) + boff + n * 2048 + k * 1024); } while (0)
#define PG8_MMA(ai, bj, At, Bt) do { __builtin_amdgcn_s_setprio(1); _Pragma("unroll") for (int m = 0; m < 4; ++m) _Pragma("unroll") for (int n = 0; n < 2; ++n) _Pragma("unroll") for (int k = 0; k < 2; ++k) \
        acc[ai][bj][m][n] = __builtin_amdgcn_mfma_f32_16x16x32_bf16(Bt[n][k], At[m][k], acc[ai][bj][m][n], 0, 0, 0); __builtin_amdgcn_s_setprio(0); } while (0)
#define PG8_WAIT_V(n) asm volatile("s_waitcnt vmcnt(" #n ")" ::: "memory")
#define PG8_WAIT_L(n) asm volatile("s_waitcnt lgkmcnt(" #n ")" ::: "memory")
#define PG8_BAR __builtin_amdgcn_s_barrier()
#define PG8_SCHED __builtin_amdgcn_sched_barrier(0)
    Unit cur, nxt; int ui = 0;
    if (!S.next(0, cur)) return;
    f32x4 acc[2][2][4][2];
#pragma unroll
    for (int a = 0; a < 2; ++a)
#pragma unroll
        for (int b = 0; b < 2; ++b)
#pragma unroll
            for (int m = 0; m < 4; ++m)
#pragma unroll
                for (int n = 0; n < 2; ++n) acc[a][b][m][n] = (f32x4){0.f, 0.f, 0.f, 0.f};
    bf16x8 At[4][2], B0[2][2], B1[2][2];
    const char* cA = S.aptr(cur); const char* cB = S.bptr(cur);
    PG8_STAGE(PG8_SB(0, 0), cB, voffB); PG8_STAGE(PG8_SB(0, 1), cB + hstep, voffB); PG8_STAGE(PG8_SA(0, 0), cA, voffA); PG8_STAGE(PG8_SA(0, 1), cA + hstep, voffA);
    if (wr == 1) PG8_BAR;
    PG8_WAIT_V(2); PG8_BAR;
    PG8_STAGE(PG8_SB(1, 0), cB + kstep, voffB); PG8_STAGE(PG8_SA(1, 0), cA + kstep, voffA); PG8_STAGE(PG8_SB(1, 1), cB + hstep + kstep, voffB);
    PG8_WAIT_V(6); PG8_BAR;
    for (;;) {
        const bool has_next = S.next(ui + 1, nxt);
        const char* nA = has_next ? S.aptr(nxt) : cA; const char* nB = has_next ? S.bptr(nxt) : cB;
        for (int t = 0; t < nt; t += 2) {
            const bool last = (t == nt - 2);
            const char* a1 = cA + (size_t)(t + 1) * kstep;
            const char* a2 = last ? nA : cA + (size_t)(t + 2) * kstep; const char* b2 = last ? nB : cB + (size_t)(t + 2) * kstep;
            const char* a3 = a2 + kstep; const char* b3 = b2 + kstep;
            PG8_LDB(B0, 0, 0); PG8_LDB(B1, 0, 1); PG8_SCHED; PG8_LDA(At, 0, 0); PG8_STAGE(PG8_SA(1, 1), a1 + hstep, voffA);
            PG8_WAIT_V(8); PG8_WAIT_L(0); PG8_BAR; PG8_MMA(0, 0, At, B0); PG8_MMA(0, 1, At, B1); PG8_BAR; PG8_SCHED;
            PG8_LDA(At, 0, 1); PG8_STAGE(PG8_SB(0, 0), b2, voffB); PG8_STAGE(PG8_SB(0, 1), b2 + hstep, voffB); PG8_STAGE(PG8_SA(0, 0), a2, voffA);
            PG8_WAIT_V(8); PG8_WAIT_L(0); PG8_BAR; PG8_MMA(1, 0, At, B0); PG8_MMA(1, 1, At, B1); PG8_BAR; PG8_SCHED;
            PG8_LDB(B0, 1, 0); PG8_LDB(B1, 1, 1); PG8_SCHED; PG8_LDA(At, 1, 0); PG8_STAGE(PG8_SA(0, 1), a2 + hstep, voffA);
            PG8_WAIT_V(8); PG8_WAIT_L(0); PG8_BAR; PG8_MMA(0, 0, At, B0); PG8_MMA(0, 1, At, B1); PG8_BAR; PG8_SCHED;
            PG8_LDA(At, 1, 1); PG8_STAGE(PG8_SB(1, 0), b3, voffB); PG8_STAGE(PG8_SB(1, 1), b3 + hstep, voffB); PG8_STAGE(PG8_SA(1, 0), a3, voffA);
            PG8_WAIT_V(8); PG8_WAIT_L(0); PG8_BAR; PG8_MMA(1, 0, At, B0); PG8_MMA(1, 1, At, B1); PG8_BAR; PG8_SCHED;
        }
        if (wr == 0) PG8_BAR;
        { int fr_ = fr, fq_ = fq; asm volatile("" : "+v"(fr_), "+v"(fq_));
          E(acc, cur, wr, wc, fr_, fq_); }
        if (!has_next) break;
#pragma unroll
        for (int a = 0; a < 2; ++a)
#pragma unroll
            for (int b = 0; b < 2; ++b)
#pragma unroll
                for (int m = 0; m < 4; ++m)
#pragma unroll
                    for (int n = 0; n < 2; ++n) acc[a][b][m][n] = (f32x4){0.f, 0.f, 0.f, 0.f};
        cur = nxt; cA = nA; cB = nB; ++ui;
        if (wr == 1) PG8_BAR;
    }
    PG8_WAIT_V(0);
    PG8_BAR;
#undef PG8_SA
#undef PG8_SB
#undef PG8_STAGE
#undef PG8_LDA
#undef PG8_LDB
#undef PG8_MMA
#undef PG8_WAIT_V
#undef PG8_WAIT_L
#undef PG8_BAR
#undef PG8_SCHED
}


struct EpiInProj {
    static constexpr bool PERM = true;
    bf16_t* P; float* Gt; const float* ropeC; const float* ropeS;
    __device__ __forceinline__ void operator()(const f32x4 (&acc)[2][2][4][2], const Unit& u, int wr, int wc, int fr, int fq) const {
        const int row0 = u.pm * BM + wr * 64 + fr;
        const bool latent = u.pm < (SEQ / BM);
#pragma unroll
        for (int bj = 0; bj < 2; ++bj) {
            const int colg = u.pn * BM + bj * HALF + wc * 32;
            const bool rope = latent && colg >= C_AQ && colg < C_AV;
            const bool gate = colg >= C_MG && colg < C_END;
            const int col0 = colg + 8 * fq;
#pragma unroll
            for (int ai = 0; ai < 2; ++ai)
#pragma unroll
                for (int m = 0; m < 4; ++m) {
                    const int row = row0 + ai * HALF + m * 16;
                    f32x4 v0 = acc[ai][bj][m][0], v1 = acc[ai][bj][m][1];
                    if (rope) {
                        const int pos = ((colg >> 5) & 1) ? (row & 63) : (row >> 6);
                        const f32x4 c0 = *(const f32x4*)(ropeC + pos * 16 + 8 * (fq & 1)), c1 = *(const f32x4*)(ropeC + pos * 16 + 8 * (fq & 1) + 4);
                        const f32x4 s0 = *(const f32x4*)(ropeS + pos * 16 + 8 * (fq & 1)), s1 = *(const f32x4*)(ropeS + pos * 16 + 8 * (fq & 1) + 4);
                        const float sg = (fq < 2) ? -1.f : 1.f;
                        f32x4 p0, p1;
#pragma unroll
                        for (int i = 0; i < 4; ++i) { p0[i] = __shfl_xor(v0[i], 32); p1[i] = __shfl_xor(v1[i], 32); }
#pragma unroll
                        for (int i = 0; i < 4; ++i) { v0[i] = v0[i] * c0[i] + sg * p0[i] * s0[i]; v1[i] = v1[i] * c1[i] + sg * p1[i] * s1[i]; }
                    }
                    u32x4 w; w.x = pk2(v0[0], v0[1]); w.y = pk2(v0[2], v0[3]); w.z = pk2(v1[0], v1[1]); w.w = pk2(v1[2], v1[3]);
                    *(u32x4*)(P + (size_t)row * LDP + col0) = w;
                    if (gate && col0 < C_END) { float* g = Gt + (size_t)row * 48 + (col0 - C_MG); *(f32x4*)g = v0; *(f32x4*)(g + 4) = v1; }
                    asm volatile("" ::: "memory");
                }
        }
    }
};
struct EpiResid {
    static constexpr bool PERM = false;
    const float* X; float* Y; const float* modl; const float* modc;
    __device__ __forceinline__ void operator()(const f32x4 (&acc)[2][2][4][2], const Unit& u, int wr, int wc, int fr, int fq) const {
        const int row0 = u.pm * BM + wr * 64 + fr, col0 = u.pn * BM + wc * 32 + 4 * fq;
        const float* md = (u.pm < SEQ / BM) ? modl : modc;
        f32x4 mv[2][2];
#pragma unroll
        for (int bj = 0; bj < 2; ++bj)
#pragma unroll
            for (int n = 0; n < 2; ++n) mv[bj][n] = *(const f32x4*)(md + col0 + bj * HALF + n * 16);
#pragma unroll
        for (int ai = 0; ai < 2; ++ai)
#pragma unroll
            for (int m = 0; m < 4; ++m) { const size_t off = (size_t)(row0 + ai * HALF + m * 16) * DM + col0;
#pragma unroll
                for (int bj = 0; bj < 2; ++bj)
#pragma unroll
                    for (int n = 0; n < 2; ++n) { const f32x4 xv = *(const f32x4*)(X + off + bj * HALF + n * 16);
                        *(f32x4*)(Y + off + bj * HALF + n * 16) = xv * ALPHA + mv[bj][n] * acc[ai][bj][m][n]; }
                asm volatile("" ::: "memory"); }
    }
};
struct EpiSwiglu {
    static constexpr bool PERM = true;
    bf16_t* O; int ld;
    __device__ __forceinline__ void operator()(const f32x4 (&acc)[2][2][4][2], const Unit& u, int wr, int wc, int fr, int fq) const {
        const int row0 = u.pm * BM + wr * 64 + fr, col0 = u.pn * HALF + wc * 32 + 8 * fq;
#pragma unroll
        for (int ai = 0; ai < 2; ++ai)
#pragma unroll
            for (int m = 0; m < 4; ++m) {
                const f32x4 g0 = acc[ai][0][m][0], g1 = acc[ai][0][m][1], u0 = acc[ai][1][m][0], u1 = acc[ai][1][m][1];
                float r[8];
#pragma unroll
                for (int i = 0; i < 4; ++i) { r[i] = siluf(g0[i]) * u0[i]; r[4 + i] = siluf(g1[i]) * u1[i]; }
                u32x4 w; w.x = pk2(r[0], r[1]); w.y = pk2(r[2], r[3]); w.z = pk2(r[4], r[5]); w.w = pk2(r[6], r[7]);
                *(u32x4*)(O + (size_t)(row0 + ai * HALF + m * 16) * ld + col0) = w;
            }
    }
};
struct EpiF32 {
    static constexpr bool PERM = false;
    float* C;
    __device__ __forceinline__ void operator()(const f32x4 (&acc)[2][2][4][2], const Unit& u, int wr, int wc, int fr, int fq) const {
        const int row0 = u.pm * BM + wr * 64 + fr, col0 = u.pn * BM + wc * 32 + 4 * fq;
#pragma unroll
        for (int ai = 0; ai < 2; ++ai)
#pragma unroll
            for (int m = 0; m < 4; ++m) { float* rowp = C + (size_t)(row0 + ai * HALF + m * 16) * DM + col0;
#pragma unroll
                for (int bj = 0; bj < 2; ++bj)
#pragma unroll
                    for (int n = 0; n < 2; ++n) *(f32x4*)(rowp + bj * HALF + n * 16) = acc[ai][bj][m][n]; }
    }
};
}

#define XB_TMO      128
#define XB_XCNT(j)  (256  + 64 * (j))
#define XB_XSUB(j)  (1280 + 64 * (j))
#define XB_XGEN(j)  (2304 + 64 * (j))
#define XB_TOP      3328
#define XB_TOPGEN   3392
#define XCD_BAR_WORDS 3456
#define XB_SPIN_CAP (1u << 18)
__device__ __forceinline__ unsigned xb_ld(unsigned* p)              { return __hip_atomic_load(p, __ATOMIC_RELAXED, __HIP_MEMORY_SCOPE_AGENT); }
__device__ __forceinline__ unsigned xb_add(unsigned* p, unsigned v) { return __hip_atomic_fetch_add(p, v, __ATOMIC_RELAXED, __HIP_MEMORY_SCOPE_AGENT); }
__device__ __forceinline__ unsigned xb_xcc_id() { return (unsigned)__builtin_amdgcn_s_getreg((3 << 11) | 20) & 0xFu; }
#define XB_SPIN(cond, bar) do { unsigned _sp = 0; while (cond) { __builtin_amdgcn_s_sleep(1); \
    if ((++_sp & 255u) == 0u) { if (xb_ld(&(bar)[XB_TMO])) break; if (_sp > XB_SPIN_CAP) { atomicAdd(&(bar)[XB_TMO], 1u); break; } } } } while (0)
struct XcdBarrier { unsigned* bar; unsigned x; volatile LAS unsigned* st; };
__device__ __forceinline__ XcdBarrier xcd_barrier_post(unsigned* bar, volatile LAS unsigned* st) {
    XcdBarrier b; b.bar = bar; b.x = xb_xcc_id(); b.st = st;
    if (threadIdx.x == 0) (void)xb_add(&bar[XB_XCNT(b.x)], 1u);
    return b;
}
__device__ __forceinline__ void xcd_barrier_complete(unsigned* bar, unsigned x, unsigned& nloc, unsigned& nx) {
    const unsigned G = gridDim.x * gridDim.y * gridDim.z;
    unsigned sum, cnt, mine, sp = 0u;
    for (;;) {
        sum = 0u; cnt = 0u; mine = 0u;
#pragma unroll
        for (unsigned j = 0; j < 16; ++j) { const unsigned c = xb_ld(&bar[XB_XCNT(j)]); sum += c; cnt += (c > 0u) ? 1u : 0u; mine = (j == x) ? c : mine; }
        if (sum == G) break;
        __builtin_amdgcn_s_sleep(1);
        if ((++sp & 255u) == 0u) { if (xb_ld(&bar[XB_TMO])) break; if (sp > XB_SPIN_CAP) { atomicAdd(&bar[XB_TMO], 1u); break; } }
    }
    nloc = mine > 0u ? mine : 1u; nx = cnt > 0u ? cnt : 1u;
}
__device__ __forceinline__ void xcd_barrier(const XcdBarrier& b) {
    asm volatile("s_waitcnt vmcnt(0)" ::: "memory");
    __syncthreads();
    if (threadIdx.x == 0) {
        unsigned* bar = b.bar;
        __builtin_amdgcn_s_waitcnt(0);
        unsigned nloc = b.st[0], nx = b.st[1];
        if (nloc == 0u) { xcd_barrier_complete(bar, b.x, nloc, nx); b.st[0] = nloc; b.st[1] = nx; }
        const unsigned old = xb_add(&bar[XB_XSUB(b.x)], 1u);
        const unsigned gen = old / nloc;
        if (old + 1u == (gen + 1u) * nloc) {
            __builtin_amdgcn_fence(__ATOMIC_RELEASE, "agent");
            asm volatile("s_waitcnt vmcnt(0)" ::: "memory");
            const unsigned og = xb_add(&bar[XB_TOP], 1u);
            const unsigned tg = og / nx;
            if (og + 1u == (tg + 1u) * nx) xb_add(&bar[XB_TOPGEN], 1u);
            else XB_SPIN(xb_ld(&bar[XB_TOPGEN]) == tg, bar);
            __builtin_amdgcn_fence(__ATOMIC_ACQUIRE, "agent");
            xb_add(&bar[XB_XGEN(b.x)], 1u);
            asm volatile("s_waitcnt vmcnt(0)" ::: "memory");
        } else {
            XB_SPIN(xb_ld(&bar[XB_XGEN(b.x)]) == gen, bar);
            __builtin_amdgcn_fence(__ATOMIC_ACQUIRE, "agent");
            asm volatile("s_waitcnt vmcnt(0)" ::: "memory");
        }
    }
    __syncthreads();
}

struct Args { const float* in[22]; float* out; unsigned char* ws; int ph_lo, ph_hi; };

__device__ __forceinline__ int in_srccol(int r, float& sc) {
    sc = 1.f;
    if (r < 1024) { if (r >= C_MK && r < C_MV) sc = 0.125f; return r; }
    if (r < C_MG) { if (r < C_AK) sc = 0.125f; else if (r >= C_GQ && r < C_GK) sc = 0.17677669529663687f; return r + 16; }
    if (r < C_GGT) return r - C_MG + 1024;
    if (r < C_END) return r;
    return -1;
}
__device__ __forceinline__ void tr_item(const float* W, int K, int N, int NP, bf16_t* WT, int mode, int half, LAS float* scr, int item, int lane) {
    const int nblk = NP >> 6, kb = item / nblk, nb = item - kb * nblk, k0 = kb << 6, n0 = nb << 6;
    const int r = n0 + lane; float sc = 1.f; int src;
    if (mode == 0) src = r; else if (mode == 1) src = in_srccol(r, sc); else { const int pn = r >> 8, w = r & 255; src = (w < 128) ? (pn * 128 + w) : (half + pn * 128 + w - 128); }
    const float* wp = W + (size_t)k0 * N + (src < 0 ? 0 : src);
#pragma unroll 16
    for (int i = 0; i < 64; ++i) { const float v = wp[(size_t)i * N]; scr[i * 65 + lane] = (src < 0) ? 0.f : v * sc; }
    LDS_WAIT();
    const int c = lane & 7;
#pragma unroll
    for (int j = 0; j < 8; ++j) { const int n = (lane >> 3) + 8 * j; const LAS float* s = scr + (8 * c) * 65 + n;
        uint4 o; o.x = pk2(s[0], s[65]); o.y = pk2(s[130], s[195]); o.z = pk2(s[260], s[325]); o.w = pk2(s[390], s[455]);
        *(uint4*)(WT + (size_t)(n0 + n) * K + k0 + 8 * c) = o; }
    LDS_WAIT();
}

__device__ __forceinline__ void chunk_rows(int d, int jc, int& base, int& step) {
    int oc;
    if (d == 0) oc = (jc < 4) ? 256 + jc : jc - 4; else oc = (jc < 4) ? 256 + (3 - jc) : 255 - (jc - 4);
    const int b0 = (oc < 256) ? oc * 64 : SEQ + (oc - 256) * 64;
    if (d == 0) { base = b0; step = 1; } else { base = b0 + 63; step = -1; }
}
__device__ __forceinline__ int oc_to_jc(int d, int oc) { if (d == 0) return oc < 256 ? oc + 4 : oc - 256; return oc < 256 ? 4 + (255 - oc) : 3 - (oc - 256); }

typedef short s16x4 __attribute__((ext_vector_type(4)));
typedef short v4i16_t __attribute__((ext_vector_type(4)));
typedef float f32x2_t __attribute__((ext_vector_type(2))); typedef __bf16 bf16x2_t __attribute__((ext_vector_type(2)));
__device__ __forceinline__ unsigned cvtpk(float lo, float hi) { f32x2_t v = {lo, hi}; bf16x2_t b = __builtin_convertvector(v, bf16x2_t); return __builtin_bit_cast(unsigned, b); }
__device__ __forceinline__ s16x4 ds_tr16(const LAS unsigned char* p) { return __builtin_bit_cast(s16x4, __builtin_amdgcn_ds_read_tr16_b64_v4i16((LAS v4i16_t*)p)); }
__device__ __forceinline__ bf16x8 cat44(s16x4 a, s16x4 b) { return __builtin_shufflevector(a, b, 0, 1, 2, 3, 4, 5, 6, 7); }
#define MFMA16(a, b, c) __builtin_amdgcn_mfma_f32_16x16x32_bf16(a, b, c, 0, 0, 0)
constexpr int AT_RS = 144, AT_TILE = 128 * AT_RS;
__device__ __forceinline__ void attn_unit(LAS unsigned char* lds, const bf16_t* P, bf16_t* CAT, int qb  , int cqb, int kvh, const float* sink, int tid, int lane, int wave) {
    const bool is_ctx = qb < 0;
    const int g = lane >> 4, i = lane & 15;
    const int hq = kvh * 4 + (wave >> 1), qh = wave & 1;
    const int qrow0 = (is_ctx ? SEQ + cqb * 128 : qb * 128) + qh * 64;
    bf16x8 bq[4][2];
#pragma unroll
    for (int qt = 0; qt < 4; ++qt)
#pragma unroll
        for (int ks = 0; ks < 2; ++ks) bq[qt][ks] = *(const bf16x8*)(P + (size_t)(qrow0 + 16 * qt + i) * LDP + C_AQ + hq * 64 + 32 * ks + 8 * g);
    f32x4 O[4][4];
#pragma unroll
    for (int dt = 0; dt < 4; ++dt)
#pragma unroll
        for (int qt = 0; qt < 4; ++qt) O[dt][qt] = (f32x4){0.f, 0.f, 0.f, 0.f};
    float m[4], l[4];
    { const float sk = sink[hq];
#pragma unroll
      for (int qt = 0; qt < 4; ++qt) { m[qt] = sk; l[qt] = (g == 0) ? 1.f : 0.f; } }
#define AT_VALID(c) ((c) >= 3 || (!is_ctx && (qb - 1 + (c)) >= 0 && (qb - 1 + (c)) < SEQ / 128))
#define AT_ROW(c) ((c) >= 3 ? SEQ + ((c) - 3) * 128 : (qb - 1 + (c)) * 128)
    u32x4 kreg[2], vreg[2];
    int c = 0; while (!AT_VALID(c)) ++c;
    __syncthreads();
#pragma unroll
    for (int t = 0; t < 2; ++t) { const int idx = tid + 512 * t, r = idx >> 3, ch = idx & 7; const bf16_t* src = P + (size_t)(AT_ROW(c) + r) * LDP + kvh * 64 + ch * 8;
        kreg[t] = *(const u32x4*)(src + C_AK); vreg[t] = *(const u32x4*)(src + C_AV); }
    int buf = 0;
#pragma unroll
    for (int t = 0; t < 2; ++t) { const int idx = tid + 512 * t, r = idx >> 3, ch = idx & 7; *(LAS u32x4*)(lds + r * AT_RS + ch * 16) = kreg[t]; *(LAS u32x4*)(lds + AT_TILE + r * AT_RS + ch * 16) = vreg[t]; }
    __syncthreads();
    while (c < 5) {
        int cn = c + 1; while (cn < 5 && !AT_VALID(cn)) ++cn;
        if (cn < 5) {
#pragma unroll
            for (int t = 0; t < 2; ++t) { const int idx = tid + 512 * t, r = idx >> 3, ch = idx & 7; const bf16_t* src = P + (size_t)(AT_ROW(cn) + r) * LDP + kvh * 64 + ch * 8;
                kreg[t] = *(const u32x4*)(src + C_AK); vreg[t] = *(const u32x4*)(src + C_AV); }
        }
        const LAS unsigned char* Kb = lds + buf * 2 * AT_TILE; const LAS unsigned char* Vb = Kb + AT_TILE;
        const bool lo_blk = (!is_ctx && c == 0), hi_blk = (!is_ctx && c == 2);
        for (int grp = 0; grp < 4; ++grp) {
            if (lo_blk && qh == 1 && grp < 2) continue;
            if (hi_blk && qh == 0 && grp >= 2) continue;
            bf16x8 kf[2][2], vf[4];
#pragma unroll
            for (int kt = 0; kt < 2; ++kt)
#pragma unroll
                for (int ks = 0; ks < 2; ++ks) kf[kt][ks] = *(const LAS bf16x8*)(Kb + (grp * 32 + kt * 16 + i) * AT_RS + (32 * ks + 8 * g) * 2);
#pragma unroll
            for (int dt = 0; dt < 4; ++dt) { const LAS unsigned char* vp = Vb + (grp * 32 + 4 * g + (i >> 2)) * AT_RS + (16 * dt + 4 * (i & 3)) * 2;
                vf[dt] = cat44(ds_tr16(vp), ds_tr16(vp + 16 * AT_RS)); }
#pragma unroll
            for (int qt = 0; qt < 4; ++qt) {
                f32x4 s0 = (f32x4){0.f, 0.f, 0.f, 0.f}, s1 = s0;
#pragma unroll
                for (int ks = 0; ks < 2; ++ks) { s0 = MFMA16(kf[0][ks], bq[qt][ks], s0); s1 = MFMA16(kf[1][ks], bq[qt][ks], s1); }
                if (lo_blk || hi_blk) {
                    const int qo = qh * 64 + qt * 16 + i, ko = grp * 32 + 4 * g;
#pragma unroll
                    for (int r = 0; r < 4; ++r) {
                        const bool v0 = lo_blk ? (ko + r >= qo) : (ko + r <= qo), v1 = lo_blk ? (ko + 16 + r >= qo) : (ko + 16 + r <= qo);
                        s0[r] = v0 ? s0[r] : -INFINITY; s1[r] = v1 ? s1[r] : -INFINITY; }
                }
                float mx = fmaxf(fmaxf(fmaxf(s0[0], s0[1]), fmaxf(s0[2], s0[3])), fmaxf(fmaxf(s1[0], s1[1]), fmaxf(s1[2], s1[3])));
                mx = fmaxf(mx, __shfl_xor(mx, 16)); mx = fmaxf(mx, __shfl_xor(mx, 32));
                const float mn = fmaxf(m[qt], mx), alpha = __expf(m[qt] - mn);
                m[qt] = mn;
                float ps = 0.f;
#pragma unroll
                for (int r = 0; r < 4; ++r) { s0[r] = __expf(s0[r] - mn); s1[r] = __expf(s1[r] - mn); ps += s0[r] + s1[r]; }
                l[qt] = l[qt] * alpha + ps;
                u32x4 pw; pw.x = cvtpk(s0[0], s0[1]); pw.y = cvtpk(s0[2], s0[3]); pw.z = cvtpk(s1[0], s1[1]); pw.w = cvtpk(s1[2], s1[3]);
                const bf16x8 pb = __builtin_bit_cast(bf16x8, pw);
#pragma unroll
                for (int dt = 0; dt < 4; ++dt) { O[dt][qt] = O[dt][qt] * alpha; O[dt][qt] = MFMA16(vf[dt], pb, O[dt][qt]); }
            }
        }
        if (cn < 5) {
            LAS unsigned char* nb = lds + (buf ^ 1) * 2 * AT_TILE;
#pragma unroll
            for (int t = 0; t < 2; ++t) { const int idx = tid + 512 * t, r = idx >> 3, ch = idx & 7; *(LAS u32x4*)(nb + r * AT_RS + ch * 16) = kreg[t]; *(LAS u32x4*)(nb + AT_TILE + r * AT_RS + ch * 16) = vreg[t]; }
        }
        __syncthreads();
        buf ^= 1; c = cn;
    }
#undef AT_VALID
#undef AT_ROW
#pragma unroll
    for (int qt = 0; qt < 4; ++qt) {
        float lt = l[qt]; lt += __shfl_xor(lt, 16); lt += __shfl_xor(lt, 32);
        const float inv = 1.f / lt;
        bf16_t* dst = CAT + (size_t)(qrow0 + 16 * qt + i) * DM + 256 + hq * 64 + 4 * g;
#pragma unroll
        for (int dt = 0; dt < 4; ++dt) { uint2 o; o.x = cvtpk(O[dt][qt][0] * inv, O[dt][qt][1] * inv); o.y = cvtpk(O[dt][qt][2] * inv, O[dt][qt][3] * inv); *(uint2*)(dst + 16 * dt) = o; }
    }
}

__device__ __forceinline__ void mlstm_summary(LAS unsigned char* lds, const bf16_t* P, const float* Gt, const float* gate_b  , float* MU, float* MNU, float* MSC, int h, int d, int jc, int tid, int lane, int wave) {
    LAS float* kf = (LAS float*)lds; LAS float* vf = kf + 64 * 65; LAS float* wv = vf + 64 * 65;
    int base, step; chunk_rows(d, jc, base, step);
    const int hd = h * 2 + d;
    __syncthreads();
    { const int s = tid >> 3, c8 = tid & 7; const int row = base + step * s; float f[8];
      load8bf(P + (size_t)row * LDP + C_MK + h * 64 + c8 * 8, f);
#pragma unroll
      for (int i = 0; i < 8; ++i) kf[s * 65 + c8 * 8 + i] = f[i];
      load8bf(P + (size_t)row * LDP + C_MV + h * 64 + c8 * 8, f);
#pragma unroll
      for (int i = 0; i < 8; ++i) vf[s * 65 + c8 * 8 + i] = f[i]; }
    if (wave == 0) {
        const int row = base + step * lane;
        const float ig = Gt[(size_t)row * 48 + d * 8 + h] + gate_b[d * 8 + h];
        const float fg = Gt[(size_t)row * 48 + d * 8 + 4 + h] + gate_b[d * 8 + 4 + h];
        const float lf = log_sigmoidf_(fg);
        const float b = scan_add(lf, lane);
        const float a = ig - b;
        const float cm = wave_max(a);
        const float B = __shfl(b, 63);
        wv[lane] = __expf(a - cm);
        if (lane == 0) { MSC[(size_t)(hd * NCH + jc) * 4 + 0] = cm; MSC[(size_t)(hd * NCH + jc) * 4 + 1] = B; }
    }
    __syncthreads();
    { const int dk = tid >> 3, dv0 = (tid & 7) * 8; float acc[8];
#pragma unroll
      for (int j = 0; j < 8; ++j) acc[j] = 0.f;
#pragma unroll 4
      for (int s = 0; s < 64; ++s) { const float kw = kf[s * 65 + dk] * wv[s];
#pragma unroll
          for (int j = 0; j < 8; ++j) acc[j] += kw * vf[s * 65 + dv0 + j]; }
      float* dst = MU + ((size_t)(hd * NCH + jc) * 4096) + dk * 64 + dv0;
      *(f32x4*)dst = (f32x4){acc[0], acc[1], acc[2], acc[3]}; *(f32x4*)(dst + 4) = (f32x4){acc[4], acc[5], acc[6], acc[7]}; }
    if (tid < 64) { float a = 0.f;
#pragma unroll 4
        for (int s = 0; s < 64; ++s) a += wv[s] * kf[s * 65 + tid];
        MNU[(size_t)(hd * NCH + jc) * 64 + tid] = a; }
}

__device__ __forceinline__ void gla_gates(LAS float* bc, LAS float* gsrc, LAS float* gup, const float* Gt, const float* g_up  , const float* g_b  , int h, int d, int base, int step, int tid) {
    for (int i = tid; i < 64 * 16; i += 512) { const int s = i >> 4, r = i & 15; gsrc[s * 17 + r] = Gt[(size_t)(base + step * s) * 48 + 16 + d * 16 + r]; }
    { const int r = tid >> 5, dk = tid & 31; gup[r * 33 + dk] = g_up[(d * 16 + r) * 128 + h * 32 + dk]; }
    __syncthreads();
#pragma unroll
    for (int i = 0; i < 4; ++i) { const int idx = tid + i * 512, s = idx >> 5, dk = idx & 31; float z = g_b[d * 128 + h * 32 + dk];
#pragma unroll
        for (int r = 0; r < 16; ++r) z += gsrc[s * 17 + r] * gup[r * 33 + dk];
        bc[s * 33 + dk] = log_sigmoidf_(z) * (1.f / 16.f); }
    __syncthreads();
    if (tid < 32) { float run = 0.f; for (int s = 0; s < 64; ++s) { run += bc[s * 33 + tid]; bc[s * 33 + tid] = run; } }
    __syncthreads();
}
__device__ __forceinline__ void gla_summary(LAS unsigned char* lds, const bf16_t* P, const float* Gt, const float* g_up, const float* g_b, float* GU, float* GDEC, int h, int d, int jc, int tid) {
    LAS float* kf = (LAS float*)lds; LAS float* vf = kf + 64 * 33; LAS float* bc = vf + 64 * 65; LAS float* gsrc = bc + 64 * 33; LAS float* gup = gsrc + 64 * 17;
    int base, step; chunk_rows(d, jc, base, step);
    const int hd = h * 2 + d;
    __syncthreads();
    if (tid < 256) { const int s = tid >> 2, c8 = tid & 3; float f[8]; load8bf(P + (size_t)(base + step * s) * LDP + C_GK + h * 32 + c8 * 8, f);
#pragma unroll
        for (int i = 0; i < 8; ++i) kf[s * 33 + c8 * 8 + i] = f[i]; }
    { const int s = tid >> 3, c8 = tid & 7; float f[8]; load8bf(P + (size_t)(base + step * s) * LDP + C_GV + h * 64 + c8 * 8, f);
#pragma unroll
      for (int i = 0; i < 8; ++i) vf[s * 65 + c8 * 8 + i] = f[i]; }
    gla_gates(bc, gsrc, gup, Gt, g_up, g_b, h, d, base, step, tid);
#pragma unroll
    for (int i = 0; i < 4; ++i) { const int idx = tid + i * 512, s = idx >> 5, dk = idx & 31; kf[s * 33 + dk] *= __expf(bc[63 * 33 + dk] - bc[s * 33 + dk]); }
    __syncthreads();
    { const int dk = tid >> 4, dv0 = (tid & 15) * 4; float acc[4] = {0.f, 0.f, 0.f, 0.f};
#pragma unroll 4
      for (int s = 0; s < 64; ++s) { const float kw = kf[s * 33 + dk];
#pragma unroll
          for (int j = 0; j < 4; ++j) acc[j] += kw * vf[s * 65 + dv0 + j]; }
      *(f32x4*)(GU + (size_t)(hd * NCH + jc) * 2048 + dk * 64 + dv0) = (f32x4){acc[0], acc[1], acc[2], acc[3]}; }
    if (tid < 32) GDEC[(size_t)(hd * NCH + jc) * 32 + tid] = __expf(bc[63 * 33 + tid]);
}

__device__ __forceinline__ void mlstm_out(LAS unsigned char* lds, const bf16_t* P, const float* Gt, const float* gate_b, const float* MC, const float* MNS, const float* MSC, const float* normw  , bf16_t* CAT, int h, int oc, int tid, int lane, int wave) {
    LAS float* qf = (LAS float*)lds; LAS float* kf = qf + 64 * 65; LAS float* vf = kf + 64 * 65; LAS float* Sm = vf + 64 * 65; LAS float* Cs = Sm + 64 * 65; LAS float* hs = Cs + 64 * 65;
    LAS float* av = hs + 64 * 65; LAS float* mxv = av + 64; LAS float* wiv = mxv + 64; LAS float* emv = wiv + 64; LAS float* nv = emv + 64; LAS float* dnv = nv + 64;
    const int b0 = (oc < 256) ? oc * 64 : SEQ + (oc - 256) * 64;
    const int t = tid >> 3, dv0 = (tid & 7) * 8;
    for (int d = 0; d < 2; ++d) {
        const int jc = oc_to_jc(d, oc), hd = h * 2 + d;
        const int base = d ? b0 + 63 : b0, step = d ? -1 : 1;
        __syncthreads();
        { const int s = tid >> 3, c8 = tid & 7; const size_t ro = (size_t)(base + step * s) * LDP + h * 64 + c8 * 8; float f[8];
          load8bf(P + ro + C_MQ, f);
#pragma unroll
          for (int i = 0; i < 8; ++i) qf[s * 65 + c8 * 8 + i] = f[i];
          load8bf(P + ro + C_MK, f);
#pragma unroll
          for (int i = 0; i < 8; ++i) kf[s * 65 + c8 * 8 + i] = f[i];
          load8bf(P + ro + C_MV, f);
#pragma unroll
          for (int i = 0; i < 8; ++i) vf[s * 65 + c8 * 8 + i] = f[i];
          const f32x4 c0 = *(const f32x4*)(MC + (size_t)(hd * NCH + jc) * 4096 + s * 64 + c8 * 8), c1 = *(const f32x4*)(MC + (size_t)(hd * NCH + jc) * 4096 + s * 64 + c8 * 8 + 4);
#pragma unroll
          for (int i = 0; i < 4; ++i) { Cs[s * 65 + c8 * 8 + i] = c0[i]; Cs[s * 65 + c8 * 8 + 4 + i] = c1[i]; } }
        if (tid < 64) nv[tid] = MNS[(size_t)(hd * NCH + jc) * 64 + tid];
        if (wave == 1) {
            const int row = base + step * lane;
            const float ig = Gt[(size_t)row * 48 + d * 8 + h] + gate_b[d * 8 + h];
            const float fg = Gt[(size_t)row * 48 + d * 8 + 4 + h] + gate_b[d * 8 + 4 + h];
            const float lf = log_sigmoidf_(fg);
            const float b = scan_add(lf, lane);
            const float a = ig - b;
            const float cm = scan_max(a, lane);
            const float mst = MSC[(size_t)(hd * NCH + jc) * 4 + 2];
            const float mx = fmaxf(mst, cm);
            av[lane] = a; mxv[lane] = mx; wiv[lane] = __expf(mst - mx); emv[lane] = __expf(-(b + mx));
        }
        __syncthreads();
        { const int s0 = (tid & 7) * 8; float acc[8];
#pragma unroll
          for (int j = 0; j < 8; ++j) acc[j] = 0.f;
#pragma unroll 4
          for (int dk = 0; dk < 64; ++dk) { const float qv = qf[t * 65 + dk];
#pragma unroll
              for (int j = 0; j < 8; ++j) acc[j] += qv * kf[(s0 + j) * 65 + dk]; }
          const float mxt = mxv[t];
#pragma unroll
          for (int j = 0; j < 8; ++j) { const int s = s0 + j; Sm[t * 65 + s] = (s <= t) ? acc[j] * __expf(av[s] - mxt) : 0.f; } }
        __syncthreads();
        if (tid < 64) { float dsum = 0.f, qn = 0.f;
#pragma unroll 4
            for (int s = 0; s < 64; ++s) { dsum += Sm[tid * 65 + s]; qn += qf[tid * 65 + s] * nv[s]; }
            dnv[tid] = dsum + wiv[tid] * qn; }
        float num[8], qc[8];
#pragma unroll
        for (int j = 0; j < 8; ++j) { num[j] = 0.f; qc[j] = 0.f; }
#pragma unroll 4
        for (int s = 0; s < 64; ++s) { const float sv = Sm[t * 65 + s], qv = qf[t * 65 + s];
#pragma unroll
            for (int j = 0; j < 8; ++j) { num[j] += sv * vf[s * 65 + dv0 + j]; qc[j] += qv * Cs[s * 65 + dv0 + j]; } }
        __syncthreads();
        { const float wi = wiv[t], den = fmaxf(fabsf(dnv[t]), emv[t]), inv = 1.f / den; const int to = d ? 63 - t : t;
#pragma unroll
          for (int j = 0; j < 8; ++j) { const float hv = (num[j] + wi * qc[j]) * inv; if (d == 0) hs[to * 65 + dv0 + j] = hv; else hs[to * 65 + dv0 + j] += hv; } }
    }
    __syncthreads();
    { float x[8]; float s1 = 0.f;
#pragma unroll
      for (int j = 0; j < 8; ++j) { x[j] = hs[t * 65 + dv0 + j]; s1 += x[j]; }
      s1 += __shfl_xor(s1, 1); s1 += __shfl_xor(s1, 2); s1 += __shfl_xor(s1, 4);
      const float mu = s1 * (1.f / 64.f); float s2 = 0.f;
#pragma unroll
      for (int j = 0; j < 8; ++j) { x[j] -= mu; s2 += x[j] * x[j]; }
      s2 += __shfl_xor(s2, 1); s2 += __shfl_xor(s2, 2); s2 += __shfl_xor(s2, 4);
      const float rstd = rsqrtf(s2 * (1.f / 64.f) + LN_EPS);
      const int row = b0 + t; float og[8]; load8bf(P + (size_t)row * LDP + C_MO + h * 64 + dv0, og);
      float r[8];
#pragma unroll
      for (int j = 0; j < 8; ++j) r[j] = x[j] * rstd * normw[h * 64 + dv0 + j] * sigmoidf_(og[j]);
      uint4 o; o.x = pk2(r[0], r[1]); o.y = pk2(r[2], r[3]); o.z = pk2(r[4], r[5]); o.w = pk2(r[6], r[7]);
      *(uint4*)(CAT + (size_t)row * DM + h * 64 + dv0) = o; }
}

__device__ __forceinline__ void gla_out(LAS unsigned char* lds, const bf16_t* P, const float* Gt, const float* g_up, const float* g_b, const float* GS, const float* normw, bf16_t* CAT, int h, int oc, int tid) {
    LAS float* qf = (LAS float*)lds; LAS float* kf = qf + 64 * 33; LAS float* vf = kf + 64 * 33; LAS float* bc = vf + 64 * 65; LAS float* Sm = bc + 64 * 33; LAS float* Ss = Sm + 64 * 65; LAS float* hs = Ss + 32 * 65;
    LAS float* gsrc = hs + 64 * 65; LAS float* gup = gsrc + 64 * 17;
    const int b0 = (oc < 256) ? oc * 64 : SEQ + (oc - 256) * 64;
    const int t = tid >> 3, dv0 = (tid & 7) * 8;
    for (int d = 0; d < 2; ++d) {
        const int jc = oc_to_jc(d, oc), hd = h * 2 + d;
        const int base = d ? b0 + 63 : b0, step = d ? -1 : 1;
        __syncthreads();
        { const int s = tid >> 3, c8 = tid & 7; const size_t ro = (size_t)(base + step * s) * LDP; float f[8];
          if (c8 < 4) { load8bf(P + ro + C_GQ + h * 32 + c8 * 8, f);
#pragma unroll
              for (int i = 0; i < 8; ++i) qf[s * 33 + c8 * 8 + i] = f[i]; }
          else { load8bf(P + ro + C_GK + h * 32 + (c8 - 4) * 8, f);
#pragma unroll
              for (int i = 0; i < 8; ++i) kf[s * 33 + (c8 - 4) * 8 + i] = f[i]; }
          load8bf(P + ro + C_GV + h * 64 + c8 * 8, f);
#pragma unroll
          for (int i = 0; i < 8; ++i) vf[s * 65 + c8 * 8 + i] = f[i]; }
        { const int dk = tid >> 4, c4 = (tid & 15) * 4; const f32x4 sv = *(const f32x4*)(GS + (size_t)(hd * NCH + jc) * 2048 + dk * 64 + c4);
#pragma unroll
          for (int i = 0; i < 4; ++i) Ss[dk * 65 + c4 + i] = sv[i]; }
        gla_gates(bc, gsrc, gup, Gt, g_up, g_b, h, d, base, step, tid);
#pragma unroll
        for (int i = 0; i < 4; ++i) { const int idx = tid + i * 512, s = idx >> 5, dk = idx & 31; const float b = bc[s * 33 + dk]; qf[s * 33 + dk] *= __expf(b); kf[s * 33 + dk] *= __expf(-b); }
        __syncthreads();
        { const int s0 = (tid & 7) * 8; float acc[8];
#pragma unroll
          for (int j = 0; j < 8; ++j) acc[j] = 0.f;
#pragma unroll 4
          for (int dk = 0; dk < 32; ++dk) { const float qv = qf[t * 33 + dk];
#pragma unroll
              for (int j = 0; j < 8; ++j) acc[j] += qv * kf[(s0 + j) * 33 + dk]; }
#pragma unroll
          for (int j = 0; j < 8; ++j) { const int s = s0 + j; Sm[t * 65 + s] = (s <= t) ? acc[j] : 0.f; } }
        __syncthreads();
        float num[8];
#pragma unroll
        for (int j = 0; j < 8; ++j) num[j] = 0.f;
#pragma unroll 4
        for (int s = 0; s < 64; ++s) { const float sv = Sm[t * 65 + s];
#pragma unroll
            for (int j = 0; j < 8; ++j) num[j] += sv * vf[s * 65 + dv0 + j]; }
#pragma unroll 4
        for (int dk = 0; dk < 32; ++dk) { const float qv = qf[t * 33 + dk];
#pragma unroll
            for (int j = 0; j < 8; ++j) num[j] += qv * Ss[dk * 65 + dv0 + j]; }
        { const int to = d ? 63 - t : t;
#pragma unroll
          for (int j = 0; j < 8; ++j) { if (d == 0) hs[to * 65 + dv0 + j] = num[j]; else hs[to * 65 + dv0 + j] += num[j]; } }
    }
    __syncthreads();
    { float x[8]; float s1 = 0.f;
#pragma unroll
      for (int j = 0; j < 8; ++j) { x[j] = hs[t * 65 + dv0 + j]; s1 += x[j]; }
      s1 += __shfl_xor(s1, 1); s1 += __shfl_xor(s1, 2); s1 += __shfl_xor(s1, 4);
      const float mu = s1 * (1.f / 64.f); float s2 = 0.f;
#pragma unroll
      for (int j = 0; j < 8; ++j) { x[j] -= mu; s2 += x[j] * x[j]; }
      s2 += __shfl_xor(s2, 1); s2 += __shfl_xor(s2, 2); s2 += __shfl_xor(s2, 4);
      const float rstd = rsqrtf(s2 * (1.f / 64.f) + LN_EPS);
      const int row = b0 + t; float gg[8]; load8bf(P + (size_t)row * LDP + C_GG + h * 64 + dv0, gg);
      float r[8];
#pragma unroll
      for (int j = 0; j < 8; ++j) r[j] = x[j] * rstd * normw[h * 64 + dv0 + j] * siluf(gg[j]);
      uint4 o; o.x = pk2(r[0], r[1]); o.y = pk2(r[2], r[3]); o.z = pk2(r[4], r[5]); o.w = pk2(r[6], r[7]);
      *(uint4*)(CAT + (size_t)row * DM + 768 + h * 64 + dv0) = o; }
}

__device__ __forceinline__ void ln16(f32x4 (&v)[4], const float* w, const float* b, int lane) {
    float s = 0.f;
#pragma unroll
    for (int j = 0; j < 4; ++j) s += (v[j][0] + v[j][1]) + (v[j][2] + v[j][3]);
    const float mean = wave_sum(s) * (1.f / DM); float s2 = 0.f;
#pragma unroll
    for (int j = 0; j < 4; ++j) { v[j] = v[j] - mean; s2 += (v[j][0] * v[j][0] + v[j][1] * v[j][1]) + (v[j][2] * v[j][2] + v[j][3] * v[j][3]); }
    const float rstd = rsqrtf(wave_sum(s2) * (1.f / DM) + LN_EPS);
#pragma unroll
    for (int j = 0; j < 4; ++j) { const f32x4 wv = *(const f32x4*)(w + 4 * lane + 256 * j), bv = *(const f32x4*)(b + 4 * lane + 256 * j); v[j] = v[j] * rstd * wv + bv; }
}
__device__ __forceinline__ void mod_store(f32x4 (&v)[4], const float* shift, const float* scale, bf16_t* hrow, int lane) {
#pragma unroll
    for (int j = 0; j < 4; ++j) { const f32x4 sh = *(const f32x4*)(shift + 4 * lane + 256 * j), sc = *(const f32x4*)(scale + 4 * lane + 256 * j);
        v[j] = v[j] * (sc + 1.f) + sh;
        uint2 o; o.x = pk2(v[j][0], v[j][1]); o.y = pk2(v[j][2], v[j][3]); *(uint2*)(hrow + 4 * lane + 256 * j) = o; }
}

__global__ void __launch_bounds__(512, 2) fwd(Args a_unused) {
    extern __shared__ __attribute__((aligned(16))) unsigned char lds_raw[];
    LAS unsigned char* lds = (LAS unsigned char*)lds_raw;
    const int wave0 = __builtin_amdgcn_readfirstlane(threadIdx.x >> 6);
    const int G = gridDim.x, bid = blockIdx.x;
    typedef const __attribute__((address_space(4))) Args* ArgsP;
    ArgsP ap0 = (ArgsP)__builtin_amdgcn_kernarg_segment_ptr();
#define PH_CTX() int wave = wave0; asm volatile("" : "+s"(wave)); unsigned ones_ = ~0u; asm volatile("" : "+s"(ones_)); const int lane = (int)__builtin_amdgcn_mbcnt_hi(ones_, __builtin_amdgcn_mbcnt_lo(ones_, 0u)); const int tid = wave * 64 + lane; \
    ArgsP ap = ap0; asm volatile("" : "+s"(ap)); unsigned char* ws = ap->ws; const int gw = bid * 8 + wave, NGW = G * 8; (void)lane; (void)gw; (void)NGW; (void)ws
#define WSP(T, off) ((T*)(ws + (off)))
    volatile LAS unsigned* MISC = (volatile LAS unsigned*)(lds + MISC_OFF);
    if (threadIdx.x < 32) MISC[threadIdx.x] = 0u;
    __syncthreads();
    XcdBarrier bar; bar.bar = (unsigned*)(ap0->ws + WS_CTL) + CW_BAR; bar.x = 0; bar.st = MISC + 8;
    if (MK_ONE_LAUNCH) bar = xcd_barrier_post(bar.bar, MISC + 8);
    const int lo = ap0->ph_lo, hi = ap0->ph_hi;
#define IN(k) (lo <= (k) && (k) < hi)
#define SEAM(k) do { if (MK_ONE_LAUNCH && (k) + 1 < hi) xcd_barrier(bar); } while (0)

    if (IN(0)) {
        PH_CTX();
        float* MODS = WSP(float, WS_MODS);
        LAS float* scs = (LAS float*)lds;
        for (int i = tid; i < 2048; i += 512) scs[i] = siluf(i < 1024 ? ap->in[1][i] : ap->in[3][i - 1024]);
        __syncthreads();
        for (int u = bid; u < 4 * 8 * 12; u += G) {
            const int l = u / 96, rem = u % 96, kc = rem / 12, ng = rem % 12, n = ng * 512 + tid;
            const float* w = ap->in[4] + ((size_t)l * 1024 + kc * 128) * 6144 + n;
            float a0 = 0.f, a1 = 0.f;
#pragma unroll 8
            for (int k = 0; k < 128; ++k) { const float wv = w[(size_t)k * 6144]; a0 += scs[kc * 128 + k] * wv; a1 += scs[1024 + kc * 128 + k] * wv; }
            if (kc == 0) { const float bb = ap->in[5][l * 6144 + n]; a0 += bb; a1 += bb; }
            atomicAdd(MODS + (size_t)(l * 2 + 0) * 6144 + n, a0); atomicAdd(MODS + (size_t)(l * 2 + 1) * 6144 + n, a1);
        }
        if (bid < 8) { float* ropeC = WSP(float, WS_ROPE); float* ropeS = ropeC + 256 * 16;
            const int i = bid * 512 + tid, pos = i >> 4, fi = i & 15; const float inv = powf(10000.f, -(float)fi / 16.f); const float ang = (float)pos * inv; float sn, cs; sincosf(ang, &sn, &cs); ropeC[i] = cs; ropeS[i] = sn; }
        __syncthreads();
        LAS float* scr = (LAS float*)(lds + wave * 16640);
        constexpr int I_A = 16 * 44, I_B = 16 * 16, I_C = 16 * 88, I_D = 44 * 16, I_E = 16 * 112, I_F = 56 * 16;
        constexpr int N_A = 4 * I_A, N_B = 4 * I_B, N_C = 2 * I_C, N_D = 2 * I_D, N_E = 16 * I_E, N_F = 16 * I_F;
        for (int it = gw; it < N_A + N_B + N_C + N_D + N_E + N_F; it += NGW) {
            int r = it;
            if (r < N_E) { const int mi = r / I_E; tr_item(ap->in[20] + (size_t)mi * DM * 2 * DEXP, DM, 2 * DEXP, 2 * DEXP, WSP(bf16_t, WS_MGU) + (size_t)mi * 2 * DEXP * DM, 2, DEXP, scr, r % I_E, lane); continue; } r -= N_E;
            if (r < N_F) { const int mi = r / I_F; tr_item(ap->in[21] + (size_t)mi * DEXP * DM, DEXP, DM, DM, WSP(bf16_t, WS_MDN) + (size_t)mi * DM * DEXP, 0, 0, scr, r % I_F, lane); continue; } r -= N_F;
            if (r < N_A) { const int mi = r / I_A; tr_item(ap->in[6] + (size_t)mi * DM * IN_COLS, DM, IN_COLS, NPIN, WSP(bf16_t, WS_WIN) + (size_t)mi * NPIN * DM, 1, 0, scr, r % I_A, lane); continue; } r -= N_A;
            if (r < N_B) { const int mi = r / I_B; tr_item(ap->in[13] + (size_t)mi * DM * DM, DM, DM, DM, WSP(bf16_t, WS_WOUT) + (size_t)mi * DM * DM, 0, 0, scr, r % I_B, lane); continue; } r -= N_B;
            if (r < N_C) { const int mi = r / I_C; tr_item(ap->in[16] + (size_t)mi * DM * 2 * DFF, DM, 2 * DFF, 2 * DFF, WSP(bf16_t, WS_FGU) + (size_t)mi * 2 * DFF * DM, 2, DFF, scr, r % I_C, lane); continue; } r -= N_C;
            { const int mi = r / I_D; tr_item(ap->in[17] + (size_t)mi * DFF * DM, DFF, DM, DM, WSP(bf16_t, WS_FDN) + (size_t)mi * DM * DFF, 0, 0, scr, r % I_D, lane); }
        }
        SEAM(0);
    }
    if (IN(1)) {
        PH_CTX();
        float* X = WSP(float, WS_X); bf16_t* H = WSP(bf16_t, WS_H); const float* MODS = WSP(float, WS_MODS);
        for (int r = gw; r < TT; r += NGW) {
            const int wch = r >= SEQ; const float* src = wch ? ap->in[2] + (size_t)(r - SEQ) * DM : ap->in[0] + (size_t)r * DM;
            f32x4 v[4];
#pragma unroll
            for (int j = 0; j < 4; ++j) { v[j] = *(const f32x4*)(src + 4 * lane + 256 * j); *(f32x4*)(X + (size_t)r * DM + 4 * lane + 256 * j) = v[j]; }
            const float* md = MODS + (size_t)(0 * 2 + wch) * 6144;
            mod_store(v, md, md + 1024, H + (size_t)r * DM, lane);
        }
        SEAM(1);
    }

    for (int l = 0; l < DEPTH; ++l) {
        const int pb = 2 + 10 * l;
        const bool lastl = (l == DEPTH - 1), moe = (l & 1);
        const int nrows = lastl ? SEQ : TT;

        if (IN(pb + 0)) {
            PH_CTX();
            pg8::StaticOrder S; S.init(WSP(bf16_t, WS_H), WSP(bf16_t, WS_WIN) + (size_t)l * NPIN * DM, DM, TT, NPIN, G, bid);
            pg8::EpiInProj E{WSP(bf16_t, WS_P), WSP(float, WS_G), WSP(float, WS_ROPE), WSP(float, WS_ROPE) + 256 * 16};
            pg8::gemm_phase<pg8::EpiInProj, pg8::StaticOrder>(lds, DM, S, E, tid);
            SEAM(pb + 0);
        }
        if (IN(pb + 1)) {
            if (!lastl && bid < 4) { PH_CTX(); attn_unit(lds, WSP(bf16_t, WS_P), WSP(bf16_t, WS_CAT), -1, bid >> 1, bid & 1, ap->in[9] + l * 8, tid, lane, wave); }
            { PH_CTX();
              for (int r = bid; r < 8 * NCH; r += G) { const int hd = r / NCH, jc = r % NCH;
                  mlstm_summary(lds, WSP(bf16_t, WS_P), WSP(float, WS_G), ap->in[7] + l * 16, WSP(float, WS_MU), WSP(float, WS_MNU), WSP(float, WS_MSC), hd >> 1, hd & 1, jc, tid, lane, wave); } }
            { PH_CTX();
              for (int r = (bid + 128) % G; r < 8 * NCH; r += G) { const int hd = r / NCH, jc = r % NCH;
                  gla_summary(lds, WSP(bf16_t, WS_P), WSP(float, WS_G), ap->in[10] + (size_t)l * 2 * 16 * 128, ap->in[11] + l * 256, WSP(float, WS_GU), WSP(float, WS_GDEC), hd >> 1, hd & 1, jc, tid); } }
            SEAM(pb + 1);
        }
        if (IN(pb + 2)) {
            PH_CTX();
            float* MSC = WSP(float, WS_MSC);
            const int wi = wave * G + bid;
            const int e0 = wi * 64;
            if (e0 < 32768 + 512) {
                const bool isC = e0 < 32768;
                const int hd = isC ? e0 / 4096 : (e0 - 32768) / 64, idx = isC ? (e0 % 4096) + lane : lane;
                const float* U = isC ? WSP(float, WS_MU) + (size_t)hd * NCH * 4096 + idx : WSP(float, WS_MNU) + (size_t)hd * NCH * 64 + idx;
                float* St = isC ? WSP(float, WS_MC) + (size_t)hd * NCH * 4096 + idx : WSP(float, WS_MNS) + (size_t)hd * NCH * 64 + idx;
                const int str = isC ? 4096 : 64;
                const bool wr_m = isC && (e0 % 4096) == 0 && lane == 0;
                float m = 0.f, cval = 0.f;
                for (int n0 = 0; n0 < NCH; n0 += 4) {
                    float uu[4], cm[4], BB[4];
#pragma unroll
                    for (int j = 0; j < 4; ++j) { uu[j] = U[(size_t)(n0 + j) * str]; cm[j] = MSC[(size_t)(hd * NCH + n0 + j) * 4]; BB[j] = MSC[(size_t)(hd * NCH + n0 + j) * 4 + 1]; }
#pragma unroll
                    for (int j = 0; j < 4; ++j) {
                        St[(size_t)(n0 + j) * str] = cval;
                        if (wr_m) MSC[(size_t)(hd * NCH + n0 + j) * 4 + 2] = m;
                        const float mx = fmaxf(m, cm[j]);
                        cval = __expf(m - mx) * cval + __expf(cm[j] - mx) * uu[j];
                        m = BB[j] + mx;
                    }
                }
            } else if (e0 < 32768 + 512 + 16384) {
                const int e2 = e0 - 33280, hd = e2 / 2048, idx = (e2 % 2048) + lane, dk = idx >> 6;
                const float* U = WSP(float, WS_GU) + (size_t)hd * NCH * 2048 + idx; float* St = WSP(float, WS_GS) + (size_t)hd * NCH * 2048 + idx; const float* DC = WSP(float, WS_GDEC) + (size_t)hd * NCH * 32 + dk;
                float sval = 0.f;
                for (int n0 = 0; n0 < NCH; n0 += 4) {
                    float uu[4], dc[4];
#pragma unroll
                    for (int j = 0; j < 4; ++j) { uu[j] = U[(size_t)(n0 + j) * 2048]; dc[j] = DC[(size_t)(n0 + j) * 32]; }
#pragma unroll
                    for (int j = 0; j < 4; ++j) { St[(size_t)(n0 + j) * 2048] = sval; sval = dc[j] * sval + uu[j]; }
                }
            }
            SEAM(pb + 2);
        }
        if (IN(pb + 3)) {
            const int noc = lastl ? 256 : 260;
            { PH_CTX();
              for (int u = bid; u < 256; u += G) attn_unit(lds, WSP(bf16_t, WS_P), WSP(bf16_t, WS_CAT), u >> 1, 0, u & 1, ap->in[9] + l * 8, tid, lane, wave); }
            { PH_CTX();
              for (int r = bid; r < 4 * noc; r += G) { const int h = r / noc, oc = r % noc;
                  mlstm_out(lds, WSP(bf16_t, WS_P), WSP(float, WS_G), ap->in[7] + l * 16, WSP(float, WS_MC), WSP(float, WS_MNS), WSP(float, WS_MSC), ap->in[8] + l * 256, WSP(bf16_t, WS_CAT), h, oc, tid, lane, wave); } }
            { PH_CTX();
              for (int r = (bid + 240) % G; r < 4 * noc; r += G) { const int h = r / noc, oc = r % noc;
                  gla_out(lds, WSP(bf16_t, WS_P), WSP(float, WS_G), ap->in[10] + (size_t)l * 2 * 16 * 128, ap->in[11] + l * 256, WSP(float, WS_GS), ap->in[12] + l * 256, WSP(bf16_t, WS_CAT), h, oc, tid); } }
            SEAM(pb + 3);
        }
        if (IN(pb + 4)) {
            PH_CTX();
            const float* modl = WSP(float, WS_MODS) + (size_t)(l * 2 + 0) * 6144;
            pg8::StaticOrder S; S.init(WSP(bf16_t, WS_CAT), WSP(bf16_t, WS_WOUT) + (size_t)l * DM * DM, DM, nrows, DM, G, bid);
            pg8::EpiResid E{WSP(float, WS_X), WSP(float, WS_Y), modl + 2 * 1024, modl + 6144 + 2 * 1024};
            pg8::gemm_phase<pg8::EpiResid, pg8::StaticOrder>(lds, DM, S, E, tid);
            SEAM(pb + 4);
        }
        if (IN(pb + 5)) {
            PH_CTX();
            float* X = WSP(float, WS_X); bf16_t* H = WSP(bf16_t, WS_H); const float* Y = WSP(float, WS_Y);
            const float* modl = WSP(float, WS_MODS) + (size_t)(l * 2 + 0) * 6144;
            unsigned* mcnt = WSP(unsigned, WS_CTL) + CW_MOE + 64 * 8 * (l >> 1);
            LAS float* RW = (LAS float*)lds;
            if (moe) { const float* rw = ap->in[18] + (size_t)(l >> 1) * DM * 8; for (int i = tid; i < 8192; i += 512) { const int e = i >> 10, c = i & 1023; RW[i] = rw[c * 8 + e]; } __syncthreads(); }
            const float* lw = ap->in[14] + (size_t)(l * 2 + 0) * DM; const float* lb = ap->in[15] + (size_t)(l * 2 + 0) * DM;
            for (int r = gw; r < nrows; r += NGW) {
                const int wch = r >= SEQ; const float* md = modl + wch * 6144;
                f32x4 v[4];
#pragma unroll
                for (int j = 0; j < 4; ++j) v[j] = *(const f32x4*)(Y + (size_t)r * DM + 4 * lane + 256 * j);
                ln16(v, lw, lb, lane);
#pragma unroll
                for (int j = 0; j < 4; ++j) *(f32x4*)(X + (size_t)r * DM + 4 * lane + 256 * j) = v[j];
                mod_store(v, md + 3 * 1024, md + 4 * 1024, H + (size_t)r * DM, lane);
                if (moe) {
                    float lg[8];
#pragma unroll
                    for (int e = 0; e < 8; ++e) { float s = 0.f;
#pragma unroll
                        for (int j = 0; j < 4; ++j) { const f32x4 w = *(const LAS f32x4*)(RW + e * 1024 + 4 * lane + 256 * j); s += v[j][0] * w[0] + v[j][1] * w[1] + v[j][2] * w[2] + v[j][3] * w[3]; }
                        lg[e] = wave_sum(s) + ap->in[19][(l >> 1) * 8 + e]; }
                    int e0 = 0; float l0 = lg[0];
#pragma unroll
                    for (int e = 1; e < 8; ++e) if (lg[e] > l0) { l0 = lg[e]; e0 = e; }
                    int e1 = -1; float l1 = -INFINITY;
#pragma unroll
                    for (int e = 0; e < 8; ++e) if (e != e0 && lg[e] > l1) { l1 = lg[e]; e1 = e; }
                    if (lane == 0) {
                        const float w0 = 1.f / (1.f + __expf(l1 - l0));
                        const int p0 = (int)atomicAdd(mcnt + 64 * e0, 1u), p1 = (int)atomicAdd(mcnt + 64 * e1, 1u);
                        WSP(int2, WS_TOKE)[r] = make_int2(e0, e1); WSP(int2, WS_TOKP)[r] = make_int2(p0, p1); WSP(float2, WS_TOKW)[r] = make_float2(w0, 1.f - w0);
                    }
                }
            }
            SEAM(pb + 5);
        }
#define MOE_TS() int ts0 = 0, ts1, ts2, ts3, ts4, ts5, ts6, ts7, ts8; { const unsigned* mcnt = WSP(unsigned, WS_CTL) + CW_MOE + 64 * 8 * (l >> 1); \
            ts1 = ts0 + (int)((__hip_atomic_load(mcnt + 64 * 0, __ATOMIC_RELAXED, __HIP_MEMORY_SCOPE_AGENT) + 255u) >> 8); ts2 = ts1 + (int)((__hip_atomic_load(mcnt + 64 * 1, __ATOMIC_RELAXED, __HIP_MEMORY_SCOPE_AGENT) + 255u) >> 8); \
            ts3 = ts2 + (int)((__hip_atomic_load(mcnt + 64 * 2, __ATOMIC_RELAXED, __HIP_MEMORY_SCOPE_AGENT) + 255u) >> 8); ts4 = ts3 + (int)((__hip_atomic_load(mcnt + 64 * 3, __ATOMIC_RELAXED, __HIP_MEMORY_SCOPE_AGENT) + 255u) >> 8); \
            ts5 = ts4 + (int)((__hip_atomic_load(mcnt + 64 * 4, __ATOMIC_RELAXED, __HIP_MEMORY_SCOPE_AGENT) + 255u) >> 8); ts6 = ts5 + (int)((__hip_atomic_load(mcnt + 64 * 5, __ATOMIC_RELAXED, __HIP_MEMORY_SCOPE_AGENT) + 255u) >> 8); \
            ts7 = ts6 + (int)((__hip_atomic_load(mcnt + 64 * 6, __ATOMIC_RELAXED, __HIP_MEMORY_SCOPE_AGENT) + 255u) >> 8); ts8 = ts7 + (int)((__hip_atomic_load(mcnt + 64 * 7, __ATOMIC_RELAXED, __HIP_MEMORY_SCOPE_AGENT) + 255u) >> 8); \
            ts1 = __builtin_amdgcn_readfirstlane(ts1); ts2 = __builtin_amdgcn_readfirstlane(ts2); ts3 = __builtin_amdgcn_readfirstlane(ts3); ts4 = __builtin_amdgcn_readfirstlane(ts4); \
            ts5 = __builtin_amdgcn_readfirstlane(ts5); ts6 = __builtin_amdgcn_readfirstlane(ts6); ts7 = __builtin_amdgcn_readfirstlane(ts7); ts8 = __builtin_amdgcn_readfirstlane(ts8); } (void)ts0; (void)ts8
        if (IN(pb + 6) && moe) {
            PH_CTX();
            MOE_TS();
            const bf16_t* H = WSP(bf16_t, WS_H); bf16_t* XB = WSP(bf16_t, WS_XB);
            for (int r = gw; r < nrows; r += NGW) {
                const int2 ee = WSP(int2, WS_TOKE)[r], pp = WSP(int2, WS_TOKP)[r];
                const int b0 = ee.x == 0 ? ts0 : ee.x == 1 ? ts1 : ee.x == 2 ? ts2 : ee.x == 3 ? ts3 : ee.x == 4 ? ts4 : ee.x == 5 ? ts5 : ee.x == 6 ? ts6 : ts7;
                const int b1 = ee.y == 0 ? ts0 : ee.y == 1 ? ts1 : ee.y == 2 ? ts2 : ee.y == 3 ? ts3 : ee.y == 4 ? ts4 : ee.y == 5 ? ts5 : ee.y == 6 ? ts6 : ts7;
                const int s0 = b0 * 256 + pp.x, s1 = b1 * 256 + pp.y;
                const uint4 h0 = *(const uint4*)(H + (size_t)r * DM + 8 * lane), h1 = *(const uint4*)(H + (size_t)r * DM + 512 + 8 * lane);
                *(uint4*)(XB + (size_t)s0 * DM + 8 * lane) = h0; *(uint4*)(XB + (size_t)s0 * DM + 512 + 8 * lane) = h1;
                *(uint4*)(XB + (size_t)s1 * DM + 8 * lane) = h0; *(uint4*)(XB + (size_t)s1 * DM + 512 + 8 * lane) = h1;
                if (lane == 0) WSP(int2, WS_TOKS)[r] = make_int2(s0, s1);
            }
            SEAM(pb + 6);
        }
        if (IN(pb + 7)) {
            PH_CTX();
            if (!moe) {
                pg8::StaticOrder S; S.init(WSP(bf16_t, WS_H), WSP(bf16_t, WS_FGU) + (size_t)(l >> 1) * 2 * DFF * DM, DM, nrows, 2 * DFF, G, bid);
                pg8::EpiSwiglu E{WSP(bf16_t, WS_ACT), DFF};
                pg8::gemm_phase<pg8::EpiSwiglu, pg8::StaticOrder>(lds, DM, S, E, tid);
            } else {
                MOE_TS();
                pg8::MoeOrder S; S.A = (const char*)WSP(bf16_t, WS_XB); S.Bt = (const char*)(WSP(bf16_t, WS_MGU) + (size_t)(l >> 1) * 8 * 2 * DEXP * DM); S.K = DM; S.N = 2 * DEXP; S.nN = 2 * DEXP / 256; S.ntile = ts8; S.G = G; S.c = bid;
                S.ts1 = ts1; S.ts2 = ts2; S.ts3 = ts3; S.ts4 = ts4; S.ts5 = ts5; S.ts6 = ts6; S.ts7 = ts7;
                pg8::EpiSwiglu E{WSP(bf16_t, WS_ACT), DEXP};
                pg8::gemm_phase<pg8::EpiSwiglu, pg8::MoeOrder>(lds, DM, S, E, tid);
            }
            SEAM(pb + 7);
        }
        if (IN(pb + 8)) {
            PH_CTX();
            if (!moe) {
                const float* modl = WSP(float, WS_MODS) + (size_t)(l * 2 + 0) * 6144;
                pg8::StaticOrder S; S.init(WSP(bf16_t, WS_ACT), WSP(bf16_t, WS_FDN) + (size_t)(l >> 1) * DM * DFF, DFF, nrows, DM, G, bid);
                pg8::EpiResid E{WSP(float, WS_X), WSP(float, WS_Y), modl + 5 * 1024, modl + 6144 + 5 * 1024};
                pg8::gemm_phase<pg8::EpiResid, pg8::StaticOrder>(lds, DFF, S, E, tid);
            } else {
                MOE_TS();
                pg8::MoeOrder S; S.A = (const char*)WSP(bf16_t, WS_ACT); S.Bt = (const char*)(WSP(bf16_t, WS_MDN) + (size_t)(l >> 1) * 8 * DM * DEXP); S.K = DEXP; S.N = DM; S.nN = DM / 256; S.ntile = ts8; S.G = G; S.c = bid;
                S.ts1 = ts1; S.ts2 = ts2; S.ts3 = ts3; S.ts4 = ts4; S.ts5 = ts5; S.ts6 = ts6; S.ts7 = ts7;
                pg8::EpiF32 E{WSP(float, WS_YS)};
                pg8::gemm_phase<pg8::EpiF32, pg8::MoeOrder>(lds, DEXP, S, E, tid);
            }
            SEAM(pb + 8);
        }
        if (IN(pb + 9)) {
            PH_CTX();
            float* X = WSP(float, WS_X); bf16_t* H = WSP(bf16_t, WS_H); const float* Y = WSP(float, WS_Y); const float* YS = WSP(float, WS_YS);
            const float* modl = WSP(float, WS_MODS) + (size_t)(l * 2 + 0) * 6144;
            const float* lw = ap->in[14] + (size_t)(l * 2 + 1) * DM; const float* lb = ap->in[15] + (size_t)(l * 2 + 1) * DM;
            for (int r = gw; r < nrows; r += NGW) {
                const int wch = r >= SEQ; const float* md = modl + wch * 6144;
                f32x4 v[4];
                if (!moe) {
#pragma unroll
                    for (int j = 0; j < 4; ++j) v[j] = *(const f32x4*)(Y + (size_t)r * DM + 4 * lane + 256 * j);
                } else {
                    const int2 ss = WSP(int2, WS_TOKS)[r]; const float2 ww = WSP(float2, WS_TOKW)[r];
#pragma unroll
                    for (int j = 0; j < 4; ++j) { const int c = 4 * lane + 256 * j;
                        const f32x4 y0 = *(const f32x4*)(YS + (size_t)ss.x * DM + c), y1 = *(const f32x4*)(YS + (size_t)ss.y * DM + c), xv = *(const f32x4*)(X + (size_t)r * DM + c), g5 = *(const f32x4*)(md + 5 * 1024 + c);
                        v[j] = xv * ALPHA + g5 * (y0 * ww.x + y1 * ww.y); }
                }
                ln16(v, lw, lb, lane);
                if (lastl) {
#pragma unroll
                    for (int j = 0; j < 4; ++j) *(f32x4*)(ap->out + (size_t)r * DM + 4 * lane + 256 * j) = v[j];
                } else {
#pragma unroll
                    for (int j = 0; j < 4; ++j) *(f32x4*)(X + (size_t)r * DM + 4 * lane + 256 * j) = v[j];
                    const float* mdn = modl + 2 * 6144 + wch * 6144;
                    mod_store(v, mdn, mdn + 1024, H + (size_t)r * DM, lane);
                }
            }
            SEAM(pb + 9);
        }
    }
#undef IN
#undef SEAM
}

extern "C" void kernel_launch(void* const* d_in, const int* in_sizes, int n_in, void* d_out, int out_size, void* d_ws, size_t ws_size, hipStream_t stream) {
    static int grid = 0;
    if (grid == 0) {
        if (n_in != 22 || ws_size < WS_END) { fprintf(stderr, "kernel_launch: unexpected n_in %d / ws %zu (need %zu)\n", n_in, ws_size, (size_t)WS_END); grid = -1; return; }
        int dev = 0, cus = 0;
        if (hipGetDevice(&dev) != hipSuccess || hipDeviceGetAttribute(&cus, hipDeviceAttributeMultiprocessorCount, dev) != hipSuccess) { grid = -1; return; }
        if (hipFuncSetAttribute((const void*)fwd, hipFuncAttributeMaxDynamicSharedMemorySize, LDS_BYTES) != hipSuccess) { fprintf(stderr, "kernel_launch: hipFuncSetAttribute failed\n"); grid = -1; return; }
        int per_cu = 0;
        if (hipOccupancyMaxActiveBlocksPerMultiprocessor(&per_cu, (const void*)fwd, 512, LDS_BYTES) != hipSuccess || per_cu < 1) fprintf(stderr, "kernel_launch: occupancy query reports %d\n", per_cu);
        (void)hipGetLastError();
        grid = cus;
    }
    if (grid < 0) return;
    (void)hipMemsetAsync((char*)d_ws + WS_CTL, 0, CTL_BYTES, stream);
    Args a{};
    for (int i = 0; i < 22; ++i) a.in[i] = (const float*)d_in[i];
    a.out = (float*)d_out; a.ws = (unsigned char*)d_ws;
#if MK_ONE_LAUNCH
    a.ph_lo = 0; a.ph_hi = NPH;
    hipLaunchKernelGGL(fwd, dim3(grid), dim3(512), LDS_BYTES, stream, a);
#else
    for (int p = 0; p < NPH; ++p) {
        if (p >= 2 && ((p - 2) % 10) == 6 && ((((p - 2) / 10) & 1) == 0)) continue;
        a.ph_lo = p; a.ph_hi = p + 1;
        hipLaunchKernelGGL(fwd, dim3(grid), dim3(512), LDS_BYTES, stream, a);
    }
#endif
}
```

```cpp
#include <hip/hip_runtime.h>
#include <cstdio>
#include <cstdint>

#ifndef MK_ONE_LAUNCH
#define MK_ONE_LAUNCH 1
#endif

#define LAS __attribute__((address_space(3)))
#define GAS __attribute__((address_space(1)))
typedef unsigned short bf16_t;
typedef short bf16x8 __attribute__((ext_vector_type(8)));
typedef float f32x4 __attribute__((ext_vector_type(4)));
typedef unsigned u32x4 __attribute__((ext_vector_type(4)));

constexpr int DM = 1024, SEQ = 16384, NCTX = 256, TT = SEQ + NCTX, DEPTH = 4;
constexpr int IN_COLS = 2608, NPIN = 2816, LDP = 2816;
constexpr int C_MQ = 0, C_MK = 256, C_MV = 512, C_MO = 768, C_AQ = 1024, C_AK = 1536, C_AV = 1664, C_GQ = 1792, C_GK = 1920, C_GV = 2048, C_GG = 2304, C_MG = 2560, C_GGT = 2576, C_END = 2608;
constexpr int DFF = 2816, DEXP = 3584, NEXP = 8;
constexpr int NCH = 260;
constexpr int NSLOT = 138 * 256;
constexpr float ALPHA = 1.6817928305074290f;
constexpr float LN_EPS = 1e-5f;
constexpr int NPH = 2 + 10 * DEPTH;

constexpr size_t al256(size_t x) { return (x + 255) & ~size_t(255); }
constexpr size_t WS_CTL = 0, CTL_BYTES = 2u << 20;
constexpr size_t WS_MODS = 1u << 20;
constexpr size_t WS_ROPE = CTL_BYTES;
constexpr size_t WS_TOKE = WS_ROPE + 32768;
constexpr size_t WS_TOKP = WS_TOKE + al256((size_t)TT * 8);
constexpr size_t WS_TOKW = WS_TOKP + al256((size_t)TT * 8);
constexpr size_t WS_TOKS = WS_TOKW + al256((size_t)TT * 8);
constexpr size_t WS_WIN = WS_TOKS + al256((size_t)TT * 8);
constexpr size_t WS_WOUT = WS_WIN + (size_t)DEPTH * NPIN * DM * 2;
constexpr size_t WS_FGU = WS_WOUT + (size_t)DEPTH * DM * DM * 2;
constexpr size_t WS_FDN = WS_FGU + (size_t)2 * 2 * DFF * DM * 2;
constexpr size_t WS_MGU = WS_FDN + (size_t)2 * DM * DFF * 2;
constexpr size_t WS_MDN = WS_MGU + (size_t)16 * 2 * DEXP * DM * 2;
constexpr size_t WS_X = WS_MDN + (size_t)16 * DM * DEXP * 2;
constexpr size_t WS_H = WS_X + (size_t)TT * DM * 4;
constexpr size_t WS_P = WS_H + (size_t)TT * DM * 2;
constexpr size_t WS_G = WS_P + (size_t)TT * LDP * 2;
constexpr size_t WS_CAT = WS_G + al256((size_t)TT * 48 * 4);
constexpr size_t WS_Y = WS_CAT + (size_t)TT * DM * 2;
constexpr size_t WS_ACT = WS_Y + (size_t)TT * DM * 4;
constexpr size_t WS_XB = WS_ACT + (size_t)NSLOT * DEXP * 2;
constexpr size_t WS_YS = WS_XB + (size_t)NSLOT * DM * 2;
constexpr size_t WS_MU = WS_YS + (size_t)NSLOT * DM * 4;
constexpr size_t WS_MC = WS_MU + (size_t)8 * NCH * 4096 * 4;
constexpr size_t WS_MNU = WS_MC + (size_t)8 * NCH * 4096 * 4;
constexpr size_t WS_MNS = WS_MNU + (size_t)8 * NCH * 64 * 4;
constexpr size_t WS_MSC = WS_MNS + (size_t)8 * NCH * 64 * 4;
constexpr size_t WS_GU = WS_MSC + al256((size_t)8 * NCH * 4 * 4);
constexpr size_t WS_GS = WS_GU + (size_t)8 * NCH * 2048 * 4;
constexpr size_t WS_GDEC = WS_GS + (size_t)8 * NCH * 2048 * 4;
constexpr size_t WS_END = WS_GDEC + (size_t)8 * NCH * 32 * 4;

constexpr int CW_BAR = 4096;
constexpr int CW_MOE = 16384;

constexpr int LDS_BYTES = 147456, MISC_OFF = 147200;

__device__ __forceinline__ float bf2f(unsigned v) { return __uint_as_float(v << 16); }
__device__ __forceinline__ unsigned f2bf(float f) { unsigned u = __float_as_uint(f); return (u + 0x7fffu + ((u >> 16) & 1u)) >> 16; }
__device__ __forceinline__ unsigned pk2(float lo, float hi) { return f2bf(lo) | (f2bf(hi) << 16); }
__device__ __forceinline__ void load8bf(const bf16_t* p, float* o) {
    const uint4 v = *(const uint4*)p;
    o[0] = __uint_as_float(v.x << 16); o[1] = __uint_as_float(v.x & 0xffff0000u); o[2] = __uint_as_float(v.y << 16); o[3] = __uint_as_float(v.y & 0xffff0000u);
    o[4] = __uint_as_float(v.z << 16); o[5] = __uint_as_float(v.z & 0xffff0000u); o[6] = __uint_as_float(v.w << 16); o[7] = __uint_as_float(v.w & 0xffff0000u);
}
__device__ __forceinline__ float wave_sum(float v) {
#pragma unroll
    for (int o = 1; o < 64; o <<= 1) v += __shfl_xor(v, o);
    return v;
}
__device__ __forceinline__ float wave_max(float v) {
#pragma unroll
    for (int o = 1; o < 64; o <<= 1) v = fmaxf(v, __shfl_xor(v, o));
    return v;
}
__device__ __forceinline__ float scan_add(float v, int lane) {
#pragma unroll
    for (int o = 1; o < 64; o <<= 1) { const float t = __shfl_up(v, o); if (lane >= o) v += t; }
    return v;
}
__device__ __forceinline__ float scan_max(float v, int lane) {
#pragma unroll
    for (int o = 1; o < 64; o <<= 1) { const float t = __shfl_up(v, o); if (lane >= o) v = fmaxf(v, t); }
    return v;
}
__device__ __forceinline__ float siluf(float x) { return x / (1.f + __expf(-x)); }
__device__ __forceinline__ float sigmoidf_(float x) { return 1.f / (1.f + __expf(-x)); }
__device__ __forceinline__ float log_sigmoidf_(float x) { return fminf(x, 0.f) - log1pf(__expf(-fabsf(x))); }
#define LDS_WAIT() asm volatile("s_waitcnt lgkmcnt(0)" ::: "memory")

namespace pg8 {
constexpr int BM = 256, BK = 64, HALF = 128, HTB = HALF * BK * 2, STAGE_BYTES = 8 * HTB, NXCD = 8, WGM = 8;
__host__ __device__ __forceinline__ int lds_byte(int r, int c) { const int st = (r >> 4) * 2 + (c >> 5), rr = r & 15, cc = c & 31, ob = rr * 64 + cc * 2; return st * 1024 + (ob ^ (((ob >> 9) & 1) << 5)); }
__host__ __device__ __forceinline__ void stage_rc(int b, int& R, int& C) { const int st = b / 1024, sb = b % 1024, swz = sb ^ (((sb >> 9) & 1) << 5); R = (st >> 1) * 16 + swz / 64; C = (st & 1) * 32 + (swz % 64) / 2; }
__host__ __device__ __forceinline__ int perm32(int rho) { const int n = rho >> 4, i = rho & 15; return 8 * (i >> 2) + 4 * n + (i & 3); }
struct Unit { int pm, pn; };

struct StaticOrder {
    const char* A; const char* Bt; int K;
    int nM, nN, nwg, G, c;
    __device__ void init(const void* A_, const void* Bt_, int K_, int M, int N, int G_, int c_) { A = (const char*)A_; Bt = (const char*)Bt_; K = K_; nM = M / BM; nN = N / BM; nwg = nM * nN; G = G_; c = c_; }
    __device__ bool next(int i, Unit& u) const {
        const long L = (long)i * G + c; if (L >= nwg) return false;
        int wgid = (int)L; { const int q = nwg / NXCD, r = nwg % NXCD, xcd = wgid % NXCD, off = wgid / NXCD; wgid = (xcd < r ? xcd * (q + 1) : r * (q + 1) + (xcd - r) * q) + off; }
        const int nig = WGM * nN, gid = wgid / nig, fm = gid * WGM, gsz = (nM - fm) < WGM ? (nM - fm) : WGM;
        u.pm = fm + ((wgid % nig) % gsz); u.pn = (wgid % nig) / gsz; return true;
    }
    __device__ __forceinline__ const char* aptr(const Unit& u) const { return A + (size_t)u.pm * BM * K * 2; }
    __device__ __forceinline__ const char* bptr(const Unit& u) const { return Bt + (size_t)u.pn * BM * K * 2; }
};
struct MoeOrder {
    const char* A; const char* Bt; int K, N, nN, ntile, G, c;
    int ts1, ts2, ts3, ts4, ts5, ts6, ts7;
    __device__ bool next(int i, Unit& u) const {
        const long L = (long)i * G + c; if (L >= (long)ntile * nN) return false;
        u.pm = (int)(L / nN); u.pn = (int)(L % nN); return true;
    }
    __device__ __forceinline__ int expert(int pm) const { return (pm >= ts1) + (pm >= ts2) + (pm >= ts3) + (pm >= ts4) + (pm >= ts5) + (pm >= ts6) + (pm >= ts7); }
    __device__ __forceinline__ const char* aptr(const Unit& u) const { return A + (size_t)u.pm * BM * K * 2; }
    __device__ __forceinline__ const char* bptr(const Unit& u) const { return Bt + ((size_t)expert(u.pm) * N + (size_t)u.pn * BM) * K * 2; }
};

template <class Epi, class Sched>
__device__ __forceinline__ void gemm_phase(LAS unsigned char* lds, const int K, const Sched& S, const Epi& E, const int tid) {
    const int wid = __builtin_amdgcn_readfirstlane(tid >> 6), lane = tid & 63, wr = wid >> 2, wc = wid & 3, fr = lane & 15, fq = lane >> 4;
    const int nt = K / BK;
    unsigned voffA[2], voffB[2];
#pragma unroll
    for (int i = 0; i < 2; ++i) { int R, C; stage_rc(tid * 16 + i * 8192, R, C); const int Rb = Epi::PERM ? ((R & ~31) + perm32(R & 31)) : R;
        voffA[i] = (unsigned)(R * K + C) * 2u; voffB[i] = (unsigned)(Rb * K + C) * 2u; }
    const size_t kstep = (size_t)(BK * 2);
    const size_t hstep = (size_t)HALF * K * 2;
    const unsigned ldsw = (unsigned)wid * 1024u;
    const int aoff = lds_byte(wr * 64 + fr, fq * 8), boff = lds_byte(wc * 32 + fr, fq * 8);
#define PG8_SA(b, h) (((b) * 2 + (h)) * HTB)
#define PG8_SB(b, h) ((4 + (b) * 2 + (h)) * HTB)
#define PG8_STAGE(bufoff, gbase, voff) do { _Pragma("unroll") for (int _i = 0; _i < 2; ++_i) \
        __builtin_amdgcn_global_load_lds((const GAS unsigned*)((const GAS char*)(gbase) + (voff)[_i]), (LAS unsigned*)(lds + (bufoff) + ldsw + _i * 8192), 16, 0, 0); } while (0)
#define PG8_LDA(dst, b, h) do { _Pragma("unroll") for (int m = 0; m < 4; ++m) _Pragma("unroll") for (int k = 0; k < 2; ++k) dst[m][k] = *(const LAS bf16x8*)(lds + PG8_SA(b, h) + aoff + m * 2048 + k * 1024); } while (0)
#define PG8_LDB(dst, b, h) do { _Pragma("unroll") for (int n = 0; n < 2; ++n) _Pragma("unroll") for (int k = 0; k < 2; ++k) dst[n][k] = *(const LAS bf16x8*)(lds + PG8_SB(b, h) + boff + n * 2048 + k * 1024); } while (0)
#define PG8_MMA(ai, bj, At, Bt) do { __builtin_amdgcn_s_setprio(1); _Pragma("unroll") for (int m = 0; m < 4; ++m) _Pragma("unroll") for (int n = 0; n < 2; ++n) _Pragma("unroll") for (int k = 0; k < 2; ++k) \
        acc[ai][bj][m][n] = __builtin_amdgcn_mfma_f32_16x16x32_bf16(Bt[n][k], At[m][k], acc[ai][bj][m][n], 0, 0, 0); __builtin_amdgcn_s_setprio(0); } while (0)
#define PG8_WAIT_V(n) asm volatile("s_waitcnt vmcnt(" #n ")" ::: "memory")
#define PG8_WAIT_L(n) asm volatile("s_waitcnt lgkmcnt(" #n ")" ::: "memory")
#define PG8_BAR __builtin_amdgcn_s_barrier()
#define PG8_SCHED __builtin_amdgcn_sched_barrier(0)
    Unit cur, nxt; int ui = 0;
    if (!S.next(0, cur)) return;
    f32x4 acc[2][2][4][2];
#pragma unroll
    for (int a = 0; a < 2; ++a)
#pragma unroll
        for (int b = 0; b < 2; ++b)
#pragma unroll
            for (int m = 0; m < 4; ++m)
#pragma unroll
                for (int n = 0; n < 2; ++n) acc[a][b][m][n] = (f32x4){0.f, 0.f, 0.f, 0.f};
    bf16x8 At[4][2], B0[2][2], B1[2][2];
    const char* cA = S.aptr(cur); const char* cB = S.bptr(cur);
    PG8_STAGE(PG8_SB(0, 0), cB, voffB); PG8_STAGE(PG8_SB(0, 1), cB + hstep, voffB); PG8_STAGE(PG8_SA(0, 0), cA, voffA); PG8_STAGE(PG8_SA(0, 1), cA + hstep, voffA);
    if (wr == 1) PG8_BAR;
    PG8_WAIT_V(2); PG8_BAR;
    PG8_STAGE(PG8_SB(1, 0), cB + kstep, voffB); PG8_STAGE(PG8_SA(1, 0), cA + kstep, voffA); PG8_STAGE(PG8_SB(1, 1), cB + hstep + kstep, voffB);
    PG8_WAIT_V(6); PG8_BAR;
    for (;;) {
        const bool has_next = S.next(ui + 1, nxt);
        const char* nA = has_next ? S.aptr(nxt) : cA; const char* nB = has_next ? S.bptr(nxt) : cB;
        for (int t = 0; t < nt; t += 2) {
            const bool last = (t == nt - 2);
            const char* a1 = cA + (size_t)(t + 1) * kstep;
            const char* a2 = last ? nA : cA + (size_t)(t + 2) * kstep; const char* b2 = last ? nB : cB + (size_t)(t + 2) * kstep;
            const char* a3 = a2 + kstep; const char* b3 = b2 + kstep;
            PG8_LDB(B0, 0, 0); PG8_LDB(B1, 0, 1); PG8_SCHED; PG8_LDA(At, 0, 0); PG8_STAGE(PG8_SA(1, 1), a1 + hstep, voffA);
            PG8_WAIT_V(8); PG8_WAIT_L(0); PG8_BAR; PG8_MMA(0, 0, At, B0); PG8_MMA(0, 1, At, B1); PG8_BAR; PG8_SCHED;
            PG8_LDA(At, 0, 1); PG8_STAGE(PG8_SB(0, 0), b2, voffB); PG8_STAGE(PG8_SB(0, 1), b2 + hstep, voffB); PG8_STAGE(PG8_SA(0, 0), a2, voffA);
            PG8_WAIT_V(8); PG8_WAIT_L(0); PG8_BAR; PG8_MMA(1, 0, At, B0); PG8_MMA(1, 1, At, B1); PG8_BAR; PG8_SCHED;
            PG8_LDB(B0, 1, 0); PG8_LDB(B1, 1, 1); PG8_SCHED; PG8_LDA(At, 1, 0); PG8_STAGE(PG8_SA(0, 1), a2 + hstep, voffA);
            PG8_WAIT_V(8); PG8_WAIT_L(0); PG8_BAR; PG8_MMA(0, 0, At, B0); PG8_MMA(0, 1, At, B1); PG8_BAR; PG8_SCHED;
            PG8_LDA(At, 1, 1); PG8_STAGE(PG8_SB(1, 0), b3, voffB); PG8_STAGE(PG8_SB(1, 1), b3 + hstep, voffB); PG8_STAGE(PG8_SA(1, 0), a3, voffA);
            PG8_WAIT_V(8); PG8_WAIT_L(0); PG8_BAR; PG8_MMA(1, 0, At, B0); PG8_MMA(1, 1, At, B1); PG8_BAR; PG8_SCHED;
        }
        if (wr == 0) PG8_BAR;
        { int fr_ = fr, fq_ = fq; asm volatile("" : "+v"(fr_), "+v"(fq_));
          E(acc, cur, wr, wc, fr_, fq_); }
        if (!has_next) break;
#pragma unroll
        for (int a = 0; a < 2; ++a)
#pragma unroll
            for (int b = 0; b < 2; ++b)
#pragma unroll
                for (int m = 0; m < 4; ++m)
#pragma unroll
                    for (int n = 0; n < 2; ++n) acc[a][b][m][n] = (f32x4){0.f, 0.f, 0.f, 0.f};
        cur = nxt; cA = nA; cB = nB; ++ui;
        if (wr == 1) PG8_BAR;
    }
    PG8_WAIT_V(0);
    PG8_BAR;
#undef PG8_SA
#undef PG8_SB
#undef PG8_STAGE
#undef PG8_LDA
#undef PG8_LDB
#undef PG8_MMA
#undef PG8_WAIT_V
#undef PG8_WAIT_L
#undef PG8_BAR
#undef PG8_SCHED
}


struct EpiInProj {
    static constexpr bool PERM = true;
    bf16_t* P; float* Gt; const float* ropeC; const float* ropeS;
    __device__ __forceinline__ void operator()(const f32x4 (&acc)[2][2][4][2], const Unit& u, int wr, int wc, int fr, int fq) const {
        const int row0 = u.pm * BM + wr * 64 + fr;
        const bool latent = u.pm < (SEQ / BM);
#pragma unroll
        for (int bj = 0; bj < 2; ++bj) {
            const int colg = u.pn * BM + bj * HALF + wc * 32;
            const bool rope = latent && colg >= C_AQ && colg < C_AV;
            const bool gate = colg >= C_MG && colg < C_END;
            const int col0 = colg + 8 * fq;
#pragma unroll
            for (int ai = 0; ai < 2; ++ai)
#pragma unroll
                for (int m = 0; m < 4; ++m) {
                    const int row = row0 + ai * HALF + m * 16;
                    f32x4 v0 = acc[ai][bj][m][0], v1 = acc[ai][bj][m][1];
                    if (rope) {
                        const int pos = ((colg >> 5) & 1) ? (row & 63) : (row >> 6);
                        const f32x4 c0 = *(const f32x4*)(ropeC + pos * 16 + 8 * (fq & 1)), c1 = *(const f32x4*)(ropeC + pos * 16 + 8 * (fq & 1) + 4);
                        const f32x4 s0 = *(const f32x4*)(ropeS + pos * 16 + 8 * (fq & 1)), s1 = *(const f32x4*)(ropeS + pos * 16 + 8 * (fq & 1) + 4);
                        const float sg = (fq < 2) ? -1.f : 1.f;
                        f32x4 p0, p1;
#pragma unroll
                        for (int i = 0; i < 4; ++i) { p0[i] = __shfl_xor(v0[i], 32); p1[i] = __shfl_xor(v1[i], 32); }
#pragma unroll
                        for (int i = 0; i < 4; ++i) { v0[i] = v0[i] * c0[i] + sg * p0[i] * s0[i]; v1[i] = v1[i] * c1[i] + sg * p1[i] * s1[i]; }
                    }
                    u32x4 w; w.x = pk2(v0[0], v0[1]); w.y = pk2(v0[2], v0[3]); w.z = pk2(v1[0], v1[1]); w.w = pk2(v1[2], v1[3]);
                    *(u32x4*)(P + (size_t)row * LDP + col0) = w;
                    if (gate && col0 < C_END) { float* g = Gt + (size_t)row * 48 + (col0 - C_MG); *(f32x4*)g = v0; *(f32x4*)(g + 4) = v1; }
                    asm volatile("" ::: "memory");
                }
        }
    }
};
struct EpiResid {
    static constexpr bool PERM = false;
    const float* X; float* Y; const float* modl; const float* modc;
    __device__ __forceinline__ void operator()(const f32x4 (&acc)[2][2][4][2], const Unit& u, int wr, int wc, int fr, int fq) const {
        const int row0 = u.pm * BM + wr * 64 + fr, col0 = u.pn * BM + wc * 32 + 4 * fq;
        const float* md = (u.pm < SEQ / BM) ? modl : modc;
        f32x4 mv[2][2];
#pragma unroll
        for (int bj = 0; bj < 2; ++bj)
#pragma unroll
            for (int n = 0; n < 2; ++n) mv[bj][n] = *(const f32x4*)(md + col0 + bj * HALF + n * 16);
#pragma unroll
        for (int ai = 0; ai < 2; ++ai)
#pragma unroll
            for (int m = 0; m < 4; ++m) { const size_t off = (size_t)(row0 + ai * HALF + m * 16) * DM + col0;
#pragma unroll
                for (int bj = 0; bj < 2; ++bj)
#pragma unroll
                    for (int n = 0; n < 2; ++n) { const f32x4 xv = *(const f32x4*)(X + off + bj * HALF + n * 16);
                        *(f32x4*)(Y + off + bj * HALF + n * 16) = xv * ALPHA + mv[bj][n] * acc[ai][bj][m][n]; }
                asm volatile("" ::: "memory"); }
    }
};
struct EpiSwiglu {
    static constexpr bool PERM = true;
    bf16_t* O; int ld;
    __device__ __forceinline__ void operator()(const f32x4 (&acc)[2][2][4][2], const Unit& u, int wr, int wc, int fr, int fq) const {
        const int row0 = u.pm * BM + wr * 64 + fr, col0 = u.pn * HALF + wc * 32 + 8 * fq;
#pragma unroll
        for (int ai = 0; ai < 2; ++ai)
#pragma unroll
            for (int m = 0; m < 4; ++m) {
                const f32x4 g0 = acc[ai][0][m][0], g1 = acc[ai][0][m][1], u0 = acc[ai][1][m][0], u1 = acc[ai][1][m][1];
                float r[8];
#pragma unroll
                for (int i = 0; i < 4; ++i) { r[i] = siluf(g0[i]) * u0[i]; r[4 + i] = siluf(g1[i]) * u1[i]; }
                u32x4 w; w.x = pk2(r[0], r[1]); w.y = pk2(r[2], r[3]); w.z = pk2(r[4], r[5]); w.w = pk2(r[6], r[7]);
                *(u32x4*)(O + (size_t)(row0 + ai * HALF + m * 16) * ld + col0) = w;
            }
    }
};
struct EpiF32 {
    static constexpr bool PERM = false;
    float* C;
    __device__ __forceinline__ void operator()(const f32x4 (&acc)[2][2][4][2], const Unit& u, int wr, int wc, int fr, int fq) const {
        const int row0 = u.pm * BM + wr * 64 + fr, col0 = u.pn * BM + wc * 32 + 4 * fq;
#pragma unroll
        for (int ai = 0; ai < 2; ++ai)
#pragma unroll
            for (int m = 0; m < 4; ++m) { float* rowp = C + (size_t)(row0 + ai * HALF + m * 16) * DM + col0;
#pragma unroll
                for (int bj = 0; bj < 2; ++bj)
#pragma unroll
                    for (int n = 0; n < 2; ++n) *(f32x4*)(rowp + bj * HALF + n * 16) = acc[ai][bj][m][n]; }
    }
};
}

#define XB_TMO      128
#define XB_XCNT(j)  (256  + 64 * (j))
#define XB_XSUB(j)  (1280 + 64 * (j))
#define XB_XGEN(j)  (2304 + 64 * (j))
#define XB_TOP      3328
#define XB_TOPGEN   3392
#define XCD_BAR_WORDS 3456
#define XB_SPIN_CAP (1u << 18)
__device__ __forceinline__ unsigned xb_ld(unsigned* p)              { return __hip_atomic_load(p, __ATOMIC_RELAXED, __HIP_MEMORY_SCOPE_AGENT); }
__device__ __forceinline__ unsigned xb_add(unsigned* p, unsigned v) { return __hip_atomic_fetch_add(p, v, __ATOMIC_RELAXED, __HIP_MEMORY_SCOPE_AGENT); }
__device__ __forceinline__ unsigned xb_xcc_id() { return (unsigned)__builtin_amdgcn_s_getreg((3 << 11) | 20) & 0xFu; }
#define XB_SPIN(cond, bar) do { unsigned _sp = 0; while (cond) { __builtin_amdgcn_s_sleep(1); \
    if ((++_sp & 255u) == 0u) { if (xb_ld(&(bar)[XB_TMO])) break; if (_sp > XB_SPIN_CAP) { atomicAdd(&(bar)[XB_TMO], 1u); break; } } } } while (0)
struct XcdBarrier { unsigned* bar; unsigned x; volatile LAS unsigned* st; };
__device__ __forceinline__ XcdBarrier xcd_barrier_post(unsigned* bar, volatile LAS unsigned* st) {
    XcdBarrier b; b.bar = bar; b.x = xb_xcc_id(); b.st = st;
    if (threadIdx.x == 0) (void)xb_add(&bar[XB_XCNT(b.x)], 1u);
    return b;
}
__device__ __forceinline__ void xcd_barrier_complete(unsigned* bar, unsigned x, unsigned& nloc, unsigned& nx) {
    const unsigned G = gridDim.x * gridDim.y * gridDim.z;
    unsigned sum, cnt, mine, sp = 0u;
    for (;;) {
        sum = 0u; cnt = 0u; mine = 0u;
#pragma unroll
        for (unsigned j = 0; j < 16; ++j) { const unsigned c = xb_ld(&bar[XB_XCNT(j)]); sum += c; cnt += (c > 0u) ? 1u : 0u; mine = (j == x) ? c : mine; }
        if (sum == G) break;
        __builtin_amdgcn_s_sleep(1);
        if ((++sp & 255u) == 0u) { if (xb_ld(&bar[XB_TMO])) break; if (sp > XB_SPIN_CAP) { atomicAdd(&bar[XB_TMO], 1u); break; } }
    }
    nloc = mine > 0u ? mine : 1u; nx = cnt > 0u ? cnt : 1u;
}
__device__ __forceinline__ void xcd_barrier(const XcdBarrier& b) {
    asm volatile("s_waitcnt vmcnt(0)" ::: "memory");
    __syncthreads();
    if (threadIdx.x == 0) {
        unsigned* bar = b.bar;
        __builtin_amdgcn_s_waitcnt(0);
        unsigned nloc = b.st[0], nx = b.st[1];
        if (nloc == 0u) { xcd_barrier_complete(bar, b.x, nloc, nx); b.st[0] = nloc; b.st[1] = nx; }
        const unsigned old = xb_add(&bar[XB_XSUB(b.x)], 1u);
        const unsigned gen = old / nloc;
        if (old + 1u == (gen + 1u) * nloc) {
            __builtin_amdgcn_fence(__ATOMIC_RELEASE, "agent");
            asm volatile("s_waitcnt vmcnt(0)" ::: "memory");
            const unsigned og = xb_add(&bar[XB_TOP], 1u);
            const unsigned tg = og / nx;
            if (og + 1u == (tg + 1u) * nx) xb_add(&bar[XB_TOPGEN], 1u);
            else XB_SPIN(xb_ld(&bar[XB_TOPGEN]) == tg, bar);
            __builtin_amdgcn_fence(__ATOMIC_ACQUIRE, "agent");
            xb_add(&bar[XB_XGEN(b.x)], 1u);
            asm volatile("s_waitcnt vmcnt(0)" ::: "memory");
        } else {
            XB_SPIN(xb_ld(&bar[XB_XGEN(b.x)]) == gen, bar);
            __builtin_amdgcn_fence(__ATOMIC_ACQUIRE, "agent");
            asm volatile("s_waitcnt vmcnt(0)" ::: "memory");
        }
    }
    __syncthreads();
}

struct Args { const float* in[22]; float* out; unsigned char* ws; int ph_lo, ph_hi; };

__device__ __forceinline__ int in_srccol(int r, float& sc) {
    sc = 1.f;
    if (r < 1024) { if (r >= C_MK && r < C_MV) sc = 0.125f; return r; }
    if (r < C_MG) { if (r < C_AK) sc = 0.125f; else if (r >= C_GQ && r < C_GK) sc = 0.17677669529663687f; return r + 16; }
    if (r < C_GGT) return r - C_MG + 1024;
    if (r < C_END) return r;
    return -1;
}
__device__ __forceinline__ void tr_item(const float* W, int K, int N, int NP, bf16_t* WT, int mode, int half, LAS float* scr, int item, int lane) {
    const int nblk = NP >> 6, kb = item / nblk, nb = item - kb * nblk, k0 = kb << 6, n0 = nb << 6;
    const int r = n0 + lane; float sc = 1.f; int src;
    if (mode == 0) src = r; else if (mode == 1) src = in_srccol(r, sc); else { const int pn = r >> 8, w = r & 255; src = (w < 128) ? (pn * 128 + w) : (half + pn * 128 + w - 128); }
    const float* wp = W + (size_t)k0 * N + (src < 0 ? 0 : src);
#pragma unroll 16
    for (int i = 0; i < 64; ++i) { const float v = wp[(size_t)i * N]; scr[i * 65 + lane] = (src < 0) ? 0.f : v * sc; }
    LDS_WAIT();
    const int c = lane & 7;
#pragma unroll
    for (int j = 0; j < 8; ++j) { const int n = (lane >> 3) + 8 * j; const LAS float* s = scr + (8 * c) * 65 + n;
        uint4 o; o.x = pk2(s[0], s[65]); o.y = pk2(s[130], s[195]); o.z = pk2(s[260], s[325]); o.w = pk2(s[390], s[455]);
        *(uint4*)(WT + (size_t)(n0 + n) * K + k0 + 8 * c) = o; }
    LDS_WAIT();
}

__device__ __forceinline__ void chunk_rows(int d, int jc, int& base, int& step) {
    int oc;
    if (d == 0) oc = (jc < 4) ? 256 + jc : jc - 4; else oc = (jc < 4) ? 256 + (3 - jc) : 255 - (jc - 4);
    const int b0 = (oc < 256) ? oc * 64 : SEQ + (oc - 256) * 64;
    if (d == 0) { base = b0; step = 1; } else { base = b0 + 63; step = -1; }
}
__device__ __forceinline__ int oc_to_jc(int d, int oc) { if (d == 0) return oc < 256 ? oc + 4 : oc - 256; return oc < 256 ? 4 + (255 - oc) : 3 - (oc - 256); }

typedef short s16x4 __attribute__((ext_vector_type(4)));
typedef short v4i16_t __attribute__((ext_vector_type(4)));
typedef float f32x2_t __attribute__((ext_vector_type(2))); typedef __bf16 bf16x2_t __attribute__((ext_vector_type(2)));
__device__ __forceinline__ unsigned cvtpk(float lo, float hi) { f32x2_t v = {lo, hi}; bf16x2_t b = __builtin_convertvector(v, bf16x2_t); return __builtin_bit_cast(unsigned, b); }
__device__ __forceinline__ s16x4 ds_tr16(const LAS unsigned char* p) { return __builtin_bit_cast(s16x4, __builtin_amdgcn_ds_read_tr16_b64_v4i16((LAS v4i16_t*)p)); }
__device__ __forceinline__ bf16x8 cat44(s16x4 a, s16x4 b) { return __builtin_shufflevector(a, b, 0, 1, 2, 3, 4, 5, 6, 7); }
#define MFMA16(a, b, c) __builtin_amdgcn_mfma_f32_16x16x32_bf16(a, b, c, 0, 0, 0)
constexpr int AT_RS = 144, AT_TILE = 128 * AT_RS;
__device__ __forceinline__ void attn_unit(LAS unsigned char* lds, const bf16_t* P, bf16_t* CAT, int qb  , int cqb, int kvh, const float* sink, int tid, int lane, int wave) {
    const bool is_ctx = qb < 0;
    const int g = lane >> 4, i = lane & 15;
    const int hq = kvh * 4 + (wave >> 1), qh = wave & 1;
    const int qrow0 = (is_ctx ? SEQ + cqb * 128 : qb * 128) + qh * 64;
    bf16x8 bq[4][2];
#pragma unroll
    for (int qt = 0; qt < 4; ++qt)
#pragma unroll
        for (int ks = 0; ks < 2; ++ks) bq[qt][ks] = *(const bf16x8*)(P + (size_t)(qrow0 + 16 * qt + i) * LDP + C_AQ + hq * 64 + 32 * ks + 8 * g);
    f32x4 O[4][4];
#pragma unroll
    for (int dt = 0; dt < 4; ++dt)
#pragma unroll
        for (int qt = 0; qt < 4; ++qt) O[dt][qt] = (f32x4){0.f, 0.f, 0.f, 0.f};
    float m[4], l[4];
    { const float sk = sink[hq];
#pragma unroll
      for (int qt = 0; qt < 4; ++qt) { m[qt] = sk; l[qt] = (g == 0) ? 1.f : 0.f; } }
#define AT_VALID(c) ((c) >= 3 || (!is_ctx && (qb - 1 + (c)) >= 0 && (qb - 1 + (c)) < SEQ / 128))
#define AT_ROW(c) ((c) >= 3 ? SEQ + ((c) - 3) * 128 : (qb - 1 + (c)) * 128)
    u32x4 kreg[2], vreg[2];
    int c = 0; while (!AT_VALID(c)) ++c;
    __syncthreads();
#pragma unroll
    for (int t = 0; t < 2; ++t) { const int idx = tid + 512 * t, r = idx >> 3, ch = idx & 7; const bf16_t* src = P + (size_t)(AT_ROW(c) + r) * LDP + kvh * 64 + ch * 8;
        kreg[t] = *(const u32x4*)(src + C_AK); vreg[t] = *(const u32x4*)(src + C_AV); }
    int buf = 0;
#pragma unroll
    for (int t = 0; t < 2; ++t) { const int idx = tid + 512 * t, r = idx >> 3, ch = idx & 7; *(LAS u32x4*)(lds + r * AT_RS + ch * 16) = kreg[t]; *(LAS u32x4*)(lds + AT_TILE + r * AT_RS + ch * 16) = vreg[t]; }
    __syncthreads();
    while (c < 5) {
        int cn = c + 1; while (cn < 5 && !AT_VALID(cn)) ++cn;
        if (cn < 5) {
#pragma unroll
            for (int t = 0; t < 2; ++t) { const int idx = tid + 512 * t, r = idx >> 3, ch = idx & 7; const bf16_t* src = P + (size_t)(AT_ROW(cn) + r) * LDP + kvh * 64 + ch * 8;
                kreg[t] = *(const u32x4*)(src + C_AK); vreg[t] = *(const u32x4*)(src + C_AV); }
        }
        const LAS unsigned char* Kb = lds + buf * 2 * AT_TILE; const LAS unsigned char* Vb = Kb + AT_TILE;
        const bool lo_blk = (!is_ctx && c == 0), hi_blk = (!is_ctx && c == 2);
        for (int grp = 0; grp < 4; ++grp) {
            if (lo_blk && qh == 1 && grp < 2) continue;
            if (hi_blk && qh == 0 && grp >= 2) continue;
            bf16x8 kf[2][2], vf[4];
#pragma unroll
            for (int kt = 0; kt < 2; ++kt)
#pragma unroll
                for (int ks = 0; ks < 2; ++ks) kf[kt][ks] = *(const LAS bf16x8*)(Kb + (grp * 32 + kt * 16 + i) * AT_RS + (32 * ks + 8 * g) * 2);
#pragma unroll
            for (int dt = 0; dt < 4; ++dt) { const LAS unsigned char* vp = Vb + (grp * 32 + 4 * g + (i >> 2)) * AT_RS + (16 * dt + 4 * (i & 3)) * 2;
                vf[dt] = cat44(ds_tr16(vp), ds_tr16(vp + 16 * AT_RS)); }
#pragma unroll
            for (int qt = 0; qt < 4; ++qt) {
                f32x4 s0 = (f32x4){0.f, 0.f, 0.f, 0.f}, s1 = s0;
#pragma unroll
                for (int ks = 0; ks < 2; ++ks) { s0 = MFMA16(kf[0][ks], bq[qt][ks], s0); s1 = MFMA16(kf[1][ks], bq[qt][ks], s1); }
                if (lo_blk || hi_blk) {
                    const int qo = qh * 64 + qt * 16 + i, ko = grp * 32 + 4 * g;
#pragma unroll
                    for (int r = 0; r < 4; ++r) {
                        const bool v0 = lo_blk ? (ko + r >= qo) : (ko + r <= qo), v1 = lo_blk ? (ko + 16 + r >= qo) : (ko + 16 + r <= qo);
                        s0[r] = v0 ? s0[r] : -INFINITY; s1[r] = v1 ? s1[r] : -INFINITY; }
                }
                float mx = fmaxf(fmaxf(fmaxf(s0[0], s0[1]), fmaxf(s0[2], s0[3])), fmaxf(fmaxf(s1[0], s1[1]), fmaxf(s1[2], s1[3])));
                mx = fmaxf(mx, __shfl_xor(mx, 16)); mx = fmaxf(mx, __shfl_xor(mx, 32));
                const float mn = fmaxf(m[qt], mx), alpha = __expf(m[qt] - mn);
                m[qt] = mn;
                float ps = 0.f;
#pragma unroll
                for (int r = 0; r < 4; ++r) { s0[r] = __expf(s0[r] - mn); s1[r] = __expf(s1[r] - mn); ps += s0[r] + s1[r]; }
                l[qt] = l[qt] * alpha + ps;
                u32x4 pw; pw.x = cvtpk(s0[0], s0[1]); pw.y = cvtpk(s0[2], s0[3]); pw.z = cvtpk(s1[0], s1[1]); pw.w = cvtpk(s1[2], s1[3]);
                const bf16x8 pb = __builtin_bit_cast(bf16x8, pw);
#pragma unroll
                for (int dt = 0; dt < 4; ++dt) { O[dt][qt] = O[dt][qt] * alpha; O[dt][qt] = MFMA16(vf[dt], pb, O[dt][qt]); }
            }
        }
        if (cn < 5) {
            LAS unsigned char* nb = lds + (buf ^ 1) * 2 * AT_TILE;
#pragma unroll
            for (int t = 0; t < 2; ++t) { const int idx = tid + 512 * t, r = idx >> 3, ch = idx & 7; *(LAS u32x4*)(nb + r * AT_RS + ch * 16) = kreg[t]; *(LAS u32x4*)(nb + AT_TILE + r * AT_RS + ch * 16) = vreg[t]; }
        }
        __syncthreads();
        buf ^= 1; c = cn;
    }
#undef AT_VALID
#undef AT_ROW
#pragma unroll
    for (int qt = 0; qt < 4; ++qt) {
        float lt = l[qt]; lt += __shfl_xor(lt, 16); lt += __shfl_xor(lt, 32);
        const float inv = 1.f / lt;
        bf16_t* dst = CAT + (size_t)(qrow0 + 16 * qt + i) * DM + 256 + hq * 64 + 4 * g;
#pragma unroll
        for (int dt = 0; dt < 4; ++dt) { uint2 o; o.x = cvtpk(O[dt][qt][0] * inv, O[dt][qt][1] * inv); o.y = cvtpk(O[dt][qt][2] * inv, O[dt][qt][3] * inv); *(uint2*)(dst + 16 * dt) = o; }
    }
}

constexpr int CH_RS = 144;
constexpr int CH_T = 64 * CH_RS;
constexpr int GL_RS = 80;
constexpr int GL_T = 64 * GL_RS;
__device__ __forceinline__ int chunk_b0(int oc) { return (oc < 256) ? oc * 64 : SEQ + (oc - 256) * 64; }
__device__ __forceinline__ bf16x8 tr_frag(const LAS unsigned char* tile, int rs, int row0, int col0, int lane) {
    const int g = lane >> 4, i = lane & 15; const LAS unsigned char* p = tile + (row0 + 8 * g + (i >> 2)) * rs + (col0 + 4 * (i & 3)) * 2;
    return cat44(ds_tr16(p), ds_tr16(p + 4 * rs));
}
__device__ __forceinline__ bf16x8 tr_frag_perm(const LAS unsigned char* tile, int rs, int row0, int col0, int lane) {
    const int g = lane >> 4, i = lane & 15; const LAS unsigned char* p = tile + (row0 + 4 * g + (i >> 2)) * rs + (col0 + 4 * (i & 3)) * 2;
    return cat44(ds_tr16(p), ds_tr16(p + 16 * rs));
}
__device__ __forceinline__ void unpack8(const u32x4 v, float* o) {
    o[0] = __uint_as_float(v.x << 16); o[1] = __uint_as_float(v.x & 0xffff0000u); o[2] = __uint_as_float(v.y << 16); o[3] = __uint_as_float(v.y & 0xffff0000u);
    o[4] = __uint_as_float(v.z << 16); o[5] = __uint_as_float(v.z & 0xffff0000u); o[6] = __uint_as_float(v.w << 16); o[7] = __uint_as_float(v.w & 0xffff0000u);
}
__device__ __forceinline__ u32x4 pack8(const float* f) { u32x4 w; w.x = cvtpk(f[0], f[1]); w.y = cvtpk(f[2], f[3]); w.z = cvtpk(f[4], f[5]); w.w = cvtpk(f[6], f[7]); return w; }

__device__ __forceinline__ void mlstm_summary(LAS unsigned char* lds, const bf16_t* P, const float* Gt, const float* gate_b, float* MU, float* MNU, float* MSC, int h, int oc, int tid, int lane, int wave) {
    LAS unsigned char* Kw0 = lds; LAS unsigned char* Kw1 = lds + CH_T; LAS unsigned char* Vt = lds + 2 * CH_T; LAS float* wv = (LAS float*)(lds + 3 * CH_T);
    const int b0 = chunk_b0(oc);
    const int r = tid >> 3, ch = tid & 7;
    const u32x4 kraw = *(const u32x4*)(P + (size_t)(b0 + r) * LDP + C_MK + h * 64 + ch * 8), vraw = *(const u32x4*)(P + (size_t)(b0 + r) * LDP + C_MV + h * 64 + ch * 8);
    __syncthreads();
    if (wave < 2) {
        const int d = wave, sp = d ? 63 - lane : lane, row = b0 + sp, hd = h * 2 + d, jc = oc_to_jc(d, oc);
        const float ig = Gt[(size_t)row * 48 + d * 8 + h] + gate_b[d * 8 + h];
        const float fg = Gt[(size_t)row * 48 + d * 8 + 4 + h] + gate_b[d * 8 + 4 + h];
        const float lf = log_sigmoidf_(fg);
        const float bb = scan_add(lf, lane);
        const float av = ig - bb;
        const float cm = wave_max(av);
        const float B = __shfl(bb, 63);
        wv[d * 64 + sp] = __expf(av - cm);
        if (lane == 0) { MSC[(size_t)(hd * NCH + jc) * 4 + 0] = cm; MSC[(size_t)(hd * NCH + jc) * 4 + 1] = B; }
    }
    *(LAS u32x4*)(Vt + r * CH_RS + ch * 16) = vraw;
    __syncthreads();
    { float kf[8], t0[8], t1[8]; unpack8(kraw, kf); const float w0 = wv[r], w1 = wv[64 + r];
#pragma unroll
      for (int j = 0; j < 8; ++j) { t0[j] = kf[j] * w0; t1[j] = kf[j] * w1; }
      *(LAS u32x4*)(Kw0 + r * CH_RS + ch * 16) = pack8(t0); *(LAS u32x4*)(Kw1 + r * CH_RS + ch * 16) = pack8(t1); }
    __syncthreads();
    { const int d = wave >> 2, dkt = wave & 3, g = lane >> 4, i = lane & 15, hd = h * 2 + d, jc = oc_to_jc(d, oc);
      const LAS unsigned char* Kw = d ? Kw1 : Kw0;
      const bf16x8 a0 = tr_frag(Kw, CH_RS, 0, 16 * dkt, lane), a1 = tr_frag(Kw, CH_RS, 32, 16 * dkt, lane);
      float* dst = MU + (size_t)(hd * NCH + jc) * 4096 + (16 * dkt + 4 * g) * 64 + i;
#pragma unroll
      for (int dvt = 0; dvt < 4; ++dvt) {
          f32x4 c = (f32x4){0.f, 0.f, 0.f, 0.f};
          c = MFMA16(a0, tr_frag(Vt, CH_RS, 0, 16 * dvt, lane), c); c = MFMA16(a1, tr_frag(Vt, CH_RS, 32, 16 * dvt, lane), c);
#pragma unroll
          for (int rr = 0; rr < 4; ++rr) dst[rr * 64 + 16 * dvt] = c[rr];
      }
      const short one = (i == 0) ? (short)0x3F80 : (short)0; const bf16x8 bo = (bf16x8){one, one, one, one, one, one, one, one};
      f32x4 c1 = (f32x4){0.f, 0.f, 0.f, 0.f}; c1 = MFMA16(a0, bo, c1); c1 = MFMA16(a1, bo, c1);
      if (i == 0) *(f32x4*)(MNU + (size_t)(hd * NCH + jc) * 64 + 16 * dkt + 4 * g) = c1; }
}

__device__ __forceinline__ void mlstm_out(LAS unsigned char* lds, const bf16_t* P, const float* Gt, const float* gate_b, const bf16_t* MC, const float* MNS, const float* MSC, const float* normw, bf16_t* CAT, int h, int oc, int tid, int lane, int wave) {
    LAS unsigned char* Qt = lds; LAS unsigned char* Kt = lds + CH_T; LAS unsigned char* Vt = lds + 2 * CH_T; LAS unsigned char* Ct = lds + 3 * CH_T;
    LAS float* arr = (LAS float*)(lds + 5 * CH_T);
    LAS f32x4* hs = (LAS f32x4*)(lds + 5 * CH_T + 2 * 320 * 4);
    const int b0 = chunk_b0(oc);
    const int r = tid >> 3, ch = tid & 7;
    const size_t ro = (size_t)(b0 + r) * LDP + h * 64 + ch * 8;
    const u32x4 qraw = *(const u32x4*)(P + ro + C_MQ), kraw = *(const u32x4*)(P + ro + C_MK), vraw = *(const u32x4*)(P + ro + C_MV);
    const int jc0 = oc_to_jc(0, oc), jc1 = oc_to_jc(1, oc);
    const u32x4 c0raw = *(const u32x4*)(MC + (size_t)((h * 2 + 0) * NCH + jc0) * 4096 + r * 64 + ch * 8), c1raw = *(const u32x4*)(MC + (size_t)((h * 2 + 1) * NCH + jc1) * 4096 + r * 64 + ch * 8);
    __syncthreads();
    if (wave < 2) {
        const int d = wave, sp = d ? 63 - lane : lane, row = b0 + sp, hd = h * 2 + d, jc = d ? jc1 : jc0;
        const float ig = Gt[(size_t)row * 48 + d * 8 + h] + gate_b[d * 8 + h];
        const float fg = Gt[(size_t)row * 48 + d * 8 + 4 + h] + gate_b[d * 8 + 4 + h];
        const float lf = log_sigmoidf_(fg);
        const float bb = scan_add(lf, lane);
        const float av = ig - bb;
        const float cm = scan_max(av, lane);
        const float mst = MSC[(size_t)(hd * NCH + jc) * 4 + 2];
        const float mx = fmaxf(mst, cm);
        LAS float* A = arr + d * 320;
        A[sp] = av; A[64 + sp] = mx; A[128 + sp] = __expf(mst - mx); A[192 + sp] = __expf(-(bb + mx));
        A[256 + lane] = MNS[(size_t)(hd * NCH + jc) * 64 + lane];
    }
    *(LAS u32x4*)(Qt + r * CH_RS + ch * 16) = qraw; *(LAS u32x4*)(Kt + r * CH_RS + ch * 16) = kraw; *(LAS u32x4*)(Vt + r * CH_RS + ch * 16) = vraw;
    *(LAS u32x4*)(Ct + r * CH_RS + ch * 16) = c0raw; *(LAS u32x4*)(Ct + CH_T + r * CH_RS + ch * 16) = c1raw;
    __syncthreads();
    const int d = wave >> 2, tt = wave & 3, g = lane >> 4, i = lane & 15, t = 16 * tt + i;
    f32x4 hh[4];
    {
        const LAS float* A = arr + d * 320;
        const float mxt = A[64 + t], wt = A[128 + t], emt = A[192 + t];
        bf16x8 bq[2], bqw[2]; float qn = 0.f;
#pragma unroll
        for (int ks = 0; ks < 2; ++ks) { const u32x4 raw = *(const LAS u32x4*)(Qt + t * CH_RS + (32 * ks + 8 * g) * 2); bq[ks] = __builtin_bit_cast(bf16x8, raw);
            float qf[8], qw[8]; unpack8(raw, qf);
            const f32x4 n0 = *(const LAS f32x4*)(A + 256 + 32 * ks + 8 * g), n1 = *(const LAS f32x4*)(A + 256 + 32 * ks + 8 * g + 4);
#pragma unroll
            for (int j = 0; j < 4; ++j) { qn += qf[j] * n0[j] + qf[4 + j] * n1[j]; }
#pragma unroll
            for (int j = 0; j < 8; ++j) qw[j] = qf[j] * wt;
            bqw[ks] = __builtin_bit_cast(bf16x8, pack8(qw)); }
        qn += __shfl_xor(qn, 16); qn += __shfl_xor(qn, 32);
        float dsum = 0.f; f32x4 sT[4];
#pragma unroll
        for (int st = 0; st < 4; ++st) {
            f32x4 c = (f32x4){0.f, 0.f, 0.f, 0.f};
#pragma unroll
            for (int ks = 0; ks < 2; ++ks) c = MFMA16(*(const LAS bf16x8*)(Kt + (16 * st + i) * CH_RS + (32 * ks + 8 * g) * 2), bq[ks], c);
            const f32x4 a4 = *(const LAS f32x4*)(A + 16 * st + 4 * g);
#pragma unroll
            for (int rr = 0; rr < 4; ++rr) { const int sidx = 16 * st + 4 * g + rr; const bool ok = d ? (sidx >= t) : (sidx <= t);
                const float val = ok ? c[rr] * __expf(a4[rr] - mxt) : 0.f; sT[st][rr] = val; dsum += val; }
        }
        dsum += __shfl_xor(dsum, 16); dsum += __shfl_xor(dsum, 32);
        const float den = dsum + wt * qn, inv = 1.f / fmaxf(fabsf(den), emt);
        bf16x8 pb[2];
#pragma unroll
        for (int gp = 0; gp < 2; ++gp) { u32x4 w; w.x = cvtpk(sT[2 * gp][0], sT[2 * gp][1]); w.y = cvtpk(sT[2 * gp][2], sT[2 * gp][3]); w.z = cvtpk(sT[2 * gp + 1][0], sT[2 * gp + 1][1]); w.w = cvtpk(sT[2 * gp + 1][2], sT[2 * gp + 1][3]); pb[gp] = __builtin_bit_cast(bf16x8, w); }
        const LAS unsigned char* Cd = Ct + d * CH_T;
#pragma unroll
        for (int dvt = 0; dvt < 4; ++dvt) {
            f32x4 c = (f32x4){0.f, 0.f, 0.f, 0.f};
            c = MFMA16(tr_frag_perm(Vt, CH_RS, 0, 16 * dvt, lane), pb[0], c); c = MFMA16(tr_frag_perm(Vt, CH_RS, 32, 16 * dvt, lane), pb[1], c);
            c = MFMA16(tr_frag(Cd, CH_RS, 0, 16 * dvt, lane), bqw[0], c); c = MFMA16(tr_frag(Cd, CH_RS, 32, 16 * dvt, lane), bqw[1], c);
            hh[dvt] = c * inv;
        }
        if (d == 1) {
#pragma unroll
            for (int dvt = 0; dvt < 4; ++dvt) hs[(tt * 4 + dvt) * 64 + lane] = hh[dvt];
        }
    }
    __syncthreads();
    if (d == 0) {
        float s1 = 0.f;
#pragma unroll
        for (int dvt = 0; dvt < 4; ++dvt) { hh[dvt] = hh[dvt] + hs[(tt * 4 + dvt) * 64 + lane]; s1 += (hh[dvt][0] + hh[dvt][1]) + (hh[dvt][2] + hh[dvt][3]); }
        s1 += __shfl_xor(s1, 16); s1 += __shfl_xor(s1, 32);
        const float mu = s1 * (1.f / 64.f); float s2 = 0.f;
#pragma unroll
        for (int dvt = 0; dvt < 4; ++dvt) { hh[dvt] = hh[dvt] - mu; s2 += (hh[dvt][0] * hh[dvt][0] + hh[dvt][1] * hh[dvt][1]) + (hh[dvt][2] * hh[dvt][2] + hh[dvt][3] * hh[dvt][3]); }
        s2 += __shfl_xor(s2, 16); s2 += __shfl_xor(s2, 32);
        const float rstd = rsqrtf(s2 * (1.f / 64.f) + LN_EPS);
        const int row = b0 + t;
#pragma unroll
        for (int dvt = 0; dvt < 4; ++dvt) { const int col = h * 64 + 16 * dvt + 4 * g;
            const uint2 og = *(const uint2*)(P + (size_t)row * LDP + C_MO + col); const f32x4 nw = *(const f32x4*)(normw + col);
            const float o0 = hh[dvt][0] * rstd * nw[0] * sigmoidf_(__uint_as_float(og.x << 16)), o1 = hh[dvt][1] * rstd * nw[1] * sigmoidf_(__uint_as_float(og.x & 0xffff0000u));
            const float o2 = hh[dvt][2] * rstd * nw[2] * sigmoidf_(__uint_as_float(og.y << 16)), o3 = hh[dvt][3] * rstd * nw[3] * sigmoidf_(__uint_as_float(og.y & 0xffff0000u));
            uint2 o; o.x = cvtpk(o0, o1); o.y = cvtpk(o2, o3); *(uint2*)(CAT + (size_t)row * DM + col) = o; }
    }
}

__device__ __forceinline__ void gla_gates_wave(const float* Gt, const float* g_up, const float* g_b, int h, int b0, int lane, int wave, int& sp, float (&bc)[8]) {
    const int d = wave >> 2, dk0 = 8 * (wave & 3);
    sp = d ? 63 - lane : lane;
    const float* gs = Gt + (size_t)(b0 + sp) * 48 + 16 + d * 16;
    const f32x4 g0 = *(const f32x4*)gs, g1 = *(const f32x4*)(gs + 4), g2 = *(const f32x4*)(gs + 8), g3 = *(const f32x4*)(gs + 12);
    const float gv[16] = {g0[0], g0[1], g0[2], g0[3], g1[0], g1[1], g1[2], g1[3], g2[0], g2[1], g2[2], g2[3], g3[0], g3[1], g3[2], g3[3]};
#pragma unroll
    for (int c = 0; c < 8; ++c) {
        float z = g_b[d * 128 + h * 32 + dk0 + c];
#pragma unroll
        for (int rr = 0; rr < 16; ++rr) z += gv[rr] * g_up[(d * 16 + rr) * 128 + h * 32 + dk0 + c];
        bc[c] = scan_add(log_sigmoidf_(z) * (1.f / 16.f), lane);
    }
}
__device__ __forceinline__ void gla_summary(LAS unsigned char* lds, const bf16_t* P, const float* Gt, const float* g_up, const float* g_b, float* GU, float* GDEC, int h, int oc, int tid, int lane, int wave) {
    LAS unsigned char* Kd = lds; LAS unsigned char* Vt = lds + 2 * GL_T;
    const int b0 = chunk_b0(oc);
    { const int r = tid >> 3, ch = tid & 7; const u32x4 vraw = *(const u32x4*)(P + (size_t)(b0 + r) * LDP + C_GV + h * 64 + ch * 8);
      __syncthreads();
      *(LAS u32x4*)(Vt + r * CH_RS + ch * 16) = vraw; }
    { const int d = wave >> 2, dk0 = 8 * (wave & 3), hd = h * 2 + d, jc = oc_to_jc(d, oc);
      int sp; float bc[8]; gla_gates_wave(Gt, g_up, g_b, h, b0, lane, wave, sp, bc);
      float kf[8]; unpack8(*(const u32x4*)(P + (size_t)(b0 + sp) * LDP + C_GK + h * 32 + dk0), kf);
      float dec[8];
#pragma unroll
      for (int c = 0; c < 8; ++c) { const float bL = __shfl(bc[c], 63); kf[c] *= __expf(bL - bc[c]); dec[c] = __expf(bL); }
      *(LAS u32x4*)(Kd + d * GL_T + sp * GL_RS + dk0 * 2) = pack8(kf);
      if (lane == 0) { float* dp = GDEC + (size_t)(hd * NCH + jc) * 32 + dk0; *(f32x4*)dp = (f32x4){dec[0], dec[1], dec[2], dec[3]}; *(f32x4*)(dp + 4) = (f32x4){dec[4], dec[5], dec[6], dec[7]}; } }
    __syncthreads();
    { const int d = wave >> 2, dkt = (wave >> 1) & 1, dvh = wave & 1, g = lane >> 4, i = lane & 15, hd = h * 2 + d, jc = oc_to_jc(d, oc);
      const bf16x8 a0 = tr_frag(Kd + d * GL_T, GL_RS, 0, 16 * dkt, lane), a1 = tr_frag(Kd + d * GL_T, GL_RS, 32, 16 * dkt, lane);
      float* dst = GU + (size_t)(hd * NCH + jc) * 2048 + (16 * dkt + 4 * g) * 64 + i;
#pragma unroll
      for (int q = 0; q < 2; ++q) { const int dvt = 2 * dvh + q;
          f32x4 c = (f32x4){0.f, 0.f, 0.f, 0.f};
          c = MFMA16(a0, tr_frag(Vt, CH_RS, 0, 16 * dvt, lane), c); c = MFMA16(a1, tr_frag(Vt, CH_RS, 32, 16 * dvt, lane), c);
#pragma unroll
          for (int rr = 0; rr < 4; ++rr) dst[rr * 64 + 16 * dvt] = c[rr]; } }
}
__device__ __forceinline__ void gla_out(LAS unsigned char* lds, const bf16_t* P, const float* Gt, const float* g_up, const float* g_b, const bf16_t* GS, const float* normw, bf16_t* CAT, int h, int oc, int tid, int lane, int wave) {
    LAS unsigned char* Qs = lds; LAS unsigned char* Ks = lds + 2 * GL_T; LAS unsigned char* Vt = lds + 4 * GL_T; LAS unsigned char* St = Vt + CH_T;
    LAS f32x4* hs = (LAS f32x4*)(St + 2 * 32 * CH_RS);
    const int b0 = chunk_b0(oc);
    { const int r = tid >> 3, ch = tid & 7; const u32x4 vraw = *(const u32x4*)(P + (size_t)(b0 + r) * LDP + C_GV + h * 64 + ch * 8);
      const int dd = r >> 5, rk = r & 31; const u32x4 sraw = *(const u32x4*)(GS + (size_t)((h * 2 + dd) * NCH + oc_to_jc(dd, oc)) * 2048 + rk * 64 + ch * 8);
      __syncthreads();
      *(LAS u32x4*)(Vt + r * CH_RS + ch * 16) = vraw; *(LAS u32x4*)(St + dd * 32 * CH_RS + rk * CH_RS + ch * 16) = sraw; }
    { const int d = wave >> 2, dk0 = 8 * (wave & 3);
      int sp; float bc[8]; gla_gates_wave(Gt, g_up, g_b, h, b0, lane, wave, sp, bc);
      float qf[8], kf[8]; unpack8(*(const u32x4*)(P + (size_t)(b0 + sp) * LDP + C_GQ + h * 32 + dk0), qf); unpack8(*(const u32x4*)(P + (size_t)(b0 + sp) * LDP + C_GK + h * 32 + dk0), kf);
#pragma unroll
      for (int c = 0; c < 8; ++c) { qf[c] *= __expf(bc[c]); kf[c] *= __expf(-bc[c]); }
      *(LAS u32x4*)(Qs + d * GL_T + sp * GL_RS + dk0 * 2) = pack8(qf); *(LAS u32x4*)(Ks + d * GL_T + sp * GL_RS + dk0 * 2) = pack8(kf); }
    __syncthreads();
    const int d = wave >> 2, tt = wave & 3, g = lane >> 4, i = lane & 15, t = 16 * tt + i;
    f32x4 hh[4];
    {
        const bf16x8 bq = *(const LAS bf16x8*)(Qs + d * GL_T + t * GL_RS + 16 * g);
        f32x4 sT[4];
#pragma unroll
        for (int st = 0; st < 4; ++st) {
            f32x4 c = (f32x4){0.f, 0.f, 0.f, 0.f};
            c = MFMA16(*(const LAS bf16x8*)(Ks + d * GL_T + (16 * st + i) * GL_RS + 16 * g), bq, c);
#pragma unroll
            for (int rr = 0; rr < 4; ++rr) { const int sidx = 16 * st + 4 * g + rr; const bool ok = d ? (sidx >= t) : (sidx <= t); sT[st][rr] = ok ? c[rr] : 0.f; }
        }
        bf16x8 pb[2];
#pragma unroll
        for (int gp = 0; gp < 2; ++gp) { u32x4 w; w.x = cvtpk(sT[2 * gp][0], sT[2 * gp][1]); w.y = cvtpk(sT[2 * gp][2], sT[2 * gp][3]); w.z = cvtpk(sT[2 * gp + 1][0], sT[2 * gp + 1][1]); w.w = cvtpk(sT[2 * gp + 1][2], sT[2 * gp + 1][3]); pb[gp] = __builtin_bit_cast(bf16x8, w); }
#pragma unroll
        for (int dvt = 0; dvt < 4; ++dvt) {
            f32x4 c = (f32x4){0.f, 0.f, 0.f, 0.f};
            c = MFMA16(tr_frag_perm(Vt, CH_RS, 0, 16 * dvt, lane), pb[0], c); c = MFMA16(tr_frag_perm(Vt, CH_RS, 32, 16 * dvt, lane), pb[1], c);
            c = MFMA16(tr_frag(St + d * 32 * CH_RS, CH_RS, 0, 16 * dvt, lane), bq, c);
            hh[dvt] = c;
        }
        if (d == 1) {
#pragma unroll
            for (int dvt = 0; dvt < 4; ++dvt) hs[(tt * 4 + dvt) * 64 + lane] = hh[dvt];
        }
    }
    __syncthreads();
    if (d == 0) {
        float s1 = 0.f;
#pragma unroll
        for (int dvt = 0; dvt < 4; ++dvt) { hh[dvt] = hh[dvt] + hs[(tt * 4 + dvt) * 64 + lane]; s1 += (hh[dvt][0] + hh[dvt][1]) + (hh[dvt][2] + hh[dvt][3]); }
        s1 += __shfl_xor(s1, 16); s1 += __shfl_xor(s1, 32);
        const float mu = s1 * (1.f / 64.f); float s2 = 0.f;
#pragma unroll
        for (int dvt = 0; dvt < 4; ++dvt) { hh[dvt] = hh[dvt] - mu; s2 += (hh[dvt][0] * hh[dvt][0] + hh[dvt][1] * hh[dvt][1]) + (hh[dvt][2] * hh[dvt][2] + hh[dvt][3] * hh[dvt][3]); }
        s2 += __shfl_xor(s2, 16); s2 += __shfl_xor(s2, 32);
        const float rstd = rsqrtf(s2 * (1.f / 64.f) + LN_EPS);
        const int row = b0 + t;
#pragma unroll
        for (int dvt = 0; dvt < 4; ++dvt) { const int col = h * 64 + 16 * dvt + 4 * g;
            const uint2 gg = *(const uint2*)(P + (size_t)row * LDP + C_GG + col); const f32x4 nw = *(const f32x4*)(normw + col);
            const float o0 = hh[dvt][0] * rstd * nw[0] * siluf(__uint_as_float(gg.x << 16)), o1 = hh[dvt][1] * rstd * nw[1] * siluf(__uint_as_float(gg.x & 0xffff0000u));
            const float o2 = hh[dvt][2] * rstd * nw[2] * siluf(__uint_as_float(gg.y << 16)), o3 = hh[dvt][3] * rstd * nw[3] * siluf(__uint_as_float(gg.y & 0xffff0000u));
            uint2 o; o.x = cvtpk(o0, o1); o.y = cvtpk(o2, o3); *(uint2*)(CAT + (size_t)row * DM + 768 + col) = o; }
    }
}

__device__ __forceinline__ void ln16(f32x4 (&v)[4], const float* w, const float* b, int lane) {
    float s = 0.f;
#pragma unroll
    for (int j = 0; j < 4; ++j) s += (v[j][0] + v[j][1]) + (v[j][2] + v[j][3]);
    const float mean = wave_sum(s) * (1.f / DM); float s2 = 0.f;
#pragma unroll
    for (int j = 0; j < 4; ++j) { v[j] = v[j] - mean; s2 += (v[j][0] * v[j][0] + v[j][1] * v[j][1]) + (v[j][2] * v[j][2] + v[j][3] * v[j][3]); }
    const float rstd = rsqrtf(wave_sum(s2) * (1.f / DM) + LN_EPS);
#pragma unroll
    for (int j = 0; j < 4; ++j) { const f32x4 wv = *(const f32x4*)(w + 4 * lane + 256 * j), bv = *(const f32x4*)(b + 4 * lane + 256 * j); v[j] = v[j] * rstd * wv + bv; }
}
__device__ __forceinline__ void mod_store(f32x4 (&v)[4], const float* shift, const float* scale, bf16_t* hrow, int lane) {
#pragma unroll
    for (int j = 0; j < 4; ++j) { const f32x4 sh = *(const f32x4*)(shift + 4 * lane + 256 * j), sc = *(const f32x4*)(scale + 4 * lane + 256 * j);
        v[j] = v[j] * (sc + 1.f) + sh;
        uint2 o; o.x = pk2(v[j][0], v[j][1]); o.y = pk2(v[j][2], v[j][3]); *(uint2*)(hrow + 4 * lane + 256 * j) = o; }
}

__global__ void __launch_bounds__(512, 2) fwd(Args a_unused) {
    extern __shared__ __attribute__((aligned(16))) unsigned char lds_raw[];
    LAS unsigned char* lds = (LAS unsigned char*)lds_raw;
    const int wave0 = __builtin_amdgcn_readfirstlane(threadIdx.x >> 6);
    const int G = gridDim.x, bid = blockIdx.x;
    typedef const __attribute__((address_space(4))) Args* ArgsP;
    ArgsP ap0 = (ArgsP)__builtin_amdgcn_kernarg_segment_ptr();
#define PH_CTX() int wave = wave0; asm volatile("" : "+s"(wave)); unsigned ones_ = ~0u; asm volatile("" : "+s"(ones_)); const int lane = (int)__builtin_amdgcn_mbcnt_hi(ones_, __builtin_amdgcn_mbcnt_lo(ones_, 0u)); const int tid = wave * 64 + lane; \
    ArgsP ap = ap0; asm volatile("" : "+s"(ap)); unsigned char* ws = ap->ws; const int gw = bid * 8 + wave, NGW = G * 8; (void)lane; (void)gw; (void)NGW; (void)ws
#define WSP(T, off) ((T*)(ws + (off)))
    volatile LAS unsigned* MISC = (volatile LAS unsigned*)(lds + MISC_OFF);
    if (threadIdx.x < 32) MISC[threadIdx.x] = 0u;
    __syncthreads();
    XcdBarrier bar; bar.bar = (unsigned*)(ap0->ws + WS_CTL) + CW_BAR; bar.x = 0; bar.st = MISC + 8;
    if (MK_ONE_LAUNCH) bar = xcd_barrier_post(bar.bar, MISC + 8);
    const int lo = ap0->ph_lo, hi = ap0->ph_hi;
#define IN(k) (lo <= (k) && (k) < hi)
#define SEAM(k) do { if (MK_ONE_LAUNCH && (k) + 1 < hi) xcd_barrier(bar); } while (0)

    if (IN(0)) {
        PH_CTX();
        float* MODS = WSP(float, WS_MODS);
        LAS float* scs = (LAS float*)lds;
        for (int i = tid; i < 2048; i += 512) scs[i] = siluf(i < 1024 ? ap->in[1][i] : ap->in[3][i - 1024]);
        __syncthreads();
        for (int u = bid; u < 4 * 8 * 12; u += G) {
            const int l = u / 96, rem = u % 96, kc = rem / 12, ng = rem % 12, n = ng * 512 + tid;
            const float* w = ap->in[4] + ((size_t)l * 1024 + kc * 128) * 6144 + n;
            float a0 = 0.f, a1 = 0.f;
#pragma unroll 8
            for (int k = 0; k < 128; ++k) { const float wv = w[(size_t)k * 6144]; a0 += scs[kc * 128 + k] * wv; a1 += scs[1024 + kc * 128 + k] * wv; }
            if (kc == 0) { const float bb = ap->in[5][l * 6144 + n]; a0 += bb; a1 += bb; }
            atomicAdd(MODS + (size_t)(l * 2 + 0) * 6144 + n, a0); atomicAdd(MODS + (size_t)(l * 2 + 1) * 6144 + n, a1);
        }
        if (bid < 8) { float* ropeC = WSP(float, WS_ROPE); float* ropeS = ropeC + 256 * 16;
            const int i = bid * 512 + tid, pos = i >> 4, fi = i & 15; const float inv = powf(10000.f, -(float)fi / 16.f); const float ang = (float)pos * inv; float sn, cs; sincosf(ang, &sn, &cs); ropeC[i] = cs; ropeS[i] = sn; }
        __syncthreads();
        LAS float* scr = (LAS float*)(lds + wave * 16640);
        constexpr int I_A = 16 * 44, I_B = 16 * 16, I_C = 16 * 88, I_D = 44 * 16, I_E = 16 * 112, I_F = 56 * 16;
        constexpr int N_A = 4 * I_A, N_B = 4 * I_B, N_C = 2 * I_C, N_D = 2 * I_D, N_E = 16 * I_E, N_F = 16 * I_F;
        for (int it = gw; it < N_A + N_B + N_C + N_D + N_E + N_F; it += NGW) {
            int r = it;
            if (r < N_E) { const int mi = r / I_E; tr_item(ap->in[20] + (size_t)mi * DM * 2 * DEXP, DM, 2 * DEXP, 2 * DEXP, WSP(bf16_t, WS_MGU) + (size_t)mi * 2 * DEXP * DM, 2, DEXP, scr, r % I_E, lane); continue; } r -= N_E;
            if (r < N_F) { const int mi = r / I_F; tr_item(ap->in[21] + (size_t)mi * DEXP * DM, DEXP, DM, DM, WSP(bf16_t, WS_MDN) + (size_t)mi * DM * DEXP, 0, 0, scr, r % I_F, lane); continue; } r -= N_F;
            if (r < N_A) { const int mi = r / I_A; tr_item(ap->in[6] + (size_t)mi * DM * IN_COLS, DM, IN_COLS, NPIN, WSP(bf16_t, WS_WIN) + (size_t)mi * NPIN * DM, 1, 0, scr, r % I_A, lane); continue; } r -= N_A;
            if (r < N_B) { const int mi = r / I_B; tr_item(ap->in[13] + (size_t)mi * DM * DM, DM, DM, DM, WSP(bf16_t, WS_WOUT) + (size_t)mi * DM * DM, 0, 0, scr, r % I_B, lane); continue; } r -= N_B;
            if (r < N_C) { const int mi = r / I_C; tr_item(ap->in[16] + (size_t)mi * DM * 2 * DFF, DM, 2 * DFF, 2 * DFF, WSP(bf16_t, WS_FGU) + (size_t)mi * 2 * DFF * DM, 2, DFF, scr, r % I_C, lane); continue; } r -= N_C;
            { const int mi = r / I_D; tr_item(ap->in[17] + (size_t)mi * DFF * DM, DFF, DM, DM, WSP(bf16_t, WS_FDN) + (size_t)mi * DM * DFF, 0, 0, scr, r % I_D, lane); }
        }
        SEAM(0);
    }
    if (IN(1)) {
        PH_CTX();
        float* X = WSP(float, WS_X); bf16_t* H = WSP(bf16_t, WS_H); const float* MODS = WSP(float, WS_MODS);
        for (int r = gw; r < TT; r += NGW) {
            const int wch = r >= SEQ; const float* src = wch ? ap->in[2] + (size_t)(r - SEQ) * DM : ap->in[0] + (size_t)r * DM;
            f32x4 v[4];
#pragma unroll
            for (int j = 0; j < 4; ++j) { v[j] = *(const f32x4*)(src + 4 * lane + 256 * j); *(f32x4*)(X + (size_t)r * DM + 4 * lane + 256 * j) = v[j]; }
            const float* md = MODS + (size_t)(0 * 2 + wch) * 6144;
            mod_store(v, md, md + 1024, H + (size_t)r * DM, lane);
        }
        SEAM(1);
    }

    for (int l = 0; l < DEPTH; ++l) {
        const int pb = 2 + 10 * l;
        const bool lastl = (l == DEPTH - 1), moe = (l & 1);
        const int nrows = lastl ? SEQ : TT;

        if (IN(pb + 0)) {
            PH_CTX();
            pg8::StaticOrder S; S.init(WSP(bf16_t, WS_H), WSP(bf16_t, WS_WIN) + (size_t)l * NPIN * DM, DM, TT, NPIN, G, bid);
            pg8::EpiInProj E{WSP(bf16_t, WS_P), WSP(float, WS_G), WSP(float, WS_ROPE), WSP(float, WS_ROPE) + 256 * 16};
            pg8::gemm_phase<pg8::EpiInProj, pg8::StaticOrder>(lds, DM, S, E, tid);
            SEAM(pb + 0);
        }
        if (IN(pb + 1)) {
            if (!lastl && bid < 4) { PH_CTX(); attn_unit(lds, WSP(bf16_t, WS_P), WSP(bf16_t, WS_CAT), -1, bid >> 1, bid & 1, ap->in[9] + l * 8, tid, lane, wave); }
            { PH_CTX();
              for (int r = bid; r < 4 * NCH; r += G) { const int h = r / NCH, oc = r % NCH;
                  mlstm_summary(lds, WSP(bf16_t, WS_P), WSP(float, WS_G), ap->in[7] + l * 16, WSP(float, WS_MU), WSP(float, WS_MNU), WSP(float, WS_MSC), h, oc, tid, lane, wave); } }
            { PH_CTX();
              for (int r = (bid + 240) % G; r < 4 * NCH; r += G) { const int h = r / NCH, oc = r % NCH;
                  gla_summary(lds, WSP(bf16_t, WS_P), WSP(float, WS_G), ap->in[10] + (size_t)l * 2 * 16 * 128, ap->in[11] + l * 256, WSP(float, WS_GU), WSP(float, WS_GDEC), h, oc, tid, lane, wave); } }
            SEAM(pb + 1);
        }
        if (IN(pb + 2)) {
            PH_CTX();
            float* MSC = WSP(float, WS_MSC);
            const int wi = wave * G + bid;
            const int e0 = wi * 64;
            if (e0 < 32768 + 512) {
                const bool isC = e0 < 32768;
                const int hd = isC ? e0 / 4096 : (e0 - 32768) / 64, idx = isC ? (e0 % 4096) + lane : lane;
                const float* U = isC ? WSP(float, WS_MU) + (size_t)hd * NCH * 4096 + idx : WSP(float, WS_MNU) + (size_t)hd * NCH * 64 + idx;
                bf16_t* StC = WSP(bf16_t, WS_MC) + (size_t)hd * NCH * 4096 + idx; float* StN = WSP(float, WS_MNS) + (size_t)hd * NCH * 64 + idx;
                const int str = isC ? 4096 : 64;
                const bool wr_m = isC && (e0 % 4096) == 0 && lane == 0;
                float m = 0.f, cval = 0.f;
                for (int n0 = 0; n0 < NCH; n0 += 4) {
                    float uu[4], cm[4], BB[4];
#pragma unroll
                    for (int j = 0; j < 4; ++j) { uu[j] = U[(size_t)(n0 + j) * str]; cm[j] = MSC[(size_t)(hd * NCH + n0 + j) * 4]; BB[j] = MSC[(size_t)(hd * NCH + n0 + j) * 4 + 1]; }
#pragma unroll
                    for (int j = 0; j < 4; ++j) {
                        if (isC) StC[(size_t)(n0 + j) * 4096] = (bf16_t)f2bf(cval); else StN[(size_t)(n0 + j) * 64] = cval;
                        if (wr_m) MSC[(size_t)(hd * NCH + n0 + j) * 4 + 2] = m;
                        const float mx = fmaxf(m, cm[j]);
                        cval = __expf(m - mx) * cval + __expf(cm[j] - mx) * uu[j];
                        m = BB[j] + mx;
                    }
                }
            } else if (e0 < 32768 + 512 + 16384) {
                const int e2 = e0 - 33280, hd = e2 / 2048, idx = (e2 % 2048) + lane, dk = idx >> 6;
                const float* U = WSP(float, WS_GU) + (size_t)hd * NCH * 2048 + idx; bf16_t* St = WSP(bf16_t, WS_GS) + (size_t)hd * NCH * 2048 + idx; const float* DC = WSP(float, WS_GDEC) + (size_t)hd * NCH * 32 + dk;
                float sval = 0.f;
                for (int n0 = 0; n0 < NCH; n0 += 4) {
                    float uu[4], dc[4];
#pragma unroll
                    for (int j = 0; j < 4; ++j) { uu[j] = U[(size_t)(n0 + j) * 2048]; dc[j] = DC[(size_t)(n0 + j) * 32]; }
#pragma unroll
                    for (int j = 0; j < 4; ++j) { St[(size_t)(n0 + j) * 2048] = (bf16_t)f2bf(sval); sval = dc[j] * sval + uu[j]; }
                }
            }
            SEAM(pb + 2);
        }
        if (IN(pb + 3)) {
            const int noc = lastl ? 256 : 260;
            { PH_CTX();
              for (int u = bid; u < 256; u += G) attn_unit(lds, WSP(bf16_t, WS_P), WSP(bf16_t, WS_CAT), u >> 1, 0, u & 1, ap->in[9] + l * 8, tid, lane, wave); }
            { PH_CTX();
              for (int r = bid; r < 4 * noc; r += G) { const int h = r / noc, oc = r % noc;
                  mlstm_out(lds, WSP(bf16_t, WS_P), WSP(float, WS_G), ap->in[7] + l * 16, WSP(bf16_t, WS_MC), WSP(float, WS_MNS), WSP(float, WS_MSC), ap->in[8] + l * 256, WSP(bf16_t, WS_CAT), h, oc, tid, lane, wave); } }
            { PH_CTX();
              for (int r = (bid + 240) % G; r < 4 * noc; r += G) { const int h = r / noc, oc = r % noc;
                  gla_out(lds, WSP(bf16_t, WS_P), WSP(float, WS_G), ap->in[10] + (size_t)l * 2 * 16 * 128, ap->in[11] + l * 256, WSP(bf16_t, WS_GS), ap->in[12] + l * 256, WSP(bf16_t, WS_CAT), h, oc, tid, lane, wave); } }
            SEAM(pb + 3);
        }
        if (IN(pb + 4)) {
            PH_CTX();
            const float* modl = WSP(float, WS_MODS) + (size_t)(l * 2 + 0) * 6144;
            pg8::StaticOrder S; S.init(WSP(bf16_t, WS_CAT), WSP(bf16_t, WS_WOUT) + (size_t)l * DM * DM, DM, nrows, DM, G, bid);
            pg8::EpiResid E{WSP(float, WS_X), WSP(float, WS_Y), modl + 2 * 1024, modl + 6144 + 2 * 1024};
            pg8::gemm_phase<pg8::EpiResid, pg8::StaticOrder>(lds, DM, S, E, tid);
            SEAM(pb + 4);
        }
        if (IN(pb + 5)) {
            PH_CTX();
            float* X = WSP(float, WS_X); bf16_t* H = WSP(bf16_t, WS_H); const float* Y = WSP(float, WS_Y);
            const float* modl = WSP(float, WS_MODS) + (size_t)(l * 2 + 0) * 6144;
            unsigned* mcnt = WSP(unsigned, WS_CTL) + CW_MOE + 64 * 8 * (l >> 1);
            LAS float* RW = (LAS float*)lds;
            if (moe) { const float* rw = ap->in[18] + (size_t)(l >> 1) * DM * 8; for (int i = tid; i < 8192; i += 512) { const int e = i >> 10, c = i & 1023; RW[i] = rw[c * 8 + e]; } __syncthreads(); }
            const float* lw = ap->in[14] + (size_t)(l * 2 + 0) * DM; const float* lb = ap->in[15] + (size_t)(l * 2 + 0) * DM;
            for (int r = gw; r < nrows; r += NGW) {
                const int wch = r >= SEQ; const float* md = modl + wch * 6144;
                f32x4 v[4];
#pragma unroll
                for (int j = 0; j < 4; ++j) v[j] = *(const f32x4*)(Y + (size_t)r * DM + 4 * lane + 256 * j);
                ln16(v, lw, lb, lane);
#pragma unroll
                for (int j = 0; j < 4; ++j) *(f32x4*)(X + (size_t)r * DM + 4 * lane + 256 * j) = v[j];
                mod_store(v, md + 3 * 1024, md + 4 * 1024, H + (size_t)r * DM, lane);
                if (moe) {
                    float lg[8];
#pragma unroll
                    for (int e = 0; e < 8; ++e) { float s = 0.f;
#pragma unroll
                        for (int j = 0; j < 4; ++j) { const f32x4 w = *(const LAS f32x4*)(RW + e * 1024 + 4 * lane + 256 * j); s += v[j][0] * w[0] + v[j][1] * w[1] + v[j][2] * w[2] + v[j][3] * w[3]; }
                        lg[e] = wave_sum(s) + ap->in[19][(l >> 1) * 8 + e]; }
                    int e0 = 0; float l0 = lg[0];
#pragma unroll
                    for (int e = 1; e < 8; ++e) if (lg[e] > l0) { l0 = lg[e]; e0 = e; }
                    int e1 = -1; float l1 = -INFINITY;
#pragma unroll
                    for (int e = 0; e < 8; ++e) if (e != e0 && lg[e] > l1) { l1 = lg[e]; e1 = e; }
                    if (lane == 0) {
                        const float w0 = 1.f / (1.f + __expf(l1 - l0));
                        const int p0 = (int)atomicAdd(mcnt + 64 * e0, 1u), p1 = (int)atomicAdd(mcnt + 64 * e1, 1u);
                        WSP(int2, WS_TOKE)[r] = make_int2(e0, e1); WSP(int2, WS_TOKP)[r] = make_int2(p0, p1); WSP(float2, WS_TOKW)[r] = make_float2(w0, 1.f - w0);
                    }
                }
            }
            SEAM(pb + 5);
        }
#define MOE_TS() int ts0 = 0, ts1, ts2, ts3, ts4, ts5, ts6, ts7, ts8; { const unsigned* mcnt = WSP(unsigned, WS_CTL) + CW_MOE + 64 * 8 * (l >> 1); \
            ts1 = ts0 + (int)((__hip_atomic_load(mcnt + 64 * 0, __ATOMIC_RELAXED, __HIP_MEMORY_SCOPE_AGENT) + 255u) >> 8); ts2 = ts1 + (int)((__hip_atomic_load(mcnt + 64 * 1, __ATOMIC_RELAXED, __HIP_MEMORY_SCOPE_AGENT) + 255u) >> 8); \
            ts3 = ts2 + (int)((__hip_atomic_load(mcnt + 64 * 2, __ATOMIC_RELAXED, __HIP_MEMORY_SCOPE_AGENT) + 255u) >> 8); ts4 = ts3 + (int)((__hip_atomic_load(mcnt + 64 * 3, __ATOMIC_RELAXED, __HIP_MEMORY_SCOPE_AGENT) + 255u) >> 8); \
            ts5 = ts4 + (int)((__hip_atomic_load(mcnt + 64 * 4, __ATOMIC_RELAXED, __HIP_MEMORY_SCOPE_AGENT) + 255u) >> 8); ts6 = ts5 + (int)((__hip_atomic_load(mcnt + 64 * 5, __ATOMIC_RELAXED, __HIP_MEMORY_SCOPE_AGENT) + 255u) >> 8); \
            ts7 = ts6 + (int)((__hip_atomic_load(mcnt + 64 * 6, __ATOMIC_RELAXED, __HIP_MEMORY_SCOPE_AGENT) + 255u) >> 8); ts8 = ts7 + (int)((__hip_atomic_load(mcnt + 64 * 7, __ATOMIC_RELAXED, __HIP_MEMORY_SCOPE_AGENT) + 255u) >> 8); \
            ts1 = __builtin_amdgcn_readfirstlane(ts1); ts2 = __builtin_amdgcn_readfirstlane(ts2); ts3 = __builtin_amdgcn_readfirstlane(ts3); ts4 = __builtin_amdgcn_readfirstlane(ts4); \
            ts5 = __builtin_amdgcn_readfirstlane(ts5); ts6 = __builtin_amdgcn_readfirstlane(ts6); ts7 = __builtin_amdgcn_readfirstlane(ts7); ts8 = __builtin_amdgcn_readfirstlane(ts8); } (void)ts0; (void)ts8
        if (IN(pb + 6) && moe) {
            PH_CTX();
            MOE_TS();
            const bf16_t* H = WSP(bf16_t, WS_H); bf16_t* XB = WSP(bf16_t, WS_XB);
            for (int r = gw; r < nrows; r += NGW) {
                const int2 ee = WSP(int2, WS_TOKE)[r], pp = WSP(int2, WS_TOKP)[r];
                const int b0 = ee.x == 0 ? ts0 : ee.x == 1 ? ts1 : ee.x == 2 ? ts2 : ee.x == 3 ? ts3 : ee.x == 4 ? ts4 : ee.x == 5 ? ts5 : ee.x == 6 ? ts6 : ts7;
                const int b1 = ee.y == 0 ? ts0 : ee.y == 1 ? ts1 : ee.y == 2 ? ts2 : ee.y == 3 ? ts3 : ee.y == 4 ? ts4 : ee.y == 5 ? ts5 : ee.y == 6 ? ts6 : ts7;
                const int s0 = b0 * 256 + pp.x, s1 = b1 * 256 + pp.y;
                const uint4 h0 = *(const uint4*)(H + (size_t)r * DM + 8 * lane), h1 = *(const uint4*)(H + (size_t)r * DM + 512 + 8 * lane);
                *(uint4*)(XB + (size_t)s0 * DM + 8 * lane) = h0; *(uint4*)(XB + (size_t)s0 * DM + 512 + 8 * lane) = h1;
                *(uint4*)(XB + (size_t)s1 * DM + 8 * lane) = h0; *(uint4*)(XB + (size_t)s1 * DM + 512 + 8 * lane) = h1;
                if (lane == 0) WSP(int2, WS_TOKS)[r] = make_int2(s0, s1);
            }
            SEAM(pb + 6);
        }
        if (IN(pb + 7)) {
            PH_CTX();
            if (!moe) {
                pg8::StaticOrder S; S.init(WSP(bf16_t, WS_H), WSP(bf16_t, WS_FGU) + (size_t)(l >> 1) * 2 * DFF * DM, DM, nrows, 2 * DFF, G, bid);
                pg8::EpiSwiglu E{WSP(bf16_t, WS_ACT), DFF};
                pg8::gemm_phase<pg8::EpiSwiglu, pg8::StaticOrder>(lds, DM, S, E, tid);
            } else {
                MOE_TS();
                pg8::MoeOrder S; S.A = (const char*)WSP(bf16_t, WS_XB); S.Bt = (const char*)(WSP(bf16_t, WS_MGU) + (size_t)(l >> 1) * 8 * 2 * DEXP * DM); S.K = DM; S.N = 2 * DEXP; S.nN = 2 * DEXP / 256; S.ntile = ts8; S.G = G; S.c = bid;
                S.ts1 = ts1; S.ts2 = ts2; S.ts3 = ts3; S.ts4 = ts4; S.ts5 = ts5; S.ts6 = ts6; S.ts7 = ts7;
                pg8::EpiSwiglu E{WSP(bf16_t, WS_ACT), DEXP};
                pg8::gemm_phase<pg8::EpiSwiglu, pg8::MoeOrder>(lds, DM, S, E, tid);
            }
            SEAM(pb + 7);
        }
        if (IN(pb + 8)) {
            PH_CTX();
            if (!moe) {
                const float* modl = WSP(float, WS_MODS) + (size_t)(l * 2 + 0) * 6144;
                pg8::StaticOrder S; S.init(WSP(bf16_t, WS_ACT), WSP(bf16_t, WS_FDN) + (size_t)(l >> 1) * DM * DFF, DFF, nrows, DM, G, bid);
                pg8::EpiResid E{WSP(float, WS_X), WSP(float, WS_Y), modl + 5 * 1024, modl + 6144 + 5 * 1024};
                pg8::gemm_phase<pg8::EpiResid, pg8::StaticOrder>(lds, DFF, S, E, tid);
            } else {
                MOE_TS();
                pg8::MoeOrder S; S.A = (const char*)WSP(bf16_t, WS_ACT); S.Bt = (const char*)(WSP(bf16_t, WS_MDN) + (size_t)(l >> 1) * 8 * DM * DEXP); S.K = DEXP; S.N = DM; S.nN = DM / 256; S.ntile = ts8; S.G = G; S.c = bid;
                S.ts1 = ts1; S.ts2 = ts2; S.ts3 = ts3; S.ts4 = ts4; S.ts5 = ts5; S.ts6 = ts6; S.ts7 = ts7;
                pg8::EpiF32 E{WSP(float, WS_YS)};
                pg8::gemm_phase<pg8::EpiF32, pg8::MoeOrder>(lds, DEXP, S, E, tid);
            }
            SEAM(pb + 8);
        }
        if (IN(pb + 9)) {
            PH_CTX();
            float* X = WSP(float, WS_X); bf16_t* H = WSP(bf16_t, WS_H); const float* Y = WSP(float, WS_Y); const float* YS = WSP(float, WS_YS);
            const float* modl = WSP(float, WS_MODS) + (size_t)(l * 2 + 0) * 6144;
            const float* lw = ap->in[14] + (size_t)(l * 2 + 1) * DM; const float* lb = ap->in[15] + (size_t)(l * 2 + 1) * DM;
            for (int r = gw; r < nrows; r += NGW) {
                const int wch = r >= SEQ; const float* md = modl + wch * 6144;
                f32x4 v[4];
                if (!moe) {
#pragma unroll
                    for (int j = 0; j < 4; ++j) v[j] = *(const f32x4*)(Y + (size_t)r * DM + 4 * lane + 256 * j);
                } else {
                    const int2 ss = WSP(int2, WS_TOKS)[r]; const float2 ww = WSP(float2, WS_TOKW)[r];
#pragma unroll
                    for (int j = 0; j < 4; ++j) { const int c = 4 * lane + 256 * j;
                        const f32x4 y0 = *(const f32x4*)(YS + (size_t)ss.x * DM + c), y1 = *(const f32x4*)(YS + (size_t)ss.y * DM + c), xv = *(const f32x4*)(X + (size_t)r * DM + c), g5 = *(const f32x4*)(md + 5 * 1024 + c);
                        v[j] = xv * ALPHA + g5 * (y0 * ww.x + y1 * ww.y); }
                }
                ln16(v, lw, lb, lane);
                if (lastl) {
#pragma unroll
                    for (int j = 0; j < 4; ++j) *(f32x4*)(ap->out + (size_t)r * DM + 4 * lane + 256 * j) = v[j];
                } else {
#pragma unroll
                    for (int j = 0; j < 4; ++j) *(f32x4*)(X + (size_t)r * DM + 4 * lane + 256 * j) = v[j];
                    const float* mdn = modl + 2 * 6144 + wch * 6144;
                    mod_store(v, mdn, mdn + 1024, H + (size_t)r * DM, lane);
                }
            }
            SEAM(pb + 9);
        }
    }
#undef IN
#undef SEAM
}

extern "C" void kernel_launch(void* const* d_in, const int* in_sizes, int n_in, void* d_out, int out_size, void* d_ws, size_t ws_size, hipStream_t stream) {
    static int grid = 0;
    if (grid == 0) {
        if (n_in != 22 || ws_size < WS_END) { fprintf(stderr, "kernel_launch: unexpected n_in %d / ws %zu (need %zu)\n", n_in, ws_size, (size_t)WS_END); grid = -1; return; }
        int dev = 0, cus = 0;
        if (hipGetDevice(&dev) != hipSuccess || hipDeviceGetAttribute(&cus, hipDeviceAttributeMultiprocessorCount, dev) != hipSuccess) { grid = -1; return; }
        if (hipFuncSetAttribute((const void*)fwd, hipFuncAttributeMaxDynamicSharedMemorySize, LDS_BYTES) != hipSuccess) { fprintf(stderr, "kernel_launch: hipFuncSetAttribute failed\n"); grid = -1; return; }
        int per_cu = 0;
        if (hipOccupancyMaxActiveBlocksPerMultiprocessor(&per_cu, (const void*)fwd, 512, LDS_BYTES) != hipSuccess || per_cu < 1) fprintf(stderr, "kernel_launch: occupancy query reports %d\n", per_cu);
        (void)hipGetLastError();
        grid = cus;
    }
    if (grid < 0) return;
    (void)hipMemsetAsync((char*)d_ws + WS_CTL, 0, CTL_BYTES, stream);
    Args a{};
    for (int i = 0; i < 22; ++i) a.in[i] = (const float*)d_in[i];
    a.out = (float*)d_out; a.ws = (unsigned char*)d_ws;
#if MK_ONE_LAUNCH
    a.ph_lo = 0; a.ph_hi = NPH;
    hipLaunchKernelGGL(fwd, dim3(grid), dim3(512), LDS_BYTES, stream, a);
#else
    for (int p = 0; p < NPH; ++p) {
        if (p >= 2 && ((p - 2) % 10) == 6 && ((((p - 2) / 10) & 1) == 0)) continue;
        a.ph_lo = p; a.ph_hi = p + 1;
        hipLaunchKernelGGL(fwd, dim3(grid), dim3(512), LDS_BYTES, stream, a);
    }
#endif
}
```

```cpp
#include <hip/hip_runtime.h>
#include <cstdio>
#include <cstdint>

#ifndef MK_ONE_LAUNCH
#define MK_ONE_LAUNCH 1
#endif

#ifndef DUP_MASK
#define DUP_MASK 0
#endif
#define PHASE_REP(k) for (int rep_ = 0; rep_ < 1 + ((DUP_MASK >> (k)) & 1); ++rep_)
#define LAS __attribute__((address_space(3)))
#define GAS __attribute__((address_space(1)))
typedef unsigned short bf16_t;
typedef short bf16x8 __attribute__((ext_vector_type(8)));
typedef float f32x4 __attribute__((ext_vector_type(4)));
typedef unsigned u32x4 __attribute__((ext_vector_type(4)));

constexpr int DM = 1024, SEQ = 16384, NCTX = 256, TT = SEQ + NCTX, DEPTH = 4;
constexpr int IN_COLS = 2608, NPIN = 2816, LDP = 2816;
constexpr int C_MQ = 0, C_MK = 256, C_MV = 512, C_MO = 768, C_AQ = 1024, C_AK = 1536, C_AV = 1664, C_GQ = 1792, C_GK = 1920, C_GV = 2048, C_GG = 2304, C_MG = 2560, C_GGT = 2576, C_END = 2608;
constexpr int DFF = 2816, DEXP = 3584, NEXP = 8;
constexpr int NCH = 260;
constexpr int NSLOT = 138 * 256;
constexpr float ALPHA = 1.6817928305074290f;
constexpr float LN_EPS = 1e-5f;
constexpr int NPH = 2 + 10 * DEPTH;

constexpr size_t al256(size_t x) { return (x + 255) & ~size_t(255); }
constexpr size_t WS_CTL = 0, CTL_BYTES = 2u << 20;
constexpr size_t WS_MODS = 1u << 20;
constexpr size_t WS_ROPE = CTL_BYTES;
constexpr size_t WS_TOKE = WS_ROPE + 32768;
constexpr size_t WS_TOKP = WS_TOKE + al256((size_t)TT * 8);
constexpr size_t WS_TOKW = WS_TOKP + al256((size_t)TT * 8);
constexpr size_t WS_TOKS = WS_TOKW + al256((size_t)TT * 8);
constexpr size_t WS_WIN = WS_TOKS + al256((size_t)TT * 8);
constexpr size_t WS_WOUT = WS_WIN + (size_t)DEPTH * NPIN * DM * 2;
constexpr size_t WS_FGU = WS_WOUT + (size_t)DEPTH * DM * DM * 2;
constexpr size_t WS_FDN = WS_FGU + (size_t)2 * 2 * DFF * DM * 2;
constexpr size_t WS_MGU = WS_FDN + (size_t)2 * DM * DFF * 2;
constexpr size_t WS_MDN = WS_MGU + (size_t)16 * 2 * DEXP * DM * 2;
constexpr size_t WS_X = WS_MDN + (size_t)16 * DM * DEXP * 2;
constexpr size_t WS_H = WS_X + (size_t)TT * DM * 4;
constexpr size_t WS_P = WS_H + (size_t)TT * DM * 2;
constexpr size_t WS_G = WS_P + (size_t)TT * LDP * 2;
constexpr size_t WS_CAT = WS_G + al256((size_t)TT * 48 * 4);
constexpr size_t WS_Y = WS_CAT + (size_t)TT * DM * 2;
constexpr size_t WS_ACT = WS_Y + (size_t)TT * DM * 4;
constexpr size_t WS_XB = WS_ACT + (size_t)NSLOT * DEXP * 2;
constexpr size_t WS_YS = WS_XB + (size_t)NSLOT * DM * 2;
constexpr size_t WS_MU = WS_YS + (size_t)NSLOT * DM * 4;
constexpr size_t WS_MC = WS_MU + (size_t)8 * NCH * 4096 * 4;
constexpr size_t WS_MNU = WS_MC + (size_t)8 * NCH * 4096 * 4;
constexpr size_t WS_MNS = WS_MNU + (size_t)8 * NCH * 64 * 4;
constexpr size_t WS_MSC = WS_MNS + (size_t)8 * NCH * 64 * 4;
constexpr size_t WS_GU = WS_MSC + al256((size_t)8 * NCH * 4 * 4);
constexpr size_t WS_GS = WS_GU + (size_t)8 * NCH * 2048 * 4;
constexpr size_t WS_GDEC = WS_GS + (size_t)8 * NCH * 2048 * 4;
constexpr size_t WS_YP = WS_GDEC + (size_t)8 * NCH * 32 * 4;
constexpr size_t WS_END = WS_YP + (size_t)256 * 256 * 256 * 4;

constexpr int CW_BAR = 4096;
constexpr int CW_MOE = 16384;

constexpr int LDS_BYTES = 147456, MISC_OFF = 147200;

__device__ __forceinline__ float bf2f(unsigned v) { return __uint_as_float(v << 16); }
__device__ __forceinline__ unsigned f2bf(float f) { unsigned u = __float_as_uint(f); return (u + 0x7fffu + ((u >> 16) & 1u)) >> 16; }
__device__ __forceinline__ unsigned pk2(float lo, float hi) { return f2bf(lo) | (f2bf(hi) << 16); }
__device__ __forceinline__ void load8bf(const bf16_t* p, float* o) {
    const uint4 v = *(const uint4*)p;
    o[0] = __uint_as_float(v.x << 16); o[1] = __uint_as_float(v.x & 0xffff0000u); o[2] = __uint_as_float(v.y << 16); o[3] = __uint_as_float(v.y & 0xffff0000u);
    o[4] = __uint_as_float(v.z << 16); o[5] = __uint_as_float(v.z & 0xffff0000u); o[6] = __uint_as_float(v.w << 16); o[7] = __uint_as_float(v.w & 0xffff0000u);
}
__device__ __forceinline__ float wave_sum(float v) {
#pragma unroll
    for (int o = 1; o < 64; o <<= 1) v += __shfl_xor(v, o);
    return v;
}
__device__ __forceinline__ float wave_max(float v) {
#pragma unroll
    for (int o = 1; o < 64; o <<= 1) v = fmaxf(v, __shfl_xor(v, o));
    return v;
}
__device__ __forceinline__ float scan_add(float v, int lane) {
#pragma unroll
    for (int o = 1; o < 64; o <<= 1) { const float t = __shfl_up(v, o); if (lane >= o) v += t; }
    return v;
}
__device__ __forceinline__ float scan_max(float v, int lane) {
#pragma unroll
    for (int o = 1; o < 64; o <<= 1) { const float t = __shfl_up(v, o); if (lane >= o) v = fmaxf(v, t); }
    return v;
}
__device__ __forceinline__ float siluf(float x) { return x * __builtin_amdgcn_rcpf(1.f + __expf(-x)); }
__device__ __forceinline__ float sigmoidf_(float x) { return __builtin_amdgcn_rcpf(1.f + __expf(-x)); }
__device__ __forceinline__ float log_sigmoidf_(float x) { return fminf(x, 0.f) - log1pf(__expf(-fabsf(x))); }
typedef short s16x4 __attribute__((ext_vector_type(4)));
typedef short v4i16_t __attribute__((ext_vector_type(4)));
typedef float f32x2_t __attribute__((ext_vector_type(2))); typedef __bf16 bf16x2_t __attribute__((ext_vector_type(2)));
__device__ __forceinline__ unsigned cvtpk(float lo, float hi) { f32x2_t v = {lo, hi}; bf16x2_t b = __builtin_convertvector(v, bf16x2_t); return __builtin_bit_cast(unsigned, b); }
__device__ __forceinline__ s16x4 ds_tr16(const LAS unsigned char* p) { return __builtin_bit_cast(s16x4, __builtin_amdgcn_ds_read_tr16_b64_v4i16((LAS v4i16_t*)p)); }
__device__ __forceinline__ bf16x8 cat44(s16x4 a, s16x4 b) { return __builtin_shufflevector(a, b, 0, 1, 2, 3, 4, 5, 6, 7); }
#define MFMA16(a, b, c) __builtin_amdgcn_mfma_f32_16x16x32_bf16(a, b, c, 0, 0, 0)
#define LDS_WAIT() asm volatile("s_waitcnt lgkmcnt(0)" ::: "memory")

namespace pg8 {
constexpr int BM = 256, BK = 64, HALF = 128, HTB = HALF * BK * 2, STAGE_BYTES = 8 * HTB, NXCD = 8, WGM = 8;
__host__ __device__ __forceinline__ int lds_byte(int r, int c) { const int st = (r >> 4) * 2 + (c >> 5), rr = r & 15, cc = c & 31, ob = rr * 64 + cc * 2; return st * 1024 + (ob ^ (((ob >> 9) & 1) << 5)); }
__host__ __device__ __forceinline__ void stage_rc(int b, int& R, int& C) { const int st = b / 1024, sb = b % 1024, swz = sb ^ (((sb >> 9) & 1) << 5); R = (st >> 1) * 16 + swz / 64; C = (st & 1) * 32 + (swz % 64) / 2; }
__host__ __device__ __forceinline__ int perm32(int rho) { const int n = rho >> 4, i = rho & 15; return 8 * (i >> 2) + 4 * n + (i & 3); }
struct Unit { int pm, pn, kt0, nkt, part; };

struct StaticOrder {
    const char* A; const char* Bt; int K;
    int nM, nN, nwg, G, c;
    __device__ void init(const void* A_, const void* Bt_, int K_, int M, int N, int G_, int c_) { A = (const char*)A_; Bt = (const char*)Bt_; K = K_; nM = M / BM; nN = N / BM; nwg = nM * nN; G = G_; c = c_; }
    __device__ __forceinline__ bool next(int i, Unit& u) const {
        const long L = (long)i * G + c; if (L >= nwg) return false;
        int wgid = (int)L; { const int q = nwg / NXCD, r = nwg % NXCD, xcd = wgid % NXCD, off = wgid / NXCD; wgid = (xcd < r ? xcd * (q + 1) : r * (q + 1) + (xcd - r) * q) + off; }
        const int nig = WGM * nN, gid = wgid / nig, fm = gid * WGM, gsz = (nM - fm) < WGM ? (nM - fm) : WGM;
        u.pm = fm + ((wgid % nig) % gsz); u.pn = (wgid % nig) / gsz; u.kt0 = 0; u.nkt = K / BK; u.part = -1; return true;
    }
    __device__ __forceinline__ const char* aptr(const Unit& u) const { return A + (size_t)u.pm * BM * K * 2; }
    __device__ __forceinline__ const char* bptr(const Unit& u) const { return Bt + (size_t)u.pn * BM * K * 2; }
};
struct MoeOrder {
    const char* A; const char* Bt; int K, N, nN, ntile, G, c;
    int ts1, ts2, ts3, ts4, ts5, ts6, ts7;
    __device__ __forceinline__ bool next(int i, Unit& u) const {
        const long L = (long)i * G + c; if (L >= (long)ntile * nN) return false;
        u.pm = (int)(L / nN); u.pn = (int)(L % nN); u.kt0 = 0; u.nkt = K / BK; u.part = -1; return true;
    }
    __device__ __forceinline__ int expert(int pm) const { return (pm >= ts1) + (pm >= ts2) + (pm >= ts3) + (pm >= ts4) + (pm >= ts5) + (pm >= ts6) + (pm >= ts7); }
    __device__ __forceinline__ const char* aptr(const Unit& u) const { return A + (size_t)u.pm * BM * K * 2; }
    __device__ __forceinline__ const char* bptr(const Unit& u) const { return Bt + ((size_t)expert(u.pm) * N + (size_t)u.pn * BM) * K * 2; }
};

struct TailOrder {
    const char* A; const char* Bt; int K, N, nN, npan, G, c, tp, s;
    int ts1, ts2, ts3, ts4, ts5, ts6, ts7;
    __device__ __forceinline__ void dense(const void* A_, const void* Bt_, int K_, int N_, int npan_, int G_, int c_, int tp_, int s_) {
        A = (const char*)A_; Bt = (const char*)Bt_; K = K_; N = N_; nN = N_ / BM; npan = npan_; G = G_; c = c_; tp = tp_; s = s_;
        ts1 = ts2 = ts3 = ts4 = ts5 = ts6 = ts7 = 0x7fffffff; }
    __device__ __forceinline__ bool next(int i, Unit& u) const {
        const int L = i * G + c, nfull = (npan - tp) * nN, ksub = (K / BK) / s;
        const bool tail = L >= nfull; const int j = L - nfull, tu = tp * nN, tu1 = tu > 0 ? tu : 1;
        const int part = tail ? j / tu1 : -1, r = tail ? j % tu1 : 0;
        u.part = part; u.pm = tail ? (npan - tp) + r / nN : L / nN; u.pn = tail ? r % nN : L % nN; u.kt0 = tail ? part * ksub : 0; u.nkt = tail ? ksub : K / BK;
        return tail ? (j < tu * s) : true;
    }
    __device__ __forceinline__ int expert(int pm) const { return (pm >= ts1) + (pm >= ts2) + (pm >= ts3) + (pm >= ts4) + (pm >= ts5) + (pm >= ts6) + (pm >= ts7); }
    __device__ __forceinline__ const char* aptr(const Unit& u) const { return A + ((size_t)u.pm * BM * K + (size_t)u.kt0 * BK) * 2; }
    __device__ __forceinline__ const char* bptr(const Unit& u) const { return Bt + (((size_t)expert(u.pm) * N + (size_t)u.pn * BM) * K + (size_t)u.kt0 * BK) * 2; }
};
__device__ __forceinline__ void tail_params(int npan, int nN, int nkt, int G, int& tp, int& s) {
    const int rem = (npan * nN) % G;
    tp = 0; s = 1;
    if (rem == 0 || (rem % nN) != 0) return;
    int best = 1;
    if (nkt == 16) { if (rem * 4 <= G) best = 4; else if (rem * 2 <= G) best = 2; }
    else if (nkt == 44) { if (rem * 11 <= G) best = 11; else if (rem * 2 <= G) best = 2; }
    else if (nkt == 56) { if (rem * 14 <= G) best = 14; else if (rem * 7 <= G) best = 7; else if (rem * 4 <= G) best = 4; else if (rem * 2 <= G) best = 2; }
    if (best > 1) { tp = rem / nN; s = best; }
}

template <class Epi, class Sched>
__device__ __forceinline__ void gemm_phase(LAS unsigned char* lds, const int K, const Sched& S, const Epi& E, const int tid) {
    const int wid = __builtin_amdgcn_readfirstlane(tid >> 6), lane = tid & 63, wr = wid >> 2, wc = wid & 3, fr = lane & 15, fq = lane >> 4;
    unsigned voffA[2], voffB[2];
#pragma unroll
    for (int i = 0; i < 2; ++i) { int R, C; stage_rc(tid * 16 + i * 8192, R, C); const int Rb = Epi::PERM ? ((R & ~31) + perm32(R & 31)) : R;
        voffA[i] = (unsigned)(R * K + C) * 2u; voffB[i] = (unsigned)(Rb * K + C) * 2u; }
    const size_t kstep = (size_t)(BK * 2);
    const size_t hstep = (size_t)HALF * K * 2;
    const unsigned ldsw = (unsigned)wid * 1024u;
    const int aoff = lds_byte(wr * 64 + fr, fq * 8), boff = lds_byte(wc * 32 + fr, fq * 8);
#define PG8_SA(b, h) (((b) * 2 + (h)) * HTB)
#define PG8_SB(b, h) ((4 + (b) * 2 + (h)) * HTB)
#define PG8_STAGE(bufoff, gbase, voff) do { _Pragma("unroll") for (int _i = 0; _i < 2; ++_i) \
        __builtin_amdgcn_global_load_lds((const GAS unsigned*)((const GAS char*)(gbase) + (voff)[_i]), (LAS unsigned*)(lds + (bufoff) + ldsw + _i * 8192), 16, 0, 0); } while (0)
#define PG8_LDA(dst, b, h) do { _Pragma("unroll") for (int m = 0; m < 4; ++m) _Pragma("unroll") for (int k = 0; k < 2; ++k) dst[m][k] = *(const LAS bf16x8*)(lds + PG8_SA(b, h) + aoff + m * 2048 + k * 1024); } while (0)
#define PG8_LDB(dst, b, h) do { _Pragma("unroll") for (int n = 0; n < 2; ++n) _Pragma("unroll") for (int k = 0; k < 2; ++k) dst[n][k] = *(const LAS bf16x8*)(lds + PG8_SB(b, h) + boff + n * 2048 + k * 1024); } while (0)
#define PG8_MMA(ai, bj, At, Bt) do { __builtin_amdgcn_s_setprio(1); _Pragma("unroll") for (int m = 0; m < 4; ++m) _Pragma("unroll") for (int n = 0; n < 2; ++n) _Pragma("unroll") for (int k = 0; k < 2; ++k) \
        acc[ai][bj][m][n] = __builtin_amdgcn_mfma_f32_16x16x32_bf16(Bt[n][k], At[m][k], acc[ai][bj][m][n], 0, 0, 0); __builtin_amdgcn_s_setprio(0); } while (0)
#define PG8_WAIT_V(n) asm volatile("s_waitcnt vmcnt(" #n ")" ::: "memory")
#define PG8_WAIT_L(n) asm volatile("s_waitcnt lgkmcnt(" #n ")" ::: "memory")
#define PG8_BAR __builtin_amdgcn_s_barrier()
#define PG8_SCHED __builtin_amdgcn_sched_barrier(0)
    Unit cur, nxt; int ui = 0;
    if (!S.next(0, cur)) return;
    f32x4 acc[2][2][4][2];
#pragma unroll
    for (int a = 0; a < 2; ++a)
#pragma unroll
        for (int b = 0; b < 2; ++b)
#pragma unroll
            for (int m = 0; m < 4; ++m)
#pragma unroll
                for (int n = 0; n < 2; ++n) acc[a][b][m][n] = (f32x4){0.f, 0.f, 0.f, 0.f};
    bf16x8 At[4][2], B0[2][2], B1[2][2];
    const char* cA = S.aptr(cur); const char* cB = S.bptr(cur);
    PG8_STAGE(PG8_SB(0, 0), cB, voffB); PG8_STAGE(PG8_SB(0, 1), cB + hstep, voffB); PG8_STAGE(PG8_SA(0, 0), cA, voffA); PG8_STAGE(PG8_SA(0, 1), cA + hstep, voffA);
    if (wr == 1) PG8_BAR;
    PG8_WAIT_V(2); PG8_BAR;
    PG8_STAGE(PG8_SB(1, 0), cB + kstep, voffB); PG8_STAGE(PG8_SA(1, 0), cA + kstep, voffA); PG8_STAGE(PG8_SB(1, 1), cB + hstep + kstep, voffB);
    PG8_WAIT_V(6); PG8_BAR;
    for (;;) {
        const bool has_next = S.next(ui + 1, nxt);
        const char* nA = has_next ? S.aptr(nxt) : cA; const char* nB = has_next ? S.bptr(nxt) : cB;
        const int nt = cur.nkt;
        for (int t = 0; t < nt; t += 2) {
            const bool last = (t == nt - 2);
            const char* a1 = cA + (size_t)(t + 1) * kstep;
            const char* a2 = last ? nA : cA + (size_t)(t + 2) * kstep; const char* b2 = last ? nB : cB + (size_t)(t + 2) * kstep;
            const char* a3 = a2 + kstep; const char* b3 = b2 + kstep;
            PG8_LDB(B0, 0, 0); PG8_LDB(B1, 0, 1); PG8_SCHED; PG8_LDA(At, 0, 0); PG8_STAGE(PG8_SA(1, 1), a1 + hstep, voffA);
            PG8_WAIT_V(8); PG8_WAIT_L(0); PG8_BAR; PG8_MMA(0, 0, At, B0); PG8_MMA(0, 1, At, B1); PG8_BAR; PG8_SCHED;
            PG8_LDA(At, 0, 1); PG8_STAGE(PG8_SB(0, 0), b2, voffB); PG8_STAGE(PG8_SB(0, 1), b2 + hstep, voffB); PG8_STAGE(PG8_SA(0, 0), a2, voffA);
            PG8_WAIT_V(8); PG8_WAIT_L(0); PG8_BAR; PG8_MMA(1, 0, At, B0); PG8_MMA(1, 1, At, B1); PG8_BAR; PG8_SCHED;
            PG8_LDB(B0, 1, 0); PG8_LDB(B1, 1, 1); PG8_SCHED; PG8_LDA(At, 1, 0); PG8_STAGE(PG8_SA(0, 1), a2 + hstep, voffA);
            PG8_WAIT_V(8); PG8_WAIT_L(0); PG8_BAR; PG8_MMA(0, 0, At, B0); PG8_MMA(0, 1, At, B1); PG8_BAR; PG8_SCHED;
            PG8_LDA(At, 1, 1); PG8_STAGE(PG8_SB(1, 0), b3, voffB); PG8_STAGE(PG8_SB(1, 1), b3 + hstep, voffB); PG8_STAGE(PG8_SA(1, 0), a3, voffA);
            PG8_WAIT_V(8); PG8_WAIT_L(0); PG8_BAR; PG8_MMA(1, 0, At, B0); PG8_MMA(1, 1, At, B1); PG8_BAR; PG8_SCHED;
        }
        if (wr == 0) PG8_BAR;
        { int fr_ = fr, fq_ = fq; asm volatile("" : "+v"(fr_), "+v"(fq_));
          E(acc, cur, wr, wc, fr_, fq_); }
        if (!has_next) break;
#pragma unroll
        for (int a = 0; a < 2; ++a)
#pragma unroll
            for (int b = 0; b < 2; ++b)
#pragma unroll
                for (int m = 0; m < 4; ++m)
#pragma unroll
                    for (int n = 0; n < 2; ++n) acc[a][b][m][n] = (f32x4){0.f, 0.f, 0.f, 0.f};
        cur = nxt; cA = nA; cB = nB; ++ui;
        if (wr == 1) PG8_BAR;
    }
    PG8_WAIT_V(0);
    PG8_BAR;
#undef PG8_SA
#undef PG8_SB
#undef PG8_STAGE
#undef PG8_LDA
#undef PG8_LDB
#undef PG8_MMA
#undef PG8_WAIT_V
#undef PG8_WAIT_L
#undef PG8_BAR
#undef PG8_SCHED
}


struct EpiInProj {
    static constexpr bool PERM = true;
    bf16_t* P; float* Gt; const float* ropeC; const float* ropeS;
    __device__ __forceinline__ void operator()(const f32x4 (&acc)[2][2][4][2], const Unit& u, int wr, int wc, int fr, int fq) const {
        const int row0 = u.pm * BM + wr * 64 + fr;
        const bool latent = u.pm < (SEQ / BM);
#pragma unroll
        for (int bj = 0; bj < 2; ++bj) {
            const int colg = u.pn * BM + bj * HALF + wc * 32;
            const bool rope = latent && colg >= C_AQ && colg < C_AV;
            const bool gate = colg >= C_MG && colg < C_END;
            const int col0 = colg + 8 * fq;
#pragma unroll
            for (int ai = 0; ai < 2; ++ai)
#pragma unroll
                for (int m = 0; m < 4; ++m) {
                    const int row = row0 + ai * HALF + m * 16;
                    f32x4 v0 = acc[ai][bj][m][0], v1 = acc[ai][bj][m][1];
                    if (rope) {
                        const int pos = ((colg >> 5) & 1) ? (row & 63) : (row >> 6);
                        const f32x4 c0 = *(const f32x4*)(ropeC + pos * 16 + 8 * (fq & 1)), c1 = *(const f32x4*)(ropeC + pos * 16 + 8 * (fq & 1) + 4);
                        const f32x4 s0 = *(const f32x4*)(ropeS + pos * 16 + 8 * (fq & 1)), s1 = *(const f32x4*)(ropeS + pos * 16 + 8 * (fq & 1) + 4);
                        const float sg = (fq < 2) ? -1.f : 1.f;
                        f32x4 p0, p1;
#pragma unroll
                        for (int i = 0; i < 4; ++i) { p0[i] = __shfl_xor(v0[i], 32); p1[i] = __shfl_xor(v1[i], 32); }
#pragma unroll
                        for (int i = 0; i < 4; ++i) { v0[i] = v0[i] * c0[i] + sg * p0[i] * s0[i]; v1[i] = v1[i] * c1[i] + sg * p1[i] * s1[i]; }
                    }
                    u32x4 w; w.x = cvtpk(v0[0], v0[1]); w.y = cvtpk(v0[2], v0[3]); w.z = cvtpk(v1[0], v1[1]); w.w = cvtpk(v1[2], v1[3]);
                    *(u32x4*)(P + (size_t)row * LDP + col0) = w;
                    if (gate && col0 < C_END) { float* g = Gt + (size_t)row * 48 + (col0 - C_MG); *(f32x4*)g = v0; *(f32x4*)(g + 4) = v1; }
                    asm volatile("" ::: "memory");
                }
        }
    }
};
struct EpiResid {
    static constexpr bool PERM = false;
    const float* X; float* Y; const float* modl; const float* modc; float* YP; int tail_row0, tail_rows;
    __device__ __forceinline__ void operator()(const f32x4 (&acc)[2][2][4][2], const Unit& u, int wr, int wc, int fr, int fq) const {
        const int row0 = u.pm * BM + wr * 64 + fr, col0 = u.pn * BM + wc * 32 + 4 * fq;
        if (u.part >= 0) {
#pragma unroll
            for (int ai = 0; ai < 2; ++ai)
#pragma unroll
                for (int m = 0; m < 4; ++m) { float* rowp = YP + ((size_t)u.part * tail_rows + (row0 + ai * HALF + m * 16 - tail_row0)) * DM + col0;
#pragma unroll
                    for (int bj = 0; bj < 2; ++bj)
#pragma unroll
                        for (int n = 0; n < 2; ++n) *(f32x4*)(rowp + bj * HALF + n * 16) = acc[ai][bj][m][n]; }
            return;
        }
        const float* md = (u.pm < SEQ / BM) ? modl : modc;
        f32x4 mv[2][2];
#pragma unroll
        for (int bj = 0; bj < 2; ++bj)
#pragma unroll
            for (int n = 0; n < 2; ++n) mv[bj][n] = *(const f32x4*)(md + col0 + bj * HALF + n * 16);
#pragma unroll
        for (int ai = 0; ai < 2; ++ai)
#pragma unroll
            for (int m = 0; m < 4; ++m) { const size_t off = (size_t)(row0 + ai * HALF + m * 16) * DM + col0;
#pragma unroll
                for (int bj = 0; bj < 2; ++bj)
#pragma unroll
                    for (int n = 0; n < 2; ++n) { const f32x4 xv = *(const f32x4*)(X + off + bj * HALF + n * 16);
                        *(f32x4*)(Y + off + bj * HALF + n * 16) = xv * ALPHA + mv[bj][n] * acc[ai][bj][m][n]; }
                asm volatile("" ::: "memory"); }
    }
};
struct EpiSwiglu {
    static constexpr bool PERM = true;
    bf16_t* O; int ld;
    __device__ __forceinline__ void operator()(const f32x4 (&acc)[2][2][4][2], const Unit& u, int wr, int wc, int fr, int fq) const {
        const int row0 = u.pm * BM + wr * 64 + fr, col0 = u.pn * HALF + wc * 32 + 8 * fq;
#pragma unroll
        for (int ai = 0; ai < 2; ++ai)
#pragma unroll
            for (int m = 0; m < 4; ++m) {
                const f32x4 g0 = acc[ai][0][m][0], g1 = acc[ai][0][m][1], u0 = acc[ai][1][m][0], u1 = acc[ai][1][m][1];
                float r[8];
#pragma unroll
                for (int i = 0; i < 4; ++i) { r[i] = siluf(g0[i]) * u0[i]; r[4 + i] = siluf(g1[i]) * u1[i]; }
                u32x4 w; w.x = cvtpk(r[0], r[1]); w.y = cvtpk(r[2], r[3]); w.z = cvtpk(r[4], r[5]); w.w = cvtpk(r[6], r[7]);
                *(u32x4*)(O + (size_t)(row0 + ai * HALF + m * 16) * ld + col0) = w;
            }
    }
};
struct EpiF32 {
    static constexpr bool PERM = false;
    float* C; float* YP; int tail_row0, tail_rows;
    __device__ __forceinline__ void operator()(const f32x4 (&acc)[2][2][4][2], const Unit& u, int wr, int wc, int fr, int fq) const {
        const int row0 = u.pm * BM + wr * 64 + fr, col0 = u.pn * BM + wc * 32 + 4 * fq;
        float* base = (u.part >= 0) ? YP + ((size_t)u.part * tail_rows - tail_row0) * DM : C;
#pragma unroll
        for (int ai = 0; ai < 2; ++ai)
#pragma unroll
            for (int m = 0; m < 4; ++m) { float* rowp = base + (size_t)(row0 + ai * HALF + m * 16) * DM + col0;
#pragma unroll
                for (int bj = 0; bj < 2; ++bj)
#pragma unroll
                    for (int n = 0; n < 2; ++n) *(f32x4*)(rowp + bj * HALF + n * 16) = acc[ai][bj][m][n]; }
    }
};
}

#define XB_TMO      128
#define XB_XCNT(j)  (256  + 64 * (j))
#define XB_XSUB(j)  (1280 + 64 * (j))
#define XB_XGEN(j)  (2304 + 64 * (j))
#define XB_TOP      3328
#define XB_TOPGEN   3392
#define XCD_BAR_WORDS 3456
#define XB_SPIN_CAP (1u << 18)
__device__ __forceinline__ unsigned xb_ld(unsigned* p)              { return __hip_atomic_load(p, __ATOMIC_RELAXED, __HIP_MEMORY_SCOPE_AGENT); }
__device__ __forceinline__ unsigned xb_add(unsigned* p, unsigned v) { return __hip_atomic_fetch_add(p, v, __ATOMIC_RELAXED, __HIP_MEMORY_SCOPE_AGENT); }
__device__ __forceinline__ unsigned xb_xcc_id() { return (unsigned)__builtin_amdgcn_s_getreg((3 << 11) | 20) & 0xFu; }
#define XB_SPIN(cond, bar) do { unsigned _sp = 0; while (cond) { __builtin_amdgcn_s_sleep(1); \
    if ((++_sp & 255u) == 0u) { if (xb_ld(&(bar)[XB_TMO])) break; if (_sp > XB_SPIN_CAP) { atomicAdd(&(bar)[XB_TMO], 1u); break; } } } } while (0)
struct XcdBarrier { unsigned* bar; unsigned x; volatile LAS unsigned* st; };
__device__ __forceinline__ XcdBarrier xcd_barrier_post(unsigned* bar, volatile LAS unsigned* st) {
    XcdBarrier b; b.bar = bar; b.x = xb_xcc_id(); b.st = st;
    if (threadIdx.x == 0) (void)xb_add(&bar[XB_XCNT(b.x)], 1u);
    return b;
}
__device__ __forceinline__ void xcd_barrier_complete(unsigned* bar, unsigned x, unsigned& nloc, unsigned& nx) {
    const unsigned G = gridDim.x * gridDim.y * gridDim.z;
    unsigned sum, cnt, mine, sp = 0u;
    for (;;) {
        sum = 0u; cnt = 0u; mine = 0u;
#pragma unroll
        for (unsigned j = 0; j < 16; ++j) { const unsigned c = xb_ld(&bar[XB_XCNT(j)]); sum += c; cnt += (c > 0u) ? 1u : 0u; mine = (j == x) ? c : mine; }
        if (sum == G) break;
        __builtin_amdgcn_s_sleep(1);
        if ((++sp & 255u) == 0u) { if (xb_ld(&bar[XB_TMO])) break; if (sp > XB_SPIN_CAP) { atomicAdd(&bar[XB_TMO], 1u); break; } }
    }
    nloc = mine > 0u ? mine : 1u; nx = cnt > 0u ? cnt : 1u;
}
__device__ __forceinline__ void xcd_barrier(const XcdBarrier& b) {
    asm volatile("s_waitcnt vmcnt(0)" ::: "memory");
    __syncthreads();
    if (threadIdx.x == 0) {
        unsigned* bar = b.bar;
        __builtin_amdgcn_s_waitcnt(0);
        unsigned nloc = b.st[0], nx = b.st[1];
        if (nloc == 0u) { xcd_barrier_complete(bar, b.x, nloc, nx); b.st[0] = nloc; b.st[1] = nx; }
        const unsigned old = xb_add(&bar[XB_XSUB(b.x)], 1u);
        const unsigned gen = old / nloc;
        if (old + 1u == (gen + 1u) * nloc) {
            __builtin_amdgcn_fence(__ATOMIC_RELEASE, "agent");
            asm volatile("s_waitcnt vmcnt(0)" ::: "memory");
            const unsigned og = xb_add(&bar[XB_TOP], 1u);
            const unsigned tg = og / nx;
            if (og + 1u == (tg + 1u) * nx) xb_add(&bar[XB_TOPGEN], 1u);
            else XB_SPIN(xb_ld(&bar[XB_TOPGEN]) == tg, bar);
            __builtin_amdgcn_fence(__ATOMIC_ACQUIRE, "agent");
            xb_add(&bar[XB_XGEN(b.x)], 1u);
            asm volatile("s_waitcnt vmcnt(0)" ::: "memory");
        } else {
            XB_SPIN(xb_ld(&bar[XB_XGEN(b.x)]) == gen, bar);
            __builtin_amdgcn_fence(__ATOMIC_ACQUIRE, "agent");
            asm volatile("s_waitcnt vmcnt(0)" ::: "memory");
        }
    }
    __syncthreads();
}

struct Args { const float* in[22]; float* out; unsigned char* ws; int ph_lo, ph_hi; };

__device__ __forceinline__ int in_srccol(int r, float& sc) {
    sc = 1.f;
    if (r < 1024) { if (r >= C_MK && r < C_MV) sc = 0.125f; return r; }
    if (r < C_MG) { if (r < C_AK) sc = 0.125f; else if (r >= C_GQ && r < C_GK) sc = 0.17677669529663687f; return r + 16; }
    if (r < C_GGT) return r - C_MG + 1024;
    if (r < C_END) return r;
    return -1;
}
__device__ __forceinline__ void tr_item(const float* W, int K, int N, int NP, bf16_t* WT, int mode, int half, LAS float* scr, int item, int lane) {
    const int nblk = NP >> 6, kb = item / nblk, nb = item - kb * nblk, k0 = kb << 6, n0 = nb << 6;
    const int r = n0 + lane; float sc = 1.f; int src;
    if (mode == 0) src = r; else if (mode == 1) src = in_srccol(r, sc); else { const int pn = r >> 8, w = r & 255; src = (w < 128) ? (pn * 128 + w) : (half + pn * 128 + w - 128); }
    const float* wp = W + (size_t)k0 * N + (src < 0 ? 0 : src);
#pragma unroll 16
    for (int i = 0; i < 64; ++i) { const float v = wp[(size_t)i * N]; scr[i * 65 + lane] = (src < 0) ? 0.f : v * sc; }
    LDS_WAIT();
    const int c = lane & 7;
#pragma unroll
    for (int j = 0; j < 8; ++j) { const int n = (lane >> 3) + 8 * j; const LAS float* s = scr + (8 * c) * 65 + n;
        uint4 o; o.x = pk2(s[0], s[65]); o.y = pk2(s[130], s[195]); o.z = pk2(s[260], s[325]); o.w = pk2(s[390], s[455]);
        *(uint4*)(WT + (size_t)(n0 + n) * K + k0 + 8 * c) = o; }
    LDS_WAIT();
}

__device__ __forceinline__ void chunk_rows(int d, int jc, int& base, int& step) {
    int oc;
    if (d == 0) oc = (jc < 4) ? 256 + jc : jc - 4; else oc = (jc < 4) ? 256 + (3 - jc) : 255 - (jc - 4);
    const int b0 = (oc < 256) ? oc * 64 : SEQ + (oc - 256) * 64;
    if (d == 0) { base = b0; step = 1; } else { base = b0 + 63; step = -1; }
}
__device__ __forceinline__ int oc_to_jc(int d, int oc) { if (d == 0) return oc < 256 ? oc + 4 : oc - 256; return oc < 256 ? 4 + (255 - oc) : 3 - (oc - 256); }

constexpr int AT_RS = 144, AT_TILE = 128 * AT_RS;
__device__ __forceinline__ void attn_unit(LAS unsigned char* lds, const bf16_t* P, bf16_t* CAT, int qb  , int cqb, int kvh, const float* sink, int tid, int lane, int wave) {
    const bool is_ctx = qb < 0;
    const int g = lane >> 4, i = lane & 15;
    const int hq = kvh * 4 + (wave >> 1), qh = wave & 1;
    const int qrow0 = (is_ctx ? SEQ + cqb * 128 : qb * 128) + qh * 64;
    bf16x8 bq[4][2];
#pragma unroll
    for (int qt = 0; qt < 4; ++qt)
#pragma unroll
        for (int ks = 0; ks < 2; ++ks) bq[qt][ks] = *(const bf16x8*)(P + (size_t)(qrow0 + 16 * qt + i) * LDP + C_AQ + hq * 64 + 32 * ks + 8 * g);
    f32x4 O[4][4];
#pragma unroll
    for (int dt = 0; dt < 4; ++dt)
#pragma unroll
        for (int qt = 0; qt < 4; ++qt) O[dt][qt] = (f32x4){0.f, 0.f, 0.f, 0.f};
    float m[4], l[4];
    { const float sk = sink[hq];
#pragma unroll
      for (int qt = 0; qt < 4; ++qt) { m[qt] = sk; l[qt] = (g == 0) ? 1.f : 0.f; } }
#define AT_VALID(c) ((c) >= 3 || (!is_ctx && (qb - 1 + (c)) >= 0 && (qb - 1 + (c)) < SEQ / 128))
#define AT_ROW(c) ((c) >= 3 ? SEQ + ((c) - 3) * 128 : (qb - 1 + (c)) * 128)
    u32x4 kreg[2], vreg[2];
    int c = 0; while (!AT_VALID(c)) ++c;
    __syncthreads();
#pragma unroll
    for (int t = 0; t < 2; ++t) { const int idx = tid + 512 * t, r = idx >> 3, ch = idx & 7; const bf16_t* src = P + (size_t)(AT_ROW(c) + r) * LDP + kvh * 64 + ch * 8;
        kreg[t] = *(const u32x4*)(src + C_AK); vreg[t] = *(const u32x4*)(src + C_AV); }
    int buf = 0;
#pragma unroll
    for (int t = 0; t < 2; ++t) { const int idx = tid + 512 * t, r = idx >> 3, ch = idx & 7; *(LAS u32x4*)(lds + r * AT_RS + ch * 16) = kreg[t]; *(LAS u32x4*)(lds + AT_TILE + r * AT_RS + ch * 16) = vreg[t]; }
    __syncthreads();
    while (c < 5) {
        int cn = c + 1; while (cn < 5 && !AT_VALID(cn)) ++cn;
        if (cn < 5) {
#pragma unroll
            for (int t = 0; t < 2; ++t) { const int idx = tid + 512 * t, r = idx >> 3, ch = idx & 7; const bf16_t* src = P + (size_t)(AT_ROW(cn) + r) * LDP + kvh * 64 + ch * 8;
                kreg[t] = *(const u32x4*)(src + C_AK); vreg[t] = *(const u32x4*)(src + C_AV); }
        }
        const LAS unsigned char* Kb = lds + buf * 2 * AT_TILE; const LAS unsigned char* Vb = Kb + AT_TILE;
        const bool lo_blk = (!is_ctx && c == 0), hi_blk = (!is_ctx && c == 2);
        for (int grp = 0; grp < 4; ++grp) {
            if (lo_blk && qh == 1 && grp < 2) continue;
            if (hi_blk && qh == 0 && grp >= 2) continue;
            bf16x8 kf[2][2], vf[4];
#pragma unroll
            for (int kt = 0; kt < 2; ++kt)
#pragma unroll
                for (int ks = 0; ks < 2; ++ks) kf[kt][ks] = *(const LAS bf16x8*)(Kb + (grp * 32 + kt * 16 + i) * AT_RS + (32 * ks + 8 * g) * 2);
#pragma unroll
            for (int dt = 0; dt < 4; ++dt) { const LAS unsigned char* vp = Vb + (grp * 32 + 4 * g + (i >> 2)) * AT_RS + (16 * dt + 4 * (i & 3)) * 2;
                vf[dt] = cat44(ds_tr16(vp), ds_tr16(vp + 16 * AT_RS)); }
#pragma unroll
            for (int qt = 0; qt < 4; ++qt) {
                f32x4 s0 = (f32x4){0.f, 0.f, 0.f, 0.f}, s1 = s0;
#pragma unroll
                for (int ks = 0; ks < 2; ++ks) { s0 = MFMA16(kf[0][ks], bq[qt][ks], s0); s1 = MFMA16(kf[1][ks], bq[qt][ks], s1); }
                if (lo_blk || hi_blk) {
                    const int qo = qh * 64 + qt * 16 + i, ko = grp * 32 + 4 * g;
#pragma unroll
                    for (int r = 0; r < 4; ++r) {
                        const bool v0 = lo_blk ? (ko + r >= qo) : (ko + r <= qo), v1 = lo_blk ? (ko + 16 + r >= qo) : (ko + 16 + r <= qo);
                        s0[r] = v0 ? s0[r] : -INFINITY; s1[r] = v1 ? s1[r] : -INFINITY; }
                }
                float mx = fmaxf(fmaxf(fmaxf(s0[0], s0[1]), fmaxf(s0[2], s0[3])), fmaxf(fmaxf(s1[0], s1[1]), fmaxf(s1[2], s1[3])));
                mx = fmaxf(mx, __shfl_xor(mx, 16)); mx = fmaxf(mx, __shfl_xor(mx, 32));
                const float mn = fmaxf(m[qt], mx), alpha = __expf(m[qt] - mn);
                m[qt] = mn;
                float ps = 0.f;
#pragma unroll
                for (int r = 0; r < 4; ++r) { s0[r] = __expf(s0[r] - mn); s1[r] = __expf(s1[r] - mn); ps += s0[r] + s1[r]; }
                l[qt] = l[qt] * alpha + ps;
                u32x4 pw; pw.x = cvtpk(s0[0], s0[1]); pw.y = cvtpk(s0[2], s0[3]); pw.z = cvtpk(s1[0], s1[1]); pw.w = cvtpk(s1[2], s1[3]);
                const bf16x8 pb = __builtin_bit_cast(bf16x8, pw);
#pragma unroll
                for (int dt = 0; dt < 4; ++dt) { O[dt][qt] = O[dt][qt] * alpha; O[dt][qt] = MFMA16(vf[dt], pb, O[dt][qt]); }
            }
        }
        if (cn < 5) {
            LAS unsigned char* nb = lds + (buf ^ 1) * 2 * AT_TILE;
#pragma unroll
            for (int t = 0; t < 2; ++t) { const int idx = tid + 512 * t, r = idx >> 3, ch = idx & 7; *(LAS u32x4*)(nb + r * AT_RS + ch * 16) = kreg[t]; *(LAS u32x4*)(nb + AT_TILE + r * AT_RS + ch * 16) = vreg[t]; }
        }
        __syncthreads();
        buf ^= 1; c = cn;
    }
#undef AT_VALID
#undef AT_ROW
#pragma unroll
    for (int qt = 0; qt < 4; ++qt) {
        float lt = l[qt]; lt += __shfl_xor(lt, 16); lt += __shfl_xor(lt, 32);
        const float inv = 1.f / lt;
        bf16_t* dst = CAT + (size_t)(qrow0 + 16 * qt + i) * DM + 256 + hq * 64 + 4 * g;
#pragma unroll
        for (int dt = 0; dt < 4; ++dt) { uint2 o; o.x = cvtpk(O[dt][qt][0] * inv, O[dt][qt][1] * inv); o.y = cvtpk(O[dt][qt][2] * inv, O[dt][qt][3] * inv); *(uint2*)(dst + 16 * dt) = o; }
    }
}

constexpr int CH_RS = 144;
constexpr int CH_T = 64 * CH_RS;
constexpr int GL_RS = 80;
constexpr int GL_T = 64 * GL_RS;
__device__ __forceinline__ int chunk_b0(int oc) { return (oc < 256) ? oc * 64 : SEQ + (oc - 256) * 64; }
__device__ __forceinline__ bf16x8 tr_frag(const LAS unsigned char* tile, int rs, int row0, int col0, int lane) {
    const int g = lane >> 4, i = lane & 15; const LAS unsigned char* p = tile + (row0 + 8 * g + (i >> 2)) * rs + (col0 + 4 * (i & 3)) * 2;
    return cat44(ds_tr16(p), ds_tr16(p + 4 * rs));
}
__device__ __forceinline__ bf16x8 tr_frag_perm(const LAS unsigned char* tile, int rs, int row0, int col0, int lane) {
    const int g = lane >> 4, i = lane & 15; const LAS unsigned char* p = tile + (row0 + 4 * g + (i >> 2)) * rs + (col0 + 4 * (i & 3)) * 2;
    return cat44(ds_tr16(p), ds_tr16(p + 16 * rs));
}
__device__ __forceinline__ void unpack8(const u32x4 v, float* o) {
    o[0] = __uint_as_float(v.x << 16); o[1] = __uint_as_float(v.x & 0xffff0000u); o[2] = __uint_as_float(v.y << 16); o[3] = __uint_as_float(v.y & 0xffff0000u);
    o[4] = __uint_as_float(v.z << 16); o[5] = __uint_as_float(v.z & 0xffff0000u); o[6] = __uint_as_float(v.w << 16); o[7] = __uint_as_float(v.w & 0xffff0000u);
}
__device__ __forceinline__ u32x4 pack8(const float* f) { u32x4 w; w.x = cvtpk(f[0], f[1]); w.y = cvtpk(f[2], f[3]); w.z = cvtpk(f[4], f[5]); w.w = cvtpk(f[6], f[7]); return w; }

__device__ __forceinline__ void mlstm_summary(LAS unsigned char* lds, const bf16_t* P, const float* Gt, const float* gate_b, float* MU, float* MNU, float* MSC, int h, int oc, int tid, int lane, int wave) {
    LAS unsigned char* Kw0 = lds; LAS unsigned char* Kw1 = lds + CH_T; LAS unsigned char* Vt = lds + 2 * CH_T; LAS float* wv = (LAS float*)(lds + 3 * CH_T);
    const int b0 = chunk_b0(oc);
    const int r = tid >> 3, ch = tid & 7;
    const u32x4 kraw = *(const u32x4*)(P + (size_t)(b0 + r) * LDP + C_MK + h * 64 + ch * 8), vraw = *(const u32x4*)(P + (size_t)(b0 + r) * LDP + C_MV + h * 64 + ch * 8);
    __syncthreads();
    if (wave < 2) {
        const int d = wave, sp = d ? 63 - lane : lane, row = b0 + sp, hd = h * 2 + d, jc = oc_to_jc(d, oc);
        const float ig = Gt[(size_t)row * 48 + d * 8 + h] + gate_b[d * 8 + h];
        const float fg = Gt[(size_t)row * 48 + d * 8 + 4 + h] + gate_b[d * 8 + 4 + h];
        const float lf = log_sigmoidf_(fg);
        const float bb = scan_add(lf, lane);
        const float av = ig - bb;
        const float cm = wave_max(av);
        const float B = __shfl(bb, 63);
        wv[d * 64 + sp] = __expf(av - cm);
        if (lane == 0) { MSC[(size_t)(hd * NCH + jc) * 4 + 0] = cm; MSC[(size_t)(hd * NCH + jc) * 4 + 1] = B; }
    }
    *(LAS u32x4*)(Vt + r * CH_RS + ch * 16) = vraw;
    __syncthreads();
    { float kf[8], t0[8], t1[8]; unpack8(kraw, kf); const float w0 = wv[r], w1 = wv[64 + r];
#pragma unroll
      for (int j = 0; j < 8; ++j) { t0[j] = kf[j] * w0; t1[j] = kf[j] * w1; }
      *(LAS u32x4*)(Kw0 + r * CH_RS + ch * 16) = pack8(t0); *(LAS u32x4*)(Kw1 + r * CH_RS + ch * 16) = pack8(t1); }
    __syncthreads();
    { const int d = wave >> 2, dkt = wave & 3, g = lane >> 4, i = lane & 15, hd = h * 2 + d, jc = oc_to_jc(d, oc);
      const LAS unsigned char* Kw = d ? Kw1 : Kw0;
      const bf16x8 a0 = tr_frag(Kw, CH_RS, 0, 16 * dkt, lane), a1 = tr_frag(Kw, CH_RS, 32, 16 * dkt, lane);
      float* dst = MU + ((size_t)(hd * 64 + 16 * dkt + i) * NCH + jc) * 64 + 4 * g;
#pragma unroll
      for (int dvt = 0; dvt < 4; ++dvt) {
          f32x4 c = (f32x4){0.f, 0.f, 0.f, 0.f};
          c = MFMA16(tr_frag(Vt, CH_RS, 0, 16 * dvt, lane), a0, c); c = MFMA16(tr_frag(Vt, CH_RS, 32, 16 * dvt, lane), a1, c);
          *(f32x4*)(dst + 16 * dvt) = c;
      }
      const short one = (i == 0) ? (short)0x3F80 : (short)0; const bf16x8 bo = (bf16x8){one, one, one, one, one, one, one, one};
      f32x4 c1 = (f32x4){0.f, 0.f, 0.f, 0.f}; c1 = MFMA16(a0, bo, c1); c1 = MFMA16(a1, bo, c1);
      if (i == 0) *(f32x4*)(MNU + (size_t)(hd * NCH + jc) * 64 + 16 * dkt + 4 * g) = c1; }
}

__device__ __forceinline__ void mlstm_out(LAS unsigned char* lds, const bf16_t* P, const float* Gt, const float* gate_b, const bf16_t* MC, const float* MNS, const float* MSC, const float* normw, bf16_t* CAT, int h, int oc, int tid, int lane, int wave) {
    LAS unsigned char* Qt = lds; LAS unsigned char* Kt = lds + CH_T; LAS unsigned char* Vt = lds + 2 * CH_T; LAS unsigned char* Ct = lds + 3 * CH_T;
    LAS float* arr = (LAS float*)(lds + 5 * CH_T);
    LAS f32x4* hs = (LAS f32x4*)(lds + 5 * CH_T + 2 * 320 * 4);
    const int b0 = chunk_b0(oc);
    const int r = tid >> 3, ch = tid & 7;
    const size_t ro = (size_t)(b0 + r) * LDP + h * 64 + ch * 8;
    const u32x4 qraw = *(const u32x4*)(P + ro + C_MQ), kraw = *(const u32x4*)(P + ro + C_MK), vraw = *(const u32x4*)(P + ro + C_MV);
    const int jc0 = oc_to_jc(0, oc), jc1 = oc_to_jc(1, oc);
    const u32x4 c0raw = *(const u32x4*)(MC + ((size_t)((h * 2 + 0) * 64 + r) * NCH + jc0) * 64 + ch * 8), c1raw = *(const u32x4*)(MC + ((size_t)((h * 2 + 1) * 64 + r) * NCH + jc1) * 64 + ch * 8);
    __syncthreads();
    if (wave < 2) {
        const int d = wave, sp = d ? 63 - lane : lane, row = b0 + sp, hd = h * 2 + d, jc = d ? jc1 : jc0;
        const float ig = Gt[(size_t)row * 48 + d * 8 + h] + gate_b[d * 8 + h];
        const float fg = Gt[(size_t)row * 48 + d * 8 + 4 + h] + gate_b[d * 8 + 4 + h];
        const float lf = log_sigmoidf_(fg);
        const float bb = scan_add(lf, lane);
        const float av = ig - bb;
        const float cm = scan_max(av, lane);
        const float mst = MSC[(size_t)(hd * NCH + jc) * 4 + 2];
        const float mx = fmaxf(mst, cm);
        LAS float* A = arr + d * 320;
        A[sp] = av; A[64 + sp] = mx; A[128 + sp] = __expf(mst - mx); A[192 + sp] = __expf(-(bb + mx));
        A[256 + lane] = MNS[(size_t)(hd * NCH + jc) * 64 + lane];
    }
    *(LAS u32x4*)(Qt + r * CH_RS + ch * 16) = qraw; *(LAS u32x4*)(Kt + r * CH_RS + ch * 16) = kraw; *(LAS u32x4*)(Vt + r * CH_RS + ch * 16) = vraw;
    *(LAS u32x4*)(Ct + r * CH_RS + ch * 16) = c0raw; *(LAS u32x4*)(Ct + CH_T + r * CH_RS + ch * 16) = c1raw;
    __syncthreads();
    const int d = wave >> 2, tt = wave & 3, g = lane >> 4, i = lane & 15, t = 16 * tt + i;
    f32x4 hh[4];
    {
        const LAS float* A = arr + d * 320;
        const float mxt = A[64 + t], wt = A[128 + t], emt = A[192 + t];
        bf16x8 bq[2], bqw[2]; float qn = 0.f;
#pragma unroll
        for (int ks = 0; ks < 2; ++ks) { const u32x4 raw = *(const LAS u32x4*)(Qt + t * CH_RS + (32 * ks + 8 * g) * 2); bq[ks] = __builtin_bit_cast(bf16x8, raw);
            float qf[8], qw[8]; unpack8(raw, qf);
            const f32x4 n0 = *(const LAS f32x4*)(A + 256 + 32 * ks + 8 * g), n1 = *(const LAS f32x4*)(A + 256 + 32 * ks + 8 * g + 4);
#pragma unroll
            for (int j = 0; j < 4; ++j) { qn += qf[j] * n0[j] + qf[4 + j] * n1[j]; }
#pragma unroll
            for (int j = 0; j < 8; ++j) qw[j] = qf[j] * wt;
            bqw[ks] = __builtin_bit_cast(bf16x8, pack8(qw)); }
        qn += __shfl_xor(qn, 16); qn += __shfl_xor(qn, 32);
        float dsum = 0.f; f32x4 sT[4];
#pragma unroll
        for (int st = 0; st < 4; ++st) {
            f32x4 c = (f32x4){0.f, 0.f, 0.f, 0.f};
#pragma unroll
            for (int ks = 0; ks < 2; ++ks) c = MFMA16(*(const LAS bf16x8*)(Kt + (16 * st + i) * CH_RS + (32 * ks + 8 * g) * 2), bq[ks], c);
            const f32x4 a4 = *(const LAS f32x4*)(A + 16 * st + 4 * g);
#pragma unroll
            for (int rr = 0; rr < 4; ++rr) { const int sidx = 16 * st + 4 * g + rr; const bool ok = d ? (sidx >= t) : (sidx <= t);
                const float val = ok ? c[rr] * __expf(a4[rr] - mxt) : 0.f; sT[st][rr] = val; dsum += val; }
        }
        dsum += __shfl_xor(dsum, 16); dsum += __shfl_xor(dsum, 32);
        const float den = dsum + wt * qn, inv = 1.f / fmaxf(fabsf(den), emt);
        bf16x8 pb[2];
#pragma unroll
        for (int gp = 0; gp < 2; ++gp) { u32x4 w; w.x = cvtpk(sT[2 * gp][0], sT[2 * gp][1]); w.y = cvtpk(sT[2 * gp][2], sT[2 * gp][3]); w.z = cvtpk(sT[2 * gp + 1][0], sT[2 * gp + 1][1]); w.w = cvtpk(sT[2 * gp + 1][2], sT[2 * gp + 1][3]); pb[gp] = __builtin_bit_cast(bf16x8, w); }
        const LAS unsigned char* Cd = Ct + d * CH_T;
#pragma unroll
        for (int dvt = 0; dvt < 4; ++dvt) {
            f32x4 c = (f32x4){0.f, 0.f, 0.f, 0.f};
            c = MFMA16(tr_frag_perm(Vt, CH_RS, 0, 16 * dvt, lane), pb[0], c); c = MFMA16(tr_frag_perm(Vt, CH_RS, 32, 16 * dvt, lane), pb[1], c);
            c = MFMA16(tr_frag(Cd, CH_RS, 0, 16 * dvt, lane), bqw[0], c); c = MFMA16(tr_frag(Cd, CH_RS, 32, 16 * dvt, lane), bqw[1], c);
            hh[dvt] = c * inv;
        }
        if (d == 1) {
#pragma unroll
            for (int dvt = 0; dvt < 4; ++dvt) hs[(tt * 4 + dvt) * 64 + lane] = hh[dvt];
        }
    }
    __syncthreads();
    if (d == 0) {
        float s1 = 0.f;
#pragma unroll
        for (int dvt = 0; dvt < 4; ++dvt) { hh[dvt] = hh[dvt] + hs[(tt * 4 + dvt) * 64 + lane]; s1 += (hh[dvt][0] + hh[dvt][1]) + (hh[dvt][2] + hh[dvt][3]); }
        s1 += __shfl_xor(s1, 16); s1 += __shfl_xor(s1, 32);
        const float mu = s1 * (1.f / 64.f); float s2 = 0.f;
#pragma unroll
        for (int dvt = 0; dvt < 4; ++dvt) { hh[dvt] = hh[dvt] - mu; s2 += (hh[dvt][0] * hh[dvt][0] + hh[dvt][1] * hh[dvt][1]) + (hh[dvt][2] * hh[dvt][2] + hh[dvt][3] * hh[dvt][3]); }
        s2 += __shfl_xor(s2, 16); s2 += __shfl_xor(s2, 32);
        const float rstd = rsqrtf(s2 * (1.f / 64.f) + LN_EPS);
        const int row = b0 + t;
#pragma unroll
        for (int dvt = 0; dvt < 4; ++dvt) { const int col = h * 64 + 16 * dvt + 4 * g;
            const uint2 og = *(const uint2*)(P + (size_t)row * LDP + C_MO + col); const f32x4 nw = *(const f32x4*)(normw + col);
            const float o0 = hh[dvt][0] * rstd * nw[0] * sigmoidf_(__uint_as_float(og.x << 16)), o1 = hh[dvt][1] * rstd * nw[1] * sigmoidf_(__uint_as_float(og.x & 0xffff0000u));
            const float o2 = hh[dvt][2] * rstd * nw[2] * sigmoidf_(__uint_as_float(og.y << 16)), o3 = hh[dvt][3] * rstd * nw[3] * sigmoidf_(__uint_as_float(og.y & 0xffff0000u));
            uint2 o; o.x = cvtpk(o0, o1); o.y = cvtpk(o2, o3); *(uint2*)(CAT + (size_t)row * DM + col) = o; }
    }
}

__device__ __forceinline__ void gla_gates_wave(const float* Gt, const float* g_up, const float* g_b, int h, int b0, int lane, int wave, int& sp, float (&bc)[8]) {
    const int d = wave >> 2, dk0 = 8 * (wave & 3);
    sp = d ? 63 - lane : lane;
    const float* gs = Gt + (size_t)(b0 + sp) * 48 + 16 + d * 16;
    const f32x4 g0 = *(const f32x4*)gs, g1 = *(const f32x4*)(gs + 4), g2 = *(const f32x4*)(gs + 8), g3 = *(const f32x4*)(gs + 12);
    const float gv[16] = {g0[0], g0[1], g0[2], g0[3], g1[0], g1[1], g1[2], g1[3], g2[0], g2[1], g2[2], g2[3], g3[0], g3[1], g3[2], g3[3]};
#pragma unroll
    for (int c = 0; c < 8; ++c) {
        float z = g_b[d * 128 + h * 32 + dk0 + c];
#pragma unroll
        for (int rr = 0; rr < 16; ++rr) z += gv[rr] * g_up[(d * 16 + rr) * 128 + h * 32 + dk0 + c];
        bc[c] = scan_add(log_sigmoidf_(z) * (1.f / 16.f), lane);
    }
}
__device__ __forceinline__ void gla_summary(LAS unsigned char* lds, const bf16_t* P, const float* Gt, const float* g_up, const float* g_b, float* GU, float* GDEC, int h, int oc, int tid, int lane, int wave) {
    LAS unsigned char* Kd = lds; LAS unsigned char* Vt = lds + 2 * GL_T;
    const int b0 = chunk_b0(oc);
    { const int r = tid >> 3, ch = tid & 7; const u32x4 vraw = *(const u32x4*)(P + (size_t)(b0 + r) * LDP + C_GV + h * 64 + ch * 8);
      __syncthreads();
      *(LAS u32x4*)(Vt + r * CH_RS + ch * 16) = vraw; }
    { const int d = wave >> 2, dk0 = 8 * (wave & 3), hd = h * 2 + d, jc = oc_to_jc(d, oc);
      int sp; float bc[8]; gla_gates_wave(Gt, g_up, g_b, h, b0, lane, wave, sp, bc);
      float kf[8]; unpack8(*(const u32x4*)(P + (size_t)(b0 + sp) * LDP + C_GK + h * 32 + dk0), kf);
      float dec[8];
#pragma unroll
      for (int c = 0; c < 8; ++c) { const float bL = __shfl(bc[c], 63); kf[c] *= __expf(bL - bc[c]); dec[c] = __expf(bL); }
      *(LAS u32x4*)(Kd + d * GL_T + sp * GL_RS + dk0 * 2) = pack8(kf);
      if (lane == 0) { float* dp = GDEC + (size_t)(hd * NCH + jc) * 32 + dk0; *(f32x4*)dp = (f32x4){dec[0], dec[1], dec[2], dec[3]}; *(f32x4*)(dp + 4) = (f32x4){dec[4], dec[5], dec[6], dec[7]}; } }
    __syncthreads();
    { const int d = wave >> 2, dkt = (wave >> 1) & 1, dvh = wave & 1, g = lane >> 4, i = lane & 15, hd = h * 2 + d, jc = oc_to_jc(d, oc);
      const bf16x8 a0 = tr_frag(Kd + d * GL_T, GL_RS, 0, 16 * dkt, lane), a1 = tr_frag(Kd + d * GL_T, GL_RS, 32, 16 * dkt, lane);
      float* dst = GU + ((size_t)(hd * 32 + 16 * dkt + i) * NCH + jc) * 64 + 4 * g;
#pragma unroll
      for (int q = 0; q < 2; ++q) { const int dvt = 2 * dvh + q;
          f32x4 c = (f32x4){0.f, 0.f, 0.f, 0.f};
          c = MFMA16(tr_frag(Vt, CH_RS, 0, 16 * dvt, lane), a0, c); c = MFMA16(tr_frag(Vt, CH_RS, 32, 16 * dvt, lane), a1, c);
          *(f32x4*)(dst + 16 * dvt) = c; } }
}
__device__ __forceinline__ void gla_out(LAS unsigned char* lds, const bf16_t* P, const float* Gt, const float* g_up, const float* g_b, const bf16_t* GS, const float* normw, bf16_t* CAT, int h, int oc, int tid, int lane, int wave) {
    LAS unsigned char* Qs = lds; LAS unsigned char* Ks = lds + 2 * GL_T; LAS unsigned char* Vt = lds + 4 * GL_T; LAS unsigned char* St = Vt + CH_T;
    LAS f32x4* hs = (LAS f32x4*)(St + 2 * 32 * CH_RS);
    const int b0 = chunk_b0(oc);
    { const int r = tid >> 3, ch = tid & 7; const u32x4 vraw = *(const u32x4*)(P + (size_t)(b0 + r) * LDP + C_GV + h * 64 + ch * 8);
      const int dd = r >> 5, rk = r & 31; const u32x4 sraw = *(const u32x4*)(GS + ((size_t)((h * 2 + dd) * 32 + rk) * NCH + oc_to_jc(dd, oc)) * 64 + ch * 8);
      __syncthreads();
      *(LAS u32x4*)(Vt + r * CH_RS + ch * 16) = vraw; *(LAS u32x4*)(St + dd * 32 * CH_RS + rk * CH_RS + ch * 16) = sraw; }
    { const int d = wave >> 2, dk0 = 8 * (wave & 3);
      int sp; float bc[8]; gla_gates_wave(Gt, g_up, g_b, h, b0, lane, wave, sp, bc);
      float qf[8], kf[8]; unpack8(*(const u32x4*)(P + (size_t)(b0 + sp) * LDP + C_GQ + h * 32 + dk0), qf); unpack8(*(const u32x4*)(P + (size_t)(b0 + sp) * LDP + C_GK + h * 32 + dk0), kf);
#pragma unroll
      for (int c = 0; c < 8; ++c) { qf[c] *= __expf(bc[c]); kf[c] *= __expf(-bc[c]); }
      *(LAS u32x4*)(Qs + d * GL_T + sp * GL_RS + dk0 * 2) = pack8(qf); *(LAS u32x4*)(Ks + d * GL_T + sp * GL_RS + dk0 * 2) = pack8(kf); }
    __syncthreads();
    const int d = wave >> 2, tt = wave & 3, g = lane >> 4, i = lane & 15, t = 16 * tt + i;
    f32x4 hh[4];
    {
        const bf16x8 bq = *(const LAS bf16x8*)(Qs + d * GL_T + t * GL_RS + 16 * g);
        f32x4 sT[4];
#pragma unroll
        for (int st = 0; st < 4; ++st) {
            f32x4 c = (f32x4){0.f, 0.f, 0.f, 0.f};
            c = MFMA16(*(const LAS bf16x8*)(Ks + d * GL_T + (16 * st + i) * GL_RS + 16 * g), bq, c);
#pragma unroll
            for (int rr = 0; rr < 4; ++rr) { const int sidx = 16 * st + 4 * g + rr; const bool ok = d ? (sidx >= t) : (sidx <= t); sT[st][rr] = ok ? c[rr] : 0.f; }
        }
        bf16x8 pb[2];
#pragma unroll
        for (int gp = 0; gp < 2; ++gp) { u32x4 w; w.x = cvtpk(sT[2 * gp][0], sT[2 * gp][1]); w.y = cvtpk(sT[2 * gp][2], sT[2 * gp][3]); w.z = cvtpk(sT[2 * gp + 1][0], sT[2 * gp + 1][1]); w.w = cvtpk(sT[2 * gp + 1][2], sT[2 * gp + 1][3]); pb[gp] = __builtin_bit_cast(bf16x8, w); }
#pragma unroll
        for (int dvt = 0; dvt < 4; ++dvt) {
            f32x4 c = (f32x4){0.f, 0.f, 0.f, 0.f};
            c = MFMA16(tr_frag_perm(Vt, CH_RS, 0, 16 * dvt, lane), pb[0], c); c = MFMA16(tr_frag_perm(Vt, CH_RS, 32, 16 * dvt, lane), pb[1], c);
            c = MFMA16(tr_frag(St + d * 32 * CH_RS, CH_RS, 0, 16 * dvt, lane), bq, c);
            hh[dvt] = c;
        }
        if (d == 1) {
#pragma unroll
            for (int dvt = 0; dvt < 4; ++dvt) hs[(tt * 4 + dvt) * 64 + lane] = hh[dvt];
        }
    }
    __syncthreads();
    if (d == 0) {
        float s1 = 0.f;
#pragma unroll
        for (int dvt = 0; dvt < 4; ++dvt) { hh[dvt] = hh[dvt] + hs[(tt * 4 + dvt) * 64 + lane]; s1 += (hh[dvt][0] + hh[dvt][1]) + (hh[dvt][2] + hh[dvt][3]); }
        s1 += __shfl_xor(s1, 16); s1 += __shfl_xor(s1, 32);
        const float mu = s1 * (1.f / 64.f); float s2 = 0.f;
#pragma unroll
        for (int dvt = 0; dvt < 4; ++dvt) { hh[dvt] = hh[dvt] - mu; s2 += (hh[dvt][0] * hh[dvt][0] + hh[dvt][1] * hh[dvt][1]) + (hh[dvt][2] * hh[dvt][2] + hh[dvt][3] * hh[dvt][3]); }
        s2 += __shfl_xor(s2, 16); s2 += __shfl_xor(s2, 32);
        const float rstd = rsqrtf(s2 * (1.f / 64.f) + LN_EPS);
        const int row = b0 + t;
#pragma unroll
        for (int dvt = 0; dvt < 4; ++dvt) { const int col = h * 64 + 16 * dvt + 4 * g;
            const uint2 gg = *(const uint2*)(P + (size_t)row * LDP + C_GG + col); const f32x4 nw = *(const f32x4*)(normw + col);
            const float o0 = hh[dvt][0] * rstd * nw[0] * siluf(__uint_as_float(gg.x << 16)), o1 = hh[dvt][1] * rstd * nw[1] * siluf(__uint_as_float(gg.x & 0xffff0000u));
            const float o2 = hh[dvt][2] * rstd * nw[2] * siluf(__uint_as_float(gg.y << 16)), o3 = hh[dvt][3] * rstd * nw[3] * siluf(__uint_as_float(gg.y & 0xffff0000u));
            uint2 o; o.x = cvtpk(o0, o1); o.y = cvtpk(o2, o3); *(uint2*)(CAT + (size_t)row * DM + 768 + col) = o; }
    }
}

__device__ __forceinline__ void ln16(f32x4 (&v)[4], const float* w, const float* b, int lane) {
    float s = 0.f;
#pragma unroll
    for (int j = 0; j < 4; ++j) s += (v[j][0] + v[j][1]) + (v[j][2] + v[j][3]);
    const float mean = wave_sum(s) * (1.f / DM); float s2 = 0.f;
#pragma unroll
    for (int j = 0; j < 4; ++j) { v[j] = v[j] - mean; s2 += (v[j][0] * v[j][0] + v[j][1] * v[j][1]) + (v[j][2] * v[j][2] + v[j][3] * v[j][3]); }
    const float rstd = rsqrtf(wave_sum(s2) * (1.f / DM) + LN_EPS);
#pragma unroll
    for (int j = 0; j < 4; ++j) { const f32x4 wv = *(const f32x4*)(w + 4 * lane + 256 * j), bv = *(const f32x4*)(b + 4 * lane + 256 * j); v[j] = v[j] * rstd * wv + bv; }
}
__device__ __forceinline__ void mod_store(f32x4 (&v)[4], const float* shift, const float* scale, bf16_t* hrow, int lane) {
#pragma unroll
    for (int j = 0; j < 4; ++j) { const f32x4 sh = *(const f32x4*)(shift + 4 * lane + 256 * j), sc = *(const f32x4*)(scale + 4 * lane + 256 * j);
        v[j] = v[j] * (sc + 1.f) + sh;
        uint2 o; o.x = cvtpk(v[j][0], v[j][1]); o.y = cvtpk(v[j][2], v[j][3]); *(uint2*)(hrow + 4 * lane + 256 * j) = o; }
}

__global__ void __launch_bounds__(512, 2) fwd(Args a_unused) {
    extern __shared__ __attribute__((aligned(16))) unsigned char lds_raw[];
    LAS unsigned char* lds = (LAS unsigned char*)lds_raw;
    const int wave0 = __builtin_amdgcn_readfirstlane(threadIdx.x >> 6);
    const int G = gridDim.x, bid = blockIdx.x;
    typedef const __attribute__((address_space(4))) Args* ArgsP;
    ArgsP ap0 = (ArgsP)__builtin_amdgcn_kernarg_segment_ptr();
#define PH_CTX() int wave = wave0; asm volatile("" : "+s"(wave)); unsigned ones_ = ~0u; asm volatile("" : "+s"(ones_)); const int lane = (int)__builtin_amdgcn_mbcnt_hi(ones_, __builtin_amdgcn_mbcnt_lo(ones_, 0u)); const int tid = wave * 64 + lane; \
    ArgsP ap = ap0; asm volatile("" : "+s"(ap)); unsigned char* ws = ap->ws; const int gw = bid * 8 + wave, NGW = G * 8; (void)lane; (void)gw; (void)NGW; (void)ws
#define WSP(T, off) ((T*)(ws + (off)))
    volatile LAS unsigned* MISC = (volatile LAS unsigned*)(lds + MISC_OFF);
    if (threadIdx.x < 32) MISC[threadIdx.x] = 0u;
    __syncthreads();
    XcdBarrier bar; bar.bar = (unsigned*)(ap0->ws + WS_CTL) + CW_BAR; bar.x = 0; bar.st = MISC + 8;
    if (MK_ONE_LAUNCH) bar = xcd_barrier_post(bar.bar, MISC + 8);
    const int lo = ap0->ph_lo, hi = ap0->ph_hi;
#define IN(k) (lo <= (k) && (k) < hi)
#define SEAM(k) do { if (MK_ONE_LAUNCH && (k) + 1 < hi) xcd_barrier(bar); } while (0)

    if (IN(0)) {
        PH_CTX();
        float* MODS = WSP(float, WS_MODS);
        LAS float* scs = (LAS float*)lds;
        for (int i = tid; i < 2048; i += 512) scs[i] = siluf(i < 1024 ? ap->in[1][i] : ap->in[3][i - 1024]);
        __syncthreads();
        for (int u = bid; u < 4 * 8 * 12; u += G) {
            const int l = u / 96, rem = u % 96, kc = rem / 12, ng = rem % 12, n = ng * 512 + tid;
            const float* w = ap->in[4] + ((size_t)l * 1024 + kc * 128) * 6144 + n;
            float a0 = 0.f, a1 = 0.f;
#pragma unroll 8
            for (int k = 0; k < 128; ++k) { const float wv = w[(size_t)k * 6144]; a0 += scs[kc * 128 + k] * wv; a1 += scs[1024 + kc * 128 + k] * wv; }
            if (kc == 0) { const float bb = ap->in[5][l * 6144 + n]; a0 += bb; a1 += bb; }
            atomicAdd(MODS + (size_t)(l * 2 + 0) * 6144 + n, a0); atomicAdd(MODS + (size_t)(l * 2 + 1) * 6144 + n, a1);
        }
        if (bid < 8) { float* ropeC = WSP(float, WS_ROPE); float* ropeS = ropeC + 256 * 16;
            const int i = bid * 512 + tid, pos = i >> 4, fi = i & 15; const float inv = powf(10000.f, -(float)fi / 16.f); const float ang = (float)pos * inv; float sn, cs; sincosf(ang, &sn, &cs); ropeC[i] = cs; ropeS[i] = sn; }
        __syncthreads();
        LAS float* scr = (LAS float*)(lds + wave * 16640);
        constexpr int I_A = 16 * 44, I_B = 16 * 16, I_C = 16 * 88, I_D = 44 * 16, I_E = 16 * 112, I_F = 56 * 16;
        constexpr int N_A = 4 * I_A, N_B = 4 * I_B, N_C = 2 * I_C, N_D = 2 * I_D, N_E = 16 * I_E, N_F = 16 * I_F;
        for (int it = gw; it < N_A + N_B + N_C + N_D + N_E + N_F; it += NGW) {
            int r = it;
            if (r < N_E) { const int mi = r / I_E; tr_item(ap->in[20] + (size_t)mi * DM * 2 * DEXP, DM, 2 * DEXP, 2 * DEXP, WSP(bf16_t, WS_MGU) + (size_t)mi * 2 * DEXP * DM, 2, DEXP, scr, r % I_E, lane); continue; } r -= N_E;
            if (r < N_F) { const int mi = r / I_F; tr_item(ap->in[21] + (size_t)mi * DEXP * DM, DEXP, DM, DM, WSP(bf16_t, WS_MDN) + (size_t)mi * DM * DEXP, 0, 0, scr, r % I_F, lane); continue; } r -= N_F;
            if (r < N_A) { const int mi = r / I_A; tr_item(ap->in[6] + (size_t)mi * DM * IN_COLS, DM, IN_COLS, NPIN, WSP(bf16_t, WS_WIN) + (size_t)mi * NPIN * DM, 1, 0, scr, r % I_A, lane); continue; } r -= N_A;
            if (r < N_B) { const int mi = r / I_B; tr_item(ap->in[13] + (size_t)mi * DM * DM, DM, DM, DM, WSP(bf16_t, WS_WOUT) + (size_t)mi * DM * DM, 0, 0, scr, r % I_B, lane); continue; } r -= N_B;
            if (r < N_C) { const int mi = r / I_C; tr_item(ap->in[16] + (size_t)mi * DM * 2 * DFF, DM, 2 * DFF, 2 * DFF, WSP(bf16_t, WS_FGU) + (size_t)mi * 2 * DFF * DM, 2, DFF, scr, r % I_C, lane); continue; } r -= N_C;
            { const int mi = r / I_D; tr_item(ap->in[17] + (size_t)mi * DFF * DM, DFF, DM, DM, WSP(bf16_t, WS_FDN) + (size_t)mi * DM * DFF, 0, 0, scr, r % I_D, lane); }
        }
        SEAM(0);
    }
    if (IN(1)) {
        PH_CTX();
        float* X = WSP(float, WS_X); bf16_t* H = WSP(bf16_t, WS_H); const float* MODS = WSP(float, WS_MODS);
        for (int r = gw; r < TT; r += NGW) {
            const int wch = r >= SEQ; const float* src = wch ? ap->in[2] + (size_t)(r - SEQ) * DM : ap->in[0] + (size_t)r * DM;
            f32x4 v[4];
#pragma unroll
            for (int j = 0; j < 4; ++j) { v[j] = *(const f32x4*)(src + 4 * lane + 256 * j); *(f32x4*)(X + (size_t)r * DM + 4 * lane + 256 * j) = v[j]; }
            const float* md = MODS + (size_t)(0 * 2 + wch) * 6144;
            mod_store(v, md, md + 1024, H + (size_t)r * DM, lane);
        }
        SEAM(1);
    }

    for (int l = 0; l < DEPTH; ++l) {
        const int pb = 2 + 10 * l;
        const bool lastl = (l == DEPTH - 1), moe = (l & 1);
        const int nrows = lastl ? SEQ : TT;

        PHASE_REP(0) if (IN(pb + 0)) {
            PH_CTX();
            pg8::StaticOrder S; S.init(WSP(bf16_t, WS_H), WSP(bf16_t, WS_WIN) + (size_t)l * NPIN * DM, DM, TT, NPIN, G, bid);
            pg8::EpiInProj E{WSP(bf16_t, WS_P), WSP(float, WS_G), WSP(float, WS_ROPE), WSP(float, WS_ROPE) + 256 * 16};
            pg8::gemm_phase<pg8::EpiInProj, pg8::StaticOrder>(lds, DM, S, E, tid);
            SEAM(pb + 0);
        }
        PHASE_REP(1) if (IN(pb + 1)) {
            if (!lastl && bid < 4) { PH_CTX(); attn_unit(lds, WSP(bf16_t, WS_P), WSP(bf16_t, WS_CAT), -1, bid >> 1, bid & 1, ap->in[9] + l * 8, tid, lane, wave); }
            { PH_CTX();
              for (int r = bid; r < 4 * NCH; r += G) { const int h = r / NCH, oc = r % NCH;
                  mlstm_summary(lds, WSP(bf16_t, WS_P), WSP(float, WS_G), ap->in[7] + l * 16, WSP(float, WS_MU), WSP(float, WS_MNU), WSP(float, WS_MSC), h, oc, tid, lane, wave); } }
            { PH_CTX();
              for (int r = (bid + 240) % G; r < 4 * NCH; r += G) { const int h = r / NCH, oc = r % NCH;
                  gla_summary(lds, WSP(bf16_t, WS_P), WSP(float, WS_G), ap->in[10] + (size_t)l * 2 * 16 * 128, ap->in[11] + l * 256, WSP(float, WS_GU), WSP(float, WS_GDEC), h, oc, tid, lane, wave); } }
            SEAM(pb + 1);
        }
        PHASE_REP(2) if (IN(pb + 2)) {
            PH_CTX();
            const int wi = wave * G + bid;
            const int e0 = wi * 64;
            LAS float* sc = (LAS float*)(lds + wave * 4096);
#define SC_LOAD(buf, b) _Pragma("unroll") for (int j = 0; j < 52; ++j) buf[j] = U[(size_t)((b) * 52 + j) * str]
            if (e0 < 32768 + 512) {
                const bool isC = e0 < 32768;
                const int hd = isC ? e0 / 4096 : (e0 - 32768) / 64, idx = isC ? (e0 % 4096) + lane : lane;
                const int dkr = (e0 % 4096) >> 6;
                const float* __restrict__ U = isC ? WSP(float, WS_MU) + (size_t)(hd * 64 + dkr) * NCH * 64 + lane : WSP(float, WS_MNU) + (size_t)hd * NCH * 64 + lane;
                bf16_t* __restrict__ StC = WSP(bf16_t, WS_MC) + (size_t)(hd * 64 + dkr) * NCH * 64 + lane; float* __restrict__ StN = WSP(float, WS_MNS) + (size_t)hd * NCH * 64 + lane;
                float* __restrict__ MSC = WSP(float, WS_MSC) + (size_t)hd * NCH * 4;
                const int str = 64;
                const bool wr_m = isC && (e0 % 4096) == 0 && lane == 0;
                for (int k = lane; k < NCH; k += 64) { const float2 v = *(const float2*)(MSC + k * 4); sc[2 * k] = v.x; sc[2 * k + 1] = v.y; }
                LDS_WAIT();
                float m = 0.f, cval = 0.f;
#define SC_STEP_M(buf, b) _Pragma("unroll") for (int j = 0; j < 52; ++j) { const int n = (b) * 52 + j; \
                    if (isC) StC[(size_t)n * 64] = (bf16_t)f2bf(cval); else StN[(size_t)n * 64] = cval; \
                    if (wr_m) MSC[n * 4 + 2] = m; \
                    const float cmv = sc[2 * n], Bv = sc[2 * n + 1], mx = fmaxf(m, cmv); \
                    cval = __expf(m - mx) * cval + __expf(cmv - mx) * buf[j]; m = Bv + mx; }
                float ua[52], ub[52];
                SC_LOAD(ua, 0);
                SC_LOAD(ub, 1); SC_STEP_M(ua, 0); SC_LOAD(ua, 2); SC_STEP_M(ub, 1);
                SC_LOAD(ub, 3); SC_STEP_M(ua, 2); SC_LOAD(ua, 4); SC_STEP_M(ub, 3);
                SC_STEP_M(ua, 4);
#undef SC_STEP_M
            } else if (e0 < 32768 + 512 + 16384) {
                const int e2 = e0 - 33280, hd = e2 / 2048, idx = (e2 % 2048) + lane, dk = (e2 % 2048) >> 6;
                const float* __restrict__ U = WSP(float, WS_GU) + (size_t)(hd * 32 + dk) * NCH * 64 + lane; bf16_t* __restrict__ St = WSP(bf16_t, WS_GS) + (size_t)(hd * 32 + dk) * NCH * 64 + lane;
                const float* __restrict__ DC = WSP(float, WS_GDEC) + (size_t)hd * NCH * 32 + dk;
                const int str = 64;
                for (int k = lane; k < NCH; k += 64) sc[k] = DC[(size_t)k * 32];
                LDS_WAIT();
                float sval = 0.f;
#define SC_STEP_G(buf, b) _Pragma("unroll") for (int j = 0; j < 52; ++j) { const int n = (b) * 52 + j; St[(size_t)n * 64] = (bf16_t)f2bf(sval); sval = sc[n] * sval + buf[j]; }
                float ua[52], ub[52];
                SC_LOAD(ua, 0);
                SC_LOAD(ub, 1); SC_STEP_G(ua, 0); SC_LOAD(ua, 2); SC_STEP_G(ub, 1);
                SC_LOAD(ub, 3); SC_STEP_G(ua, 2); SC_LOAD(ua, 4); SC_STEP_G(ub, 3);
                SC_STEP_G(ua, 4);
#undef SC_STEP_G
            }
#undef SC_LOAD
            SEAM(pb + 2);
        }
        PHASE_REP(3) if (IN(pb + 3)) {
            const int noc = lastl ? 256 : 260;
            { PH_CTX();
              for (int u = bid; u < 256; u += G) attn_unit(lds, WSP(bf16_t, WS_P), WSP(bf16_t, WS_CAT), u >> 1, 0, u & 1, ap->in[9] + l * 8, tid, lane, wave); }
            { PH_CTX();
              for (int r = bid; r < 4 * noc; r += G) { const int h = r / noc, oc = r % noc;
                  mlstm_out(lds, WSP(bf16_t, WS_P), WSP(float, WS_G), ap->in[7] + l * 16, WSP(bf16_t, WS_MC), WSP(float, WS_MNS), WSP(float, WS_MSC), ap->in[8] + l * 256, WSP(bf16_t, WS_CAT), h, oc, tid, lane, wave); } }
            { PH_CTX();
              for (int r = (bid + 240) % G; r < 4 * noc; r += G) { const int h = r / noc, oc = r % noc;
                  gla_out(lds, WSP(bf16_t, WS_P), WSP(float, WS_G), ap->in[10] + (size_t)l * 2 * 16 * 128, ap->in[11] + l * 256, WSP(bf16_t, WS_GS), ap->in[12] + l * 256, WSP(bf16_t, WS_CAT), h, oc, tid, lane, wave); } }
            SEAM(pb + 3);
        }
        PHASE_REP(4) if (IN(pb + 4)) {
            PH_CTX();
            const float* modl = WSP(float, WS_MODS) + (size_t)(l * 2 + 0) * 6144;
            int tp, sp; pg8::tail_params(nrows / 256, 4, DM / 64, G, tp, sp);
            pg8::TailOrder S; S.dense(WSP(bf16_t, WS_CAT), WSP(bf16_t, WS_WOUT) + (size_t)l * DM * DM, DM, DM, nrows / 256, G, bid, tp, sp);
            pg8::EpiResid E{WSP(float, WS_X), WSP(float, WS_Y), modl + 2 * 1024, modl + 6144 + 2 * 1024, WSP(float, WS_YP), nrows - tp * 256, tp * 256};
            pg8::gemm_phase<pg8::EpiResid, pg8::TailOrder>(lds, DM, S, E, tid);
            SEAM(pb + 4);
        }
        if (IN(pb + 5)) {
            PH_CTX();
            float* X = WSP(float, WS_X); bf16_t* H = WSP(bf16_t, WS_H); const float* Y = WSP(float, WS_Y);
            const float* modl = WSP(float, WS_MODS) + (size_t)(l * 2 + 0) * 6144;
            unsigned* mcnt = WSP(unsigned, WS_CTL) + CW_MOE + 64 * 8 * (l >> 1);
            LAS float* RW = (LAS float*)lds;
            if (moe) { const float* rw = ap->in[18] + (size_t)(l >> 1) * DM * 8; for (int i = tid; i < 8192; i += 512) { const int e = i >> 10, c = i & 1023; RW[i] = rw[c * 8 + e]; } __syncthreads(); }
            const float* lw = ap->in[14] + (size_t)(l * 2 + 0) * DM; const float* lb = ap->in[15] + (size_t)(l * 2 + 0) * DM;
            int tp, sp; pg8::tail_params(nrows / 256, 4, DM / 64, G, tp, sp);
            const int tail0 = nrows - tp * 256; const float* YP = WSP(float, WS_YP);
            for (int r = gw; r < nrows; r += NGW) {
                const int wch = r >= SEQ; const float* md = modl + wch * 6144;
                f32x4 v[4];
                if (r < tail0) {
#pragma unroll
                    for (int j = 0; j < 4; ++j) v[j] = *(const f32x4*)(Y + (size_t)r * DM + 4 * lane + 256 * j);
                } else {
#pragma unroll
                    for (int j = 0; j < 4; ++j) { const int c = 4 * lane + 256 * j; f32x4 a4 = (f32x4){0.f, 0.f, 0.f, 0.f};
                        for (int p = 0; p < sp; ++p) a4 = a4 + *(const f32x4*)(YP + ((size_t)p * tp * 256 + (r - tail0)) * DM + c);
                        v[j] = *(const f32x4*)(X + (size_t)r * DM + c) * ALPHA + *(const f32x4*)(md + 2 * 1024 + c) * a4; }
                }
                ln16(v, lw, lb, lane);
#pragma unroll
                for (int j = 0; j < 4; ++j) *(f32x4*)(X + (size_t)r * DM + 4 * lane + 256 * j) = v[j];
                mod_store(v, md + 3 * 1024, md + 4 * 1024, H + (size_t)r * DM, lane);
                if (moe) {
                    float lg[8];
#pragma unroll
                    for (int e = 0; e < 8; ++e) { float s = 0.f;
#pragma unroll
                        for (int j = 0; j < 4; ++j) { const f32x4 w = *(const LAS f32x4*)(RW + e * 1024 + 4 * lane + 256 * j); s += v[j][0] * w[0] + v[j][1] * w[1] + v[j][2] * w[2] + v[j][3] * w[3]; }
                        lg[e] = wave_sum(s) + ap->in[19][(l >> 1) * 8 + e]; }
                    int e0 = 0; float l0 = lg[0];
#pragma unroll
                    for (int e = 1; e < 8; ++e) if (lg[e] > l0) { l0 = lg[e]; e0 = e; }
                    int e1 = -1; float l1 = -INFINITY;
#pragma unroll
                    for (int e = 0; e < 8; ++e) if (e != e0 && lg[e] > l1) { l1 = lg[e]; e1 = e; }
                    if (lane == 0) {
                        const float w0 = 1.f / (1.f + __expf(l1 - l0));
                        const int p0 = (int)atomicAdd(mcnt + 64 * e0, 1u), p1 = (int)atomicAdd(mcnt + 64 * e1, 1u);
                        WSP(int2, WS_TOKE)[r] = make_int2(e0, e1); WSP(int2, WS_TOKP)[r] = make_int2(p0, p1); WSP(float2, WS_TOKW)[r] = make_float2(w0, 1.f - w0);
                    }
                }
            }
            SEAM(pb + 5);
        }
#define MOE_TS() int ts0 = 0, ts1, ts2, ts3, ts4, ts5, ts6, ts7, ts8; { const unsigned* mcnt = WSP(unsigned, WS_CTL) + CW_MOE + 64 * 8 * (l >> 1); \
            ts1 = ts0 + (int)((__hip_atomic_load(mcnt + 64 * 0, __ATOMIC_RELAXED, __HIP_MEMORY_SCOPE_AGENT) + 255u) >> 8); ts2 = ts1 + (int)((__hip_atomic_load(mcnt + 64 * 1, __ATOMIC_RELAXED, __HIP_MEMORY_SCOPE_AGENT) + 255u) >> 8); \
            ts3 = ts2 + (int)((__hip_atomic_load(mcnt + 64 * 2, __ATOMIC_RELAXED, __HIP_MEMORY_SCOPE_AGENT) + 255u) >> 8); ts4 = ts3 + (int)((__hip_atomic_load(mcnt + 64 * 3, __ATOMIC_RELAXED, __HIP_MEMORY_SCOPE_AGENT) + 255u) >> 8); \
            ts5 = ts4 + (int)((__hip_atomic_load(mcnt + 64 * 4, __ATOMIC_RELAXED, __HIP_MEMORY_SCOPE_AGENT) + 255u) >> 8); ts6 = ts5 + (int)((__hip_atomic_load(mcnt + 64 * 5, __ATOMIC_RELAXED, __HIP_MEMORY_SCOPE_AGENT) + 255u) >> 8); \
            ts7 = ts6 + (int)((__hip_atomic_load(mcnt + 64 * 6, __ATOMIC_RELAXED, __HIP_MEMORY_SCOPE_AGENT) + 255u) >> 8); ts8 = ts7 + (int)((__hip_atomic_load(mcnt + 64 * 7, __ATOMIC_RELAXED, __HIP_MEMORY_SCOPE_AGENT) + 255u) >> 8); \
            ts1 = __builtin_amdgcn_readfirstlane(ts1); ts2 = __builtin_amdgcn_readfirstlane(ts2); ts3 = __builtin_amdgcn_readfirstlane(ts3); ts4 = __builtin_amdgcn_readfirstlane(ts4); \
            ts5 = __builtin_amdgcn_readfirstlane(ts5); ts6 = __builtin_amdgcn_readfirstlane(ts6); ts7 = __builtin_amdgcn_readfirstlane(ts7); ts8 = __builtin_amdgcn_readfirstlane(ts8); } (void)ts0; (void)ts8
        PHASE_REP(6) if (IN(pb + 6) && moe) {
            PH_CTX();
            MOE_TS();
            const bf16_t* H = WSP(bf16_t, WS_H); bf16_t* XB = WSP(bf16_t, WS_XB);
            for (int r = gw; r < nrows; r += NGW) {
                const int2 ee = WSP(int2, WS_TOKE)[r], pp = WSP(int2, WS_TOKP)[r];
                const int b0 = ee.x == 0 ? ts0 : ee.x == 1 ? ts1 : ee.x == 2 ? ts2 : ee.x == 3 ? ts3 : ee.x == 4 ? ts4 : ee.x == 5 ? ts5 : ee.x == 6 ? ts6 : ts7;
                const int b1 = ee.y == 0 ? ts0 : ee.y == 1 ? ts1 : ee.y == 2 ? ts2 : ee.y == 3 ? ts3 : ee.y == 4 ? ts4 : ee.y == 5 ? ts5 : ee.y == 6 ? ts6 : ts7;
                const int s0 = b0 * 256 + pp.x, s1 = b1 * 256 + pp.y;
                const uint4 h0 = *(const uint4*)(H + (size_t)r * DM + 8 * lane), h1 = *(const uint4*)(H + (size_t)r * DM + 512 + 8 * lane);
                *(uint4*)(XB + (size_t)s0 * DM + 8 * lane) = h0; *(uint4*)(XB + (size_t)s0 * DM + 512 + 8 * lane) = h1;
                *(uint4*)(XB + (size_t)s1 * DM + 8 * lane) = h0; *(uint4*)(XB + (size_t)s1 * DM + 512 + 8 * lane) = h1;
                if (lane == 0) WSP(int2, WS_TOKS)[r] = make_int2(s0, s1);
            }
            SEAM(pb + 6);
        }
        PHASE_REP(7) if (IN(pb + 7)) {
            PH_CTX();
            if (!moe) {
                pg8::StaticOrder S; S.init(WSP(bf16_t, WS_H), WSP(bf16_t, WS_FGU) + (size_t)(l >> 1) * 2 * DFF * DM, DM, nrows, 2 * DFF, G, bid);
                pg8::EpiSwiglu E{WSP(bf16_t, WS_ACT), DFF};
                pg8::gemm_phase<pg8::EpiSwiglu, pg8::StaticOrder>(lds, DM, S, E, tid);
            } else {
                MOE_TS();
                pg8::MoeOrder S; S.A = (const char*)WSP(bf16_t, WS_XB); S.Bt = (const char*)(WSP(bf16_t, WS_MGU) + (size_t)(l >> 1) * 8 * 2 * DEXP * DM); S.K = DM; S.N = 2 * DEXP; S.nN = 2 * DEXP / 256; S.ntile = ts8; S.G = G; S.c = bid;
                S.ts1 = ts1; S.ts2 = ts2; S.ts3 = ts3; S.ts4 = ts4; S.ts5 = ts5; S.ts6 = ts6; S.ts7 = ts7;
                pg8::EpiSwiglu E{WSP(bf16_t, WS_ACT), DEXP};
                pg8::gemm_phase<pg8::EpiSwiglu, pg8::MoeOrder>(lds, DM, S, E, tid);
            }
            SEAM(pb + 7);
        }
        PHASE_REP(8) if (IN(pb + 8)) {
            PH_CTX();
            if (!moe) {
                const float* modl = WSP(float, WS_MODS) + (size_t)(l * 2 + 0) * 6144;
                int tp, sp; pg8::tail_params(nrows / 256, 4, DFF / 64, G, tp, sp);
                pg8::TailOrder S; S.dense(WSP(bf16_t, WS_ACT), WSP(bf16_t, WS_FDN) + (size_t)(l >> 1) * DM * DFF, DFF, DM, nrows / 256, G, bid, tp, sp);
                pg8::EpiResid E{WSP(float, WS_X), WSP(float, WS_Y), modl + 5 * 1024, modl + 6144 + 5 * 1024, WSP(float, WS_YP), nrows - tp * 256, tp * 256};
                pg8::gemm_phase<pg8::EpiResid, pg8::TailOrder>(lds, DFF, S, E, tid);
            } else {
                MOE_TS();
                int tp, sp; pg8::tail_params(ts8, 4, DEXP / 64, G, tp, sp);
                pg8::TailOrder S; S.dense(WSP(bf16_t, WS_ACT), WSP(bf16_t, WS_MDN) + (size_t)(l >> 1) * 8 * DM * DEXP, DEXP, DM, ts8, G, bid, tp, sp);
                S.ts1 = ts1; S.ts2 = ts2; S.ts3 = ts3; S.ts4 = ts4; S.ts5 = ts5; S.ts6 = ts6; S.ts7 = ts7;
                pg8::EpiF32 E{WSP(float, WS_YS), WSP(float, WS_YP), (ts8 - tp) * 256, tp * 256};
                pg8::gemm_phase<pg8::EpiF32, pg8::TailOrder>(lds, DEXP, S, E, tid);
            }
            SEAM(pb + 8);
        }
        if (IN(pb + 9)) {
            PH_CTX();
            float* X = WSP(float, WS_X); bf16_t* H = WSP(bf16_t, WS_H); const float* Y = WSP(float, WS_Y); const float* YS = WSP(float, WS_YS);
            const float* modl = WSP(float, WS_MODS) + (size_t)(l * 2 + 0) * 6144;
            const float* lw = ap->in[14] + (size_t)(l * 2 + 1) * DM; const float* lb = ap->in[15] + (size_t)(l * 2 + 1) * DM;
            int tp, sp, tail0; const float* YP = WSP(float, WS_YP);
            if (!moe) { pg8::tail_params(nrows / 256, 4, DFF / 64, G, tp, sp); tail0 = nrows - tp * 256; }
            else { MOE_TS(); pg8::tail_params(ts8, 4, DEXP / 64, G, tp, sp); tail0 = (ts8 - tp) * 256; }
            for (int r = gw; r < nrows; r += NGW) {
                const int wch = r >= SEQ; const float* md = modl + wch * 6144;
                f32x4 v[4];
                if (!moe) {
                    if (r < tail0) {
#pragma unroll
                        for (int j = 0; j < 4; ++j) v[j] = *(const f32x4*)(Y + (size_t)r * DM + 4 * lane + 256 * j);
                    } else {
#pragma unroll
                        for (int j = 0; j < 4; ++j) { const int c = 4 * lane + 256 * j; f32x4 a4 = (f32x4){0.f, 0.f, 0.f, 0.f};
                            for (int p = 0; p < sp; ++p) a4 = a4 + *(const f32x4*)(YP + ((size_t)p * tp * 256 + (r - tail0)) * DM + c);
                            v[j] = *(const f32x4*)(X + (size_t)r * DM + c) * ALPHA + *(const f32x4*)(md + 5 * 1024 + c) * a4; }
                    }
                } else {
                    const int2 ss = WSP(int2, WS_TOKS)[r]; const float2 ww = WSP(float2, WS_TOKW)[r];
#pragma unroll
                    for (int j = 0; j < 4; ++j) { const int c = 4 * lane + 256 * j;
                        f32x4 y0, y1;
                        if (ss.x < tail0) y0 = *(const f32x4*)(YS + (size_t)ss.x * DM + c);
                        else { y0 = (f32x4){0.f, 0.f, 0.f, 0.f}; for (int p = 0; p < sp; ++p) y0 = y0 + *(const f32x4*)(YP + ((size_t)p * tp * 256 + (ss.x - tail0)) * DM + c); }
                        if (ss.y < tail0) y1 = *(const f32x4*)(YS + (size_t)ss.y * DM + c);
                        else { y1 = (f32x4){0.f, 0.f, 0.f, 0.f}; for (int p = 0; p < sp; ++p) y1 = y1 + *(const f32x4*)(YP + ((size_t)p * tp * 256 + (ss.y - tail0)) * DM + c); }
                        const f32x4 xv = *(const f32x4*)(X + (size_t)r * DM + c), g5 = *(const f32x4*)(md + 5 * 1024 + c);
                        v[j] = xv * ALPHA + g5 * (y0 * ww.x + y1 * ww.y); }
                }
                ln16(v, lw, lb, lane);
                if (lastl) {
#pragma unroll
                    for (int j = 0; j < 4; ++j) *(f32x4*)(ap->out + (size_t)r * DM + 4 * lane + 256 * j) = v[j];
                } else {
#pragma unroll
                    for (int j = 0; j < 4; ++j) *(f32x4*)(X + (size_t)r * DM + 4 * lane + 256 * j) = v[j];
                    const float* mdn = modl + 2 * 6144 + wch * 6144;
                    mod_store(v, mdn, mdn + 1024, H + (size_t)r * DM, lane);
                }
            }
            SEAM(pb + 9);
        }
    }
#undef IN
#undef SEAM
}

extern "C" void kernel_launch(void* const* d_in, const int* in_sizes, int n_in, void* d_out, int out_size, void* d_ws, size_t ws_size, hipStream_t stream) {
    static int grid = 0;
    if (grid == 0) {
        if (n_in != 22 || ws_size < WS_END) { fprintf(stderr, "kernel_launch: unexpected n_in %d / ws %zu (need %zu)\n", n_in, ws_size, (size_t)WS_END); grid = -1; return; }
        int dev = 0, cus = 0;
        if (hipGetDevice(&dev) != hipSuccess || hipDeviceGetAttribute(&cus, hipDeviceAttributeMultiprocessorCount, dev) != hipSuccess) { grid = -1; return; }
        if (hipFuncSetAttribute((const void*)fwd, hipFuncAttributeMaxDynamicSharedMemorySize, LDS_BYTES) != hipSuccess) { fprintf(stderr, "kernel_launch: hipFuncSetAttribute failed\n"); grid = -1; return; }
        int per_cu = 0;
        if (hipOccupancyMaxActiveBlocksPerMultiprocessor(&per_cu, (const void*)fwd, 512, LDS_BYTES) != hipSuccess || per_cu < 1) fprintf(stderr, "kernel_launch: occupancy query reports %d\n", per_cu);
        (void)hipGetLastError();
        grid = cus;
    }
    if (grid < 0) return;
    (void)hipMemsetAsync((char*)d_ws + WS_CTL, 0, CTL_BYTES, stream);
    Args a{};
    for (int i = 0; i < 22; ++i) a.in[i] = (const float*)d_in[i];
    a.out = (float*)d_out; a.ws = (unsigned char*)d_ws;
#if MK_ONE_LAUNCH
    a.ph_lo = 0; a.ph_hi = NPH;
    hipLaunchKernelGGL(fwd, dim3(grid), dim3(512), LDS_BYTES, stream, a);
#else
    for (int p = 0; p < NPH; ++p) {
        if (p >= 2 && ((p - 2) % 10) == 6 && ((((p - 2) / 10) & 1) == 0)) continue;
        a.ph_lo = p; a.ph_hi = p + 1;
        hipLaunchKernelGGL(fwd, dim3(grid), dim3(512), LDS_BYTES, stream, a);
    }
#endif
}
```

```cpp
#include <hip/hip_runtime.h>
#include <cstdio>
#include <cstdint>

#ifndef MK_ONE_LAUNCH
#define MK_ONE_LAUNCH 1
#endif

#ifndef DUP_MASK
#define DUP_MASK 0
#endif
#define PHASE_REP(k) for (int rep_ = 0; rep_ < 1 + ((DUP_MASK >> (k)) & 1); ++rep_)
#define LAS __attribute__((address_space(3)))
#define GAS __attribute__((address_space(1)))
typedef unsigned short bf16_t;
typedef short bf16x8 __attribute__((ext_vector_type(8)));
typedef float f32x4 __attribute__((ext_vector_type(4)));
typedef unsigned u32x4 __attribute__((ext_vector_type(4)));

constexpr int DM = 1024, SEQ = 16384, NCTX = 256, TT = SEQ + NCTX, DEPTH = 4;
constexpr int IN_COLS = 2608, NPIN = 2816, LDP = 2816;
constexpr int C_MQ = 0, C_MK = 256, C_MV = 512, C_MO = 768, C_AQ = 1024, C_AK = 1536, C_AV = 1664, C_GQ = 1792, C_GK = 1920, C_GV = 2048, C_GG = 2304, C_MG = 2560, C_GGT = 2576, C_END = 2608;
constexpr int DFF = 2816, DEXP = 3584, NEXP = 8;
constexpr int NCH = 260;
constexpr int NSLOT = 138 * 256;
constexpr float ALPHA = 1.6817928305074290f;
constexpr float LN_EPS = 1e-5f;
constexpr int NPH = 2 + 10 * DEPTH;

constexpr size_t al256(size_t x) { return (x + 255) & ~size_t(255); }
constexpr size_t WS_CTL = 0, CTL_BYTES = 2u << 20;
constexpr size_t WS_MODS = 1u << 20;
constexpr size_t WS_ROPE = CTL_BYTES;
constexpr size_t WS_TOKE = WS_ROPE + 32768;
constexpr size_t WS_TOKP = WS_TOKE + al256((size_t)TT * 8);
constexpr size_t WS_TOKW = WS_TOKP + al256((size_t)TT * 8);
constexpr size_t WS_TOKS = WS_TOKW + al256((size_t)TT * 8);
constexpr size_t WS_WIN = WS_TOKS + al256((size_t)TT * 8);
constexpr size_t WS_WOUT = WS_WIN + (size_t)DEPTH * NPIN * DM * 2;
constexpr size_t WS_FGU = WS_WOUT + (size_t)DEPTH * DM * DM * 2;
constexpr size_t WS_FDN = WS_FGU + (size_t)2 * 2 * DFF * DM * 2;
constexpr size_t WS_MGU = WS_FDN + (size_t)2 * DM * DFF * 2;
constexpr size_t WS_MDN = WS_MGU + (size_t)16 * 2 * DEXP * DM * 2;
constexpr size_t WS_X = WS_MDN + (size_t)16 * DM * DEXP * 2;
constexpr size_t WS_H = WS_X + (size_t)TT * DM * 4;
constexpr size_t WS_P = WS_H + (size_t)TT * DM * 2;
constexpr size_t WS_G = WS_P + (size_t)TT * LDP * 2;
constexpr size_t WS_CAT = WS_G + al256((size_t)TT * 48 * 4);
constexpr size_t WS_Y = WS_CAT + (size_t)TT * DM * 2;
constexpr size_t WS_ACT = WS_Y + (size_t)TT * DM * 4;
constexpr size_t WS_XB = WS_ACT + (size_t)NSLOT * DEXP * 2;
constexpr size_t WS_YS = WS_XB + (size_t)NEXP * TT * DM * 2;
constexpr size_t WS_MU = WS_YS + (size_t)NSLOT * DM * 4;
constexpr size_t WS_MC = WS_MU + (size_t)8 * NCH * 4096 * 4;
constexpr size_t WS_MNU = WS_MC + (size_t)8 * NCH * 4096 * 4;
constexpr size_t WS_MNS = WS_MNU + (size_t)8 * NCH * 64 * 4;
constexpr size_t WS_MSC = WS_MNS + (size_t)8 * NCH * 64 * 4;
constexpr size_t WS_GU = WS_MSC + al256((size_t)8 * NCH * 4 * 4);
constexpr size_t WS_GS = WS_GU + (size_t)8 * NCH * 2048 * 4;
constexpr size_t WS_GDEC = WS_GS + (size_t)8 * NCH * 2048 * 4;
constexpr size_t WS_YP = WS_GDEC + (size_t)8 * NCH * 32 * 4;
constexpr size_t WS_END = WS_YP + (size_t)256 * 256 * 256 * 4;

constexpr int CW_BAR = 4096;
constexpr int CW_MOE = 16384;

constexpr int LDS_BYTES = 147456, MISC_OFF = 147200;

__device__ __forceinline__ float bf2f(unsigned v) { return __uint_as_float(v << 16); }
__device__ __forceinline__ unsigned f2bf(float f) { unsigned u = __float_as_uint(f); return (u + 0x7fffu + ((u >> 16) & 1u)) >> 16; }
__device__ __forceinline__ unsigned pk2(float lo, float hi) { return f2bf(lo) | (f2bf(hi) << 16); }
__device__ __forceinline__ void load8bf(const bf16_t* p, float* o) {
    const uint4 v = *(const uint4*)p;
    o[0] = __uint_as_float(v.x << 16); o[1] = __uint_as_float(v.x & 0xffff0000u); o[2] = __uint_as_float(v.y << 16); o[3] = __uint_as_float(v.y & 0xffff0000u);
    o[4] = __uint_as_float(v.z << 16); o[5] = __uint_as_float(v.z & 0xffff0000u); o[6] = __uint_as_float(v.w << 16); o[7] = __uint_as_float(v.w & 0xffff0000u);
}
__device__ __forceinline__ float wave_sum(float v) {
#pragma unroll
    for (int o = 1; o < 64; o <<= 1) v += __shfl_xor(v, o);
    return v;
}
__device__ __forceinline__ float wave_max(float v) {
#pragma unroll
    for (int o = 1; o < 64; o <<= 1) v = fmaxf(v, __shfl_xor(v, o));
    return v;
}
__device__ __forceinline__ float scan_add(float v, int lane) {
#pragma unroll
    for (int o = 1; o < 64; o <<= 1) { const float t = __shfl_up(v, o); if (lane >= o) v += t; }
    return v;
}
__device__ __forceinline__ float scan_max(float v, int lane) {
#pragma unroll
    for (int o = 1; o < 64; o <<= 1) { const float t = __shfl_up(v, o); if (lane >= o) v = fmaxf(v, t); }
    return v;
}
__device__ __forceinline__ float siluf(float x) { return x * __builtin_amdgcn_rcpf(1.f + __expf(-x)); }
__device__ __forceinline__ float sigmoidf_(float x) { return __builtin_amdgcn_rcpf(1.f + __expf(-x)); }
__device__ __forceinline__ float log_sigmoidf_(float x) {
    const float t = __expf(-fabsf(x)); const float l1p = (t < 0.01f) ? t * (1.f + t * (-0.5f + t * 0.33333333f)) : __logf(1.f + t); return fminf(x, 0.f) - l1p; }
typedef short s16x4 __attribute__((ext_vector_type(4)));
typedef short v4i16_t __attribute__((ext_vector_type(4)));
typedef float f32x2_t __attribute__((ext_vector_type(2))); typedef __bf16 bf16x2_t __attribute__((ext_vector_type(2)));
__device__ __forceinline__ unsigned cvtpk(float lo, float hi) { f32x2_t v = {lo, hi}; bf16x2_t b = __builtin_convertvector(v, bf16x2_t); return __builtin_bit_cast(unsigned, b); }
__device__ __forceinline__ s16x4 ds_tr16(const LAS unsigned char* p) { return __builtin_bit_cast(s16x4, __builtin_amdgcn_ds_read_tr16_b64_v4i16((LAS v4i16_t*)p)); }
__device__ __forceinline__ bf16x8 cat44(s16x4 a, s16x4 b) { return __builtin_shufflevector(a, b, 0, 1, 2, 3, 4, 5, 6, 7); }
#define MFMA16(a, b, c) __builtin_amdgcn_mfma_f32_16x16x32_bf16(a, b, c, 0, 0, 0)
__device__ __forceinline__ float grp_max(float v) {
    const auto a = __builtin_amdgcn_permlane16_swap(__float_as_uint(v), __float_as_uint(v), false, false); v = fmaxf(__uint_as_float(a[0]), __uint_as_float(a[1]));
    const auto b = __builtin_amdgcn_permlane32_swap(__float_as_uint(v), __float_as_uint(v), false, false); return fmaxf(__uint_as_float(b[0]), __uint_as_float(b[1])); }
__device__ __forceinline__ float grp_sum(float v) {
    const auto a = __builtin_amdgcn_permlane16_swap(__float_as_uint(v), __float_as_uint(v), false, false); v = __uint_as_float(a[0]) + __uint_as_float(a[1]);
    const auto b = __builtin_amdgcn_permlane32_swap(__float_as_uint(v), __float_as_uint(v), false, false); return __uint_as_float(b[0]) + __uint_as_float(b[1]); }
#define LDS_WAIT() asm volatile("s_waitcnt lgkmcnt(0)" ::: "memory")

namespace pg8 {
constexpr int BM = 256, BK = 64, HALF = 128, HTB = HALF * BK * 2, STAGE_BYTES = 8 * HTB, NXCD = 8, WGM = 8;
__host__ __device__ __forceinline__ int lds_byte(int r, int c) { const int st = (r >> 4) * 2 + (c >> 5), rr = r & 15, cc = c & 31, ob = rr * 64 + cc * 2; return st * 1024 + (ob ^ (((ob >> 9) & 1) << 5)); }
__host__ __device__ __forceinline__ void stage_rc(int b, int& R, int& C) { const int st = b / 1024, sb = b % 1024, swz = sb ^ (((sb >> 9) & 1) << 5); R = (st >> 1) * 16 + swz / 64; C = (st & 1) * 32 + (swz % 64) / 2; }
__host__ __device__ __forceinline__ int perm32(int rho) { const int n = rho >> 4, i = rho & 15; return 8 * (i >> 2) + 4 * n + (i & 3); }
struct Unit { int pm, pn, kt0, nkt, part; };

struct StaticOrder {
    const char* A; const char* Bt; int K;
    int nM, nN, nwg, G, c;
    __device__ void init(const void* A_, const void* Bt_, int K_, int M, int N, int G_, int c_) { A = (const char*)A_; Bt = (const char*)Bt_; K = K_; nM = M / BM; nN = N / BM; nwg = nM * nN; G = G_; c = c_; }
    __device__ __forceinline__ bool next(int i, Unit& u) const {
        const long L = (long)i * G + c; if (L >= nwg) return false;
        int wgid = (int)L; { const int q = nwg / NXCD, r = nwg % NXCD, xcd = wgid % NXCD, off = wgid / NXCD; wgid = (xcd < r ? xcd * (q + 1) : r * (q + 1) + (xcd - r) * q) + off; }
        const int nig = WGM * nN, gid = wgid / nig, fm = gid * WGM, gsz = (nM - fm) < WGM ? (nM - fm) : WGM;
        u.pm = fm + ((wgid % nig) % gsz); u.pn = (wgid % nig) / gsz; u.kt0 = 0; u.nkt = K / BK; u.part = -1; return true;
    }
    __device__ __forceinline__ const char* aptr(const Unit& u) const { return A + (size_t)u.pm * BM * K * 2; }
    __device__ __forceinline__ const char* bptr(const Unit& u) const { return Bt + (size_t)u.pn * BM * K * 2; }
};
struct MoeOrder {
    const char* A; const char* Bt; int K, N, nN, ntile, G, c;
    int ts1, ts2, ts3, ts4, ts5, ts6, ts7;
    __device__ __forceinline__ bool next(int i, Unit& u) const {
        const long L = (long)i * G + c; if (L >= (long)ntile * nN) return false;
        u.pm = (int)(L / nN); u.pn = (int)(L % nN); u.kt0 = 0; u.nkt = K / BK; u.part = -1; return true;
    }
    __device__ __forceinline__ int expert(int pm) const { return (pm >= ts1) + (pm >= ts2) + (pm >= ts3) + (pm >= ts4) + (pm >= ts5) + (pm >= ts6) + (pm >= ts7); }
    __device__ __forceinline__ const char* aptr(const Unit& u) const {
        const int e = expert(u.pm); const int t0 = e == 0 ? 0 : e == 1 ? ts1 : e == 2 ? ts2 : e == 3 ? ts3 : e == 4 ? ts4 : e == 5 ? ts5 : e == 6 ? ts6 : ts7;
        return A + ((size_t)e * TT + (size_t)(u.pm - t0) * BM) * K * 2; }
    __device__ __forceinline__ const char* bptr(const Unit& u) const { return Bt + ((size_t)expert(u.pm) * N + (size_t)u.pn * BM) * K * 2; }
};

struct TailOrder {
    const char* A; const char* Bt; int K, N, nN, npan, G, c, tp, s;
    int ts1, ts2, ts3, ts4, ts5, ts6, ts7;
    __device__ __forceinline__ void dense(const void* A_, const void* Bt_, int K_, int N_, int npan_, int G_, int c_, int tp_, int s_) {
        A = (const char*)A_; Bt = (const char*)Bt_; K = K_; N = N_; nN = N_ / BM; npan = npan_; G = G_; c = c_; tp = tp_; s = s_;
        ts1 = ts2 = ts3 = ts4 = ts5 = ts6 = ts7 = 0x7fffffff; }
    __device__ __forceinline__ bool next(int i, Unit& u) const {
        const int L = i * G + c, nfull = (npan - tp) * nN, ksub = (K / BK) / s;
        const bool tail = L >= nfull; const int j = L - nfull, tu = tp * nN, tu1 = tu > 0 ? tu : 1;
        const int part = tail ? j / tu1 : -1, r = tail ? j % tu1 : 0;
        u.part = part; u.pm = tail ? (npan - tp) + r / nN : L / nN; u.pn = tail ? r % nN : L % nN; u.kt0 = tail ? part * ksub : 0; u.nkt = tail ? ksub : K / BK;
        return tail ? (j < tu * s) : true;
    }
    __device__ __forceinline__ int expert(int pm) const { return (pm >= ts1) + (pm >= ts2) + (pm >= ts3) + (pm >= ts4) + (pm >= ts5) + (pm >= ts6) + (pm >= ts7); }
    __device__ __forceinline__ const char* aptr(const Unit& u) const { return A + ((size_t)u.pm * BM * K + (size_t)u.kt0 * BK) * 2; }
    __device__ __forceinline__ const char* bptr(const Unit& u) const { return Bt + (((size_t)expert(u.pm) * N + (size_t)u.pn * BM) * K + (size_t)u.kt0 * BK) * 2; }
};
__device__ __forceinline__ void tail_params(int npan, int nN, int nkt, int G, int& tp, int& s) {
    const int rem = (npan * nN) % G;
    tp = 0; s = 1;
    if (rem == 0 || (rem % nN) != 0) return;
    int best = 1;
    if (nkt == 16) { if (rem * 4 <= G) best = 4; else if (rem * 2 <= G) best = 2; }
    else if (nkt == 44) { if (rem * 11 <= G) best = 11; else if (rem * 2 <= G) best = 2; }
    else if (nkt == 56) { if (rem * 14 <= G) best = 14; else if (rem * 7 <= G) best = 7; else if (rem * 4 <= G) best = 4; else if (rem * 2 <= G) best = 2; }
    if (best > 1) { tp = rem / nN; s = best; }
}

template <class Epi, class Sched>
__device__ __forceinline__ void gemm_phase(LAS unsigned char* lds, const int K, const Sched& S, const Epi& E, const int tid) {
    const int wid = __builtin_amdgcn_readfirstlane(tid >> 6), lane = tid & 63, wr = wid >> 2, wc = wid & 3, fr = lane & 15, fq = lane >> 4;
    unsigned voffA[2], voffB[2];
#pragma unroll
    for (int i = 0; i < 2; ++i) { int R, C; stage_rc(tid * 16 + i * 8192, R, C); const int Rb = Epi::PERM ? ((R & ~31) + perm32(R & 31)) : R;
        voffA[i] = (unsigned)(R * K + C) * 2u; voffB[i] = (unsigned)(Rb * K + C) * 2u; }
    const size_t kstep = (size_t)(BK * 2);
    const size_t hstep = (size_t)HALF * K * 2;
    const unsigned ldsw = (unsigned)wid * 1024u;
    const int aoff = lds_byte(wr * 64 + fr, fq * 8), boff = lds_byte(wc * 32 + fr, fq * 8);
#define PG8_SA(b, h) (((b) * 2 + (h)) * HTB)
#define PG8_SB(b, h) ((4 + (b) * 2 + (h)) * HTB)
#define PG8_STAGE(bufoff, gbase, voff) do { _Pragma("unroll") for (int _i = 0; _i < 2; ++_i) \
        __builtin_amdgcn_global_load_lds((const GAS unsigned*)((const GAS char*)(gbase) + (voff)[_i]), (LAS unsigned*)(lds + (bufoff) + ldsw + _i * 8192), 16, 0, 0); } while (0)
#define PG8_LDA(dst, b, h) do { _Pragma("unroll") for (int m = 0; m < 4; ++m) _Pragma("unroll") for (int k = 0; k < 2; ++k) dst[m][k] = *(const LAS bf16x8*)(lds + PG8_SA(b, h) + aoff + m * 2048 + k * 1024); } while (0)
#define PG8_LDB(dst, b, h) do { _Pragma("unroll") for (int n = 0; n < 2; ++n) _Pragma("unroll") for (int k = 0; k < 2; ++k) dst[n][k] = *(const LAS bf16x8*)(lds + PG8_SB(b, h) + boff + n * 2048 + k * 1024); } while (0)
#define PG8_MMA(ai, bj, At, Bt) do { __builtin_amdgcn_s_setprio(1); _Pragma("unroll") for (int m = 0; m < 4; ++m) _Pragma("unroll") for (int n = 0; n < 2; ++n) _Pragma("unroll") for (int k = 0; k < 2; ++k) \
        acc[ai][bj][m][n] = __builtin_amdgcn_mfma_f32_16x16x32_bf16(Bt[n][k], At[m][k], acc[ai][bj][m][n], 0, 0, 0); __builtin_amdgcn_s_setprio(0); } while (0)
#define PG8_WAIT_V(n) asm volatile("s_waitcnt vmcnt(" #n ")" ::: "memory")
#define PG8_WAIT_L(n) asm volatile("s_waitcnt lgkmcnt(" #n ")" ::: "memory")
#define PG8_BAR __builtin_amdgcn_s_barrier()
#define PG8_SCHED __builtin_amdgcn_sched_barrier(0)
    Unit cur, nxt; int ui = 0;
    if (!S.next(0, cur)) return;
    f32x4 acc[2][2][4][2];
#pragma unroll
    for (int a = 0; a < 2; ++a)
#pragma unroll
        for (int b = 0; b < 2; ++b)
#pragma unroll
            for (int m = 0; m < 4; ++m)
#pragma unroll
                for (int n = 0; n < 2; ++n) acc[a][b][m][n] = (f32x4){0.f, 0.f, 0.f, 0.f};
    bf16x8 At[4][2], B0[2][2], B1[2][2];
    const char* cA = S.aptr(cur); const char* cB = S.bptr(cur);
    PG8_STAGE(PG8_SB(0, 0), cB, voffB); PG8_STAGE(PG8_SB(0, 1), cB + hstep, voffB); PG8_STAGE(PG8_SA(0, 0), cA, voffA); PG8_STAGE(PG8_SA(0, 1), cA + hstep, voffA);
    if (wr == 1) PG8_BAR;
    PG8_WAIT_V(2); PG8_BAR;
    PG8_STAGE(PG8_SB(1, 0), cB + kstep, voffB); PG8_STAGE(PG8_SA(1, 0), cA + kstep, voffA); PG8_STAGE(PG8_SB(1, 1), cB + hstep + kstep, voffB);
    PG8_WAIT_V(6); PG8_BAR;
    for (;;) {
        const bool has_next = S.next(ui + 1, nxt);
        const char* nA = has_next ? S.aptr(nxt) : cA; const char* nB = has_next ? S.bptr(nxt) : cB;
        const int nt = cur.nkt;
        for (int t = 0; t < nt; t += 2) {
            const bool last = (t == nt - 2);
            const char* a1 = cA + (size_t)(t + 1) * kstep;
            const char* a2 = last ? nA : cA + (size_t)(t + 2) * kstep; const char* b2 = last ? nB : cB + (size_t)(t + 2) * kstep;
            const char* a3 = a2 + kstep; const char* b3 = b2 + kstep;
            PG8_LDB(B0, 0, 0); PG8_LDB(B1, 0, 1); PG8_SCHED; PG8_LDA(At, 0, 0); PG8_STAGE(PG8_SA(1, 1), a1 + hstep, voffA);
            PG8_WAIT_V(8); PG8_WAIT_L(0); PG8_BAR; PG8_MMA(0, 0, At, B0); PG8_MMA(0, 1, At, B1); PG8_BAR; PG8_SCHED;
            PG8_LDA(At, 0, 1); PG8_STAGE(PG8_SB(0, 0), b2, voffB); PG8_STAGE(PG8_SB(0, 1), b2 + hstep, voffB); PG8_STAGE(PG8_SA(0, 0), a2, voffA);
            PG8_WAIT_V(8); PG8_WAIT_L(0); PG8_BAR; PG8_MMA(1, 0, At, B0); PG8_MMA(1, 1, At, B1); PG8_BAR; PG8_SCHED;
            PG8_LDB(B0, 1, 0); PG8_LDB(B1, 1, 1); PG8_SCHED; PG8_LDA(At, 1, 0); PG8_STAGE(PG8_SA(0, 1), a2 + hstep, voffA);
            PG8_WAIT_V(8); PG8_WAIT_L(0); PG8_BAR; PG8_MMA(0, 0, At, B0); PG8_MMA(0, 1, At, B1); PG8_BAR; PG8_SCHED;
            PG8_LDA(At, 1, 1); PG8_STAGE(PG8_SB(1, 0), b3, voffB); PG8_STAGE(PG8_SB(1, 1), b3 + hstep, voffB); PG8_STAGE(PG8_SA(1, 0), a3, voffA);
            PG8_WAIT_V(8); PG8_WAIT_L(0); PG8_BAR; PG8_MMA(1, 0, At, B0); PG8_MMA(1, 1, At, B1); PG8_BAR; PG8_SCHED;
        }
        if (wr == 0) PG8_BAR;
        { int fr_ = fr, fq_ = fq; asm volatile("" : "+v"(fr_), "+v"(fq_));
          E(acc, cur, wr, wc, fr_, fq_); }
        if (!has_next) break;
#pragma unroll
        for (int a = 0; a < 2; ++a)
#pragma unroll
            for (int b = 0; b < 2; ++b)
#pragma unroll
                for (int m = 0; m < 4; ++m)
#pragma unroll
                    for (int n = 0; n < 2; ++n) acc[a][b][m][n] = (f32x4){0.f, 0.f, 0.f, 0.f};
        cur = nxt; cA = nA; cB = nB; ++ui;
        if (wr == 1) PG8_BAR;
    }
    PG8_WAIT_V(0);
    PG8_BAR;
#undef PG8_SA
#undef PG8_SB
#undef PG8_STAGE
#undef PG8_LDA
#undef PG8_LDB
#undef PG8_MMA
#undef PG8_WAIT_V
#undef PG8_WAIT_L
#undef PG8_BAR
#undef PG8_SCHED
}


struct EpiInProj {
    static constexpr bool PERM = true;
    bf16_t* P; float* Gt; const float* ropeC; const float* ropeS;
    __device__ __forceinline__ void operator()(const f32x4 (&acc)[2][2][4][2], const Unit& u, int wr, int wc, int fr, int fq) const {
        const int row0 = u.pm * BM + wr * 64 + fr;
        const bool latent = u.pm < (SEQ / BM);
#pragma unroll
        for (int bj = 0; bj < 2; ++bj) {
            const int colg = u.pn * BM + bj * HALF + wc * 32;
            const bool rope = latent && colg >= C_AQ && colg < C_AV;
            const bool gate = colg >= C_MG && colg < C_END;
            const int col0 = colg + 8 * fq;
#pragma unroll
            for (int ai = 0; ai < 2; ++ai)
#pragma unroll
                for (int m = 0; m < 4; ++m) {
                    const int row = row0 + ai * HALF + m * 16;
                    f32x4 v0 = acc[ai][bj][m][0], v1 = acc[ai][bj][m][1];
                    if (rope) {
                        const int pos = ((colg >> 5) & 1) ? (row & 63) : (row >> 6);
                        const f32x4 c0 = *(const f32x4*)(ropeC + pos * 16 + 8 * (fq & 1)), c1 = *(const f32x4*)(ropeC + pos * 16 + 8 * (fq & 1) + 4);
                        const f32x4 s0 = *(const f32x4*)(ropeS + pos * 16 + 8 * (fq & 1)), s1 = *(const f32x4*)(ropeS + pos * 16 + 8 * (fq & 1) + 4);
                        const float sg = (fq < 2) ? -1.f : 1.f;
                        f32x4 p0, p1;
#pragma unroll
                        for (int i = 0; i < 4; ++i) { p0[i] = __shfl_xor(v0[i], 32); p1[i] = __shfl_xor(v1[i], 32); }
#pragma unroll
                        for (int i = 0; i < 4; ++i) { v0[i] = v0[i] * c0[i] + sg * p0[i] * s0[i]; v1[i] = v1[i] * c1[i] + sg * p1[i] * s1[i]; }
                    }
                    u32x4 w; w.x = cvtpk(v0[0], v0[1]); w.y = cvtpk(v0[2], v0[3]); w.z = cvtpk(v1[0], v1[1]); w.w = cvtpk(v1[2], v1[3]);
                    *(u32x4*)(P + (size_t)row * LDP + col0) = w;
                    if (gate && col0 < C_END) { float* g = Gt + (size_t)row * 48 + (col0 - C_MG); *(f32x4*)g = v0; *(f32x4*)(g + 4) = v1; }
                    asm volatile("" ::: "memory");
                }
        }
    }
};
struct EpiResid {
    static constexpr bool PERM = false;
    const float* X; float* Y; const float* modl; const float* modc; float* YP; int tail_row0, tail_rows;
    __device__ __forceinline__ void operator()(const f32x4 (&acc)[2][2][4][2], const Unit& u, int wr, int wc, int fr, int fq) const {
        const int row0 = u.pm * BM + wr * 64 + fr, col0 = u.pn * BM + wc * 32 + 4 * fq;
        if (u.part >= 0) {
#pragma unroll
            for (int ai = 0; ai < 2; ++ai)
#pragma unroll
                for (int m = 0; m < 4; ++m) { float* rowp = YP + ((size_t)u.part * tail_rows + (row0 + ai * HALF + m * 16 - tail_row0)) * DM + col0;
#pragma unroll
                    for (int bj = 0; bj < 2; ++bj)
#pragma unroll
                        for (int n = 0; n < 2; ++n) *(f32x4*)(rowp + bj * HALF + n * 16) = acc[ai][bj][m][n]; }
            return;
        }
        const float* md = (u.pm < SEQ / BM) ? modl : modc;
        f32x4 mv[2][2];
#pragma unroll
        for (int bj = 0; bj < 2; ++bj)
#pragma unroll
            for (int n = 0; n < 2; ++n) mv[bj][n] = *(const f32x4*)(md + col0 + bj * HALF + n * 16);
#pragma unroll
        for (int ai = 0; ai < 2; ++ai)
#pragma unroll
            for (int m = 0; m < 4; ++m) { const size_t off = (size_t)(row0 + ai * HALF + m * 16) * DM + col0;
#pragma unroll
                for (int bj = 0; bj < 2; ++bj)
#pragma unroll
                    for (int n = 0; n < 2; ++n) { const f32x4 xv = *(const f32x4*)(X + off + bj * HALF + n * 16);
                        *(f32x4*)(Y + off + bj * HALF + n * 16) = xv * ALPHA + mv[bj][n] * acc[ai][bj][m][n]; }
                asm volatile("" ::: "memory"); }
    }
};
struct EpiSwiglu {
    static constexpr bool PERM = true;
    bf16_t* O; int ld;
    __device__ __forceinline__ void operator()(const f32x4 (&acc)[2][2][4][2], const Unit& u, int wr, int wc, int fr, int fq) const {
        const int row0 = u.pm * BM + wr * 64 + fr, col0 = u.pn * HALF + wc * 32 + 8 * fq;
#pragma unroll
        for (int ai = 0; ai < 2; ++ai)
#pragma unroll
            for (int m = 0; m < 4; ++m) {
                const f32x4 g0 = acc[ai][0][m][0], g1 = acc[ai][0][m][1], u0 = acc[ai][1][m][0], u1 = acc[ai][1][m][1];
                float r[8];
#pragma unroll
                for (int i = 0; i < 4; ++i) { r[i] = siluf(g0[i]) * u0[i]; r[4 + i] = siluf(g1[i]) * u1[i]; }
                u32x4 w; w.x = cvtpk(r[0], r[1]); w.y = cvtpk(r[2], r[3]); w.z = cvtpk(r[4], r[5]); w.w = cvtpk(r[6], r[7]);
                *(u32x4*)(O + (size_t)(row0 + ai * HALF + m * 16) * ld + col0) = w;
            }
    }
};
struct EpiF32 {
    static constexpr bool PERM = false;
    float* C; float* YP; int tail_row0, tail_rows;
    __device__ __forceinline__ void operator()(const f32x4 (&acc)[2][2][4][2], const Unit& u, int wr, int wc, int fr, int fq) const {
        const int row0 = u.pm * BM + wr * 64 + fr, col0 = u.pn * BM + wc * 32 + 4 * fq;
        float* base = (u.part >= 0) ? YP + ((size_t)u.part * tail_rows - tail_row0) * DM : C;
#pragma unroll
        for (int ai = 0; ai < 2; ++ai)
#pragma unroll
            for (int m = 0; m < 4; ++m) { float* rowp = base + (size_t)(row0 + ai * HALF + m * 16) * DM + col0;
#pragma unroll
                for (int bj = 0; bj < 2; ++bj)
#pragma unroll
                    for (int n = 0; n < 2; ++n) *(f32x4*)(rowp + bj * HALF + n * 16) = acc[ai][bj][m][n]; }
    }
};
}

#define XB_TMO      128
#define XB_XCNT(j)  (256  + 64 * (j))
#define XB_XSUB(j)  (1280 + 64 * (j))
#define XB_XGEN(j)  (2304 + 64 * (j))
#define XB_TOP      3328
#define XB_TOPGEN   3392
#define XCD_BAR_WORDS 3456
#define XB_SPIN_CAP (1u << 18)
__device__ __forceinline__ unsigned xb_ld(unsigned* p)              { return __hip_atomic_load(p, __ATOMIC_RELAXED, __HIP_MEMORY_SCOPE_AGENT); }
__device__ __forceinline__ unsigned xb_add(unsigned* p, unsigned v) { return __hip_atomic_fetch_add(p, v, __ATOMIC_RELAXED, __HIP_MEMORY_SCOPE_AGENT); }
__device__ __forceinline__ unsigned xb_xcc_id() { return (unsigned)__builtin_amdgcn_s_getreg((3 << 11) | 20) & 0xFu; }
#define XB_SPIN(cond, bar) do { unsigned _sp = 0; while (cond) { __builtin_amdgcn_s_sleep(1); \
    if ((++_sp & 255u) == 0u) { if (xb_ld(&(bar)[XB_TMO])) break; if (_sp > XB_SPIN_CAP) { atomicAdd(&(bar)[XB_TMO], 1u); break; } } } } while (0)
struct XcdBarrier { unsigned* bar; unsigned x; volatile LAS unsigned* st; };
__device__ __forceinline__ XcdBarrier xcd_barrier_post(unsigned* bar, volatile LAS unsigned* st) {
    XcdBarrier b; b.bar = bar; b.x = xb_xcc_id(); b.st = st;
    if (threadIdx.x == 0) (void)xb_add(&bar[XB_XCNT(b.x)], 1u);
    return b;
}
__device__ __forceinline__ void xcd_barrier_complete(unsigned* bar, unsigned x, unsigned& nloc, unsigned& nx) {
    const unsigned G = gridDim.x * gridDim.y * gridDim.z;
    unsigned sum, cnt, mine, sp = 0u;
    for (;;) {
        sum = 0u; cnt = 0u; mine = 0u;
#pragma unroll
        for (unsigned j = 0; j < 16; ++j) { const unsigned c = xb_ld(&bar[XB_XCNT(j)]); sum += c; cnt += (c > 0u) ? 1u : 0u; mine = (j == x) ? c : mine; }
        if (sum == G) break;
        __builtin_amdgcn_s_sleep(1);
        if ((++sp & 255u) == 0u) { if (xb_ld(&bar[XB_TMO])) break; if (sp > XB_SPIN_CAP) { atomicAdd(&bar[XB_TMO], 1u); break; } }
    }
    nloc = mine > 0u ? mine : 1u; nx = cnt > 0u ? cnt : 1u;
}
__device__ __forceinline__ void xcd_barrier(const XcdBarrier& b) {
    asm volatile("s_waitcnt vmcnt(0)" ::: "memory");
    __syncthreads();
    if (threadIdx.x == 0) {
        unsigned* bar = b.bar;
        __builtin_amdgcn_s_waitcnt(0);
        unsigned nloc = b.st[0], nx = b.st[1];
        if (nloc == 0u) { xcd_barrier_complete(bar, b.x, nloc, nx); b.st[0] = nloc; b.st[1] = nx; }
        const unsigned old = xb_add(&bar[XB_XSUB(b.x)], 1u);
        const unsigned gen = old / nloc;
        if (old + 1u == (gen + 1u) * nloc) {
            __builtin_amdgcn_fence(__ATOMIC_RELEASE, "agent");
            asm volatile("s_waitcnt vmcnt(0)" ::: "memory");
            const unsigned og = xb_add(&bar[XB_TOP], 1u);
            const unsigned tg = og / nx;
            if (og + 1u == (tg + 1u) * nx) xb_add(&bar[XB_TOPGEN], 1u);
            else XB_SPIN(xb_ld(&bar[XB_TOPGEN]) == tg, bar);
            __builtin_amdgcn_fence(__ATOMIC_ACQUIRE, "agent");
            xb_add(&bar[XB_XGEN(b.x)], 1u);
            asm volatile("s_waitcnt vmcnt(0)" ::: "memory");
        } else {
            XB_SPIN(xb_ld(&bar[XB_XGEN(b.x)]) == gen, bar);
            __builtin_amdgcn_fence(__ATOMIC_ACQUIRE, "agent");
            asm volatile("s_waitcnt vmcnt(0)" ::: "memory");
        }
    }
    __syncthreads();
}

struct Args { const float* in[22]; float* out; unsigned char* ws; int ph_lo, ph_hi; };

__device__ __forceinline__ int in_srccol(int r, float& sc) {
    sc = 1.f;
    if (r < 1024) { if (r >= C_MK && r < C_MV) sc = 0.125f; return r; }
    if (r < C_MG) { if (r < C_AK) sc = 0.125f * 1.4426950408889634f; else if (r >= C_GQ && r < C_GK) sc = 0.17677669529663687f; return r + 16; }
    if (r < C_GGT) return r - C_MG + 1024;
    if (r < C_END) return r;
    return -1;
}
__device__ __forceinline__ void tr_item(const float* W, int K, int N, int NP, bf16_t* WT, int mode, int half, LAS float* scr, int item, int lane) {
    const int nblk = NP >> 6, kb = item / nblk, nb = item - kb * nblk, k0 = kb << 6, n0 = nb << 6;
    const int r = n0 + lane; float sc = 1.f; int src;
    if (mode == 0) src = r; else if (mode == 1) src = in_srccol(r, sc); else { const int pn = r >> 8, w = r & 255; src = (w < 128) ? (pn * 128 + w) : (half + pn * 128 + w - 128); }
    const float* wp = W + (size_t)k0 * N + (src < 0 ? 0 : src);
#pragma unroll 16
    for (int i = 0; i < 64; ++i) { const float v = wp[(size_t)i * N]; scr[i * 65 + lane] = (src < 0) ? 0.f : v * sc; }
    LDS_WAIT();
    const int c = lane & 7;
#pragma unroll
    for (int j = 0; j < 8; ++j) { const int n = (lane >> 3) + 8 * j; const LAS float* s = scr + (8 * c) * 65 + n;
        uint4 o; o.x = pk2(s[0], s[65]); o.y = pk2(s[130], s[195]); o.z = pk2(s[260], s[325]); o.w = pk2(s[390], s[455]);
        *(uint4*)(WT + (size_t)(n0 + n) * K + k0 + 8 * c) = o; }
    LDS_WAIT();
}

__device__ __forceinline__ void chunk_rows(int d, int jc, int& base, int& step) {
    int oc;
    if (d == 0) oc = (jc < 4) ? 256 + jc : jc - 4; else oc = (jc < 4) ? 256 + (3 - jc) : 255 - (jc - 4);
    const int b0 = (oc < 256) ? oc * 64 : SEQ + (oc - 256) * 64;
    if (d == 0) { base = b0; step = 1; } else { base = b0 + 63; step = -1; }
}
__device__ __forceinline__ int oc_to_jc(int d, int oc) { if (d == 0) return oc < 256 ? oc + 4 : oc - 256; return oc < 256 ? 4 + (255 - oc) : 3 - (oc - 256); }

constexpr int AT_RS = 144, AT_TILE = 128 * AT_RS;
__device__ __forceinline__ void attn_unit(LAS unsigned char* lds, const bf16_t* P, bf16_t* CAT, int qb  , int cqb, int kvh, const float* sink, int tid, int lane, int wave) {
    const bool is_ctx = qb < 0;
    const int g = lane >> 4, i = lane & 15;
    const int hq = kvh * 4 + (wave >> 1), qh = wave & 1;
    const int qrow0 = (is_ctx ? SEQ + cqb * 128 : qb * 128) + qh * 64;
    bf16x8 bq[4][2];
#pragma unroll
    for (int qt = 0; qt < 4; ++qt)
#pragma unroll
        for (int ks = 0; ks < 2; ++ks) bq[qt][ks] = *(const bf16x8*)(P + (size_t)(qrow0 + 16 * qt + i) * LDP + C_AQ + hq * 64 + 32 * ks + 8 * g);
    f32x4 O[4][4];
#pragma unroll
    for (int dt = 0; dt < 4; ++dt)
#pragma unroll
        for (int qt = 0; qt < 4; ++qt) O[dt][qt] = (f32x4){0.f, 0.f, 0.f, 0.f};
    float m[4], l[4];
    { const float sk = sink[hq] * 1.4426950408889634f;
#pragma unroll
      for (int qt = 0; qt < 4; ++qt) { m[qt] = sk; l[qt] = (g == 0) ? 1.f : 0.f; } }
#define AT_VALID(c) ((c) >= 3 || (!is_ctx && (qb - 1 + (c)) >= 0 && (qb - 1 + (c)) < SEQ / 128))
#define AT_ROW(c) ((c) >= 3 ? SEQ + ((c) - 3) * 128 : (qb - 1 + (c)) * 128)
    u32x4 kreg[2], vreg[2];
    int c = 0; while (!AT_VALID(c)) ++c;
    __syncthreads();
#pragma unroll
    for (int t = 0; t < 2; ++t) { const int idx = tid + 512 * t, r = idx >> 3, ch = idx & 7; const bf16_t* src = P + (size_t)(AT_ROW(c) + r) * LDP + kvh * 64 + ch * 8;
        kreg[t] = *(const u32x4*)(src + C_AK); vreg[t] = *(const u32x4*)(src + C_AV); }
    int buf = 0;
#pragma unroll
    for (int t = 0; t < 2; ++t) { const int idx = tid + 512 * t, r = idx >> 3, ch = idx & 7; *(LAS u32x4*)(lds + r * AT_RS + ch * 16) = kreg[t]; *(LAS u32x4*)(lds + AT_TILE + r * AT_RS + ch * 16) = vreg[t]; }
    __syncthreads();
    while (c < 5) {
        int cn = c + 1; while (cn < 5 && !AT_VALID(cn)) ++cn;
        if (cn < 5) {
#pragma unroll
            for (int t = 0; t < 2; ++t) { const int idx = tid + 512 * t, r = idx >> 3, ch = idx & 7; const bf16_t* src = P + (size_t)(AT_ROW(cn) + r) * LDP + kvh * 64 + ch * 8;
                kreg[t] = *(const u32x4*)(src + C_AK); vreg[t] = *(const u32x4*)(src + C_AV); }
        }
        const LAS unsigned char* Kb = lds + buf * 2 * AT_TILE; const LAS unsigned char* Vb = Kb + AT_TILE;
        const bool lo_blk = (!is_ctx && c == 0), hi_blk = (!is_ctx && c == 2);
        for (int grp = 0; grp < 4; ++grp) {
            if (lo_blk && qh == 1 && grp < 2) continue;
            if (hi_blk && qh == 0 && grp >= 2) continue;
            bf16x8 kf[2][2], vf[4];
#pragma unroll
            for (int kt = 0; kt < 2; ++kt)
#pragma unroll
                for (int ks = 0; ks < 2; ++ks) kf[kt][ks] = *(const LAS bf16x8*)(Kb + (grp * 32 + kt * 16 + i) * AT_RS + (32 * ks + 8 * g) * 2);
#pragma unroll
            for (int dt = 0; dt < 4; ++dt) { const LAS unsigned char* vp = Vb + (grp * 32 + 4 * g + (i >> 2)) * AT_RS + (16 * dt + 4 * (i & 3)) * 2;
                vf[dt] = cat44(ds_tr16(vp), ds_tr16(vp + 16 * AT_RS)); }
#pragma unroll
            for (int qt = 0; qt < 4; ++qt) {
                f32x4 s0 = (f32x4){0.f, 0.f, 0.f, 0.f}, s1 = s0;
#pragma unroll
                for (int ks = 0; ks < 2; ++ks) { s0 = MFMA16(kf[0][ks], bq[qt][ks], s0); s1 = MFMA16(kf[1][ks], bq[qt][ks], s1); }
                if (lo_blk || hi_blk) {
                    const int qo = qh * 64 + qt * 16 + i, ko = grp * 32 + 4 * g;
#pragma unroll
                    for (int r = 0; r < 4; ++r) {
                        const bool v0 = lo_blk ? (ko + r >= qo) : (ko + r <= qo), v1 = lo_blk ? (ko + 16 + r >= qo) : (ko + 16 + r <= qo);
                        s0[r] = v0 ? s0[r] : -INFINITY; s1[r] = v1 ? s1[r] : -INFINITY; }
                }
                float mx = fmaxf(fmaxf(fmaxf(s0[0], s0[1]), fmaxf(s0[2], s0[3])), fmaxf(fmaxf(s1[0], s1[1]), fmaxf(s1[2], s1[3])));
                mx = grp_max(mx);
                if (__any(mx > m[qt])) {
                    const float mn = fmaxf(m[qt], mx), alpha = __builtin_amdgcn_exp2f(m[qt] - mn);
                    m[qt] = mn; l[qt] *= alpha;
#pragma unroll
                    for (int dt = 0; dt < 4; ++dt) O[dt][qt] = O[dt][qt] * alpha;
                }
                const float mq = m[qt];
                float ps = 0.f;
#pragma unroll
                for (int r = 0; r < 4; ++r) { s0[r] = __builtin_amdgcn_exp2f(s0[r] - mq); s1[r] = __builtin_amdgcn_exp2f(s1[r] - mq); ps += s0[r] + s1[r]; }
                l[qt] += ps;
                u32x4 pw; pw.x = cvtpk(s0[0], s0[1]); pw.y = cvtpk(s0[2], s0[3]); pw.z = cvtpk(s1[0], s1[1]); pw.w = cvtpk(s1[2], s1[3]);
                const bf16x8 pb = __builtin_bit_cast(bf16x8, pw);
#pragma unroll
                for (int dt = 0; dt < 4; ++dt) O[dt][qt] = MFMA16(vf[dt], pb, O[dt][qt]);
            }
        }
        if (cn < 5) {
            LAS unsigned char* nb = lds + (buf ^ 1) * 2 * AT_TILE;
#pragma unroll
            for (int t = 0; t < 2; ++t) { const int idx = tid + 512 * t, r = idx >> 3, ch = idx & 7; *(LAS u32x4*)(nb + r * AT_RS + ch * 16) = kreg[t]; *(LAS u32x4*)(nb + AT_TILE + r * AT_RS + ch * 16) = vreg[t]; }
        }
        __syncthreads();
        buf ^= 1; c = cn;
    }
#undef AT_VALID
#undef AT_ROW
#pragma unroll
    for (int qt = 0; qt < 4; ++qt) {
        const float inv = 1.f / grp_sum(l[qt]);
        bf16_t* dst = CAT + (size_t)(qrow0 + 16 * qt + i) * DM + 256 + hq * 64 + 4 * g;
#pragma unroll
        for (int dt = 0; dt < 4; ++dt) { uint2 o; o.x = cvtpk(O[dt][qt][0] * inv, O[dt][qt][1] * inv); o.y = cvtpk(O[dt][qt][2] * inv, O[dt][qt][3] * inv); *(uint2*)(dst + 16 * dt) = o; }
    }
}

constexpr int CH_RS = 144;
constexpr int CH_T = 64 * CH_RS;
constexpr int GL_RS = 80;
constexpr int GL_T = 64 * GL_RS;
__device__ __forceinline__ int chunk_b0(int oc) { return (oc < 256) ? oc * 64 : SEQ + (oc - 256) * 64; }
__device__ __forceinline__ bf16x8 tr_frag(const LAS unsigned char* tile, int rs, int row0, int col0, int lane) {
    const int g = lane >> 4, i = lane & 15; const LAS unsigned char* p = tile + (row0 + 8 * g + (i >> 2)) * rs + (col0 + 4 * (i & 3)) * 2;
    return cat44(ds_tr16(p), ds_tr16(p + 4 * rs));
}
__device__ __forceinline__ bf16x8 tr_frag_perm(const LAS unsigned char* tile, int rs, int row0, int col0, int lane) {
    const int g = lane >> 4, i = lane & 15; const LAS unsigned char* p = tile + (row0 + 4 * g + (i >> 2)) * rs + (col0 + 4 * (i & 3)) * 2;
    return cat44(ds_tr16(p), ds_tr16(p + 16 * rs));
}
__device__ __forceinline__ void unpack8(const u32x4 v, float* o) {
    o[0] = __uint_as_float(v.x << 16); o[1] = __uint_as_float(v.x & 0xffff0000u); o[2] = __uint_as_float(v.y << 16); o[3] = __uint_as_float(v.y & 0xffff0000u);
    o[4] = __uint_as_float(v.z << 16); o[5] = __uint_as_float(v.z & 0xffff0000u); o[6] = __uint_as_float(v.w << 16); o[7] = __uint_as_float(v.w & 0xffff0000u);
}
__device__ __forceinline__ u32x4 pack8(const float* f) { u32x4 w; w.x = cvtpk(f[0], f[1]); w.y = cvtpk(f[2], f[3]); w.z = cvtpk(f[4], f[5]); w.w = cvtpk(f[6], f[7]); return w; }

#define LBAR() do { asm volatile("s_waitcnt lgkmcnt(0)" ::: "memory"); __builtin_amdgcn_s_barrier(); asm volatile("" ::: "memory"); } while (0)

struct MsRaw { u32x4 k, v; float ig, fg, gbi, gbf; };
__device__ __forceinline__ MsRaw mlstm_summary_load(const bf16_t* P, const float* Gt, const float* gate_b, int h, int oc, int tid, int lane, int wave) {
    MsRaw R; const int b0 = chunk_b0(oc), r = tid >> 3, ch = tid & 7;
    R.k = *(const u32x4*)(P + (size_t)(b0 + r) * LDP + C_MK + h * 64 + ch * 8); R.v = *(const u32x4*)(P + (size_t)(b0 + r) * LDP + C_MV + h * 64 + ch * 8);
    { const int d = wave & 1, sp = d ? 63 - lane : lane, row = b0 + sp;
      R.ig = Gt[(size_t)row * 48 + d * 8 + h]; R.gbi = gate_b[d * 8 + h]; R.fg = Gt[(size_t)row * 48 + d * 8 + 4 + h]; R.gbf = gate_b[d * 8 + 4 + h]; }
    return R;
}
__device__ __forceinline__ void mlstm_summary_body(LAS unsigned char* lds, const MsRaw& R, float* MU, float* MNU, float* MSC, int h, int oc, int tid, int lane, int wave) {
    LAS unsigned char* Kw0 = lds; LAS unsigned char* Kw1 = lds + CH_T; LAS unsigned char* Vt = lds + 2 * CH_T; LAS float* wv = (LAS float*)(lds + 3 * CH_T);
    const int r = tid >> 3, ch = tid & 7;
    LBAR();
    if (wave < 2) {
        const int d = wave, sp = d ? 63 - lane : lane, hd = h * 2 + d, jc = oc_to_jc(d, oc);
        const float lf = log_sigmoidf_(R.fg + R.gbf);
        const float bb = scan_add(lf, lane);
        const float av = (R.ig + R.gbi) - bb;
        const float cm = wave_max(av);
        const float B = __shfl(bb, 63);
        wv[d * 64 + sp] = __expf(av - cm);
        if (lane == 0) { MSC[(size_t)(hd * NCH + jc) * 4 + 0] = cm; MSC[(size_t)(hd * NCH + jc) * 4 + 1] = B; }
    }
    *(LAS u32x4*)(Vt + r * CH_RS + ch * 16) = R.v;
    LBAR();
    { float kf[8], t0[8], t1[8]; unpack8(R.k, kf); const float w0 = wv[r], w1 = wv[64 + r];
#pragma unroll
      for (int j = 0; j < 8; ++j) { t0[j] = kf[j] * w0; t1[j] = kf[j] * w1; }
      *(LAS u32x4*)(Kw0 + r * CH_RS + ch * 16) = pack8(t0); *(LAS u32x4*)(Kw1 + r * CH_RS + ch * 16) = pack8(t1); }
    LBAR();
    { const int d = wave >> 2, dkt = wave & 3, g = lane >> 4, i = lane & 15, hd = h * 2 + d, jc = oc_to_jc(d, oc);
      const LAS unsigned char* Kw = d ? Kw1 : Kw0;
      const bf16x8 a0 = tr_frag(Kw, CH_RS, 0, 16 * dkt, lane), a1 = tr_frag(Kw, CH_RS, 32, 16 * dkt, lane);
      float* dst = MU + ((size_t)(hd * 64 + 16 * dkt + i) * NCH + jc) * 64 + 4 * g;
#pragma unroll
      for (int dvt = 0; dvt < 4; ++dvt) {
          f32x4 c = (f32x4){0.f, 0.f, 0.f, 0.f};
          c = MFMA16(tr_frag(Vt, CH_RS, 0, 16 * dvt, lane), a0, c); c = MFMA16(tr_frag(Vt, CH_RS, 32, 16 * dvt, lane), a1, c);
          *(f32x4*)(dst + 16 * dvt) = c;
      }
      const short one = (i == 0) ? (short)0x3F80 : (short)0; const bf16x8 bo = (bf16x8){one, one, one, one, one, one, one, one};
      f32x4 c1 = (f32x4){0.f, 0.f, 0.f, 0.f}; c1 = MFMA16(a0, bo, c1); c1 = MFMA16(a1, bo, c1);
      if (i == 0) *(f32x4*)(MNU + (size_t)(hd * NCH + jc) * 64 + 16 * dkt + 4 * g) = c1; }
}

struct MoRaw { u32x4 q, k, v, c0, c1; float ig, fg, gbi, gbf, mst, nv; uint2 og[4]; };
__device__ __forceinline__ MoRaw mlstm_out_load(const bf16_t* P, const float* Gt, const float* gate_b, const bf16_t* MC, const float* MNS, const float* MSC, int h, int oc, int tid, int lane, int wave) {
    MoRaw R; const int b0 = chunk_b0(oc), r = tid >> 3, ch = tid & 7;
    const size_t ro = (size_t)(b0 + r) * LDP + h * 64 + ch * 8;
    R.q = *(const u32x4*)(P + ro + C_MQ); R.k = *(const u32x4*)(P + ro + C_MK); R.v = *(const u32x4*)(P + ro + C_MV);
    const int jc0 = oc_to_jc(0, oc), jc1 = oc_to_jc(1, oc);
    R.c0 = *(const u32x4*)(MC + ((size_t)((h * 2 + 0) * 64 + r) * NCH + jc0) * 64 + ch * 8); R.c1 = *(const u32x4*)(MC + ((size_t)((h * 2 + 1) * 64 + r) * NCH + jc1) * 64 + ch * 8);
    { const int d = wave & 1, sp = d ? 63 - lane : lane, row = b0 + sp, hd = h * 2 + d, jc = d ? jc1 : jc0;
        R.ig = Gt[(size_t)row * 48 + d * 8 + h]; R.gbi = gate_b[d * 8 + h]; R.fg = Gt[(size_t)row * 48 + d * 8 + 4 + h]; R.gbf = gate_b[d * 8 + 4 + h];
        R.mst = MSC[(size_t)(hd * NCH + jc) * 4 + 2]; R.nv = MNS[(size_t)(hd * NCH + jc) * 64 + lane]; }
    { const int tt = wave & 3, g = lane >> 4, i = lane & 15, row = b0 + 16 * tt + i;
#pragma unroll
      for (int dvt = 0; dvt < 4; ++dvt) R.og[dvt] = *(const uint2*)(P + (size_t)row * LDP + C_MO + h * 64 + 16 * dvt + 4 * g); }
    return R;
}
__device__ __forceinline__ void mlstm_out_body(LAS unsigned char* lds, const MoRaw& R, const float* normw, bf16_t* CAT, int h, int oc, int tid, int lane, int wave) {
    LAS unsigned char* Qt = lds; LAS unsigned char* Kt = lds + CH_T; LAS unsigned char* Vt = lds + 2 * CH_T; LAS unsigned char* Ct = lds + 3 * CH_T;
    LAS float* arr = (LAS float*)(lds + 5 * CH_T);
    LAS f32x4* hs = (LAS f32x4*)(lds + 5 * CH_T + 2 * 320 * 4);
    const int b0 = chunk_b0(oc);
    const int r = tid >> 3, ch = tid & 7;
    LBAR();
    if (wave < 2) {
        const int d = wave, sp = d ? 63 - lane : lane;
        const float lf = log_sigmoidf_(R.fg + R.gbf);
        const float bb = scan_add(lf, lane);
        const float av = (R.ig + R.gbi) - bb;
        const float cm = scan_max(av, lane);
        const float mx = fmaxf(R.mst, cm);
        LAS float* A = arr + d * 320;
        A[sp] = av; A[64 + sp] = mx; A[128 + sp] = __expf(R.mst - mx); A[192 + sp] = __expf(-(bb + mx));
        A[256 + lane] = R.nv;
    }
    *(LAS u32x4*)(Qt + r * CH_RS + ch * 16) = R.q; *(LAS u32x4*)(Kt + r * CH_RS + ch * 16) = R.k; *(LAS u32x4*)(Vt + r * CH_RS + ch * 16) = R.v;
    *(LAS u32x4*)(Ct + r * CH_RS + ch * 16) = R.c0; *(LAS u32x4*)(Ct + CH_T + r * CH_RS + ch * 16) = R.c1;
    LBAR();
    const int d = wave >> 2, tt = wave & 3, g = lane >> 4, i = lane & 15, t = 16 * tt + i;
    f32x4 hh[4];
    {
        const LAS float* A = arr + d * 320;
        const float mxt = A[64 + t], wt = A[128 + t], emt = A[192 + t];
        bf16x8 bq[2], bqw[2]; float qn = 0.f;
#pragma unroll
        for (int ks = 0; ks < 2; ++ks) { const u32x4 raw = *(const LAS u32x4*)(Qt + t * CH_RS + (32 * ks + 8 * g) * 2); bq[ks] = __builtin_bit_cast(bf16x8, raw);
            float qf[8], qw[8]; unpack8(raw, qf);
            const f32x4 n0 = *(const LAS f32x4*)(A + 256 + 32 * ks + 8 * g), n1 = *(const LAS f32x4*)(A + 256 + 32 * ks + 8 * g + 4);
#pragma unroll
            for (int j = 0; j < 4; ++j) { qn += qf[j] * n0[j] + qf[4 + j] * n1[j]; }
#pragma unroll
            for (int j = 0; j < 8; ++j) qw[j] = qf[j] * wt;
            bqw[ks] = __builtin_bit_cast(bf16x8, pack8(qw)); }
        qn += __shfl_xor(qn, 16); qn += __shfl_xor(qn, 32);
        float dsum = 0.f; f32x4 sT[4];
#pragma unroll
        for (int st = 0; st < 4; ++st) {
            f32x4 c = (f32x4){0.f, 0.f, 0.f, 0.f};
#pragma unroll
            for (int ks = 0; ks < 2; ++ks) c = MFMA16(*(const LAS bf16x8*)(Kt + (16 * st + i) * CH_RS + (32 * ks + 8 * g) * 2), bq[ks], c);
            const f32x4 a4 = *(const LAS f32x4*)(A + 16 * st + 4 * g);
#pragma unroll
            for (int rr = 0; rr < 4; ++rr) { const int sidx = 16 * st + 4 * g + rr; const bool ok = d ? (sidx >= t) : (sidx <= t);
                const float val = ok ? c[rr] * __expf(a4[rr] - mxt) : 0.f; sT[st][rr] = val; dsum += val; }
        }
        dsum += __shfl_xor(dsum, 16); dsum += __shfl_xor(dsum, 32);
        const float den = dsum + wt * qn, inv = 1.f / fmaxf(fabsf(den), emt);
        bf16x8 pb[2];
#pragma unroll
        for (int gp = 0; gp < 2; ++gp) { u32x4 w; w.x = cvtpk(sT[2 * gp][0], sT[2 * gp][1]); w.y = cvtpk(sT[2 * gp][2], sT[2 * gp][3]); w.z = cvtpk(sT[2 * gp + 1][0], sT[2 * gp + 1][1]); w.w = cvtpk(sT[2 * gp + 1][2], sT[2 * gp + 1][3]); pb[gp] = __builtin_bit_cast(bf16x8, w); }
        const LAS unsigned char* Cd = Ct + d * CH_T;
#pragma unroll
        for (int dvt = 0; dvt < 4; ++dvt) {
            f32x4 c = (f32x4){0.f, 0.f, 0.f, 0.f};
            c = MFMA16(tr_frag_perm(Vt, CH_RS, 0, 16 * dvt, lane), pb[0], c); c = MFMA16(tr_frag_perm(Vt, CH_RS, 32, 16 * dvt, lane), pb[1], c);
            c = MFMA16(tr_frag(Cd, CH_RS, 0, 16 * dvt, lane), bqw[0], c); c = MFMA16(tr_frag(Cd, CH_RS, 32, 16 * dvt, lane), bqw[1], c);
            hh[dvt] = c * inv;
        }
        if (d == 1) {
#pragma unroll
            for (int dvt = 0; dvt < 4; ++dvt) hs[(tt * 4 + dvt) * 64 + lane] = hh[dvt];
        }
    }
    LBAR();
    if (d == 0) {
        float s1 = 0.f;
#pragma unroll
        for (int dvt = 0; dvt < 4; ++dvt) { hh[dvt] = hh[dvt] + hs[(tt * 4 + dvt) * 64 + lane]; s1 += (hh[dvt][0] + hh[dvt][1]) + (hh[dvt][2] + hh[dvt][3]); }
        s1 += __shfl_xor(s1, 16); s1 += __shfl_xor(s1, 32);
        const float mu = s1 * (1.f / 64.f); float s2 = 0.f;
#pragma unroll
        for (int dvt = 0; dvt < 4; ++dvt) { hh[dvt] = hh[dvt] - mu; s2 += (hh[dvt][0] * hh[dvt][0] + hh[dvt][1] * hh[dvt][1]) + (hh[dvt][2] * hh[dvt][2] + hh[dvt][3] * hh[dvt][3]); }
        s2 += __shfl_xor(s2, 16); s2 += __shfl_xor(s2, 32);
        const float rstd = rsqrtf(s2 * (1.f / 64.f) + LN_EPS);
        const int row = b0 + t;
#pragma unroll
        for (int dvt = 0; dvt < 4; ++dvt) { const int col = h * 64 + 16 * dvt + 4 * g;
            const uint2 og = R.og[dvt]; const f32x4 nw = *(const f32x4*)(normw + col);
            const float o0 = hh[dvt][0] * rstd * nw[0] * sigmoidf_(__uint_as_float(og.x << 16)), o1 = hh[dvt][1] * rstd * nw[1] * sigmoidf_(__uint_as_float(og.x & 0xffff0000u));
            const float o2 = hh[dvt][2] * rstd * nw[2] * sigmoidf_(__uint_as_float(og.y << 16)), o3 = hh[dvt][3] * rstd * nw[3] * sigmoidf_(__uint_as_float(og.y & 0xffff0000u));
            uint2 o; o.x = cvtpk(o0, o1); o.y = cvtpk(o2, o3); *(uint2*)(CAT + (size_t)row * DM + col) = o; }
    }
}

struct GgRaw { f32x4 g0, g1, g2, g3; };
__device__ __forceinline__ GgRaw gla_gates_load(const float* Gt, int b0, int lane, int wave) {
    const int d = wave >> 2, sp = d ? 63 - lane : lane; const float* gs = Gt + (size_t)(b0 + sp) * 48 + 16 + d * 16;
    GgRaw R; R.g0 = *(const f32x4*)gs; R.g1 = *(const f32x4*)(gs + 4); R.g2 = *(const f32x4*)(gs + 8); R.g3 = *(const f32x4*)(gs + 12); return R;
}
__device__ __forceinline__ void gla_gates_wave(const GgRaw& R, const LAS float* g_up, const LAS float* g_b, int h, int lane, int wave, float (&bc)[8]) {
    const int d = wave >> 2, dk0 = 8 * (wave & 3);
    const float gv[16] = {R.g0[0], R.g0[1], R.g0[2], R.g0[3], R.g1[0], R.g1[1], R.g1[2], R.g1[3], R.g2[0], R.g2[1], R.g2[2], R.g2[3], R.g3[0], R.g3[1], R.g3[2], R.g3[3]};
    float z[8];
    { const f32x4 b0 = *(const LAS f32x4*)(g_b + d * 128 + h * 32 + dk0), b1 = *(const LAS f32x4*)(g_b + d * 128 + h * 32 + dk0 + 4);
#pragma unroll
      for (int c = 0; c < 4; ++c) { z[c] = b0[c]; z[4 + c] = b1[c]; } }
#pragma unroll
    for (int rr = 0; rr < 16; ++rr) { const f32x4 u0 = *(const LAS f32x4*)(g_up + (d * 16 + rr) * 128 + h * 32 + dk0), u1 = *(const LAS f32x4*)(g_up + (d * 16 + rr) * 128 + h * 32 + dk0 + 4);
#pragma unroll
        for (int c = 0; c < 4; ++c) { z[c] += gv[rr] * u0[c]; z[4 + c] += gv[rr] * u1[c]; } }
#pragma unroll
    for (int c = 0; c < 8; ++c) bc[c] = scan_add(log_sigmoidf_(z[c]) * (1.f / 16.f), lane);
}
struct GsRaw { u32x4 v, k; GgRaw gg; };
__device__ __forceinline__ GsRaw gla_summary_load(const bf16_t* P, const float* Gt, int h, int oc, int tid, int lane, int wave) {
    GsRaw R; const int b0 = chunk_b0(oc), r = tid >> 3, ch = tid & 7, d = wave >> 2, dk0 = 8 * (wave & 3), sp = d ? 63 - lane : lane;
    R.v = *(const u32x4*)(P + (size_t)(b0 + r) * LDP + C_GV + h * 64 + ch * 8);
    R.k = *(const u32x4*)(P + (size_t)(b0 + sp) * LDP + C_GK + h * 32 + dk0);
    R.gg = gla_gates_load(Gt, b0, lane, wave);
    return R;
}
__device__ __forceinline__ void gla_summary_body(LAS unsigned char* lds, const GsRaw& R, const LAS float* g_up, const LAS float* g_b, float* GU, float* GDEC, int h, int oc, int tid, int lane, int wave) {
    LAS unsigned char* Kd = lds; LAS unsigned char* Vt = lds + 2 * GL_T;
    { const int r = tid >> 3, ch = tid & 7;
      LBAR();
      *(LAS u32x4*)(Vt + r * CH_RS + ch * 16) = R.v; }
    { const int d = wave >> 2, dk0 = 8 * (wave & 3), hd = h * 2 + d, jc = oc_to_jc(d, oc), sp = d ? 63 - lane : lane;
      float bc[8]; gla_gates_wave(R.gg, g_up, g_b, h, lane, wave, bc);
      float kf[8]; unpack8(R.k, kf);
      float dec[8];
#pragma unroll
      for (int c = 0; c < 8; ++c) { const float bL = __shfl(bc[c], 63); kf[c] *= __expf(bL - bc[c]); dec[c] = __expf(bL); }
      *(LAS u32x4*)(Kd + d * GL_T + sp * GL_RS + dk0 * 2) = pack8(kf);
      if (lane == 0) { float* dp = GDEC + (size_t)(hd * NCH + jc) * 32 + dk0; *(f32x4*)dp = (f32x4){dec[0], dec[1], dec[2], dec[3]}; *(f32x4*)(dp + 4) = (f32x4){dec[4], dec[5], dec[6], dec[7]}; } }
    LBAR();
    { const int d = wave >> 2, dkt = (wave >> 1) & 1, dvh = wave & 1, g = lane >> 4, i = lane & 15, hd = h * 2 + d, jc = oc_to_jc(d, oc);
      const bf16x8 a0 = tr_frag(Kd + d * GL_T, GL_RS, 0, 16 * dkt, lane), a1 = tr_frag(Kd + d * GL_T, GL_RS, 32, 16 * dkt, lane);
      float* dst = GU + ((size_t)(hd * 32 + 16 * dkt + i) * NCH + jc) * 64 + 4 * g;
#pragma unroll
      for (int q = 0; q < 2; ++q) { const int dvt = 2 * dvh + q;
          f32x4 c = (f32x4){0.f, 0.f, 0.f, 0.f};
          c = MFMA16(tr_frag(Vt, CH_RS, 0, 16 * dvt, lane), a0, c); c = MFMA16(tr_frag(Vt, CH_RS, 32, 16 * dvt, lane), a1, c);
          *(f32x4*)(dst + 16 * dvt) = c; } }
}
struct GoRaw { u32x4 v, s, q, k; GgRaw gg; uint2 og[4]; };
__device__ __forceinline__ GoRaw gla_out_load(const bf16_t* P, const float* Gt, const bf16_t* GS, int h, int oc, int tid, int lane, int wave) {
    GoRaw R; const int b0 = chunk_b0(oc), r = tid >> 3, ch = tid & 7, d = wave >> 2, dk0 = 8 * (wave & 3), sp = d ? 63 - lane : lane;
    R.v = *(const u32x4*)(P + (size_t)(b0 + r) * LDP + C_GV + h * 64 + ch * 8);
    { const int dd = r >> 5, rk = r & 31; R.s = *(const u32x4*)(GS + ((size_t)((h * 2 + dd) * 32 + rk) * NCH + oc_to_jc(dd, oc)) * 64 + ch * 8); }
    R.q = *(const u32x4*)(P + (size_t)(b0 + sp) * LDP + C_GQ + h * 32 + dk0); R.k = *(const u32x4*)(P + (size_t)(b0 + sp) * LDP + C_GK + h * 32 + dk0);
    R.gg = gla_gates_load(Gt, b0, lane, wave);
    { const int tt = wave & 3, g = lane >> 4, i = lane & 15, row = b0 + 16 * tt + i;
#pragma unroll
      for (int dvt = 0; dvt < 4; ++dvt) R.og[dvt] = *(const uint2*)(P + (size_t)row * LDP + C_GG + h * 64 + 16 * dvt + 4 * g); }
    return R;
}
__device__ __forceinline__ void gla_out_body(LAS unsigned char* lds, const GoRaw& R, const LAS float* g_up, const LAS float* g_b, const float* normw, bf16_t* CAT, int h, int oc, int tid, int lane, int wave) {
    LAS unsigned char* Qs = lds; LAS unsigned char* Ks = lds + 2 * GL_T; LAS unsigned char* Vt = lds + 4 * GL_T; LAS unsigned char* St = Vt + CH_T;
    LAS f32x4* hs = (LAS f32x4*)(St + 2 * 32 * CH_RS);
    const int b0 = chunk_b0(oc);
    { const int r = tid >> 3, ch = tid & 7, dd = r >> 5, rk = r & 31;
      LBAR();
      *(LAS u32x4*)(Vt + r * CH_RS + ch * 16) = R.v; *(LAS u32x4*)(St + dd * 32 * CH_RS + rk * CH_RS + ch * 16) = R.s; }
    { const int d = wave >> 2, dk0 = 8 * (wave & 3), sp = d ? 63 - lane : lane;
      float bc[8]; gla_gates_wave(R.gg, g_up, g_b, h, lane, wave, bc);
      float qf[8], kf[8]; unpack8(R.q, qf); unpack8(R.k, kf);
#pragma unroll
      for (int c = 0; c < 8; ++c) { qf[c] *= __expf(bc[c]); kf[c] *= __expf(-bc[c]); }
      *(LAS u32x4*)(Qs + d * GL_T + sp * GL_RS + dk0 * 2) = pack8(qf); *(LAS u32x4*)(Ks + d * GL_T + sp * GL_RS + dk0 * 2) = pack8(kf); }
    LBAR();
    const int d = wave >> 2, tt = wave & 3, g = lane >> 4, i = lane & 15, t = 16 * tt + i;
    f32x4 hh[4];
    {
        const bf16x8 bq = *(const LAS bf16x8*)(Qs + d * GL_T + t * GL_RS + 16 * g);
        f32x4 sT[4];
#pragma unroll
        for (int st = 0; st < 4; ++st) {
            f32x4 c = (f32x4){0.f, 0.f, 0.f, 0.f};
            c = MFMA16(*(const LAS bf16x8*)(Ks + d * GL_T + (16 * st + i) * GL_RS + 16 * g), bq, c);
#pragma unroll
            for (int rr = 0; rr < 4; ++rr) { const int sidx = 16 * st + 4 * g + rr; const bool ok = d ? (sidx >= t) : (sidx <= t); sT[st][rr] = ok ? c[rr] : 0.f; }
        }
        bf16x8 pb[2];
#pragma unroll
        for (int gp = 0; gp < 2; ++gp) { u32x4 w; w.x = cvtpk(sT[2 * gp][0], sT[2 * gp][1]); w.y = cvtpk(sT[2 * gp][2], sT[2 * gp][3]); w.z = cvtpk(sT[2 * gp + 1][0], sT[2 * gp + 1][1]); w.w = cvtpk(sT[2 * gp + 1][2], sT[2 * gp + 1][3]); pb[gp] = __builtin_bit_cast(bf16x8, w); }
#pragma unroll
        for (int dvt = 0; dvt < 4; ++dvt) {
            f32x4 c = (f32x4){0.f, 0.f, 0.f, 0.f};
            c = MFMA16(tr_frag_perm(Vt, CH_RS, 0, 16 * dvt, lane), pb[0], c); c = MFMA16(tr_frag_perm(Vt, CH_RS, 32, 16 * dvt, lane), pb[1], c);
            c = MFMA16(tr_frag(St + d * 32 * CH_RS, CH_RS, 0, 16 * dvt, lane), bq, c);
            hh[dvt] = c;
        }
        if (d == 1) {
#pragma unroll
            for (int dvt = 0; dvt < 4; ++dvt) hs[(tt * 4 + dvt) * 64 + lane] = hh[dvt];
        }
    }
    LBAR();
    if (d == 0) {
        float s1 = 0.f;
#pragma unroll
        for (int dvt = 0; dvt < 4; ++dvt) { hh[dvt] = hh[dvt] + hs[(tt * 4 + dvt) * 64 + lane]; s1 += (hh[dvt][0] + hh[dvt][1]) + (hh[dvt][2] + hh[dvt][3]); }
        s1 += __shfl_xor(s1, 16); s1 += __shfl_xor(s1, 32);
        const float mu = s1 * (1.f / 64.f); float s2 = 0.f;
#pragma unroll
        for (int dvt = 0; dvt < 4; ++dvt) { hh[dvt] = hh[dvt] - mu; s2 += (hh[dvt][0] * hh[dvt][0] + hh[dvt][1] * hh[dvt][1]) + (hh[dvt][2] * hh[dvt][2] + hh[dvt][3] * hh[dvt][3]); }
        s2 += __shfl_xor(s2, 16); s2 += __shfl_xor(s2, 32);
        const float rstd = rsqrtf(s2 * (1.f / 64.f) + LN_EPS);
        const int row = b0 + t;
#pragma unroll
        for (int dvt = 0; dvt < 4; ++dvt) { const int col = h * 64 + 16 * dvt + 4 * g;
            const uint2 gg = R.og[dvt]; const f32x4 nw = *(const f32x4*)(normw + col);
            const float o0 = hh[dvt][0] * rstd * nw[0] * siluf(__uint_as_float(gg.x << 16)), o1 = hh[dvt][1] * rstd * nw[1] * siluf(__uint_as_float(gg.x & 0xffff0000u));
            const float o2 = hh[dvt][2] * rstd * nw[2] * siluf(__uint_as_float(gg.y << 16)), o3 = hh[dvt][3] * rstd * nw[3] * siluf(__uint_as_float(gg.y & 0xffff0000u));
            uint2 o; o.x = cvtpk(o0, o1); o.y = cvtpk(o2, o3); *(uint2*)(CAT + (size_t)row * DM + 768 + col) = o; }
    }
}

__device__ __forceinline__ void ln16(f32x4 (&v)[4], const float* w, const float* b, int lane) {
    float s = 0.f;
#pragma unroll
    for (int j = 0; j < 4; ++j) s += (v[j][0] + v[j][1]) + (v[j][2] + v[j][3]);
    const float mean = wave_sum(s) * (1.f / DM); float s2 = 0.f;
#pragma unroll
    for (int j = 0; j < 4; ++j) { v[j] = v[j] - mean; s2 += (v[j][0] * v[j][0] + v[j][1] * v[j][1]) + (v[j][2] * v[j][2] + v[j][3] * v[j][3]); }
    const float rstd = rsqrtf(wave_sum(s2) * (1.f / DM) + LN_EPS);
#pragma unroll
    for (int j = 0; j < 4; ++j) { const f32x4 wv = *(const f32x4*)(w + 4 * lane + 256 * j), bv = *(const f32x4*)(b + 4 * lane + 256 * j); v[j] = v[j] * rstd * wv + bv; }
}
__device__ __forceinline__ void mod_store(f32x4 (&v)[4], const float* shift, const float* scale, bf16_t* hrow, int lane) {
#pragma unroll
    for (int j = 0; j < 4; ++j) { const f32x4 sh = *(const f32x4*)(shift + 4 * lane + 256 * j), sc = *(const f32x4*)(scale + 4 * lane + 256 * j);
        v[j] = v[j] * (sc + 1.f) + sh;
        uint2 o; o.x = cvtpk(v[j][0], v[j][1]); o.y = cvtpk(v[j][2], v[j][3]); *(uint2*)(hrow + 4 * lane + 256 * j) = o; }
}

__global__ void __launch_bounds__(512, 2) fwd(Args a_unused) {
    extern __shared__ __attribute__((aligned(16))) unsigned char lds_raw[];
    LAS unsigned char* lds = (LAS unsigned char*)lds_raw;
    const int wave0 = __builtin_amdgcn_readfirstlane(threadIdx.x >> 6);
    const int G = gridDim.x, bid = blockIdx.x;
    typedef const __attribute__((address_space(4))) Args* ArgsP;
    ArgsP ap0 = (ArgsP)__builtin_amdgcn_kernarg_segment_ptr();
#define PH_CTX() int wave = wave0; asm volatile("" : "+s"(wave)); unsigned ones_ = ~0u; asm volatile("" : "+s"(ones_)); const int lane = (int)__builtin_amdgcn_mbcnt_hi(ones_, __builtin_amdgcn_mbcnt_lo(ones_, 0u)); const int tid = wave * 64 + lane; \
    ArgsP ap = ap0; asm volatile("" : "+s"(ap)); unsigned char* ws = ap->ws; const int gw = bid * 8 + wave, NGW = G * 8; (void)lane; (void)gw; (void)NGW; (void)ws
#define WSP(T, off) ((T*)(ws + (off)))
    volatile LAS unsigned* MISC = (volatile LAS unsigned*)(lds + MISC_OFF);
    if (threadIdx.x < 32) MISC[threadIdx.x] = 0u;
    __syncthreads();
    XcdBarrier bar; bar.bar = (unsigned*)(ap0->ws + WS_CTL) + CW_BAR; bar.x = 0; bar.st = MISC + 8;
    if (MK_ONE_LAUNCH) bar = xcd_barrier_post(bar.bar, MISC + 8);
    const int lo = ap0->ph_lo, hi = ap0->ph_hi;
#define IN(k) (lo <= (k) && (k) < hi)
#define SEAM(k) do { if (MK_ONE_LAUNCH && (k) + 1 < hi) xcd_barrier(bar); } while (0)

    if (IN(0)) {
        PH_CTX();
        float* MODS = WSP(float, WS_MODS);
        LAS float* scs = (LAS float*)lds;
        for (int i = tid; i < 2048; i += 512) scs[i] = siluf(i < 1024 ? ap->in[1][i] : ap->in[3][i - 1024]);
        __syncthreads();
        for (int u = bid; u < 4 * 8 * 12; u += G) {
            const int l = u / 96, rem = u % 96, kc = rem / 12, ng = rem % 12, n = ng * 512 + tid;
            const float* w = ap->in[4] + ((size_t)l * 1024 + kc * 128) * 6144 + n;
            float a0 = 0.f, a1 = 0.f;
#pragma unroll 8
            for (int k = 0; k < 128; ++k) { const float wv = w[(size_t)k * 6144]; a0 += scs[kc * 128 + k] * wv; a1 += scs[1024 + kc * 128 + k] * wv; }
            if (kc == 0) { const float bb = ap->in[5][l * 6144 + n]; a0 += bb; a1 += bb; }
            atomicAdd(MODS + (size_t)(l * 2 + 0) * 6144 + n, a0); atomicAdd(MODS + (size_t)(l * 2 + 1) * 6144 + n, a1);
        }
        if (bid < 8) { float* ropeC = WSP(float, WS_ROPE); float* ropeS = ropeC + 256 * 16;
            const int i = bid * 512 + tid, pos = i >> 4, fi = i & 15; const float inv = powf(10000.f, -(float)fi / 16.f); const float ang = (float)pos * inv; float sn, cs; sincosf(ang, &sn, &cs); ropeC[i] = cs; ropeS[i] = sn; }
        __syncthreads();
        LAS float* scr = (LAS float*)(lds + wave * 16640);
        constexpr int I_A = 16 * 44, I_B = 16 * 16, I_C = 16 * 88, I_D = 44 * 16, I_E = 16 * 112, I_F = 56 * 16;
        constexpr int N_A = 4 * I_A, N_B = 4 * I_B, N_C = 2 * I_C, N_D = 2 * I_D, N_E = 16 * I_E, N_F = 16 * I_F;
        for (int it = gw; it < N_A + N_B + N_C + N_D + N_E + N_F; it += NGW) {
            int r = it;
            if (r < N_E) { const int mi = r / I_E; tr_item(ap->in[20] + (size_t)mi * DM * 2 * DEXP, DM, 2 * DEXP, 2 * DEXP, WSP(bf16_t, WS_MGU) + (size_t)mi * 2 * DEXP * DM, 2, DEXP, scr, r % I_E, lane); continue; } r -= N_E;
            if (r < N_F) { const int mi = r / I_F; tr_item(ap->in[21] + (size_t)mi * DEXP * DM, DEXP, DM, DM, WSP(bf16_t, WS_MDN) + (size_t)mi * DM * DEXP, 0, 0, scr, r % I_F, lane); continue; } r -= N_F;
            if (r < N_A) { const int mi = r / I_A; tr_item(ap->in[6] + (size_t)mi * DM * IN_COLS, DM, IN_COLS, NPIN, WSP(bf16_t, WS_WIN) + (size_t)mi * NPIN * DM, 1, 0, scr, r % I_A, lane); continue; } r -= N_A;
            if (r < N_B) { const int mi = r / I_B; tr_item(ap->in[13] + (size_t)mi * DM * DM, DM, DM, DM, WSP(bf16_t, WS_WOUT) + (size_t)mi * DM * DM, 0, 0, scr, r % I_B, lane); continue; } r -= N_B;
            if (r < N_C) { const int mi = r / I_C; tr_item(ap->in[16] + (size_t)mi * DM * 2 * DFF, DM, 2 * DFF, 2 * DFF, WSP(bf16_t, WS_FGU) + (size_t)mi * 2 * DFF * DM, 2, DFF, scr, r % I_C, lane); continue; } r -= N_C;
            { const int mi = r / I_D; tr_item(ap->in[17] + (size_t)mi * DFF * DM, DFF, DM, DM, WSP(bf16_t, WS_FDN) + (size_t)mi * DM * DFF, 0, 0, scr, r % I_D, lane); }
        }
        SEAM(0);
    }
    if (IN(1)) {
        PH_CTX();
        float* X = WSP(float, WS_X); bf16_t* H = WSP(bf16_t, WS_H); const float* MODS = WSP(float, WS_MODS);
        for (int r = gw; r < TT; r += NGW) {
            const int wch = r >= SEQ; const float* src = wch ? ap->in[2] + (size_t)(r - SEQ) * DM : ap->in[0] + (size_t)r * DM;
            f32x4 v[4];
#pragma unroll
            for (int j = 0; j < 4; ++j) { v[j] = *(const f32x4*)(src + 4 * lane + 256 * j); *(f32x4*)(X + (size_t)r * DM + 4 * lane + 256 * j) = v[j]; }
            const float* md = MODS + (size_t)(0 * 2 + wch) * 6144;
            mod_store(v, md, md + 1024, H + (size_t)r * DM, lane);
        }
        SEAM(1);
    }

    for (int l = 0; l < DEPTH; ++l) {
        const int pb = 2 + 10 * l;
        const bool lastl = (l == DEPTH - 1), moe = (l & 1);
        const int nrows = lastl ? SEQ : TT;

        PHASE_REP(0) if (IN(pb + 0)) {
            PH_CTX();
            pg8::StaticOrder S; S.init(WSP(bf16_t, WS_H), WSP(bf16_t, WS_WIN) + (size_t)l * NPIN * DM, DM, TT, NPIN, G, bid);
            pg8::EpiInProj E{WSP(bf16_t, WS_P), WSP(float, WS_G), WSP(float, WS_ROPE), WSP(float, WS_ROPE) + 256 * 16};
            pg8::gemm_phase<pg8::EpiInProj, pg8::StaticOrder>(lds, DM, S, E, tid);
            SEAM(pb + 0);
        }
        PHASE_REP(1) if (IN(pb + 1)) {
            if (!lastl && bid < 4) { PH_CTX(); attn_unit(lds, WSP(bf16_t, WS_P), WSP(bf16_t, WS_CAT), -1, bid >> 1, bid & 1, ap->in[9] + l * 8, tid, lane, wave); }
            { PH_CTX();
              const bf16_t* P = WSP(bf16_t, WS_P); const float* Gt = WSP(float, WS_G); const float* gate_b = ap->in[7] + l * 16;
#define UNIT_LOOP2(N_, start_, RawT, LOAD, BODY) do { int u0_ = (start_); if (u0_ < (N_)) { RawT A_ = LOAD(u0_); for (;;) { \
                  const int u1_ = u0_ + G; const RawT B_ = LOAD(u1_ < (N_) ? u1_ : u0_); BODY(A_, u0_); if (u1_ >= (N_)) break; \
                  const int u2_ = u1_ + G; A_ = LOAD(u2_ < (N_) ? u2_ : u1_); BODY(B_, u1_); if (u2_ >= (N_)) break; u0_ = u2_; } } } while (0)
#define MS_LOAD(u) mlstm_summary_load(P, Gt, gate_b, (u) / NCH, (u) % NCH, tid, lane, wave)
#define MS_BODY(R, u) mlstm_summary_body(lds, R, WSP(float, WS_MU), WSP(float, WS_MNU), WSP(float, WS_MSC), (u) / NCH, (u) % NCH, tid, lane, wave)
              UNIT_LOOP2(4 * NCH, bid, MsRaw, MS_LOAD, MS_BODY); }
            { PH_CTX();
              const bf16_t* P = WSP(bf16_t, WS_P); const float* Gt = WSP(float, WS_G);
#define GS_LOAD(u) gla_summary_load(P, Gt, (u) / NCH, (u) % NCH, tid, lane, wave)
              LAS float* gupL = (LAS float*)(lds + 65536); LAS float* gbL = gupL + 4096;
              __syncthreads(); for (int i = tid; i < 4096; i += 512) gupL[i] = ap->in[10][(size_t)l * 4096 + i]; if (tid < 256) gbL[tid] = ap->in[11][l * 256 + tid]; __syncthreads();
#define GS_BODY(R, u) gla_summary_body(lds, R, gupL, gbL, WSP(float, WS_GU), WSP(float, WS_GDEC), (u) / NCH, (u) % NCH, tid, lane, wave)
              UNIT_LOOP2(4 * NCH, (bid + 240) % G, GsRaw, GS_LOAD, GS_BODY); }
            SEAM(pb + 1);
        }
        PHASE_REP(2) if (IN(pb + 2)) {
            PH_CTX();
            const int wi = wave * G + bid;
            const int e0 = wi * 64;
            LAS float* sc = (LAS float*)(lds + wave * 4096);
#define SC_LOAD(buf, b) _Pragma("unroll") for (int j = 0; j < 52; ++j) buf[j] = U[(size_t)((b) * 52 + j) * str]
            if (e0 < 32768 + 512) {
                const bool isC = e0 < 32768;
                const int hd = isC ? e0 / 4096 : (e0 - 32768) / 64, idx = isC ? (e0 % 4096) + lane : lane;
                const int dkr = (e0 % 4096) >> 6;
                const float* __restrict__ U = isC ? WSP(float, WS_MU) + (size_t)(hd * 64 + dkr) * NCH * 64 + lane : WSP(float, WS_MNU) + (size_t)hd * NCH * 64 + lane;
                bf16_t* __restrict__ StC = WSP(bf16_t, WS_MC) + (size_t)(hd * 64 + dkr) * NCH * 64 + lane; float* __restrict__ StN = WSP(float, WS_MNS) + (size_t)hd * NCH * 64 + lane;
                float* __restrict__ MSC = WSP(float, WS_MSC) + (size_t)hd * NCH * 4;
                const int str = 64;
                const bool wr_m = isC && (e0 % 4096) == 0 && lane == 0;
                for (int k = lane; k < NCH; k += 64) { const float2 v = *(const float2*)(MSC + k * 4); sc[2 * k] = v.x; sc[2 * k + 1] = v.y; }
                LDS_WAIT();
                float m = 0.f, cval = 0.f;
#define SC_STEP_M(buf, b) _Pragma("unroll") for (int j = 0; j < 52; ++j) { const int n = (b) * 52 + j; \
                    if (isC) StC[(size_t)n * 64] = (bf16_t)f2bf(cval); else StN[(size_t)n * 64] = cval; \
                    if (wr_m) MSC[n * 4 + 2] = m; \
                    const float cmv = sc[2 * n], Bv = sc[2 * n + 1], mx = fmaxf(m, cmv); \
                    cval = __expf(m - mx) * cval + __expf(cmv - mx) * buf[j]; m = Bv + mx; }
                float ua[52], ub[52];
                SC_LOAD(ua, 0);
                SC_LOAD(ub, 1); SC_STEP_M(ua, 0); SC_LOAD(ua, 2); SC_STEP_M(ub, 1);
                SC_LOAD(ub, 3); SC_STEP_M(ua, 2); SC_LOAD(ua, 4); SC_STEP_M(ub, 3);
                SC_STEP_M(ua, 4);
#undef SC_STEP_M
            } else if (e0 < 32768 + 512 + 16384) {
                const int e2 = e0 - 33280, hd = e2 / 2048, idx = (e2 % 2048) + lane, dk = (e2 % 2048) >> 6;
                const float* __restrict__ U = WSP(float, WS_GU) + (size_t)(hd * 32 + dk) * NCH * 64 + lane; bf16_t* __restrict__ St = WSP(bf16_t, WS_GS) + (size_t)(hd * 32 + dk) * NCH * 64 + lane;
                const float* __restrict__ DC = WSP(float, WS_GDEC) + (size_t)hd * NCH * 32 + dk;
                const int str = 64;
                for (int k = lane; k < NCH; k += 64) sc[k] = DC[(size_t)k * 32];
                LDS_WAIT();
                float sval = 0.f;
#define SC_STEP_G(buf, b) _Pragma("unroll") for (int j = 0; j < 52; ++j) { const int n = (b) * 52 + j; St[(size_t)n * 64] = (bf16_t)f2bf(sval); sval = sc[n] * sval + buf[j]; }
                float ua[52], ub[52];
                SC_LOAD(ua, 0);
                SC_LOAD(ub, 1); SC_STEP_G(ua, 0); SC_LOAD(ua, 2); SC_STEP_G(ub, 1);
                SC_LOAD(ub, 3); SC_STEP_G(ua, 2); SC_LOAD(ua, 4); SC_STEP_G(ub, 3);
                SC_STEP_G(ua, 4);
#undef SC_STEP_G
            }
#undef SC_LOAD
            SEAM(pb + 2);
        }
        PHASE_REP(3) if (IN(pb + 3)) {
            const int noc = lastl ? 256 : 260;
            { PH_CTX();
              for (int u = bid; u < 256; u += G) attn_unit(lds, WSP(bf16_t, WS_P), WSP(bf16_t, WS_CAT), u >> 1, 0, u & 1, ap->in[9] + l * 8, tid, lane, wave); }
            { PH_CTX();
              const bf16_t* P = WSP(bf16_t, WS_P); const float* Gt = WSP(float, WS_G); const float* gate_b = ap->in[7] + l * 16;
              const bf16_t* MC = WSP(bf16_t, WS_MC); const float* MNS = WSP(float, WS_MNS); const float* MSC = WSP(float, WS_MSC);
#define MO_LOAD(u) mlstm_out_load(P, Gt, gate_b, MC, MNS, MSC, (u) / noc, (u) % noc, tid, lane, wave)
#define MO_BODY(R, u) mlstm_out_body(lds, R, ap->in[8] + l * 256, WSP(bf16_t, WS_CAT), (u) / noc, (u) % noc, tid, lane, wave)
              UNIT_LOOP2(4 * noc, bid, MoRaw, MO_LOAD, MO_BODY); }
            { PH_CTX();
              const bf16_t* P = WSP(bf16_t, WS_P); const float* Gt = WSP(float, WS_G); const bf16_t* GS = WSP(bf16_t, WS_GS);
#define GO_LOAD(u) gla_out_load(P, Gt, GS, (u) / noc, (u) % noc, tid, lane, wave)
              LAS float* gupL = (LAS float*)(lds + 65536); LAS float* gbL = gupL + 4096;
              __syncthreads(); for (int i = tid; i < 4096; i += 512) gupL[i] = ap->in[10][(size_t)l * 4096 + i]; if (tid < 256) gbL[tid] = ap->in[11][l * 256 + tid]; __syncthreads();
#define GO_BODY(R, u) gla_out_body(lds, R, gupL, gbL, ap->in[12] + l * 256, WSP(bf16_t, WS_CAT), (u) / noc, (u) % noc, tid, lane, wave)
              UNIT_LOOP2(4 * noc, (bid + 240) % G, GoRaw, GO_LOAD, GO_BODY); }
            SEAM(pb + 3);
        }
        PHASE_REP(4) if (IN(pb + 4)) {
            PH_CTX();
            const float* modl = WSP(float, WS_MODS) + (size_t)(l * 2 + 0) * 6144;
            int tp, sp; pg8::tail_params(nrows / 256, 4, DM / 64, G, tp, sp);
            pg8::TailOrder S; S.dense(WSP(bf16_t, WS_CAT), WSP(bf16_t, WS_WOUT) + (size_t)l * DM * DM, DM, DM, nrows / 256, G, bid, tp, sp);
            pg8::EpiResid E{WSP(float, WS_X), WSP(float, WS_Y), modl + 2 * 1024, modl + 6144 + 2 * 1024, WSP(float, WS_YP), nrows - tp * 256, tp * 256};
            pg8::gemm_phase<pg8::EpiResid, pg8::TailOrder>(lds, DM, S, E, tid);
            SEAM(pb + 4);
        }
        if (IN(pb + 5)) {
            PH_CTX();
            float* X = WSP(float, WS_X); bf16_t* H = WSP(bf16_t, WS_H); const float* Y = WSP(float, WS_Y);
            const float* modl = WSP(float, WS_MODS) + (size_t)(l * 2 + 0) * 6144;
            unsigned* mcnt = WSP(unsigned, WS_CTL) + CW_MOE + 64 * 8 * (l >> 1);
            LAS float* RW = (LAS float*)lds;
            if (moe) { const float* rw = ap->in[18] + (size_t)(l >> 1) * DM * 8; for (int i = tid; i < 8192; i += 512) { const int e = i >> 10, c = i & 1023; RW[i] = rw[c * 8 + e]; } __syncthreads(); }
            const float* lw = ap->in[14] + (size_t)(l * 2 + 0) * DM; const float* lb = ap->in[15] + (size_t)(l * 2 + 0) * DM;
            int tp, sp; pg8::tail_params(nrows / 256, 4, DM / 64, G, tp, sp);
            const int tail0 = nrows - tp * 256; const float* YP = WSP(float, WS_YP);
            for (int r = gw; r < nrows; r += NGW) {
                const int wch = r >= SEQ; const float* md = modl + wch * 6144;
                f32x4 v[4];
                if (r < tail0) {
#pragma unroll
                    for (int j = 0; j < 4; ++j) v[j] = *(const f32x4*)(Y + (size_t)r * DM + 4 * lane + 256 * j);
                } else {
#pragma unroll
                    for (int j = 0; j < 4; ++j) { const int c = 4 * lane + 256 * j; f32x4 a4 = (f32x4){0.f, 0.f, 0.f, 0.f};
                        for (int p = 0; p < sp; ++p) a4 = a4 + *(const f32x4*)(YP + ((size_t)p * tp * 256 + (r - tail0)) * DM + c);
                        v[j] = *(const f32x4*)(X + (size_t)r * DM + c) * ALPHA + *(const f32x4*)(md + 2 * 1024 + c) * a4; }
                }
                ln16(v, lw, lb, lane);
#pragma unroll
                for (int j = 0; j < 4; ++j) *(f32x4*)(X + (size_t)r * DM + 4 * lane + 256 * j) = v[j];
                if (!moe) mod_store(v, md + 3 * 1024, md + 4 * 1024, H + (size_t)r * DM, lane);
                else {
#pragma unroll
                    for (int j = 0; j < 4; ++j) { const f32x4 sh = *(const f32x4*)(md + 3 * 1024 + 4 * lane + 256 * j), sc = *(const f32x4*)(md + 4 * 1024 + 4 * lane + 256 * j); v[j] = v[j] * (sc + 1.f) + sh; }
                    float lg[8];
#pragma unroll
                    for (int e = 0; e < 8; ++e) { float s = 0.f;
#pragma unroll
                        for (int j = 0; j < 4; ++j) { const f32x4 w = *(const LAS f32x4*)(RW + e * 1024 + 4 * lane + 256 * j); s += v[j][0] * w[0] + v[j][1] * w[1] + v[j][2] * w[2] + v[j][3] * w[3]; }
                        lg[e] = wave_sum(s) + ap->in[19][(l >> 1) * 8 + e]; }
                    int e0 = 0; float l0 = lg[0];
#pragma unroll
                    for (int e = 1; e < 8; ++e) if (lg[e] > l0) { l0 = lg[e]; e0 = e; }
                    int e1 = -1; float l1 = -INFINITY;
#pragma unroll
                    for (int e = 0; e < 8; ++e) if (e != e0 && lg[e] > l1) { l1 = lg[e]; e1 = e; }
                    int p0 = 0, p1 = 0;
                    if (lane == 0) {
                        const float w0 = 1.f / (1.f + __expf(l1 - l0));
                        p0 = (int)atomicAdd(mcnt + 64 * e0, 1u); p1 = (int)atomicAdd(mcnt + 64 * e1, 1u);
                        WSP(int2, WS_TOKE)[r] = make_int2(e0, e1); WSP(int2, WS_TOKP)[r] = make_int2(p0, p1); WSP(float2, WS_TOKW)[r] = make_float2(w0, 1.f - w0);
                    }
                    p0 = __builtin_amdgcn_readfirstlane(p0); p1 = __builtin_amdgcn_readfirstlane(p1);
                    bf16_t* x0 = WSP(bf16_t, WS_XB) + ((size_t)e0 * TT + p0) * DM; bf16_t* x1 = WSP(bf16_t, WS_XB) + ((size_t)e1 * TT + p1) * DM;
#pragma unroll
                    for (int j = 0; j < 4; ++j) { uint2 o; o.x = cvtpk(v[j][0], v[j][1]); o.y = cvtpk(v[j][2], v[j][3]); *(uint2*)(x0 + 4 * lane + 256 * j) = o; *(uint2*)(x1 + 4 * lane + 256 * j) = o; }
                }
            }
            SEAM(pb + 5);
        }
#define MOE_TS() int ts0 = 0, ts1, ts2, ts3, ts4, ts5, ts6, ts7, ts8; { const unsigned* mcnt = WSP(unsigned, WS_CTL) + CW_MOE + 64 * 8 * (l >> 1); \
            ts1 = ts0 + (int)((__hip_atomic_load(mcnt + 64 * 0, __ATOMIC_RELAXED, __HIP_MEMORY_SCOPE_AGENT) + 255u) >> 8); ts2 = ts1 + (int)((__hip_atomic_load(mcnt + 64 * 1, __ATOMIC_RELAXED, __HIP_MEMORY_SCOPE_AGENT) + 255u) >> 8); \
            ts3 = ts2 + (int)((__hip_atomic_load(mcnt + 64 * 2, __ATOMIC_RELAXED, __HIP_MEMORY_SCOPE_AGENT) + 255u) >> 8); ts4 = ts3 + (int)((__hip_atomic_load(mcnt + 64 * 3, __ATOMIC_RELAXED, __HIP_MEMORY_SCOPE_AGENT) + 255u) >> 8); \
            ts5 = ts4 + (int)((__hip_atomic_load(mcnt + 64 * 4, __ATOMIC_RELAXED, __HIP_MEMORY_SCOPE_AGENT) + 255u) >> 8); ts6 = ts5 + (int)((__hip_atomic_load(mcnt + 64 * 5, __ATOMIC_RELAXED, __HIP_MEMORY_SCOPE_AGENT) + 255u) >> 8); \
            ts7 = ts6 + (int)((__hip_atomic_load(mcnt + 64 * 6, __ATOMIC_RELAXED, __HIP_MEMORY_SCOPE_AGENT) + 255u) >> 8); ts8 = ts7 + (int)((__hip_atomic_load(mcnt + 64 * 7, __ATOMIC_RELAXED, __HIP_MEMORY_SCOPE_AGENT) + 255u) >> 8); \
            ts1 = __builtin_amdgcn_readfirstlane(ts1); ts2 = __builtin_amdgcn_readfirstlane(ts2); ts3 = __builtin_amdgcn_readfirstlane(ts3); ts4 = __builtin_amdgcn_readfirstlane(ts4); \
            ts5 = __builtin_amdgcn_readfirstlane(ts5); ts6 = __builtin_amdgcn_readfirstlane(ts6); ts7 = __builtin_amdgcn_readfirstlane(ts7); ts8 = __builtin_amdgcn_readfirstlane(ts8); } (void)ts0; (void)ts8
        PHASE_REP(7) if (IN(pb + 7)) {
            PH_CTX();
            if (!moe) {
                pg8::StaticOrder S; S.init(WSP(bf16_t, WS_H), WSP(bf16_t, WS_FGU) + (size_t)(l >> 1) * 2 * DFF * DM, DM, nrows, 2 * DFF, G, bid);
                pg8::EpiSwiglu E{WSP(bf16_t, WS_ACT), DFF};
                pg8::gemm_phase<pg8::EpiSwiglu, pg8::StaticOrder>(lds, DM, S, E, tid);
            } else {
                MOE_TS();
                pg8::MoeOrder S; S.A = (const char*)WSP(bf16_t, WS_XB); S.Bt = (const char*)(WSP(bf16_t, WS_MGU) + (size_t)(l >> 1) * 8 * 2 * DEXP * DM); S.K = DM; S.N = 2 * DEXP; S.nN = 2 * DEXP / 256; S.ntile = ts8; S.G = G; S.c = bid;
                S.ts1 = ts1; S.ts2 = ts2; S.ts3 = ts3; S.ts4 = ts4; S.ts5 = ts5; S.ts6 = ts6; S.ts7 = ts7;
                pg8::EpiSwiglu E{WSP(bf16_t, WS_ACT), DEXP};
                pg8::gemm_phase<pg8::EpiSwiglu, pg8::MoeOrder>(lds, DM, S, E, tid);
            }
            SEAM(pb + 7);
        }
        PHASE_REP(8) if (IN(pb + 8)) {
            PH_CTX();
            if (!moe) {
                const float* modl = WSP(float, WS_MODS) + (size_t)(l * 2 + 0) * 6144;
                int tp, sp; pg8::tail_params(nrows / 256, 4, DFF / 64, G, tp, sp);
                pg8::TailOrder S; S.dense(WSP(bf16_t, WS_ACT), WSP(bf16_t, WS_FDN) + (size_t)(l >> 1) * DM * DFF, DFF, DM, nrows / 256, G, bid, tp, sp);
                pg8::EpiResid E{WSP(float, WS_X), WSP(float, WS_Y), modl + 5 * 1024, modl + 6144 + 5 * 1024, WSP(float, WS_YP), nrows - tp * 256, tp * 256};
                pg8::gemm_phase<pg8::EpiResid, pg8::TailOrder>(lds, DFF, S, E, tid);
            } else {
                MOE_TS();
                int tp, sp; pg8::tail_params(ts8, 4, DEXP / 64, G, tp, sp);
                pg8::TailOrder S; S.dense(WSP(bf16_t, WS_ACT), WSP(bf16_t, WS_MDN) + (size_t)(l >> 1) * 8 * DM * DEXP, DEXP, DM, ts8, G, bid, tp, sp);
                S.ts1 = ts1; S.ts2 = ts2; S.ts3 = ts3; S.ts4 = ts4; S.ts5 = ts5; S.ts6 = ts6; S.ts7 = ts7;
                pg8::EpiF32 E{WSP(float, WS_YS), WSP(float, WS_YP), (ts8 - tp) * 256, tp * 256};
                pg8::gemm_phase<pg8::EpiF32, pg8::TailOrder>(lds, DEXP, S, E, tid);
            }
            SEAM(pb + 8);
        }
        if (IN(pb + 9)) {
            PH_CTX();
            float* X = WSP(float, WS_X); bf16_t* H = WSP(bf16_t, WS_H); const float* Y = WSP(float, WS_Y); const float* YS = WSP(float, WS_YS);
            const float* modl = WSP(float, WS_MODS) + (size_t)(l * 2 + 0) * 6144;
            const float* lw = ap->in[14] + (size_t)(l * 2 + 1) * DM; const float* lb = ap->in[15] + (size_t)(l * 2 + 1) * DM;
            int tp, sp, tail0; const float* YP = WSP(float, WS_YP);
            MOE_TS();
            if (!moe) { pg8::tail_params(nrows / 256, 4, DFF / 64, G, tp, sp); tail0 = nrows - tp * 256; }
            else { pg8::tail_params(ts8, 4, DEXP / 64, G, tp, sp); tail0 = (ts8 - tp) * 256; }
            for (int r = gw; r < nrows; r += NGW) {
                const int wch = r >= SEQ; const float* md = modl + wch * 6144;
                f32x4 v[4];
                if (!moe) {
                    if (r < tail0) {
#pragma unroll
                        for (int j = 0; j < 4; ++j) v[j] = *(const f32x4*)(Y + (size_t)r * DM + 4 * lane + 256 * j);
                    } else {
#pragma unroll
                        for (int j = 0; j < 4; ++j) { const int c = 4 * lane + 256 * j; f32x4 a4 = (f32x4){0.f, 0.f, 0.f, 0.f};
                            for (int p = 0; p < sp; ++p) a4 = a4 + *(const f32x4*)(YP + ((size_t)p * tp * 256 + (r - tail0)) * DM + c);
                            v[j] = *(const f32x4*)(X + (size_t)r * DM + c) * ALPHA + *(const f32x4*)(md + 5 * 1024 + c) * a4; }
                    }
                } else {
                    const int2 ee = WSP(int2, WS_TOKE)[r], pp = WSP(int2, WS_TOKP)[r]; const float2 ww = WSP(float2, WS_TOKW)[r];
                    int2 ss;
                    ss.x = 256 * (ee.x == 0 ? ts0 : ee.x == 1 ? ts1 : ee.x == 2 ? ts2 : ee.x == 3 ? ts3 : ee.x == 4 ? ts4 : ee.x == 5 ? ts5 : ee.x == 6 ? ts6 : ts7) + pp.x;
                    ss.y = 256 * (ee.y == 0 ? ts0 : ee.y == 1 ? ts1 : ee.y == 2 ? ts2 : ee.y == 3 ? ts3 : ee.y == 4 ? ts4 : ee.y == 5 ? ts5 : ee.y == 6 ? ts6 : ts7) + pp.y;
#pragma unroll
                    for (int j = 0; j < 4; ++j) { const int c = 4 * lane + 256 * j;
                        f32x4 y0, y1;
                        if (ss.x < tail0) y0 = *(const f32x4*)(YS + (size_t)ss.x * DM + c);
                        else { y0 = (f32x4){0.f, 0.f, 0.f, 0.f}; for (int p = 0; p < sp; ++p) y0 = y0 + *(const f32x4*)(YP + ((size_t)p * tp * 256 + (ss.x - tail0)) * DM + c); }
                        if (ss.y < tail0) y1 = *(const f32x4*)(YS + (size_t)ss.y * DM + c);
                        else { y1 = (f32x4){0.f, 0.f, 0.f, 0.f}; for (int p = 0; p < sp; ++p) y1 = y1 + *(const f32x4*)(YP + ((size_t)p * tp * 256 + (ss.y - tail0)) * DM + c); }
                        const f32x4 xv = *(const f32x4*)(X + (size_t)r * DM + c), g5 = *(const f32x4*)(md + 5 * 1024 + c);
                        v[j] = xv * ALPHA + g5 * (y0 * ww.x + y1 * ww.y); }
                }
                ln16(v, lw, lb, lane);
                if (lastl) {
#pragma unroll
                    for (int j = 0; j < 4; ++j) *(f32x4*)(ap->out + (size_t)r * DM + 4 * lane + 256 * j) = v[j];
                } else {
#pragma unroll
                    for (int j = 0; j < 4; ++j) *(f32x4*)(X + (size_t)r * DM + 4 * lane + 256 * j) = v[j];
                    const float* mdn = modl + 2 * 6144 + wch * 6144;
                    mod_store(v, mdn, mdn + 1024, H + (size_t)r * DM, lane);
                }
            }
            SEAM(pb + 9);
        }
    }
#undef IN
#undef SEAM
}

extern "C" void kernel_launch(void* const* d_in, const int* in_sizes, int n_in, void* d_out, int out_size, void* d_ws, size_t ws_size, hipStream_t stream) {
    static int grid = 0;
    if (grid == 0) {
        if (n_in != 22 || ws_size < WS_END) { fprintf(stderr, "kernel_launch: unexpected n_in %d / ws %zu (need %zu)\n", n_in, ws_size, (size_t)WS_END); grid = -1; return; }
        int dev = 0, cus = 0;
        if (hipGetDevice(&dev) != hipSuccess || hipDeviceGetAttribute(&cus, hipDeviceAttributeMultiprocessorCount, dev) != hipSuccess) { grid = -1; return; }
        if (hipFuncSetAttribute((const void*)fwd, hipFuncAttributeMaxDynamicSharedMemorySize, LDS_BYTES) != hipSuccess) { fprintf(stderr, "kernel_launch: hipFuncSetAttribute failed\n"); grid = -1; return; }
        int per_cu = 0;
        if (hipOccupancyMaxActiveBlocksPerMultiprocessor(&per_cu, (const void*)fwd, 512, LDS_BYTES) != hipSuccess || per_cu < 1) fprintf(stderr, "kernel_launch: occupancy query reports %d\n", per_cu);
        (void)hipGetLastError();
        grid = cus;
    }
    if (grid < 0) return;
    (void)hipMemsetAsync((char*)d_ws + WS_CTL, 0, CTL_BYTES, stream);
    Args a{};
    for (int i = 0; i < 22; ++i) a.in[i] = (const float*)d_in[i];
    a.out = (float*)d_out; a.ws = (unsigned char*)d_ws;
#if MK_ONE_LAUNCH
    a.ph_lo = 0; a.ph_hi = NPH;
    hipLaunchKernelGGL(fwd, dim3(grid), dim3(512), LDS_BYTES, stream, a);
#else
    for (int p = 0; p < NPH; ++p) {
        if (p >= 2 && ((p - 2) % 10) == 6 && ((((p - 2) / 10) & 1) == 0)) continue;
        a.ph_lo = p; a.ph_hi = p + 1;
        hipLaunchKernelGGL(fwd, dim3(grid), dim3(512), LDS_BYTES, stream, a);
    }
#endif
}
```

```cpp
#include <hip/hip_runtime.h>
#include <cstdio>
#include <cstdint>

#ifndef MK_ONE_LAUNCH
#define MK_ONE_LAUNCH 1
#endif

#ifndef DUP_MASK
#define DUP_MASK 0
#endif
#define PHASE_REP(k) for (int rep_ = 0; rep_ < 1 + ((DUP_MASK >> (k)) & 1); ++rep_)
#define LAS __attribute__((address_space(3)))
#define GAS __attribute__((address_space(1)))
typedef unsigned short bf16_t;
typedef short bf16x8 __attribute__((ext_vector_type(8)));
typedef float f32x4 __attribute__((ext_vector_type(4)));
typedef unsigned u32x4 __attribute__((ext_vector_type(4)));

constexpr int DM = 1024, SEQ = 16384, NCTX = 256, TT = SEQ + NCTX, DEPTH = 4;
constexpr int IN_COLS = 2608, NPIN = 2816, LDP = 2816;
constexpr int C_MQ = 0, C_MK = 256, C_MV = 512, C_MO = 768, C_AQ = 1024, C_AK = 1536, C_AV = 1664, C_GQ = 1792, C_GK = 1920, C_GV = 2048, C_GG = 2304, C_MG = 2560, C_GGT = 2576, C_END = 2608;
constexpr int DFF = 2816, DEXP = 3584, NEXP = 8;
constexpr int NCH = 260;
constexpr int NSLOT = 138 * 256;
constexpr float ALPHA = 1.6817928305074290f;
constexpr float LN_EPS = 1e-5f;
constexpr int NPH = 2 + 10 * DEPTH;

constexpr size_t al256(size_t x) { return (x + 255) & ~size_t(255); }
constexpr size_t WS_CTL = 0, CTL_BYTES = 2u << 20;
constexpr size_t WS_MODS = 1u << 20;
constexpr size_t WS_ROPE = CTL_BYTES;
constexpr size_t WS_TOKE = WS_ROPE + 32768;
constexpr size_t WS_TOKP = WS_TOKE + al256((size_t)TT * 8);
constexpr size_t WS_TOKW = WS_TOKP + al256((size_t)TT * 8);
constexpr size_t WS_TOKS = WS_TOKW + al256((size_t)TT * 8);
constexpr size_t WS_WIN = WS_TOKS + al256((size_t)TT * 8);
constexpr size_t WS_WOUT = WS_WIN + (size_t)DEPTH * NPIN * DM * 2;
constexpr size_t WS_FGU = WS_WOUT + (size_t)DEPTH * DM * DM * 2;
constexpr size_t WS_FDN = WS_FGU + (size_t)2 * 2 * DFF * DM * 2;
constexpr size_t WS_MGU = WS_FDN + (size_t)2 * DM * DFF * 2;
constexpr size_t WS_MDN = WS_MGU + (size_t)16 * 2 * DEXP * DM * 2;
constexpr size_t WS_X = WS_MDN + (size_t)16 * DM * DEXP * 2;
constexpr size_t WS_H = WS_X + (size_t)TT * DM * 4;
constexpr size_t WS_P = WS_H + (size_t)TT * DM * 2;
constexpr size_t WS_G = WS_P + (size_t)TT * LDP * 2;
constexpr size_t WS_CAT = WS_G + al256((size_t)TT * 48 * 4);
constexpr size_t WS_Y = WS_CAT + (size_t)TT * DM * 2;
constexpr size_t WS_ACT = WS_Y + (size_t)TT * DM * 4;
constexpr size_t WS_XB = WS_ACT + (size_t)NSLOT * DEXP * 2;
constexpr size_t WS_YS = WS_XB + (size_t)NEXP * TT * DM * 2;
constexpr size_t WS_MU = WS_YS + (size_t)NSLOT * DM * 4;
constexpr size_t WS_MC = WS_MU + (size_t)8 * NCH * 4096 * 4;
constexpr size_t WS_MNU = WS_MC + (size_t)8 * NCH * 4096 * 4;
constexpr size_t WS_MNS = WS_MNU + (size_t)8 * NCH * 64 * 4;
constexpr size_t WS_MSC = WS_MNS + (size_t)8 * NCH * 64 * 4;
constexpr size_t WS_GU = WS_MSC + al256((size_t)8 * NCH * 4 * 4);
constexpr size_t WS_GS = WS_GU + (size_t)8 * NCH * 2048 * 4;
constexpr size_t WS_GDEC = WS_GS + (size_t)8 * NCH * 2048 * 4;
constexpr size_t WS_YP = WS_GDEC + (size_t)8 * NCH * 32 * 4;
constexpr size_t WS_END = WS_YP + (size_t)256 * 256 * 256 * 4;

constexpr int CW_BAR = 4096;
constexpr int CW_MOE = 16384;

constexpr int LDS_BYTES = 147456, MISC_OFF = 147200;

__device__ __forceinline__ float bf2f(unsigned v) { return __uint_as_float(v << 16); }
__device__ __forceinline__ unsigned f2bf(float f) { unsigned u = __float_as_uint(f); return (u + 0x7fffu + ((u >> 16) & 1u)) >> 16; }
__device__ __forceinline__ unsigned pk2(float lo, float hi) { return f2bf(lo) | (f2bf(hi) << 16); }
__device__ __forceinline__ void load8bf(const bf16_t* p, float* o) {
    const uint4 v = *(const uint4*)p;
    o[0] = __uint_as_float(v.x << 16); o[1] = __uint_as_float(v.x & 0xffff0000u); o[2] = __uint_as_float(v.y << 16); o[3] = __uint_as_float(v.y & 0xffff0000u);
    o[4] = __uint_as_float(v.z << 16); o[5] = __uint_as_float(v.z & 0xffff0000u); o[6] = __uint_as_float(v.w << 16); o[7] = __uint_as_float(v.w & 0xffff0000u);
}
__device__ __forceinline__ float wave_sum(float v) {
#pragma unroll
    for (int o = 1; o < 64; o <<= 1) v += __shfl_xor(v, o);
    return v;
}
__device__ __forceinline__ float wave_max(float v) {
#pragma unroll
    for (int o = 1; o < 64; o <<= 1) v = fmaxf(v, __shfl_xor(v, o));
    return v;
}
__device__ __forceinline__ float scan_add(float v, int lane) {
#pragma unroll
    for (int o = 1; o < 64; o <<= 1) { const float t = __shfl_up(v, o); if (lane >= o) v += t; }
    return v;
}
__device__ __forceinline__ float scan_max(float v, int lane) {
#pragma unroll
    for (int o = 1; o < 64; o <<= 1) { const float t = __shfl_up(v, o); if (lane >= o) v = fmaxf(v, t); }
    return v;
}
__device__ __forceinline__ float siluf(float x) { return x * __builtin_amdgcn_rcpf(1.f + __expf(-x)); }
__device__ __forceinline__ float sigmoidf_(float x) { return __builtin_amdgcn_rcpf(1.f + __expf(-x)); }
__device__ __forceinline__ float log_sigmoidf_(float x) {
    const float t = __expf(-fabsf(x)); const float l1p = (t < 0.01f) ? t * (1.f + t * (-0.5f + t * 0.33333333f)) : __logf(1.f + t); return fminf(x, 0.f) - l1p; }
typedef short s16x4 __attribute__((ext_vector_type(4)));
typedef short v4i16_t __attribute__((ext_vector_type(4)));
typedef float f32x2_t __attribute__((ext_vector_type(2))); typedef __bf16 bf16x2_t __attribute__((ext_vector_type(2)));
__device__ __forceinline__ unsigned cvtpk(float lo, float hi) { f32x2_t v = {lo, hi}; bf16x2_t b = __builtin_convertvector(v, bf16x2_t); return __builtin_bit_cast(unsigned, b); }
__device__ __forceinline__ s16x4 ds_tr16(const LAS unsigned char* p) { return __builtin_bit_cast(s16x4, __builtin_amdgcn_ds_read_tr16_b64_v4i16((LAS v4i16_t*)p)); }
__device__ __forceinline__ bf16x8 cat44(s16x4 a, s16x4 b) { return __builtin_shufflevector(a, b, 0, 1, 2, 3, 4, 5, 6, 7); }
#define MFMA16(a, b, c) __builtin_amdgcn_mfma_f32_16x16x32_bf16(a, b, c, 0, 0, 0)
__device__ __forceinline__ float grp_max(float v) {
    const auto a = __builtin_amdgcn_permlane16_swap(__float_as_uint(v), __float_as_uint(v), false, false); v = fmaxf(__uint_as_float(a[0]), __uint_as_float(a[1]));
    const auto b = __builtin_amdgcn_permlane32_swap(__float_as_uint(v), __float_as_uint(v), false, false); return fmaxf(__uint_as_float(b[0]), __uint_as_float(b[1])); }
__device__ __forceinline__ float grp_sum(float v) {
    const auto a = __builtin_amdgcn_permlane16_swap(__float_as_uint(v), __float_as_uint(v), false, false); v = __uint_as_float(a[0]) + __uint_as_float(a[1]);
    const auto b = __builtin_amdgcn_permlane32_swap(__float_as_uint(v), __float_as_uint(v), false, false); return __uint_as_float(b[0]) + __uint_as_float(b[1]); }
#define LDS_WAIT() asm volatile("s_waitcnt lgkmcnt(0)" ::: "memory")

namespace pg8 {
constexpr int BM = 256, BK = 64, HALF = 128, HTB = HALF * BK * 2, STAGE_BYTES = 8 * HTB, NXCD = 8, WGM = 8;
__host__ __device__ __forceinline__ int lds_byte(int r, int c) { const int st = (r >> 4) * 2 + (c >> 5), rr = r & 15, cc = c & 31, ob = rr * 64 + cc * 2; return st * 1024 + (ob ^ (((ob >> 9) & 1) << 5)); }
__host__ __device__ __forceinline__ void stage_rc(int b, int& R, int& C) { const int st = b / 1024, sb = b % 1024, swz = sb ^ (((sb >> 9) & 1) << 5); R = (st >> 1) * 16 + swz / 64; C = (st & 1) * 32 + (swz % 64) / 2; }
__host__ __device__ __forceinline__ int perm32(int rho) { const int n = rho >> 4, i = rho & 15; return 8 * (i >> 2) + 4 * n + (i & 3); }
struct Unit { int pm, pn, kt0, nkt, part; };

struct StaticOrder {
    const char* A; const char* Bt; int K;
    int nM, nN, nwg, G, c;
    __device__ void init(const void* A_, const void* Bt_, int K_, int M, int N, int G_, int c_) { A = (const char*)A_; Bt = (const char*)Bt_; K = K_; nM = M / BM; nN = N / BM; nwg = nM * nN; G = G_; c = c_; }
    __device__ __forceinline__ bool next(int i, Unit& u) const {
        const long L = (long)i * G + c; if (L >= nwg) return false;
        int wgid = (int)L; { const int q = nwg / NXCD, r = nwg % NXCD, xcd = wgid % NXCD, off = wgid / NXCD; wgid = (xcd < r ? xcd * (q + 1) : r * (q + 1) + (xcd - r) * q) + off; }
        const int nig = WGM * nN, gid = wgid / nig, fm = gid * WGM, gsz = (nM - fm) < WGM ? (nM - fm) : WGM;
        u.pm = fm + ((wgid % nig) % gsz); u.pn = (wgid % nig) / gsz; u.kt0 = 0; u.nkt = K / BK; u.part = -1; return true;
    }
    __device__ __forceinline__ const char* aptr(const Unit& u) const { return A + (size_t)u.pm * BM * K * 2; }
    __device__ __forceinline__ const char* bptr(const Unit& u) const { return Bt + (size_t)u.pn * BM * K * 2; }
};
struct MoeOrder {
    const char* A; const char* Bt; int K, N, nN, ntile, G, c;
    int ts1, ts2, ts3, ts4, ts5, ts6, ts7;
    __device__ __forceinline__ bool next(int i, Unit& u) const {
        const long L = (long)i * G + c; if (L >= (long)ntile * nN) return false;
        u.pm = (int)(L / nN); u.pn = (int)(L % nN); u.kt0 = 0; u.nkt = K / BK; u.part = -1; return true;
    }
    __device__ __forceinline__ int expert(int pm) const { return (pm >= ts1) + (pm >= ts2) + (pm >= ts3) + (pm >= ts4) + (pm >= ts5) + (pm >= ts6) + (pm >= ts7); }
    __device__ __forceinline__ const char* aptr(const Unit& u) const {
        const int e = expert(u.pm); const int t0 = e == 0 ? 0 : e == 1 ? ts1 : e == 2 ? ts2 : e == 3 ? ts3 : e == 4 ? ts4 : e == 5 ? ts5 : e == 6 ? ts6 : ts7;
        return A + ((size_t)e * TT + (size_t)(u.pm - t0) * BM) * K * 2; }
    __device__ __forceinline__ const char* bptr(const Unit& u) const { return Bt + ((size_t)expert(u.pm) * N + (size_t)u.pn * BM) * K * 2; }
};

struct TailOrder {
    const char* A; const char* Bt; int K, N, nN, npan, G, c, tp, s;
    int ts1, ts2, ts3, ts4, ts5, ts6, ts7;
    __device__ __forceinline__ void dense(const void* A_, const void* Bt_, int K_, int N_, int npan_, int G_, int c_, int tp_, int s_) {
        A = (const char*)A_; Bt = (const char*)Bt_; K = K_; N = N_; nN = N_ / BM; npan = npan_; G = G_; c = c_; tp = tp_; s = s_;
        ts1 = ts2 = ts3 = ts4 = ts5 = ts6 = ts7 = 0x7fffffff; }
    __device__ __forceinline__ bool next(int i, Unit& u) const {
        const int L = i * G + c, nfull = (npan - tp) * nN, ksub = (K / BK) / s;
        const bool tail = L >= nfull; const int j = L - nfull, tu = tp * nN, tu1 = tu > 0 ? tu : 1;
        const int part = tail ? j / tu1 : -1, r = tail ? j % tu1 : 0;
        u.part = part; u.pm = tail ? (npan - tp) + r / nN : L / nN; u.pn = tail ? r % nN : L % nN; u.kt0 = tail ? part * ksub : 0; u.nkt = tail ? ksub : K / BK;
        return tail ? (j < tu * s) : true;
    }
    __device__ __forceinline__ int expert(int pm) const { return (pm >= ts1) + (pm >= ts2) + (pm >= ts3) + (pm >= ts4) + (pm >= ts5) + (pm >= ts6) + (pm >= ts7); }
    __device__ __forceinline__ const char* aptr(const Unit& u) const { return A + ((size_t)u.pm * BM * K + (size_t)u.kt0 * BK) * 2; }
    __device__ __forceinline__ const char* bptr(const Unit& u) const { return Bt + (((size_t)expert(u.pm) * N + (size_t)u.pn * BM) * K + (size_t)u.kt0 * BK) * 2; }
};
__device__ __forceinline__ void tail_params(int npan, int nN, int nkt, int G, int& tp, int& s) {
    const int rem = (npan * nN) % G;
    tp = 0; s = 1;
    if (rem == 0 || (rem % nN) != 0) return;
    int best = 1;
    if (nkt == 16) { if (rem * 4 <= G) best = 4; else if (rem * 2 <= G) best = 2; }
    else if (nkt == 44) { if (rem * 11 <= G) best = 11; else if (rem * 2 <= G) best = 2; }
    else if (nkt == 56) { if (rem * 14 <= G) best = 14; else if (rem * 7 <= G) best = 7; else if (rem * 4 <= G) best = 4; else if (rem * 2 <= G) best = 2; }
    if (best > 1) { tp = rem / nN; s = best; }
}

template <class Epi, class Sched>
__device__ __forceinline__ void gemm_phase(LAS unsigned char* lds, const int K, const Sched& S, const Epi& E, const int tid) {
    const int wid = __builtin_amdgcn_readfirstlane(tid >> 6), lane = tid & 63, wr = wid >> 2, wc = wid & 3, fr = lane & 15, fq = lane >> 4;
    unsigned voffA[2], voffB[2];
#pragma unroll
    for (int i = 0; i < 2; ++i) { int R, C; stage_rc(tid * 16 + i * 8192, R, C); const int Rb = Epi::PERM ? ((R & ~31) + perm32(R & 31)) : R;
        voffA[i] = (unsigned)(R * K + C) * 2u; voffB[i] = (unsigned)(Rb * K + C) * 2u; }
    const size_t kstep = (size_t)(BK * 2);
    const size_t hstep = (size_t)HALF * K * 2;
    const unsigned ldsw = (unsigned)wid * 1024u;
    const int aoff = lds_byte(wr * 64 + fr, fq * 8), boff = lds_byte(wc * 32 + fr, fq * 8);
#define PG8_SA(b, h) (((b) * 2 + (h)) * HTB)
#define PG8_SB(b, h) ((4 + (b) * 2 + (h)) * HTB)
#define PG8_STAGE(bufoff, gbase, voff) do { _Pragma("unroll") for (int _i = 0; _i < 2; ++_i) \
        __builtin_amdgcn_global_load_lds((const GAS unsigned*)((const GAS char*)(gbase) + (voff)[_i]), (LAS unsigned*)(lds + (bufoff) + ldsw + _i * 8192), 16, 0, 0); } while (0)
#define PG8_LDA(dst, b, h) do { _Pragma("unroll") for (int m = 0; m < 4; ++m) _Pragma("unroll") for (int k = 0; k < 2; ++k) dst[m][k] = *(const LAS bf16x8*)(lds + PG8_SA(b, h) + aoff + m * 2048 + k * 1024); } while (0)
#define PG8_LDB(dst, b, h) do { _Pragma("unroll") for (int n = 0; n < 2; ++n) _Pragma("unroll") for (int k = 0; k < 2; ++k) dst[n][k] = *(const LAS bf16x8*)(lds + PG8_SB(b, h) + boff + n * 2048 + k * 1024); } while (0)
#define PG8_MMA(ai, bj, At, Bt) do { __builtin_amdgcn_s_setprio(1); _Pragma("unroll") for (int m = 0; m < 4; ++m) _Pragma("unroll") for (int n = 0; n < 2; ++n) _Pragma("unroll") for (int k = 0; k < 2; ++k) \
        acc[ai][bj][m][n] = __builtin_amdgcn_mfma_f32_16x16x32_bf16(Bt[n][k], At[m][k], acc[ai][bj][m][n], 0, 0, 0); __builtin_amdgcn_s_setprio(0); } while (0)
#define PG8_WAIT_V(n) asm volatile("s_waitcnt vmcnt(" #n ")" ::: "memory")
#define PG8_WAIT_L(n) asm volatile("s_waitcnt lgkmcnt(" #n ")" ::: "memory")
#define PG8_BAR __builtin_amdgcn_s_barrier()
#define PG8_SCHED __builtin_amdgcn_sched_barrier(0)
    Unit cur, nxt; int ui = 0;
    if (!S.next(0, cur)) return;
    f32x4 acc[2][2][4][2];
#pragma unroll
    for (int a = 0; a < 2; ++a)
#pragma unroll
        for (int b = 0; b < 2; ++b)
#pragma unroll
            for (int m = 0; m < 4; ++m)
#pragma unroll
                for (int n = 0; n < 2; ++n) acc[a][b][m][n] = (f32x4){0.f, 0.f, 0.f, 0.f};
    bf16x8 At[4][2], B0[2][2], B1[2][2];
    const char* cA = S.aptr(cur); const char* cB = S.bptr(cur);
    PG8_STAGE(PG8_SB(0, 0), cB, voffB); PG8_STAGE(PG8_SB(0, 1), cB + hstep, voffB); PG8_STAGE(PG8_SA(0, 0), cA, voffA); PG8_STAGE(PG8_SA(0, 1), cA + hstep, voffA);
    if (wr == 1) PG8_BAR;
    PG8_WAIT_V(2); PG8_BAR;
    PG8_STAGE(PG8_SB(1, 0), cB + kstep, voffB); PG8_STAGE(PG8_SA(1, 0), cA + kstep, voffA); PG8_STAGE(PG8_SB(1, 1), cB + hstep + kstep, voffB);
    PG8_WAIT_V(6); PG8_BAR;
    for (;;) {
        const bool has_next = S.next(ui + 1, nxt);
        const char* nA = has_next ? S.aptr(nxt) : cA; const char* nB = has_next ? S.bptr(nxt) : cB;
        const int nt = cur.nkt;
        for (int t = 0; t < nt; t += 2) {
            const bool last = (t == nt - 2);
            const char* a1 = cA + (size_t)(t + 1) * kstep;
            const char* a2 = last ? nA : cA + (size_t)(t + 2) * kstep; const char* b2 = last ? nB : cB + (size_t)(t + 2) * kstep;
            const char* a3 = a2 + kstep; const char* b3 = b2 + kstep;
            PG8_LDB(B0, 0, 0); PG8_LDB(B1, 0, 1); PG8_SCHED; PG8_LDA(At, 0, 0); PG8_STAGE(PG8_SA(1, 1), a1 + hstep, voffA);
            PG8_WAIT_V(8); PG8_WAIT_L(0); PG8_BAR; PG8_MMA(0, 0, At, B0); PG8_MMA(0, 1, At, B1); PG8_BAR; PG8_SCHED;
            PG8_LDA(At, 0, 1); PG8_STAGE(PG8_SB(0, 0), b2, voffB); PG8_STAGE(PG8_SB(0, 1), b2 + hstep, voffB); PG8_STAGE(PG8_SA(0, 0), a2, voffA);
            PG8_WAIT_V(8); PG8_WAIT_L(0); PG8_BAR; PG8_MMA(1, 0, At, B0); PG8_MMA(1, 1, At, B1); PG8_BAR; PG8_SCHED;
            PG8_LDB(B0, 1, 0); PG8_LDB(B1, 1, 1); PG8_SCHED; PG8_LDA(At, 1, 0); PG8_STAGE(PG8_SA(0, 1), a2 + hstep, voffA);
            PG8_WAIT_V(8); PG8_WAIT_L(0); PG8_BAR; PG8_MMA(0, 0, At, B0); PG8_MMA(0, 1, At, B1); PG8_BAR; PG8_SCHED;
            PG8_LDA(At, 1, 1); PG8_STAGE(PG8_SB(1, 0), b3, voffB); PG8_STAGE(PG8_SB(1, 1), b3 + hstep, voffB); PG8_STAGE(PG8_SA(1, 0), a3, voffA);
            PG8_WAIT_V(8); PG8_WAIT_L(0); PG8_BAR; PG8_MMA(1, 0, At, B0); PG8_MMA(1, 1, At, B1); PG8_BAR; PG8_SCHED;
        }
        if (wr == 0) PG8_BAR;
        { int fr_ = fr, fq_ = fq; asm volatile("" : "+v"(fr_), "+v"(fq_));
          E(acc, cur, wr, wc, fr_, fq_); }
        if (!has_next) break;
#pragma unroll
        for (int a = 0; a < 2; ++a)
#pragma unroll
            for (int b = 0; b < 2; ++b)
#pragma unroll
                for (int m = 0; m < 4; ++m)
#pragma unroll
                    for (int n = 0; n < 2; ++n) acc[a][b][m][n] = (f32x4){0.f, 0.f, 0.f, 0.f};
        cur = nxt; cA = nA; cB = nB; ++ui;
        if (wr == 1) PG8_BAR;
    }
    PG8_WAIT_V(0);
    PG8_BAR;
#undef PG8_SA
#undef PG8_SB
#undef PG8_STAGE
#undef PG8_LDA
#undef PG8_LDB
#undef PG8_MMA
#undef PG8_WAIT_V
#undef PG8_WAIT_L
#undef PG8_BAR
#undef PG8_SCHED
}


struct EpiInProj {
    static constexpr bool PERM = true;
    bf16_t* P; float* Gt; const float* ropeC; const float* ropeS;
    __device__ __forceinline__ void operator()(const f32x4 (&acc)[2][2][4][2], const Unit& u, int wr, int wc, int fr, int fq) const {
        const int row0 = u.pm * BM + wr * 64 + fr;
        const bool latent = u.pm < (SEQ / BM);
#pragma unroll
        for (int bj = 0; bj < 2; ++bj) {
            const int colg = u.pn * BM + bj * HALF + wc * 32;
            const bool rope = latent && colg >= C_AQ && colg < C_AV;
            const bool gate = colg >= C_MG && colg < C_END;
            const int col0 = colg + 8 * fq;
#pragma unroll
            for (int ai = 0; ai < 2; ++ai)
#pragma unroll
                for (int m = 0; m < 4; ++m) {
                    const int row = row0 + ai * HALF + m * 16;
                    f32x4 v0 = acc[ai][bj][m][0], v1 = acc[ai][bj][m][1];
                    if (rope) {
                        const int pos = ((colg >> 5) & 1) ? (row & 63) : (row >> 6);
                        const f32x4 c0 = *(const f32x4*)(ropeC + pos * 16 + 8 * (fq & 1)), c1 = *(const f32x4*)(ropeC + pos * 16 + 8 * (fq & 1) + 4);
                        const f32x4 s0 = *(const f32x4*)(ropeS + pos * 16 + 8 * (fq & 1)), s1 = *(const f32x4*)(ropeS + pos * 16 + 8 * (fq & 1) + 4);
                        const float sg = (fq < 2) ? -1.f : 1.f;
                        f32x4 p0, p1;
#pragma unroll
                        for (int i = 0; i < 4; ++i) { p0[i] = __shfl_xor(v0[i], 32); p1[i] = __shfl_xor(v1[i], 32); }
#pragma unroll
                        for (int i = 0; i < 4; ++i) { v0[i] = v0[i] * c0[i] + sg * p0[i] * s0[i]; v1[i] = v1[i] * c1[i] + sg * p1[i] * s1[i]; }
                    }
                    u32x4 w; w.x = cvtpk(v0[0], v0[1]); w.y = cvtpk(v0[2], v0[3]); w.z = cvtpk(v1[0], v1[1]); w.w = cvtpk(v1[2], v1[3]);
                    *(u32x4*)(P + (size_t)row * LDP + col0) = w;
                    if (gate && col0 < C_END) { float* g = Gt + (size_t)row * 48 + (col0 - C_MG); *(f32x4*)g = v0; *(f32x4*)(g + 4) = v1; }
                    asm volatile("" ::: "memory");
                }
        }
    }
};
struct EpiResid {
    static constexpr bool PERM = true;
    bf16_t* Yb; const float* modl; const float* modc; float* YP; int tail_row0, tail_rows;
    __device__ __forceinline__ void operator()(const f32x4 (&acc)[2][2][4][2], const Unit& u, int wr, int wc, int fr, int fq) const {
        const int row0 = u.pm * BM + wr * 64 + fr, col0 = u.pn * BM + wc * 32 + 8 * fq;
        if (u.part >= 0) {
#pragma unroll
            for (int ai = 0; ai < 2; ++ai)
#pragma unroll
                for (int m = 0; m < 4; ++m) { float* rowp = YP + ((size_t)u.part * tail_rows + (row0 + ai * HALF + m * 16 - tail_row0)) * DM + col0;
#pragma unroll
                    for (int bj = 0; bj < 2; ++bj)
#pragma unroll
                        for (int n = 0; n < 2; ++n) *(f32x4*)(rowp + bj * HALF + n * 4) = acc[ai][bj][m][n]; }
            return;
        }
        const float* md = (u.pm < SEQ / BM) ? modl : modc;
        f32x4 mv[2][2];
#pragma unroll
        for (int bj = 0; bj < 2; ++bj)
#pragma unroll
            for (int n = 0; n < 2; ++n) mv[bj][n] = *(const f32x4*)(md + col0 + bj * HALF + n * 4);
#pragma unroll
        for (int ai = 0; ai < 2; ++ai)
#pragma unroll
            for (int m = 0; m < 4; ++m) { bf16_t* rowp = Yb + (size_t)(row0 + ai * HALF + m * 16) * DM + col0;
#pragma unroll
                for (int bj = 0; bj < 2; ++bj) { const f32x4 v0 = mv[bj][0] * acc[ai][bj][m][0], v1 = mv[bj][1] * acc[ai][bj][m][1];
                    u32x4 w; w.x = cvtpk(v0[0], v0[1]); w.y = cvtpk(v0[2], v0[3]); w.z = cvtpk(v1[0], v1[1]); w.w = cvtpk(v1[2], v1[3]);
                    *(u32x4*)(rowp + bj * HALF) = w; } }
    }
};
struct EpiSwiglu {
    static constexpr bool PERM = true;
    bf16_t* O; int ld;
    __device__ __forceinline__ void operator()(const f32x4 (&acc)[2][2][4][2], const Unit& u, int wr, int wc, int fr, int fq) const {
        const int row0 = u.pm * BM + wr * 64 + fr, col0 = u.pn * HALF + wc * 32 + 8 * fq;
#pragma unroll
        for (int ai = 0; ai < 2; ++ai)
#pragma unroll
            for (int m = 0; m < 4; ++m) {
                const f32x4 g0 = acc[ai][0][m][0], g1 = acc[ai][0][m][1], u0 = acc[ai][1][m][0], u1 = acc[ai][1][m][1];
                float r[8];
#pragma unroll
                for (int i = 0; i < 4; ++i) { r[i] = siluf(g0[i]) * u0[i]; r[4 + i] = siluf(g1[i]) * u1[i]; }
                u32x4 w; w.x = cvtpk(r[0], r[1]); w.y = cvtpk(r[2], r[3]); w.z = cvtpk(r[4], r[5]); w.w = cvtpk(r[6], r[7]);
                *(u32x4*)(O + (size_t)(row0 + ai * HALF + m * 16) * ld + col0) = w;
            }
    }
};
struct EpiRaw {
    static constexpr bool PERM = true;
    bf16_t* C; float* YP; int tail_row0, tail_rows;
    __device__ __forceinline__ void operator()(const f32x4 (&acc)[2][2][4][2], const Unit& u, int wr, int wc, int fr, int fq) const {
        const int row0 = u.pm * BM + wr * 64 + fr, col0 = u.pn * BM + wc * 32 + 8 * fq;
        if (u.part >= 0) {
#pragma unroll
            for (int ai = 0; ai < 2; ++ai)
#pragma unroll
                for (int m = 0; m < 4; ++m) { float* rowp = YP + ((size_t)u.part * tail_rows + (row0 + ai * HALF + m * 16 - tail_row0)) * DM + col0;
#pragma unroll
                    for (int bj = 0; bj < 2; ++bj)
#pragma unroll
                        for (int n = 0; n < 2; ++n) *(f32x4*)(rowp + bj * HALF + n * 4) = acc[ai][bj][m][n]; }
            return;
        }
#pragma unroll
        for (int ai = 0; ai < 2; ++ai)
#pragma unroll
            for (int m = 0; m < 4; ++m) { bf16_t* rowp = C + (size_t)(row0 + ai * HALF + m * 16) * DM + col0;
#pragma unroll
                for (int bj = 0; bj < 2; ++bj) { const f32x4 v0 = acc[ai][bj][m][0], v1 = acc[ai][bj][m][1];
                    u32x4 w; w.x = cvtpk(v0[0], v0[1]); w.y = cvtpk(v0[2], v0[3]); w.z = cvtpk(v1[0], v1[1]); w.w = cvtpk(v1[2], v1[3]);
                    *(u32x4*)(rowp + bj * HALF) = w; } }
    }
};
}

#define XB_TMO      128
#define XB_XCNT(j)  (256  + 64 * (j))
#define XB_XSUB(j)  (1280 + 64 * (j))
#define XB_XGEN(j)  (2304 + 64 * (j))
#define XB_TOP      3328
#define XB_TOPGEN   3392
#define XCD_BAR_WORDS 3456
#define XB_SPIN_CAP (1u << 18)
__device__ __forceinline__ unsigned xb_ld(unsigned* p)              { return __hip_atomic_load(p, __ATOMIC_RELAXED, __HIP_MEMORY_SCOPE_AGENT); }
__device__ __forceinline__ unsigned xb_add(unsigned* p, unsigned v) { return __hip_atomic_fetch_add(p, v, __ATOMIC_RELAXED, __HIP_MEMORY_SCOPE_AGENT); }
__device__ __forceinline__ unsigned xb_xcc_id() { return (unsigned)__builtin_amdgcn_s_getreg((3 << 11) | 20) & 0xFu; }
#define XB_SPIN(cond, bar) do { unsigned _sp = 0; while (cond) { __builtin_amdgcn_s_sleep(1); \
    if ((++_sp & 255u) == 0u) { if (xb_ld(&(bar)[XB_TMO])) break; if (_sp > XB_SPIN_CAP) { atomicAdd(&(bar)[XB_TMO], 1u); break; } } } } while (0)
struct XcdBarrier { unsigned* bar; unsigned x; volatile LAS unsigned* st; };
__device__ __forceinline__ XcdBarrier xcd_barrier_post(unsigned* bar, volatile LAS unsigned* st) {
    XcdBarrier b; b.bar = bar; b.x = xb_xcc_id(); b.st = st;
    if (threadIdx.x == 0) (void)xb_add(&bar[XB_XCNT(b.x)], 1u);
    return b;
}
__device__ __forceinline__ void xcd_barrier_complete(unsigned* bar, unsigned x, unsigned& nloc, unsigned& nx) {
    const unsigned G = gridDim.x * gridDim.y * gridDim.z;
    unsigned sum, cnt, mine, sp = 0u;
    for (;;) {
        sum = 0u; cnt = 0u; mine = 0u;
#pragma unroll
        for (unsigned j = 0; j < 16; ++j) { const unsigned c = xb_ld(&bar[XB_XCNT(j)]); sum += c; cnt += (c > 0u) ? 1u : 0u; mine = (j == x) ? c : mine; }
        if (sum == G) break;
        __builtin_amdgcn_s_sleep(1);
        if ((++sp & 255u) == 0u) { if (xb_ld(&bar[XB_TMO])) break; if (sp > XB_SPIN_CAP) { atomicAdd(&bar[XB_TMO], 1u); break; } }
    }
    nloc = mine > 0u ? mine : 1u; nx = cnt > 0u ? cnt : 1u;
}
__device__ __forceinline__ void xcd_barrier(const XcdBarrier& b) {
    asm volatile("s_waitcnt vmcnt(0)" ::: "memory");
    __syncthreads();
    if (threadIdx.x == 0) {
        unsigned* bar = b.bar;
        __builtin_amdgcn_s_waitcnt(0);
        unsigned nloc = b.st[0], nx = b.st[1];
        if (nloc == 0u) { xcd_barrier_complete(bar, b.x, nloc, nx); b.st[0] = nloc; b.st[1] = nx; }
        const unsigned old = xb_add(&bar[XB_XSUB(b.x)], 1u);
        const unsigned gen = old / nloc;
        if (old + 1u == (gen + 1u) * nloc) {
            __builtin_amdgcn_fence(__ATOMIC_RELEASE, "agent");
            asm volatile("s_waitcnt vmcnt(0)" ::: "memory");
            const unsigned og = xb_add(&bar[XB_TOP], 1u);
            const unsigned tg = og / nx;
            if (og + 1u == (tg + 1u) * nx) xb_add(&bar[XB_TOPGEN], 1u);
            else XB_SPIN(xb_ld(&bar[XB_TOPGEN]) == tg, bar);
            __builtin_amdgcn_fence(__ATOMIC_ACQUIRE, "agent");
            xb_add(&bar[XB_XGEN(b.x)], 1u);
            asm volatile("s_waitcnt vmcnt(0)" ::: "memory");
        } else {
            XB_SPIN(xb_ld(&bar[XB_XGEN(b.x)]) == gen, bar);
            __builtin_amdgcn_fence(__ATOMIC_ACQUIRE, "agent");
            asm volatile("s_waitcnt vmcnt(0)" ::: "memory");
        }
    }
    __syncthreads();
}

struct Args { const float* in[22]; float* out; unsigned char* ws; int ph_lo, ph_hi; };

__device__ __forceinline__ int in_srccol(int r, float& sc) {
    sc = 1.f;
    if (r < 1024) { if (r >= C_MK && r < C_MV) sc = 0.125f; return r; }
    if (r < C_MG) { if (r < C_AK) sc = 0.125f * 1.4426950408889634f; else if (r >= C_GQ && r < C_GK) sc = 0.17677669529663687f; return r + 16; }
    if (r < C_GGT) return r - C_MG + 1024;
    if (r < C_END) return r;
    return -1;
}
__device__ __forceinline__ void tr_item(const float* W, int K, int N, int NP, bf16_t* WT, int mode, int half, LAS float* scr, int item, int lane) {
    const int nblk = NP >> 6, kb = item / nblk, nb = item - kb * nblk, k0 = kb << 6, n0 = nb << 6;
    const int r = n0 + lane; float sc = 1.f; int src;
    if (mode == 0) src = r; else if (mode == 1) src = in_srccol(r, sc); else { const int pn = r >> 8, w = r & 255; src = (w < 128) ? (pn * 128 + w) : (half + pn * 128 + w - 128); }
    const float* wp = W + (size_t)k0 * N + (src < 0 ? 0 : src);
#pragma unroll 16
    for (int i = 0; i < 64; ++i) { const float v = wp[(size_t)i * N]; scr[i * 65 + lane] = (src < 0) ? 0.f : v * sc; }
    LDS_WAIT();
    const int c = lane & 7;
#pragma unroll
    for (int j = 0; j < 8; ++j) { const int n = (lane >> 3) + 8 * j; const LAS float* s = scr + (8 * c) * 65 + n;
        uint4 o; o.x = pk2(s[0], s[65]); o.y = pk2(s[130], s[195]); o.z = pk2(s[260], s[325]); o.w = pk2(s[390], s[455]);
        *(uint4*)(WT + (size_t)(n0 + n) * K + k0 + 8 * c) = o; }
    LDS_WAIT();
}

__device__ __forceinline__ void chunk_rows(int d, int jc, int& base, int& step) {
    int oc;
    if (d == 0) oc = (jc < 4) ? 256 + jc : jc - 4; else oc = (jc < 4) ? 256 + (3 - jc) : 255 - (jc - 4);
    const int b0 = (oc < 256) ? oc * 64 : SEQ + (oc - 256) * 64;
    if (d == 0) { base = b0; step = 1; } else { base = b0 + 63; step = -1; }
}
__device__ __forceinline__ int oc_to_jc(int d, int oc) { if (d == 0) return oc < 256 ? oc + 4 : oc - 256; return oc < 256 ? 4 + (255 - oc) : 3 - (oc - 256); }

constexpr int AT_RS = 144, AT_TILE = 128 * AT_RS;
__device__ __forceinline__ void attn_unit(LAS unsigned char* lds, const bf16_t* P, bf16_t* CAT, int qb  , int cqb, int kvh, const float* sink, int tid, int lane, int wave) {
    const bool is_ctx = qb < 0;
    const int g = lane >> 4, i = lane & 15;
    const int hq = kvh * 4 + (wave >> 1), qh = wave & 1;
    const int qrow0 = (is_ctx ? SEQ + cqb * 128 : qb * 128) + qh * 64;
    bf16x8 bq[4][2];
#pragma unroll
    for (int qt = 0; qt < 4; ++qt)
#pragma unroll
        for (int ks = 0; ks < 2; ++ks) bq[qt][ks] = *(const bf16x8*)(P + (size_t)(qrow0 + 16 * qt + i) * LDP + C_AQ + hq * 64 + 32 * ks + 8 * g);
    f32x4 O[4][4];
#pragma unroll
    for (int dt = 0; dt < 4; ++dt)
#pragma unroll
        for (int qt = 0; qt < 4; ++qt) O[dt][qt] = (f32x4){0.f, 0.f, 0.f, 0.f};
    float m[4], l[4];
    { const float sk = sink[hq] * 1.4426950408889634f;
#pragma unroll
      for (int qt = 0; qt < 4; ++qt) { m[qt] = sk; l[qt] = (g == 0) ? 1.f : 0.f; } }
#define AT_VALID(c) ((c) >= 3 || (!is_ctx && (qb - 1 + (c)) >= 0 && (qb - 1 + (c)) < SEQ / 128))
#define AT_ROW(c) ((c) >= 3 ? SEQ + ((c) - 3) * 128 : (qb - 1 + (c)) * 128)
    u32x4 kreg[2], vreg[2];
    int c = 0; while (!AT_VALID(c)) ++c;
    __syncthreads();
#pragma unroll
    for (int t = 0; t < 2; ++t) { const int idx = tid + 512 * t, r = idx >> 3, ch = idx & 7; const bf16_t* src = P + (size_t)(AT_ROW(c) + r) * LDP + kvh * 64 + ch * 8;
        kreg[t] = *(const u32x4*)(src + C_AK); vreg[t] = *(const u32x4*)(src + C_AV); }
    int buf = 0;
#pragma unroll
    for (int t = 0; t < 2; ++t) { const int idx = tid + 512 * t, r = idx >> 3, ch = idx & 7; *(LAS u32x4*)(lds + r * AT_RS + ch * 16) = kreg[t]; *(LAS u32x4*)(lds + AT_TILE + r * AT_RS + ch * 16) = vreg[t]; }
    __syncthreads();
    while (c < 5) {
        int cn = c + 1; while (cn < 5 && !AT_VALID(cn)) ++cn;
        if (cn < 5) {
#pragma unroll
            for (int t = 0; t < 2; ++t) { const int idx = tid + 512 * t, r = idx >> 3, ch = idx & 7; const bf16_t* src = P + (size_t)(AT_ROW(cn) + r) * LDP + kvh * 64 + ch * 8;
                kreg[t] = *(const u32x4*)(src + C_AK); vreg[t] = *(const u32x4*)(src + C_AV); }
        }
        const LAS unsigned char* Kb = lds + buf * 2 * AT_TILE; const LAS unsigned char* Vb = Kb + AT_TILE;
        const bool lo_blk = (!is_ctx && c == 0), hi_blk = (!is_ctx && c == 2);
        for (int grp = 0; grp < 4; ++grp) {
            if (lo_blk && qh == 1 && grp < 2) continue;
            if (hi_blk && qh == 0 && grp >= 2) continue;
            bf16x8 kf[2][2], vf[4];
#pragma unroll
            for (int kt = 0; kt < 2; ++kt)
#pragma unroll
                for (int ks = 0; ks < 2; ++ks) kf[kt][ks] = *(const LAS bf16x8*)(Kb + (grp * 32 + kt * 16 + i) * AT_RS + (32 * ks + 8 * g) * 2);
#pragma unroll
            for (int dt = 0; dt < 4; ++dt) { const LAS unsigned char* vp = Vb + (grp * 32 + 4 * g + (i >> 2)) * AT_RS + (16 * dt + 4 * (i & 3)) * 2;
                vf[dt] = cat44(ds_tr16(vp), ds_tr16(vp + 16 * AT_RS)); }
#pragma unroll
            for (int qt = 0; qt < 4; ++qt) {
                f32x4 s0 = (f32x4){0.f, 0.f, 0.f, 0.f}, s1 = s0;
#pragma unroll
                for (int ks = 0; ks < 2; ++ks) { s0 = MFMA16(kf[0][ks], bq[qt][ks], s0); s1 = MFMA16(kf[1][ks], bq[qt][ks], s1); }
                if (lo_blk || hi_blk) {
                    const int qo = qh * 64 + qt * 16 + i, ko = grp * 32 + 4 * g;
#pragma unroll
                    for (int r = 0; r < 4; ++r) {
                        const bool v0 = lo_blk ? (ko + r >= qo) : (ko + r <= qo), v1 = lo_blk ? (ko + 16 + r >= qo) : (ko + 16 + r <= qo);
                        s0[r] = v0 ? s0[r] : -INFINITY; s1[r] = v1 ? s1[r] : -INFINITY; }
                }
                float mx = fmaxf(fmaxf(fmaxf(s0[0], s0[1]), fmaxf(s0[2], s0[3])), fmaxf(fmaxf(s1[0], s1[1]), fmaxf(s1[2], s1[3])));
                mx = grp_max(mx);
                if (__any(mx > m[qt])) {
                    const float mn = fmaxf(m[qt], mx), alpha = __builtin_amdgcn_exp2f(m[qt] - mn);
                    m[qt] = mn; l[qt] *= alpha;
#pragma unroll
                    for (int dt = 0; dt < 4; ++dt) O[dt][qt] = O[dt][qt] * alpha;
                }
                const float mq = m[qt];
                float ps = 0.f;
#pragma unroll
                for (int r = 0; r < 4; ++r) { s0[r] = __builtin_amdgcn_exp2f(s0[r] - mq); s1[r] = __builtin_amdgcn_exp2f(s1[r] - mq); ps += s0[r] + s1[r]; }
                l[qt] += ps;
                u32x4 pw; pw.x = cvtpk(s0[0], s0[1]); pw.y = cvtpk(s0[2], s0[3]); pw.z = cvtpk(s1[0], s1[1]); pw.w = cvtpk(s1[2], s1[3]);
                const bf16x8 pb = __builtin_bit_cast(bf16x8, pw);
#pragma unroll
                for (int dt = 0; dt < 4; ++dt) O[dt][qt] = MFMA16(vf[dt], pb, O[dt][qt]);
            }
        }
        if (cn < 5) {
            LAS unsigned char* nb = lds + (buf ^ 1) * 2 * AT_TILE;
#pragma unroll
            for (int t = 0; t < 2; ++t) { const int idx = tid + 512 * t, r = idx >> 3, ch = idx & 7; *(LAS u32x4*)(nb + r * AT_RS + ch * 16) = kreg[t]; *(LAS u32x4*)(nb + AT_TILE + r * AT_RS + ch * 16) = vreg[t]; }
        }
        __syncthreads();
        buf ^= 1; c = cn;
    }
#undef AT_VALID
#undef AT_ROW
#pragma unroll
    for (int qt = 0; qt < 4; ++qt) {
        const float inv = 1.f / grp_sum(l[qt]);
        bf16_t* dst = CAT + (size_t)(qrow0 + 16 * qt + i) * DM + 256 + hq * 64 + 4 * g;
#pragma unroll
        for (int dt = 0; dt < 4; ++dt) { uint2 o; o.x = cvtpk(O[dt][qt][0] * inv, O[dt][qt][1] * inv); o.y = cvtpk(O[dt][qt][2] * inv, O[dt][qt][3] * inv); *(uint2*)(dst + 16 * dt) = o; }
    }
}

constexpr int CH_RS = 144;
constexpr int CH_T = 64 * CH_RS;
constexpr int GL_RS = 80;
constexpr int GL_T = 64 * GL_RS;
__device__ __forceinline__ int chunk_b0(int oc) { return (oc < 256) ? oc * 64 : SEQ + (oc - 256) * 64; }
__device__ __forceinline__ bf16x8 tr_frag(const LAS unsigned char* tile, int rs, int row0, int col0, int lane) {
    const int g = lane >> 4, i = lane & 15; const LAS unsigned char* p = tile + (row0 + 8 * g + (i >> 2)) * rs + (col0 + 4 * (i & 3)) * 2;
    return cat44(ds_tr16(p), ds_tr16(p + 4 * rs));
}
__device__ __forceinline__ bf16x8 tr_frag_perm(const LAS unsigned char* tile, int rs, int row0, int col0, int lane) {
    const int g = lane >> 4, i = lane & 15; const LAS unsigned char* p = tile + (row0 + 4 * g + (i >> 2)) * rs + (col0 + 4 * (i & 3)) * 2;
    return cat44(ds_tr16(p), ds_tr16(p + 16 * rs));
}
__device__ __forceinline__ void unpack8(const u32x4 v, float* o) {
    o[0] = __uint_as_float(v.x << 16); o[1] = __uint_as_float(v.x & 0xffff0000u); o[2] = __uint_as_float(v.y << 16); o[3] = __uint_as_float(v.y & 0xffff0000u);
    o[4] = __uint_as_float(v.z << 16); o[5] = __uint_as_float(v.z & 0xffff0000u); o[6] = __uint_as_float(v.w << 16); o[7] = __uint_as_float(v.w & 0xffff0000u);
}
__device__ __forceinline__ u32x4 pack8(const float* f) { u32x4 w; w.x = cvtpk(f[0], f[1]); w.y = cvtpk(f[2], f[3]); w.z = cvtpk(f[4], f[5]); w.w = cvtpk(f[6], f[7]); return w; }

#define LBAR() do { asm volatile("s_waitcnt lgkmcnt(0)" ::: "memory"); __builtin_amdgcn_s_barrier(); asm volatile("" ::: "memory"); } while (0)

struct MsRaw { u32x4 k, v; float ig, fg, gbi, gbf; };
__device__ __forceinline__ MsRaw mlstm_summary_load(const bf16_t* P, const float* Gt, const float* gate_b, int h, int oc, int tid, int lane, int wave) {
    MsRaw R; const int b0 = chunk_b0(oc), r = tid >> 3, ch = tid & 7;
    R.k = *(const u32x4*)(P + (size_t)(b0 + r) * LDP + C_MK + h * 64 + ch * 8); R.v = *(const u32x4*)(P + (size_t)(b0 + r) * LDP + C_MV + h * 64 + ch * 8);
    { const int d = wave & 1, sp = d ? 63 - lane : lane, row = b0 + sp;
      R.ig = Gt[(size_t)row * 48 + d * 8 + h]; R.gbi = gate_b[d * 8 + h]; R.fg = Gt[(size_t)row * 48 + d * 8 + 4 + h]; R.gbf = gate_b[d * 8 + 4 + h]; }
    return R;
}
__device__ __forceinline__ void mlstm_summary_body(LAS unsigned char* lds, const MsRaw& R, float* MU, float* MNU, float* MSC, int h, int oc, int tid, int lane, int wave) {
    LAS unsigned char* Kw0 = lds; LAS unsigned char* Kw1 = lds + CH_T; LAS unsigned char* Vt = lds + 2 * CH_T; LAS float* wv = (LAS float*)(lds + 3 * CH_T);
    const int r = tid >> 3, ch = tid & 7;
    LBAR();
    if (wave < 2) {
        const int d = wave, sp = d ? 63 - lane : lane, hd = h * 2 + d, jc = oc_to_jc(d, oc);
        const float lf = log_sigmoidf_(R.fg + R.gbf);
        const float bb = scan_add(lf, lane);
        const float av = (R.ig + R.gbi) - bb;
        const float cm = wave_max(av);
        const float B = __shfl(bb, 63);
        wv[d * 64 + sp] = __expf(av - cm);
        if (lane == 0) { MSC[(size_t)(hd * NCH + jc) * 4 + 0] = cm; MSC[(size_t)(hd * NCH + jc) * 4 + 1] = B; }
    }
    *(LAS u32x4*)(Vt + r * CH_RS + ch * 16) = R.v;
    LBAR();
    { float kf[8], t0[8], t1[8]; unpack8(R.k, kf); const float w0 = wv[r], w1 = wv[64 + r];
#pragma unroll
      for (int j = 0; j < 8; ++j) { t0[j] = kf[j] * w0; t1[j] = kf[j] * w1; }
      *(LAS u32x4*)(Kw0 + r * CH_RS + ch * 16) = pack8(t0); *(LAS u32x4*)(Kw1 + r * CH_RS + ch * 16) = pack8(t1); }
    LBAR();
    { const int d = wave >> 2, dkt = wave & 3, g = lane >> 4, i = lane & 15, hd = h * 2 + d, jc = oc_to_jc(d, oc);
      const LAS unsigned char* Kw = d ? Kw1 : Kw0;
      const bf16x8 a0 = tr_frag(Kw, CH_RS, 0, 16 * dkt, lane), a1 = tr_frag(Kw, CH_RS, 32, 16 * dkt, lane);
      float* dst = MU + ((size_t)(hd * 64 + 16 * dkt + i) * NCH + jc) * 64 + 4 * g;
#pragma unroll
      for (int dvt = 0; dvt < 4; ++dvt) {
          f32x4 c = (f32x4){0.f, 0.f, 0.f, 0.f};
          c = MFMA16(tr_frag(Vt, CH_RS, 0, 16 * dvt, lane), a0, c); c = MFMA16(tr_frag(Vt, CH_RS, 32, 16 * dvt, lane), a1, c);
          *(f32x4*)(dst + 16 * dvt) = c;
      }
      const short one = (i == 0) ? (short)0x3F80 : (short)0; const bf16x8 bo = (bf16x8){one, one, one, one, one, one, one, one};
      f32x4 c1 = (f32x4){0.f, 0.f, 0.f, 0.f}; c1 = MFMA16(a0, bo, c1); c1 = MFMA16(a1, bo, c1);
      if (i == 0) *(f32x4*)(MNU + (size_t)(hd * NCH + jc) * 64 + 16 * dkt + 4 * g) = c1; }
}

struct MoRaw { u32x4 q, k, v, c0, c1; float ig, fg, gbi, gbf, mst, nv; uint2 og[4]; };
__device__ __forceinline__ MoRaw mlstm_out_load(const bf16_t* P, const float* Gt, const float* gate_b, const bf16_t* MC, const float* MNS, const float* MSC, int h, int oc, int tid, int lane, int wave) {
    MoRaw R; const int b0 = chunk_b0(oc), r = tid >> 3, ch = tid & 7;
    const size_t ro = (size_t)(b0 + r) * LDP + h * 64 + ch * 8;
    R.q = *(const u32x4*)(P + ro + C_MQ); R.k = *(const u32x4*)(P + ro + C_MK); R.v = *(const u32x4*)(P + ro + C_MV);
    const int jc0 = oc_to_jc(0, oc), jc1 = oc_to_jc(1, oc);
    R.c0 = *(const u32x4*)(MC + ((size_t)((h * 2 + 0) * 64 + r) * NCH + jc0) * 64 + ch * 8); R.c1 = *(const u32x4*)(MC + ((size_t)((h * 2 + 1) * 64 + r) * NCH + jc1) * 64 + ch * 8);
    { const int d = wave & 1, sp = d ? 63 - lane : lane, row = b0 + sp, hd = h * 2 + d, jc = d ? jc1 : jc0;
        R.ig = Gt[(size_t)row * 48 + d * 8 + h]; R.gbi = gate_b[d * 8 + h]; R.fg = Gt[(size_t)row * 48 + d * 8 + 4 + h]; R.gbf = gate_b[d * 8 + 4 + h];
        R.mst = MSC[(size_t)(hd * NCH + jc) * 4 + 2]; R.nv = MNS[(size_t)(hd * NCH + jc) * 64 + lane]; }
    { const int tt = wave & 3, g = lane >> 4, i = lane & 15, row = b0 + 16 * tt + i;
#pragma unroll
      for (int dvt = 0; dvt < 4; ++dvt) R.og[dvt] = *(const uint2*)(P + (size_t)row * LDP + C_MO + h * 64 + 16 * dvt + 4 * g); }
    return R;
}
__device__ __forceinline__ void mlstm_out_body(LAS unsigned char* lds, const MoRaw& R, const float* normw, bf16_t* CAT, int h, int oc, int tid, int lane, int wave) {
    LAS unsigned char* Qt = lds; LAS unsigned char* Kt = lds + CH_T; LAS unsigned char* Vt = lds + 2 * CH_T; LAS unsigned char* Ct = lds + 3 * CH_T;
    LAS float* arr = (LAS float*)(lds + 5 * CH_T);
    LAS f32x4* hs = (LAS f32x4*)(lds + 5 * CH_T + 2 * 320 * 4);
    const int b0 = chunk_b0(oc);
    const int r = tid >> 3, ch = tid & 7;
    LBAR();
    if (wave < 2) {
        const int d = wave, sp = d ? 63 - lane : lane;
        const float lf = log_sigmoidf_(R.fg + R.gbf);
        const float bb = scan_add(lf, lane);
        const float av = (R.ig + R.gbi) - bb;
        const float cm = scan_max(av, lane);
        const float mx = fmaxf(R.mst, cm);
        LAS float* A = arr + d * 320;
        A[sp] = av; A[64 + sp] = mx; A[128 + sp] = __expf(R.mst - mx); A[192 + sp] = __expf(-(bb + mx));
        A[256 + lane] = R.nv;
    }
    *(LAS u32x4*)(Qt + r * CH_RS + ch * 16) = R.q; *(LAS u32x4*)(Kt + r * CH_RS + ch * 16) = R.k; *(LAS u32x4*)(Vt + r * CH_RS + ch * 16) = R.v;
    *(LAS u32x4*)(Ct + r * CH_RS + ch * 16) = R.c0; *(LAS u32x4*)(Ct + CH_T + r * CH_RS + ch * 16) = R.c1;
    LBAR();
    const int d = wave >> 2, tt = wave & 3, g = lane >> 4, i = lane & 15, t = 16 * tt + i;
    f32x4 hh[4];
    {
        const LAS float* A = arr + d * 320;
        const float mxt = A[64 + t], wt = A[128 + t], emt = A[192 + t];
        bf16x8 bq[2], bqw[2]; float qn = 0.f;
#pragma unroll
        for (int ks = 0; ks < 2; ++ks) { const u32x4 raw = *(const LAS u32x4*)(Qt + t * CH_RS + (32 * ks + 8 * g) * 2); bq[ks] = __builtin_bit_cast(bf16x8, raw);
            float qf[8], qw[8]; unpack8(raw, qf);
            const f32x4 n0 = *(const LAS f32x4*)(A + 256 + 32 * ks + 8 * g), n1 = *(const LAS f32x4*)(A + 256 + 32 * ks + 8 * g + 4);
#pragma unroll
            for (int j = 0; j < 4; ++j) { qn += qf[j] * n0[j] + qf[4 + j] * n1[j]; }
#pragma unroll
            for (int j = 0; j < 8; ++j) qw[j] = qf[j] * wt;
            bqw[ks] = __builtin_bit_cast(bf16x8, pack8(qw)); }
        qn += __shfl_xor(qn, 16); qn += __shfl_xor(qn, 32);
        float dsum = 0.f; f32x4 sT[4];
#pragma unroll
        for (int st = 0; st < 4; ++st) {
            f32x4 c = (f32x4){0.f, 0.f, 0.f, 0.f};
#pragma unroll
            for (int ks = 0; ks < 2; ++ks) c = MFMA16(*(const LAS bf16x8*)(Kt + (16 * st + i) * CH_RS + (32 * ks + 8 * g) * 2), bq[ks], c);
            const f32x4 a4 = *(const LAS f32x4*)(A + 16 * st + 4 * g);
#pragma unroll
            for (int rr = 0; rr < 4; ++rr) { const int sidx = 16 * st + 4 * g + rr; const bool ok = d ? (sidx >= t) : (sidx <= t);
                const float val = ok ? c[rr] * __expf(a4[rr] - mxt) : 0.f; sT[st][rr] = val; dsum += val; }
        }
        dsum += __shfl_xor(dsum, 16); dsum += __shfl_xor(dsum, 32);
        const float den = dsum + wt * qn, inv = 1.f / fmaxf(fabsf(den), emt);
        bf16x8 pb[2];
#pragma unroll
        for (int gp = 0; gp < 2; ++gp) { u32x4 w; w.x = cvtpk(sT[2 * gp][0], sT[2 * gp][1]); w.y = cvtpk(sT[2 * gp][2], sT[2 * gp][3]); w.z = cvtpk(sT[2 * gp + 1][0], sT[2 * gp + 1][1]); w.w = cvtpk(sT[2 * gp + 1][2], sT[2 * gp + 1][3]); pb[gp] = __builtin_bit_cast(bf16x8, w); }
        const LAS unsigned char* Cd = Ct + d * CH_T;
#pragma unroll
        for (int dvt = 0; dvt < 4; ++dvt) {
            f32x4 c = (f32x4){0.f, 0.f, 0.f, 0.f};
            c = MFMA16(tr_frag_perm(Vt, CH_RS, 0, 16 * dvt, lane), pb[0], c); c = MFMA16(tr_frag_perm(Vt, CH_RS, 32, 16 * dvt, lane), pb[1], c);
            c = MFMA16(tr_frag(Cd, CH_RS, 0, 16 * dvt, lane), bqw[0], c); c = MFMA16(tr_frag(Cd, CH_RS, 32, 16 * dvt, lane), bqw[1], c);
            hh[dvt] = c * inv;
        }
        if (d == 1) {
#pragma unroll
            for (int dvt = 0; dvt < 4; ++dvt) hs[(tt * 4 + dvt) * 64 + lane] = hh[dvt];
        }
    }
    LBAR();
    if (d == 0) {
        float s1 = 0.f;
#pragma unroll
        for (int dvt = 0; dvt < 4; ++dvt) { hh[dvt] = hh[dvt] + hs[(tt * 4 + dvt) * 64 + lane]; s1 += (hh[dvt][0] + hh[dvt][1]) + (hh[dvt][2] + hh[dvt][3]); }
        s1 += __shfl_xor(s1, 16); s1 += __shfl_xor(s1, 32);
        const float mu = s1 * (1.f / 64.f); float s2 = 0.f;
#pragma unroll
        for (int dvt = 0; dvt < 4; ++dvt) { hh[dvt] = hh[dvt] - mu; s2 += (hh[dvt][0] * hh[dvt][0] + hh[dvt][1] * hh[dvt][1]) + (hh[dvt][2] * hh[dvt][2] + hh[dvt][3] * hh[dvt][3]); }
        s2 += __shfl_xor(s2, 16); s2 += __shfl_xor(s2, 32);
        const float rstd = rsqrtf(s2 * (1.f / 64.f) + LN_EPS);
        const int row = b0 + t;
#pragma unroll
        for (int dvt = 0; dvt < 4; ++dvt) { const int col = h * 64 + 16 * dvt + 4 * g;
            const uint2 og = R.og[dvt]; const f32x4 nw = *(const f32x4*)(normw + col);
            const float o0 = hh[dvt][0] * rstd * nw[0] * sigmoidf_(__uint_as_float(og.x << 16)), o1 = hh[dvt][1] * rstd * nw[1] * sigmoidf_(__uint_as_float(og.x & 0xffff0000u));
            const float o2 = hh[dvt][2] * rstd * nw[2] * sigmoidf_(__uint_as_float(og.y << 16)), o3 = hh[dvt][3] * rstd * nw[3] * sigmoidf_(__uint_as_float(og.y & 0xffff0000u));
            uint2 o; o.x = cvtpk(o0, o1); o.y = cvtpk(o2, o3); *(uint2*)(CAT + (size_t)row * DM + col) = o; }
    }
}

struct GgRaw { f32x4 g0, g1, g2, g3; };
__device__ __forceinline__ GgRaw gla_gates_load(const float* Gt, int b0, int lane, int wave) {
    const int d = wave >> 2, sp = d ? 63 - lane : lane; const float* gs = Gt + (size_t)(b0 + sp) * 48 + 16 + d * 16;
    GgRaw R; R.g0 = *(const f32x4*)gs; R.g1 = *(const f32x4*)(gs + 4); R.g2 = *(const f32x4*)(gs + 8); R.g3 = *(const f32x4*)(gs + 12); return R;
}
__device__ __forceinline__ void gla_gates_wave(const GgRaw& R, const LAS float* g_up, const LAS float* g_b, int h, int lane, int wave, float (&bc)[8]) {
    const int d = wave >> 2, dk0 = 8 * (wave & 3);
    const float gv[16] = {R.g0[0], R.g0[1], R.g0[2], R.g0[3], R.g1[0], R.g1[1], R.g1[2], R.g1[3], R.g2[0], R.g2[1], R.g2[2], R.g2[3], R.g3[0], R.g3[1], R.g3[2], R.g3[3]};
    float z[8];
    { const f32x4 b0 = *(const LAS f32x4*)(g_b + d * 128 + h * 32 + dk0), b1 = *(const LAS f32x4*)(g_b + d * 128 + h * 32 + dk0 + 4);
#pragma unroll
      for (int c = 0; c < 4; ++c) { z[c] = b0[c]; z[4 + c] = b1[c]; } }
#pragma unroll
    for (int rr = 0; rr < 16; ++rr) { const f32x4 u0 = *(const LAS f32x4*)(g_up + (d * 16 + rr) * 128 + h * 32 + dk0), u1 = *(const LAS f32x4*)(g_up + (d * 16 + rr) * 128 + h * 32 + dk0 + 4);
#pragma unroll
        for (int c = 0; c < 4; ++c) { z[c] += gv[rr] * u0[c]; z[4 + c] += gv[rr] * u1[c]; } }
#pragma unroll
    for (int c = 0; c < 8; ++c) bc[c] = scan_add(log_sigmoidf_(z[c]) * (1.f / 16.f), lane);
}
struct GsRaw { u32x4 v, k; GgRaw gg; };
__device__ __forceinline__ GsRaw gla_summary_load(const bf16_t* P, const float* Gt, int h, int oc, int tid, int lane, int wave) {
    GsRaw R; const int b0 = chunk_b0(oc), r = tid >> 3, ch = tid & 7, d = wave >> 2, dk0 = 8 * (wave & 3), sp = d ? 63 - lane : lane;
    R.v = *(const u32x4*)(P + (size_t)(b0 + r) * LDP + C_GV + h * 64 + ch * 8);
    R.k = *(const u32x4*)(P + (size_t)(b0 + sp) * LDP + C_GK + h * 32 + dk0);
    R.gg = gla_gates_load(Gt, b0, lane, wave);
    return R;
}
__device__ __forceinline__ void gla_summary_body(LAS unsigned char* lds, const GsRaw& R, const LAS float* g_up, const LAS float* g_b, float* GU, float* GDEC, int h, int oc, int tid, int lane, int wave) {
    LAS unsigned char* Kd = lds; LAS unsigned char* Vt = lds + 2 * GL_T;
    { const int r = tid >> 3, ch = tid & 7;
      LBAR();
      *(LAS u32x4*)(Vt + r * CH_RS + ch * 16) = R.v; }
    { const int d = wave >> 2, dk0 = 8 * (wave & 3), hd = h * 2 + d, jc = oc_to_jc(d, oc), sp = d ? 63 - lane : lane;
      float bc[8]; gla_gates_wave(R.gg, g_up, g_b, h, lane, wave, bc);
      float kf[8]; unpack8(R.k, kf);
      float dec[8];
#pragma unroll
      for (int c = 0; c < 8; ++c) { const float bL = __shfl(bc[c], 63); kf[c] *= __expf(bL - bc[c]); dec[c] = __expf(bL); }
      *(LAS u32x4*)(Kd + d * GL_T + sp * GL_RS + dk0 * 2) = pack8(kf);
      if (lane == 0) { float* dp = GDEC + (size_t)(hd * NCH + jc) * 32 + dk0; *(f32x4*)dp = (f32x4){dec[0], dec[1], dec[2], dec[3]}; *(f32x4*)(dp + 4) = (f32x4){dec[4], dec[5], dec[6], dec[7]}; } }
    LBAR();
    { const int d = wave >> 2, dkt = (wave >> 1) & 1, dvh = wave & 1, g = lane >> 4, i = lane & 15, hd = h * 2 + d, jc = oc_to_jc(d, oc);
      const bf16x8 a0 = tr_frag(Kd + d * GL_T, GL_RS, 0, 16 * dkt, lane), a1 = tr_frag(Kd + d * GL_T, GL_RS, 32, 16 * dkt, lane);
      float* dst = GU + ((size_t)(hd * 32 + 16 * dkt + i) * NCH + jc) * 64 + 4 * g;
#pragma unroll
      for (int q = 0; q < 2; ++q) { const int dvt = 2 * dvh + q;
          f32x4 c = (f32x4){0.f, 0.f, 0.f, 0.f};
          c = MFMA16(tr_frag(Vt, CH_RS, 0, 16 * dvt, lane), a0, c); c = MFMA16(tr_frag(Vt, CH_RS, 32, 16 * dvt, lane), a1, c);
          *(f32x4*)(dst + 16 * dvt) = c; } }
}
struct GoRaw { u32x4 v, s, q, k; GgRaw gg; uint2 og[4]; };
__device__ __forceinline__ GoRaw gla_out_load(const bf16_t* P, const float* Gt, const bf16_t* GS, int h, int oc, int tid, int lane, int wave) {
    GoRaw R; const int b0 = chunk_b0(oc), r = tid >> 3, ch = tid & 7, d = wave >> 2, dk0 = 8 * (wave & 3), sp = d ? 63 - lane : lane;
    R.v = *(const u32x4*)(P + (size_t)(b0 + r) * LDP + C_GV + h * 64 + ch * 8);
    { const int dd = r >> 5, rk = r & 31; R.s = *(const u32x4*)(GS + ((size_t)((h * 2 + dd) * 32 + rk) * NCH + oc_to_jc(dd, oc)) * 64 + ch * 8); }
    R.q = *(const u32x4*)(P + (size_t)(b0 + sp) * LDP + C_GQ + h * 32 + dk0); R.k = *(const u32x4*)(P + (size_t)(b0 + sp) * LDP + C_GK + h * 32 + dk0);
    R.gg = gla_gates_load(Gt, b0, lane, wave);
    { const int tt = wave & 3, g = lane >> 4, i = lane & 15, row = b0 + 16 * tt + i;
#pragma unroll
      for (int dvt = 0; dvt < 4; ++dvt) R.og[dvt] = *(const uint2*)(P + (size_t)row * LDP + C_GG + h * 64 + 16 * dvt + 4 * g); }
    return R;
}
__device__ __forceinline__ void gla_out_body(LAS unsigned char* lds, const GoRaw& R, const LAS float* g_up, const LAS float* g_b, const float* normw, bf16_t* CAT, int h, int oc, int tid, int lane, int wave) {
    LAS unsigned char* Qs = lds; LAS unsigned char* Ks = lds + 2 * GL_T; LAS unsigned char* Vt = lds + 4 * GL_T; LAS unsigned char* St = Vt + CH_T;
    LAS f32x4* hs = (LAS f32x4*)(St + 2 * 32 * CH_RS);
    const int b0 = chunk_b0(oc);
    { const int r = tid >> 3, ch = tid & 7, dd = r >> 5, rk = r & 31;
      LBAR();
      *(LAS u32x4*)(Vt + r * CH_RS + ch * 16) = R.v; *(LAS u32x4*)(St + dd * 32 * CH_RS + rk * CH_RS + ch * 16) = R.s; }
    { const int d = wave >> 2, dk0 = 8 * (wave & 3), sp = d ? 63 - lane : lane;
      float bc[8]; gla_gates_wave(R.gg, g_up, g_b, h, lane, wave, bc);
      float qf[8], kf[8]; unpack8(R.q, qf); unpack8(R.k, kf);
#pragma unroll
      for (int c = 0; c < 8; ++c) { qf[c] *= __expf(bc[c]); kf[c] *= __expf(-bc[c]); }
      *(LAS u32x4*)(Qs + d * GL_T + sp * GL_RS + dk0 * 2) = pack8(qf); *(LAS u32x4*)(Ks + d * GL_T + sp * GL_RS + dk0 * 2) = pack8(kf); }
    LBAR();
    const int d = wave >> 2, tt = wave & 3, g = lane >> 4, i = lane & 15, t = 16 * tt + i;
    f32x4 hh[4];
    {
        const bf16x8 bq = *(const LAS bf16x8*)(Qs + d * GL_T + t * GL_RS + 16 * g);
        f32x4 sT[4];
#pragma unroll
        for (int st = 0; st < 4; ++st) {
            f32x4 c = (f32x4){0.f, 0.f, 0.f, 0.f};
            c = MFMA16(*(const LAS bf16x8*)(Ks + d * GL_T + (16 * st + i) * GL_RS + 16 * g), bq, c);
#pragma unroll
            for (int rr = 0; rr < 4; ++rr) { const int sidx = 16 * st + 4 * g + rr; const bool ok = d ? (sidx >= t) : (sidx <= t); sT[st][rr] = ok ? c[rr] : 0.f; }
        }
        bf16x8 pb[2];
#pragma unroll
        for (int gp = 0; gp < 2; ++gp) { u32x4 w; w.x = cvtpk(sT[2 * gp][0], sT[2 * gp][1]); w.y = cvtpk(sT[2 * gp][2], sT[2 * gp][3]); w.z = cvtpk(sT[2 * gp + 1][0], sT[2 * gp + 1][1]); w.w = cvtpk(sT[2 * gp + 1][2], sT[2 * gp + 1][3]); pb[gp] = __builtin_bit_cast(bf16x8, w); }
#pragma unroll
        for (int dvt = 0; dvt < 4; ++dvt) {
            f32x4 c = (f32x4){0.f, 0.f, 0.f, 0.f};
            c = MFMA16(tr_frag_perm(Vt, CH_RS, 0, 16 * dvt, lane), pb[0], c); c = MFMA16(tr_frag_perm(Vt, CH_RS, 32, 16 * dvt, lane), pb[1], c);
            c = MFMA16(tr_frag(St + d * 32 * CH_RS, CH_RS, 0, 16 * dvt, lane), bq, c);
            hh[dvt] = c;
        }
        if (d == 1) {
#pragma unroll
            for (int dvt = 0; dvt < 4; ++dvt) hs[(tt * 4 + dvt) * 64 + lane] = hh[dvt];
        }
    }
    LBAR();
    if (d == 0) {
        float s1 = 0.f;
#pragma unroll
        for (int dvt = 0; dvt < 4; ++dvt) { hh[dvt] = hh[dvt] + hs[(tt * 4 + dvt) * 64 + lane]; s1 += (hh[dvt][0] + hh[dvt][1]) + (hh[dvt][2] + hh[dvt][3]); }
        s1 += __shfl_xor(s1, 16); s1 += __shfl_xor(s1, 32);
        const float mu = s1 * (1.f / 64.f); float s2 = 0.f;
#pragma unroll
        for (int dvt = 0; dvt < 4; ++dvt) { hh[dvt] = hh[dvt] - mu; s2 += (hh[dvt][0] * hh[dvt][0] + hh[dvt][1] * hh[dvt][1]) + (hh[dvt][2] * hh[dvt][2] + hh[dvt][3] * hh[dvt][3]); }
        s2 += __shfl_xor(s2, 16); s2 += __shfl_xor(s2, 32);
        const float rstd = rsqrtf(s2 * (1.f / 64.f) + LN_EPS);
        const int row = b0 + t;
#pragma unroll
        for (int dvt = 0; dvt < 4; ++dvt) { const int col = h * 64 + 16 * dvt + 4 * g;
            const uint2 gg = R.og[dvt]; const f32x4 nw = *(const f32x4*)(normw + col);
            const float o0 = hh[dvt][0] * rstd * nw[0] * siluf(__uint_as_float(gg.x << 16)), o1 = hh[dvt][1] * rstd * nw[1] * siluf(__uint_as_float(gg.x & 0xffff0000u));
            const float o2 = hh[dvt][2] * rstd * nw[2] * siluf(__uint_as_float(gg.y << 16)), o3 = hh[dvt][3] * rstd * nw[3] * siluf(__uint_as_float(gg.y & 0xffff0000u));
            uint2 o; o.x = cvtpk(o0, o1); o.y = cvtpk(o2, o3); *(uint2*)(CAT + (size_t)row * DM + 768 + col) = o; }
    }
}

__device__ __forceinline__ f32x4 ld4bf(const bf16_t* p) { const uint2 v = *(const uint2*)p; return (f32x4){__uint_as_float(v.x << 16), __uint_as_float(v.x & 0xffff0000u), __uint_as_float(v.y << 16), __uint_as_float(v.y & 0xffff0000u)}; }
__device__ __forceinline__ void ln16(f32x4 (&v)[4], const float* w, const float* b, int lane) {
    float s = 0.f;
#pragma unroll
    for (int j = 0; j < 4; ++j) s += (v[j][0] + v[j][1]) + (v[j][2] + v[j][3]);
    const float mean = wave_sum(s) * (1.f / DM); float s2 = 0.f;
#pragma unroll
    for (int j = 0; j < 4; ++j) { v[j] = v[j] - mean; s2 += (v[j][0] * v[j][0] + v[j][1] * v[j][1]) + (v[j][2] * v[j][2] + v[j][3] * v[j][3]); }
    const float rstd = rsqrtf(wave_sum(s2) * (1.f / DM) + LN_EPS);
#pragma unroll
    for (int j = 0; j < 4; ++j) { const f32x4 wv = *(const f32x4*)(w + 4 * lane + 256 * j), bv = *(const f32x4*)(b + 4 * lane + 256 * j); v[j] = v[j] * rstd * wv + bv; }
}
__device__ __forceinline__ void mod_store(f32x4 (&v)[4], const float* shift, const float* scale, bf16_t* hrow, int lane) {
#pragma unroll
    for (int j = 0; j < 4; ++j) { const f32x4 sh = *(const f32x4*)(shift + 4 * lane + 256 * j), sc = *(const f32x4*)(scale + 4 * lane + 256 * j);
        v[j] = v[j] * (sc + 1.f) + sh;
        uint2 o; o.x = cvtpk(v[j][0], v[j][1]); o.y = cvtpk(v[j][2], v[j][3]); *(uint2*)(hrow + 4 * lane + 256 * j) = o; }
}

__global__ void __launch_bounds__(512, 2) fwd(Args a_unused) {
    extern __shared__ __attribute__((aligned(16))) unsigned char lds_raw[];
    LAS unsigned char* lds = (LAS unsigned char*)lds_raw;
    const int wave0 = __builtin_amdgcn_readfirstlane(threadIdx.x >> 6);
    const int G = gridDim.x, bid = blockIdx.x;
    typedef const __attribute__((address_space(4))) Args* ArgsP;
    ArgsP ap0 = (ArgsP)__builtin_amdgcn_kernarg_segment_ptr();
#define PH_CTX() int wave = wave0; asm volatile("" : "+s"(wave)); unsigned ones_ = ~0u; asm volatile("" : "+s"(ones_)); const int lane = (int)__builtin_amdgcn_mbcnt_hi(ones_, __builtin_amdgcn_mbcnt_lo(ones_, 0u)); const int tid = wave * 64 + lane; \
    ArgsP ap = ap0; asm volatile("" : "+s"(ap)); unsigned char* ws = ap->ws; const int gw = bid * 8 + wave, NGW = G * 8; (void)lane; (void)gw; (void)NGW; (void)ws
#define WSP(T, off) ((T*)(ws + (off)))
    volatile LAS unsigned* MISC = (volatile LAS unsigned*)(lds + MISC_OFF);
    if (threadIdx.x < 32) MISC[threadIdx.x] = 0u;
    __syncthreads();
    XcdBarrier bar; bar.bar = (unsigned*)(ap0->ws + WS_CTL) + CW_BAR; bar.x = 0; bar.st = MISC + 8;
    if (MK_ONE_LAUNCH) bar = xcd_barrier_post(bar.bar, MISC + 8);
    const int lo = ap0->ph_lo, hi = ap0->ph_hi;
#define IN(k) (lo <= (k) && (k) < hi)
#define SEAM(k) do { if (MK_ONE_LAUNCH && (k) + 1 < hi) xcd_barrier(bar); } while (0)

    if (IN(0)) {
        PH_CTX();
        float* MODS = WSP(float, WS_MODS);
        LAS float* scs = (LAS float*)lds;
        for (int i = tid; i < 2048; i += 512) scs[i] = siluf(i < 1024 ? ap->in[1][i] : ap->in[3][i - 1024]);
        __syncthreads();
        for (int u = bid; u < 4 * 8 * 12; u += G) {
            const int l = u / 96, rem = u % 96, kc = rem / 12, ng = rem % 12, n = ng * 512 + tid;
            const float* w = ap->in[4] + ((size_t)l * 1024 + kc * 128) * 6144 + n;
            float a0 = 0.f, a1 = 0.f;
#pragma unroll 8
            for (int k = 0; k < 128; ++k) { const float wv = w[(size_t)k * 6144]; a0 += scs[kc * 128 + k] * wv; a1 += scs[1024 + kc * 128 + k] * wv; }
            if (kc == 0) { const float bb = ap->in[5][l * 6144 + n]; a0 += bb; a1 += bb; }
            atomicAdd(MODS + (size_t)(l * 2 + 0) * 6144 + n, a0); atomicAdd(MODS + (size_t)(l * 2 + 1) * 6144 + n, a1);
        }
        if (bid < 8) { float* ropeC = WSP(float, WS_ROPE); float* ropeS = ropeC + 256 * 16;
            const int i = bid * 512 + tid, pos = i >> 4, fi = i & 15; const float inv = powf(10000.f, -(float)fi / 16.f); const float ang = (float)pos * inv; float sn, cs; sincosf(ang, &sn, &cs); ropeC[i] = cs; ropeS[i] = sn; }
        __syncthreads();
        LAS float* scr = (LAS float*)(lds + wave * 16640);
        constexpr int I_A = 16 * 44, I_B = 16 * 16, I_C = 16 * 88, I_D = 44 * 16, I_E = 16 * 112, I_F = 56 * 16;
        constexpr int N_A = 4 * I_A, N_B = 4 * I_B, N_C = 2 * I_C, N_D = 2 * I_D, N_E = 16 * I_E, N_F = 16 * I_F;
        for (int it = gw; it < N_A + N_B + N_C + N_D + N_E + N_F; it += NGW) {
            int r = it;
            if (r < N_E) { const int mi = r / I_E; tr_item(ap->in[20] + (size_t)mi * DM * 2 * DEXP, DM, 2 * DEXP, 2 * DEXP, WSP(bf16_t, WS_MGU) + (size_t)mi * 2 * DEXP * DM, 2, DEXP, scr, r % I_E, lane); continue; } r -= N_E;
            if (r < N_F) { const int mi = r / I_F; tr_item(ap->in[21] + (size_t)mi * DEXP * DM, DEXP, DM, DM, WSP(bf16_t, WS_MDN) + (size_t)mi * DM * DEXP, 0, 0, scr, r % I_F, lane); continue; } r -= N_F;
            if (r < N_A) { const int mi = r / I_A; tr_item(ap->in[6] + (size_t)mi * DM * IN_COLS, DM, IN_COLS, NPIN, WSP(bf16_t, WS_WIN) + (size_t)mi * NPIN * DM, 1, 0, scr, r % I_A, lane); continue; } r -= N_A;
            if (r < N_B) { const int mi = r / I_B; tr_item(ap->in[13] + (size_t)mi * DM * DM, DM, DM, DM, WSP(bf16_t, WS_WOUT) + (size_t)mi * DM * DM, 0, 0, scr, r % I_B, lane); continue; } r -= N_B;
            if (r < N_C) { const int mi = r / I_C; tr_item(ap->in[16] + (size_t)mi * DM * 2 * DFF, DM, 2 * DFF, 2 * DFF, WSP(bf16_t, WS_FGU) + (size_t)mi * 2 * DFF * DM, 2, DFF, scr, r % I_C, lane); continue; } r -= N_C;
            { const int mi = r / I_D; tr_item(ap->in[17] + (size_t)mi * DFF * DM, DFF, DM, DM, WSP(bf16_t, WS_FDN) + (size_t)mi * DM * DFF, 0, 0, scr, r % I_D, lane); }
        }
        SEAM(0);
    }
    if (IN(1)) {
        PH_CTX();
        float* X = WSP(float, WS_X); bf16_t* H = WSP(bf16_t, WS_H); const float* MODS = WSP(float, WS_MODS);
        for (int r = gw; r < TT; r += NGW) {
            const int wch = r >= SEQ; const float* src = wch ? ap->in[2] + (size_t)(r - SEQ) * DM : ap->in[0] + (size_t)r * DM;
            f32x4 v[4];
#pragma unroll
            for (int j = 0; j < 4; ++j) { v[j] = *(const f32x4*)(src + 4 * lane + 256 * j); *(f32x4*)(X + (size_t)r * DM + 4 * lane + 256 * j) = v[j]; }
            const float* md = MODS + (size_t)(0 * 2 + wch) * 6144;
            mod_store(v, md, md + 1024, H + (size_t)r * DM, lane);
        }
        SEAM(1);
    }

    for (int l = 0; l < DEPTH; ++l) {
        const int pb = 2 + 10 * l;
        const bool lastl = (l == DEPTH - 1), moe = (l & 1);
        const int nrows = lastl ? SEQ : TT;

        PHASE_REP(0) if (IN(pb + 0)) {
            PH_CTX();
            pg8::StaticOrder S; S.init(WSP(bf16_t, WS_H), WSP(bf16_t, WS_WIN) + (size_t)l * NPIN * DM, DM, TT, NPIN, G, bid);
            pg8::EpiInProj E{WSP(bf16_t, WS_P), WSP(float, WS_G), WSP(float, WS_ROPE), WSP(float, WS_ROPE) + 256 * 16};
            pg8::gemm_phase<pg8::EpiInProj, pg8::StaticOrder>(lds, DM, S, E, tid);
            SEAM(pb + 0);
        }
        PHASE_REP(1) if (IN(pb + 1)) {
            if (!lastl && bid >= 32 && bid < 36) { PH_CTX(); attn_unit(lds, WSP(bf16_t, WS_P), WSP(bf16_t, WS_CAT), -1, (bid - 32) >> 1, bid & 1, ap->in[9] + l * 8, tid, lane, wave); }
            { PH_CTX();
              const bf16_t* P = WSP(bf16_t, WS_P); const float* Gt = WSP(float, WS_G); const float* gate_b = ap->in[7] + l * 16;
#define UNIT_LOOP2(N_, start_, RawT, LOAD, BODY) do { int u0_ = (start_); if (u0_ < (N_)) { RawT A_ = LOAD(u0_); for (;;) { \
                  const int u1_ = u0_ + G; const RawT B_ = LOAD(u1_ < (N_) ? u1_ : u0_); BODY(A_, u0_); if (u1_ >= (N_)) break; \
                  const int u2_ = u1_ + G; A_ = LOAD(u2_ < (N_) ? u2_ : u1_); BODY(B_, u1_); if (u2_ >= (N_)) break; u0_ = u2_; } } } while (0)
#define MS_LOAD(u) mlstm_summary_load(P, Gt, gate_b, (u) / NCH, (u) % NCH, tid, lane, wave)
#define MS_BODY(R, u) mlstm_summary_body(lds, R, WSP(float, WS_MU), WSP(float, WS_MNU), WSP(float, WS_MSC), (u) / NCH, (u) % NCH, tid, lane, wave)
              UNIT_LOOP2(4 * NCH, bid, MsRaw, MS_LOAD, MS_BODY); }
            { PH_CTX();
              const bf16_t* P = WSP(bf16_t, WS_P); const float* Gt = WSP(float, WS_G);
#define GS_LOAD(u) gla_summary_load(P, Gt, (u) / NCH, (u) % NCH, tid, lane, wave)
              LAS float* gupL = (LAS float*)(lds + 65536); LAS float* gbL = gupL + 4096;
              __syncthreads(); for (int i = tid; i < 4096; i += 512) gupL[i] = ap->in[10][(size_t)l * 4096 + i]; if (tid < 256) gbL[tid] = ap->in[11][l * 256 + tid]; __syncthreads();
#define GS_BODY(R, u) gla_summary_body(lds, R, gupL, gbL, WSP(float, WS_GU), WSP(float, WS_GDEC), (u) / NCH, (u) % NCH, tid, lane, wave)
              UNIT_LOOP2(4 * NCH, (bid + 240) % G, GsRaw, GS_LOAD, GS_BODY); }
            SEAM(pb + 1);
        }
        PHASE_REP(2) if (IN(pb + 2)) {
            PH_CTX();
            const int wi = wave * G + bid;
            const int e0 = wi * 64;
            LAS float* sc = (LAS float*)(lds + wave * 4096);
#define SC_LOAD(buf, b) _Pragma("unroll") for (int j = 0; j < 52; ++j) buf[j] = U[(size_t)((b) * 52 + j) * str]
            if (e0 < 32768 + 512) {
                const bool isC = e0 < 32768;
                const int hd = isC ? e0 / 4096 : (e0 - 32768) / 64, idx = isC ? (e0 % 4096) + lane : lane;
                const int dkr = (e0 % 4096) >> 6;
                const float* __restrict__ U = isC ? WSP(float, WS_MU) + (size_t)(hd * 64 + dkr) * NCH * 64 + lane : WSP(float, WS_MNU) + (size_t)hd * NCH * 64 + lane;
                bf16_t* __restrict__ StC = WSP(bf16_t, WS_MC) + (size_t)(hd * 64 + dkr) * NCH * 64 + lane; float* __restrict__ StN = WSP(float, WS_MNS) + (size_t)hd * NCH * 64 + lane;
                float* __restrict__ MSC = WSP(float, WS_MSC) + (size_t)hd * NCH * 4;
                const int str = 64;
                const bool wr_m = isC && (e0 % 4096) == 0 && lane == 0;
                for (int k = lane; k < NCH; k += 64) { const float2 v = *(const float2*)(MSC + k * 4); sc[2 * k] = v.x; sc[2 * k + 1] = v.y; }
                LDS_WAIT();
                float m = 0.f, cval = 0.f;
#define SC_STEP_M(buf, b) _Pragma("unroll") for (int j = 0; j < 52; ++j) { const int n = (b) * 52 + j; \
                    if (isC) StC[(size_t)n * 64] = (bf16_t)f2bf(cval); else StN[(size_t)n * 64] = cval; \
                    if (wr_m) MSC[n * 4 + 2] = m; \
                    const float cmv = sc[2 * n], Bv = sc[2 * n + 1], mx = fmaxf(m, cmv); \
                    cval = __expf(m - mx) * cval + __expf(cmv - mx) * buf[j]; m = Bv + mx; }
                float ua[52], ub[52];
                SC_LOAD(ua, 0);
                SC_LOAD(ub, 1); SC_STEP_M(ua, 0); SC_LOAD(ua, 2); SC_STEP_M(ub, 1);
                SC_LOAD(ub, 3); SC_STEP_M(ua, 2); SC_LOAD(ua, 4); SC_STEP_M(ub, 3);
                SC_STEP_M(ua, 4);
#undef SC_STEP_M
            } else if (e0 < 32768 + 512 + 16384) {
                const int e2 = e0 - 33280, hd = e2 / 2048, idx = (e2 % 2048) + lane, dk = (e2 % 2048) >> 6;
                const float* __restrict__ U = WSP(float, WS_GU) + (size_t)(hd * 32 + dk) * NCH * 64 + lane; bf16_t* __restrict__ St = WSP(bf16_t, WS_GS) + (size_t)(hd * 32 + dk) * NCH * 64 + lane;
                const float* __restrict__ DC = WSP(float, WS_GDEC) + (size_t)hd * NCH * 32 + dk;
                const int str = 64;
                for (int k = lane; k < NCH; k += 64) sc[k] = DC[(size_t)k * 32];
                LDS_WAIT();
                float sval = 0.f;
#define SC_STEP_G(buf, b) _Pragma("unroll") for (int j = 0; j < 52; ++j) { const int n = (b) * 52 + j; St[(size_t)n * 64] = (bf16_t)f2bf(sval); sval = sc[n] * sval + buf[j]; }
                float ua[52], ub[52];
                SC_LOAD(ua, 0);
                SC_LOAD(ub, 1); SC_STEP_G(ua, 0); SC_LOAD(ua, 2); SC_STEP_G(ub, 1);
                SC_LOAD(ub, 3); SC_STEP_G(ua, 2); SC_LOAD(ua, 4); SC_STEP_G(ub, 3);
                SC_STEP_G(ua, 4);
#undef SC_STEP_G
            }
#undef SC_LOAD
            SEAM(pb + 2);
        }
        PHASE_REP(3) if (IN(pb + 3)) {
            const int noc = lastl ? 256 : 260;
            { PH_CTX();
              for (int u = bid; u < 256; u += G) attn_unit(lds, WSP(bf16_t, WS_P), WSP(bf16_t, WS_CAT), u >> 1, 0, u & 1, ap->in[9] + l * 8, tid, lane, wave); }
            { PH_CTX();
              const bf16_t* P = WSP(bf16_t, WS_P); const float* Gt = WSP(float, WS_G); const float* gate_b = ap->in[7] + l * 16;
              const bf16_t* MC = WSP(bf16_t, WS_MC); const float* MNS = WSP(float, WS_MNS); const float* MSC = WSP(float, WS_MSC);
#define MO_LOAD(u) mlstm_out_load(P, Gt, gate_b, MC, MNS, MSC, (u) / noc, (u) % noc, tid, lane, wave)
#define MO_BODY(R, u) mlstm_out_body(lds, R, ap->in[8] + l * 256, WSP(bf16_t, WS_CAT), (u) / noc, (u) % noc, tid, lane, wave)
              UNIT_LOOP2(4 * noc, bid, MoRaw, MO_LOAD, MO_BODY); }
            { PH_CTX();
              const bf16_t* P = WSP(bf16_t, WS_P); const float* Gt = WSP(float, WS_G); const bf16_t* GS = WSP(bf16_t, WS_GS);
#define GO_LOAD(u) gla_out_load(P, Gt, GS, (u) / noc, (u) % noc, tid, lane, wave)
              LAS float* gupL = (LAS float*)(lds + 65536); LAS float* gbL = gupL + 4096;
              __syncthreads(); for (int i = tid; i < 4096; i += 512) gupL[i] = ap->in[10][(size_t)l * 4096 + i]; if (tid < 256) gbL[tid] = ap->in[11][l * 256 + tid]; __syncthreads();
#define GO_BODY(R, u) gla_out_body(lds, R, gupL, gbL, ap->in[12] + l * 256, WSP(bf16_t, WS_CAT), (u) / noc, (u) % noc, tid, lane, wave)
              UNIT_LOOP2(4 * noc, (bid + 240) % G, GoRaw, GO_LOAD, GO_BODY); }
            SEAM(pb + 3);
        }
        PHASE_REP(4) if (IN(pb + 4)) {
            PH_CTX();
            const float* modl = WSP(float, WS_MODS) + (size_t)(l * 2 + 0) * 6144;
            int tp, sp; pg8::tail_params(nrows / 256, 4, DM / 64, G, tp, sp);
            pg8::TailOrder S; S.dense(WSP(bf16_t, WS_CAT), WSP(bf16_t, WS_WOUT) + (size_t)l * DM * DM, DM, DM, nrows / 256, G, bid, tp, sp);
            pg8::EpiResid E{WSP(bf16_t, WS_Y), modl + 2 * 1024, modl + 6144 + 2 * 1024, WSP(float, WS_YP), nrows - tp * 256, tp * 256};
            pg8::gemm_phase<pg8::EpiResid, pg8::TailOrder>(lds, DM, S, E, tid);
            SEAM(pb + 4);
        }
        if (IN(pb + 5)) {
            PH_CTX();
            float* X = WSP(float, WS_X); bf16_t* H = WSP(bf16_t, WS_H); const bf16_t* Yb = WSP(bf16_t, WS_Y);
            const float* modl = WSP(float, WS_MODS) + (size_t)(l * 2 + 0) * 6144;
            unsigned* mcnt = WSP(unsigned, WS_CTL) + CW_MOE + 64 * 8 * (l >> 1);
            LAS float* RW = (LAS float*)lds;
            if (moe) { const float* rw = ap->in[18] + (size_t)(l >> 1) * DM * 8; for (int i = tid; i < 8192; i += 512) { const int e = i >> 10, c = i & 1023; RW[i] = rw[c * 8 + e]; } __syncthreads(); }
            const float* lw = ap->in[14] + (size_t)(l * 2 + 0) * DM; const float* lb = ap->in[15] + (size_t)(l * 2 + 0) * DM;
            int tp, sp; pg8::tail_params(nrows / 256, 4, DM / 64, G, tp, sp);
            const int tail0 = nrows - tp * 256; const float* YP = WSP(float, WS_YP);
            for (int r = gw; r < nrows; r += NGW) {
                const int wch = r >= SEQ; const float* md = modl + wch * 6144;
                f32x4 v[4];
                if (r < tail0) {
#pragma unroll
                    for (int j = 0; j < 4; ++j) v[j] = *(const f32x4*)(X + (size_t)r * DM + 4 * lane + 256 * j) * ALPHA + ld4bf(Yb + (size_t)r * DM + 4 * lane + 256 * j);
                } else {
#pragma unroll
                    for (int j = 0; j < 4; ++j) { const int c = 4 * lane + 256 * j; f32x4 a4 = (f32x4){0.f, 0.f, 0.f, 0.f};
                        for (int p = 0; p < sp; ++p) a4 = a4 + *(const f32x4*)(YP + ((size_t)p * tp * 256 + (r - tail0)) * DM + c);
                        v[j] = *(const f32x4*)(X + (size_t)r * DM + c) * ALPHA + *(const f32x4*)(md + 2 * 1024 + c) * a4; }
                }
                ln16(v, lw, lb, lane);
#pragma unroll
                for (int j = 0; j < 4; ++j) *(f32x4*)(X + (size_t)r * DM + 4 * lane + 256 * j) = v[j];
                if (!moe) mod_store(v, md + 3 * 1024, md + 4 * 1024, H + (size_t)r * DM, lane);
                else {
#pragma unroll
                    for (int j = 0; j < 4; ++j) { const f32x4 sh = *(const f32x4*)(md + 3 * 1024 + 4 * lane + 256 * j), sc = *(const f32x4*)(md + 4 * 1024 + 4 * lane + 256 * j); v[j] = v[j] * (sc + 1.f) + sh; }
                    float lg[8];
#pragma unroll
                    for (int e = 0; e < 8; ++e) { float s = 0.f;
#pragma unroll
                        for (int j = 0; j < 4; ++j) { const f32x4 w = *(const LAS f32x4*)(RW + e * 1024 + 4 * lane + 256 * j); s += v[j][0] * w[0] + v[j][1] * w[1] + v[j][2] * w[2] + v[j][3] * w[3]; }
                        lg[e] = wave_sum(s) + ap->in[19][(l >> 1) * 8 + e]; }
                    int e0 = 0; float l0 = lg[0];
#pragma unroll
                    for (int e = 1; e < 8; ++e) if (lg[e] > l0) { l0 = lg[e]; e0 = e; }
                    int e1 = -1; float l1 = -INFINITY;
#pragma unroll
                    for (int e = 0; e < 8; ++e) if (e != e0 && lg[e] > l1) { l1 = lg[e]; e1 = e; }
                    int p0 = 0, p1 = 0;
                    if (lane == 0) {
                        const float w0 = 1.f / (1.f + __expf(l1 - l0));
                        p0 = (int)atomicAdd(mcnt + 64 * e0, 1u); p1 = (int)atomicAdd(mcnt + 64 * e1, 1u);
                        WSP(int2, WS_TOKE)[r] = make_int2(e0, e1); WSP(int2, WS_TOKP)[r] = make_int2(p0, p1); WSP(float2, WS_TOKW)[r] = make_float2(w0, 1.f - w0);
                    }
                    p0 = __builtin_amdgcn_readfirstlane(p0); p1 = __builtin_amdgcn_readfirstlane(p1);
                    bf16_t* x0 = WSP(bf16_t, WS_XB) + ((size_t)e0 * TT + p0) * DM; bf16_t* x1 = WSP(bf16_t, WS_XB) + ((size_t)e1 * TT + p1) * DM;
#pragma unroll
                    for (int j = 0; j < 4; ++j) { uint2 o; o.x = cvtpk(v[j][0], v[j][1]); o.y = cvtpk(v[j][2], v[j][3]); *(uint2*)(x0 + 4 * lane + 256 * j) = o; *(uint2*)(x1 + 4 * lane + 256 * j) = o; }
                }
            }
            SEAM(pb + 5);
        }
#define MOE_TS() int ts0 = 0, ts1, ts2, ts3, ts4, ts5, ts6, ts7, ts8; { const unsigned* mcnt = WSP(unsigned, WS_CTL) + CW_MOE + 64 * 8 * (l >> 1); \
            ts1 = ts0 + (int)((__hip_atomic_load(mcnt + 64 * 0, __ATOMIC_RELAXED, __HIP_MEMORY_SCOPE_AGENT) + 255u) >> 8); ts2 = ts1 + (int)((__hip_atomic_load(mcnt + 64 * 1, __ATOMIC_RELAXED, __HIP_MEMORY_SCOPE_AGENT) + 255u) >> 8); \
            ts3 = ts2 + (int)((__hip_atomic_load(mcnt + 64 * 2, __ATOMIC_RELAXED, __HIP_MEMORY_SCOPE_AGENT) + 255u) >> 8); ts4 = ts3 + (int)((__hip_atomic_load(mcnt + 64 * 3, __ATOMIC_RELAXED, __HIP_MEMORY_SCOPE_AGENT) + 255u) >> 8); \
            ts5 = ts4 + (int)((__hip_atomic_load(mcnt + 64 * 4, __ATOMIC_RELAXED, __HIP_MEMORY_SCOPE_AGENT) + 255u) >> 8); ts6 = ts5 + (int)((__hip_atomic_load(mcnt + 64 * 5, __ATOMIC_RELAXED, __HIP_MEMORY_SCOPE_AGENT) + 255u) >> 8); \
            ts7 = ts6 + (int)((__hip_atomic_load(mcnt + 64 * 6, __ATOMIC_RELAXED, __HIP_MEMORY_SCOPE_AGENT) + 255u) >> 8); ts8 = ts7 + (int)((__hip_atomic_load(mcnt + 64 * 7, __ATOMIC_RELAXED, __HIP_MEMORY_SCOPE_AGENT) + 255u) >> 8); \
            ts1 = __builtin_amdgcn_readfirstlane(ts1); ts2 = __builtin_amdgcn_readfirstlane(ts2); ts3 = __builtin_amdgcn_readfirstlane(ts3); ts4 = __builtin_amdgcn_readfirstlane(ts4); \
            ts5 = __builtin_amdgcn_readfirstlane(ts5); ts6 = __builtin_amdgcn_readfirstlane(ts6); ts7 = __builtin_amdgcn_readfirstlane(ts7); ts8 = __builtin_amdgcn_readfirstlane(ts8); } (void)ts0; (void)ts8
        PHASE_REP(7) if (IN(pb + 7)) {
            PH_CTX();
            if (!moe) {
                pg8::StaticOrder S; S.init(WSP(bf16_t, WS_H), WSP(bf16_t, WS_FGU) + (size_t)(l >> 1) * 2 * DFF * DM, DM, nrows, 2 * DFF, G, bid);
                pg8::EpiSwiglu E{WSP(bf16_t, WS_ACT), DFF};
                pg8::gemm_phase<pg8::EpiSwiglu, pg8::StaticOrder>(lds, DM, S, E, tid);
            } else {
                MOE_TS();
                pg8::MoeOrder S; S.A = (const char*)WSP(bf16_t, WS_XB); S.Bt = (const char*)(WSP(bf16_t, WS_MGU) + (size_t)(l >> 1) * 8 * 2 * DEXP * DM); S.K = DM; S.N = 2 * DEXP; S.nN = 2 * DEXP / 256; S.ntile = ts8; S.G = G; S.c = bid;
                S.ts1 = ts1; S.ts2 = ts2; S.ts3 = ts3; S.ts4 = ts4; S.ts5 = ts5; S.ts6 = ts6; S.ts7 = ts7;
                pg8::EpiSwiglu E{WSP(bf16_t, WS_ACT), DEXP};
                pg8::gemm_phase<pg8::EpiSwiglu, pg8::MoeOrder>(lds, DM, S, E, tid);
            }
            SEAM(pb + 7);
        }
        PHASE_REP(8) if (IN(pb + 8)) {
            PH_CTX();
            if (!moe) {
                const float* modl = WSP(float, WS_MODS) + (size_t)(l * 2 + 0) * 6144;
                int tp, sp; pg8::tail_params(nrows / 256, 4, DFF / 64, G, tp, sp);
                pg8::TailOrder S; S.dense(WSP(bf16_t, WS_ACT), WSP(bf16_t, WS_FDN) + (size_t)(l >> 1) * DM * DFF, DFF, DM, nrows / 256, G, bid, tp, sp);
                pg8::EpiResid E{WSP(bf16_t, WS_Y), modl + 5 * 1024, modl + 6144 + 5 * 1024, WSP(float, WS_YP), nrows - tp * 256, tp * 256};
                pg8::gemm_phase<pg8::EpiResid, pg8::TailOrder>(lds, DFF, S, E, tid);
            } else {
                MOE_TS();
                int tp, sp; pg8::tail_params(ts8, 4, DEXP / 64, G, tp, sp);
                pg8::TailOrder S; S.dense(WSP(bf16_t, WS_ACT), WSP(bf16_t, WS_MDN) + (size_t)(l >> 1) * 8 * DM * DEXP, DEXP, DM, ts8, G, bid, tp, sp);
                S.ts1 = ts1; S.ts2 = ts2; S.ts3 = ts3; S.ts4 = ts4; S.ts5 = ts5; S.ts6 = ts6; S.ts7 = ts7;
                pg8::EpiRaw E{WSP(bf16_t, WS_YS), WSP(float, WS_YP), (ts8 - tp) * 256, tp * 256};
                pg8::gemm_phase<pg8::EpiRaw, pg8::TailOrder>(lds, DEXP, S, E, tid);
            }
            SEAM(pb + 8);
        }
        if (IN(pb + 9)) {
            PH_CTX();
            float* X = WSP(float, WS_X); bf16_t* H = WSP(bf16_t, WS_H); const bf16_t* Yb = WSP(bf16_t, WS_Y); const bf16_t* YS = WSP(bf16_t, WS_YS);
            const float* modl = WSP(float, WS_MODS) + (size_t)(l * 2 + 0) * 6144;
            const float* lw = ap->in[14] + (size_t)(l * 2 + 1) * DM; const float* lb = ap->in[15] + (size_t)(l * 2 + 1) * DM;
            int tp, sp, tail0; const float* YP = WSP(float, WS_YP);
            MOE_TS();
            if (!moe) { pg8::tail_params(nrows / 256, 4, DFF / 64, G, tp, sp); tail0 = nrows - tp * 256; }
            else { pg8::tail_params(ts8, 4, DEXP / 64, G, tp, sp); tail0 = (ts8 - tp) * 256; }
            for (int r = gw; r < nrows; r += NGW) {
                const int wch = r >= SEQ; const float* md = modl + wch * 6144;
                f32x4 v[4];
                if (!moe) {
                    if (r < tail0) {
#pragma unroll
                        for (int j = 0; j < 4; ++j) v[j] = *(const f32x4*)(X + (size_t)r * DM + 4 * lane + 256 * j) * ALPHA + ld4bf(Yb + (size_t)r * DM + 4 * lane + 256 * j);
                    } else {
#pragma unroll
                        for (int j = 0; j < 4; ++j) { const int c = 4 * lane + 256 * j; f32x4 a4 = (f32x4){0.f, 0.f, 0.f, 0.f};
                            for (int p = 0; p < sp; ++p) a4 = a4 + *(const f32x4*)(YP + ((size_t)p * tp * 256 + (r - tail0)) * DM + c);
                            v[j] = *(const f32x4*)(X + (size_t)r * DM + c) * ALPHA + *(const f32x4*)(md + 5 * 1024 + c) * a4; }
                    }
                } else {
                    const int2 ee = WSP(int2, WS_TOKE)[r], pp = WSP(int2, WS_TOKP)[r]; const float2 ww = WSP(float2, WS_TOKW)[r];
                    int2 ss;
                    ss.x = 256 * (ee.x == 0 ? ts0 : ee.x == 1 ? ts1 : ee.x == 2 ? ts2 : ee.x == 3 ? ts3 : ee.x == 4 ? ts4 : ee.x == 5 ? ts5 : ee.x == 6 ? ts6 : ts7) + pp.x;
                    ss.y = 256 * (ee.y == 0 ? ts0 : ee.y == 1 ? ts1 : ee.y == 2 ? ts2 : ee.y == 3 ? ts3 : ee.y == 4 ? ts4 : ee.y == 5 ? ts5 : ee.y == 6 ? ts6 : ts7) + pp.y;
#pragma unroll
                    for (int j = 0; j < 4; ++j) { const int c = 4 * lane + 256 * j;
                        f32x4 y0, y1;
                        if (ss.x < tail0) y0 = ld4bf(YS + (size_t)ss.x * DM + c);
                        else { y0 = (f32x4){0.f, 0.f, 0.f, 0.f}; for (int p = 0; p < sp; ++p) y0 = y0 + *(const f32x4*)(YP + ((size_t)p * tp * 256 + (ss.x - tail0)) * DM + c); }
                        if (ss.y < tail0) y1 = ld4bf(YS + (size_t)ss.y * DM + c);
                        else { y1 = (f32x4){0.f, 0.f, 0.f, 0.f}; for (int p = 0; p < sp; ++p) y1 = y1 + *(const f32x4*)(YP + ((size_t)p * tp * 256 + (ss.y - tail0)) * DM + c); }
                        const f32x4 xv = *(const f32x4*)(X + (size_t)r * DM + c), g5 = *(const f32x4*)(md + 5 * 1024 + c);
                        v[j] = xv * ALPHA + g5 * (y0 * ww.x + y1 * ww.y); }
                }
                ln16(v, lw, lb, lane);
                if (lastl) {
#pragma unroll
                    for (int j = 0; j < 4; ++j) *(f32x4*)(ap->out + (size_t)r * DM + 4 * lane + 256 * j) = v[j];
                } else {
#pragma unroll
                    for (int j = 0; j < 4; ++j) *(f32x4*)(X + (size_t)r * DM + 4 * lane + 256 * j) = v[j];
                    const float* mdn = modl + 2 * 6144 + wch * 6144;
                    mod_store(v, mdn, mdn + 1024, H + (size_t)r * DM, lane);
                }
            }
            SEAM(pb + 9);
        }
    }
#undef IN
#undef SEAM
}

extern "C" void kernel_launch(void* const* d_in, const int* in_sizes, int n_in, void* d_out, int out_size, void* d_ws, size_t ws_size, hipStream_t stream) {
    static int grid = 0;
    if (grid == 0) {
        if (n_in != 22 || ws_size < WS_END) { fprintf(stderr, "kernel_launch: unexpected n_in %d / ws %zu (need %zu)\n", n_in, ws_size, (size_t)WS_END); grid = -1; return; }
        int dev = 0, cus = 0;
        if (hipGetDevice(&dev) != hipSuccess || hipDeviceGetAttribute(&cus, hipDeviceAttributeMultiprocessorCount, dev) != hipSuccess) { grid = -1; return; }
        if (hipFuncSetAttribute((const void*)fwd, hipFuncAttributeMaxDynamicSharedMemorySize, LDS_BYTES) != hipSuccess) { fprintf(stderr, "kernel_launch: hipFuncSetAttribute failed\n"); grid = -1; return; }
        int per_cu = 0;
        if (hipOccupancyMaxActiveBlocksPerMultiprocessor(&per_cu, (const void*)fwd, 512, LDS_BYTES) != hipSuccess || per_cu < 1) fprintf(stderr, "kernel_launch: occupancy query reports %d\n", per_cu);
        (void)hipGetLastError();
        grid = cus;
    }
    if (grid < 0) return;
    (void)hipMemsetAsync((char*)d_ws + WS_CTL, 0, CTL_BYTES, stream);
    Args a{};
    for (int i = 0; i < 22; ++i) a.in[i] = (const float*)d_in[i];
    a.out = (float*)d_out; a.ws = (unsigned char*)d_ws;
#if MK_ONE_LAUNCH
    a.ph_lo = 0; a.ph_hi = NPH;
    hipLaunchKernelGGL(fwd, dim3(grid), dim3(512), LDS_BYTES, stream, a);
#else
    for (int p = 0; p < NPH; ++p) {
        if (p >= 2 && ((p - 2) % 10) == 6 && ((((p - 2) / 10) & 1) == 0)) continue;
        a.ph_lo = p; a.ph_hi = p + 1;
        hipLaunchKernelGGL(fwd, dim3(grid), dim3(512), LDS_BYTES, stream, a);
    }
#endif
}
```

```cpp
#include <hip/hip_runtime.h>
#include <cstdio>
#include <cstdint>

#ifndef MK_ONE_LAUNCH
#define MK_ONE_LAUNCH 1
#endif

#ifndef DUP_MASK
#define DUP_MASK 0
#endif
#define PHASE_REP(k) for (int rep_ = 0; rep_ < 1 + ((DUP_MASK >> (k)) & 1); ++rep_)
#define LAS __attribute__((address_space(3)))
#define GAS __attribute__((address_space(1)))
typedef unsigned short bf16_t;
typedef short bf16x8 __attribute__((ext_vector_type(8)));
typedef float f32x4 __attribute__((ext_vector_type(4)));
typedef unsigned u32x4 __attribute__((ext_vector_type(4)));

constexpr int DM = 1024, SEQ = 16384, NCTX = 256, TT = SEQ + NCTX, DEPTH = 4;
constexpr int IN_COLS = 2608, NPIN = 2816, LDP = 2816;
constexpr int C_MQ = 0, C_MK = 256, C_MV = 512, C_MO = 768, C_AQ = 1024, C_AK = 1536, C_AV = 1664, C_GQ = 1792, C_GK = 1920, C_GV = 2048, C_GG = 2304, C_MG = 2560, C_GGT = 2576, C_END = 2608;
constexpr int DFF = 2816, DEXP = 3584, NEXP = 8;
constexpr int NCH = 260;
constexpr int NSLOT = 138 * 256;
constexpr float ALPHA = 1.6817928305074290f;
constexpr float LN_EPS = 1e-5f;
constexpr int NPH = 2 + 10 * DEPTH;

constexpr size_t al256(size_t x) { return (x + 255) & ~size_t(255); }
constexpr size_t WS_CTL = 0, CTL_BYTES = 2u << 20;
constexpr size_t WS_MODS = 1u << 20;
constexpr size_t WS_ROPE = CTL_BYTES;
constexpr size_t WS_TOKE = WS_ROPE + 32768;
constexpr size_t WS_TOKP = WS_TOKE + al256((size_t)TT * 8);
constexpr size_t WS_TOKW = WS_TOKP + al256((size_t)TT * 8);
constexpr size_t WS_TOKS = WS_TOKW + al256((size_t)TT * 8);
constexpr size_t WS_WIN = WS_TOKS + al256((size_t)TT * 8);
constexpr size_t WS_WOUT = WS_WIN + (size_t)DEPTH * NPIN * DM * 2;
constexpr size_t WS_FGU = WS_WOUT + (size_t)DEPTH * DM * DM * 2;
constexpr size_t WS_FDN = WS_FGU + (size_t)2 * 2 * DFF * DM * 2;
constexpr size_t WS_MGU = WS_FDN + (size_t)2 * DM * DFF * 2;
constexpr size_t WS_MDN = WS_MGU + (size_t)16 * 2 * DEXP * DM * 2;
constexpr size_t WS_X = WS_MDN + (size_t)16 * DM * DEXP * 2;
constexpr size_t WS_H = WS_X + (size_t)TT * DM * 4;
constexpr size_t WS_P = WS_H + (size_t)TT * DM * 2;
constexpr size_t WS_G = WS_P + (size_t)TT * LDP * 2;
constexpr size_t WS_CAT = WS_G + al256((size_t)TT * 48 * 4);
constexpr size_t WS_Y = WS_CAT + (size_t)TT * DM * 2;
constexpr size_t WS_ACT = WS_Y + (size_t)TT * DM * 4;
constexpr size_t WS_XB = WS_ACT + (size_t)NSLOT * DEXP * 2;
constexpr size_t WS_YS = WS_XB + (size_t)NEXP * TT * DM * 2;
constexpr size_t WS_MU = WS_YS + (size_t)NSLOT * DM * 4;
constexpr size_t WS_MC = WS_MU + (size_t)8 * NCH * 4096 * 4;
constexpr size_t WS_MNU = WS_MC + (size_t)8 * NCH * 4096 * 4;
constexpr size_t WS_MNS = WS_MNU + (size_t)8 * NCH * 64 * 4;
constexpr size_t WS_MSC = WS_MNS + (size_t)8 * NCH * 64 * 4;
constexpr size_t WS_GU = WS_MSC + al256((size_t)8 * NCH * 4 * 4);
constexpr size_t WS_GS = WS_GU + (size_t)8 * NCH * 2048 * 4;
constexpr size_t WS_GDEC = WS_GS + (size_t)8 * NCH * 2048 * 4;
constexpr size_t WS_YP = WS_GDEC + (size_t)8 * NCH * 32 * 4;
constexpr size_t WS_END = WS_YP + (size_t)256 * 256 * 256 * 4;

constexpr int CW_BAR = 4096;
constexpr int CW_MOE = 16384;

constexpr int LDS_BYTES = 147456, MISC_OFF = 147200;

__device__ __forceinline__ float bf2f(unsigned v) { return __uint_as_float(v << 16); }
__device__ __forceinline__ unsigned f2bf(float f) { unsigned u = __float_as_uint(f); return (u + 0x7fffu + ((u >> 16) & 1u)) >> 16; }
__device__ __forceinline__ unsigned pk2(float lo, float hi) { return f2bf(lo) | (f2bf(hi) << 16); }
__device__ __forceinline__ void load8bf(const bf16_t* p, float* o) {
    const uint4 v = *(const uint4*)p;
    o[0] = __uint_as_float(v.x << 16); o[1] = __uint_as_float(v.x & 0xffff0000u); o[2] = __uint_as_float(v.y << 16); o[3] = __uint_as_float(v.y & 0xffff0000u);
    o[4] = __uint_as_float(v.z << 16); o[5] = __uint_as_float(v.z & 0xffff0000u); o[6] = __uint_as_float(v.w << 16); o[7] = __uint_as_float(v.w & 0xffff0000u);
}
__device__ __forceinline__ float wave_sum(float v) {
#pragma unroll
    for (int o = 1; o < 64; o <<= 1) v += __shfl_xor(v, o);
    return v;
}
__device__ __forceinline__ float wave_max(float v) {
#pragma unroll
    for (int o = 1; o < 64; o <<= 1) v = fmaxf(v, __shfl_xor(v, o));
    return v;
}
__device__ __forceinline__ float scan_add(float v, int lane) {
#pragma unroll
    for (int o = 1; o < 64; o <<= 1) { const float t = __shfl_up(v, o); if (lane >= o) v += t; }
    return v;
}
__device__ __forceinline__ float scan_max(float v, int lane) {
#pragma unroll
    for (int o = 1; o < 64; o <<= 1) { const float t = __shfl_up(v, o); if (lane >= o) v = fmaxf(v, t); }
    return v;
}
__device__ __forceinline__ float siluf(float x) { return x * __builtin_amdgcn_rcpf(1.f + __expf(-x)); }
__device__ __forceinline__ float sigmoidf_(float x) { return __builtin_amdgcn_rcpf(1.f + __expf(-x)); }
__device__ __forceinline__ float log_sigmoidf_(float x) {
    const float t = __expf(-fabsf(x)); const float l1p = (t < 0.01f) ? t * (1.f + t * (-0.5f + t * 0.33333333f)) : __logf(1.f + t); return fminf(x, 0.f) - l1p; }
typedef short s16x4 __attribute__((ext_vector_type(4)));
typedef short v4i16_t __attribute__((ext_vector_type(4)));
typedef float f32x2_t __attribute__((ext_vector_type(2))); typedef __bf16 bf16x2_t __attribute__((ext_vector_type(2)));
__device__ __forceinline__ unsigned cvtpk(float lo, float hi) { f32x2_t v = {lo, hi}; bf16x2_t b = __builtin_convertvector(v, bf16x2_t); return __builtin_bit_cast(unsigned, b); }
__device__ __forceinline__ s16x4 ds_tr16(const LAS unsigned char* p) { return __builtin_bit_cast(s16x4, __builtin_amdgcn_ds_read_tr16_b64_v4i16((LAS v4i16_t*)p)); }
__device__ __forceinline__ bf16x8 cat44(s16x4 a, s16x4 b) { return __builtin_shufflevector(a, b, 0, 1, 2, 3, 4, 5, 6, 7); }
#define MFMA16(a, b, c) __builtin_amdgcn_mfma_f32_16x16x32_bf16(a, b, c, 0, 0, 0)
__device__ __forceinline__ float grp_max(float v) {
    const auto a = __builtin_amdgcn_permlane16_swap(__float_as_uint(v), __float_as_uint(v), false, false); v = fmaxf(__uint_as_float(a[0]), __uint_as_float(a[1]));
    const auto b = __builtin_amdgcn_permlane32_swap(__float_as_uint(v), __float_as_uint(v), false, false); return fmaxf(__uint_as_float(b[0]), __uint_as_float(b[1])); }
__device__ __forceinline__ float grp_sum(float v) {
    const auto a = __builtin_amdgcn_permlane16_swap(__float_as_uint(v), __float_as_uint(v), false, false); v = __uint_as_float(a[0]) + __uint_as_float(a[1]);
    const auto b = __builtin_amdgcn_permlane32_swap(__float_as_uint(v), __float_as_uint(v), false, false); return __uint_as_float(b[0]) + __uint_as_float(b[1]); }
#define LDS_WAIT() asm volatile("s_waitcnt lgkmcnt(0)" ::: "memory")

namespace pg8 {
constexpr int BM = 256, BK = 64, HALF = 128, HTB = HALF * BK * 2, STAGE_BYTES = 8 * HTB, NXCD = 8, WGM = 8;
__host__ __device__ __forceinline__ int lds_byte(int r, int c) { const int st = (r >> 4) * 2 + (c >> 5), rr = r & 15, cc = c & 31, ob = rr * 64 + cc * 2; return st * 1024 + (ob ^ (((ob >> 9) & 1) << 5)); }
__host__ __device__ __forceinline__ void stage_rc(int b, int& R, int& C) { const int st = b / 1024, sb = b % 1024, swz = sb ^ (((sb >> 9) & 1) << 5); R = (st >> 1) * 16 + swz / 64; C = (st & 1) * 32 + (swz % 64) / 2; }
__host__ __device__ __forceinline__ int perm32(int rho) { const int n = rho >> 4, i = rho & 15; return 8 * (i >> 2) + 4 * n + (i & 3); }
struct Unit { int pm, pn, kt0, nkt, part; };

struct StaticOrder {
    const char* A; const char* Bt; int K;
    int nM, nN, nwg, G, c;
    __device__ void init(const void* A_, const void* Bt_, int K_, int M, int N, int G_, int c_) { A = (const char*)A_; Bt = (const char*)Bt_; K = K_; nM = M / BM; nN = N / BM; nwg = nM * nN; G = G_; c = c_; }
    __device__ __forceinline__ bool next(int i, Unit& u) const {
        const long L = (long)i * G + c; if (L >= nwg) return false;
        int wgid = (int)L; { const int q = nwg / NXCD, r = nwg % NXCD, xcd = wgid % NXCD, off = wgid / NXCD; wgid = (xcd < r ? xcd * (q + 1) : r * (q + 1) + (xcd - r) * q) + off; }
        const int nig = WGM * nN, gid = wgid / nig, fm = gid * WGM, gsz = (nM - fm) < WGM ? (nM - fm) : WGM;
        u.pm = fm + ((wgid % nig) % gsz); u.pn = (wgid % nig) / gsz; u.kt0 = 0; u.nkt = K / BK; u.part = -1; return true;
    }
    __device__ __forceinline__ const char* aptr(const Unit& u) const { return A + (size_t)u.pm * BM * K * 2; }
    __device__ __forceinline__ const char* bptr(const Unit& u) const { return Bt + (size_t)u.pn * BM * K * 2; }
};
struct MoeOrder {
    const char* A; const char* Bt; int K, N, nN, ntile, G, c;
    int ts1, ts2, ts3, ts4, ts5, ts6, ts7;
    __device__ __forceinline__ bool next(int i, Unit& u) const {
        const long L = (long)i * G + c; if (L >= (long)ntile * nN) return false;
        u.pm = (int)(L / nN); u.pn = (int)(L % nN); u.kt0 = 0; u.nkt = K / BK; u.part = -1; return true;
    }
    __device__ __forceinline__ int expert(int pm) const { return (pm >= ts1) + (pm >= ts2) + (pm >= ts3) + (pm >= ts4) + (pm >= ts5) + (pm >= ts6) + (pm >= ts7); }
    __device__ __forceinline__ const char* aptr(const Unit& u) const {
        const int e = expert(u.pm); const int t0 = e == 0 ? 0 : e == 1 ? ts1 : e == 2 ? ts2 : e == 3 ? ts3 : e == 4 ? ts4 : e == 5 ? ts5 : e == 6 ? ts6 : ts7;
        return A + ((size_t)e * TT + (size_t)(u.pm - t0) * BM) * K * 2; }
    __device__ __forceinline__ const char* bptr(const Unit& u) const { return Bt + ((size_t)expert(u.pm) * N + (size_t)u.pn * BM) * K * 2; }
};

struct TailOrder {
    const char* A; const char* Bt; int K, N, nN, npan, G, c, tp, s;
    int ts1, ts2, ts3, ts4, ts5, ts6, ts7;
    __device__ __forceinline__ void dense(const void* A_, const void* Bt_, int K_, int N_, int npan_, int G_, int c_, int tp_, int s_) {
        A = (const char*)A_; Bt = (const char*)Bt_; K = K_; N = N_; nN = N_ / BM; npan = npan_; G = G_; c = c_; tp = tp_; s = s_;
        ts1 = ts2 = ts3 = ts4 = ts5 = ts6 = ts7 = 0x7fffffff; }
    __device__ __forceinline__ bool next(int i, Unit& u) const {
        const int L = i * G + c, nfull = (npan - tp) * nN, ksub = (K / BK) / s;
        const bool tail = L >= nfull; const int j = L - nfull, tu = tp * nN, tu1 = tu > 0 ? tu : 1;
        const int part = tail ? j / tu1 : -1, r = tail ? j % tu1 : 0;
        u.part = part; u.pm = tail ? (npan - tp) + r / nN : L / nN; u.pn = tail ? r % nN : L % nN; u.kt0 = tail ? part * ksub : 0; u.nkt = tail ? ksub : K / BK;
        return tail ? (j < tu * s) : true;
    }
    __device__ __forceinline__ int expert(int pm) const { return (pm >= ts1) + (pm >= ts2) + (pm >= ts3) + (pm >= ts4) + (pm >= ts5) + (pm >= ts6) + (pm >= ts7); }
    __device__ __forceinline__ const char* aptr(const Unit& u) const { return A + ((size_t)u.pm * BM * K + (size_t)u.kt0 * BK) * 2; }
    __device__ __forceinline__ const char* bptr(const Unit& u) const { return Bt + (((size_t)expert(u.pm) * N + (size_t)u.pn * BM) * K + (size_t)u.kt0 * BK) * 2; }
};
__device__ __forceinline__ void tail_params(int npan, int nN, int nkt, int G, int& tp, int& s) {
    const int rem = (npan * nN) % G;
    tp = 0; s = 1;
    if (rem == 0 || (rem % nN) != 0) return;
    int best = 1;
    if (nkt == 16) { if (rem * 4 <= G) best = 4; else if (rem * 2 <= G) best = 2; }
    else if (nkt == 44) { if (rem * 11 <= G) best = 11; else if (rem * 2 <= G) best = 2; }
    else if (nkt == 56) { if (rem * 14 <= G) best = 14; else if (rem * 7 <= G) best = 7; else if (rem * 4 <= G) best = 4; else if (rem * 2 <= G) best = 2; }
    if (best > 1) { tp = rem / nN; s = best; }
}

template <class Epi, class Sched>
__device__ __forceinline__ void gemm_phase(LAS unsigned char* lds, const int K, const Sched& S, const Epi& E, const int tid) {
    const int wid = __builtin_amdgcn_readfirstlane(tid >> 6), lane = tid & 63, wr = wid >> 2, wc = wid & 3, fr = lane & 15, fq = lane >> 4;
    unsigned voffA[2], voffB[2];
#pragma unroll
    for (int i = 0; i < 2; ++i) { int R, C; stage_rc(tid * 16 + i * 8192, R, C); const int Rb = Epi::PERM ? ((R & ~31) + perm32(R & 31)) : R;
        voffA[i] = (unsigned)(R * K + C) * 2u; voffB[i] = (unsigned)(Rb * K + C) * 2u; }
    const size_t kstep = (size_t)(BK * 2);
    const size_t hstep = (size_t)HALF * K * 2;
    const unsigned ldsw = (unsigned)wid * 1024u;
    const int aoff = lds_byte(wr * 64 + fr, fq * 8), boff = lds_byte(wc * 32 + fr, fq * 8);
#define PG8_SA(b, h) (((b) * 2 + (h)) * HTB)
#define PG8_SB(b, h) ((4 + (b) * 2 + (h)) * HTB)
#define PG8_STAGE(bufoff, gbase, voff) do { _Pragma("unroll") for (int _i = 0; _i < 2; ++_i) \
        __builtin_amdgcn_global_load_lds((const GAS unsigned*)((const GAS char*)(gbase) + (voff)[_i]), (LAS unsigned*)(lds + (bufoff) + ldsw + _i * 8192), 16, 0, 0); } while (0)
#define PG8_LDA(dst, b, h) do { _Pragma("unroll") for (int m = 0; m < 4; ++m) _Pragma("unroll") for (int k = 0; k < 2; ++k) dst[m][k] = *(const LAS bf16x8*)(lds + PG8_SA(b, h) + aoff + m * 2048 + k * 1024); } while (0)
#define PG8_LDB(dst, b, h) do { _Pragma("unroll") for (int n = 0; n < 2; ++n) _Pragma("unroll") for (int k = 0; k < 2; ++k) dst[n][k] = *(const LAS bf16x8*)(lds + PG8_SB(b, h) + boff + n * 2048 + k * 1024); } while (0)
#define PG8_MMA(ai, bj, At, Bt) do { __builtin_amdgcn_s_setprio(1); _Pragma("unroll") for (int m = 0; m < 4; ++m) _Pragma("unroll") for (int n = 0; n < 2; ++n) _Pragma("unroll") for (int k = 0; k < 2; ++k) \
        acc[ai][bj][m][n] = __builtin_amdgcn_mfma_f32_16x16x32_bf16(Bt[n][k], At[m][k], acc[ai][bj][m][n], 0, 0, 0); __builtin_amdgcn_s_setprio(0); } while (0)
#define PG8_WAIT_V(n) asm volatile("s_waitcnt vmcnt(" #n ")" ::: "memory")
#define PG8_WAIT_L(n) asm volatile("s_waitcnt lgkmcnt(" #n ")" ::: "memory")
#define PG8_BAR __builtin_amdgcn_s_barrier()
#define PG8_SCHED __builtin_amdgcn_sched_barrier(0)
    Unit cur, nxt; int ui = 0;
    if (!S.next(0, cur)) return;
    f32x4 acc[2][2][4][2];
#pragma unroll
    for (int a = 0; a < 2; ++a)
#pragma unroll
        for (int b = 0; b < 2; ++b)
#pragma unroll
            for (int m = 0; m < 4; ++m)
#pragma unroll
                for (int n = 0; n < 2; ++n) acc[a][b][m][n] = (f32x4){0.f, 0.f, 0.f, 0.f};
    bf16x8 At[4][2], B0[2][2], B1[2][2];
    const char* cA = S.aptr(cur); const char* cB = S.bptr(cur);
    PG8_STAGE(PG8_SB(0, 0), cB, voffB); PG8_STAGE(PG8_SB(0, 1), cB + hstep, voffB); PG8_STAGE(PG8_SA(0, 0), cA, voffA); PG8_STAGE(PG8_SA(0, 1), cA + hstep, voffA);
    if (wr == 1) PG8_BAR;
    PG8_WAIT_V(2); PG8_BAR;
    PG8_STAGE(PG8_SB(1, 0), cB + kstep, voffB); PG8_STAGE(PG8_SA(1, 0), cA + kstep, voffA); PG8_STAGE(PG8_SB(1, 1), cB + hstep + kstep, voffB);
    PG8_WAIT_V(6); PG8_BAR;
    for (;;) {
        const bool has_next = S.next(ui + 1, nxt);
        const char* nA = has_next ? S.aptr(nxt) : cA; const char* nB = has_next ? S.bptr(nxt) : cB;
        const int nt = cur.nkt;
        for (int t = 0; t < nt; t += 2) {
            const bool last = (t == nt - 2);
            const char* a1 = cA + (size_t)(t + 1) * kstep;
            const char* a2 = last ? nA : cA + (size_t)(t + 2) * kstep; const char* b2 = last ? nB : cB + (size_t)(t + 2) * kstep;
            const char* a3 = a2 + kstep; const char* b3 = b2 + kstep;
            PG8_LDB(B0, 0, 0); PG8_LDB(B1, 0, 1); PG8_SCHED; PG8_LDA(At, 0, 0); PG8_STAGE(PG8_SA(1, 1), a1 + hstep, voffA);
            PG8_WAIT_V(8); PG8_WAIT_L(0); PG8_BAR; PG8_MMA(0, 0, At, B0); PG8_MMA(0, 1, At, B1); PG8_BAR; PG8_SCHED;
            PG8_LDA(At, 0, 1); PG8_STAGE(PG8_SB(0, 0), b2, voffB); PG8_STAGE(PG8_SB(0, 1), b2 + hstep, voffB); PG8_STAGE(PG8_SA(0, 0), a2, voffA);
            PG8_WAIT_V(8); PG8_WAIT_L(0); PG8_BAR; PG8_MMA(1, 0, At, B0); PG8_MMA(1, 1, At, B1); PG8_BAR; PG8_SCHED;
            PG8_LDB(B0, 1, 0); PG8_LDB(B1, 1, 1); PG8_SCHED; PG8_LDA(At, 1, 0); PG8_STAGE(PG8_SA(0, 1), a2 + hstep, voffA);
            PG8_WAIT_V(8); PG8_WAIT_L(0); PG8_BAR; PG8_MMA(0, 0, At, B0); PG8_MMA(0, 1, At, B1); PG8_BAR; PG8_SCHED;
            PG8_LDA(At, 1, 1); PG8_STAGE(PG8_SB(1, 0), b3, voffB); PG8_STAGE(PG8_SB(1, 1), b3 + hstep, voffB); PG8_STAGE(PG8_SA(1, 0), a3, voffA);
            PG8_WAIT_V(8); PG8_WAIT_L(0); PG8_BAR; PG8_MMA(1, 0, At, B0); PG8_MMA(1, 1, At, B1); PG8_BAR; PG8_SCHED;
        }
        if (wr == 0) PG8_BAR;
        { int fr_ = fr, fq_ = fq; asm volatile("" : "+v"(fr_), "+v"(fq_));
          E(acc, cur, wr, wc, fr_, fq_); }
        if (!has_next) break;
#pragma unroll
        for (int a = 0; a < 2; ++a)
#pragma unroll
            for (int b = 0; b < 2; ++b)
#pragma unroll
                for (int m = 0; m < 4; ++m)
#pragma unroll
                    for (int n = 0; n < 2; ++n) acc[a][b][m][n] = (f32x4){0.f, 0.f, 0.f, 0.f};
        cur = nxt; cA = nA; cB = nB; ++ui;
        if (wr == 1) PG8_BAR;
    }
    PG8_WAIT_V(0);
    PG8_BAR;
#undef PG8_SA
#undef PG8_SB
#undef PG8_STAGE
#undef PG8_LDA
#undef PG8_LDB
#undef PG8_MMA
#undef PG8_WAIT_V
#undef PG8_WAIT_L
#undef PG8_BAR
#undef PG8_SCHED
}


struct EpiInProj {
    static constexpr bool PERM = true;
    bf16_t* P; float* Gt; const float* ropeC; const float* ropeS;
    __device__ __forceinline__ void operator()(const f32x4 (&acc)[2][2][4][2], const Unit& u, int wr, int wc, int fr, int fq) const {
        const int row0 = u.pm * BM + wr * 64 + fr;
        const bool latent = u.pm < (SEQ / BM);
#pragma unroll
        for (int bj = 0; bj < 2; ++bj) {
            const int colg = u.pn * BM + bj * HALF + wc * 32;
            const bool rope = latent && colg >= C_AQ && colg < C_AV;
            const bool gate = colg >= C_MG && colg < C_END;
            const int col0 = colg + 8 * fq;
#pragma unroll
            for (int ai = 0; ai < 2; ++ai)
#pragma unroll
                for (int m = 0; m < 4; ++m) {
                    const int row = row0 + ai * HALF + m * 16;
                    f32x4 v0 = acc[ai][bj][m][0], v1 = acc[ai][bj][m][1];
                    if (rope) {
                        const int pos = ((colg >> 5) & 1) ? (row & 63) : (row >> 6);
                        const f32x4 c0 = *(const f32x4*)(ropeC + pos * 16 + 8 * (fq & 1)), c1 = *(const f32x4*)(ropeC + pos * 16 + 8 * (fq & 1) + 4);
                        const f32x4 s0 = *(const f32x4*)(ropeS + pos * 16 + 8 * (fq & 1)), s1 = *(const f32x4*)(ropeS + pos * 16 + 8 * (fq & 1) + 4);
                        const float sg = (fq < 2) ? -1.f : 1.f;
                        f32x4 p0, p1;
#pragma unroll
                        for (int i = 0; i < 4; ++i) { p0[i] = __shfl_xor(v0[i], 32); p1[i] = __shfl_xor(v1[i], 32); }
#pragma unroll
                        for (int i = 0; i < 4; ++i) { v0[i] = v0[i] * c0[i] + sg * p0[i] * s0[i]; v1[i] = v1[i] * c1[i] + sg * p1[i] * s1[i]; }
                    }
                    u32x4 w; w.x = cvtpk(v0[0], v0[1]); w.y = cvtpk(v0[2], v0[3]); w.z = cvtpk(v1[0], v1[1]); w.w = cvtpk(v1[2], v1[3]);
                    *(u32x4*)(P + (size_t)row * LDP + col0) = w;
                    if (gate && col0 < C_END) { float* g = Gt + (size_t)row * 48 + (col0 - C_MG); *(f32x4*)g = v0; *(f32x4*)(g + 4) = v1; }
                    asm volatile("" ::: "memory");
                }
        }
    }
};
struct EpiResid {
    static constexpr bool PERM = true;
    bf16_t* Yb; const float* modl; const float* modc; float* YP; int tail_row0, tail_rows;
    __device__ __forceinline__ void operator()(const f32x4 (&acc)[2][2][4][2], const Unit& u, int wr, int wc, int fr, int fq) const {
        const int row0 = u.pm * BM + wr * 64 + fr, col0 = u.pn * BM + wc * 32 + 8 * fq;
        if (u.part >= 0) {
#pragma unroll
            for (int ai = 0; ai < 2; ++ai)
#pragma unroll
                for (int m = 0; m < 4; ++m) { float* rowp = YP + ((size_t)u.part * tail_rows + (row0 + ai * HALF + m * 16 - tail_row0)) * DM + col0;
#pragma unroll
                    for (int bj = 0; bj < 2; ++bj)
#pragma unroll
                        for (int n = 0; n < 2; ++n) *(f32x4*)(rowp + bj * HALF + n * 4) = acc[ai][bj][m][n]; }
            return;
        }
        const float* md = (u.pm < SEQ / BM) ? modl : modc;
        f32x4 mv[2][2];
#pragma unroll
        for (int bj = 0; bj < 2; ++bj)
#pragma unroll
            for (int n = 0; n < 2; ++n) mv[bj][n] = *(const f32x4*)(md + col0 + bj * HALF + n * 4);
#pragma unroll
        for (int ai = 0; ai < 2; ++ai)
#pragma unroll
            for (int m = 0; m < 4; ++m) { bf16_t* rowp = Yb + (size_t)(row0 + ai * HALF + m * 16) * DM + col0;
#pragma unroll
                for (int bj = 0; bj < 2; ++bj) { const f32x4 v0 = mv[bj][0] * acc[ai][bj][m][0], v1 = mv[bj][1] * acc[ai][bj][m][1];
                    u32x4 w; w.x = cvtpk(v0[0], v0[1]); w.y = cvtpk(v0[2], v0[3]); w.z = cvtpk(v1[0], v1[1]); w.w = cvtpk(v1[2], v1[3]);
                    *(u32x4*)(rowp + bj * HALF) = w; } }
    }
};
struct EpiSwiglu {
    static constexpr bool PERM = true;
    bf16_t* O; int ld;
    __device__ __forceinline__ void operator()(const f32x4 (&acc)[2][2][4][2], const Unit& u, int wr, int wc, int fr, int fq) const {
        const int row0 = u.pm * BM + wr * 64 + fr, col0 = u.pn * HALF + wc * 32 + 8 * fq;
#pragma unroll
        for (int ai = 0; ai < 2; ++ai)
#pragma unroll
            for (int m = 0; m < 4; ++m) {
                const f32x4 g0 = acc[ai][0][m][0], g1 = acc[ai][0][m][1], u0 = acc[ai][1][m][0], u1 = acc[ai][1][m][1];
                float r[8];
#pragma unroll
                for (int i = 0; i < 4; ++i) { r[i] = siluf(g0[i]) * u0[i]; r[4 + i] = siluf(g1[i]) * u1[i]; }
                u32x4 w; w.x = cvtpk(r[0], r[1]); w.y = cvtpk(r[2], r[3]); w.z = cvtpk(r[4], r[5]); w.w = cvtpk(r[6], r[7]);
                *(u32x4*)(O + (size_t)(row0 + ai * HALF + m * 16) * ld + col0) = w;
            }
    }
};
struct EpiRaw {
    static constexpr bool PERM = true;
    bf16_t* C; float* YP; int tail_row0, tail_rows;
    __device__ __forceinline__ void operator()(const f32x4 (&acc)[2][2][4][2], const Unit& u, int wr, int wc, int fr, int fq) const {
        const int row0 = u.pm * BM + wr * 64 + fr, col0 = u.pn * BM + wc * 32 + 8 * fq;
        if (u.part >= 0) {
#pragma unroll
            for (int ai = 0; ai < 2; ++ai)
#pragma unroll
                for (int m = 0; m < 4; ++m) { float* rowp = YP + ((size_t)u.part * tail_rows + (row0 + ai * HALF + m * 16 - tail_row0)) * DM + col0;
#pragma unroll
                    for (int bj = 0; bj < 2; ++bj)
#pragma unroll
                        for (int n = 0; n < 2; ++n) *(f32x4*)(rowp + bj * HALF + n * 4) = acc[ai][bj][m][n]; }
            return;
        }
#pragma unroll
        for (int ai = 0; ai < 2; ++ai)
#pragma unroll
            for (int m = 0; m < 4; ++m) { bf16_t* rowp = C + (size_t)(row0 + ai * HALF + m * 16) * DM + col0;
#pragma unroll
                for (int bj = 0; bj < 2; ++bj) { const f32x4 v0 = acc[ai][bj][m][0], v1 = acc[ai][bj][m][1];
                    u32x4 w; w.x = cvtpk(v0[0], v0[1]); w.y = cvtpk(v0[2], v0[3]); w.z = cvtpk(v1[0], v1[1]); w.w = cvtpk(v1[2], v1[3]);
                    *(u32x4*)(rowp + bj * HALF) = w; } }
    }
};
}

#define XB_TMO      128
#define XB_XCNT(j)  (256  + 64 * (j))
#define XB_XSUB(j)  (1280 + 64 * (j))
#define XB_XGEN(j)  (2304 + 64 * (j))
#define XB_TOP      3328
#define XB_TOPGEN   3392
#define XCD_BAR_WORDS 3456
#define XB_SPIN_CAP (1u << 18)
__device__ __forceinline__ unsigned xb_ld(unsigned* p)              { return __hip_atomic_load(p, __ATOMIC_RELAXED, __HIP_MEMORY_SCOPE_AGENT); }
__device__ __forceinline__ unsigned xb_add(unsigned* p, unsigned v) { return __hip_atomic_fetch_add(p, v, __ATOMIC_RELAXED, __HIP_MEMORY_SCOPE_AGENT); }
__device__ __forceinline__ unsigned xb_xcc_id() { return (unsigned)__builtin_amdgcn_s_getreg((3 << 11) | 20) & 0xFu; }
#define XB_SPIN(cond, bar) do { unsigned _sp = 0; while (cond) { __builtin_amdgcn_s_sleep(1); \
    if ((++_sp & 255u) == 0u) { if (xb_ld(&(bar)[XB_TMO])) break; if (_sp > XB_SPIN_CAP) { atomicAdd(&(bar)[XB_TMO], 1u); break; } } } } while (0)
struct XcdBarrier { unsigned* bar; unsigned x; volatile LAS unsigned* st; };
__device__ __forceinline__ XcdBarrier xcd_barrier_post(unsigned* bar, volatile LAS unsigned* st) {
    XcdBarrier b; b.bar = bar; b.x = xb_xcc_id(); b.st = st;
    if (threadIdx.x == 0) (void)xb_add(&bar[XB_XCNT(b.x)], 1u);
    return b;
}
__device__ __forceinline__ void xcd_barrier_complete(unsigned* bar, unsigned x, unsigned& nloc, unsigned& nx) {
    const unsigned G = gridDim.x * gridDim.y * gridDim.z;
    unsigned sum, cnt, mine, sp = 0u;
    for (;;) {
        sum = 0u; cnt = 0u; mine = 0u;
#pragma unroll
        for (unsigned j = 0; j < 16; ++j) { const unsigned c = xb_ld(&bar[XB_XCNT(j)]); sum += c; cnt += (c > 0u) ? 1u : 0u; mine = (j == x) ? c : mine; }
        if (sum == G) break;
        __builtin_amdgcn_s_sleep(1);
        if ((++sp & 255u) == 0u) { if (xb_ld(&bar[XB_TMO])) break; if (sp > XB_SPIN_CAP) { atomicAdd(&bar[XB_TMO], 1u); break; } }
    }
    nloc = mine > 0u ? mine : 1u; nx = cnt > 0u ? cnt : 1u;
}
__device__ __forceinline__ void xcd_barrier(const XcdBarrier& b) {
    asm volatile("s_waitcnt vmcnt(0)" ::: "memory");
    __syncthreads();
    if (threadIdx.x == 0) {
        unsigned* bar = b.bar;
        __builtin_amdgcn_s_waitcnt(0);
        unsigned nloc = b.st[0], nx = b.st[1];
        if (nloc == 0u) { xcd_barrier_complete(bar, b.x, nloc, nx); b.st[0] = nloc; b.st[1] = nx; }
        const unsigned old = xb_add(&bar[XB_XSUB(b.x)], 1u);
        const unsigned gen = old / nloc;
        if (old + 1u == (gen + 1u) * nloc) {
            __builtin_amdgcn_fence(__ATOMIC_RELEASE, "agent");
            asm volatile("s_waitcnt vmcnt(0)" ::: "memory");
            const unsigned og = xb_add(&bar[XB_TOP], 1u);
            const unsigned tg = og / nx;
            if (og + 1u == (tg + 1u) * nx) xb_add(&bar[XB_TOPGEN], 1u);
            else XB_SPIN(xb_ld(&bar[XB_TOPGEN]) == tg, bar);
            __builtin_amdgcn_fence(__ATOMIC_ACQUIRE, "agent");
            xb_add(&bar[XB_XGEN(b.x)], 1u);
            asm volatile("s_waitcnt vmcnt(0)" ::: "memory");
        } else {
            XB_SPIN(xb_ld(&bar[XB_XGEN(b.x)]) == gen, bar);
            __builtin_amdgcn_fence(__ATOMIC_ACQUIRE, "agent");
            asm volatile("s_waitcnt vmcnt(0)" ::: "memory");
        }
    }
    __syncthreads();
}

struct Args { const float* in[22]; float* out; unsigned char* ws; int ph_lo, ph_hi; };

__device__ __forceinline__ int in_srccol(int r, float& sc) {
    sc = 1.f;
    if (r < 1024) { if (r >= C_MK && r < C_MV) sc = 0.125f; return r; }
    if (r < C_MG) { if (r < C_AK) sc = 0.125f * 1.4426950408889634f; else if (r >= C_GQ && r < C_GK) sc = 0.17677669529663687f; return r + 16; }
    if (r < C_GGT) return r - C_MG + 1024;
    if (r < C_END) return r;
    return -1;
}
__device__ __forceinline__ void tr_item(const float* W, int K, int N, int NP, bf16_t* WT, int mode, int half, LAS float* scr, int item, int lane) {
    const int nblk = NP >> 6, kb = item / nblk, nb = item - kb * nblk, k0 = kb << 6, n0 = nb << 6;
    const int r = n0 + lane; float sc = 1.f; int src;
    if (mode == 0) src = r; else if (mode == 1) src = in_srccol(r, sc); else { const int pn = r >> 8, w = r & 255; src = (w < 128) ? (pn * 128 + w) : (half + pn * 128 + w - 128); }
    const float* wp = W + (size_t)k0 * N + (src < 0 ? 0 : src);
#pragma unroll 16
    for (int i = 0; i < 64; ++i) { const float v = wp[(size_t)i * N]; scr[i * 65 + lane] = (src < 0) ? 0.f : v * sc; }
    LDS_WAIT();
    const int c = lane & 7;
#pragma unroll
    for (int j = 0; j < 8; ++j) { const int n = (lane >> 3) + 8 * j; const LAS float* s = scr + (8 * c) * 65 + n;
        uint4 o; o.x = pk2(s[0], s[65]); o.y = pk2(s[130], s[195]); o.z = pk2(s[260], s[325]); o.w = pk2(s[390], s[455]);
        *(uint4*)(WT + (size_t)(n0 + n) * K + k0 + 8 * c) = o; }
    LDS_WAIT();
}

__device__ __forceinline__ void chunk_rows(int d, int jc, int& base, int& step) {
    int oc;
    if (d == 0) oc = (jc < 4) ? 256 + jc : jc - 4; else oc = (jc < 4) ? 256 + (3 - jc) : 255 - (jc - 4);
    const int b0 = (oc < 256) ? oc * 64 : SEQ + (oc - 256) * 64;
    if (d == 0) { base = b0; step = 1; } else { base = b0 + 63; step = -1; }
}
__device__ __forceinline__ int oc_to_jc(int d, int oc) { if (d == 0) return oc < 256 ? oc + 4 : oc - 256; return oc < 256 ? 4 + (255 - oc) : 3 - (oc - 256); }

constexpr int AT_RS = 144, AT_TILE = 128 * AT_RS;
__device__ __forceinline__ void attn_unit(LAS unsigned char* lds, const bf16_t* P, bf16_t* CAT, int qb  , int cqb, int kvh, const float* sink, int tid, int lane, int wave) {
    const bool is_ctx = qb < 0;
    const int g = lane >> 4, i = lane & 15;
    const int hq = kvh * 4 + (wave >> 1), qh = wave & 1;
    const int qrow0 = (is_ctx ? SEQ + cqb * 128 : qb * 128) + qh * 64;
    bf16x8 bq[4][2];
#pragma unroll
    for (int qt = 0; qt < 4; ++qt)
#pragma unroll
        for (int ks = 0; ks < 2; ++ks) bq[qt][ks] = *(const bf16x8*)(P + (size_t)(qrow0 + 16 * qt + i) * LDP + C_AQ + hq * 64 + 32 * ks + 8 * g);
    f32x4 O[4][4];
#pragma unroll
    for (int dt = 0; dt < 4; ++dt)
#pragma unroll
        for (int qt = 0; qt < 4; ++qt) O[dt][qt] = (f32x4){0.f, 0.f, 0.f, 0.f};
    float m[4], l[4];
    { const float sk = sink[hq] * 1.4426950408889634f;
#pragma unroll
      for (int qt = 0; qt < 4; ++qt) { m[qt] = sk; l[qt] = (g == 0) ? 1.f : 0.f; } }
#define AT_VALID(c) ((c) >= 3 || (!is_ctx && (qb - 1 + (c)) >= 0 && (qb - 1 + (c)) < SEQ / 128))
#define AT_ROW(c) ((c) >= 3 ? SEQ + ((c) - 3) * 128 : (qb - 1 + (c)) * 128)
    u32x4 kreg[2], vreg[2];
    int c = 0; while (!AT_VALID(c)) ++c;
    __syncthreads();
#pragma unroll
    for (int t = 0; t < 2; ++t) { const int idx = tid + 512 * t, r = idx >> 3, ch = idx & 7; const bf16_t* src = P + (size_t)(AT_ROW(c) + r) * LDP + kvh * 64 + ch * 8;
        kreg[t] = *(const u32x4*)(src + C_AK); vreg[t] = *(const u32x4*)(src + C_AV); }
    int buf = 0;
#pragma unroll
    for (int t = 0; t < 2; ++t) { const int idx = tid + 512 * t, r = idx >> 3, ch = idx & 7; *(LAS u32x4*)(lds + r * AT_RS + ch * 16) = kreg[t]; *(LAS u32x4*)(lds + AT_TILE + r * AT_RS + ch * 16) = vreg[t]; }
    __syncthreads();
    while (c < 5) {
        int cn = c + 1; while (cn < 5 && !AT_VALID(cn)) ++cn;
        if (cn < 5) {
#pragma unroll
            for (int t = 0; t < 2; ++t) { const int idx = tid + 512 * t, r = idx >> 3, ch = idx & 7; const bf16_t* src = P + (size_t)(AT_ROW(cn) + r) * LDP + kvh * 64 + ch * 8;
                kreg[t] = *(const u32x4*)(src + C_AK); vreg[t] = *(const u32x4*)(src + C_AV); }
        }
        const LAS unsigned char* Kb = lds + buf * 2 * AT_TILE; const LAS unsigned char* Vb = Kb + AT_TILE;
        const bool lo_blk = (!is_ctx && c == 0), hi_blk = (!is_ctx && c == 2);
        for (int grp = 0; grp < 4; ++grp) {
            if (lo_blk && qh == 1 && grp < 2) continue;
            if (hi_blk && qh == 0 && grp >= 2) continue;
            bf16x8 kf[2][2], vf[4];
#pragma unroll
            for (int kt = 0; kt < 2; ++kt)
#pragma unroll
                for (int ks = 0; ks < 2; ++ks) kf[kt][ks] = *(const LAS bf16x8*)(Kb + (grp * 32 + kt * 16 + i) * AT_RS + (32 * ks + 8 * g) * 2);
#pragma unroll
            for (int dt = 0; dt < 4; ++dt) { const LAS unsigned char* vp = Vb + (grp * 32 + 4 * g + (i >> 2)) * AT_RS + (16 * dt + 4 * (i & 3)) * 2;
                vf[dt] = cat44(ds_tr16(vp), ds_tr16(vp + 16 * AT_RS)); }
#pragma unroll
            for (int qt = 0; qt < 4; ++qt) {
                f32x4 s0 = (f32x4){0.f, 0.f, 0.f, 0.f}, s1 = s0;
#pragma unroll
                for (int ks = 0; ks < 2; ++ks) { s0 = MFMA16(kf[0][ks], bq[qt][ks], s0); s1 = MFMA16(kf[1][ks], bq[qt][ks], s1); }
                if (lo_blk || hi_blk) {
                    const int qo = qh * 64 + qt * 16 + i, ko = grp * 32 + 4 * g;
#pragma unroll
                    for (int r = 0; r < 4; ++r) {
                        const bool v0 = lo_blk ? (ko + r >= qo) : (ko + r <= qo), v1 = lo_blk ? (ko + 16 + r >= qo) : (ko + 16 + r <= qo);
                        s0[r] = v0 ? s0[r] : -INFINITY; s1[r] = v1 ? s1[r] : -INFINITY; }
                }
                float mx = fmaxf(fmaxf(fmaxf(s0[0], s0[1]), fmaxf(s0[2], s0[3])), fmaxf(fmaxf(s1[0], s1[1]), fmaxf(s1[2], s1[3])));
                mx = grp_max(mx);
                if (__any(mx > m[qt])) {
                    const float mn = fmaxf(m[qt], mx), alpha = __builtin_amdgcn_exp2f(m[qt] - mn);
                    m[qt] = mn; l[qt] *= alpha;
#pragma unroll
                    for (int dt = 0; dt < 4; ++dt) O[dt][qt] = O[dt][qt] * alpha;
                }
                const float mq = m[qt];
                float ps = 0.f;
#pragma unroll
                for (int r = 0; r < 4; ++r) { s0[r] = __builtin_amdgcn_exp2f(s0[r] - mq); s1[r] = __builtin_amdgcn_exp2f(s1[r] - mq); ps += s0[r] + s1[r]; }
                l[qt] += ps;
                u32x4 pw; pw.x = cvtpk(s0[0], s0[1]); pw.y = cvtpk(s0[2], s0[3]); pw.z = cvtpk(s1[0], s1[1]); pw.w = cvtpk(s1[2], s1[3]);
                const bf16x8 pb = __builtin_bit_cast(bf16x8, pw);
#pragma unroll
                for (int dt = 0; dt < 4; ++dt) O[dt][qt] = MFMA16(vf[dt], pb, O[dt][qt]);
            }
        }
        if (cn < 5) {
            LAS unsigned char* nb = lds + (buf ^ 1) * 2 * AT_TILE;
#pragma unroll
            for (int t = 0; t < 2; ++t) { const int idx = tid + 512 * t, r = idx >> 3, ch = idx & 7; *(LAS u32x4*)(nb + r * AT_RS + ch * 16) = kreg[t]; *(LAS u32x4*)(nb + AT_TILE + r * AT_RS + ch * 16) = vreg[t]; }
        }
        __syncthreads();
        buf ^= 1; c = cn;
    }
#undef AT_VALID
#undef AT_ROW
#pragma unroll
    for (int qt = 0; qt < 4; ++qt) {
        const float inv = 1.f / grp_sum(l[qt]);
        bf16_t* dst = CAT + (size_t)(qrow0 + 16 * qt + i) * DM + 256 + hq * 64 + 4 * g;
#pragma unroll
        for (int dt = 0; dt < 4; ++dt) { uint2 o; o.x = cvtpk(O[dt][qt][0] * inv, O[dt][qt][1] * inv); o.y = cvtpk(O[dt][qt][2] * inv, O[dt][qt][3] * inv); *(uint2*)(dst + 16 * dt) = o; }
    }
}

constexpr int CH_RS = 144;
constexpr int CH_T = 64 * CH_RS;
constexpr int GL_RS = 80;
constexpr int GL_T = 64 * GL_RS;
__device__ __forceinline__ int chunk_b0(int oc) { return (oc < 256) ? oc * 64 : SEQ + (oc - 256) * 64; }
__device__ __forceinline__ bf16x8 tr_frag(const LAS unsigned char* tile, int rs, int row0, int col0, int lane) {
    const int g = lane >> 4, i = lane & 15; const LAS unsigned char* p = tile + (row0 + 8 * g + (i >> 2)) * rs + (col0 + 4 * (i & 3)) * 2;
    return cat44(ds_tr16(p), ds_tr16(p + 4 * rs));
}
__device__ __forceinline__ bf16x8 tr_frag_perm(const LAS unsigned char* tile, int rs, int row0, int col0, int lane) {
    const int g = lane >> 4, i = lane & 15; const LAS unsigned char* p = tile + (row0 + 4 * g + (i >> 2)) * rs + (col0 + 4 * (i & 3)) * 2;
    return cat44(ds_tr16(p), ds_tr16(p + 16 * rs));
}
__device__ __forceinline__ void unpack8(const u32x4 v, float* o) {
    o[0] = __uint_as_float(v.x << 16); o[1] = __uint_as_float(v.x & 0xffff0000u); o[2] = __uint_as_float(v.y << 16); o[3] = __uint_as_float(v.y & 0xffff0000u);
    o[4] = __uint_as_float(v.z << 16); o[5] = __uint_as_float(v.z & 0xffff0000u); o[6] = __uint_as_float(v.w << 16); o[7] = __uint_as_float(v.w & 0xffff0000u);
}
__device__ __forceinline__ u32x4 pack8(const float* f) { u32x4 w; w.x = cvtpk(f[0], f[1]); w.y = cvtpk(f[2], f[3]); w.z = cvtpk(f[4], f[5]); w.w = cvtpk(f[6], f[7]); return w; }

#define LBAR() do { asm volatile("s_waitcnt lgkmcnt(0)" ::: "memory"); __builtin_amdgcn_s_barrier(); asm volatile("" ::: "memory"); } while (0)

struct MsRaw { u32x4 k, v; float ig, fg, gbi, gbf; };
__device__ __forceinline__ MsRaw mlstm_summary_load(const bf16_t* P, const float* Gt, const float* gate_b, int h, int oc, int tid, int lane, int wave) {
    MsRaw R; const int b0 = chunk_b0(oc), r = tid >> 3, ch = tid & 7;
    R.k = *(const u32x4*)(P + (size_t)(b0 + r) * LDP + C_MK + h * 64 + ch * 8); R.v = *(const u32x4*)(P + (size_t)(b0 + r) * LDP + C_MV + h * 64 + ch * 8);
    { const int d = wave & 1, sp = d ? 63 - lane : lane, row = b0 + sp;
      R.ig = Gt[(size_t)row * 48 + d * 8 + h]; R.gbi = gate_b[d * 8 + h]; R.fg = Gt[(size_t)row * 48 + d * 8 + 4 + h]; R.gbf = gate_b[d * 8 + 4 + h]; }
    return R;
}
__device__ __forceinline__ void mlstm_summary_body(LAS unsigned char* lds, const MsRaw& R, float* MU, float* MNU, float* MSC, int h, int oc, int tid, int lane, int wave) {
    LAS unsigned char* Kw0 = lds; LAS unsigned char* Kw1 = lds + CH_T; LAS unsigned char* Vt = lds + 2 * CH_T; LAS float* wv = (LAS float*)(lds + 3 * CH_T);
    const int r = tid >> 3, ch = tid & 7;
    LBAR();
    if (wave < 2) {
        const int d = wave, sp = d ? 63 - lane : lane, hd = h * 2 + d, jc = oc_to_jc(d, oc);
        const float lf = log_sigmoidf_(R.fg + R.gbf);
        const float bb = scan_add(lf, lane);
        const float av = (R.ig + R.gbi) - bb;
        const float cm = wave_max(av);
        const float B = __shfl(bb, 63);
        wv[d * 64 + sp] = __expf(av - cm);
        if (lane == 0) { MSC[(size_t)(hd * NCH + jc) * 4 + 0] = cm; MSC[(size_t)(hd * NCH + jc) * 4 + 1] = B; }
    }
    *(LAS u32x4*)(Vt + r * CH_RS + ch * 16) = R.v;
    LBAR();
    { float kf[8], t0[8], t1[8]; unpack8(R.k, kf); const float w0 = wv[r], w1 = wv[64 + r];
#pragma unroll
      for (int j = 0; j < 8; ++j) { t0[j] = kf[j] * w0; t1[j] = kf[j] * w1; }
      *(LAS u32x4*)(Kw0 + r * CH_RS + ch * 16) = pack8(t0); *(LAS u32x4*)(Kw1 + r * CH_RS + ch * 16) = pack8(t1); }
    LBAR();
    { const int d = wave >> 2, dkt = wave & 3, g = lane >> 4, i = lane & 15, hd = h * 2 + d, jc = oc_to_jc(d, oc);
      const LAS unsigned char* Kw = d ? Kw1 : Kw0;
      const bf16x8 a0 = tr_frag(Kw, CH_RS, 0, 16 * dkt, lane), a1 = tr_frag(Kw, CH_RS, 32, 16 * dkt, lane);
      float* dst = MU + ((size_t)(hd * 64 + 16 * dkt + i) * NCH + jc) * 64 + 4 * g;
#pragma unroll
      for (int dvt = 0; dvt < 4; ++dvt) {
          f32x4 c = (f32x4){0.f, 0.f, 0.f, 0.f};
          c = MFMA16(tr_frag(Vt, CH_RS, 0, 16 * dvt, lane), a0, c); c = MFMA16(tr_frag(Vt, CH_RS, 32, 16 * dvt, lane), a1, c);
          *(f32x4*)(dst + 16 * dvt) = c;
      }
      const short one = (i == 0) ? (short)0x3F80 : (short)0; const bf16x8 bo = (bf16x8){one, one, one, one, one, one, one, one};
      f32x4 c1 = (f32x4){0.f, 0.f, 0.f, 0.f}; c1 = MFMA16(a0, bo, c1); c1 = MFMA16(a1, bo, c1);
      if (i == 0) *(f32x4*)(MNU + (size_t)(hd * NCH + jc) * 64 + 16 * dkt + 4 * g) = c1; }
}

struct MoRaw { u32x4 q, k, v, c0, c1; float ig, fg, gbi, gbf, mst, nv; uint2 og[4]; };
__device__ __forceinline__ MoRaw mlstm_out_load(const bf16_t* P, const float* Gt, const float* gate_b, const bf16_t* MC, const float* MNS, const float* MSC, int h, int oc, int tid, int lane, int wave) {
    MoRaw R; const int b0 = chunk_b0(oc), r = tid >> 3, ch = tid & 7;
    const size_t ro = (size_t)(b0 + r) * LDP + h * 64 + ch * 8;
    R.q = *(const u32x4*)(P + ro + C_MQ); R.k = *(const u32x4*)(P + ro + C_MK); R.v = *(const u32x4*)(P + ro + C_MV);
    const int jc0 = oc_to_jc(0, oc), jc1 = oc_to_jc(1, oc);
    R.c0 = *(const u32x4*)(MC + ((size_t)((h * 2 + 0) * 64 + r) * NCH + jc0) * 64 + ch * 8); R.c1 = *(const u32x4*)(MC + ((size_t)((h * 2 + 1) * 64 + r) * NCH + jc1) * 64 + ch * 8);
    { const int d = wave & 1, sp = d ? 63 - lane : lane, row = b0 + sp, hd = h * 2 + d, jc = d ? jc1 : jc0;
        R.ig = Gt[(size_t)row * 48 + d * 8 + h]; R.gbi = gate_b[d * 8 + h]; R.fg = Gt[(size_t)row * 48 + d * 8 + 4 + h]; R.gbf = gate_b[d * 8 + 4 + h];
        R.mst = MSC[(size_t)(hd * NCH + jc) * 4 + 2]; R.nv = MNS[(size_t)(hd * NCH + jc) * 64 + lane]; }
    { const int tt = wave & 3, g = lane >> 4, i = lane & 15, row = b0 + 16 * tt + i;
#pragma unroll
      for (int dvt = 0; dvt < 4; ++dvt) R.og[dvt] = *(const uint2*)(P + (size_t)row * LDP + C_MO + h * 64 + 16 * dvt + 4 * g); }
    return R;
}
__device__ __forceinline__ void mlstm_out_body(LAS unsigned char* lds, const MoRaw& R, const float* normw, bf16_t* CAT, int h, int oc, int tid, int lane, int wave) {
    LAS unsigned char* Qt = lds; LAS unsigned char* Kt = lds + CH_T; LAS unsigned char* Vt = lds + 2 * CH_T; LAS unsigned char* Ct = lds + 3 * CH_T;
    LAS float* arr = (LAS float*)(lds + 5 * CH_T);
    LAS f32x4* hs = (LAS f32x4*)(lds + 5 * CH_T + 2 * 320 * 4);
    const int b0 = chunk_b0(oc);
    const int r = tid >> 3, ch = tid & 7;
    LBAR();
    if (wave < 2) {
        const int d = wave, sp = d ? 63 - lane : lane;
        const float lf = log_sigmoidf_(R.fg + R.gbf);
        const float bb = scan_add(lf, lane);
        const float av = (R.ig + R.gbi) - bb;
        const float cm = scan_max(av, lane);
        const float mx = fmaxf(R.mst, cm);
        LAS float* A = arr + d * 320;
        A[sp] = av; A[64 + sp] = mx; A[128 + sp] = __expf(R.mst - mx); A[192 + sp] = __expf(-(bb + mx));
        A[256 + lane] = R.nv;
    }
    *(LAS u32x4*)(Qt + r * CH_RS + ch * 16) = R.q; *(LAS u32x4*)(Kt + r * CH_RS + ch * 16) = R.k; *(LAS u32x4*)(Vt + r * CH_RS + ch * 16) = R.v;
    *(LAS u32x4*)(Ct + r * CH_RS + ch * 16) = R.c0; *(LAS u32x4*)(Ct + CH_T + r * CH_RS + ch * 16) = R.c1;
    LBAR();
    const int d = wave >> 2, tt = wave & 3, g = lane >> 4, i = lane & 15, t = 16 * tt + i;
    f32x4 hh[4];
    {
        const LAS float* A = arr + d * 320;
        const float mxt = A[64 + t], wt = A[128 + t], emt = A[192 + t];
        bf16x8 bq[2], bqw[2]; float qn = 0.f;
#pragma unroll
        for (int ks = 0; ks < 2; ++ks) { const u32x4 raw = *(const LAS u32x4*)(Qt + t * CH_RS + (32 * ks + 8 * g) * 2); bq[ks] = __builtin_bit_cast(bf16x8, raw);
            float qf[8], qw[8]; unpack8(raw, qf);
            const f32x4 n0 = *(const LAS f32x4*)(A + 256 + 32 * ks + 8 * g), n1 = *(const LAS f32x4*)(A + 256 + 32 * ks + 8 * g + 4);
#pragma unroll
            for (int j = 0; j < 4; ++j) { qn += qf[j] * n0[j] + qf[4 + j] * n1[j]; }
#pragma unroll
            for (int j = 0; j < 8; ++j) qw[j] = qf[j] * wt;
            bqw[ks] = __builtin_bit_cast(bf16x8, pack8(qw)); }
        qn += __shfl_xor(qn, 16); qn += __shfl_xor(qn, 32);
        float dsum = 0.f; f32x4 sT[4];
#pragma unroll
        for (int st = 0; st < 4; ++st) {
            f32x4 c = (f32x4){0.f, 0.f, 0.f, 0.f};
#pragma unroll
            for (int ks = 0; ks < 2; ++ks) c = MFMA16(*(const LAS bf16x8*)(Kt + (16 * st + i) * CH_RS + (32 * ks + 8 * g) * 2), bq[ks], c);
            const f32x4 a4 = *(const LAS f32x4*)(A + 16 * st + 4 * g);
#pragma unroll
            for (int rr = 0; rr < 4; ++rr) { const int sidx = 16 * st + 4 * g + rr; const bool ok = d ? (sidx >= t) : (sidx <= t);
                const float val = ok ? c[rr] * __expf(a4[rr] - mxt) : 0.f; sT[st][rr] = val; dsum += val; }
        }
        dsum += __shfl_xor(dsum, 16); dsum += __shfl_xor(dsum, 32);
        const float den = dsum + wt * qn, inv = 1.f / fmaxf(fabsf(den), emt);
        bf16x8 pb[2];
#pragma unroll
        for (int gp = 0; gp < 2; ++gp) { u32x4 w; w.x = cvtpk(sT[2 * gp][0], sT[2 * gp][1]); w.y = cvtpk(sT[2 * gp][2], sT[2 * gp][3]); w.z = cvtpk(sT[2 * gp + 1][0], sT[2 * gp + 1][1]); w.w = cvtpk(sT[2 * gp + 1][2], sT[2 * gp + 1][3]); pb[gp] = __builtin_bit_cast(bf16x8, w); }
        const LAS unsigned char* Cd = Ct + d * CH_T;
#pragma unroll
        for (int dvt = 0; dvt < 4; ++dvt) {
            f32x4 c = (f32x4){0.f, 0.f, 0.f, 0.f};
            c = MFMA16(tr_frag_perm(Vt, CH_RS, 0, 16 * dvt, lane), pb[0], c); c = MFMA16(tr_frag_perm(Vt, CH_RS, 32, 16 * dvt, lane), pb[1], c);
            c = MFMA16(tr_frag(Cd, CH_RS, 0, 16 * dvt, lane), bqw[0], c); c = MFMA16(tr_frag(Cd, CH_RS, 32, 16 * dvt, lane), bqw[1], c);
            hh[dvt] = c * inv;
        }
        if (d == 1) {
#pragma unroll
            for (int dvt = 0; dvt < 4; ++dvt) hs[(tt * 4 + dvt) * 64 + lane] = hh[dvt];
        }
    }
    LBAR();
    if (d == 0) {
        float s1 = 0.f;
#pragma unroll
        for (int dvt = 0; dvt < 4; ++dvt) { hh[dvt] = hh[dvt] + hs[(tt * 4 + dvt) * 64 + lane]; s1 += (hh[dvt][0] + hh[dvt][1]) + (hh[dvt][2] + hh[dvt][3]); }
        s1 += __shfl_xor(s1, 16); s1 += __shfl_xor(s1, 32);
        const float mu = s1 * (1.f / 64.f); float s2 = 0.f;
#pragma unroll
        for (int dvt = 0; dvt < 4; ++dvt) { hh[dvt] = hh[dvt] - mu; s2 += (hh[dvt][0] * hh[dvt][0] + hh[dvt][1] * hh[dvt][1]) + (hh[dvt][2] * hh[dvt][2] + hh[dvt][3] * hh[dvt][3]); }
        s2 += __shfl_xor(s2, 16); s2 += __shfl_xor(s2, 32);
        const float rstd = rsqrtf(s2 * (1.f / 64.f) + LN_EPS);
        const int row = b0 + t;
#pragma unroll
        for (int dvt = 0; dvt < 4; ++dvt) { const int col = h * 64 + 16 * dvt + 4 * g;
            const uint2 og = R.og[dvt]; const f32x4 nw = *(const f32x4*)(normw + col);
            const float o0 = hh[dvt][0] * rstd * nw[0] * sigmoidf_(__uint_as_float(og.x << 16)), o1 = hh[dvt][1] * rstd * nw[1] * sigmoidf_(__uint_as_float(og.x & 0xffff0000u));
            const float o2 = hh[dvt][2] * rstd * nw[2] * sigmoidf_(__uint_as_float(og.y << 16)), o3 = hh[dvt][3] * rstd * nw[3] * sigmoidf_(__uint_as_float(og.y & 0xffff0000u));
            uint2 o; o.x = cvtpk(o0, o1); o.y = cvtpk(o2, o3); *(uint2*)(CAT + (size_t)row * DM + col) = o; }
    }
}

struct GgRaw { f32x4 g0, g1, g2, g3; };
__device__ __forceinline__ GgRaw gla_gates_load(const float* Gt, int b0, int lane, int wave) {
    const int d = wave >> 2, sp = d ? 63 - lane : lane; const float* gs = Gt + (size_t)(b0 + sp) * 48 + 16 + d * 16;
    GgRaw R; R.g0 = *(const f32x4*)gs; R.g1 = *(const f32x4*)(gs + 4); R.g2 = *(const f32x4*)(gs + 8); R.g3 = *(const f32x4*)(gs + 12); return R;
}
__device__ __forceinline__ void gla_gates_wave(const GgRaw& R, const LAS float* g_up, const LAS float* g_b, int h, int lane, int wave, float (&bc)[8]) {
    const int d = wave >> 2, dk0 = 8 * (wave & 3);
    const float gv[16] = {R.g0[0], R.g0[1], R.g0[2], R.g0[3], R.g1[0], R.g1[1], R.g1[2], R.g1[3], R.g2[0], R.g2[1], R.g2[2], R.g2[3], R.g3[0], R.g3[1], R.g3[2], R.g3[3]};
    float z[8];
    { const f32x4 b0 = *(const LAS f32x4*)(g_b + d * 128 + h * 32 + dk0), b1 = *(const LAS f32x4*)(g_b + d * 128 + h * 32 + dk0 + 4);
#pragma unroll
      for (int c = 0; c < 4; ++c) { z[c] = b0[c]; z[4 + c] = b1[c]; } }
#pragma unroll
    for (int rr = 0; rr < 16; ++rr) { const f32x4 u0 = *(const LAS f32x4*)(g_up + (d * 16 + rr) * 128 + h * 32 + dk0), u1 = *(const LAS f32x4*)(g_up + (d * 16 + rr) * 128 + h * 32 + dk0 + 4);
#pragma unroll
        for (int c = 0; c < 4; ++c) { z[c] += gv[rr] * u0[c]; z[4 + c] += gv[rr] * u1[c]; } }
#pragma unroll
    for (int c = 0; c < 8; ++c) bc[c] = scan_add(log_sigmoidf_(z[c]) * (1.f / 16.f), lane);
}
struct GsRaw { u32x4 v, k; GgRaw gg; };
__device__ __forceinline__ GsRaw gla_summary_load(const bf16_t* P, const float* Gt, int h, int oc, int tid, int lane, int wave) {
    GsRaw R; const int b0 = chunk_b0(oc), r = tid >> 3, ch = tid & 7, d = wave >> 2, dk0 = 8 * (wave & 3), sp = d ? 63 - lane : lane;
    R.v = *(const u32x4*)(P + (size_t)(b0 + r) * LDP + C_GV + h * 64 + ch * 8);
    R.k = *(const u32x4*)(P + (size_t)(b0 + sp) * LDP + C_GK + h * 32 + dk0);
    R.gg = gla_gates_load(Gt, b0, lane, wave);
    return R;
}
__device__ __forceinline__ void gla_summary_body(LAS unsigned char* lds, const GsRaw& R, const LAS float* g_up, const LAS float* g_b, float* GU, float* GDEC, int h, int oc, int tid, int lane, int wave) {
    LAS unsigned char* Kd = lds; LAS unsigned char* Vt = lds + 2 * GL_T;
    { const int r = tid >> 3, ch = tid & 7;
      LBAR();
      *(LAS u32x4*)(Vt + r * CH_RS + ch * 16) = R.v; }
    { const int d = wave >> 2, dk0 = 8 * (wave & 3), hd = h * 2 + d, jc = oc_to_jc(d, oc), sp = d ? 63 - lane : lane;
      float bc[8]; gla_gates_wave(R.gg, g_up, g_b, h, lane, wave, bc);
      float kf[8]; unpack8(R.k, kf);
      float dec[8];
#pragma unroll
      for (int c = 0; c < 8; ++c) { const float bL = __shfl(bc[c], 63); kf[c] *= __expf(bL - bc[c]); dec[c] = __expf(bL); }
      *(LAS u32x4*)(Kd + d * GL_T + sp * GL_RS + dk0 * 2) = pack8(kf);
      if (lane == 0) { float* dp = GDEC + (size_t)(hd * NCH + jc) * 32 + dk0; *(f32x4*)dp = (f32x4){dec[0], dec[1], dec[2], dec[3]}; *(f32x4*)(dp + 4) = (f32x4){dec[4], dec[5], dec[6], dec[7]}; } }
    LBAR();
    { const int d = wave >> 2, dkt = (wave >> 1) & 1, dvh = wave & 1, g = lane >> 4, i = lane & 15, hd = h * 2 + d, jc = oc_to_jc(d, oc);
      const bf16x8 a0 = tr_frag(Kd + d * GL_T, GL_RS, 0, 16 * dkt, lane), a1 = tr_frag(Kd + d * GL_T, GL_RS, 32, 16 * dkt, lane);
      float* dst = GU + ((size_t)(hd * 32 + 16 * dkt + i) * NCH + jc) * 64 + 4 * g;
#pragma unroll
      for (int q = 0; q < 2; ++q) { const int dvt = 2 * dvh + q;
          f32x4 c = (f32x4){0.f, 0.f, 0.f, 0.f};
          c = MFMA16(tr_frag(Vt, CH_RS, 0, 16 * dvt, lane), a0, c); c = MFMA16(tr_frag(Vt, CH_RS, 32, 16 * dvt, lane), a1, c);
          *(f32x4*)(dst + 16 * dvt) = c; } }
}
struct GoRaw { u32x4 v, s, q, k; GgRaw gg; uint2 og[4]; };
__device__ __forceinline__ GoRaw gla_out_load(const bf16_t* P, const float* Gt, const bf16_t* GS, int h, int oc, int tid, int lane, int wave) {
    GoRaw R; const int b0 = chunk_b0(oc), r = tid >> 3, ch = tid & 7, d = wave >> 2, dk0 = 8 * (wave & 3), sp = d ? 63 - lane : lane;
    R.v = *(const u32x4*)(P + (size_t)(b0 + r) * LDP + C_GV + h * 64 + ch * 8);
    { const int dd = r >> 5, rk = r & 31; R.s = *(const u32x4*)(GS + ((size_t)((h * 2 + dd) * 32 + rk) * NCH + oc_to_jc(dd, oc)) * 64 + ch * 8); }
    R.q = *(const u32x4*)(P + (size_t)(b0 + sp) * LDP + C_GQ + h * 32 + dk0); R.k = *(const u32x4*)(P + (size_t)(b0 + sp) * LDP + C_GK + h * 32 + dk0);
    R.gg = gla_gates_load(Gt, b0, lane, wave);
    { const int tt = wave & 3, g = lane >> 4, i = lane & 15, row = b0 + 16 * tt + i;
#pragma unroll
      for (int dvt = 0; dvt < 4; ++dvt) R.og[dvt] = *(const uint2*)(P + (size_t)row * LDP + C_GG + h * 64 + 16 * dvt + 4 * g); }
    return R;
}
__device__ __forceinline__ void gla_out_body(LAS unsigned char* lds, const GoRaw& R, const LAS float* g_up, const LAS float* g_b, const float* normw, bf16_t* CAT, int h, int oc, int tid, int lane, int wave) {
    LAS unsigned char* Qs = lds; LAS unsigned char* Ks = lds + 2 * GL_T; LAS unsigned char* Vt = lds + 4 * GL_T; LAS unsigned char* St = Vt + CH_T;
    LAS f32x4* hs = (LAS f32x4*)(St + 2 * 32 * CH_RS);
    const int b0 = chunk_b0(oc);
    { const int r = tid >> 3, ch = tid & 7, dd = r >> 5, rk = r & 31;
      LBAR();
      *(LAS u32x4*)(Vt + r * CH_RS + ch * 16) = R.v; *(LAS u32x4*)(St + dd * 32 * CH_RS + rk * CH_RS + ch * 16) = R.s; }
    { const int d = wave >> 2, dk0 = 8 * (wave & 3), sp = d ? 63 - lane : lane;
      float bc[8]; gla_gates_wave(R.gg, g_up, g_b, h, lane, wave, bc);
      float qf[8], kf[8]; unpack8(R.q, qf); unpack8(R.k, kf);
#pragma unroll
      for (int c = 0; c < 8; ++c) { qf[c] *= __expf(bc[c]); kf[c] *= __expf(-bc[c]); }
      *(LAS u32x4*)(Qs + d * GL_T + sp * GL_RS + dk0 * 2) = pack8(qf); *(LAS u32x4*)(Ks + d * GL_T + sp * GL_RS + dk0 * 2) = pack8(kf); }
    LBAR();
    const int d = wave >> 2, tt = wave & 3, g = lane >> 4, i = lane & 15, t = 16 * tt + i;
    f32x4 hh[4];
    {
        const bf16x8 bq = *(const LAS bf16x8*)(Qs + d * GL_T + t * GL_RS + 16 * g);
        f32x4 sT[4];
#pragma unroll
        for (int st = 0; st < 4; ++st) {
            f32x4 c = (f32x4){0.f, 0.f, 0.f, 0.f};
            c = MFMA16(*(const LAS bf16x8*)(Ks + d * GL_T + (16 * st + i) * GL_RS + 16 * g), bq, c);
#pragma unroll
            for (int rr = 0; rr < 4; ++rr) { const int sidx = 16 * st + 4 * g + rr; const bool ok = d ? (sidx >= t) : (sidx <= t); sT[st][rr] = ok ? c[rr] : 0.f; }
        }
        bf16x8 pb[2];
#pragma unroll
        for (int gp = 0; gp < 2; ++gp) { u32x4 w; w.x = cvtpk(sT[2 * gp][0], sT[2 * gp][1]); w.y = cvtpk(sT[2 * gp][2], sT[2 * gp][3]); w.z = cvtpk(sT[2 * gp + 1][0], sT[2 * gp + 1][1]); w.w = cvtpk(sT[2 * gp + 1][2], sT[2 * gp + 1][3]); pb[gp] = __builtin_bit_cast(bf16x8, w); }
#pragma unroll
        for (int dvt = 0; dvt < 4; ++dvt) {
            f32x4 c = (f32x4){0.f, 0.f, 0.f, 0.f};
            c = MFMA16(tr_frag_perm(Vt, CH_RS, 0, 16 * dvt, lane), pb[0], c); c = MFMA16(tr_frag_perm(Vt, CH_RS, 32, 16 * dvt, lane), pb[1], c);
            c = MFMA16(tr_frag(St + d * 32 * CH_RS, CH_RS, 0, 16 * dvt, lane), bq, c);
            hh[dvt] = c;
        }
        if (d == 1) {
#pragma unroll
            for (int dvt = 0; dvt < 4; ++dvt) hs[(tt * 4 + dvt) * 64 + lane] = hh[dvt];
        }
    }
    LBAR();
    if (d == 0) {
        float s1 = 0.f;
#pragma unroll
        for (int dvt = 0; dvt < 4; ++dvt) { hh[dvt] = hh[dvt] + hs[(tt * 4 + dvt) * 64 + lane]; s1 += (hh[dvt][0] + hh[dvt][1]) + (hh[dvt][2] + hh[dvt][3]); }
        s1 += __shfl_xor(s1, 16); s1 += __shfl_xor(s1, 32);
        const float mu = s1 * (1.f / 64.f); float s2 = 0.f;
#pragma unroll
        for (int dvt = 0; dvt < 4; ++dvt) { hh[dvt] = hh[dvt] - mu; s2 += (hh[dvt][0] * hh[dvt][0] + hh[dvt][1] * hh[dvt][1]) + (hh[dvt][2] * hh[dvt][2] + hh[dvt][3] * hh[dvt][3]); }
        s2 += __shfl_xor(s2, 16); s2 += __shfl_xor(s2, 32);
        const float rstd = rsqrtf(s2 * (1.f / 64.f) + LN_EPS);
        const int row = b0 + t;
#pragma unroll
        for (int dvt = 0; dvt < 4; ++dvt) { const int col = h * 64 + 16 * dvt + 4 * g;
            const uint2 gg = R.og[dvt]; const f32x4 nw = *(const f32x4*)(normw + col);
            const float o0 = hh[dvt][0] * rstd * nw[0] * siluf(__uint_as_float(gg.x << 16)), o1 = hh[dvt][1] * rstd * nw[1] * siluf(__uint_as_float(gg.x & 0xffff0000u));
            const float o2 = hh[dvt][2] * rstd * nw[2] * siluf(__uint_as_float(gg.y << 16)), o3 = hh[dvt][3] * rstd * nw[3] * siluf(__uint_as_float(gg.y & 0xffff0000u));
            uint2 o; o.x = cvtpk(o0, o1); o.y = cvtpk(o2, o3); *(uint2*)(CAT + (size_t)row * DM + 768 + col) = o; }
    }
}

__device__ __forceinline__ f32x4 ld4bf(const bf16_t* p) { const uint2 v = *(const uint2*)p; return (f32x4){__uint_as_float(v.x << 16), __uint_as_float(v.x & 0xffff0000u), __uint_as_float(v.y << 16), __uint_as_float(v.y & 0xffff0000u)}; }
__device__ __forceinline__ void ln16(f32x4 (&v)[4], const float* w, const float* b, int lane) {
    float s = 0.f;
#pragma unroll
    for (int j = 0; j < 4; ++j) s += (v[j][0] + v[j][1]) + (v[j][2] + v[j][3]);
    const float mean = wave_sum(s) * (1.f / DM); float s2 = 0.f;
#pragma unroll
    for (int j = 0; j < 4; ++j) { v[j] = v[j] - mean; s2 += (v[j][0] * v[j][0] + v[j][1] * v[j][1]) + (v[j][2] * v[j][2] + v[j][3] * v[j][3]); }
    const float rstd = rsqrtf(wave_sum(s2) * (1.f / DM) + LN_EPS);
#pragma unroll
    for (int j = 0; j < 4; ++j) { const f32x4 wv = *(const f32x4*)(w + 4 * lane + 256 * j), bv = *(const f32x4*)(b + 4 * lane + 256 * j); v[j] = v[j] * rstd * wv + bv; }
}
__device__ __forceinline__ void mod_store(f32x4 (&v)[4], const float* shift, const float* scale, bf16_t* hrow, int lane) {
#pragma unroll
    for (int j = 0; j < 4; ++j) { const f32x4 sh = *(const f32x4*)(shift + 4 * lane + 256 * j), sc = *(const f32x4*)(scale + 4 * lane + 256 * j);
        v[j] = v[j] * (sc + 1.f) + sh;
        uint2 o; o.x = cvtpk(v[j][0], v[j][1]); o.y = cvtpk(v[j][2], v[j][3]); *(uint2*)(hrow + 4 * lane + 256 * j) = o; }
}

__global__ void __launch_bounds__(512, 2) fwd(Args a_unused) {
    extern __shared__ __attribute__((aligned(16))) unsigned char lds_raw[];
    LAS unsigned char* lds = (LAS unsigned char*)lds_raw;
    const int wave0 = __builtin_amdgcn_readfirstlane(threadIdx.x >> 6);
    const int G = gridDim.x, bid = blockIdx.x;
    typedef const __attribute__((address_space(4))) Args* ArgsP;
    ArgsP ap0 = (ArgsP)__builtin_amdgcn_kernarg_segment_ptr();
#define PH_CTX() int wave = wave0; asm volatile("" : "+s"(wave)); unsigned ones_ = ~0u; asm volatile("" : "+s"(ones_)); const int lane = (int)__builtin_amdgcn_mbcnt_hi(ones_, __builtin_amdgcn_mbcnt_lo(ones_, 0u)); const int tid = wave * 64 + lane; \
    ArgsP ap = ap0; asm volatile("" : "+s"(ap)); unsigned char* ws = ap->ws; const int gw = bid * 8 + wave, NGW = G * 8; (void)lane; (void)gw; (void)NGW; (void)ws
#define WSP(T, off) ((T*)(ws + (off)))
    volatile LAS unsigned* MISC = (volatile LAS unsigned*)(lds + MISC_OFF);
    if (threadIdx.x < 32) MISC[threadIdx.x] = 0u;
    __syncthreads();
    XcdBarrier bar; bar.bar = (unsigned*)(ap0->ws + WS_CTL) + CW_BAR; bar.x = 0; bar.st = MISC + 8;
    if (MK_ONE_LAUNCH) bar = xcd_barrier_post(bar.bar, MISC + 8);
    const int lo = ap0->ph_lo, hi = ap0->ph_hi;
#define IN(k) (lo <= (k) && (k) < hi)
#define SEAM(k) do { if (MK_ONE_LAUNCH && (k) + 1 < hi) xcd_barrier(bar); } while (0)

    if (IN(0)) {
        PH_CTX();
        float* MODS = WSP(float, WS_MODS);
        LAS float* scs = (LAS float*)lds;
        for (int i = tid; i < 2048; i += 512) scs[i] = siluf(i < 1024 ? ap->in[1][i] : ap->in[3][i - 1024]);
        __syncthreads();
        for (int u = bid; u < 4 * 8 * 12; u += G) {
            const int l = u / 96, rem = u % 96, kc = rem / 12, ng = rem % 12, n = ng * 512 + tid;
            const float* w = ap->in[4] + ((size_t)l * 1024 + kc * 128) * 6144 + n;
            float a0 = 0.f, a1 = 0.f;
#pragma unroll 8
            for (int k = 0; k < 128; ++k) { const float wv = w[(size_t)k * 6144]; a0 += scs[kc * 128 + k] * wv; a1 += scs[1024 + kc * 128 + k] * wv; }
            if (kc == 0) { const float bb = ap->in[5][l * 6144 + n]; a0 += bb; a1 += bb; }
            atomicAdd(MODS + (size_t)(l * 2 + 0) * 6144 + n, a0); atomicAdd(MODS + (size_t)(l * 2 + 1) * 6144 + n, a1);
        }
        if (bid < 8) { float* ropeC = WSP(float, WS_ROPE); float* ropeS = ropeC + 256 * 16;
            const int i = bid * 512 + tid, pos = i >> 4, fi = i & 15; const float inv = powf(10000.f, -(float)fi / 16.f); const float ang = (float)pos * inv; float sn, cs; sincosf(ang, &sn, &cs); ropeC[i] = cs; ropeS[i] = sn; }
        __syncthreads();
        LAS float* scr = (LAS float*)(lds + wave * 16640);
        constexpr int I_A = 16 * 44, I_B = 16 * 16, I_C = 16 * 88, I_D = 44 * 16, I_E = 16 * 112, I_F = 56 * 16;
        constexpr int N_A = 4 * I_A, N_B = 4 * I_B, N_C = 2 * I_C, N_D = 2 * I_D, N_E = 16 * I_E, N_F = 16 * I_F;
        for (int it = gw; it < N_A + N_B + N_C + N_D + N_E + N_F; it += NGW) {
            int r = it;
            if (r < N_E) { const int mi = r / I_E; tr_item(ap->in[20] + (size_t)mi * DM * 2 * DEXP, DM, 2 * DEXP, 2 * DEXP, WSP(bf16_t, WS_MGU) + (size_t)mi * 2 * DEXP * DM, 2, DEXP, scr, r % I_E, lane); continue; } r -= N_E;
            if (r < N_F) { const int mi = r / I_F; tr_item(ap->in[21] + (size_t)mi * DEXP * DM, DEXP, DM, DM, WSP(bf16_t, WS_MDN) + (size_t)mi * DM * DEXP, 0, 0, scr, r % I_F, lane); continue; } r -= N_F;
            if (r < N_A) { const int mi = r / I_A; tr_item(ap->in[6] + (size_t)mi * DM * IN_COLS, DM, IN_COLS, NPIN, WSP(bf16_t, WS_WIN) + (size_t)mi * NPIN * DM, 1, 0, scr, r % I_A, lane); continue; } r -= N_A;
            if (r < N_B) { const int mi = r / I_B; tr_item(ap->in[13] + (size_t)mi * DM * DM, DM, DM, DM, WSP(bf16_t, WS_WOUT) + (size_t)mi * DM * DM, 0, 0, scr, r % I_B, lane); continue; } r -= N_B;
            if (r < N_C) { const int mi = r / I_C; tr_item(ap->in[16] + (size_t)mi * DM * 2 * DFF, DM, 2 * DFF, 2 * DFF, WSP(bf16_t, WS_FGU) + (size_t)mi * 2 * DFF * DM, 2, DFF, scr, r % I_C, lane); continue; } r -= N_C;
            { const int mi = r / I_D; tr_item(ap->in[17] + (size_t)mi * DFF * DM, DFF, DM, DM, WSP(bf16_t, WS_FDN) + (size_t)mi * DM * DFF, 0, 0, scr, r % I_D, lane); }
        }
        SEAM(0);
    }
    if (IN(1)) {
        PH_CTX();
        bf16_t* H = WSP(bf16_t, WS_H); const float* MODS = WSP(float, WS_MODS);
        for (int r = gw; r < TT; r += NGW) {
            const int wch = r >= SEQ; const float* src = wch ? ap->in[2] + (size_t)(r - SEQ) * DM : ap->in[0] + (size_t)r * DM;
            f32x4 v[4];
#pragma unroll
            for (int j = 0; j < 4; ++j) v[j] = *(const f32x4*)(src + 4 * lane + 256 * j);
            const float* md = MODS + (size_t)(0 * 2 + wch) * 6144;
            mod_store(v, md, md + 1024, H + (size_t)r * DM, lane);
        }
        SEAM(1);
    }

    for (int l = 0; l < DEPTH; ++l) {
        const int pb = 2 + 10 * l;
        const bool lastl = (l == DEPTH - 1), moe = (l & 1);
        const int nrows = lastl ? SEQ : TT;

        PHASE_REP(0) if (IN(pb + 0)) {
            PH_CTX();
            pg8::StaticOrder S; S.init(WSP(bf16_t, WS_H), WSP(bf16_t, WS_WIN) + (size_t)l * NPIN * DM, DM, TT, NPIN, G, bid);
            pg8::EpiInProj E{WSP(bf16_t, WS_P), WSP(float, WS_G), WSP(float, WS_ROPE), WSP(float, WS_ROPE) + 256 * 16};
            pg8::gemm_phase<pg8::EpiInProj, pg8::StaticOrder>(lds, DM, S, E, tid);
            SEAM(pb + 0);
        }
        PHASE_REP(1) if (IN(pb + 1)) {
            if (!lastl && bid >= 32 && bid < 36) { PH_CTX(); attn_unit(lds, WSP(bf16_t, WS_P), WSP(bf16_t, WS_CAT), -1, (bid - 32) >> 1, bid & 1, ap->in[9] + l * 8, tid, lane, wave); }
            { PH_CTX();
              const bf16_t* P = WSP(bf16_t, WS_P); const float* Gt = WSP(float, WS_G); const float* gate_b = ap->in[7] + l * 16;
#define UNIT_LOOP2(N_, start_, RawT, LOAD, BODY) do { int u0_ = (start_); if (u0_ < (N_)) { RawT A_ = LOAD(u0_); for (;;) { \
                  const int u1_ = u0_ + G; const RawT B_ = LOAD(u1_ < (N_) ? u1_ : u0_); BODY(A_, u0_); if (u1_ >= (N_)) break; \
                  const int u2_ = u1_ + G; A_ = LOAD(u2_ < (N_) ? u2_ : u1_); BODY(B_, u1_); if (u2_ >= (N_)) break; u0_ = u2_; } } } while (0)
#define MS_LOAD(u) mlstm_summary_load(P, Gt, gate_b, (u) / NCH, (u) % NCH, tid, lane, wave)
#define MS_BODY(R, u) mlstm_summary_body(lds, R, WSP(float, WS_MU), WSP(float, WS_MNU), WSP(float, WS_MSC), (u) / NCH, (u) % NCH, tid, lane, wave)
              UNIT_LOOP2(4 * NCH, bid, MsRaw, MS_LOAD, MS_BODY); }
            { PH_CTX();
              const bf16_t* P = WSP(bf16_t, WS_P); const float* Gt = WSP(float, WS_G);
#define GS_LOAD(u) gla_summary_load(P, Gt, (u) / NCH, (u) % NCH, tid, lane, wave)
              LAS float* gupL = (LAS float*)(lds + 65536); LAS float* gbL = gupL + 4096;
              __syncthreads(); for (int i = tid; i < 4096; i += 512) gupL[i] = ap->in[10][(size_t)l * 4096 + i]; if (tid < 256) gbL[tid] = ap->in[11][l * 256 + tid]; __syncthreads();
#define GS_BODY(R, u) gla_summary_body(lds, R, gupL, gbL, WSP(float, WS_GU), WSP(float, WS_GDEC), (u) / NCH, (u) % NCH, tid, lane, wave)
              UNIT_LOOP2(4 * NCH, (bid + 240) % G, GsRaw, GS_LOAD, GS_BODY); }
            SEAM(pb + 1);
        }
        PHASE_REP(2) if (IN(pb + 2)) {
            PH_CTX();
            const int wi = wave * G + bid;
            const int e0 = wi * 64;
            LAS float* sc = (LAS float*)(lds + wave * 4096);
#define SC_LOAD(buf, b) _Pragma("unroll") for (int j = 0; j < 52; ++j) buf[j] = U[(size_t)((b) * 52 + j) * str]
            if (e0 < 32768 + 512) {
                const bool isC = e0 < 32768;
                const int hd = isC ? e0 / 4096 : (e0 - 32768) / 64, idx = isC ? (e0 % 4096) + lane : lane;
                const int dkr = (e0 % 4096) >> 6;
                const float* __restrict__ U = isC ? WSP(float, WS_MU) + (size_t)(hd * 64 + dkr) * NCH * 64 + lane : WSP(float, WS_MNU) + (size_t)hd * NCH * 64 + lane;
                bf16_t* __restrict__ StC = WSP(bf16_t, WS_MC) + (size_t)(hd * 64 + dkr) * NCH * 64 + lane; float* __restrict__ StN = WSP(float, WS_MNS) + (size_t)hd * NCH * 64 + lane;
                float* __restrict__ MSC = WSP(float, WS_MSC) + (size_t)hd * NCH * 4;
                const int str = 64;
                const bool wr_m = isC && (e0 % 4096) == 0 && lane == 0;
                for (int k = lane; k < NCH; k += 64) { const float2 v = *(const float2*)(MSC + k * 4); sc[2 * k] = v.x; sc[2 * k + 1] = v.y; }
                LDS_WAIT();
                float m = 0.f, cval = 0.f;
#define SC_STEP_M(buf, b) _Pragma("unroll") for (int j = 0; j < 52; ++j) { const int n = (b) * 52 + j; \
                    if (isC) StC[(size_t)n * 64] = (bf16_t)f2bf(cval); else StN[(size_t)n * 64] = cval; \
                    if (wr_m) MSC[n * 4 + 2] = m; \
                    const float cmv = sc[2 * n], Bv = sc[2 * n + 1], mx = fmaxf(m, cmv); \
                    cval = __expf(m - mx) * cval + __expf(cmv - mx) * buf[j]; m = Bv + mx; }
                float ua[52], ub[52];
                SC_LOAD(ua, 0);
                SC_LOAD(ub, 1); SC_STEP_M(ua, 0); SC_LOAD(ua, 2); SC_STEP_M(ub, 1);
                SC_LOAD(ub, 3); SC_STEP_M(ua, 2); SC_LOAD(ua, 4); SC_STEP_M(ub, 3);
                SC_STEP_M(ua, 4);
#undef SC_STEP_M
            } else if (e0 < 32768 + 512 + 16384) {
                const int e2 = e0 - 33280, hd = e2 / 2048, idx = (e2 % 2048) + lane, dk = (e2 % 2048) >> 6;
                const float* __restrict__ U = WSP(float, WS_GU) + (size_t)(hd * 32 + dk) * NCH * 64 + lane; bf16_t* __restrict__ St = WSP(bf16_t, WS_GS) + (size_t)(hd * 32 + dk) * NCH * 64 + lane;
                const float* __restrict__ DC = WSP(float, WS_GDEC) + (size_t)hd * NCH * 32 + dk;
                const int str = 64;
                for (int k = lane; k < NCH; k += 64) sc[k] = DC[(size_t)k * 32];
                LDS_WAIT();
                float sval = 0.f;
#define SC_STEP_G(buf, b) _Pragma("unroll") for (int j = 0; j < 52; ++j) { const int n = (b) * 52 + j; St[(size_t)n * 64] = (bf16_t)f2bf(sval); sval = sc[n] * sval + buf[j]; }
                float ua[52], ub[52];
                SC_LOAD(ua, 0);
                SC_LOAD(ub, 1); SC_STEP_G(ua, 0); SC_LOAD(ua, 2); SC_STEP_G(ub, 1);
                SC_LOAD(ub, 3); SC_STEP_G(ua, 2); SC_LOAD(ua, 4); SC_STEP_G(ub, 3);
                SC_STEP_G(ua, 4);
#undef SC_STEP_G
            }
#undef SC_LOAD
            SEAM(pb + 2);
        }
        PHASE_REP(3) if (IN(pb + 3)) {
            const int noc = lastl ? 256 : 260;
            { PH_CTX();
              for (int u = bid; u < 256; u += G) attn_unit(lds, WSP(bf16_t, WS_P), WSP(bf16_t, WS_CAT), u >> 1, 0, u & 1, ap->in[9] + l * 8, tid, lane, wave); }
            { PH_CTX();
              const bf16_t* P = WSP(bf16_t, WS_P); const float* Gt = WSP(float, WS_G); const float* gate_b = ap->in[7] + l * 16;
              const bf16_t* MC = WSP(bf16_t, WS_MC); const float* MNS = WSP(float, WS_MNS); const float* MSC = WSP(float, WS_MSC);
#define MO_LOAD(u) mlstm_out_load(P, Gt, gate_b, MC, MNS, MSC, (u) / noc, (u) % noc, tid, lane, wave)
#define MO_BODY(R, u) mlstm_out_body(lds, R, ap->in[8] + l * 256, WSP(bf16_t, WS_CAT), (u) / noc, (u) % noc, tid, lane, wave)
              UNIT_LOOP2(4 * noc, bid, MoRaw, MO_LOAD, MO_BODY); }
            { PH_CTX();
              const bf16_t* P = WSP(bf16_t, WS_P); const float* Gt = WSP(float, WS_G); const bf16_t* GS = WSP(bf16_t, WS_GS);
#define GO_LOAD(u) gla_out_load(P, Gt, GS, (u) / noc, (u) % noc, tid, lane, wave)
              LAS float* gupL = (LAS float*)(lds + 65536); LAS float* gbL = gupL + 4096;
              __syncthreads(); for (int i = tid; i < 4096; i += 512) gupL[i] = ap->in[10][(size_t)l * 4096 + i]; if (tid < 256) gbL[tid] = ap->in[11][l * 256 + tid]; __syncthreads();
#define GO_BODY(R, u) gla_out_body(lds, R, gupL, gbL, ap->in[12] + l * 256, WSP(bf16_t, WS_CAT), (u) / noc, (u) % noc, tid, lane, wave)
              UNIT_LOOP2(4 * noc, (bid + 240) % G, GoRaw, GO_LOAD, GO_BODY); }
            SEAM(pb + 3);
        }
        PHASE_REP(4) if (IN(pb + 4)) {
            PH_CTX();
            const float* modl = WSP(float, WS_MODS) + (size_t)(l * 2 + 0) * 6144;
            int tp, sp; pg8::tail_params(nrows / 256, 4, DM / 64, G, tp, sp);
            pg8::TailOrder S; S.dense(WSP(bf16_t, WS_CAT), WSP(bf16_t, WS_WOUT) + (size_t)l * DM * DM, DM, DM, nrows / 256, G, bid, tp, sp);
            pg8::EpiResid E{WSP(bf16_t, WS_Y), modl + 2 * 1024, modl + 6144 + 2 * 1024, WSP(float, WS_YP), nrows - tp * 256, tp * 256};
            pg8::gemm_phase<pg8::EpiResid, pg8::TailOrder>(lds, DM, S, E, tid);
            SEAM(pb + 4);
        }
        if (IN(pb + 5)) {
            PH_CTX();
            float* X = WSP(float, WS_X); bf16_t* H = WSP(bf16_t, WS_H); const bf16_t* Yb = WSP(bf16_t, WS_Y);
            const float* modl = WSP(float, WS_MODS) + (size_t)(l * 2 + 0) * 6144;
            unsigned* mcnt = WSP(unsigned, WS_CTL) + CW_MOE + 64 * 8 * (l >> 1);
            LAS float* RW = (LAS float*)lds;
            if (moe) { const float* rw = ap->in[18] + (size_t)(l >> 1) * DM * 8; for (int i = tid; i < 8192; i += 512) { const int e = i >> 10, c = i & 1023; RW[i] = rw[c * 8 + e]; } __syncthreads(); }
            const float* lw = ap->in[14] + (size_t)(l * 2 + 0) * DM; const float* lb = ap->in[15] + (size_t)(l * 2 + 0) * DM;
            int tp, sp; pg8::tail_params(nrows / 256, 4, DM / 64, G, tp, sp);
            const int tail0 = nrows - tp * 256; const float* YP = WSP(float, WS_YP);
            for (int r = gw; r < nrows; r += NGW) {
                const int wch = r >= SEQ; const float* md = modl + wch * 6144;
                const float* xres = (l == 0) ? (wch ? ap->in[2] + (size_t)(r - SEQ) * DM : ap->in[0] + (size_t)r * DM) : X + (size_t)r * DM;
                f32x4 v[4];
                if (r < tail0) {
#pragma unroll
                    for (int j = 0; j < 4; ++j) v[j] = *(const f32x4*)(xres + 4 * lane + 256 * j) * ALPHA + ld4bf(Yb + (size_t)r * DM + 4 * lane + 256 * j);
                } else {
#pragma unroll
                    for (int j = 0; j < 4; ++j) { const int c = 4 * lane + 256 * j; f32x4 a4 = (f32x4){0.f, 0.f, 0.f, 0.f};
                        for (int p = 0; p < sp; ++p) a4 = a4 + *(const f32x4*)(YP + ((size_t)p * tp * 256 + (r - tail0)) * DM + c);
                        v[j] = *(const f32x4*)(xres + c) * ALPHA + *(const f32x4*)(md + 2 * 1024 + c) * a4; }
                }
                ln16(v, lw, lb, lane);
#pragma unroll
                for (int j = 0; j < 4; ++j) *(f32x4*)(X + (size_t)r * DM + 4 * lane + 256 * j) = v[j];
                if (!moe) mod_store(v, md + 3 * 1024, md + 4 * 1024, H + (size_t)r * DM, lane);
                else {
#pragma unroll
                    for (int j = 0; j < 4; ++j) { const f32x4 sh = *(const f32x4*)(md + 3 * 1024 + 4 * lane + 256 * j), sc = *(const f32x4*)(md + 4 * 1024 + 4 * lane + 256 * j); v[j] = v[j] * (sc + 1.f) + sh; }
                    float lg[8];
#pragma unroll
                    for (int e = 0; e < 8; ++e) { float s = 0.f;
#pragma unroll
                        for (int j = 0; j < 4; ++j) { const f32x4 w = *(const LAS f32x4*)(RW + e * 1024 + 4 * lane + 256 * j); s += v[j][0] * w[0] + v[j][1] * w[1] + v[j][2] * w[2] + v[j][3] * w[3]; }
                        lg[e] = wave_sum(s) + ap->in[19][(l >> 1) * 8 + e]; }
                    int e0 = 0; float l0 = lg[0];
#pragma unroll
                    for (int e = 1; e < 8; ++e) if (lg[e] > l0) { l0 = lg[e]; e0 = e; }
                    int e1 = -1; float l1 = -INFINITY;
#pragma unroll
                    for (int e = 0; e < 8; ++e) if (e != e0 && lg[e] > l1) { l1 = lg[e]; e1 = e; }
                    int p0 = 0, p1 = 0;
                    if (lane == 0) {
                        const float w0 = 1.f / (1.f + __expf(l1 - l0));
                        p0 = (int)atomicAdd(mcnt + 64 * e0, 1u); p1 = (int)atomicAdd(mcnt + 64 * e1, 1u);
                        WSP(int2, WS_TOKE)[r] = make_int2(e0, e1); WSP(int2, WS_TOKP)[r] = make_int2(p0, p1); WSP(float2, WS_TOKW)[r] = make_float2(w0, 1.f - w0);
                    }
                    p0 = __builtin_amdgcn_readfirstlane(p0); p1 = __builtin_amdgcn_readfirstlane(p1);
                    bf16_t* x0 = WSP(bf16_t, WS_XB) + ((size_t)e0 * TT + p0) * DM; bf16_t* x1 = WSP(bf16_t, WS_XB) + ((size_t)e1 * TT + p1) * DM;
#pragma unroll
                    for (int j = 0; j < 4; ++j) { uint2 o; o.x = cvtpk(v[j][0], v[j][1]); o.y = cvtpk(v[j][2], v[j][3]); *(uint2*)(x0 + 4 * lane + 256 * j) = o; *(uint2*)(x1 + 4 * lane + 256 * j) = o; }
                }
            }
            SEAM(pb + 5);
        }
#define MOE_TS() int ts0 = 0, ts1, ts2, ts3, ts4, ts5, ts6, ts7, ts8; { const unsigned* mcnt = WSP(unsigned, WS_CTL) + CW_MOE + 64 * 8 * (l >> 1); \
            ts1 = ts0 + (int)((__hip_atomic_load(mcnt + 64 * 0, __ATOMIC_RELAXED, __HIP_MEMORY_SCOPE_AGENT) + 255u) >> 8); ts2 = ts1 + (int)((__hip_atomic_load(mcnt + 64 * 1, __ATOMIC_RELAXED, __HIP_MEMORY_SCOPE_AGENT) + 255u) >> 8); \
            ts3 = ts2 + (int)((__hip_atomic_load(mcnt + 64 * 2, __ATOMIC_RELAXED, __HIP_MEMORY_SCOPE_AGENT) + 255u) >> 8); ts4 = ts3 + (int)((__hip_atomic_load(mcnt + 64 * 3, __ATOMIC_RELAXED, __HIP_MEMORY_SCOPE_AGENT) + 255u) >> 8); \
            ts5 = ts4 + (int)((__hip_atomic_load(mcnt + 64 * 4, __ATOMIC_RELAXED, __HIP_MEMORY_SCOPE_AGENT) + 255u) >> 8); ts6 = ts5 + (int)((__hip_atomic_load(mcnt + 64 * 5, __ATOMIC_RELAXED, __HIP_MEMORY_SCOPE_AGENT) + 255u) >> 8); \
            ts7 = ts6 + (int)((__hip_atomic_load(mcnt + 64 * 6, __ATOMIC_RELAXED, __HIP_MEMORY_SCOPE_AGENT) + 255u) >> 8); ts8 = ts7 + (int)((__hip_atomic_load(mcnt + 64 * 7, __ATOMIC_RELAXED, __HIP_MEMORY_SCOPE_AGENT) + 255u) >> 8); \
            ts1 = __builtin_amdgcn_readfirstlane(ts1); ts2 = __builtin_amdgcn_readfirstlane(ts2); ts3 = __builtin_amdgcn_readfirstlane(ts3); ts4 = __builtin_amdgcn_readfirstlane(ts4); \
            ts5 = __builtin_amdgcn_readfirstlane(ts5); ts6 = __builtin_amdgcn_readfirstlane(ts6); ts7 = __builtin_amdgcn_readfirstlane(ts7); ts8 = __builtin_amdgcn_readfirstlane(ts8); } (void)ts0; (void)ts8
        PHASE_REP(7) if (IN(pb + 7)) {
            PH_CTX();
            if (!moe) {
                pg8::StaticOrder S; S.init(WSP(bf16_t, WS_H), WSP(bf16_t, WS_FGU) + (size_t)(l >> 1) * 2 * DFF * DM, DM, nrows, 2 * DFF, G, bid);
                pg8::EpiSwiglu E{WSP(bf16_t, WS_ACT), DFF};
                pg8::gemm_phase<pg8::EpiSwiglu, pg8::StaticOrder>(lds, DM, S, E, tid);
            } else {
                MOE_TS();
                pg8::MoeOrder S; S.A = (const char*)WSP(bf16_t, WS_XB); S.Bt = (const char*)(WSP(bf16_t, WS_MGU) + (size_t)(l >> 1) * 8 * 2 * DEXP * DM); S.K = DM; S.N = 2 * DEXP; S.nN = 2 * DEXP / 256; S.ntile = ts8; S.G = G; S.c = bid;
                S.ts1 = ts1; S.ts2 = ts2; S.ts3 = ts3; S.ts4 = ts4; S.ts5 = ts5; S.ts6 = ts6; S.ts7 = ts7;
                pg8::EpiSwiglu E{WSP(bf16_t, WS_ACT), DEXP};
                pg8::gemm_phase<pg8::EpiSwiglu, pg8::MoeOrder>(lds, DM, S, E, tid);
            }
            SEAM(pb + 7);
        }
        PHASE_REP(8) if (IN(pb + 8)) {
            PH_CTX();
            if (!moe) {
                const float* modl = WSP(float, WS_MODS) + (size_t)(l * 2 + 0) * 6144;
                int tp, sp; pg8::tail_params(nrows / 256, 4, DFF / 64, G, tp, sp);
                pg8::TailOrder S; S.dense(WSP(bf16_t, WS_ACT), WSP(bf16_t, WS_FDN) + (size_t)(l >> 1) * DM * DFF, DFF, DM, nrows / 256, G, bid, tp, sp);
                pg8::EpiResid E{WSP(bf16_t, WS_Y), modl + 5 * 1024, modl + 6144 + 5 * 1024, WSP(float, WS_YP), nrows - tp * 256, tp * 256};
                pg8::gemm_phase<pg8::EpiResid, pg8::TailOrder>(lds, DFF, S, E, tid);
            } else {
                MOE_TS();
                int tp, sp; pg8::tail_params(ts8, 4, DEXP / 64, G, tp, sp);
                pg8::TailOrder S; S.dense(WSP(bf16_t, WS_ACT), WSP(bf16_t, WS_MDN) + (size_t)(l >> 1) * 8 * DM * DEXP, DEXP, DM, ts8, G, bid, tp, sp);
                S.ts1 = ts1; S.ts2 = ts2; S.ts3 = ts3; S.ts4 = ts4; S.ts5 = ts5; S.ts6 = ts6; S.ts7 = ts7;
                pg8::EpiRaw E{WSP(bf16_t, WS_YS), WSP(float, WS_YP), (ts8 - tp) * 256, tp * 256};
                pg8::gemm_phase<pg8::EpiRaw, pg8::TailOrder>(lds, DEXP, S, E, tid);
            }
            SEAM(pb + 8);
        }
        if (IN(pb + 9)) {
            PH_CTX();
            float* X = WSP(float, WS_X); bf16_t* H = WSP(bf16_t, WS_H); const bf16_t* Yb = WSP(bf16_t, WS_Y); const bf16_t* YS = WSP(bf16_t, WS_YS);
            const float* modl = WSP(float, WS_MODS) + (size_t)(l * 2 + 0) * 6144;
            const float* lw = ap->in[14] + (size_t)(l * 2 + 1) * DM; const float* lb = ap->in[15] + (size_t)(l * 2 + 1) * DM;
            int tp, sp, tail0; const float* YP = WSP(float, WS_YP);
            MOE_TS();
            if (!moe) { pg8::tail_params(nrows / 256, 4, DFF / 64, G, tp, sp); tail0 = nrows - tp * 256; }
            else { pg8::tail_params(ts8, 4, DEXP / 64, G, tp, sp); tail0 = (ts8 - tp) * 256; }
            for (int r = gw; r < nrows; r += NGW) {
                const int wch = r >= SEQ; const float* md = modl + wch * 6144;
                f32x4 v[4];
                if (!moe) {
                    if (r < tail0) {
#pragma unroll
                        for (int j = 0; j < 4; ++j) v[j] = *(const f32x4*)(X + (size_t)r * DM + 4 * lane + 256 * j) * ALPHA + ld4bf(Yb + (size_t)r * DM + 4 * lane + 256 * j);
                    } else {
#pragma unroll
                        for (int j = 0; j < 4; ++j) { const int c = 4 * lane + 256 * j; f32x4 a4 = (f32x4){0.f, 0.f, 0.f, 0.f};
                            for (int p = 0; p < sp; ++p) a4 = a4 + *(const f32x4*)(YP + ((size_t)p * tp * 256 + (r - tail0)) * DM + c);
                            v[j] = *(const f32x4*)(X + (size_t)r * DM + c) * ALPHA + *(const f32x4*)(md + 5 * 1024 + c) * a4; }
                    }
                } else {
                    const int2 ee = WSP(int2, WS_TOKE)[r], pp = WSP(int2, WS_TOKP)[r]; const float2 ww = WSP(float2, WS_TOKW)[r];
                    int2 ss;
                    ss.x = 256 * (ee.x == 0 ? ts0 : ee.x == 1 ? ts1 : ee.x == 2 ? ts2 : ee.x == 3 ? ts3 : ee.x == 4 ? ts4 : ee.x == 5 ? ts5 : ee.x == 6 ? ts6 : ts7) + pp.x;
                    ss.y = 256 * (ee.y == 0 ? ts0 : ee.y == 1 ? ts1 : ee.y == 2 ? ts2 : ee.y == 3 ? ts3 : ee.y == 4 ? ts4 : ee.y == 5 ? ts5 : ee.y == 6 ? ts6 : ts7) + pp.y;
#pragma unroll
                    for (int j = 0; j < 4; ++j) { const int c = 4 * lane + 256 * j;
                        f32x4 y0, y1;
                        if (ss.x < tail0) y0 = ld4bf(YS + (size_t)ss.x * DM + c);
                        else { y0 = (f32x4){0.f, 0.f, 0.f, 0.f}; for (int p = 0; p < sp; ++p) y0 = y0 + *(const f32x4*)(YP + ((size_t)p * tp * 256 + (ss.x - tail0)) * DM + c); }
                        if (ss.y < tail0) y1 = ld4bf(YS + (size_t)ss.y * DM + c);
                        else { y1 = (f32x4){0.f, 0.f, 0.f, 0.f}; for (int p = 0; p < sp; ++p) y1 = y1 + *(const f32x4*)(YP + ((size_t)p * tp * 256 + (ss.y - tail0)) * DM + c); }
                        const f32x4 xv = *(const f32x4*)(X + (size_t)r * DM + c), g5 = *(const f32x4*)(md + 5 * 1024 + c);
                        v[j] = xv * ALPHA + g5 * (y0 * ww.x + y1 * ww.y); }
                }
                ln16(v, lw, lb, lane);
                if (lastl) {
#pragma unroll
                    for (int j = 0; j < 4; ++j) *(f32x4*)(ap->out + (size_t)r * DM + 4 * lane + 256 * j) = v[j];
                } else {
#pragma unroll
                    for (int j = 0; j < 4; ++j) *(f32x4*)(X + (size_t)r * DM + 4 * lane + 256 * j) = v[j];
                    const float* mdn = modl + 2 * 6144 + wch * 6144;
                    mod_store(v, mdn, mdn + 1024, H + (size_t)r * DM, lane);
                }
            }
            SEAM(pb + 9);
        }
    }
#undef IN
#undef SEAM
}

extern "C" void kernel_launch(void* const* d_in, const int* in_sizes, int n_in, void* d_out, int out_size, void* d_ws, size_t ws_size, hipStream_t stream) {
    static int grid = 0;
    if (grid == 0) {
        if (n_in != 22 || ws_size < WS_END) { fprintf(stderr, "kernel_launch: unexpected n_in %d / ws %zu (need %zu)\n", n_in, ws_size, (size_t)WS_END); grid = -1; return; }
        int dev = 0, cus = 0;
        if (hipGetDevice(&dev) != hipSuccess || hipDeviceGetAttribute(&cus, hipDeviceAttributeMultiprocessorCount, dev) != hipSuccess) { grid = -1; return; }
        if (hipFuncSetAttribute((const void*)fwd, hipFuncAttributeMaxDynamicSharedMemorySize, LDS_BYTES) != hipSuccess) { fprintf(stderr, "kernel_launch: hipFuncSetAttribute failed\n"); grid = -1; return; }
        int per_cu = 0;
        if (hipOccupancyMaxActiveBlocksPerMultiprocessor(&per_cu, (const void*)fwd, 512, LDS_BYTES) != hipSuccess || per_cu < 1) fprintf(stderr, "kernel_launch: occupancy query reports %d\n", per_cu);
        (void)hipGetLastError();
        grid = cus;
    }
    if (grid < 0) return;
    (void)hipMemsetAsync((char*)d_ws + WS_CTL, 0, CTL_BYTES, stream);
    Args a{};
    for (int i = 0; i < 22; ++i) a.in[i] = (const float*)d_in[i];
    a.out = (float*)d_out; a.ws = (unsigned char*)d_ws;
#if MK_ONE_LAUNCH
    a.ph_lo = 0; a.ph_hi = NPH;
    hipLaunchKernelGGL(fwd, dim3(grid), dim3(512), LDS_BYTES, stream, a);
#else
    for (int p = 0; p < NPH; ++p) {
        if (p >= 2 && ((p - 2) % 10) == 6 && ((((p - 2) / 10) & 1) == 0)) continue;
        a.ph_lo = p; a.ph_hi = p + 1;
        hipLaunchKernelGGL(fwd, dim3(grid), dim3(512), LDS_BYTES, stream, a);
    }
#endif
}
```

```cpp
#include <hip/hip_runtime.h>
#include <cstdio>
#include <cstdint>

#ifndef MK_ONE_LAUNCH
#define MK_ONE_LAUNCH 1
#endif

#ifndef DUP_MASK
#define DUP_MASK 0
#endif
#define PHASE_REP(k) for (int rep_ = 0; rep_ < 1 + ((DUP_MASK >> (k)) & 1); ++rep_)
#define LAS __attribute__((address_space(3)))
#define GAS __attribute__((address_space(1)))
typedef unsigned short bf16_t;
typedef short bf16x8 __attribute__((ext_vector_type(8)));
typedef float f32x4 __attribute__((ext_vector_type(4)));
typedef unsigned u32x4 __attribute__((ext_vector_type(4)));
typedef unsigned u32x2_t __attribute__((ext_vector_type(2)));

constexpr int DM = 1024, SEQ = 16384, NCTX = 256, TT = SEQ + NCTX, DEPTH = 4;
constexpr int IN_COLS = 2608, NPIN = 2816, LDP = 2816;
constexpr int C_MQ = 0, C_MK = 256, C_MV = 512, C_MO = 768, C_AQ = 1024, C_AK = 1536, C_AV = 1664, C_GQ = 1792, C_GK = 1920, C_GV = 2048, C_GG = 2304, C_MG = 2560, C_GGT = 2576, C_END = 2608;
constexpr int DFF = 2816, DEXP = 3584, NEXP = 8;
constexpr int NCH = 260;
constexpr int NSLOT = 138 * 256;
constexpr float ALPHA = 1.6817928305074290f;
constexpr float LN_EPS = 1e-5f;
constexpr float MGU_SCALE = 32.f, MDN_SCALE = 256.f, ACT_SCALE = 4.f;
constexpr int NPH = 2 + 10 * DEPTH;

constexpr size_t al256(size_t x) { return (x + 255) & ~size_t(255); }
constexpr size_t WS_CTL = 0, CTL_BYTES = 2u << 20;
constexpr size_t WS_MODS = 1u << 20;
constexpr size_t WS_ROPE = CTL_BYTES;
constexpr size_t WS_TOKE = WS_ROPE + 32768;
constexpr size_t WS_TOKP = WS_TOKE + al256((size_t)TT * 8);
constexpr size_t WS_TOKW = WS_TOKP + al256((size_t)TT * 8);
constexpr size_t WS_TOKS = WS_TOKW + al256((size_t)TT * 8);
constexpr size_t WS_WIN = WS_TOKS + al256((size_t)TT * 8);
constexpr size_t WS_WOUT = WS_WIN + (size_t)DEPTH * NPIN * DM * 2;
constexpr size_t WS_FGU = WS_WOUT + (size_t)DEPTH * DM * DM * 2;
constexpr size_t WS_FDN = WS_FGU + (size_t)2 * 2 * DFF * DM * 2;
constexpr size_t WS_MGU = WS_FDN + (size_t)2 * DM * DFF * 2;
constexpr size_t WS_MDN = WS_MGU + (size_t)16 * 2 * DEXP * DM * 2;
constexpr size_t WS_X = WS_MDN + (size_t)16 * DM * DEXP * 2;
constexpr size_t WS_H = WS_X + (size_t)TT * DM * 4;
constexpr size_t WS_P = WS_H + (size_t)TT * DM * 2;
constexpr size_t WS_G = WS_P + (size_t)TT * LDP * 2;
constexpr size_t WS_CAT = WS_G + al256((size_t)TT * 48 * 4);
constexpr size_t WS_Y = WS_CAT + (size_t)TT * DM * 2;
constexpr size_t WS_ACT = WS_Y + (size_t)TT * DM * 4;
constexpr size_t WS_XB = WS_ACT + (size_t)NSLOT * DEXP * 2;
constexpr size_t WS_YS = WS_XB + (size_t)NEXP * TT * DM * 2;
constexpr size_t WS_MU = WS_YS + (size_t)NSLOT * DM * 4;
constexpr size_t WS_MC = WS_MU + (size_t)8 * NCH * 4096 * 4;
constexpr size_t WS_MNU = WS_MC + (size_t)8 * NCH * 4096 * 4;
constexpr size_t WS_MNS = WS_MNU + (size_t)8 * NCH * 64 * 4;
constexpr size_t WS_MSC = WS_MNS + (size_t)8 * NCH * 64 * 4;
constexpr size_t WS_GU = WS_MSC + al256((size_t)8 * NCH * 4 * 4);
constexpr size_t WS_GS = WS_GU + (size_t)8 * NCH * 2048 * 4;
constexpr size_t WS_GDEC = WS_GS + (size_t)8 * NCH * 2048 * 4;
constexpr size_t WS_YP = WS_GDEC + (size_t)8 * NCH * 32 * 4;
constexpr size_t WS_END = WS_YP + (size_t)256 * 256 * 256 * 4;

constexpr int CW_BAR = 4096;
constexpr int CW_MOE = 16384;

constexpr int LDS_BYTES = 147456, MISC_OFF = 147200;

__device__ __forceinline__ float bf2f(unsigned v) { return __uint_as_float(v << 16); }
__device__ __forceinline__ unsigned f2bf(float f) { unsigned u = __float_as_uint(f); return (u + 0x7fffu + ((u >> 16) & 1u)) >> 16; }
__device__ __forceinline__ unsigned pk2(float lo, float hi) { return f2bf(lo) | (f2bf(hi) << 16); }
__device__ __forceinline__ void load8bf(const bf16_t* p, float* o) {
    const uint4 v = *(const uint4*)p;
    o[0] = __uint_as_float(v.x << 16); o[1] = __uint_as_float(v.x & 0xffff0000u); o[2] = __uint_as_float(v.y << 16); o[3] = __uint_as_float(v.y & 0xffff0000u);
    o[4] = __uint_as_float(v.z << 16); o[5] = __uint_as_float(v.z & 0xffff0000u); o[6] = __uint_as_float(v.w << 16); o[7] = __uint_as_float(v.w & 0xffff0000u);
}
__device__ __forceinline__ float wave_sum(float v) {
#pragma unroll
    for (int o = 1; o < 64; o <<= 1) v += __shfl_xor(v, o);
    return v;
}
__device__ __forceinline__ float wave_max(float v) {
#pragma unroll
    for (int o = 1; o < 64; o <<= 1) v = fmaxf(v, __shfl_xor(v, o));
    return v;
}
__device__ __forceinline__ float scan_add(float v, int lane) {
#pragma unroll
    for (int o = 1; o < 64; o <<= 1) { const float t = __shfl_up(v, o); if (lane >= o) v += t; }
    return v;
}
__device__ __forceinline__ float scan_max(float v, int lane) {
#pragma unroll
    for (int o = 1; o < 64; o <<= 1) { const float t = __shfl_up(v, o); if (lane >= o) v = fmaxf(v, t); }
    return v;
}
__device__ __forceinline__ float siluf(float x) { return x * __builtin_amdgcn_rcpf(1.f + __expf(-x)); }
__device__ __forceinline__ float sigmoidf_(float x) { return __builtin_amdgcn_rcpf(1.f + __expf(-x)); }
__device__ __forceinline__ float log_sigmoidf_(float x) {
    const float t = __expf(-fabsf(x)); const float l1p = (t < 0.01f) ? t * (1.f + t * (-0.5f + t * 0.33333333f)) : __logf(1.f + t); return fminf(x, 0.f) - l1p; }
typedef short s16x4 __attribute__((ext_vector_type(4)));
typedef short v4i16_t __attribute__((ext_vector_type(4)));
typedef float f32x2_t __attribute__((ext_vector_type(2))); typedef __bf16 bf16x2_t __attribute__((ext_vector_type(2)));
__device__ __forceinline__ unsigned cvtpk(float lo, float hi) { f32x2_t v = {lo, hi}; bf16x2_t b = __builtin_convertvector(v, bf16x2_t); return __builtin_bit_cast(unsigned, b); }
__device__ __forceinline__ s16x4 ds_tr16(const LAS unsigned char* p) { return __builtin_bit_cast(s16x4, __builtin_amdgcn_ds_read_tr16_b64_v4i16((LAS v4i16_t*)p)); }
__device__ __forceinline__ bf16x8 cat44(s16x4 a, s16x4 b) { return __builtin_shufflevector(a, b, 0, 1, 2, 3, 4, 5, 6, 7); }
#define MFMA16(a, b, c) __builtin_amdgcn_mfma_f32_16x16x32_bf16(a, b, c, 0, 0, 0)
__device__ __forceinline__ float grp_max(float v) {
    const auto a = __builtin_amdgcn_permlane16_swap(__float_as_uint(v), __float_as_uint(v), false, false); v = fmaxf(__uint_as_float(a[0]), __uint_as_float(a[1]));
    const auto b = __builtin_amdgcn_permlane32_swap(__float_as_uint(v), __float_as_uint(v), false, false); return fmaxf(__uint_as_float(b[0]), __uint_as_float(b[1])); }
__device__ __forceinline__ float grp_sum(float v) {
    const auto a = __builtin_amdgcn_permlane16_swap(__float_as_uint(v), __float_as_uint(v), false, false); v = __uint_as_float(a[0]) + __uint_as_float(a[1]);
    const auto b = __builtin_amdgcn_permlane32_swap(__float_as_uint(v), __float_as_uint(v), false, false); return __uint_as_float(b[0]) + __uint_as_float(b[1]); }
__device__ __forceinline__ unsigned pk4_fp8(float a, float b, float c, float d) { int w = 0; w = __builtin_amdgcn_cvt_pk_fp8_f32(a, b, w, false); w = __builtin_amdgcn_cvt_pk_fp8_f32(c, d, w, true); return (unsigned)w; }
#define LDS_WAIT() asm volatile("s_waitcnt lgkmcnt(0)" ::: "memory")

namespace pg8 {
constexpr int BM = 256, BK = 64, HALF = 128, HTB = HALF * BK * 2, STAGE_BYTES = 8 * HTB, NXCD = 8, WGM = 8;
__host__ __device__ __forceinline__ int lds_byte(int r, int c) { const int st = (r >> 4) * 2 + (c >> 5), rr = r & 15, cc = c & 31, ob = rr * 64 + cc * 2; return st * 1024 + (ob ^ (((ob >> 9) & 1) << 5)); }
__host__ __device__ __forceinline__ void stage_rc(int b, int& R, int& C) { const int st = b / 1024, sb = b % 1024, swz = sb ^ (((sb >> 9) & 1) << 5); R = (st >> 1) * 16 + swz / 64; C = (st & 1) * 32 + (swz % 64) / 2; }
__host__ __device__ __forceinline__ int perm32(int rho) { const int n = rho >> 4, i = rho & 15; return 8 * (i >> 2) + 4 * n + (i & 3); }
struct Unit { int pm, pn, kt0, nkt, part; };

struct StaticOrder {
    const char* A; const char* Bt; int K;
    int nM, nN, nwg, G, c;
    __device__ void init(const void* A_, const void* Bt_, int K_, int M, int N, int G_, int c_) { A = (const char*)A_; Bt = (const char*)Bt_; K = K_; nM = M / BM; nN = N / BM; nwg = nM * nN; G = G_; c = c_; }
    __device__ __forceinline__ bool next(int i, Unit& u) const {
        const long L = (long)i * G + c; if (L >= nwg) return false;
        int wgid = (int)L; { const int q = nwg / NXCD, r = nwg % NXCD, xcd = wgid % NXCD, off = wgid / NXCD; wgid = (xcd < r ? xcd * (q + 1) : r * (q + 1) + (xcd - r) * q) + off; }
        const int nig = WGM * nN, gid = wgid / nig, fm = gid * WGM, gsz = (nM - fm) < WGM ? (nM - fm) : WGM;
        u.pm = fm + ((wgid % nig) % gsz); u.pn = (wgid % nig) / gsz; u.kt0 = 0; u.nkt = K / BK; u.part = -1; return true;
    }
    __device__ __forceinline__ unsigned aoff(const Unit& u) const { return (unsigned)(u.pm * BM * K * 2); }
    __device__ __forceinline__ unsigned boff(const Unit& u) const { return (unsigned)(u.pn * BM * K * 2); }
};
struct MoeOrder {
    const char* A; const char* Bt; int K, N, nN, ntile, G, c;
    int ts1, ts2, ts3, ts4, ts5, ts6, ts7;
    __device__ __forceinline__ bool next(int i, Unit& u) const {
        const long L = (long)i * G + c; if (L >= (long)ntile * nN) return false;
        u.pm = (int)(L / nN); u.pn = (int)(L % nN); u.kt0 = 0; u.nkt = K / BK; u.part = -1; return true;
    }
    __device__ __forceinline__ int expert(int pm) const { return (pm >= ts1) + (pm >= ts2) + (pm >= ts3) + (pm >= ts4) + (pm >= ts5) + (pm >= ts6) + (pm >= ts7); }
    __device__ __forceinline__ unsigned aoff(const Unit& u) const {
        const int e = expert(u.pm); const int t0 = e == 0 ? 0 : e == 1 ? ts1 : e == 2 ? ts2 : e == 3 ? ts3 : e == 4 ? ts4 : e == 5 ? ts5 : e == 6 ? ts6 : ts7;
        return (unsigned)((e * TT + (u.pm - t0) * BM) * K * 2); }
    __device__ __forceinline__ unsigned boff(const Unit& u) const { return (unsigned)((expert(u.pm) * N + u.pn * BM) * K * 2); }
};
struct TailOrder {
    const char* A; const char* Bt; int K, N, nN, npan, G, c, tp, s;
    int ts1, ts2, ts3, ts4, ts5, ts6, ts7;
    __device__ __forceinline__ void dense(const void* A_, const void* Bt_, int K_, int N_, int npan_, int G_, int c_, int tp_, int s_) {
        A = (const char*)A_; Bt = (const char*)Bt_; K = K_; N = N_; nN = N_ / BM; npan = npan_; G = G_; c = c_; tp = tp_; s = s_;
        ts1 = ts2 = ts3 = ts4 = ts5 = ts6 = ts7 = 0x7fffffff; }
    __device__ __forceinline__ bool next(int i, Unit& u) const {
        const int L = i * G + c, nfull = (npan - tp) * nN, ksub = (K / BK) / s;
        const bool tail = L >= nfull; const int j = L - nfull, tu = tp * nN, tu1 = tu > 0 ? tu : 1;
        const int part = tail ? j / tu1 : -1, r = tail ? j % tu1 : 0;
        u.part = part; u.pm = tail ? (npan - tp) + r / nN : L / nN; u.pn = tail ? r % nN : L % nN; u.kt0 = tail ? part * ksub : 0; u.nkt = tail ? ksub : K / BK;
        return tail ? (j < tu * s) : true;
    }
    __device__ __forceinline__ int expert(int pm) const { return (pm >= ts1) + (pm >= ts2) + (pm >= ts3) + (pm >= ts4) + (pm >= ts5) + (pm >= ts6) + (pm >= ts7); }
    __device__ __forceinline__ unsigned aoff(const Unit& u) const { return (unsigned)((u.pm * BM * K + u.kt0 * BK) * 2); }
    __device__ __forceinline__ unsigned boff(const Unit& u) const { return (unsigned)((((expert(u.pm) * N + u.pn * BM) * K) + u.kt0 * BK) * 2); }
};
__device__ __forceinline__ void tail_params(int npan, int nN, int nkt, int G, int& tp, int& s) {
    const int rem = (npan * nN) % G;
    tp = 0; s = 1;
    if (rem == 0 || (rem % nN) != 0) return;
    int best = 1;
    if (nkt == 16) { if (rem * 4 <= G) best = 4; else if (rem * 2 <= G) best = 2; }
    else if (nkt == 44) { if (rem * 11 <= G) best = 11; else if (rem * 2 <= G) best = 2; }
    else if (nkt == 28) { if (rem * 7 <= G) best = 7; else if (rem * 2 <= G) best = 2; }
    else if (nkt == 56) { if (rem * 14 <= G) best = 14; else if (rem * 7 <= G) best = 7; else if (rem * 4 <= G) best = 4; else if (rem * 2 <= G) best = 2; }
    if (best > 1) { tp = rem / nN; s = best; }
}

typedef int v8i32 __attribute__((ext_vector_type(8)));
typedef int i32x4 __attribute__((ext_vector_type(4)));
template <class Epi, class Sched, bool F8 = false>
__device__ __forceinline__ void gemm_phase(LAS unsigned char* lds, const int K, const Sched& S, const Epi& E, const int tid) {
    const int wid = __builtin_amdgcn_readfirstlane(tid >> 6), lane = tid & 63, wr = wid >> 2, wc = wid & 3, fr = lane & 15, fq = lane >> 4;
    unsigned voffA[2], voffB[2];
#pragma unroll
    for (int i = 0; i < 2; ++i) { int R, C; stage_rc(tid * 16 + i * 8192, R, C); const int Rb = Epi::PERM ? ((R & ~31) + perm32(R & 31)) : R;
        voffA[i] = (unsigned)(R * K + C) * 2u; voffB[i] = (unsigned)(Rb * K + C) * 2u; }
    const unsigned kstep = (unsigned)(BK * 2);
    const unsigned hstep = (unsigned)(HALF * K * 2);
    const __amdgpu_buffer_rsrc_t rA = __builtin_amdgcn_make_buffer_rsrc((void*)S.A, 0, 0x7ffffff0, 0x00020000), rB = __builtin_amdgcn_make_buffer_rsrc((void*)S.Bt, 0, 0x7ffffff0, 0x00020000);
    const unsigned ldsw = (unsigned)wid * 1024u;
    const int aoff = lds_byte(wr * 64 + fr, fq * 8), boff = lds_byte(wc * 32 + fr, fq * 8);
#define PG8_SA(b, h) (((b) * 2 + (h)) * HTB)
#define PG8_SB(b, h) ((4 + (b) * 2 + (h)) * HTB)
#define PG8_STAGE(bufoff, rs, soff, voff) do { _Pragma("unroll") for (int _i = 0; _i < 2; ++_i) \
        __builtin_amdgcn_raw_ptr_buffer_load_lds(rs, (LAS void*)(lds + (bufoff) + ldsw + _i * 8192), 16, (int)(voff)[_i], (int)(soff), 0, 0); } while (0)
#define PG8_LDA(dst, b, h) do { _Pragma("unroll") for (int m = 0; m < 4; ++m) { const i32x4 lo_ = *(const LAS i32x4*)(lds + PG8_SA(b, h) + aoff + m * 2048), hi_ = *(const LAS i32x4*)(lds + PG8_SA(b, h) + aoff + m * 2048 + 1024); \
        dst[m] = (v8i32){lo_[0], lo_[1], lo_[2], lo_[3], hi_[0], hi_[1], hi_[2], hi_[3]}; } } while (0)
#define PG8_LDB(dst, b, h) do { _Pragma("unroll") for (int n = 0; n < 2; ++n) { const i32x4 lo_ = *(const LAS i32x4*)(lds + PG8_SB(b, h) + boff + n * 2048), hi_ = *(const LAS i32x4*)(lds + PG8_SB(b, h) + boff + n * 2048 + 1024); \
        dst[n] = (v8i32){lo_[0], lo_[1], lo_[2], lo_[3], hi_[0], hi_[1], hi_[2], hi_[3]}; } } while (0)
#define PG8_LO(v) __builtin_bit_cast(bf16x8, __builtin_shufflevector(v, v, 0, 1, 2, 3))
#define PG8_HI(v) __builtin_bit_cast(bf16x8, __builtin_shufflevector(v, v, 4, 5, 6, 7))
#define PG8_MMA(ai, bj, At, Bt) do { __builtin_amdgcn_s_setprio(1); _Pragma("unroll") for (int m = 0; m < 4; ++m) _Pragma("unroll") for (int n = 0; n < 2; ++n) { \
        if constexpr (F8) acc[ai][bj][m][n] = __builtin_amdgcn_mfma_scale_f32_16x16x128_f8f6f4(Bt[n], At[m], acc[ai][bj][m][n], 0, 0, 0, 0x7f7f7f7f, 0, 0x7f7f7f7f); \
        else { acc[ai][bj][m][n] = __builtin_amdgcn_mfma_f32_16x16x32_bf16(PG8_LO(Bt[n]), PG8_LO(At[m]), acc[ai][bj][m][n], 0, 0, 0); \
               acc[ai][bj][m][n] = __builtin_amdgcn_mfma_f32_16x16x32_bf16(PG8_HI(Bt[n]), PG8_HI(At[m]), acc[ai][bj][m][n], 0, 0, 0); } } \
        __builtin_amdgcn_s_setprio(0); } while (0)
#define PG8_WAIT_V(n) asm volatile("s_waitcnt vmcnt(" #n ")" ::: "memory")
#define PG8_WAIT_L(n) asm volatile("s_waitcnt lgkmcnt(" #n ")" ::: "memory")
#define PG8_BAR __builtin_amdgcn_s_barrier()
#define PG8_SCHED __builtin_amdgcn_sched_barrier(0)
    Unit cur, nxt; int ui = 0;
    if (!S.next(0, cur)) return;
    f32x4 acc[2][2][4][2];
#pragma unroll
    for (int a = 0; a < 2; ++a)
#pragma unroll
        for (int b = 0; b < 2; ++b)
#pragma unroll
            for (int m = 0; m < 4; ++m)
#pragma unroll
                for (int n = 0; n < 2; ++n) acc[a][b][m][n] = (f32x4){0.f, 0.f, 0.f, 0.f};
    v8i32 At[4], B0[2], B1[2];
    unsigned cA = S.aoff(cur), cB = S.boff(cur);
    PG8_STAGE(PG8_SB(0, 0), rB, cB, voffB); PG8_STAGE(PG8_SB(0, 1), rB, cB + hstep, voffB); PG8_STAGE(PG8_SA(0, 0), rA, cA, voffA); PG8_STAGE(PG8_SA(0, 1), rA, cA + hstep, voffA);
    if (wr == 1) PG8_BAR;
    PG8_WAIT_V(2); PG8_BAR;
    PG8_STAGE(PG8_SB(1, 0), rB, cB + kstep, voffB); PG8_STAGE(PG8_SA(1, 0), rA, cA + kstep, voffA); PG8_STAGE(PG8_SB(1, 1), rB, cB + hstep + kstep, voffB);
    PG8_WAIT_V(6); PG8_BAR;
    for (;;) {
        const bool has_next = S.next(ui + 1, nxt);
        const unsigned nA = has_next ? S.aoff(nxt) : cA, nB = has_next ? S.boff(nxt) : cB;
        const int nt = cur.nkt;
        for (int t = 0; t < nt; t += 2) {
            const bool last = (t == nt - 2);
            const unsigned a1 = cA + (unsigned)(t + 1) * kstep;
            const unsigned a2 = last ? nA : cA + (unsigned)(t + 2) * kstep, b2 = last ? nB : cB + (unsigned)(t + 2) * kstep;
            const unsigned a3 = a2 + kstep, b3 = b2 + kstep;
            PG8_LDB(B0, 0, 0); PG8_LDB(B1, 0, 1); PG8_SCHED; PG8_LDA(At, 0, 0); PG8_STAGE(PG8_SA(1, 1), rA, a1 + hstep, voffA);
            PG8_WAIT_V(8); PG8_WAIT_L(0); PG8_BAR; PG8_MMA(0, 0, At, B0); PG8_MMA(0, 1, At, B1); PG8_BAR; PG8_SCHED;
            PG8_LDA(At, 0, 1); PG8_STAGE(PG8_SB(0, 0), rB, b2, voffB); PG8_STAGE(PG8_SB(0, 1), rB, b2 + hstep, voffB); PG8_STAGE(PG8_SA(0, 0), rA, a2, voffA);
            PG8_WAIT_V(8); PG8_WAIT_L(0); PG8_BAR; PG8_MMA(1, 0, At, B0); PG8_MMA(1, 1, At, B1); PG8_BAR; PG8_SCHED;
            PG8_LDB(B0, 1, 0); PG8_LDB(B1, 1, 1); PG8_SCHED; PG8_LDA(At, 1, 0); PG8_STAGE(PG8_SA(0, 1), rA, a2 + hstep, voffA);
            PG8_WAIT_V(8); PG8_WAIT_L(0); PG8_BAR; PG8_MMA(0, 0, At, B0); PG8_MMA(0, 1, At, B1); PG8_BAR; PG8_SCHED;
            PG8_LDA(At, 1, 1); PG8_STAGE(PG8_SB(1, 0), rB, b3, voffB); PG8_STAGE(PG8_SB(1, 1), rB, b3 + hstep, voffB); PG8_STAGE(PG8_SA(1, 0), rA, a3, voffA);
            PG8_WAIT_V(8); PG8_WAIT_L(0); PG8_BAR; PG8_MMA(1, 0, At, B0); PG8_MMA(1, 1, At, B1); PG8_BAR; PG8_SCHED;
        }
        if (wr == 0) PG8_BAR;
        { unsigned on_ = ~0u; asm volatile("" : "+s"(on_)); const int l2_ = (int)__builtin_amdgcn_mbcnt_hi(on_, __builtin_amdgcn_mbcnt_lo(on_, 0u));
          E(acc, cur, wr, wc, l2_ & 15, l2_ >> 4); }
        if (!has_next) break;
#pragma unroll
        for (int a = 0; a < 2; ++a)
#pragma unroll
            for (int b = 0; b < 2; ++b)
#pragma unroll
                for (int m = 0; m < 4; ++m)
#pragma unroll
                    for (int n = 0; n < 2; ++n) acc[a][b][m][n] = (f32x4){0.f, 0.f, 0.f, 0.f};
        cur = nxt; cA = nA; cB = nB; ++ui;
        if (wr == 1) PG8_BAR;
    }
    PG8_WAIT_V(0);
    PG8_BAR;
#undef PG8_SA
#undef PG8_SB
#undef PG8_STAGE
#undef PG8_LDA
#undef PG8_LDB
#undef PG8_MMA
#undef PG8_WAIT_V
#undef PG8_WAIT_L
#undef PG8_BAR
#undef PG8_SCHED
}


struct EpiInProj {
    static constexpr bool PERM = true;
    bf16_t* P; float* Gt; const float* ropeC; const float* ropeS;
    __device__ __forceinline__ void operator()(const f32x4 (&acc)[2][2][4][2], const Unit& u, int wr, int wc, int fr, int fq) const {
        const int row0 = u.pm * BM + wr * 64 + fr;
        const bool latent = u.pm < (SEQ / BM);
#pragma unroll
        for (int bj = 0; bj < 2; ++bj) {
            const int colg = u.pn * BM + bj * HALF + wc * 32;
            const bool rope = latent && colg >= C_AQ && colg < C_AV;
            const bool gate = colg >= C_MG && colg < C_END;
            const int col0 = colg + 8 * fq;
#pragma unroll
            for (int ai = 0; ai < 2; ++ai)
#pragma unroll
                for (int m = 0; m < 4; ++m) {
                    const int row = row0 + ai * HALF + m * 16;
                    f32x4 v0 = acc[ai][bj][m][0], v1 = acc[ai][bj][m][1];
                    if (rope) {
                        const int pos = ((colg >> 5) & 1) ? (row & 63) : (row >> 6);
                        const f32x4 c0 = *(const f32x4*)(ropeC + pos * 16 + 8 * (fq & 1)), c1 = *(const f32x4*)(ropeC + pos * 16 + 8 * (fq & 1) + 4);
                        const f32x4 s0 = *(const f32x4*)(ropeS + pos * 16 + 8 * (fq & 1)), s1 = *(const f32x4*)(ropeS + pos * 16 + 8 * (fq & 1) + 4);
                        const float sg = (fq < 2) ? -1.f : 1.f;
                        f32x4 p0, p1;
#pragma unroll
                        for (int i = 0; i < 4; ++i) { p0[i] = __shfl_xor(v0[i], 32); p1[i] = __shfl_xor(v1[i], 32); }
#pragma unroll
                        for (int i = 0; i < 4; ++i) { v0[i] = v0[i] * c0[i] + sg * p0[i] * s0[i]; v1[i] = v1[i] * c1[i] + sg * p1[i] * s1[i]; }
                    }
                    u32x4 w; w.x = cvtpk(v0[0], v0[1]); w.y = cvtpk(v0[2], v0[3]); w.z = cvtpk(v1[0], v1[1]); w.w = cvtpk(v1[2], v1[3]);
                    *(u32x4*)(P + (size_t)row * LDP + col0) = w;
                    if (gate && col0 < C_END) { float* g = Gt + (size_t)row * 48 + (col0 - C_MG); *(f32x4*)g = v0; *(f32x4*)(g + 4) = v1; }
                    asm volatile("" ::: "memory");
                }
        }
    }
};
struct EpiResid {
    static constexpr bool PERM = true;
    bf16_t* Yb; const float* modl; const float* modc; float* YP; int tail_row0, tail_rows;
    __device__ __forceinline__ void operator()(const f32x4 (&acc)[2][2][4][2], const Unit& u, int wr, int wc, int fr, int fq) const {
        const int row0 = u.pm * BM + wr * 64 + fr, col0 = u.pn * BM + wc * 32 + 8 * fq;
        if (u.part >= 0) {
#pragma unroll
            for (int ai = 0; ai < 2; ++ai)
#pragma unroll
                for (int m = 0; m < 4; ++m) { float* rowp = YP + ((size_t)u.part * tail_rows + (row0 + ai * HALF + m * 16 - tail_row0)) * DM + col0;
#pragma unroll
                    for (int bj = 0; bj < 2; ++bj)
#pragma unroll
                        for (int n = 0; n < 2; ++n) *(f32x4*)(rowp + bj * HALF + n * 4) = acc[ai][bj][m][n]; }
            return;
        }
        const float* md = (u.pm < SEQ / BM) ? modl : modc;
        f32x4 mv[2][2];
#pragma unroll
        for (int bj = 0; bj < 2; ++bj)
#pragma unroll
            for (int n = 0; n < 2; ++n) mv[bj][n] = *(const f32x4*)(md + col0 + bj * HALF + n * 4);
#pragma unroll
        for (int ai = 0; ai < 2; ++ai)
#pragma unroll
            for (int m = 0; m < 4; ++m) { bf16_t* rowp = Yb + (size_t)(row0 + ai * HALF + m * 16) * DM + col0;
#pragma unroll
                for (int bj = 0; bj < 2; ++bj) { const f32x4 v0 = mv[bj][0] * acc[ai][bj][m][0], v1 = mv[bj][1] * acc[ai][bj][m][1];
                    u32x4 w; w.x = cvtpk(v0[0], v0[1]); w.y = cvtpk(v0[2], v0[3]); w.z = cvtpk(v1[0], v1[1]); w.w = cvtpk(v1[2], v1[3]);
                    *(u32x4*)(rowp + bj * HALF) = w; } }
    }
};
template <bool O8 = false> struct EpiSwigluT {
    static constexpr bool PERM = true;
    bf16_t* O; int ld; float sc; float osc;
    __device__ __forceinline__ void operator()(const f32x4 (&acc)[2][2][4][2], const Unit& u, int wr, int wc, int fr, int fq) const {
        const int row0 = u.pm * BM + wr * 64 + fr, col0 = u.pn * HALF + wc * 32 + 8 * fq;
#pragma unroll
        for (int ai = 0; ai < 2; ++ai)
#pragma unroll
            for (int m = 0; m < 4; ++m) {
                const f32x4 g0 = acc[ai][0][m][0], g1 = acc[ai][0][m][1], u0 = acc[ai][1][m][0], u1 = acc[ai][1][m][1];
                float r[8];
#pragma unroll
                for (int i = 0; i < 4; ++i) { r[i] = siluf(g0[i] * sc) * (u0[i] * sc); r[4 + i] = siluf(g1[i] * sc) * (u1[i] * sc); }
                if constexpr (O8) { uint2 w; w.x = pk4_fp8(r[0] * osc, r[1] * osc, r[2] * osc, r[3] * osc); w.y = pk4_fp8(r[4] * osc, r[5] * osc, r[6] * osc, r[7] * osc);
                    *(uint2*)((unsigned char*)O + (size_t)(row0 + ai * HALF + m * 16) * ld + col0) = w; }
                else { u32x4 w; w.x = cvtpk(r[0], r[1]); w.y = cvtpk(r[2], r[3]); w.z = cvtpk(r[4], r[5]); w.w = cvtpk(r[6], r[7]);
                    *(u32x4*)(O + (size_t)(row0 + ai * HALF + m * 16) * ld + col0) = w; }
            }
    }
};
typedef EpiSwigluT<false> EpiSwiglu;
struct EpiRaw {
    static constexpr bool PERM = true;
    bf16_t* C; float* YP; int tail_row0, tail_rows; float sc;
    __device__ __forceinline__ void operator()(const f32x4 (&acc)[2][2][4][2], const Unit& u, int wr, int wc, int fr, int fq) const {
        const int row0 = u.pm * BM + wr * 64 + fr, col0 = u.pn * BM + wc * 32 + 8 * fq;
        if (u.part >= 0) {
#pragma unroll
            for (int ai = 0; ai < 2; ++ai)
#pragma unroll
                for (int m = 0; m < 4; ++m) { float* rowp = YP + ((size_t)u.part * tail_rows + (row0 + ai * HALF + m * 16 - tail_row0)) * DM + col0;
#pragma unroll
                    for (int bj = 0; bj < 2; ++bj)
#pragma unroll
                        for (int n = 0; n < 2; ++n) *(f32x4*)(rowp + bj * HALF + n * 4) = acc[ai][bj][m][n] * sc; }
            return;
        }
#pragma unroll
        for (int ai = 0; ai < 2; ++ai)
#pragma unroll
            for (int m = 0; m < 4; ++m) { bf16_t* rowp = C + (size_t)(row0 + ai * HALF + m * 16) * DM + col0;
#pragma unroll
                for (int bj = 0; bj < 2; ++bj) { const f32x4 v0 = acc[ai][bj][m][0] * sc, v1 = acc[ai][bj][m][1] * sc;
                    u32x4 w; w.x = cvtpk(v0[0], v0[1]); w.y = cvtpk(v0[2], v0[3]); w.z = cvtpk(v1[0], v1[1]); w.w = cvtpk(v1[2], v1[3]);
                    *(u32x4*)(rowp + bj * HALF) = w; } }
    }
};
}

#define XB_TMO      128
#define XB_XCNT(j)  (256  + 64 * (j))
#define XB_XSUB(j)  (1280 + 64 * (j))
#define XB_XGEN(j)  (2304 + 64 * (j))
#define XB_TOP      3328
#define XB_TOPGEN   3392
#define XCD_BAR_WORDS 3456
#define XB_SPIN_CAP (1u << 18)
__device__ __forceinline__ unsigned xb_ld(unsigned* p)              { return __hip_atomic_load(p, __ATOMIC_RELAXED, __HIP_MEMORY_SCOPE_AGENT); }
__device__ __forceinline__ unsigned xb_add(unsigned* p, unsigned v) { return __hip_atomic_fetch_add(p, v, __ATOMIC_RELAXED, __HIP_MEMORY_SCOPE_AGENT); }
__device__ __forceinline__ unsigned xb_xcc_id() { return (unsigned)__builtin_amdgcn_s_getreg((3 << 11) | 20) & 0xFu; }
#define XB_SPIN(cond, bar) do { unsigned _sp = 0; while (cond) { __builtin_amdgcn_s_sleep(1); \
    if ((++_sp & 255u) == 0u) { if (xb_ld(&(bar)[XB_TMO])) break; if (_sp > XB_SPIN_CAP) { atomicAdd(&(bar)[XB_TMO], 1u); break; } } } } while (0)
struct XcdBarrier { unsigned* bar; unsigned x; volatile LAS unsigned* st; };
__device__ __forceinline__ XcdBarrier xcd_barrier_post(unsigned* bar, volatile LAS unsigned* st) {
    XcdBarrier b; b.bar = bar; b.x = xb_xcc_id(); b.st = st;
    if (threadIdx.x == 0) (void)xb_add(&bar[XB_XCNT(b.x)], 1u);
    return b;
}
__device__ __forceinline__ void xcd_barrier_complete(unsigned* bar, unsigned x, unsigned& nloc, unsigned& nx) {
    const unsigned G = gridDim.x * gridDim.y * gridDim.z;
    unsigned sum, cnt, mine, sp = 0u;
    for (;;) {
        sum = 0u; cnt = 0u; mine = 0u;
#pragma unroll
        for (unsigned j = 0; j < 16; ++j) { const unsigned c = xb_ld(&bar[XB_XCNT(j)]); sum += c; cnt += (c > 0u) ? 1u : 0u; mine = (j == x) ? c : mine; }
        if (sum == G) break;
        __builtin_amdgcn_s_sleep(1);
        if ((++sp & 255u) == 0u) { if (xb_ld(&bar[XB_TMO])) break; if (sp > XB_SPIN_CAP) { atomicAdd(&bar[XB_TMO], 1u); break; } }
    }
    nloc = mine > 0u ? mine : 1u; nx = cnt > 0u ? cnt : 1u;
}
__device__ __forceinline__ void xcd_barrier(const XcdBarrier& b) {
    asm volatile("s_waitcnt vmcnt(0)" ::: "memory");
    __syncthreads();
    if (threadIdx.x == 0) {
        unsigned* bar = b.bar;
        __builtin_amdgcn_s_waitcnt(0);
        unsigned nloc = b.st[0], nx = b.st[1];
        if (nloc == 0u) { xcd_barrier_complete(bar, b.x, nloc, nx); b.st[0] = nloc; b.st[1] = nx; }
        const unsigned old = xb_add(&bar[XB_XSUB(b.x)], 1u);
        const unsigned gen = old / nloc;
        if (old + 1u == (gen + 1u) * nloc) {
            __builtin_amdgcn_fence(__ATOMIC_RELEASE, "agent");
            asm volatile("s_waitcnt vmcnt(0)" ::: "memory");
            const unsigned og = xb_add(&bar[XB_TOP], 1u);
            const unsigned tg = og / nx;
            if (og + 1u == (tg + 1u) * nx) xb_add(&bar[XB_TOPGEN], 1u);
            else XB_SPIN(xb_ld(&bar[XB_TOPGEN]) == tg, bar);
            __builtin_amdgcn_fence(__ATOMIC_ACQUIRE, "agent");
            xb_add(&bar[XB_XGEN(b.x)], 1u);
            asm volatile("s_waitcnt vmcnt(0)" ::: "memory");
        } else {
            XB_SPIN(xb_ld(&bar[XB_XGEN(b.x)]) == gen, bar);
            __builtin_amdgcn_fence(__ATOMIC_ACQUIRE, "agent");
            asm volatile("s_waitcnt vmcnt(0)" ::: "memory");
        }
    }
    __syncthreads();
}

struct Args { const float* in[22]; float* out; unsigned char* ws; int ph_lo, ph_hi; };

__device__ __forceinline__ int in_srccol(int r, float& sc) {
    sc = 1.f;
    if (r < 1024) { if (r >= C_MK && r < C_MV) sc = 0.125f; return r; }
    if (r < C_MG) { if (r < C_AK) sc = 0.125f * 1.4426950408889634f; else if (r >= C_GQ && r < C_GK) sc = 0.17677669529663687f; return r + 16; }
    if (r < C_GGT) return r - C_MG + 1024;
    if (r < C_END) return r;
    return -1;
}
template <bool F8 = false>
__device__ __forceinline__ void tr_item(const float* W, int K, int N, int NP, bf16_t* WT, int mode, int half, LAS float* scr, int item, int lane, float f8scale = 1.f) {
    const int nblk = NP >> 6, kb = item / nblk, nb = item - kb * nblk, k0 = kb << 6, n0 = nb << 6;
    const int r = n0 + lane; float sc = 1.f; int src;
    if (mode == 0) src = r; else if (mode == 1) src = in_srccol(r, sc); else { const int pn = r >> 8, w = r & 255; src = (w < 128) ? (pn * 128 + w) : (half + pn * 128 + w - 128); }
    if (F8) sc = f8scale;
    const float* wp = W + (size_t)k0 * N + (src < 0 ? 0 : src);
#pragma unroll 16
    for (int i = 0; i < 64; ++i) { const float v = wp[(size_t)i * N]; scr[i * 65 + lane] = (src < 0) ? 0.f : v * sc; }
    LDS_WAIT();
    const int c = lane & 7;
#pragma unroll
    for (int j = 0; j < 8; ++j) { const int n = (lane >> 3) + 8 * j; const LAS float* s = scr + (8 * c) * 65 + n;
        if constexpr (F8) { uint2 o; o.x = pk4_fp8(s[0], s[65], s[130], s[195]); o.y = pk4_fp8(s[260], s[325], s[390], s[455]); *(uint2*)((unsigned char*)WT + (size_t)(n0 + n) * K + k0 + 8 * c) = o; }
        else { uint4 o; o.x = pk2(s[0], s[65]); o.y = pk2(s[130], s[195]); o.z = pk2(s[260], s[325]); o.w = pk2(s[390], s[455]);
        *(uint4*)(WT + (size_t)(n0 + n) * K + k0 + 8 * c) = o; } }
    LDS_WAIT();
}

__device__ __forceinline__ void tr_item_f8_wg(LAS unsigned char* lds, const float* __restrict__ W, int K, int N, int NP, unsigned char* __restrict__ WT, int mode, int half, int item, int tid, int lane, int wave, float sc) {
    constexpr int RS = 136;
    const int nblk = NP >> 8, kb = item / nblk, nb = item - kb * nblk, k0 = kb << 7, nb0 = nb << 8, n0 = nb0 + 4 * lane;
    int src = n0;
    if (mode == 2) { const int pn = n0 >> 8, w = n0 & 255; src = (w < 128) ? (pn * 128 + w) : (half + pn * 128 + w - 128); }
    f32x4 v[2][8];
#pragma unroll
    for (int q = 0; q < 2; ++q)
#pragma unroll
        for (int i = 0; i < 8; ++i) v[q][i] = *(const f32x4*)(W + (size_t)(k0 + (wave * 2 + q) * 8 + i) * N + src);
    __syncthreads();
#pragma unroll
    for (int q = 0; q < 2; ++q)
#pragma unroll
        for (int e = 0; e < 4; ++e) { u32x2_t o; o.x = pk4_fp8(v[q][0][e] * sc, v[q][1][e] * sc, v[q][2][e] * sc, v[q][3][e] * sc); o.y = pk4_fp8(v[q][4][e] * sc, v[q][5][e] * sc, v[q][6][e] * sc, v[q][7][e] * sc);
            *(LAS u32x2_t*)(lds + (4 * lane + e) * RS + (wave * 2 + q) * 8) = o; }
    __syncthreads();
#pragma unroll
    for (int j = 0; j < 4; ++j) { const int idx = tid + 512 * j, r = idx >> 3, ch = idx & 7;
        *(u32x4*)(WT + (size_t)(nb0 + r) * K + k0 + ch * 16) = *(const LAS u32x4*)(lds + r * RS + ch * 16); }
}

__device__ __forceinline__ void chunk_rows(int d, int jc, int& base, int& step) {
    int oc;
    if (d == 0) oc = (jc < 4) ? 256 + jc : jc - 4; else oc = (jc < 4) ? 256 + (3 - jc) : 255 - (jc - 4);
    const int b0 = (oc < 256) ? oc * 64 : SEQ + (oc - 256) * 64;
    if (d == 0) { base = b0; step = 1; } else { base = b0 + 63; step = -1; }
}
__device__ __forceinline__ int oc_to_jc(int d, int oc) { if (d == 0) return oc < 256 ? oc + 4 : oc - 256; return oc < 256 ? 4 + (255 - oc) : 3 - (oc - 256); }

constexpr int AT_RS = 144, AT_TILE = 128 * AT_RS;
__device__ __forceinline__ void attn_unit(LAS unsigned char* lds, const bf16_t* P, bf16_t* CAT, int qb  , int cqb, int kvh, const float* sink, int tid, int lane, int wave) {
    const bool is_ctx = qb < 0;
    const int g = lane >> 4, i = lane & 15;
    const int hq = kvh * 4 + (wave >> 1), qh = wave & 1;
    const int qrow0 = (is_ctx ? SEQ + cqb * 128 : qb * 128) + qh * 64;
    bf16x8 bq[4][2];
#pragma unroll
    for (int qt = 0; qt < 4; ++qt)
#pragma unroll
        for (int ks = 0; ks < 2; ++ks) bq[qt][ks] = *(const bf16x8*)(P + (size_t)(qrow0 + 16 * qt + i) * LDP + C_AQ + hq * 64 + 32 * ks + 8 * g);
    f32x4 O[4][4];
#pragma unroll
    for (int dt = 0; dt < 4; ++dt)
#pragma unroll
        for (int qt = 0; qt < 4; ++qt) O[dt][qt] = (f32x4){0.f, 0.f, 0.f, 0.f};
    float m[4], l[4];
    { const float sk = sink[hq] * 1.4426950408889634f;
#pragma unroll
      for (int qt = 0; qt < 4; ++qt) { m[qt] = sk; l[qt] = (g == 0) ? 1.f : 0.f; } }
#define AT_VALID(c) ((c) >= 3 || (!is_ctx && (qb - 1 + (c)) >= 0 && (qb - 1 + (c)) < SEQ / 128))
#define AT_ROW(c) ((c) >= 3 ? SEQ + ((c) - 3) * 128 : (qb - 1 + (c)) * 128)
    u32x4 kreg[2], vreg[2];
    int c = 0; while (!AT_VALID(c)) ++c;
#pragma unroll
    for (int t = 0; t < 2; ++t) { const int idx = tid + 512 * t, r = idx >> 3, ch = idx & 7; const bf16_t* src = P + (size_t)(AT_ROW(c) + r) * LDP + kvh * 64 + ch * 8;
        kreg[t] = *(const u32x4*)(src + C_AK); vreg[t] = *(const u32x4*)(src + C_AV); }
    __syncthreads();
    int buf = 0;
#pragma unroll
    for (int t = 0; t < 2; ++t) { const int idx = tid + 512 * t, r = idx >> 3, ch = idx & 7; *(LAS u32x4*)(lds + r * AT_RS + ch * 16) = kreg[t]; *(LAS u32x4*)(lds + AT_TILE + r * AT_RS + ch * 16) = vreg[t]; }
    __syncthreads();
    while (c < 5) {
        int cn = c + 1; while (cn < 5 && !AT_VALID(cn)) ++cn;
        if (cn < 5) {
#pragma unroll
            for (int t = 0; t < 2; ++t) { const int idx = tid + 512 * t, r = idx >> 3, ch = idx & 7; const bf16_t* src = P + (size_t)(AT_ROW(cn) + r) * LDP + kvh * 64 + ch * 8;
                kreg[t] = *(const u32x4*)(src + C_AK); vreg[t] = *(const u32x4*)(src + C_AV); }
        }
        const LAS unsigned char* Kb = lds + buf * 2 * AT_TILE; const LAS unsigned char* Vb = Kb + AT_TILE;
        const bool lo_blk = (!is_ctx && c == 0), hi_blk = (!is_ctx && c == 2);
        for (int grp = 0; grp < 4; ++grp) {
            if (lo_blk && qh == 1 && grp < 2) continue;
            if (hi_blk && qh == 0 && grp >= 2) continue;
            bf16x8 kf[2][2], vf[4];
#pragma unroll
            for (int kt = 0; kt < 2; ++kt)
#pragma unroll
                for (int ks = 0; ks < 2; ++ks) kf[kt][ks] = *(const LAS bf16x8*)(Kb + (grp * 32 + kt * 16 + i) * AT_RS + (32 * ks + 8 * g) * 2);
#pragma unroll
            for (int dt = 0; dt < 4; ++dt) { const LAS unsigned char* vp = Vb + (grp * 32 + 4 * g + (i >> 2)) * AT_RS + (16 * dt + 4 * (i & 3)) * 2;
                vf[dt] = cat44(ds_tr16(vp), ds_tr16(vp + 16 * AT_RS)); }
            f32x4 s0[4], s1[4];
#pragma unroll
            for (int qt = 0; qt < 4; ++qt) {
                s0[qt] = (f32x4){0.f, 0.f, 0.f, 0.f}; s1[qt] = s0[qt];
#pragma unroll
                for (int ks = 0; ks < 2; ++ks) { s0[qt] = MFMA16(kf[0][ks], bq[qt][ks], s0[qt]); s1[qt] = MFMA16(kf[1][ks], bq[qt][ks], s1[qt]); }
            }
            bf16x8 pb[4];
#pragma unroll
            for (int qt = 0; qt < 4; ++qt) {
                if (lo_blk || hi_blk) {
                    const int qo = qh * 64 + qt * 16 + i, ko = grp * 32 + 4 * g;
#pragma unroll
                    for (int r = 0; r < 4; ++r) {
                        const bool v0 = lo_blk ? (ko + r >= qo) : (ko + r <= qo), v1 = lo_blk ? (ko + 16 + r >= qo) : (ko + 16 + r <= qo);
                        s0[qt][r] = v0 ? s0[qt][r] : -INFINITY; s1[qt][r] = v1 ? s1[qt][r] : -INFINITY; }
                }
                float mx = fmaxf(fmaxf(fmaxf(s0[qt][0], s0[qt][1]), fmaxf(s0[qt][2], s0[qt][3])), fmaxf(fmaxf(s1[qt][0], s1[qt][1]), fmaxf(s1[qt][2], s1[qt][3])));
                mx = grp_max(mx);
                if (__any(mx > m[qt])) {
                    const float mn = fmaxf(m[qt], mx), alpha = __builtin_amdgcn_exp2f(m[qt] - mn);
                    m[qt] = mn; l[qt] *= alpha;
#pragma unroll
                    for (int dt = 0; dt < 4; ++dt) O[dt][qt] = O[dt][qt] * alpha;
                }
                const float mq = m[qt];
                float ps = 0.f;
#pragma unroll
                for (int r = 0; r < 4; ++r) { s0[qt][r] = __builtin_amdgcn_exp2f(s0[qt][r] - mq); s1[qt][r] = __builtin_amdgcn_exp2f(s1[qt][r] - mq); ps += s0[qt][r] + s1[qt][r]; }
                l[qt] += ps;
                u32x4 pw; pw.x = cvtpk(s0[qt][0], s0[qt][1]); pw.y = cvtpk(s0[qt][2], s0[qt][3]); pw.z = cvtpk(s1[qt][0], s1[qt][1]); pw.w = cvtpk(s1[qt][2], s1[qt][3]);
                pb[qt] = __builtin_bit_cast(bf16x8, pw);
            }
#pragma unroll
            for (int qt = 0; qt < 4; ++qt)
#pragma unroll
                for (int dt = 0; dt < 4; ++dt) O[dt][qt] = MFMA16(vf[dt], pb[qt], O[dt][qt]);
        }
        if (cn < 5) {
            LAS unsigned char* nb = lds + (buf ^ 1) * 2 * AT_TILE;
#pragma unroll
            for (int t = 0; t < 2; ++t) { const int idx = tid + 512 * t, r = idx >> 3, ch = idx & 7; *(LAS u32x4*)(nb + r * AT_RS + ch * 16) = kreg[t]; *(LAS u32x4*)(nb + AT_TILE + r * AT_RS + ch * 16) = vreg[t]; }
        }
        __syncthreads();
        buf ^= 1; c = cn;
    }
#undef AT_VALID
#undef AT_ROW
#pragma unroll
    for (int qt = 0; qt < 4; ++qt) {
        const float inv = 1.f / grp_sum(l[qt]);
        bf16_t* dst = CAT + (size_t)(qrow0 + 16 * qt + i) * DM + 256 + hq * 64 + 4 * g;
#pragma unroll
        for (int dt = 0; dt < 4; ++dt) { uint2 o; o.x = cvtpk(O[dt][qt][0] * inv, O[dt][qt][1] * inv); o.y = cvtpk(O[dt][qt][2] * inv, O[dt][qt][3] * inv); *(uint2*)(dst + 16 * dt) = o; }
    }
}

constexpr int CH_RS = 144;
constexpr int CH_T = 64 * CH_RS;
constexpr int GL_RS = 80;
constexpr int GL_T = 64 * GL_RS;
__device__ __forceinline__ int chunk_b0(int oc) { return (oc < 256) ? oc * 64 : SEQ + (oc - 256) * 64; }
__device__ __forceinline__ bf16x8 tr_frag(const LAS unsigned char* tile, int rs, int row0, int col0, int lane) {
    const int g = lane >> 4, i = lane & 15; const LAS unsigned char* p = tile + (row0 + 8 * g + (i >> 2)) * rs + (col0 + 4 * (i & 3)) * 2;
    return cat44(ds_tr16(p), ds_tr16(p + 4 * rs));
}
__device__ __forceinline__ bf16x8 tr_frag_perm(const LAS unsigned char* tile, int rs, int row0, int col0, int lane) {
    const int g = lane >> 4, i = lane & 15; const LAS unsigned char* p = tile + (row0 + 4 * g + (i >> 2)) * rs + (col0 + 4 * (i & 3)) * 2;
    return cat44(ds_tr16(p), ds_tr16(p + 16 * rs));
}
__device__ __forceinline__ void unpack8(const u32x4 v, float* o) {
    o[0] = __uint_as_float(v.x << 16); o[1] = __uint_as_float(v.x & 0xffff0000u); o[2] = __uint_as_float(v.y << 16); o[3] = __uint_as_float(v.y & 0xffff0000u);
    o[4] = __uint_as_float(v.z << 16); o[5] = __uint_as_float(v.z & 0xffff0000u); o[6] = __uint_as_float(v.w << 16); o[7] = __uint_as_float(v.w & 0xffff0000u);
}
__device__ __forceinline__ u32x4 pack8(const float* f) { u32x4 w; w.x = cvtpk(f[0], f[1]); w.y = cvtpk(f[2], f[3]); w.z = cvtpk(f[4], f[5]); w.w = cvtpk(f[6], f[7]); return w; }

#define LBAR() do { asm volatile("s_waitcnt lgkmcnt(0)" ::: "memory"); __builtin_amdgcn_s_barrier(); asm volatile("" ::: "memory"); } while (0)

struct MsRaw { u32x4 k, v; float ig, fg, gbi, gbf; };
__device__ __forceinline__ MsRaw mlstm_summary_load(const bf16_t* P, const float* Gt, const float* gate_b, int h, int oc, int tid, int lane, int wave) {
    MsRaw R; const int b0 = chunk_b0(oc), r = tid >> 3, ch = tid & 7;
    R.k = *(const u32x4*)(P + (size_t)(b0 + r) * LDP + C_MK + h * 64 + ch * 8); R.v = *(const u32x4*)(P + (size_t)(b0 + r) * LDP + C_MV + h * 64 + ch * 8);
    { const int d = wave & 1, sp = d ? 63 - lane : lane, row = b0 + sp;
      R.ig = Gt[(size_t)row * 48 + d * 8 + h]; R.gbi = gate_b[d * 8 + h]; R.fg = Gt[(size_t)row * 48 + d * 8 + 4 + h]; R.gbf = gate_b[d * 8 + 4 + h]; }
    return R;
}
__device__ __forceinline__ void mlstm_summary_body(LAS unsigned char* lds, const MsRaw& R, float* MU, float* MNU, float* MSC, int h, int oc, int tid, int lane, int wave) {
    LAS unsigned char* Kw0 = lds; LAS unsigned char* Kw1 = lds + CH_T; LAS unsigned char* Vt = lds + 2 * CH_T; LAS float* wv = (LAS float*)(lds + 3 * CH_T);
    const int r = tid >> 3, ch = tid & 7;
    LBAR();
    if (wave < 2) {
        const int d = wave, sp = d ? 63 - lane : lane, hd = h * 2 + d, jc = oc_to_jc(d, oc);
        const float lf = log_sigmoidf_(R.fg + R.gbf);
        const float bb = scan_add(lf, lane);
        const float av = (R.ig + R.gbi) - bb;
        const float cm = wave_max(av);
        const float B = __shfl(bb, 63);
        wv[d * 64 + sp] = __expf(av - cm);
        if (lane == 0) { MSC[(size_t)(hd * NCH + jc) * 4 + 0] = cm; MSC[(size_t)(hd * NCH + jc) * 4 + 1] = B; }
    }
    *(LAS u32x4*)(Vt + r * CH_RS + ch * 16) = R.v;
    LBAR();
    { float kf[8], t0[8], t1[8]; unpack8(R.k, kf); const float w0 = wv[r], w1 = wv[64 + r];
#pragma unroll
      for (int j = 0; j < 8; ++j) { t0[j] = kf[j] * w0; t1[j] = kf[j] * w1; }
      *(LAS u32x4*)(Kw0 + r * CH_RS + ch * 16) = pack8(t0); *(LAS u32x4*)(Kw1 + r * CH_RS + ch * 16) = pack8(t1); }
    LBAR();
    { const int d = wave >> 2, dkt = wave & 3, g = lane >> 4, i = lane & 15, hd = h * 2 + d, jc = oc_to_jc(d, oc);
      const LAS unsigned char* Kw = d ? Kw1 : Kw0;
      const bf16x8 a0 = tr_frag(Kw, CH_RS, 0, 16 * dkt, lane), a1 = tr_frag(Kw, CH_RS, 32, 16 * dkt, lane);
      float* dst = MU + ((size_t)(hd * 64 + 16 * dkt + i) * NCH + jc) * 64 + 4 * g;
#pragma unroll
      for (int dvt = 0; dvt < 4; ++dvt) {
          f32x4 c = (f32x4){0.f, 0.f, 0.f, 0.f};
          c = MFMA16(tr_frag(Vt, CH_RS, 0, 16 * dvt, lane), a0, c); c = MFMA16(tr_frag(Vt, CH_RS, 32, 16 * dvt, lane), a1, c);
          *(f32x4*)(dst + 16 * dvt) = c;
      }
      const short one = (i == 0) ? (short)0x3F80 : (short)0; const bf16x8 bo = (bf16x8){one, one, one, one, one, one, one, one};
      f32x4 c1 = (f32x4){0.f, 0.f, 0.f, 0.f}; c1 = MFMA16(a0, bo, c1); c1 = MFMA16(a1, bo, c1);
      if (i == 0) *(f32x4*)(MNU + (size_t)(hd * NCH + jc) * 64 + 16 * dkt + 4 * g) = c1; }
}

struct MoRaw { u32x4 q, k, v, c0, c1; float ig, fg, gbi, gbf, mst, nv; uint2 og[4]; };
__device__ __forceinline__ MoRaw mlstm_out_load(const bf16_t* P, const float* Gt, const float* gate_b, const bf16_t* MC, const float* MNS, const float* MSC, int h, int oc, int tid, int lane, int wave) {
    MoRaw R; const int b0 = chunk_b0(oc), r = tid >> 3, ch = tid & 7;
    const size_t ro = (size_t)(b0 + r) * LDP + h * 64 + ch * 8;
    R.q = *(const u32x4*)(P + ro + C_MQ); R.k = *(const u32x4*)(P + ro + C_MK); R.v = *(const u32x4*)(P + ro + C_MV);
    const int jc0 = oc_to_jc(0, oc), jc1 = oc_to_jc(1, oc);
    R.c0 = *(const u32x4*)(MC + ((size_t)((h * 2 + 0) * 64 + r) * NCH + jc0) * 64 + ch * 8); R.c1 = *(const u32x4*)(MC + ((size_t)((h * 2 + 1) * 64 + r) * NCH + jc1) * 64 + ch * 8);
    { const int d = wave & 1, sp = d ? 63 - lane : lane, row = b0 + sp, hd = h * 2 + d, jc = d ? jc1 : jc0;
        R.ig = Gt[(size_t)row * 48 + d * 8 + h]; R.gbi = gate_b[d * 8 + h]; R.fg = Gt[(size_t)row * 48 + d * 8 + 4 + h]; R.gbf = gate_b[d * 8 + 4 + h];
        R.mst = MSC[(size_t)(hd * NCH + jc) * 4 + 2]; R.nv = MNS[(size_t)(hd * NCH + jc) * 64 + lane]; }
    { const int tt = wave & 3, g = lane >> 4, i = lane & 15, row = b0 + 16 * tt + i;
#pragma unroll
      for (int dvt = 0; dvt < 4; ++dvt) R.og[dvt] = *(const uint2*)(P + (size_t)row * LDP + C_MO + h * 64 + 16 * dvt + 4 * g); }
    return R;
}
__device__ __forceinline__ void mlstm_out_body(LAS unsigned char* lds, const MoRaw& R, const float* normw, bf16_t* CAT, int h, int oc, int tid, int lane, int wave) {
    LAS unsigned char* Qt = lds; LAS unsigned char* Kt = lds + CH_T; LAS unsigned char* Vt = lds + 2 * CH_T; LAS unsigned char* Ct = lds + 3 * CH_T;
    LAS float* arr = (LAS float*)(lds + 5 * CH_T);
    LAS f32x4* hs = (LAS f32x4*)(lds + 5 * CH_T + 2 * 320 * 4);
    const int b0 = chunk_b0(oc);
    const int r = tid >> 3, ch = tid & 7;
    LBAR();
    if (wave < 2) {
        const int d = wave, sp = d ? 63 - lane : lane;
        const float lf = log_sigmoidf_(R.fg + R.gbf);
        const float bb = scan_add(lf, lane);
        const float av = (R.ig + R.gbi) - bb;
        const float cm = scan_max(av, lane);
        const float mx = fmaxf(R.mst, cm);
        LAS float* A = arr + d * 320;
        A[sp] = av; A[64 + sp] = mx; A[128 + sp] = __expf(R.mst - mx); A[192 + sp] = __expf(-(bb + mx));
        A[256 + lane] = R.nv;
    }
    *(LAS u32x4*)(Qt + r * CH_RS + ch * 16) = R.q; *(LAS u32x4*)(Kt + r * CH_RS + ch * 16) = R.k; *(LAS u32x4*)(Vt + r * CH_RS + ch * 16) = R.v;
    *(LAS u32x4*)(Ct + r * CH_RS + ch * 16) = R.c0; *(LAS u32x4*)(Ct + CH_T + r * CH_RS + ch * 16) = R.c1;
    LBAR();
    const int d = wave >> 2, tt = wave & 3, g = lane >> 4, i = lane & 15, t = 16 * tt + i;
    f32x4 hh[4];
    {
        const LAS float* A = arr + d * 320;
        const float mxt = A[64 + t], wt = A[128 + t], emt = A[192 + t];
        bf16x8 bq[2], bqw[2]; float qn = 0.f;
#pragma unroll
        for (int ks = 0; ks < 2; ++ks) { const u32x4 raw = *(const LAS u32x4*)(Qt + t * CH_RS + (32 * ks + 8 * g) * 2); bq[ks] = __builtin_bit_cast(bf16x8, raw);
            float qf[8], qw[8]; unpack8(raw, qf);
            const f32x4 n0 = *(const LAS f32x4*)(A + 256 + 32 * ks + 8 * g), n1 = *(const LAS f32x4*)(A + 256 + 32 * ks + 8 * g + 4);
#pragma unroll
            for (int j = 0; j < 4; ++j) { qn += qf[j] * n0[j] + qf[4 + j] * n1[j]; }
#pragma unroll
            for (int j = 0; j < 8; ++j) qw[j] = qf[j] * wt;
            bqw[ks] = __builtin_bit_cast(bf16x8, pack8(qw)); }
        qn += __shfl_xor(qn, 16); qn += __shfl_xor(qn, 32);
        float dsum = 0.f; f32x4 sT[4];
#pragma unroll
        for (int st = 0; st < 4; ++st) {
            f32x4 c = (f32x4){0.f, 0.f, 0.f, 0.f};
#pragma unroll
            for (int ks = 0; ks < 2; ++ks) c = MFMA16(*(const LAS bf16x8*)(Kt + (16 * st + i) * CH_RS + (32 * ks + 8 * g) * 2), bq[ks], c);
            const f32x4 a4 = *(const LAS f32x4*)(A + 16 * st + 4 * g);
#pragma unroll
            for (int rr = 0; rr < 4; ++rr) { const int sidx = 16 * st + 4 * g + rr; const bool ok = d ? (sidx >= t) : (sidx <= t);
                const float val = ok ? c[rr] * __expf(a4[rr] - mxt) : 0.f; sT[st][rr] = val; dsum += val; }
        }
        dsum += __shfl_xor(dsum, 16); dsum += __shfl_xor(dsum, 32);
        const float den = dsum + wt * qn, inv = 1.f / fmaxf(fabsf(den), emt);
        bf16x8 pb[2];
#pragma unroll
        for (int gp = 0; gp < 2; ++gp) { u32x4 w; w.x = cvtpk(sT[2 * gp][0], sT[2 * gp][1]); w.y = cvtpk(sT[2 * gp][2], sT[2 * gp][3]); w.z = cvtpk(sT[2 * gp + 1][0], sT[2 * gp + 1][1]); w.w = cvtpk(sT[2 * gp + 1][2], sT[2 * gp + 1][3]); pb[gp] = __builtin_bit_cast(bf16x8, w); }
        const LAS unsigned char* Cd = Ct + d * CH_T;
#pragma unroll
        for (int dvt = 0; dvt < 4; ++dvt) {
            f32x4 c = (f32x4){0.f, 0.f, 0.f, 0.f};
            c = MFMA16(tr_frag_perm(Vt, CH_RS, 0, 16 * dvt, lane), pb[0], c); c = MFMA16(tr_frag_perm(Vt, CH_RS, 32, 16 * dvt, lane), pb[1], c);
            c = MFMA16(tr_frag(Cd, CH_RS, 0, 16 * dvt, lane), bqw[0], c); c = MFMA16(tr_frag(Cd, CH_RS, 32, 16 * dvt, lane), bqw[1], c);
            hh[dvt] = c * inv;
        }
        if (d == 1) {
#pragma unroll
            for (int dvt = 0; dvt < 4; ++dvt) hs[(tt * 4 + dvt) * 64 + lane] = hh[dvt];
        }
    }
    LBAR();
    if (d == 0) {
        float s1 = 0.f;
#pragma unroll
        for (int dvt = 0; dvt < 4; ++dvt) { hh[dvt] = hh[dvt] + hs[(tt * 4 + dvt) * 64 + lane]; s1 += (hh[dvt][0] + hh[dvt][1]) + (hh[dvt][2] + hh[dvt][3]); }
        s1 += __shfl_xor(s1, 16); s1 += __shfl_xor(s1, 32);
        const float mu = s1 * (1.f / 64.f); float s2 = 0.f;
#pragma unroll
        for (int dvt = 0; dvt < 4; ++dvt) { hh[dvt] = hh[dvt] - mu; s2 += (hh[dvt][0] * hh[dvt][0] + hh[dvt][1] * hh[dvt][1]) + (hh[dvt][2] * hh[dvt][2] + hh[dvt][3] * hh[dvt][3]); }
        s2 += __shfl_xor(s2, 16); s2 += __shfl_xor(s2, 32);
        const float rstd = rsqrtf(s2 * (1.f / 64.f) + LN_EPS);
        const int row = b0 + t;
#pragma unroll
        for (int dvt = 0; dvt < 4; ++dvt) { const int col = h * 64 + 16 * dvt + 4 * g;
            const uint2 og = R.og[dvt]; const f32x4 nw = *(const f32x4*)(normw + col);
            const float o0 = hh[dvt][0] * rstd * nw[0] * sigmoidf_(__uint_as_float(og.x << 16)), o1 = hh[dvt][1] * rstd * nw[1] * sigmoidf_(__uint_as_float(og.x & 0xffff0000u));
            const float o2 = hh[dvt][2] * rstd * nw[2] * sigmoidf_(__uint_as_float(og.y << 16)), o3 = hh[dvt][3] * rstd * nw[3] * sigmoidf_(__uint_as_float(og.y & 0xffff0000u));
            uint2 o; o.x = cvtpk(o0, o1); o.y = cvtpk(o2, o3); *(uint2*)(CAT + (size_t)row * DM + col) = o; }
    }
}

struct GgRaw { f32x4 g0, g1, g2, g3; };
__device__ __forceinline__ GgRaw gla_gates_load(const float* Gt, int b0, int lane, int wave) {
    const int d = wave >> 2, sp = d ? 63 - lane : lane; const float* gs = Gt + (size_t)(b0 + sp) * 48 + 16 + d * 16;
    GgRaw R; R.g0 = *(const f32x4*)gs; R.g1 = *(const f32x4*)(gs + 4); R.g2 = *(const f32x4*)(gs + 8); R.g3 = *(const f32x4*)(gs + 12); return R;
}
__device__ __forceinline__ void gla_gates_wave(const GgRaw& R, const LAS float* g_up, const LAS float* g_b, int h, int lane, int wave, float (&bc)[8]) {
    const int d = wave >> 2, dk0 = 8 * (wave & 3);
    const float gv[16] = {R.g0[0], R.g0[1], R.g0[2], R.g0[3], R.g1[0], R.g1[1], R.g1[2], R.g1[3], R.g2[0], R.g2[1], R.g2[2], R.g2[3], R.g3[0], R.g3[1], R.g3[2], R.g3[3]};
    float z[8];
    { const f32x4 b0 = *(const LAS f32x4*)(g_b + d * 128 + h * 32 + dk0), b1 = *(const LAS f32x4*)(g_b + d * 128 + h * 32 + dk0 + 4);
#pragma unroll
      for (int c = 0; c < 4; ++c) { z[c] = b0[c]; z[4 + c] = b1[c]; } }
#pragma unroll
    for (int rr = 0; rr < 16; ++rr) { const f32x4 u0 = *(const LAS f32x4*)(g_up + (d * 16 + rr) * 128 + h * 32 + dk0), u1 = *(const LAS f32x4*)(g_up + (d * 16 + rr) * 128 + h * 32 + dk0 + 4);
#pragma unroll
        for (int c = 0; c < 4; ++c) { z[c] += gv[rr] * u0[c]; z[4 + c] += gv[rr] * u1[c]; } }
#pragma unroll
    for (int c = 0; c < 8; ++c) bc[c] = scan_add(log_sigmoidf_(z[c]) * (1.f / 16.f), lane);
}
struct GsRaw { u32x4 v, k; GgRaw gg; };
__device__ __forceinline__ GsRaw gla_summary_load(const bf16_t* P, const float* Gt, int h, int oc, int tid, int lane, int wave) {
    GsRaw R; const int b0 = chunk_b0(oc), r = tid >> 3, ch = tid & 7, d = wave >> 2, dk0 = 8 * (wave & 3), sp = d ? 63 - lane : lane;
    R.v = *(const u32x4*)(P + (size_t)(b0 + r) * LDP + C_GV + h * 64 + ch * 8);
    R.k = *(const u32x4*)(P + (size_t)(b0 + sp) * LDP + C_GK + h * 32 + dk0);
    R.gg = gla_gates_load(Gt, b0, lane, wave);
    return R;
}
__device__ __forceinline__ void gla_summary_body(LAS unsigned char* lds, const GsRaw& R, const LAS float* g_up, const LAS float* g_b, float* GU, float* GDEC, int h, int oc, int tid, int lane, int wave) {
    LAS unsigned char* Kd = lds; LAS unsigned char* Vt = lds + 2 * GL_T;
    { const int r = tid >> 3, ch = tid & 7;
      LBAR();
      *(LAS u32x4*)(Vt + r * CH_RS + ch * 16) = R.v; }
    { const int d = wave >> 2, dk0 = 8 * (wave & 3), hd = h * 2 + d, jc = oc_to_jc(d, oc), sp = d ? 63 - lane : lane;
      float bc[8]; gla_gates_wave(R.gg, g_up, g_b, h, lane, wave, bc);
      float kf[8]; unpack8(R.k, kf);
      float dec[8];
#pragma unroll
      for (int c = 0; c < 8; ++c) { const float bL = __shfl(bc[c], 63); kf[c] *= __expf(bL - bc[c]); dec[c] = __expf(bL); }
      *(LAS u32x4*)(Kd + d * GL_T + sp * GL_RS + dk0 * 2) = pack8(kf);
      if (lane == 0) { float* dp = GDEC + (size_t)(hd * NCH + jc) * 32 + dk0; *(f32x4*)dp = (f32x4){dec[0], dec[1], dec[2], dec[3]}; *(f32x4*)(dp + 4) = (f32x4){dec[4], dec[5], dec[6], dec[7]}; } }
    LBAR();
    { const int d = wave >> 2, dkt = (wave >> 1) & 1, dvh = wave & 1, g = lane >> 4, i = lane & 15, hd = h * 2 + d, jc = oc_to_jc(d, oc);
      const bf16x8 a0 = tr_frag(Kd + d * GL_T, GL_RS, 0, 16 * dkt, lane), a1 = tr_frag(Kd + d * GL_T, GL_RS, 32, 16 * dkt, lane);
      float* dst = GU + ((size_t)(hd * 32 + 16 * dkt + i) * NCH + jc) * 64 + 4 * g;
#pragma unroll
      for (int q = 0; q < 2; ++q) { const int dvt = 2 * dvh + q;
          f32x4 c = (f32x4){0.f, 0.f, 0.f, 0.f};
          c = MFMA16(tr_frag(Vt, CH_RS, 0, 16 * dvt, lane), a0, c); c = MFMA16(tr_frag(Vt, CH_RS, 32, 16 * dvt, lane), a1, c);
          *(f32x4*)(dst + 16 * dvt) = c; } }
}
struct GoRaw { u32x4 v, s, q, k; GgRaw gg; uint2 og[4]; };
__device__ __forceinline__ GoRaw gla_out_load(const bf16_t* P, const float* Gt, const bf16_t* GS, int h, int oc, int tid, int lane, int wave) {
    GoRaw R; const int b0 = chunk_b0(oc), r = tid >> 3, ch = tid & 7, d = wave >> 2, dk0 = 8 * (wave & 3), sp = d ? 63 - lane : lane;
    R.v = *(const u32x4*)(P + (size_t)(b0 + r) * LDP + C_GV + h * 64 + ch * 8);
    { const int dd = r >> 5, rk = r & 31; R.s = *(const u32x4*)(GS + ((size_t)((h * 2 + dd) * 32 + rk) * NCH + oc_to_jc(dd, oc)) * 64 + ch * 8); }
    R.q = *(const u32x4*)(P + (size_t)(b0 + sp) * LDP + C_GQ + h * 32 + dk0); R.k = *(const u32x4*)(P + (size_t)(b0 + sp) * LDP + C_GK + h * 32 + dk0);
    R.gg = gla_gates_load(Gt, b0, lane, wave);
    { const int tt = wave & 3, g = lane >> 4, i = lane & 15, row = b0 + 16 * tt + i;
#pragma unroll
      for (int dvt = 0; dvt < 4; ++dvt) R.og[dvt] = *(const uint2*)(P + (size_t)row * LDP + C_GG + h * 64 + 16 * dvt + 4 * g); }
    return R;
}
__device__ __forceinline__ void gla_out_body(LAS unsigned char* lds, const GoRaw& R, const LAS float* g_up, const LAS float* g_b, const float* normw, bf16_t* CAT, int h, int oc, int tid, int lane, int wave) {
    LAS unsigned char* Qs = lds; LAS unsigned char* Ks = lds + 2 * GL_T; LAS unsigned char* Vt = lds + 4 * GL_T; LAS unsigned char* St = Vt + CH_T;
    LAS f32x4* hs = (LAS f32x4*)(St + 2 * 32 * CH_RS);
    const int b0 = chunk_b0(oc);
    { const int r = tid >> 3, ch = tid & 7, dd = r >> 5, rk = r & 31;
      LBAR();
      *(LAS u32x4*)(Vt + r * CH_RS + ch * 16) = R.v; *(LAS u32x4*)(St + dd * 32 * CH_RS + rk * CH_RS + ch * 16) = R.s; }
    { const int d = wave >> 2, dk0 = 8 * (wave & 3), sp = d ? 63 - lane : lane;
      float bc[8]; gla_gates_wave(R.gg, g_up, g_b, h, lane, wave, bc);
      float qf[8], kf[8]; unpack8(R.q, qf); unpack8(R.k, kf);
#pragma unroll
      for (int c = 0; c < 8; ++c) { qf[c] *= __expf(bc[c]); kf[c] *= __expf(-bc[c]); }
      *(LAS u32x4*)(Qs + d * GL_T + sp * GL_RS + dk0 * 2) = pack8(qf); *(LAS u32x4*)(Ks + d * GL_T + sp * GL_RS + dk0 * 2) = pack8(kf); }
    LBAR();
    const int d = wave >> 2, tt = wave & 3, g = lane >> 4, i = lane & 15, t = 16 * tt + i;
    f32x4 hh[4];
    {
        const bf16x8 bq = *(const LAS bf16x8*)(Qs + d * GL_T + t * GL_RS + 16 * g);
        f32x4 sT[4];
#pragma unroll
        for (int st = 0; st < 4; ++st) {
            f32x4 c = (f32x4){0.f, 0.f, 0.f, 0.f};
            c = MFMA16(*(const LAS bf16x8*)(Ks + d * GL_T + (16 * st + i) * GL_RS + 16 * g), bq, c);
#pragma unroll
            for (int rr = 0; rr < 4; ++rr) { const int sidx = 16 * st + 4 * g + rr; const bool ok = d ? (sidx >= t) : (sidx <= t); sT[st][rr] = ok ? c[rr] : 0.f; }
        }
        bf16x8 pb[2];
#pragma unroll
        for (int gp = 0; gp < 2; ++gp) { u32x4 w; w.x = cvtpk(sT[2 * gp][0], sT[2 * gp][1]); w.y = cvtpk(sT[2 * gp][2], sT[2 * gp][3]); w.z = cvtpk(sT[2 * gp + 1][0], sT[2 * gp + 1][1]); w.w = cvtpk(sT[2 * gp + 1][2], sT[2 * gp + 1][3]); pb[gp] = __builtin_bit_cast(bf16x8, w); }
#pragma unroll
        for (int dvt = 0; dvt < 4; ++dvt) {
            f32x4 c = (f32x4){0.f, 0.f, 0.f, 0.f};
            c = MFMA16(tr_frag_perm(Vt, CH_RS, 0, 16 * dvt, lane), pb[0], c); c = MFMA16(tr_frag_perm(Vt, CH_RS, 32, 16 * dvt, lane), pb[1], c);
            c = MFMA16(tr_frag(St + d * 32 * CH_RS, CH_RS, 0, 16 * dvt, lane), bq, c);
            hh[dvt] = c;
        }
        if (d == 1) {
#pragma unroll
            for (int dvt = 0; dvt < 4; ++dvt) hs[(tt * 4 + dvt) * 64 + lane] = hh[dvt];
        }
    }
    LBAR();
    if (d == 0) {
        float s1 = 0.f;
#pragma unroll
        for (int dvt = 0; dvt < 4; ++dvt) { hh[dvt] = hh[dvt] + hs[(tt * 4 + dvt) * 64 + lane]; s1 += (hh[dvt][0] + hh[dvt][1]) + (hh[dvt][2] + hh[dvt][3]); }
        s1 += __shfl_xor(s1, 16); s1 += __shfl_xor(s1, 32);
        const float mu = s1 * (1.f / 64.f); float s2 = 0.f;
#pragma unroll
        for (int dvt = 0; dvt < 4; ++dvt) { hh[dvt] = hh[dvt] - mu; s2 += (hh[dvt][0] * hh[dvt][0] + hh[dvt][1] * hh[dvt][1]) + (hh[dvt][2] * hh[dvt][2] + hh[dvt][3] * hh[dvt][3]); }
        s2 += __shfl_xor(s2, 16); s2 += __shfl_xor(s2, 32);
        const float rstd = rsqrtf(s2 * (1.f / 64.f) + LN_EPS);
        const int row = b0 + t;
#pragma unroll
        for (int dvt = 0; dvt < 4; ++dvt) { const int col = h * 64 + 16 * dvt + 4 * g;
            const uint2 gg = R.og[dvt]; const f32x4 nw = *(const f32x4*)(normw + col);
            const float o0 = hh[dvt][0] * rstd * nw[0] * siluf(__uint_as_float(gg.x << 16)), o1 = hh[dvt][1] * rstd * nw[1] * siluf(__uint_as_float(gg.x & 0xffff0000u));
            const float o2 = hh[dvt][2] * rstd * nw[2] * siluf(__uint_as_float(gg.y << 16)), o3 = hh[dvt][3] * rstd * nw[3] * siluf(__uint_as_float(gg.y & 0xffff0000u));
            uint2 o; o.x = cvtpk(o0, o1); o.y = cvtpk(o2, o3); *(uint2*)(CAT + (size_t)row * DM + 768 + col) = o; }
    }
}

__device__ __forceinline__ f32x4 ld4bf(const bf16_t* p) { const uint2 v = *(const uint2*)p; return (f32x4){__uint_as_float(v.x << 16), __uint_as_float(v.x & 0xffff0000u), __uint_as_float(v.y << 16), __uint_as_float(v.y & 0xffff0000u)}; }
__device__ __forceinline__ void ln16(f32x4 (&v)[4], const float* w, const float* b, int lane) {
    float s = 0.f;
#pragma unroll
    for (int j = 0; j < 4; ++j) s += (v[j][0] + v[j][1]) + (v[j][2] + v[j][3]);
    const float mean = wave_sum(s) * (1.f / DM); float s2 = 0.f;
#pragma unroll
    for (int j = 0; j < 4; ++j) { v[j] = v[j] - mean; s2 += (v[j][0] * v[j][0] + v[j][1] * v[j][1]) + (v[j][2] * v[j][2] + v[j][3] * v[j][3]); }
    const float rstd = rsqrtf(wave_sum(s2) * (1.f / DM) + LN_EPS);
#pragma unroll
    for (int j = 0; j < 4; ++j) { const f32x4 wv = *(const f32x4*)(w + 4 * lane + 256 * j), bv = *(const f32x4*)(b + 4 * lane + 256 * j); v[j] = v[j] * rstd * wv + bv; }
}
__device__ __forceinline__ void mod_store(f32x4 (&v)[4], const float* shift, const float* scale, bf16_t* hrow, int lane) {
#pragma unroll
    for (int j = 0; j < 4; ++j) { const f32x4 sh = *(const f32x4*)(shift + 4 * lane + 256 * j), sc = *(const f32x4*)(scale + 4 * lane + 256 * j);
        v[j] = v[j] * (sc + 1.f) + sh;
        uint2 o; o.x = cvtpk(v[j][0], v[j][1]); o.y = cvtpk(v[j][2], v[j][3]); *(uint2*)(hrow + 4 * lane + 256 * j) = o; }
}

__global__ void __launch_bounds__(512, 2) fwd(Args a_unused) {
    extern __shared__ __attribute__((aligned(16))) unsigned char lds_raw[];
    LAS unsigned char* lds = (LAS unsigned char*)lds_raw;
    const int wave0 = __builtin_amdgcn_readfirstlane(threadIdx.x >> 6);
    const int G0 = gridDim.x, bid0 = blockIdx.x;
    typedef const __attribute__((address_space(4))) Args* ArgsP;
    ArgsP ap0 = (ArgsP)__builtin_amdgcn_kernarg_segment_ptr();
#define PH_CTX() int G = G0, bid = bid0; asm volatile("" : "+s"(G), "+s"(bid)); int wave = wave0; asm volatile("" : "+s"(wave)); unsigned ones_ = ~0u; asm volatile("" : "+s"(ones_)); const int lane = (int)__builtin_amdgcn_mbcnt_hi(ones_, __builtin_amdgcn_mbcnt_lo(ones_, 0u)); const int tid = wave * 64 + lane; \
    ArgsP ap = ap0; asm volatile("" : "+s"(ap)); unsigned char* ws = ap->ws; const int gw = bid * 8 + wave, NGW = G * 8; (void)lane; (void)gw; (void)NGW; (void)ws
#define WSP(T, off) ((T*)(ws + (off)))
    volatile LAS unsigned* MISC = (volatile LAS unsigned*)(lds + MISC_OFF);
    if (threadIdx.x < 32) MISC[threadIdx.x] = 0u;
    __syncthreads();
    XcdBarrier bar; bar.bar = (unsigned*)(ap0->ws + WS_CTL) + CW_BAR; bar.x = 0; bar.st = MISC + 8;
    if (MK_ONE_LAUNCH) bar = xcd_barrier_post(bar.bar, MISC + 8);
    const int lo = ap0->ph_lo, hi = ap0->ph_hi;
#define IN(k) (lo <= (k) && (k) < hi)
#define SEAM(k) do { if (MK_ONE_LAUNCH && (k) + 1 < hi) xcd_barrier(bar); } while (0)

    if (IN(0)) {
        PH_CTX();
        float* MODS = WSP(float, WS_MODS);
        LAS float* scs = (LAS float*)lds;
        for (int i = tid; i < 2048; i += 512) scs[i] = siluf(i < 1024 ? ap->in[1][i] : ap->in[3][i - 1024]);
        __syncthreads();
        for (int u = bid; u < 4 * 8 * 12; u += G) {
            const int l = u / 96, rem = u % 96, kc = rem / 12, ng = rem % 12, n = ng * 512 + tid;
            const float* w = ap->in[4] + ((size_t)l * 1024 + kc * 128) * 6144 + n;
            float a0 = 0.f, a1 = 0.f;
#pragma unroll 8
            for (int k = 0; k < 128; ++k) { const float wv = w[(size_t)k * 6144]; a0 += scs[kc * 128 + k] * wv; a1 += scs[1024 + kc * 128 + k] * wv; }
            if (kc == 0) { const float bb = ap->in[5][l * 6144 + n]; a0 += bb; a1 += bb; }
            atomicAdd(MODS + (size_t)(l * 2 + 0) * 6144 + n, a0); atomicAdd(MODS + (size_t)(l * 2 + 1) * 6144 + n, a1);
        }
        if (bid < 8) { float* ropeC = WSP(float, WS_ROPE); float* ropeS = ropeC + 256 * 16;
            const int i = bid * 512 + tid, pos = i >> 4, fi = i & 15; const float inv = powf(10000.f, -(float)fi / 16.f); const float ang = (float)pos * inv; float sn, cs; sincosf(ang, &sn, &cs); ropeC[i] = cs; ropeS[i] = sn; }
        __syncthreads();
        LAS float* scr = (LAS float*)(lds + wave * 16640);
        constexpr int I_A = 16 * 44, I_B = 16 * 16, I_C = 16 * 88, I_D = 44 * 16, I_E = 0, I_F = 0;
        constexpr int N_A = 4 * I_A, N_B = 4 * I_B, N_C = 2 * I_C, N_D = 2 * I_D, N_E = 16 * I_E, N_F = 16 * I_F;
        for (int it = gw; it < N_A + N_B + N_C + N_D; it += NGW) {
            int r = it;
            if (r < N_A) { const int mi = r / I_A; tr_item(ap->in[6] + (size_t)mi * DM * IN_COLS, DM, IN_COLS, NPIN, WSP(bf16_t, WS_WIN) + (size_t)mi * NPIN * DM, 1, 0, scr, r % I_A, lane); continue; } r -= N_A;
            if (r < N_B) { const int mi = r / I_B; tr_item(ap->in[13] + (size_t)mi * DM * DM, DM, DM, DM, WSP(bf16_t, WS_WOUT) + (size_t)mi * DM * DM, 0, 0, scr, r % I_B, lane); continue; } r -= N_B;
            if (r < N_C) { const int mi = r / I_C; tr_item<true>(ap->in[16] + (size_t)mi * DM * 2 * DFF, DM, 2 * DFF, 2 * DFF, (bf16_t*)(WSP(unsigned char, WS_FGU) + (size_t)mi * 2 * DFF * DM), 2, DFF, scr, r % I_C, lane, MGU_SCALE); continue; } r -= N_C;
            { const int mi = r / I_D; tr_item(ap->in[17] + (size_t)mi * DFF * DM, DFF, DM, DM, WSP(bf16_t, WS_FDN) + (size_t)mi * DM * DFF, 0, 0, scr, r % I_D, lane); }
        }
        __syncthreads();
        { constexpr int J_GU = 8 * 28, J_DN = 28 * 4, J_PER = J_GU + J_DN;
          for (int it = bid; it < 16 * J_PER; it += G) { const int mi = it / J_PER, r = it % J_PER;
              if (r < J_GU) tr_item_f8_wg(lds, ap->in[20] + (size_t)mi * DM * 2 * DEXP, DM, 2 * DEXP, 2 * DEXP, WSP(unsigned char, WS_MGU) + (size_t)mi * 2 * DEXP * DM, 2, DEXP, r, tid, lane, wave, MGU_SCALE);
              else tr_item_f8_wg(lds, ap->in[21] + (size_t)mi * DEXP * DM, DEXP, DM, DM, WSP(unsigned char, WS_MDN) + (size_t)mi * DM * DEXP, 0, 0, r - J_GU, tid, lane, wave, MDN_SCALE); } }
        SEAM(0);
    }
    if (IN(1)) {
        PH_CTX();
        bf16_t* H = WSP(bf16_t, WS_H); const float* MODS = WSP(float, WS_MODS);
        for (int r = gw; r < TT; r += NGW) {
            const int wch = r >= SEQ; const float* src = wch ? ap->in[2] + (size_t)(r - SEQ) * DM : ap->in[0] + (size_t)r * DM;
            f32x4 v[4];
#pragma unroll
            for (int j = 0; j < 4; ++j) v[j] = *(const f32x4*)(src + 4 * lane + 256 * j);
            const float* md = MODS + (size_t)(0 * 2 + wch) * 6144;
            mod_store(v, md, md + 1024, H + (size_t)r * DM, lane);
        }
        SEAM(1);
    }

    for (int l = 0; l < DEPTH; ++l) {
        const int pb = 2 + 10 * l;
        const bool lastl = (l == DEPTH - 1), moe = (l & 1);
        const int nrows = lastl ? SEQ : TT;

        PHASE_REP(0) if (IN(pb + 0)) {
            PH_CTX();
            pg8::StaticOrder S; S.init(WSP(bf16_t, WS_H), WSP(bf16_t, WS_WIN) + (size_t)l * NPIN * DM, DM, TT, NPIN, G, bid);
            pg8::EpiInProj E{WSP(bf16_t, WS_P), WSP(float, WS_G), WSP(float, WS_ROPE), WSP(float, WS_ROPE) + 256 * 16};
            pg8::gemm_phase<pg8::EpiInProj, pg8::StaticOrder>(lds, DM, S, E, tid);
            SEAM(pb + 0);
        }
        PHASE_REP(1) if (IN(pb + 1)) {
            if (!lastl && bid0 >= 32 && bid0 < 36) { PH_CTX(); attn_unit(lds, WSP(bf16_t, WS_P), WSP(bf16_t, WS_CAT), -1, (bid - 32) >> 1, bid & 1, ap->in[9] + l * 8, tid, lane, wave); }
            { PH_CTX();
              const bf16_t* P = WSP(bf16_t, WS_P); const float* Gt = WSP(float, WS_G); const float* gate_b = ap->in[7] + l * 16;
#define UNIT_LOOP2(N_, start_, RawT, LOAD, BODY) do { int u0_ = (start_); if (u0_ < (N_)) { RawT A_ = LOAD(u0_); for (;;) { \
                  const int u1_ = u0_ + G; const RawT B_ = LOAD(u1_ < (N_) ? u1_ : u0_); BODY(A_, u0_); if (u1_ >= (N_)) break; \
                  const int u2_ = u1_ + G; A_ = LOAD(u2_ < (N_) ? u2_ : u1_); BODY(B_, u1_); if (u2_ >= (N_)) break; u0_ = u2_; } } } while (0)
#define MS_LOAD(u) mlstm_summary_load(P, Gt, gate_b, (u) / NCH, (u) % NCH, tid, lane, wave)
#define MS_BODY(R, u) mlstm_summary_body(lds, R, WSP(float, WS_MU), WSP(float, WS_MNU), WSP(float, WS_MSC), (u) / NCH, (u) % NCH, tid, lane, wave)
              UNIT_LOOP2(4 * NCH, bid, MsRaw, MS_LOAD, MS_BODY); }
            { PH_CTX();
              const bf16_t* P = WSP(bf16_t, WS_P); const float* Gt = WSP(float, WS_G);
#define GS_LOAD(u) gla_summary_load(P, Gt, (u) / NCH, (u) % NCH, tid, lane, wave)
              LAS float* gupL = (LAS float*)(lds + 65536); LAS float* gbL = gupL + 4096;
              __syncthreads(); for (int i = tid; i < 4096; i += 512) gupL[i] = ap->in[10][(size_t)l * 4096 + i]; if (tid < 256) gbL[tid] = ap->in[11][l * 256 + tid]; __syncthreads();
#define GS_BODY(R, u) gla_summary_body(lds, R, gupL, gbL, WSP(float, WS_GU), WSP(float, WS_GDEC), (u) / NCH, (u) % NCH, tid, lane, wave)
              UNIT_LOOP2(4 * NCH, (bid + 240) % G, GsRaw, GS_LOAD, GS_BODY); }
            SEAM(pb + 1);
        }
        PHASE_REP(2) if (IN(pb + 2)) {
            PH_CTX();
            const int wi = wave * G + bid;
            const int e0 = wi * 64;
            LAS float* sc = (LAS float*)(lds + wave * 4096);
#define SC_LOAD(buf, b) _Pragma("unroll") for (int j = 0; j < 52; ++j) buf[j] = U[(size_t)((b) * 52 + j) * str]
            if (e0 < 32768 + 512) {
                const bool isC = e0 < 32768;
                const int hd = isC ? e0 / 4096 : (e0 - 32768) / 64, idx = isC ? (e0 % 4096) + lane : lane;
                const int dkr = (e0 % 4096) >> 6;
                const float* __restrict__ U = isC ? WSP(float, WS_MU) + (size_t)(hd * 64 + dkr) * NCH * 64 + lane : WSP(float, WS_MNU) + (size_t)hd * NCH * 64 + lane;
                bf16_t* __restrict__ StC = WSP(bf16_t, WS_MC) + (size_t)(hd * 64 + dkr) * NCH * 64 + lane; float* __restrict__ StN = WSP(float, WS_MNS) + (size_t)hd * NCH * 64 + lane;
                float* __restrict__ MSC = WSP(float, WS_MSC) + (size_t)hd * NCH * 4;
                const int str = 64;
                const bool wr_m_wave = isC && (e0 % 4096) == 0;
                {
                    float cmv[5], Bv[5]; float a = 0.f, b = -INFINITY;
#pragma unroll
                    for (int q = 0; q < 5; ++q) { const int n = 5 * lane + q; const bool ok = n < NCH; const float2 v = ok ? *(const float2*)(MSC + n * 4) : make_float2(-INFINITY, 0.f);
                        cmv[q] = v.x; Bv[q] = v.y; b = fmaxf(b + v.y, v.x + v.y); a += v.y; }
#pragma unroll
                    for (int o = 1; o < 64; o <<= 1) { const float pa = __shfl_up(a, o), pb = __shfl_up(b, o); if (lane >= o) { b = fmaxf(pb + a, b); a = pa + a; } }
                    float ea = __shfl_up(a, 1), eb = __shfl_up(b, 1); if (lane == 0) { ea = 0.f; eb = -INFINITY; }
                    float m = fmaxf(ea, eb);
#pragma unroll
                    for (int q = 0; q < 5; ++q) { const int n = 5 * lane + q;
                        if (n < NCH) { const float mx = fmaxf(m, cmv[q]); sc[2 * n] = __expf(m - mx); sc[2 * n + 1] = __expf(cmv[q] - mx); if (wr_m_wave) MSC[n * 4 + 2] = m; m = Bv[q] + mx; } }
                }
                LDS_WAIT();
                float cval = 0.f;
#define SC_STEP_M(buf, b) _Pragma("unroll") for (int j = 0; j < 52; ++j) { const int n = (b) * 52 + j; \
                    if (isC) StC[(size_t)n * 64] = (bf16_t)f2bf(cval); else StN[(size_t)n * 64] = cval; \
                    cval = sc[2 * n] * cval + sc[2 * n + 1] * buf[j]; }
                float ua[52], ub[52];
                SC_LOAD(ua, 0);
                SC_LOAD(ub, 1); SC_STEP_M(ua, 0); SC_LOAD(ua, 2); SC_STEP_M(ub, 1);
                SC_LOAD(ub, 3); SC_STEP_M(ua, 2); SC_LOAD(ua, 4); SC_STEP_M(ub, 3);
                SC_STEP_M(ua, 4);
#undef SC_STEP_M
            } else if (e0 < 32768 + 512 + 16384) {
                const int e2 = e0 - 33280, hd = e2 / 2048, idx = (e2 % 2048) + lane, dk = (e2 % 2048) >> 6;
                const float* __restrict__ U = WSP(float, WS_GU) + (size_t)(hd * 32 + dk) * NCH * 64 + lane; bf16_t* __restrict__ St = WSP(bf16_t, WS_GS) + (size_t)(hd * 32 + dk) * NCH * 64 + lane;
                const float* __restrict__ DC = WSP(float, WS_GDEC) + (size_t)hd * NCH * 32 + dk;
                const int str = 64;
                for (int k = lane; k < NCH; k += 64) sc[k] = DC[(size_t)k * 32];
                LDS_WAIT();
                float sval = 0.f;
#define SC_STEP_G(buf, b) _Pragma("unroll") for (int j = 0; j < 52; ++j) { const int n = (b) * 52 + j; St[(size_t)n * 64] = (bf16_t)f2bf(sval); sval = sc[n] * sval + buf[j]; }
                float ua[52], ub[52];
                SC_LOAD(ua, 0);
                SC_LOAD(ub, 1); SC_STEP_G(ua, 0); SC_LOAD(ua, 2); SC_STEP_G(ub, 1);
                SC_LOAD(ub, 3); SC_STEP_G(ua, 2); SC_LOAD(ua, 4); SC_STEP_G(ub, 3);
                SC_STEP_G(ua, 4);
#undef SC_STEP_G
            }
#undef SC_LOAD
            SEAM(pb + 2);
        }
        PHASE_REP(3) if (IN(pb + 3)) {
            const int noc = lastl ? 256 : 260;
            { PH_CTX();
              for (int u = bid; u < 256; u += G) attn_unit(lds, WSP(bf16_t, WS_P), WSP(bf16_t, WS_CAT), u >> 1, 0, u & 1, ap->in[9] + l * 8, tid, lane, wave); }
            { PH_CTX();
              const bf16_t* P = WSP(bf16_t, WS_P); const float* Gt = WSP(float, WS_G); const float* gate_b = ap->in[7] + l * 16;
              const bf16_t* MC = WSP(bf16_t, WS_MC); const float* MNS = WSP(float, WS_MNS); const float* MSC = WSP(float, WS_MSC);
#define MO_LOAD(u) mlstm_out_load(P, Gt, gate_b, MC, MNS, MSC, (u) / noc, (u) % noc, tid, lane, wave)
#define MO_BODY(R, u) mlstm_out_body(lds, R, ap->in[8] + l * 256, WSP(bf16_t, WS_CAT), (u) / noc, (u) % noc, tid, lane, wave)
              UNIT_LOOP2(4 * noc, bid, MoRaw, MO_LOAD, MO_BODY); }
            { PH_CTX();
              const bf16_t* P = WSP(bf16_t, WS_P); const float* Gt = WSP(float, WS_G); const bf16_t* GS = WSP(bf16_t, WS_GS);
#define GO_LOAD(u) gla_out_load(P, Gt, GS, (u) / noc, (u) % noc, tid, lane, wave)
              LAS float* gupL = (LAS float*)(lds + 65536); LAS float* gbL = gupL + 4096;
              __syncthreads(); for (int i = tid; i < 4096; i += 512) gupL[i] = ap->in[10][(size_t)l * 4096 + i]; if (tid < 256) gbL[tid] = ap->in[11][l * 256 + tid]; __syncthreads();
#define GO_BODY(R, u) gla_out_body(lds, R, gupL, gbL, ap->in[12] + l * 256, WSP(bf16_t, WS_CAT), (u) / noc, (u) % noc, tid, lane, wave)
              UNIT_LOOP2(4 * noc, (bid + 240) % G, GoRaw, GO_LOAD, GO_BODY); }
            SEAM(pb + 3);
        }
        PHASE_REP(4) if (IN(pb + 4)) {
            PH_CTX();
            const float* modl = WSP(float, WS_MODS) + (size_t)(l * 2 + 0) * 6144;
            int tp, sp; pg8::tail_params(nrows / 256, 4, DM / 64, G, tp, sp);
            pg8::TailOrder S; S.dense(WSP(bf16_t, WS_CAT), WSP(bf16_t, WS_WOUT) + (size_t)l * DM * DM, DM, DM, nrows / 256, G, bid, tp, sp);
            pg8::EpiResid E{WSP(bf16_t, WS_Y), modl + 2 * 1024, modl + 6144 + 2 * 1024, WSP(float, WS_YP), nrows - tp * 256, tp * 256};
            pg8::gemm_phase<pg8::EpiResid, pg8::TailOrder>(lds, DM, S, E, tid);
            SEAM(pb + 4);
        }
        if (IN(pb + 5)) {
            PH_CTX();
            float* X = WSP(float, WS_X); bf16_t* H = WSP(bf16_t, WS_H); const bf16_t* Yb = WSP(bf16_t, WS_Y);
            const float* modl = WSP(float, WS_MODS) + (size_t)(l * 2 + 0) * 6144;
            unsigned* mcnt = WSP(unsigned, WS_CTL) + CW_MOE + 64 * 8 * (l >> 1);
            LAS float* RW = (LAS float*)lds;
            if (moe) { const float* rw = ap->in[18] + (size_t)(l >> 1) * DM * 8; for (int i = tid; i < 8192; i += 512) { const int e = i >> 10, c = i & 1023; RW[i] = rw[c * 8 + e]; } __syncthreads(); }
            const float* lw = ap->in[14] + (size_t)(l * 2 + 0) * DM; const float* lb = ap->in[15] + (size_t)(l * 2 + 0) * DM;
            int tp, sp; pg8::tail_params(nrows / 256, 4, DM / 64, G, tp, sp);
            const int tail0 = nrows - tp * 256; const float* YP = WSP(float, WS_YP);
            for (int r = gw; r < nrows; r += NGW) {
                const int wch = r >= SEQ; const float* md = modl + wch * 6144;
                const float* xres = (l == 0) ? (wch ? ap->in[2] + (size_t)(r - SEQ) * DM : ap->in[0] + (size_t)r * DM) : X + (size_t)r * DM;
                f32x4 v[4];
                if (r < tail0) {
#pragma unroll
                    for (int j = 0; j < 4; ++j) v[j] = *(const f32x4*)(xres + 4 * lane + 256 * j) * ALPHA + ld4bf(Yb + (size_t)r * DM + 4 * lane + 256 * j);
                } else {
#pragma unroll
                    for (int j = 0; j < 4; ++j) { const int c = 4 * lane + 256 * j; f32x4 a4 = (f32x4){0.f, 0.f, 0.f, 0.f};
                        for (int p = 0; p < sp; ++p) a4 = a4 + *(const f32x4*)(YP + ((size_t)p * tp * 256 + (r - tail0)) * DM + c);
                        v[j] = *(const f32x4*)(xres + c) * ALPHA + *(const f32x4*)(md + 2 * 1024 + c) * a4; }
                }
                ln16(v, lw, lb, lane);
#pragma unroll
                for (int j = 0; j < 4; ++j) *(f32x4*)(X + (size_t)r * DM + 4 * lane + 256 * j) = v[j];
#pragma unroll
                for (int j = 0; j < 4; ++j) { const f32x4 sh = *(const f32x4*)(md + 3 * 1024 + 4 * lane + 256 * j), sc = *(const f32x4*)(md + 4 * 1024 + 4 * lane + 256 * j); v[j] = v[j] * (sc + 1.f) + sh; }
                if (!moe) {
#pragma unroll
                    for (int j = 0; j < 4; ++j) *(unsigned*)((unsigned char*)H + (size_t)r * DM + 4 * lane + 256 * j) = pk4_fp8(v[j][0], v[j][1], v[j][2], v[j][3]);
                } else {
                    float lg[8];
#pragma unroll
                    for (int e = 0; e < 8; ++e) { float s = 0.f;
#pragma unroll
                        for (int j = 0; j < 4; ++j) { const f32x4 w = *(const LAS f32x4*)(RW + e * 1024 + 4 * lane + 256 * j); s += v[j][0] * w[0] + v[j][1] * w[1] + v[j][2] * w[2] + v[j][3] * w[3]; }
                        lg[e] = wave_sum(s) + ap->in[19][(l >> 1) * 8 + e]; }
                    int e0 = 0; float l0 = lg[0];
#pragma unroll
                    for (int e = 1; e < 8; ++e) if (lg[e] > l0) { l0 = lg[e]; e0 = e; }
                    int e1 = -1; float l1 = -INFINITY;
#pragma unroll
                    for (int e = 0; e < 8; ++e) if (e != e0 && lg[e] > l1) { l1 = lg[e]; e1 = e; }
                    int p0 = 0, p1 = 0;
                    if (lane == 0) {
                        const float w0 = 1.f / (1.f + __expf(l1 - l0));
                        p0 = (int)atomicAdd(mcnt + 64 * e0, 1u); p1 = (int)atomicAdd(mcnt + 64 * e1, 1u);
                        WSP(int2, WS_TOKE)[r] = make_int2(e0, e1); WSP(int2, WS_TOKP)[r] = make_int2(p0, p1); WSP(float2, WS_TOKW)[r] = make_float2(w0, 1.f - w0);
                    }
                    p0 = __builtin_amdgcn_readfirstlane(p0); p1 = __builtin_amdgcn_readfirstlane(p1);
                    unsigned char* x0 = WSP(unsigned char, WS_XB) + ((size_t)e0 * TT + p0) * DM; unsigned char* x1 = WSP(unsigned char, WS_XB) + ((size_t)e1 * TT + p1) * DM;
#pragma unroll
                    for (int j = 0; j < 4; ++j) { const unsigned o = pk4_fp8(v[j][0], v[j][1], v[j][2], v[j][3]); *(unsigned*)(x0 + 4 * lane + 256 * j) = o; *(unsigned*)(x1 + 4 * lane + 256 * j) = o; }
                }
            }
            SEAM(pb + 5);
        }
#define MOE_TS() int ts0 = 0, ts1, ts2, ts3, ts4, ts5, ts6, ts7, ts8; { const unsigned* mcnt = WSP(unsigned, WS_CTL) + CW_MOE + 64 * 8 * (l >> 1); \
            ts1 = ts0 + (int)((__hip_atomic_load(mcnt + 64 * 0, __ATOMIC_RELAXED, __HIP_MEMORY_SCOPE_AGENT) + 255u) >> 8); ts2 = ts1 + (int)((__hip_atomic_load(mcnt + 64 * 1, __ATOMIC_RELAXED, __HIP_MEMORY_SCOPE_AGENT) + 255u) >> 8); \
            ts3 = ts2 + (int)((__hip_atomic_load(mcnt + 64 * 2, __ATOMIC_RELAXED, __HIP_MEMORY_SCOPE_AGENT) + 255u) >> 8); ts4 = ts3 + (int)((__hip_atomic_load(mcnt + 64 * 3, __ATOMIC_RELAXED, __HIP_MEMORY_SCOPE_AGENT) + 255u) >> 8); \
            ts5 = ts4 + (int)((__hip_atomic_load(mcnt + 64 * 4, __ATOMIC_RELAXED, __HIP_MEMORY_SCOPE_AGENT) + 255u) >> 8); ts6 = ts5 + (int)((__hip_atomic_load(mcnt + 64 * 5, __ATOMIC_RELAXED, __HIP_MEMORY_SCOPE_AGENT) + 255u) >> 8); \
            ts7 = ts6 + (int)((__hip_atomic_load(mcnt + 64 * 6, __ATOMIC_RELAXED, __HIP_MEMORY_SCOPE_AGENT) + 255u) >> 8); ts8 = ts7 + (int)((__hip_atomic_load(mcnt + 64 * 7, __ATOMIC_RELAXED, __HIP_MEMORY_SCOPE_AGENT) + 255u) >> 8); \
            ts1 = __builtin_amdgcn_readfirstlane(ts1); ts2 = __builtin_amdgcn_readfirstlane(ts2); ts3 = __builtin_amdgcn_readfirstlane(ts3); ts4 = __builtin_amdgcn_readfirstlane(ts4); \
            ts5 = __builtin_amdgcn_readfirstlane(ts5); ts6 = __builtin_amdgcn_readfirstlane(ts6); ts7 = __builtin_amdgcn_readfirstlane(ts7); ts8 = __builtin_amdgcn_readfirstlane(ts8); } (void)ts0; (void)ts8
        PHASE_REP(7) if (IN(pb + 7)) {
            if (!moe) {
                PH_CTX();
                pg8::StaticOrder S; S.init(WSP(bf16_t, WS_H), WSP(unsigned char, WS_FGU) + (size_t)(l >> 1) * 2 * DFF * DM, DM / 2, nrows, 2 * DFF, G, bid);
                pg8::EpiSwiglu E{WSP(bf16_t, WS_ACT), DFF, 1.f / MGU_SCALE, 1.f};
                pg8::gemm_phase<pg8::EpiSwiglu, pg8::StaticOrder, true>(lds, DM / 2, S, E, tid);
            } else {
                PH_CTX();
                MOE_TS();
                pg8::MoeOrder S; S.A = (const char*)WSP(bf16_t, WS_XB); S.Bt = (const char*)WSP(unsigned char, WS_MGU) + (size_t)(l >> 1) * 8 * 2 * DEXP * DM; S.K = DM / 2; S.N = 2 * DEXP;     S.nN = 2 * DEXP / 256; S.ntile = ts8; S.G = G; S.c = bid;
                S.ts1 = ts1; S.ts2 = ts2; S.ts3 = ts3; S.ts4 = ts4; S.ts5 = ts5; S.ts6 = ts6; S.ts7 = ts7;
                pg8::EpiSwigluT<true> E{WSP(bf16_t, WS_ACT), DEXP, 1.f / MGU_SCALE, ACT_SCALE};
                pg8::gemm_phase<pg8::EpiSwigluT<true>, pg8::MoeOrder, true>(lds, DM / 2, S, E, tid);
            }
            SEAM(pb + 7);
        }
        PHASE_REP(8) if (IN(pb + 8)) {
            if (!moe) {
                PH_CTX();
                const float* modl = WSP(float, WS_MODS) + (size_t)(l * 2 + 0) * 6144;
                int tp, sp; pg8::tail_params(nrows / 256, 4, DFF / 64, G, tp, sp);
                pg8::TailOrder S; S.dense(WSP(bf16_t, WS_ACT), WSP(bf16_t, WS_FDN) + (size_t)(l >> 1) * DM * DFF, DFF, DM, nrows / 256, G, bid, tp, sp);
                pg8::EpiResid E{WSP(bf16_t, WS_Y), modl + 5 * 1024, modl + 6144 + 5 * 1024, WSP(float, WS_YP), nrows - tp * 256, tp * 256};
                pg8::gemm_phase<pg8::EpiResid, pg8::TailOrder>(lds, DFF, S, E, tid);
            } else {
                PH_CTX();
                MOE_TS();
                int tp, sp; pg8::tail_params(ts8, 4, DEXP / 128, G, tp, sp);
                pg8::TailOrder S; S.dense(WSP(bf16_t, WS_ACT), WSP(unsigned char, WS_MDN) + (size_t)(l >> 1) * 8 * DM * DEXP, DEXP / 2, DM, ts8, G, bid, tp, sp);
                S.ts1 = ts1; S.ts2 = ts2; S.ts3 = ts3; S.ts4 = ts4; S.ts5 = ts5; S.ts6 = ts6; S.ts7 = ts7;
                pg8::EpiRaw E{WSP(bf16_t, WS_YS), WSP(float, WS_YP), (ts8 - tp) * 256, tp * 256, 1.f / (MDN_SCALE * ACT_SCALE)};
                pg8::gemm_phase<pg8::EpiRaw, pg8::TailOrder, true>(lds, DEXP / 2, S, E, tid);
            }
            SEAM(pb + 8);
        }
        if (IN(pb + 9)) {
            PH_CTX();
            float* X = WSP(float, WS_X); bf16_t* H = WSP(bf16_t, WS_H); const bf16_t* Yb = WSP(bf16_t, WS_Y); const bf16_t* YS = WSP(bf16_t, WS_YS);
            const float* modl = WSP(float, WS_MODS) + (size_t)(l * 2 + 0) * 6144;
            const float* lw = ap->in[14] + (size_t)(l * 2 + 1) * DM; const float* lb = ap->in[15] + (size_t)(l * 2 + 1) * DM;
            int tp, sp, tail0; const float* YP = WSP(float, WS_YP);
            MOE_TS();
            if (!moe) { pg8::tail_params(nrows / 256, 4, DFF / 64, G, tp, sp); tail0 = nrows - tp * 256; }
            else { pg8::tail_params(ts8, 4, DEXP / 128, G, tp, sp); tail0 = (ts8 - tp) * 256; }
            for (int r = gw; r < nrows; r += NGW) {
                const int wch = r >= SEQ; const float* md = modl + wch * 6144;
                f32x4 v[4];
                if (!moe) {
                    if (r < tail0) {
#pragma unroll
                        for (int j = 0; j < 4; ++j) v[j] = *(const f32x4*)(X + (size_t)r * DM + 4 * lane + 256 * j) * ALPHA + ld4bf(Yb + (size_t)r * DM + 4 * lane + 256 * j);
                    } else {
#pragma unroll
                        for (int j = 0; j < 4; ++j) { const int c = 4 * lane + 256 * j; f32x4 a4 = (f32x4){0.f, 0.f, 0.f, 0.f};
                            for (int p = 0; p < sp; ++p) a4 = a4 + *(const f32x4*)(YP + ((size_t)p * tp * 256 + (r - tail0)) * DM + c);
                            v[j] = *(const f32x4*)(X + (size_t)r * DM + c) * ALPHA + *(const f32x4*)(md + 5 * 1024 + c) * a4; }
                    }
                } else {
                    const int2 ee = WSP(int2, WS_TOKE)[r], pp = WSP(int2, WS_TOKP)[r]; const float2 ww = WSP(float2, WS_TOKW)[r];
                    int2 ss;
                    ss.x = 256 * (ee.x == 0 ? ts0 : ee.x == 1 ? ts1 : ee.x == 2 ? ts2 : ee.x == 3 ? ts3 : ee.x == 4 ? ts4 : ee.x == 5 ? ts5 : ee.x == 6 ? ts6 : ts7) + pp.x;
                    ss.y = 256 * (ee.y == 0 ? ts0 : ee.y == 1 ? ts1 : ee.y == 2 ? ts2 : ee.y == 3 ? ts3 : ee.y == 4 ? ts4 : ee.y == 5 ? ts5 : ee.y == 6 ? ts6 : ts7) + pp.y;
#pragma unroll
                    for (int j = 0; j < 4; ++j) { const int c = 4 * lane + 256 * j;
                        f32x4 y0, y1;
                        if (ss.x < tail0) y0 = ld4bf(YS + (size_t)ss.x * DM + c);
                        else { y0 = (f32x4){0.f, 0.f, 0.f, 0.f}; for (int p = 0; p < sp; ++p) y0 = y0 + *(const f32x4*)(YP + ((size_t)p * tp * 256 + (ss.x - tail0)) * DM + c); }
                        if (ss.y < tail0) y1 = ld4bf(YS + (size_t)ss.y * DM + c);
                        else { y1 = (f32x4){0.f, 0.f, 0.f, 0.f}; for (int p = 0; p < sp; ++p) y1 = y1 + *(const f32x4*)(YP + ((size_t)p * tp * 256 + (ss.y - tail0)) * DM + c); }
                        const f32x4 xv = *(const f32x4*)(X + (size_t)r * DM + c), g5 = *(const f32x4*)(md + 5 * 1024 + c);
                        v[j] = xv * ALPHA + g5 * (y0 * ww.x + y1 * ww.y); }
                }
                ln16(v, lw, lb, lane);
                if (lastl) {
#pragma unroll
                    for (int j = 0; j < 4; ++j) *(f32x4*)(ap->out + (size_t)r * DM + 4 * lane + 256 * j) = v[j];
                } else {
#pragma unroll
                    for (int j = 0; j < 4; ++j) *(f32x4*)(X + (size_t)r * DM + 4 * lane + 256 * j) = v[j];
                    const float* mdn = modl + 2 * 6144 + wch * 6144;
                    mod_store(v, mdn, mdn + 1024, H + (size_t)r * DM, lane);
                }
            }
            SEAM(pb + 9);
        }
    }
#undef IN
#undef SEAM
}

extern "C" void kernel_launch(void* const* d_in, const int* in_sizes, int n_in, void* d_out, int out_size, void* d_ws, size_t ws_size, hipStream_t stream) {
    static int grid = 0;
    if (grid == 0) {
        if (n_in != 22 || ws_size < WS_END) { fprintf(stderr, "kernel_launch: unexpected n_in %d / ws %zu (need %zu)\n", n_in, ws_size, (size_t)WS_END); grid = -1; return; }
        int dev = 0, cus = 0;
        if (hipGetDevice(&dev) != hipSuccess || hipDeviceGetAttribute(&cus, hipDeviceAttributeMultiprocessorCount, dev) != hipSuccess) { grid = -1; return; }
        if (hipFuncSetAttribute((const void*)fwd, hipFuncAttributeMaxDynamicSharedMemorySize, LDS_BYTES) != hipSuccess) { fprintf(stderr, "kernel_launch: hipFuncSetAttribute failed\n"); grid = -1; return; }
        int per_cu = 0;
        if (hipOccupancyMaxActiveBlocksPerMultiprocessor(&per_cu, (const void*)fwd, 512, LDS_BYTES) != hipSuccess || per_cu < 1) fprintf(stderr, "kernel_launch: occupancy query reports %d\n", per_cu);
        (void)hipGetLastError();
        grid = cus;
    }
    if (grid < 0) return;
    (void)hipMemsetAsync((char*)d_ws + WS_CTL, 0, CTL_BYTES, stream);
    Args a{};
    for (int i = 0; i < 22; ++i) a.in[i] = (const float*)d_in[i];
    a.out = (float*)d_out; a.ws = (unsigned char*)d_ws;
#if MK_ONE_LAUNCH
    a.ph_lo = 0; a.ph_hi = NPH;
    hipLaunchKernelGGL(fwd, dim3(grid), dim3(512), LDS_BYTES, stream, a);
#else
    for (int p = 0; p < NPH; ++p) {
        if (p >= 2 && ((p - 2) % 10) == 6 && ((((p - 2) / 10) & 1) == 0)) continue;
        a.ph_lo = p; a.ph_hi = p + 1;
        hipLaunchKernelGGL(fwd, dim3(grid), dim3(512), LDS_BYTES, stream, a);
    }
#endif
}
```

```cpp
#include <hip/hip_runtime.h>
#include <cstdio>
#include <cstdint>

#ifndef MK_ONE_LAUNCH
#define MK_ONE_LAUNCH 1
#endif

#ifndef DUP_MASK
#define DUP_MASK 0
#endif
#define PHASE_REP(k) for (int rep_ = 0; rep_ < 1 + ((DUP_MASK >> (k)) & 1); ++rep_)
#define LAS __attribute__((address_space(3)))
#define GAS __attribute__((address_space(1)))
typedef unsigned short bf16_t;
typedef short bf16x8 __attribute__((ext_vector_type(8)));
typedef float f32x4 __attribute__((ext_vector_type(4)));
typedef unsigned u32x4 __attribute__((ext_vector_type(4)));
typedef unsigned u32x2_t __attribute__((ext_vector_type(2)));

constexpr int DM = 1024, SEQ = 16384, NCTX = 256, TT = SEQ + NCTX, DEPTH = 4;
constexpr int IN_COLS = 2608, NPIN = 2816, LDP = 2816;
constexpr int C_MQ = 0, C_MK = 256, C_MV = 512, C_MO = 768, C_AQ = 1024, C_AK = 1536, C_AV = 1664, C_GQ = 1792, C_GK = 1920, C_GV = 2048, C_GG = 2304, C_MG = 2560, C_GGT = 2576, C_END = 2608;
constexpr int DFF = 2816, DEXP = 3584, NEXP = 8;
constexpr int NCH = 260;
constexpr int NSLOT = 138 * 256;
constexpr float ALPHA = 1.6817928305074290f;
constexpr float LN_EPS = 1e-5f;
constexpr float MGU_SCALE = 32.f, MDN_SCALE = 256.f, ACT_SCALE = 4.f;
constexpr int NPH = 2 + 10 * DEPTH;

constexpr size_t al256(size_t x) { return (x + 255) & ~size_t(255); }
constexpr size_t WS_CTL = 0, CTL_BYTES = 2u << 20;
constexpr size_t WS_MODS = 1u << 20;
constexpr size_t WS_ROPE = CTL_BYTES;
constexpr size_t WS_TOKE = WS_ROPE + 32768;
constexpr size_t WS_TOKP = WS_TOKE + al256((size_t)TT * 8);
constexpr size_t WS_TOKW = WS_TOKP + al256((size_t)TT * 8);
constexpr size_t WS_TOKS = WS_TOKW + al256((size_t)TT * 8);
constexpr size_t WS_WIN = WS_TOKS + al256((size_t)TT * 8);
constexpr size_t WS_WOUT = WS_WIN + (size_t)DEPTH * NPIN * DM * 2;
constexpr size_t WS_FGU = WS_WOUT + (size_t)DEPTH * DM * DM * 2;
constexpr size_t WS_FDN = WS_FGU + (size_t)2 * 2 * DFF * DM * 2;
constexpr size_t WS_MGU = WS_FDN + (size_t)2 * DM * DFF * 2;
constexpr size_t WS_MDN = WS_MGU + (size_t)16 * 2 * DEXP * DM * 2;
constexpr size_t WS_X = WS_MDN + (size_t)16 * DM * DEXP * 2;
constexpr size_t WS_H = WS_X + (size_t)TT * DM * 4;
constexpr size_t WS_P = WS_H + (size_t)TT * DM * 2;
constexpr size_t WS_G = WS_P + (size_t)TT * LDP * 2;
constexpr size_t WS_CAT = WS_G + al256((size_t)TT * 48 * 4);
constexpr size_t WS_Y = WS_CAT + (size_t)TT * DM * 2;
constexpr size_t WS_ACT = WS_Y + (size_t)TT * DM * 4;
constexpr size_t WS_XB = WS_ACT + (size_t)NSLOT * DEXP * 2;
constexpr size_t WS_YS = WS_XB + (size_t)NEXP * TT * DM * 2;
constexpr size_t WS_MU = WS_YS + (size_t)NSLOT * DM * 4;
constexpr size_t WS_MC = WS_MU + (size_t)8 * NCH * 4096 * 4;
constexpr size_t WS_MNU = WS_MC + (size_t)8 * NCH * 4096 * 4;
constexpr size_t WS_MNS = WS_MNU + (size_t)8 * NCH * 64 * 4;
constexpr size_t WS_MSC = WS_MNS + (size_t)8 * NCH * 64 * 4;
constexpr size_t WS_GU = WS_MSC + al256((size_t)8 * NCH * 4 * 4);
constexpr size_t WS_GS = WS_GU + (size_t)8 * NCH * 2048 * 4;
constexpr size_t WS_GDEC = WS_GS + (size_t)8 * NCH * 2048 * 4;
constexpr size_t WS_YP = WS_GDEC + (size_t)8 * NCH * 32 * 4;
constexpr size_t WS_END = WS_YP + (size_t)256 * 256 * 256 * 4;

constexpr int CW_BAR = 4096;
constexpr int CW_MOE = 16384;

constexpr int LDS_BYTES = 147456, MISC_OFF = 147200;

__device__ __forceinline__ float bf2f(unsigned v) { return __uint_as_float(v << 16); }
__device__ __forceinline__ unsigned f2bf(float f) { unsigned u = __float_as_uint(f); return (u + 0x7fffu + ((u >> 16) & 1u)) >> 16; }
__device__ __forceinline__ unsigned pk2(float lo, float hi) { return f2bf(lo) | (f2bf(hi) << 16); }
__device__ __forceinline__ void load8bf(const bf16_t* p, float* o) {
    const uint4 v = *(const uint4*)p;
    o[0] = __uint_as_float(v.x << 16); o[1] = __uint_as_float(v.x & 0xffff0000u); o[2] = __uint_as_float(v.y << 16); o[3] = __uint_as_float(v.y & 0xffff0000u);
    o[4] = __uint_as_float(v.z << 16); o[5] = __uint_as_float(v.z & 0xffff0000u); o[6] = __uint_as_float(v.w << 16); o[7] = __uint_as_float(v.w & 0xffff0000u);
}
__device__ __forceinline__ float wave_sum(float v) {
#pragma unroll
    for (int o = 1; o < 64; o <<= 1) v += __shfl_xor(v, o);
    return v;
}
__device__ __forceinline__ float wave_max(float v) {
#pragma unroll
    for (int o = 1; o < 64; o <<= 1) v = fmaxf(v, __shfl_xor(v, o));
    return v;
}
template <int CTRL, int RM> __device__ __forceinline__ float dpp_mov(float old, float v) {
    return __uint_as_float(__builtin_amdgcn_update_dpp(__float_as_uint(old), __float_as_uint(v), CTRL, RM, 0xF, false)); }
__device__ __forceinline__ float scan_add(float v, int) {
    v += dpp_mov<0x111, 0xF>(0.f, v); v += dpp_mov<0x112, 0xF>(0.f, v); v += dpp_mov<0x114, 0xF>(0.f, v); v += dpp_mov<0x118, 0xF>(0.f, v);
    v += dpp_mov<0x142, 0xA>(0.f, v); v += dpp_mov<0x143, 0xC>(0.f, v);
    return v;
}
__device__ __forceinline__ float scan_max(float v, int) {
    v = fmaxf(v, dpp_mov<0x111, 0xF>(-INFINITY, v)); v = fmaxf(v, dpp_mov<0x112, 0xF>(-INFINITY, v)); v = fmaxf(v, dpp_mov<0x114, 0xF>(-INFINITY, v)); v = fmaxf(v, dpp_mov<0x118, 0xF>(-INFINITY, v));
    v = fmaxf(v, dpp_mov<0x142, 0xA>(-INFINITY, v)); v = fmaxf(v, dpp_mov<0x143, 0xC>(-INFINITY, v));
    return v;
}
__device__ __forceinline__ float siluf(float x) { return x * __builtin_amdgcn_rcpf(1.f + __expf(-x)); }
__device__ __forceinline__ float sigmoidf_(float x) { return __builtin_amdgcn_rcpf(1.f + __expf(-x)); }
__device__ __forceinline__ float log_sigmoidf_(float x) {
    const float t = __expf(-fabsf(x)); const float l1p = (t < 0.01f) ? t * (1.f + t * (-0.5f + t * 0.33333333f)) : __logf(1.f + t); return fminf(x, 0.f) - l1p; }
typedef short s16x4 __attribute__((ext_vector_type(4)));
typedef short v4i16_t __attribute__((ext_vector_type(4)));
typedef float f32x2_t __attribute__((ext_vector_type(2))); typedef __bf16 bf16x2_t __attribute__((ext_vector_type(2)));
__device__ __forceinline__ unsigned cvtpk(float lo, float hi) { f32x2_t v = {lo, hi}; bf16x2_t b = __builtin_convertvector(v, bf16x2_t); return __builtin_bit_cast(unsigned, b); }
__device__ __forceinline__ s16x4 ds_tr16(const LAS unsigned char* p) { return __builtin_bit_cast(s16x4, __builtin_amdgcn_ds_read_tr16_b64_v4i16((LAS v4i16_t*)p)); }
__device__ __forceinline__ bf16x8 cat44(s16x4 a, s16x4 b) { return __builtin_shufflevector(a, b, 0, 1, 2, 3, 4, 5, 6, 7); }
#define MFMA16(a, b, c) __builtin_amdgcn_mfma_f32_16x16x32_bf16(a, b, c, 0, 0, 0)
__device__ __forceinline__ float grp_max(float v) {
    const auto a = __builtin_amdgcn_permlane16_swap(__float_as_uint(v), __float_as_uint(v), false, false); v = fmaxf(__uint_as_float(a[0]), __uint_as_float(a[1]));
    const auto b = __builtin_amdgcn_permlane32_swap(__float_as_uint(v), __float_as_uint(v), false, false); return fmaxf(__uint_as_float(b[0]), __uint_as_float(b[1])); }
__device__ __forceinline__ float grp_sum(float v) {
    const auto a = __builtin_amdgcn_permlane16_swap(__float_as_uint(v), __float_as_uint(v), false, false); v = __uint_as_float(a[0]) + __uint_as_float(a[1]);
    const auto b = __builtin_amdgcn_permlane32_swap(__float_as_uint(v), __float_as_uint(v), false, false); return __uint_as_float(b[0]) + __uint_as_float(b[1]); }
__device__ __forceinline__ unsigned pk4_fp8(float a, float b, float c, float d) { int w = 0; w = __builtin_amdgcn_cvt_pk_fp8_f32(a, b, w, false); w = __builtin_amdgcn_cvt_pk_fp8_f32(c, d, w, true); return (unsigned)w; }
#define LDS_WAIT() asm volatile("s_waitcnt lgkmcnt(0)" ::: "memory")

namespace pg8 {
constexpr int BM = 256, BK = 64, HALF = 128, HTB = HALF * BK * 2, STAGE_BYTES = 8 * HTB, NXCD = 8, WGM = 8;
__host__ __device__ __forceinline__ int lds_byte(int r, int c) { const int st = (r >> 4) * 2 + (c >> 5), rr = r & 15, cc = c & 31, ob = rr * 64 + cc * 2; return st * 1024 + (ob ^ (((ob >> 9) & 1) << 5)); }
__host__ __device__ __forceinline__ void stage_rc(int b, int& R, int& C) { const int st = b / 1024, sb = b % 1024, swz = sb ^ (((sb >> 9) & 1) << 5); R = (st >> 1) * 16 + swz / 64; C = (st & 1) * 32 + (swz % 64) / 2; }
__host__ __device__ __forceinline__ int perm32(int rho) { const int n = rho >> 4, i = rho & 15; return 8 * (i >> 2) + 4 * n + (i & 3); }
struct Unit { int pm, pn, kt0, nkt, part; };

struct StaticOrder {
    const char* A; const char* Bt; int K;
    int nM, nN, nwg, G, c;
    __device__ void init(const void* A_, const void* Bt_, int K_, int M, int N, int G_, int c_) { A = (const char*)A_; Bt = (const char*)Bt_; K = K_; nM = M / BM; nN = N / BM; nwg = nM * nN; G = G_; c = c_; }
    __device__ __forceinline__ bool next(int i, Unit& u) const {
        const long L = (long)i * G + c; if (L >= nwg) return false;
        int wgid = (int)L; { const int q = nwg / NXCD, r = nwg % NXCD, xcd = wgid % NXCD, off = wgid / NXCD; wgid = (xcd < r ? xcd * (q + 1) : r * (q + 1) + (xcd - r) * q) + off; }
        const int nig = WGM * nN, gid = wgid / nig, fm = gid * WGM, gsz = (nM - fm) < WGM ? (nM - fm) : WGM;
        u.pm = fm + ((wgid % nig) % gsz); u.pn = (wgid % nig) / gsz; u.kt0 = 0; u.nkt = K / BK; u.part = -1; return true;
    }
    __device__ __forceinline__ unsigned aoff(const Unit& u) const { return (unsigned)(u.pm * BM * K * 2); }
    __device__ __forceinline__ unsigned boff(const Unit& u) const { return (unsigned)(u.pn * BM * K * 2); }
};
struct MoeOrder {
    const char* A; const char* Bt; int K, N, nN, ntile, G, c;
    int ts1, ts2, ts3, ts4, ts5, ts6, ts7;
    __device__ __forceinline__ bool next(int i, Unit& u) const {
        const long L = (long)i * G + c; if (L >= (long)ntile * nN) return false;
        u.pm = (int)(L / nN); u.pn = (int)(L % nN); u.kt0 = 0; u.nkt = K / BK; u.part = -1; return true;
    }
    __device__ __forceinline__ int expert(int pm) const { return (pm >= ts1) + (pm >= ts2) + (pm >= ts3) + (pm >= ts4) + (pm >= ts5) + (pm >= ts6) + (pm >= ts7); }
    __device__ __forceinline__ unsigned aoff(const Unit& u) const {
        const int e = expert(u.pm); const int t0 = e == 0 ? 0 : e == 1 ? ts1 : e == 2 ? ts2 : e == 3 ? ts3 : e == 4 ? ts4 : e == 5 ? ts5 : e == 6 ? ts6 : ts7;
        return (unsigned)((e * TT + (u.pm - t0) * BM) * K * 2); }
    __device__ __forceinline__ unsigned boff(const Unit& u) const { return (unsigned)((expert(u.pm) * N + u.pn * BM) * K * 2); }
};
struct TailOrder {
    const char* A; const char* Bt; int K, N, nN, npan, G, c, tp, s;
    int ts1, ts2, ts3, ts4, ts5, ts6, ts7;
    __device__ __forceinline__ void dense(const void* A_, const void* Bt_, int K_, int N_, int npan_, int G_, int c_, int tp_, int s_) {
        A = (const char*)A_; Bt = (const char*)Bt_; K = K_; N = N_; nN = N_ / BM; npan = npan_; G = G_; c = c_; tp = tp_; s = s_;
        ts1 = ts2 = ts3 = ts4 = ts5 = ts6 = ts7 = 0x7fffffff; }
    __device__ __forceinline__ bool next(int i, Unit& u) const {
        const int L = i * G + c, nfull = (npan - tp) * nN, ksub = (K / BK) / s;
        const bool tail = L >= nfull; const int j = L - nfull, tu = tp * nN, tu1 = tu > 0 ? tu : 1;
        const int part = tail ? j / tu1 : -1, r = tail ? j % tu1 : 0;
        u.part = part; u.pm = tail ? (npan - tp) + r / nN : L / nN; u.pn = tail ? r % nN : L % nN; u.kt0 = tail ? part * ksub : 0; u.nkt = tail ? ksub : K / BK;
        return tail ? (j < tu * s) : true;
    }
    __device__ __forceinline__ int expert(int pm) const { return (pm >= ts1) + (pm >= ts2) + (pm >= ts3) + (pm >= ts4) + (pm >= ts5) + (pm >= ts6) + (pm >= ts7); }
    __device__ __forceinline__ unsigned aoff(const Unit& u) const { return (unsigned)((u.pm * BM * K + u.kt0 * BK) * 2); }
    __device__ __forceinline__ unsigned boff(const Unit& u) const { return (unsigned)((((expert(u.pm) * N + u.pn * BM) * K) + u.kt0 * BK) * 2); }
};
__device__ __forceinline__ void tail_params(int npan, int nN, int nkt, int G, int& tp, int& s) {
    const int rem = (npan * nN) % G;
    tp = 0; s = 1;
    if (rem == 0 || (rem % nN) != 0) return;
    int best = 1;
    if (nkt == 16) { if (rem * 4 <= G) best = 4; else if (rem * 2 <= G) best = 2; }
    else if (nkt == 44) { if (rem * 11 <= G) best = 11; else if (rem * 2 <= G) best = 2; }
    else if (nkt == 28) { if (rem * 7 <= G) best = 7; else if (rem * 2 <= G) best = 2; }
    else if (nkt == 56) { if (rem * 14 <= G) best = 14; else if (rem * 7 <= G) best = 7; else if (rem * 4 <= G) best = 4; else if (rem * 2 <= G) best = 2; }
    if (best > 1) { tp = rem / nN; s = best; }
}

typedef int v8i32 __attribute__((ext_vector_type(8)));
typedef int i32x4 __attribute__((ext_vector_type(4)));
template <class Epi, class Sched, bool F8 = false>
__device__ __forceinline__ void gemm_phase(LAS unsigned char* lds, const int K, const Sched& S, const Epi& E, const int tid) {
    const int wid = __builtin_amdgcn_readfirstlane(tid >> 6), lane = tid & 63, wr = wid >> 2, wc = wid & 3, fr = lane & 15, fq = lane >> 4;
    unsigned voffA[2], voffB[2];
#pragma unroll
    for (int i = 0; i < 2; ++i) { int R, C; stage_rc(tid * 16 + i * 8192, R, C); const int Rb = Epi::PERM ? ((R & ~31) + perm32(R & 31)) : R;
        voffA[i] = (unsigned)(R * K + C) * 2u; voffB[i] = (unsigned)(Rb * K + C) * 2u; }
    const unsigned kstep = (unsigned)(BK * 2);
    const unsigned hstep = (unsigned)(HALF * K * 2);
    const __amdgpu_buffer_rsrc_t rA = __builtin_amdgcn_make_buffer_rsrc((void*)S.A, 0, 0x7ffffff0, 0x00020000), rB = __builtin_amdgcn_make_buffer_rsrc((void*)S.Bt, 0, 0x7ffffff0, 0x00020000);
    const unsigned ldsw = (unsigned)wid * 1024u;
    const int aoff = lds_byte(wr * 64 + fr, fq * 8), boff = lds_byte(wc * 32 + fr, fq * 8);
#define PG8_SA(b, h) (((b) * 2 + (h)) * HTB)
#define PG8_SB(b, h) ((4 + (b) * 2 + (h)) * HTB)
#define PG8_STAGE(bufoff, rs, soff, voff) do { _Pragma("unroll") for (int _i = 0; _i < 2; ++_i) \
        __builtin_amdgcn_raw_ptr_buffer_load_lds(rs, (LAS void*)(lds + (bufoff) + ldsw + _i * 8192), 16, (int)(voff)[_i], (int)(soff), 0, 0); } while (0)
#define PG8_LDA(dst, b, h) do { _Pragma("unroll") for (int m = 0; m < 4; ++m) { const i32x4 lo_ = *(const LAS i32x4*)(lds + PG8_SA(b, h) + aoff + m * 2048), hi_ = *(const LAS i32x4*)(lds + PG8_SA(b, h) + aoff + m * 2048 + 1024); \
        dst[m] = (v8i32){lo_[0], lo_[1], lo_[2], lo_[3], hi_[0], hi_[1], hi_[2], hi_[3]}; } } while (0)
#define PG8_LDB(dst, b, h) do { _Pragma("unroll") for (int n = 0; n < 2; ++n) { const i32x4 lo_ = *(const LAS i32x4*)(lds + PG8_SB(b, h) + boff + n * 2048), hi_ = *(const LAS i32x4*)(lds + PG8_SB(b, h) + boff + n * 2048 + 1024); \
        dst[n] = (v8i32){lo_[0], lo_[1], lo_[2], lo_[3], hi_[0], hi_[1], hi_[2], hi_[3]}; } } while (0)
#define PG8_LO(v) __builtin_bit_cast(bf16x8, __builtin_shufflevector(v, v, 0, 1, 2, 3))
#define PG8_HI(v) __builtin_bit_cast(bf16x8, __builtin_shufflevector(v, v, 4, 5, 6, 7))
#define PG8_MMA(ai, bj, At, Bt) do { __builtin_amdgcn_s_setprio(1); _Pragma("unroll") for (int m = 0; m < 4; ++m) _Pragma("unroll") for (int n = 0; n < 2; ++n) { \
        if constexpr (F8) acc[ai][bj][m][n] = __builtin_amdgcn_mfma_scale_f32_16x16x128_f8f6f4(Bt[n], At[m], acc[ai][bj][m][n], 0, 0, 0, 0x7f7f7f7f, 0, 0x7f7f7f7f); \
        else { acc[ai][bj][m][n] = __builtin_amdgcn_mfma_f32_16x16x32_bf16(PG8_LO(Bt[n]), PG8_LO(At[m]), acc[ai][bj][m][n], 0, 0, 0); \
               acc[ai][bj][m][n] = __builtin_amdgcn_mfma_f32_16x16x32_bf16(PG8_HI(Bt[n]), PG8_HI(At[m]), acc[ai][bj][m][n], 0, 0, 0); } } \
        __builtin_amdgcn_s_setprio(0); } while (0)
#define PG8_WAIT_V(n) asm volatile("s_waitcnt vmcnt(" #n ")" ::: "memory")
#define PG8_WAIT_L(n) asm volatile("s_waitcnt lgkmcnt(" #n ")" ::: "memory")
#define PG8_BAR __builtin_amdgcn_s_barrier()
#define PG8_SCHED __builtin_amdgcn_sched_barrier(0)
    Unit cur, nxt; int ui = 0;
    if (!S.next(0, cur)) return;
    f32x4 acc[2][2][4][2];
#pragma unroll
    for (int a = 0; a < 2; ++a)
#pragma unroll
        for (int b = 0; b < 2; ++b)
#pragma unroll
            for (int m = 0; m < 4; ++m)
#pragma unroll
                for (int n = 0; n < 2; ++n) acc[a][b][m][n] = (f32x4){0.f, 0.f, 0.f, 0.f};
    v8i32 At[4], B0[2], B1[2];
    unsigned cA = S.aoff(cur), cB = S.boff(cur);
    PG8_STAGE(PG8_SB(0, 0), rB, cB, voffB); PG8_STAGE(PG8_SB(0, 1), rB, cB + hstep, voffB); PG8_STAGE(PG8_SA(0, 0), rA, cA, voffA); PG8_STAGE(PG8_SA(0, 1), rA, cA + hstep, voffA);
    if (wr == 1) PG8_BAR;
    PG8_WAIT_V(2); PG8_BAR;
    PG8_STAGE(PG8_SB(1, 0), rB, cB + kstep, voffB); PG8_STAGE(PG8_SA(1, 0), rA, cA + kstep, voffA); PG8_STAGE(PG8_SB(1, 1), rB, cB + hstep + kstep, voffB);
    PG8_WAIT_V(6); PG8_BAR;
    for (;;) {
        const bool has_next = S.next(ui + 1, nxt);
        const unsigned nA = has_next ? S.aoff(nxt) : cA, nB = has_next ? S.boff(nxt) : cB;
        const int nt = cur.nkt;
        for (int t = 0; t < nt; t += 2) {
            const bool last = (t == nt - 2);
            const unsigned a1 = cA + (unsigned)(t + 1) * kstep;
            const unsigned a2 = last ? nA : cA + (unsigned)(t + 2) * kstep, b2 = last ? nB : cB + (unsigned)(t + 2) * kstep;
            const unsigned a3 = a2 + kstep, b3 = b2 + kstep;
            PG8_LDB(B0, 0, 0); PG8_LDB(B1, 0, 1); PG8_SCHED; PG8_LDA(At, 0, 0); PG8_STAGE(PG8_SA(1, 1), rA, a1 + hstep, voffA);
            PG8_WAIT_V(8); PG8_WAIT_L(0); PG8_BAR; PG8_MMA(0, 0, At, B0); PG8_MMA(0, 1, At, B1); PG8_BAR; PG8_SCHED;
            PG8_LDA(At, 0, 1); PG8_STAGE(PG8_SB(0, 0), rB, b2, voffB); PG8_STAGE(PG8_SB(0, 1), rB, b2 + hstep, voffB); PG8_STAGE(PG8_SA(0, 0), rA, a2, voffA);
            PG8_WAIT_V(8); PG8_WAIT_L(0); PG8_BAR; PG8_MMA(1, 0, At, B0); PG8_MMA(1, 1, At, B1); PG8_BAR; PG8_SCHED;
            PG8_LDB(B0, 1, 0); PG8_LDB(B1, 1, 1); PG8_SCHED; PG8_LDA(At, 1, 0); PG8_STAGE(PG8_SA(0, 1), rA, a2 + hstep, voffA);
            PG8_WAIT_V(8); PG8_WAIT_L(0); PG8_BAR; PG8_MMA(0, 0, At, B0); PG8_MMA(0, 1, At, B1); PG8_BAR; PG8_SCHED;
            PG8_LDA(At, 1, 1); PG8_STAGE(PG8_SB(1, 0), rB, b3, voffB); PG8_STAGE(PG8_SB(1, 1), rB, b3 + hstep, voffB); PG8_STAGE(PG8_SA(1, 0), rA, a3, voffA);
            PG8_WAIT_V(8); PG8_WAIT_L(0); PG8_BAR; PG8_MMA(1, 0, At, B0); PG8_MMA(1, 1, At, B1); PG8_BAR; PG8_SCHED;
        }
        if (wr == 0) PG8_BAR;
        { unsigned on_ = ~0u; asm volatile("" : "+s"(on_)); const int l2_ = (int)__builtin_amdgcn_mbcnt_hi(on_, __builtin_amdgcn_mbcnt_lo(on_, 0u));
          E(acc, cur, wr, wc, l2_ & 15, l2_ >> 4); }
        if (!has_next) break;
#pragma unroll
        for (int a = 0; a < 2; ++a)
#pragma unroll
            for (int b = 0; b < 2; ++b)
#pragma unroll
                for (int m = 0; m < 4; ++m)
#pragma unroll
                    for (int n = 0; n < 2; ++n) acc[a][b][m][n] = (f32x4){0.f, 0.f, 0.f, 0.f};
        cur = nxt; cA = nA; cB = nB; ++ui;
        if (wr == 1) PG8_BAR;
    }
    PG8_WAIT_V(0);
    PG8_BAR;
#undef PG8_SA
#undef PG8_SB
#undef PG8_STAGE
#undef PG8_LDA
#undef PG8_LDB
#undef PG8_MMA
#undef PG8_WAIT_V
#undef PG8_WAIT_L
#undef PG8_BAR
#undef PG8_SCHED
}


struct EpiInProj {
    static constexpr bool PERM = true;
    bf16_t* P; float* Gt; const float* ropeC; const float* ropeS;
    __device__ __forceinline__ void operator()(const f32x4 (&acc)[2][2][4][2], const Unit& u, int wr, int wc, int fr, int fq) const {
        const int row0 = u.pm * BM + wr * 64 + fr;
        const bool latent = u.pm < (SEQ / BM);
#pragma unroll
        for (int bj = 0; bj < 2; ++bj) {
            const int colg = u.pn * BM + bj * HALF + wc * 32;
            const bool rope = latent && colg >= C_AQ && colg < C_AV;
            const bool gate = colg >= C_MG && colg < C_END;
            const int col0 = colg + 8 * fq;
#pragma unroll
            for (int ai = 0; ai < 2; ++ai)
#pragma unroll
                for (int m = 0; m < 4; ++m) {
                    const int row = row0 + ai * HALF + m * 16;
                    f32x4 v0 = acc[ai][bj][m][0], v1 = acc[ai][bj][m][1];
                    if (rope) {
                        const int pos = ((colg >> 5) & 1) ? (row & 63) : (row >> 6);
                        const f32x4 c0 = *(const f32x4*)(ropeC + pos * 16 + 8 * (fq & 1)), c1 = *(const f32x4*)(ropeC + pos * 16 + 8 * (fq & 1) + 4);
                        const f32x4 s0 = *(const f32x4*)(ropeS + pos * 16 + 8 * (fq & 1)), s1 = *(const f32x4*)(ropeS + pos * 16 + 8 * (fq & 1) + 4);
                        const float sg = (fq < 2) ? -1.f : 1.f;
                        f32x4 p0, p1;
#pragma unroll
                        for (int i = 0; i < 4; ++i) { p0[i] = __shfl_xor(v0[i], 32); p1[i] = __shfl_xor(v1[i], 32); }
#pragma unroll
                        for (int i = 0; i < 4; ++i) { v0[i] = v0[i] * c0[i] + sg * p0[i] * s0[i]; v1[i] = v1[i] * c1[i] + sg * p1[i] * s1[i]; }
                    }
                    u32x4 w; w.x = cvtpk(v0[0], v0[1]); w.y = cvtpk(v0[2], v0[3]); w.z = cvtpk(v1[0], v1[1]); w.w = cvtpk(v1[2], v1[3]);
                    *(u32x4*)(P + (size_t)row * LDP + col0) = w;
                    if (gate && col0 < C_END) { float* g = Gt + (size_t)row * 48 + (col0 - C_MG); *(f32x4*)g = v0; *(f32x4*)(g + 4) = v1; }
                    asm volatile("" ::: "memory");
                }
        }
    }
};
struct EpiResid {
    static constexpr bool PERM = true;
    bf16_t* Yb; const float* modl; const float* modc; float* YP; int tail_row0, tail_rows;
    __device__ __forceinline__ void operator()(const f32x4 (&acc)[2][2][4][2], const Unit& u, int wr, int wc, int fr, int fq) const {
        const int row0 = u.pm * BM + wr * 64 + fr, col0 = u.pn * BM + wc * 32 + 8 * fq;
        if (u.part >= 0) {
#pragma unroll
            for (int ai = 0; ai < 2; ++ai)
#pragma unroll
                for (int m = 0; m < 4; ++m) { float* rowp = YP + ((size_t)u.part * tail_rows + (row0 + ai * HALF + m * 16 - tail_row0)) * DM + col0;
#pragma unroll
                    for (int bj = 0; bj < 2; ++bj)
#pragma unroll
                        for (int n = 0; n < 2; ++n) *(f32x4*)(rowp + bj * HALF + n * 4) = acc[ai][bj][m][n]; }
            return;
        }
        const float* md = (u.pm < SEQ / BM) ? modl : modc;
        f32x4 mv[2][2];
#pragma unroll
        for (int bj = 0; bj < 2; ++bj)
#pragma unroll
            for (int n = 0; n < 2; ++n) mv[bj][n] = *(const f32x4*)(md + col0 + bj * HALF + n * 4);
#pragma unroll
        for (int ai = 0; ai < 2; ++ai)
#pragma unroll
            for (int m = 0; m < 4; ++m) { bf16_t* rowp = Yb + (size_t)(row0 + ai * HALF + m * 16) * DM + col0;
#pragma unroll
                for (int bj = 0; bj < 2; ++bj) { const f32x4 v0 = mv[bj][0] * acc[ai][bj][m][0], v1 = mv[bj][1] * acc[ai][bj][m][1];
                    u32x4 w; w.x = cvtpk(v0[0], v0[1]); w.y = cvtpk(v0[2], v0[3]); w.z = cvtpk(v1[0], v1[1]); w.w = cvtpk(v1[2], v1[3]);
                    *(u32x4*)(rowp + bj * HALF) = w; } }
    }
};
template <bool O8 = false> struct EpiSwigluT {
    static constexpr bool PERM = true;
    bf16_t* O; int ld; float sc; float osc;
    __device__ __forceinline__ void operator()(const f32x4 (&acc)[2][2][4][2], const Unit& u, int wr, int wc, int fr, int fq) const {
        const int row0 = u.pm * BM + wr * 64 + fr, col0 = u.pn * HALF + wc * 32 + 8 * fq;
#pragma unroll
        for (int ai = 0; ai < 2; ++ai)
#pragma unroll
            for (int m = 0; m < 4; ++m) {
                const f32x4 g0 = acc[ai][0][m][0], g1 = acc[ai][0][m][1], u0 = acc[ai][1][m][0], u1 = acc[ai][1][m][1];
                float r[8];
#pragma unroll
                for (int i = 0; i < 4; ++i) { r[i] = siluf(g0[i] * sc) * (u0[i] * sc); r[4 + i] = siluf(g1[i] * sc) * (u1[i] * sc); }
                if constexpr (O8) { uint2 w; w.x = pk4_fp8(r[0] * osc, r[1] * osc, r[2] * osc, r[3] * osc); w.y = pk4_fp8(r[4] * osc, r[5] * osc, r[6] * osc, r[7] * osc);
                    *(uint2*)((unsigned char*)O + (size_t)(row0 + ai * HALF + m * 16) * ld + col0) = w; }
                else { u32x4 w; w.x = cvtpk(r[0], r[1]); w.y = cvtpk(r[2], r[3]); w.z = cvtpk(r[4], r[5]); w.w = cvtpk(r[6], r[7]);
                    *(u32x4*)(O + (size_t)(row0 + ai * HALF + m * 16) * ld + col0) = w; }
            }
    }
};
typedef EpiSwigluT<false> EpiSwiglu;
struct EpiRaw {
    static constexpr bool PERM = true;
    bf16_t* C; float* YP; int tail_row0, tail_rows; float sc;
    __device__ __forceinline__ void operator()(const f32x4 (&acc)[2][2][4][2], const Unit& u, int wr, int wc, int fr, int fq) const {
        const int row0 = u.pm * BM + wr * 64 + fr, col0 = u.pn * BM + wc * 32 + 8 * fq;
        if (u.part >= 0) {
#pragma unroll
            for (int ai = 0; ai < 2; ++ai)
#pragma unroll
                for (int m = 0; m < 4; ++m) { float* rowp = YP + ((size_t)u.part * tail_rows + (row0 + ai * HALF + m * 16 - tail_row0)) * DM + col0;
#pragma unroll
                    for (int bj = 0; bj < 2; ++bj)
#pragma unroll
                        for (int n = 0; n < 2; ++n) *(f32x4*)(rowp + bj * HALF + n * 4) = acc[ai][bj][m][n] * sc; }
            return;
        }
#pragma unroll
        for (int ai = 0; ai < 2; ++ai)
#pragma unroll
            for (int m = 0; m < 4; ++m) { bf16_t* rowp = C + (size_t)(row0 + ai * HALF + m * 16) * DM + col0;
#pragma unroll
                for (int bj = 0; bj < 2; ++bj) { const f32x4 v0 = acc[ai][bj][m][0] * sc, v1 = acc[ai][bj][m][1] * sc;
                    u32x4 w; w.x = cvtpk(v0[0], v0[1]); w.y = cvtpk(v0[2], v0[3]); w.z = cvtpk(v1[0], v1[1]); w.w = cvtpk(v1[2], v1[3]);
                    *(u32x4*)(rowp + bj * HALF) = w; } }
    }
};
}

#define XB_TMO      128
#define XB_XCNT(j)  (256  + 64 * (j))
#define XB_XSUB(j)  (1280 + 64 * (j))
#define XB_XGEN(j)  (2304 + 64 * (j))
#define XB_TOP      3328
#define XB_TOPGEN   3392
#define XCD_BAR_WORDS 3456
#define XB_SPIN_CAP (1u << 18)
__device__ __forceinline__ unsigned xb_ld(unsigned* p)              { return __hip_atomic_load(p, __ATOMIC_RELAXED, __HIP_MEMORY_SCOPE_AGENT); }
__device__ __forceinline__ unsigned xb_add(unsigned* p, unsigned v) { return __hip_atomic_fetch_add(p, v, __ATOMIC_RELAXED, __HIP_MEMORY_SCOPE_AGENT); }
__device__ __forceinline__ unsigned xb_xcc_id() { return (unsigned)__builtin_amdgcn_s_getreg((3 << 11) | 20) & 0xFu; }
#define XB_SPIN(cond, bar) do { unsigned _sp = 0; while (cond) { __builtin_amdgcn_s_sleep(1); \
    if ((++_sp & 255u) == 0u) { if (xb_ld(&(bar)[XB_TMO])) break; if (_sp > XB_SPIN_CAP) { atomicAdd(&(bar)[XB_TMO], 1u); break; } } } } while (0)
struct XcdBarrier { unsigned* bar; unsigned x; volatile LAS unsigned* st; };
__device__ __forceinline__ XcdBarrier xcd_barrier_post(unsigned* bar, volatile LAS unsigned* st) {
    XcdBarrier b; b.bar = bar; b.x = xb_xcc_id(); b.st = st;
    if (threadIdx.x == 0) (void)xb_add(&bar[XB_XCNT(b.x)], 1u);
    return b;
}
__device__ __forceinline__ void xcd_barrier_complete(unsigned* bar, unsigned x, unsigned& nloc, unsigned& nx) {
    const unsigned G = gridDim.x * gridDim.y * gridDim.z;
    unsigned sum, cnt, mine, sp = 0u;
    for (;;) {
        sum = 0u; cnt = 0u; mine = 0u;
#pragma unroll
        for (unsigned j = 0; j < 16; ++j) { const unsigned c = xb_ld(&bar[XB_XCNT(j)]); sum += c; cnt += (c > 0u) ? 1u : 0u; mine = (j == x) ? c : mine; }
        if (sum == G) break;
        __builtin_amdgcn_s_sleep(1);
        if ((++sp & 255u) == 0u) { if (xb_ld(&bar[XB_TMO])) break; if (sp > XB_SPIN_CAP) { atomicAdd(&bar[XB_TMO], 1u); break; } }
    }
    nloc = mine > 0u ? mine : 1u; nx = cnt > 0u ? cnt : 1u;
}
__device__ __forceinline__ void xcd_barrier(const XcdBarrier& b) {
    asm volatile("s_waitcnt vmcnt(0)" ::: "memory");
    __syncthreads();
    if (threadIdx.x == 0) {
        unsigned* bar = b.bar;
        __builtin_amdgcn_s_waitcnt(0);
        unsigned nloc = b.st[0], nx = b.st[1];
        if (nloc == 0u) { xcd_barrier_complete(bar, b.x, nloc, nx); b.st[0] = nloc; b.st[1] = nx; }
        const unsigned old = xb_add(&bar[XB_XSUB(b.x)], 1u);
        const unsigned gen = old / nloc;
        if (old + 1u == (gen + 1u) * nloc) {
            __builtin_amdgcn_fence(__ATOMIC_RELEASE, "agent");
            asm volatile("s_waitcnt vmcnt(0)" ::: "memory");
            const unsigned og = xb_add(&bar[XB_TOP], 1u);
            const unsigned tg = og / nx;
            if (og + 1u == (tg + 1u) * nx) xb_add(&bar[XB_TOPGEN], 1u);
            else XB_SPIN(xb_ld(&bar[XB_TOPGEN]) == tg, bar);
            __builtin_amdgcn_fence(__ATOMIC_ACQUIRE, "agent");
            xb_add(&bar[XB_XGEN(b.x)], 1u);
            asm volatile("s_waitcnt vmcnt(0)" ::: "memory");
        } else {
            XB_SPIN(xb_ld(&bar[XB_XGEN(b.x)]) == gen, bar);
            __builtin_amdgcn_fence(__ATOMIC_ACQUIRE, "agent");
            asm volatile("s_waitcnt vmcnt(0)" ::: "memory");
        }
    }
    __syncthreads();
}

struct Args { const float* in[22]; float* out; unsigned char* ws; int ph_lo, ph_hi; };

__device__ __forceinline__ int in_srccol(int r, float& sc) {
    sc = 1.f;
    if (r < 1024) { if (r >= C_MK && r < C_MV) sc = 0.125f; return r; }
    if (r < C_MG) { if (r < C_AK) sc = 0.125f * 1.4426950408889634f; else if (r >= C_GQ && r < C_GK) sc = 0.17677669529663687f; return r + 16; }
    if (r < C_GGT) return r - C_MG + 1024;
    if (r < C_END) return r;
    return -1;
}
template <bool F8 = false>
__device__ __forceinline__ void tr_item(const float* W, int K, int N, int NP, bf16_t* WT, int mode, int half, LAS float* scr, int item, int lane, float f8scale = 1.f) {
    const int nblk = NP >> 6, kb = item / nblk, nb = item - kb * nblk, k0 = kb << 6, n0 = nb << 6;
    const int r = n0 + lane; float sc = 1.f; int src;
    if (mode == 0) src = r; else if (mode == 1) src = in_srccol(r, sc); else { const int pn = r >> 8, w = r & 255; src = (w < 128) ? (pn * 128 + w) : (half + pn * 128 + w - 128); }
    if (F8) sc = f8scale;
    const float* wp = W + (size_t)k0 * N + (src < 0 ? 0 : src);
#pragma unroll 16
    for (int i = 0; i < 64; ++i) { const float v = wp[(size_t)i * N]; scr[i * 65 + lane] = (src < 0) ? 0.f : v * sc; }
    LDS_WAIT();
    const int c = lane & 7;
#pragma unroll
    for (int j = 0; j < 8; ++j) { const int n = (lane >> 3) + 8 * j; const LAS float* s = scr + (8 * c) * 65 + n;
        if constexpr (F8) { uint2 o; o.x = pk4_fp8(s[0], s[65], s[130], s[195]); o.y = pk4_fp8(s[260], s[325], s[390], s[455]); *(uint2*)((unsigned char*)WT + (size_t)(n0 + n) * K + k0 + 8 * c) = o; }
        else { uint4 o; o.x = pk2(s[0], s[65]); o.y = pk2(s[130], s[195]); o.z = pk2(s[260], s[325]); o.w = pk2(s[390], s[455]);
        *(uint4*)(WT + (size_t)(n0 + n) * K + k0 + 8 * c) = o; } }
    LDS_WAIT();
}

__device__ __forceinline__ void tr_item_f8_wg(LAS unsigned char* lds, const float* __restrict__ W, int K, int N, int NP, unsigned char* __restrict__ WT, int mode, int half, int item, int tid, int lane, int wave, float sc) {
    constexpr int RS = 136;
    const int nblk = NP >> 8, kb = item / nblk, nb = item - kb * nblk, k0 = kb << 7, nb0 = nb << 8, n0 = nb0 + 4 * lane;
    int src = n0;
    if (mode == 2) { const int pn = n0 >> 8, w = n0 & 255; src = (w < 128) ? (pn * 128 + w) : (half + pn * 128 + w - 128); }
    f32x4 v[2][8];
#pragma unroll
    for (int q = 0; q < 2; ++q)
#pragma unroll
        for (int i = 0; i < 8; ++i) v[q][i] = *(const f32x4*)(W + (size_t)(k0 + (wave * 2 + q) * 8 + i) * N + src);
    __syncthreads();
#pragma unroll
    for (int q = 0; q < 2; ++q)
#pragma unroll
        for (int e = 0; e < 4; ++e) { u32x2_t o; o.x = pk4_fp8(v[q][0][e] * sc, v[q][1][e] * sc, v[q][2][e] * sc, v[q][3][e] * sc); o.y = pk4_fp8(v[q][4][e] * sc, v[q][5][e] * sc, v[q][6][e] * sc, v[q][7][e] * sc);
            *(LAS u32x2_t*)(lds + (4 * lane + e) * RS + (wave * 2 + q) * 8) = o; }
    __syncthreads();
#pragma unroll
    for (int j = 0; j < 4; ++j) { const int idx = tid + 512 * j, r = idx >> 3, ch = idx & 7;
        *(u32x4*)(WT + (size_t)(nb0 + r) * K + k0 + ch * 16) = *(const LAS u32x4*)(lds + r * RS + ch * 16); }
}

__device__ __forceinline__ void chunk_rows(int d, int jc, int& base, int& step) {
    int oc;
    if (d == 0) oc = (jc < 4) ? 256 + jc : jc - 4; else oc = (jc < 4) ? 256 + (3 - jc) : 255 - (jc - 4);
    const int b0 = (oc < 256) ? oc * 64 : SEQ + (oc - 256) * 64;
    if (d == 0) { base = b0; step = 1; } else { base = b0 + 63; step = -1; }
}
__device__ __forceinline__ int oc_to_jc(int d, int oc) { if (d == 0) return oc < 256 ? oc + 4 : oc - 256; return oc < 256 ? 4 + (255 - oc) : 3 - (oc - 256); }

constexpr int AT_RS = 144, AT_TILE = 128 * AT_RS;
__device__ __forceinline__ void attn_unit(LAS unsigned char* lds, const bf16_t* P, bf16_t* CAT, int qb  , int cqb, int kvh, const float* sink, int tid, int lane, int wave) {
    const bool is_ctx = qb < 0;
    const int g = lane >> 4, i = lane & 15;
    const int hq = kvh * 4 + (wave >> 1), qh = wave & 1;
    const int qrow0 = (is_ctx ? SEQ + cqb * 128 : qb * 128) + qh * 64;
    bf16x8 bq[4][2];
#pragma unroll
    for (int qt = 0; qt < 4; ++qt)
#pragma unroll
        for (int ks = 0; ks < 2; ++ks) bq[qt][ks] = *(const bf16x8*)(P + (size_t)(qrow0 + 16 * qt + i) * LDP + C_AQ + hq * 64 + 32 * ks + 8 * g);
    f32x4 O[4][4];
#pragma unroll
    for (int dt = 0; dt < 4; ++dt)
#pragma unroll
        for (int qt = 0; qt < 4; ++qt) O[dt][qt] = (f32x4){0.f, 0.f, 0.f, 0.f};
    float m[4], l[4];
    { const float sk = sink[hq] * 1.4426950408889634f;
#pragma unroll
      for (int qt = 0; qt < 4; ++qt) { m[qt] = sk; l[qt] = (g == 0) ? 1.f : 0.f; } }
#define AT_VALID(c) ((c) >= 3 || (!is_ctx && (qb - 1 + (c)) >= 0 && (qb - 1 + (c)) < SEQ / 128))
#define AT_ROW(c) ((c) >= 3 ? SEQ + ((c) - 3) * 128 : (qb - 1 + (c)) * 128)
    u32x4 kreg[2], vreg[2];
    int c = 0; while (!AT_VALID(c)) ++c;
#pragma unroll
    for (int t = 0; t < 2; ++t) { const int idx = tid + 512 * t, r = idx >> 3, ch = idx & 7; const bf16_t* src = P + (size_t)(AT_ROW(c) + r) * LDP + kvh * 64 + ch * 8;
        kreg[t] = *(const u32x4*)(src + C_AK); vreg[t] = *(const u32x4*)(src + C_AV); }
    __syncthreads();
    int buf = 0;
#pragma unroll
    for (int t = 0; t < 2; ++t) { const int idx = tid + 512 * t, r = idx >> 3, ch = idx & 7; *(LAS u32x4*)(lds + r * AT_RS + ch * 16) = kreg[t]; *(LAS u32x4*)(lds + AT_TILE + r * AT_RS + ch * 16) = vreg[t]; }
    __syncthreads();
    while (c < 5) {
        int cn = c + 1; while (cn < 5 && !AT_VALID(cn)) ++cn;
        if (cn < 5) {
#pragma unroll
            for (int t = 0; t < 2; ++t) { const int idx = tid + 512 * t, r = idx >> 3, ch = idx & 7; const bf16_t* src = P + (size_t)(AT_ROW(cn) + r) * LDP + kvh * 64 + ch * 8;
                kreg[t] = *(const u32x4*)(src + C_AK); vreg[t] = *(const u32x4*)(src + C_AV); }
        }
        const LAS unsigned char* Kb = lds + buf * 2 * AT_TILE; const LAS unsigned char* Vb = Kb + AT_TILE;
        const bool lo_blk = (!is_ctx && c == 0), hi_blk = (!is_ctx && c == 2);
        for (int grp = 0; grp < 4; ++grp) {
            if (lo_blk && qh == 1 && grp < 2) continue;
            if (hi_blk && qh == 0 && grp >= 2) continue;
            bf16x8 kf[2][2], vf[4];
#pragma unroll
            for (int kt = 0; kt < 2; ++kt)
#pragma unroll
                for (int ks = 0; ks < 2; ++ks) kf[kt][ks] = *(const LAS bf16x8*)(Kb + (grp * 32 + kt * 16 + i) * AT_RS + (32 * ks + 8 * g) * 2);
#pragma unroll
            for (int dt = 0; dt < 4; ++dt) { const LAS unsigned char* vp = Vb + (grp * 32 + 4 * g + (i >> 2)) * AT_RS + (16 * dt + 4 * (i & 3)) * 2;
                vf[dt] = cat44(ds_tr16(vp), ds_tr16(vp + 16 * AT_RS)); }
            f32x4 s0[4], s1[4];
#pragma unroll
            for (int qt = 0; qt < 4; ++qt) {
                s0[qt] = (f32x4){0.f, 0.f, 0.f, 0.f}; s1[qt] = s0[qt];
#pragma unroll
                for (int ks = 0; ks < 2; ++ks) { s0[qt] = MFMA16(kf[0][ks], bq[qt][ks], s0[qt]); s1[qt] = MFMA16(kf[1][ks], bq[qt][ks], s1[qt]); }
            }
            bf16x8 pb[4];
#pragma unroll
            for (int qt = 0; qt < 4; ++qt) {
                if (lo_blk || hi_blk) {
                    const int qo = qh * 64 + qt * 16 + i, ko = grp * 32 + 4 * g;
#pragma unroll
                    for (int r = 0; r < 4; ++r) {
                        const bool v0 = lo_blk ? (ko + r >= qo) : (ko + r <= qo), v1 = lo_blk ? (ko + 16 + r >= qo) : (ko + 16 + r <= qo);
                        s0[qt][r] = v0 ? s0[qt][r] : -INFINITY; s1[qt][r] = v1 ? s1[qt][r] : -INFINITY; }
                }
                float mx = fmaxf(fmaxf(fmaxf(s0[qt][0], s0[qt][1]), fmaxf(s0[qt][2], s0[qt][3])), fmaxf(fmaxf(s1[qt][0], s1[qt][1]), fmaxf(s1[qt][2], s1[qt][3])));
                mx = grp_max(mx);
                if (__any(mx > m[qt])) {
                    const float mn = fmaxf(m[qt], mx), alpha = __builtin_amdgcn_exp2f(m[qt] - mn);
                    m[qt] = mn; l[qt] *= alpha;
#pragma unroll
                    for (int dt = 0; dt < 4; ++dt) O[dt][qt] = O[dt][qt] * alpha;
                }
                const float mq = m[qt];
                float ps = 0.f;
#pragma unroll
                for (int r = 0; r < 4; ++r) { s0[qt][r] = __builtin_amdgcn_exp2f(s0[qt][r] - mq); s1[qt][r] = __builtin_amdgcn_exp2f(s1[qt][r] - mq); ps += s0[qt][r] + s1[qt][r]; }
                l[qt] += ps;
                u32x4 pw; pw.x = cvtpk(s0[qt][0], s0[qt][1]); pw.y = cvtpk(s0[qt][2], s0[qt][3]); pw.z = cvtpk(s1[qt][0], s1[qt][1]); pw.w = cvtpk(s1[qt][2], s1[qt][3]);
                pb[qt] = __builtin_bit_cast(bf16x8, pw);
            }
#pragma unroll
            for (int qt = 0; qt < 4; ++qt)
#pragma unroll
                for (int dt = 0; dt < 4; ++dt) O[dt][qt] = MFMA16(vf[dt], pb[qt], O[dt][qt]);
        }
        if (cn < 5) {
            LAS unsigned char* nb = lds + (buf ^ 1) * 2 * AT_TILE;
#pragma unroll
            for (int t = 0; t < 2; ++t) { const int idx = tid + 512 * t, r = idx >> 3, ch = idx & 7; *(LAS u32x4*)(nb + r * AT_RS + ch * 16) = kreg[t]; *(LAS u32x4*)(nb + AT_TILE + r * AT_RS + ch * 16) = vreg[t]; }
        }
        __syncthreads();
        buf ^= 1; c = cn;
    }
#undef AT_VALID
#undef AT_ROW
#pragma unroll
    for (int qt = 0; qt < 4; ++qt) {
        const float inv = 1.f / grp_sum(l[qt]);
        bf16_t* dst = CAT + (size_t)(qrow0 + 16 * qt + i) * DM + 256 + hq * 64 + 4 * g;
#pragma unroll
        for (int dt = 0; dt < 4; ++dt) { uint2 o; o.x = cvtpk(O[dt][qt][0] * inv, O[dt][qt][1] * inv); o.y = cvtpk(O[dt][qt][2] * inv, O[dt][qt][3] * inv); *(uint2*)(dst + 16 * dt) = o; }
    }
}

constexpr int CH_RS = 144;
constexpr int CH_T = 64 * CH_RS;
constexpr int GL_RS = 80;
constexpr int GL_T = 64 * GL_RS;
__device__ __forceinline__ int chunk_b0(int oc) { return (oc < 256) ? oc * 64 : SEQ + (oc - 256) * 64; }
__device__ __forceinline__ bf16x8 tr_frag(const LAS unsigned char* tile, int rs, int row0, int col0, int lane) {
    const int g = lane >> 4, i = lane & 15; const LAS unsigned char* p = tile + (row0 + 8 * g + (i >> 2)) * rs + (col0 + 4 * (i & 3)) * 2;
    return cat44(ds_tr16(p), ds_tr16(p + 4 * rs));
}
__device__ __forceinline__ bf16x8 tr_frag_perm(const LAS unsigned char* tile, int rs, int row0, int col0, int lane) {
    const int g = lane >> 4, i = lane & 15; const LAS unsigned char* p = tile + (row0 + 4 * g + (i >> 2)) * rs + (col0 + 4 * (i & 3)) * 2;
    return cat44(ds_tr16(p), ds_tr16(p + 16 * rs));
}
__device__ __forceinline__ void unpack8(const u32x4 v, float* o) {
    o[0] = __uint_as_float(v.x << 16); o[1] = __uint_as_float(v.x & 0xffff0000u); o[2] = __uint_as_float(v.y << 16); o[3] = __uint_as_float(v.y & 0xffff0000u);
    o[4] = __uint_as_float(v.z << 16); o[5] = __uint_as_float(v.z & 0xffff0000u); o[6] = __uint_as_float(v.w << 16); o[7] = __uint_as_float(v.w & 0xffff0000u);
}
__device__ __forceinline__ u32x4 pack8(const float* f) { u32x4 w; w.x = cvtpk(f[0], f[1]); w.y = cvtpk(f[2], f[3]); w.z = cvtpk(f[4], f[5]); w.w = cvtpk(f[6], f[7]); return w; }

#define LBAR() do { asm volatile("s_waitcnt lgkmcnt(0)" ::: "memory"); __builtin_amdgcn_s_barrier(); asm volatile("" ::: "memory"); } while (0)

struct MsRaw { u32x4 k, v; float ig, fg, gbi, gbf; };
__device__ __forceinline__ MsRaw mlstm_summary_load(const bf16_t* P, const float* Gt, const float* gate_b, int h, int oc, int tid, int lane, int wave) {
    MsRaw R; const int b0 = chunk_b0(oc), r = tid >> 3, ch = tid & 7;
    R.k = *(const u32x4*)(P + (size_t)(b0 + r) * LDP + C_MK + h * 64 + ch * 8); R.v = *(const u32x4*)(P + (size_t)(b0 + r) * LDP + C_MV + h * 64 + ch * 8);
    { const int d = wave & 1, sp = d ? 63 - lane : lane, row = b0 + sp;
      R.ig = Gt[(size_t)row * 48 + d * 8 + h]; R.gbi = gate_b[d * 8 + h]; R.fg = Gt[(size_t)row * 48 + d * 8 + 4 + h]; R.gbf = gate_b[d * 8 + 4 + h]; }
    return R;
}
__device__ __forceinline__ void mlstm_summary_body(LAS unsigned char* lds, const MsRaw& R, float* MU, float* MNU, float* MSC, int h, int oc, int tid, int lane, int wave) {
    LAS unsigned char* Kw0 = lds; LAS unsigned char* Kw1 = lds + CH_T; LAS unsigned char* Vt = lds + 2 * CH_T; LAS float* wv = (LAS float*)(lds + 3 * CH_T);
    const int r = tid >> 3, ch = tid & 7;
    LBAR();
    if (wave < 2) {
        const int d = wave, sp = d ? 63 - lane : lane, hd = h * 2 + d, jc = oc_to_jc(d, oc);
        const float lf = log_sigmoidf_(R.fg + R.gbf);
        const float bb = scan_add(lf, lane);
        const float av = (R.ig + R.gbi) - bb;
        const float cm = wave_max(av);
        const float B = __shfl(bb, 63);
        wv[d * 64 + sp] = __expf(av - cm);
        if (lane == 0) { MSC[(size_t)(hd * NCH + jc) * 4 + 0] = cm; MSC[(size_t)(hd * NCH + jc) * 4 + 1] = B; }
    }
    *(LAS u32x4*)(Vt + r * CH_RS + ch * 16) = R.v;
    LBAR();
    { float kf[8], t0[8], t1[8]; unpack8(R.k, kf); const float w0 = wv[r], w1 = wv[64 + r];
#pragma unroll
      for (int j = 0; j < 8; ++j) { t0[j] = kf[j] * w0; t1[j] = kf[j] * w1; }
      *(LAS u32x4*)(Kw0 + r * CH_RS + ch * 16) = pack8(t0); *(LAS u32x4*)(Kw1 + r * CH_RS + ch * 16) = pack8(t1); }
    LBAR();
    { const int d = wave >> 2, dkt = wave & 3, g = lane >> 4, i = lane & 15, hd = h * 2 + d, jc = oc_to_jc(d, oc);
      const LAS unsigned char* Kw = d ? Kw1 : Kw0;
      const bf16x8 a0 = tr_frag(Kw, CH_RS, 0, 16 * dkt, lane), a1 = tr_frag(Kw, CH_RS, 32, 16 * dkt, lane);
      float* dst = MU + ((size_t)(hd * 64 + 16 * dkt + i) * NCH + jc) * 64 + 4 * g;
#pragma unroll
      for (int dvt = 0; dvt < 4; ++dvt) {
          f32x4 c = (f32x4){0.f, 0.f, 0.f, 0.f};
          c = MFMA16(tr_frag(Vt, CH_RS, 0, 16 * dvt, lane), a0, c); c = MFMA16(tr_frag(Vt, CH_RS, 32, 16 * dvt, lane), a1, c);
          *(f32x4*)(dst + 16 * dvt) = c;
      }
      const short one = (i == 0) ? (short)0x3F80 : (short)0; const bf16x8 bo = (bf16x8){one, one, one, one, one, one, one, one};
      f32x4 c1 = (f32x4){0.f, 0.f, 0.f, 0.f}; c1 = MFMA16(a0, bo, c1); c1 = MFMA16(a1, bo, c1);
      if (i == 0) *(f32x4*)(MNU + (size_t)(hd * NCH + jc) * 64 + 16 * dkt + 4 * g) = c1; }
}

struct MoRaw { u32x4 q, k, v, c0, c1; float ig, fg, gbi, gbf, mst, nv; uint2 og[4]; };
__device__ __forceinline__ MoRaw mlstm_out_load(const bf16_t* P, const float* Gt, const float* gate_b, const bf16_t* MC, const float* MNS, const float* MSC, int h, int oc, int tid, int lane, int wave) {
    MoRaw R; const int b0 = chunk_b0(oc), r = tid >> 3, ch = tid & 7;
    const size_t ro = (size_t)(b0 + r) * LDP + h * 64 + ch * 8;
    R.q = *(const u32x4*)(P + ro + C_MQ); R.k = *(const u32x4*)(P + ro + C_MK); R.v = *(const u32x4*)(P + ro + C_MV);
    const int jc0 = oc_to_jc(0, oc), jc1 = oc_to_jc(1, oc);
    R.c0 = *(const u32x4*)(MC + ((size_t)((h * 2 + 0) * 64 + r) * NCH + jc0) * 64 + ch * 8); R.c1 = *(const u32x4*)(MC + ((size_t)((h * 2 + 1) * 64 + r) * NCH + jc1) * 64 + ch * 8);
    { const int d = wave & 1, sp = d ? 63 - lane : lane, row = b0 + sp, hd = h * 2 + d, jc = d ? jc1 : jc0;
        R.ig = Gt[(size_t)row * 48 + d * 8 + h]; R.gbi = gate_b[d * 8 + h]; R.fg = Gt[(size_t)row * 48 + d * 8 + 4 + h]; R.gbf = gate_b[d * 8 + 4 + h];
        R.mst = MSC[(size_t)(hd * NCH + jc) * 4 + 2]; R.nv = MNS[(size_t)(hd * NCH + jc) * 64 + lane]; }
    { const int tt = wave & 3, g = lane >> 4, i = lane & 15, row = b0 + 16 * tt + i;
#pragma unroll
      for (int dvt = 0; dvt < 4; ++dvt) R.og[dvt] = *(const uint2*)(P + (size_t)row * LDP + C_MO + h * 64 + 16 * dvt + 4 * g); }
    return R;
}
__device__ __forceinline__ void mlstm_out_body(LAS unsigned char* lds, const MoRaw& R, const float* normw, bf16_t* CAT, int h, int oc, int tid, int lane, int wave) {
    LAS unsigned char* Qt = lds; LAS unsigned char* Kt = lds + CH_T; LAS unsigned char* Vt = lds + 2 * CH_T; LAS unsigned char* Ct = lds + 3 * CH_T;
    LAS float* arr = (LAS float*)(lds + 5 * CH_T);
    LAS f32x4* hs = (LAS f32x4*)(lds + 5 * CH_T + 2 * 320 * 4);
    const int b0 = chunk_b0(oc);
    const int r = tid >> 3, ch = tid & 7;
    LBAR();
    if (wave < 2) {
        const int d = wave, sp = d ? 63 - lane : lane;
        const float lf = log_sigmoidf_(R.fg + R.gbf);
        const float bb = scan_add(lf, lane);
        const float av = (R.ig + R.gbi) - bb;
        const float cm = scan_max(av, lane);
        const float mx = fmaxf(R.mst, cm);
        LAS float* A = arr + d * 320;
        A[sp] = av; A[64 + sp] = mx; A[128 + sp] = __expf(R.mst - mx); A[192 + sp] = __expf(-(bb + mx));
        A[256 + lane] = R.nv;
    }
    *(LAS u32x4*)(Qt + r * CH_RS + ch * 16) = R.q; *(LAS u32x4*)(Kt + r * CH_RS + ch * 16) = R.k; *(LAS u32x4*)(Vt + r * CH_RS + ch * 16) = R.v;
    *(LAS u32x4*)(Ct + r * CH_RS + ch * 16) = R.c0; *(LAS u32x4*)(Ct + CH_T + r * CH_RS + ch * 16) = R.c1;
    LBAR();
    const int d = wave >> 2, tt = wave & 3, g = lane >> 4, i = lane & 15, t = 16 * tt + i;
    f32x4 hh[4];
    {
        const LAS float* A = arr + d * 320;
        const float mxt = A[64 + t], wt = A[128 + t], emt = A[192 + t];
        bf16x8 bq[2], bqw[2]; float qn = 0.f;
#pragma unroll
        for (int ks = 0; ks < 2; ++ks) { const u32x4 raw = *(const LAS u32x4*)(Qt + t * CH_RS + (32 * ks + 8 * g) * 2); bq[ks] = __builtin_bit_cast(bf16x8, raw);
            float qf[8], qw[8]; unpack8(raw, qf);
            const f32x4 n0 = *(const LAS f32x4*)(A + 256 + 32 * ks + 8 * g), n1 = *(const LAS f32x4*)(A + 256 + 32 * ks + 8 * g + 4);
#pragma unroll
            for (int j = 0; j < 4; ++j) { qn += qf[j] * n0[j] + qf[4 + j] * n1[j]; }
#pragma unroll
            for (int j = 0; j < 8; ++j) qw[j] = qf[j] * wt;
            bqw[ks] = __builtin_bit_cast(bf16x8, pack8(qw)); }
        qn += __shfl_xor(qn, 16); qn += __shfl_xor(qn, 32);
        float dsum = 0.f; f32x4 sT[4];
#pragma unroll
        for (int st = 0; st < 4; ++st) {
            f32x4 c = (f32x4){0.f, 0.f, 0.f, 0.f};
#pragma unroll
            for (int ks = 0; ks < 2; ++ks) c = MFMA16(*(const LAS bf16x8*)(Kt + (16 * st + i) * CH_RS + (32 * ks + 8 * g) * 2), bq[ks], c);
            const f32x4 a4 = *(const LAS f32x4*)(A + 16 * st + 4 * g);
#pragma unroll
            for (int rr = 0; rr < 4; ++rr) { const int sidx = 16 * st + 4 * g + rr; const bool ok = d ? (sidx >= t) : (sidx <= t);
                const float val = ok ? c[rr] * __expf(a4[rr] - mxt) : 0.f; sT[st][rr] = val; dsum += val; }
        }
        dsum += __shfl_xor(dsum, 16); dsum += __shfl_xor(dsum, 32);
        const float den = dsum + wt * qn, inv = 1.f / fmaxf(fabsf(den), emt);
        bf16x8 pb[2];
#pragma unroll
        for (int gp = 0; gp < 2; ++gp) { u32x4 w; w.x = cvtpk(sT[2 * gp][0], sT[2 * gp][1]); w.y = cvtpk(sT[2 * gp][2], sT[2 * gp][3]); w.z = cvtpk(sT[2 * gp + 1][0], sT[2 * gp + 1][1]); w.w = cvtpk(sT[2 * gp + 1][2], sT[2 * gp + 1][3]); pb[gp] = __builtin_bit_cast(bf16x8, w); }
        const LAS unsigned char* Cd = Ct + d * CH_T;
#pragma unroll
        for (int dvt = 0; dvt < 4; ++dvt) {
            f32x4 c = (f32x4){0.f, 0.f, 0.f, 0.f};
            c = MFMA16(tr_frag_perm(Vt, CH_RS, 0, 16 * dvt, lane), pb[0], c); c = MFMA16(tr_frag_perm(Vt, CH_RS, 32, 16 * dvt, lane), pb[1], c);
            c = MFMA16(tr_frag(Cd, CH_RS, 0, 16 * dvt, lane), bqw[0], c); c = MFMA16(tr_frag(Cd, CH_RS, 32, 16 * dvt, lane), bqw[1], c);
            hh[dvt] = c * inv;
        }
        if (d == 1) {
#pragma unroll
            for (int dvt = 0; dvt < 4; ++dvt) hs[(tt * 4 + dvt) * 64 + lane] = hh[dvt];
        }
    }
    LBAR();
    if (d == 0) {
        float s1 = 0.f;
#pragma unroll
        for (int dvt = 0; dvt < 4; ++dvt) { hh[dvt] = hh[dvt] + hs[(tt * 4 + dvt) * 64 + lane]; s1 += (hh[dvt][0] + hh[dvt][1]) + (hh[dvt][2] + hh[dvt][3]); }
        s1 += __shfl_xor(s1, 16); s1 += __shfl_xor(s1, 32);
        const float mu = s1 * (1.f / 64.f); float s2 = 0.f;
#pragma unroll
        for (int dvt = 0; dvt < 4; ++dvt) { hh[dvt] = hh[dvt] - mu; s2 += (hh[dvt][0] * hh[dvt][0] + hh[dvt][1] * hh[dvt][1]) + (hh[dvt][2] * hh[dvt][2] + hh[dvt][3] * hh[dvt][3]); }
        s2 += __shfl_xor(s2, 16); s2 += __shfl_xor(s2, 32);
        const float rstd = rsqrtf(s2 * (1.f / 64.f) + LN_EPS);
        const int row = b0 + t;
#pragma unroll
        for (int dvt = 0; dvt < 4; ++dvt) { const int col = h * 64 + 16 * dvt + 4 * g;
            const uint2 og = R.og[dvt]; const f32x4 nw = *(const f32x4*)(normw + col);
            const float o0 = hh[dvt][0] * rstd * nw[0] * sigmoidf_(__uint_as_float(og.x << 16)), o1 = hh[dvt][1] * rstd * nw[1] * sigmoidf_(__uint_as_float(og.x & 0xffff0000u));
            const float o2 = hh[dvt][2] * rstd * nw[2] * sigmoidf_(__uint_as_float(og.y << 16)), o3 = hh[dvt][3] * rstd * nw[3] * sigmoidf_(__uint_as_float(og.y & 0xffff0000u));
            uint2 o; o.x = cvtpk(o0, o1); o.y = cvtpk(o2, o3); *(uint2*)(CAT + (size_t)row * DM + col) = o; }
    }
}

struct GgRaw { f32x4 g0, g1, g2, g3; };
__device__ __forceinline__ GgRaw gla_gates_load(const float* Gt, int b0, int lane, int wave) {
    const int d = wave >> 2, sp = d ? 63 - lane : lane; const float* gs = Gt + (size_t)(b0 + sp) * 48 + 16 + d * 16;
    GgRaw R; R.g0 = *(const f32x4*)gs; R.g1 = *(const f32x4*)(gs + 4); R.g2 = *(const f32x4*)(gs + 8); R.g3 = *(const f32x4*)(gs + 12); return R;
}
__device__ __forceinline__ void gla_gates_wave(const GgRaw& R, const LAS float* g_up, const LAS float* g_b, int h, int lane, int wave, float (&bc)[8]) {
    const int d = wave >> 2, dk0 = 8 * (wave & 3);
    const float gv[16] = {R.g0[0], R.g0[1], R.g0[2], R.g0[3], R.g1[0], R.g1[1], R.g1[2], R.g1[3], R.g2[0], R.g2[1], R.g2[2], R.g2[3], R.g3[0], R.g3[1], R.g3[2], R.g3[3]};
    float z[8];
    { const f32x4 b0 = *(const LAS f32x4*)(g_b + d * 128 + h * 32 + dk0), b1 = *(const LAS f32x4*)(g_b + d * 128 + h * 32 + dk0 + 4);
#pragma unroll
      for (int c = 0; c < 4; ++c) { z[c] = b0[c]; z[4 + c] = b1[c]; } }
#pragma unroll
    for (int rr = 0; rr < 16; ++rr) { const f32x4 u0 = *(const LAS f32x4*)(g_up + (d * 16 + rr) * 128 + h * 32 + dk0), u1 = *(const LAS f32x4*)(g_up + (d * 16 + rr) * 128 + h * 32 + dk0 + 4);
#pragma unroll
        for (int c = 0; c < 4; ++c) { z[c] += gv[rr] * u0[c]; z[4 + c] += gv[rr] * u1[c]; } }
#pragma unroll
    for (int c = 0; c < 8; ++c) bc[c] = scan_add(log_sigmoidf_(z[c]) * (1.f / 16.f), lane);
}
struct GsRaw { u32x4 v, k; GgRaw gg; };
__device__ __forceinline__ GsRaw gla_summary_load(const bf16_t* P, const float* Gt, int h, int oc, int tid, int lane, int wave) {
    GsRaw R; const int b0 = chunk_b0(oc), r = tid >> 3, ch = tid & 7, d = wave >> 2, dk0 = 8 * (wave & 3), sp = d ? 63 - lane : lane;
    R.v = *(const u32x4*)(P + (size_t)(b0 + r) * LDP + C_GV + h * 64 + ch * 8);
    R.k = *(const u32x4*)(P + (size_t)(b0 + sp) * LDP + C_GK + h * 32 + dk0);
    R.gg = gla_gates_load(Gt, b0, lane, wave);
    return R;
}
__device__ __forceinline__ void gla_summary_body(LAS unsigned char* lds, const GsRaw& R, const LAS float* g_up, const LAS float* g_b, float* GU, float* GDEC, int h, int oc, int tid, int lane, int wave) {
    LAS unsigned char* Kd = lds; LAS unsigned char* Vt = lds + 2 * GL_T;
    { const int r = tid >> 3, ch = tid & 7;
      LBAR();
      *(LAS u32x4*)(Vt + r * CH_RS + ch * 16) = R.v; }
    { const int d = wave >> 2, dk0 = 8 * (wave & 3), hd = h * 2 + d, jc = oc_to_jc(d, oc), sp = d ? 63 - lane : lane;
      float bc[8]; gla_gates_wave(R.gg, g_up, g_b, h, lane, wave, bc);
      float kf[8]; unpack8(R.k, kf);
      float dec[8];
#pragma unroll
      for (int c = 0; c < 8; ++c) { const float bL = __shfl(bc[c], 63); kf[c] *= __expf(bL - bc[c]); dec[c] = __expf(bL); }
      *(LAS u32x4*)(Kd + d * GL_T + sp * GL_RS + dk0 * 2) = pack8(kf);
      if (lane == 0) { float* dp = GDEC + (size_t)(hd * NCH + jc) * 32 + dk0; *(f32x4*)dp = (f32x4){dec[0], dec[1], dec[2], dec[3]}; *(f32x4*)(dp + 4) = (f32x4){dec[4], dec[5], dec[6], dec[7]}; } }
    LBAR();
    { const int d = wave >> 2, dkt = (wave >> 1) & 1, dvh = wave & 1, g = lane >> 4, i = lane & 15, hd = h * 2 + d, jc = oc_to_jc(d, oc);
      const bf16x8 a0 = tr_frag(Kd + d * GL_T, GL_RS, 0, 16 * dkt, lane), a1 = tr_frag(Kd + d * GL_T, GL_RS, 32, 16 * dkt, lane);
      float* dst = GU + ((size_t)(hd * 32 + 16 * dkt + i) * NCH + jc) * 64 + 4 * g;
#pragma unroll
      for (int q = 0; q < 2; ++q) { const int dvt = 2 * dvh + q;
          f32x4 c = (f32x4){0.f, 0.f, 0.f, 0.f};
          c = MFMA16(tr_frag(Vt, CH_RS, 0, 16 * dvt, lane), a0, c); c = MFMA16(tr_frag(Vt, CH_RS, 32, 16 * dvt, lane), a1, c);
          *(f32x4*)(dst + 16 * dvt) = c; } }
}
struct GoRaw { u32x4 v, s, q, k; GgRaw gg; uint2 og[4]; };
__device__ __forceinline__ GoRaw gla_out_load(const bf16_t* P, const float* Gt, const bf16_t* GS, int h, int oc, int tid, int lane, int wave) {
    GoRaw R; const int b0 = chunk_b0(oc), r = tid >> 3, ch = tid & 7, d = wave >> 2, dk0 = 8 * (wave & 3), sp = d ? 63 - lane : lane;
    R.v = *(const u32x4*)(P + (size_t)(b0 + r) * LDP + C_GV + h * 64 + ch * 8);
    { const int dd = r >> 5, rk = r & 31; R.s = *(const u32x4*)(GS + ((size_t)((h * 2 + dd) * 32 + rk) * NCH + oc_to_jc(dd, oc)) * 64 + ch * 8); }
    R.q = *(const u32x4*)(P + (size_t)(b0 + sp) * LDP + C_GQ + h * 32 + dk0); R.k = *(const u32x4*)(P + (size_t)(b0 + sp) * LDP + C_GK + h * 32 + dk0);
    R.gg = gla_gates_load(Gt, b0, lane, wave);
    { const int tt = wave & 3, g = lane >> 4, i = lane & 15, row = b0 + 16 * tt + i;
#pragma unroll
      for (int dvt = 0; dvt < 4; ++dvt) R.og[dvt] = *(const uint2*)(P + (size_t)row * LDP + C_GG + h * 64 + 16 * dvt + 4 * g); }
    return R;
}
__device__ __forceinline__ void gla_out_body(LAS unsigned char* lds, const GoRaw& R, const LAS float* g_up, const LAS float* g_b, const float* normw, bf16_t* CAT, int h, int oc, int tid, int lane, int wave) {
    LAS unsigned char* Qs = lds; LAS unsigned char* Ks = lds + 2 * GL_T; LAS unsigned char* Vt = lds + 4 * GL_T; LAS unsigned char* St = Vt + CH_T;
    LAS f32x4* hs = (LAS f32x4*)(St + 2 * 32 * CH_RS);
    const int b0 = chunk_b0(oc);
    { const int r = tid >> 3, ch = tid & 7, dd = r >> 5, rk = r & 31;
      LBAR();
      *(LAS u32x4*)(Vt + r * CH_RS + ch * 16) = R.v; *(LAS u32x4*)(St + dd * 32 * CH_RS + rk * CH_RS + ch * 16) = R.s; }
    { const int d = wave >> 2, dk0 = 8 * (wave & 3), sp = d ? 63 - lane : lane;
      float bc[8]; gla_gates_wave(R.gg, g_up, g_b, h, lane, wave, bc);
      float qf[8], kf[8]; unpack8(R.q, qf); unpack8(R.k, kf);
#pragma unroll
      for (int c = 0; c < 8; ++c) { qf[c] *= __expf(bc[c]); kf[c] *= __expf(-bc[c]); }
      *(LAS u32x4*)(Qs + d * GL_T + sp * GL_RS + dk0 * 2) = pack8(qf); *(LAS u32x4*)(Ks + d * GL_T + sp * GL_RS + dk0 * 2) = pack8(kf); }
    LBAR();
    const int d = wave >> 2, tt = wave & 3, g = lane >> 4, i = lane & 15, t = 16 * tt + i;
    f32x4 hh[4];
    {
        const bf16x8 bq = *(const LAS bf16x8*)(Qs + d * GL_T + t * GL_RS + 16 * g);
        f32x4 sT[4];
#pragma unroll
        for (int st = 0; st < 4; ++st) {
            f32x4 c = (f32x4){0.f, 0.f, 0.f, 0.f};
            c = MFMA16(*(const LAS bf16x8*)(Ks + d * GL_T + (16 * st + i) * GL_RS + 16 * g), bq, c);
#pragma unroll
            for (int rr = 0; rr < 4; ++rr) { const int sidx = 16 * st + 4 * g + rr; const bool ok = d ? (sidx >= t) : (sidx <= t); sT[st][rr] = ok ? c[rr] : 0.f; }
        }
        bf16x8 pb[2];
#pragma unroll
        for (int gp = 0; gp < 2; ++gp) { u32x4 w; w.x = cvtpk(sT[2 * gp][0], sT[2 * gp][1]); w.y = cvtpk(sT[2 * gp][2], sT[2 * gp][3]); w.z = cvtpk(sT[2 * gp + 1][0], sT[2 * gp + 1][1]); w.w = cvtpk(sT[2 * gp + 1][2], sT[2 * gp + 1][3]); pb[gp] = __builtin_bit_cast(bf16x8, w); }
#pragma unroll
        for (int dvt = 0; dvt < 4; ++dvt) {
            f32x4 c = (f32x4){0.f, 0.f, 0.f, 0.f};
            c = MFMA16(tr_frag_perm(Vt, CH_RS, 0, 16 * dvt, lane), pb[0], c); c = MFMA16(tr_frag_perm(Vt, CH_RS, 32, 16 * dvt, lane), pb[1], c);
            c = MFMA16(tr_frag(St + d * 32 * CH_RS, CH_RS, 0, 16 * dvt, lane), bq, c);
            hh[dvt] = c;
        }
        if (d == 1) {
#pragma unroll
            for (int dvt = 0; dvt < 4; ++dvt) hs[(tt * 4 + dvt) * 64 + lane] = hh[dvt];
        }
    }
    LBAR();
    if (d == 0) {
        float s1 = 0.f;
#pragma unroll
        for (int dvt = 0; dvt < 4; ++dvt) { hh[dvt] = hh[dvt] + hs[(tt * 4 + dvt) * 64 + lane]; s1 += (hh[dvt][0] + hh[dvt][1]) + (hh[dvt][2] + hh[dvt][3]); }
        s1 += __shfl_xor(s1, 16); s1 += __shfl_xor(s1, 32);
        const float mu = s1 * (1.f / 64.f); float s2 = 0.f;
#pragma unroll
        for (int dvt = 0; dvt < 4; ++dvt) { hh[dvt] = hh[dvt] - mu; s2 += (hh[dvt][0] * hh[dvt][0] + hh[dvt][1] * hh[dvt][1]) + (hh[dvt][2] * hh[dvt][2] + hh[dvt][3] * hh[dvt][3]); }
        s2 += __shfl_xor(s2, 16); s2 += __shfl_xor(s2, 32);
        const float rstd = rsqrtf(s2 * (1.f / 64.f) + LN_EPS);
        const int row = b0 + t;
#pragma unroll
        for (int dvt = 0; dvt < 4; ++dvt) { const int col = h * 64 + 16 * dvt + 4 * g;
            const uint2 gg = R.og[dvt]; const f32x4 nw = *(const f32x4*)(normw + col);
            const float o0 = hh[dvt][0] * rstd * nw[0] * siluf(__uint_as_float(gg.x << 16)), o1 = hh[dvt][1] * rstd * nw[1] * siluf(__uint_as_float(gg.x & 0xffff0000u));
            const float o2 = hh[dvt][2] * rstd * nw[2] * siluf(__uint_as_float(gg.y << 16)), o3 = hh[dvt][3] * rstd * nw[3] * siluf(__uint_as_float(gg.y & 0xffff0000u));
            uint2 o; o.x = cvtpk(o0, o1); o.y = cvtpk(o2, o3); *(uint2*)(CAT + (size_t)row * DM + 768 + col) = o; }
    }
}

__device__ __forceinline__ f32x4 ld4bf(const bf16_t* p) { const uint2 v = *(const uint2*)p; return (f32x4){__uint_as_float(v.x << 16), __uint_as_float(v.x & 0xffff0000u), __uint_as_float(v.y << 16), __uint_as_float(v.y & 0xffff0000u)}; }
__device__ __forceinline__ void ln16(f32x4 (&v)[4], const float* w, const float* b, int lane) {
    float s = 0.f;
#pragma unroll
    for (int j = 0; j < 4; ++j) s += (v[j][0] + v[j][1]) + (v[j][2] + v[j][3]);
    const float mean = wave_sum(s) * (1.f / DM); float s2 = 0.f;
#pragma unroll
    for (int j = 0; j < 4; ++j) { v[j] = v[j] - mean; s2 += (v[j][0] * v[j][0] + v[j][1] * v[j][1]) + (v[j][2] * v[j][2] + v[j][3] * v[j][3]); }
    const float rstd = rsqrtf(wave_sum(s2) * (1.f / DM) + LN_EPS);
#pragma unroll
    for (int j = 0; j < 4; ++j) { const f32x4 wv = *(const f32x4*)(w + 4 * lane + 256 * j), bv = *(const f32x4*)(b + 4 * lane + 256 * j); v[j] = v[j] * rstd * wv + bv; }
}
__device__ __forceinline__ void mod_store(f32x4 (&v)[4], const float* shift, const float* scale, bf16_t* hrow, int lane) {
#pragma unroll
    for (int j = 0; j < 4; ++j) { const f32x4 sh = *(const f32x4*)(shift + 4 * lane + 256 * j), sc = *(const f32x4*)(scale + 4 * lane + 256 * j);
        v[j] = v[j] * (sc + 1.f) + sh;
        uint2 o; o.x = cvtpk(v[j][0], v[j][1]); o.y = cvtpk(v[j][2], v[j][3]); *(uint2*)(hrow + 4 * lane + 256 * j) = o; }
}

__global__ void __launch_bounds__(512, 2) fwd(Args a_unused) {
    extern __shared__ __attribute__((aligned(16))) unsigned char lds_raw[];
    LAS unsigned char* lds = (LAS unsigned char*)lds_raw;
    const int wave0 = __builtin_amdgcn_readfirstlane(threadIdx.x >> 6);
    const int G0 = gridDim.x, bid0 = blockIdx.x;
    typedef const __attribute__((address_space(4))) Args* ArgsP;
    ArgsP ap0 = (ArgsP)__builtin_amdgcn_kernarg_segment_ptr();
#define PH_CTX() int G = G0, bid = bid0; asm volatile("" : "+s"(G), "+s"(bid)); int wave = wave0; asm volatile("" : "+s"(wave)); unsigned ones_ = ~0u; asm volatile("" : "+s"(ones_)); const int lane = (int)__builtin_amdgcn_mbcnt_hi(ones_, __builtin_amdgcn_mbcnt_lo(ones_, 0u)); const int tid = wave * 64 + lane; \
    ArgsP ap = ap0; asm volatile("" : "+s"(ap)); unsigned char* ws = ap->ws; const int gw = bid * 8 + wave, NGW = G * 8; (void)lane; (void)gw; (void)NGW; (void)ws
#define WSP(T, off) ((T*)(ws + (off)))
    volatile LAS unsigned* MISC = (volatile LAS unsigned*)(lds + MISC_OFF);
    if (threadIdx.x < 32) MISC[threadIdx.x] = 0u;
    __syncthreads();
    XcdBarrier bar; bar.bar = (unsigned*)(ap0->ws + WS_CTL) + CW_BAR; bar.x = 0; bar.st = MISC + 8;
    if (MK_ONE_LAUNCH) bar = xcd_barrier_post(bar.bar, MISC + 8);
    const int lo = ap0->ph_lo, hi = ap0->ph_hi;
#define IN(k) (lo <= (k) && (k) < hi)
#define SEAM(k) do { if (MK_ONE_LAUNCH && (k) + 1 < hi) xcd_barrier(bar); } while (0)

    if (IN(0)) {
        PH_CTX();
        float* MODS = WSP(float, WS_MODS);
        LAS float* scs = (LAS float*)lds;
        for (int i = tid; i < 2048; i += 512) scs[i] = siluf(i < 1024 ? ap->in[1][i] : ap->in[3][i - 1024]);
        __syncthreads();
        for (int u = bid; u < 4 * 8 * 12; u += G) {
            const int l = u / 96, rem = u % 96, kc = rem / 12, ng = rem % 12, n = ng * 512 + tid;
            const float* w = ap->in[4] + ((size_t)l * 1024 + kc * 128) * 6144 + n;
            float a0 = 0.f, a1 = 0.f;
#pragma unroll 8
            for (int k = 0; k < 128; ++k) { const float wv = w[(size_t)k * 6144]; a0 += scs[kc * 128 + k] * wv; a1 += scs[1024 + kc * 128 + k] * wv; }
            if (kc == 0) { const float bb = ap->in[5][l * 6144 + n]; a0 += bb; a1 += bb; }
            atomicAdd(MODS + (size_t)(l * 2 + 0) * 6144 + n, a0); atomicAdd(MODS + (size_t)(l * 2 + 1) * 6144 + n, a1);
        }
        if (bid < 8) { float* ropeC = WSP(float, WS_ROPE); float* ropeS = ropeC + 256 * 16;
            const int i = bid * 512 + tid, pos = i >> 4, fi = i & 15; const float inv = powf(10000.f, -(float)fi / 16.f); const float ang = (float)pos * inv; float sn, cs; sincosf(ang, &sn, &cs); ropeC[i] = cs; ropeS[i] = sn; }
        __syncthreads();
        LAS float* scr = (LAS float*)(lds + wave * 16640);
        constexpr int I_A = 16 * 44, I_B = 16 * 16, I_C = 16 * 88, I_D = 44 * 16, I_E = 0, I_F = 0;
        constexpr int N_A = 4 * I_A, N_B = 4 * I_B, N_C = 2 * I_C, N_D = 2 * I_D, N_E = 16 * I_E, N_F = 16 * I_F;
        for (int it = gw; it < N_A + N_B + N_C + N_D; it += NGW) {
            int r = it;
            if (r < N_A) { const int mi = r / I_A; tr_item(ap->in[6] + (size_t)mi * DM * IN_COLS, DM, IN_COLS, NPIN, WSP(bf16_t, WS_WIN) + (size_t)mi * NPIN * DM, 1, 0, scr, r % I_A, lane); continue; } r -= N_A;
            if (r < N_B) { const int mi = r / I_B; tr_item(ap->in[13] + (size_t)mi * DM * DM, DM, DM, DM, WSP(bf16_t, WS_WOUT) + (size_t)mi * DM * DM, 0, 0, scr, r % I_B, lane); continue; } r -= N_B;
            if (r < N_C) { const int mi = r / I_C; tr_item<true>(ap->in[16] + (size_t)mi * DM * 2 * DFF, DM, 2 * DFF, 2 * DFF, (bf16_t*)(WSP(unsigned char, WS_FGU) + (size_t)mi * 2 * DFF * DM), 2, DFF, scr, r % I_C, lane, MGU_SCALE); continue; } r -= N_C;
            { const int mi = r / I_D; tr_item(ap->in[17] + (size_t)mi * DFF * DM, DFF, DM, DM, WSP(bf16_t, WS_FDN) + (size_t)mi * DM * DFF, 0, 0, scr, r % I_D, lane); }
        }
        __syncthreads();
        { constexpr int J_GU = 8 * 28, J_DN = 28 * 4, J_PER = J_GU + J_DN;
          for (int it = bid; it < 16 * J_PER; it += G) { const int mi = it / J_PER, r = it % J_PER;
              if (r < J_GU) tr_item_f8_wg(lds, ap->in[20] + (size_t)mi * DM * 2 * DEXP, DM, 2 * DEXP, 2 * DEXP, WSP(unsigned char, WS_MGU) + (size_t)mi * 2 * DEXP * DM, 2, DEXP, r, tid, lane, wave, MGU_SCALE);
              else tr_item_f8_wg(lds, ap->in[21] + (size_t)mi * DEXP * DM, DEXP, DM, DM, WSP(unsigned char, WS_MDN) + (size_t)mi * DM * DEXP, 0, 0, r - J_GU, tid, lane, wave, MDN_SCALE); } }
        SEAM(0);
    }
    if (IN(1)) {
        PH_CTX();
        bf16_t* H = WSP(bf16_t, WS_H); const float* MODS = WSP(float, WS_MODS);
        for (int r = gw; r < TT; r += NGW) {
            const int wch = r >= SEQ; const float* src = wch ? ap->in[2] + (size_t)(r - SEQ) * DM : ap->in[0] + (size_t)r * DM;
            f32x4 v[4];
#pragma unroll
            for (int j = 0; j < 4; ++j) v[j] = *(const f32x4*)(src + 4 * lane + 256 * j);
            const float* md = MODS + (size_t)(0 * 2 + wch) * 6144;
            mod_store(v, md, md + 1024, H + (size_t)r * DM, lane);
        }
        SEAM(1);
    }

    for (int l = 0; l < DEPTH; ++l) {
        const int pb = 2 + 10 * l;
        const bool lastl = (l == DEPTH - 1), moe = (l & 1);
        const int nrows = lastl ? SEQ : TT;

        PHASE_REP(0) if (IN(pb + 0)) {
            PH_CTX();
            pg8::StaticOrder S; S.init(WSP(bf16_t, WS_H), WSP(bf16_t, WS_WIN) + (size_t)l * NPIN * DM, DM, TT, NPIN, G, bid);
            pg8::EpiInProj E{WSP(bf16_t, WS_P), WSP(float, WS_G), WSP(float, WS_ROPE), WSP(float, WS_ROPE) + 256 * 16};
            pg8::gemm_phase<pg8::EpiInProj, pg8::StaticOrder>(lds, DM, S, E, tid);
            SEAM(pb + 0);
        }
        PHASE_REP(1) if (IN(pb + 1)) {
            if (!lastl && bid0 >= 32 && bid0 < 36) { PH_CTX(); attn_unit(lds, WSP(bf16_t, WS_P), WSP(bf16_t, WS_CAT), -1, (bid - 32) >> 1, bid & 1, ap->in[9] + l * 8, tid, lane, wave); }
            { PH_CTX();
              const bf16_t* P = WSP(bf16_t, WS_P); const float* Gt = WSP(float, WS_G); const float* gate_b = ap->in[7] + l * 16;
#define UNIT_LOOP2(N_, start_, RawT, LOAD, BODY) do { int u0_ = (start_); if (u0_ < (N_)) { RawT A_ = LOAD(u0_); for (;;) { \
                  const int u1_ = u0_ + G; const RawT B_ = LOAD(u1_ < (N_) ? u1_ : u0_); BODY(A_, u0_); if (u1_ >= (N_)) break; \
                  const int u2_ = u1_ + G; A_ = LOAD(u2_ < (N_) ? u2_ : u1_); BODY(B_, u1_); if (u2_ >= (N_)) break; u0_ = u2_; } } } while (0)
#define MS_LOAD(u) mlstm_summary_load(P, Gt, gate_b, (u) / NCH, (u) % NCH, tid, lane, wave)
#define MS_BODY(R, u) mlstm_summary_body(lds, R, WSP(float, WS_MU), WSP(float, WS_MNU), WSP(float, WS_MSC), (u) / NCH, (u) % NCH, tid, lane, wave)
              UNIT_LOOP2(4 * NCH, bid, MsRaw, MS_LOAD, MS_BODY); }
            { PH_CTX();
              const bf16_t* P = WSP(bf16_t, WS_P); const float* Gt = WSP(float, WS_G);
#define GS_LOAD(u) gla_summary_load(P, Gt, (u) / NCH, (u) % NCH, tid, lane, wave)
              LAS float* gupL = (LAS float*)(lds + 65536); LAS float* gbL = gupL + 4096;
              __syncthreads(); for (int i = tid; i < 4096; i += 512) gupL[i] = ap->in[10][(size_t)l * 4096 + i]; if (tid < 256) gbL[tid] = ap->in[11][l * 256 + tid]; __syncthreads();
#define GS_BODY(R, u) gla_summary_body(lds, R, gupL, gbL, WSP(float, WS_GU), WSP(float, WS_GDEC), (u) / NCH, (u) % NCH, tid, lane, wave)
              UNIT_LOOP2(4 * NCH, (bid + 240) % G, GsRaw, GS_LOAD, GS_BODY); }
            SEAM(pb + 1);
        }
        PHASE_REP(2) if (IN(pb + 2)) {
            PH_CTX();
            const int wi = wave * G + bid;
            const int e0 = wi * 64;
            LAS float* sc = (LAS float*)(lds + wave * 4096);
#define SC_LOAD(buf, b) _Pragma("unroll") for (int j = 0; j < 52; ++j) buf[j] = U[(size_t)((b) * 52 + j) * str]
            if (e0 < 32768 + 512) {
                const bool isC = e0 < 32768;
                const int hd = isC ? e0 / 4096 : (e0 - 32768) / 64, idx = isC ? (e0 % 4096) + lane : lane;
                const int dkr = (e0 % 4096) >> 6;
                const float* __restrict__ U = isC ? WSP(float, WS_MU) + (size_t)(hd * 64 + dkr) * NCH * 64 + lane : WSP(float, WS_MNU) + (size_t)hd * NCH * 64 + lane;
                bf16_t* __restrict__ StC = WSP(bf16_t, WS_MC) + (size_t)(hd * 64 + dkr) * NCH * 64 + lane; float* __restrict__ StN = WSP(float, WS_MNS) + (size_t)hd * NCH * 64 + lane;
                float* __restrict__ MSC = WSP(float, WS_MSC) + (size_t)hd * NCH * 4;
                const int str = 64;
                const bool wr_m_wave = isC && (e0 % 4096) == 0;
                {
                    float cmv[5], Bv[5]; float a = 0.f, b = -INFINITY;
#pragma unroll
                    for (int q = 0; q < 5; ++q) { const int n = 5 * lane + q; const bool ok = n < NCH; const float2 v = ok ? *(const float2*)(MSC + n * 4) : make_float2(-INFINITY, 0.f);
                        cmv[q] = v.x; Bv[q] = v.y; b = fmaxf(b + v.y, v.x + v.y); a += v.y; }
#pragma unroll
                    for (int o = 1; o < 64; o <<= 1) { const float pa = __shfl_up(a, o), pb = __shfl_up(b, o); if (lane >= o) { b = fmaxf(pb + a, b); a = pa + a; } }
                    float ea = __shfl_up(a, 1), eb = __shfl_up(b, 1); if (lane == 0) { ea = 0.f; eb = -INFINITY; }
                    float m = fmaxf(ea, eb);
#pragma unroll
                    for (int q = 0; q < 5; ++q) { const int n = 5 * lane + q;
                        if (n < NCH) { const float mx = fmaxf(m, cmv[q]); sc[2 * n] = __expf(m - mx); sc[2 * n + 1] = __expf(cmv[q] - mx); if (wr_m_wave) MSC[n * 4 + 2] = m; m = Bv[q] + mx; } }
                }
                LDS_WAIT();
                float cval = 0.f;
#define SC_STEP_M(buf, b) _Pragma("unroll") for (int j = 0; j < 52; ++j) { const int n = (b) * 52 + j; \
                    if (isC) StC[(size_t)n * 64] = (bf16_t)f2bf(cval); else StN[(size_t)n * 64] = cval; \
                    cval = sc[2 * n] * cval + sc[2 * n + 1] * buf[j]; }
                float ua[52], ub[52];
                SC_LOAD(ua, 0);
                SC_LOAD(ub, 1); SC_STEP_M(ua, 0); SC_LOAD(ua, 2); SC_STEP_M(ub, 1);
                SC_LOAD(ub, 3); SC_STEP_M(ua, 2); SC_LOAD(ua, 4); SC_STEP_M(ub, 3);
                SC_STEP_M(ua, 4);
#undef SC_STEP_M
            } else if (e0 < 32768 + 512 + 16384) {
                const int e2 = e0 - 33280, hd = e2 / 2048, idx = (e2 % 2048) + lane, dk = (e2 % 2048) >> 6;
                const float* __restrict__ U = WSP(float, WS_GU) + (size_t)(hd * 32 + dk) * NCH * 64 + lane; bf16_t* __restrict__ St = WSP(bf16_t, WS_GS) + (size_t)(hd * 32 + dk) * NCH * 64 + lane;
                const float* __restrict__ DC = WSP(float, WS_GDEC) + (size_t)hd * NCH * 32 + dk;
                const int str = 64;
                for (int k = lane; k < NCH; k += 64) sc[k] = DC[(size_t)k * 32];
                LDS_WAIT();
                float sval = 0.f;
#define SC_STEP_G(buf, b) _Pragma("unroll") for (int j = 0; j < 52; ++j) { const int n = (b) * 52 + j; St[(size_t)n * 64] = (bf16_t)f2bf(sval); sval = sc[n] * sval + buf[j]; }
                float ua[52], ub[52];
                SC_LOAD(ua, 0);
                SC_LOAD(ub, 1); SC_STEP_G(ua, 0); SC_LOAD(ua, 2); SC_STEP_G(ub, 1);
                SC_LOAD(ub, 3); SC_STEP_G(ua, 2); SC_LOAD(ua, 4); SC_STEP_G(ub, 3);
                SC_STEP_G(ua, 4);
#undef SC_STEP_G
            }
#undef SC_LOAD
            SEAM(pb + 2);
        }
        PHASE_REP(3) if (IN(pb + 3)) {
            const int noc = lastl ? 256 : 260;
            { PH_CTX();
              for (int u = bid; u < 256; u += G) attn_unit(lds, WSP(bf16_t, WS_P), WSP(bf16_t, WS_CAT), u >> 1, 0, u & 1, ap->in[9] + l * 8, tid, lane, wave); }
            { PH_CTX();
              const bf16_t* P = WSP(bf16_t, WS_P); const float* Gt = WSP(float, WS_G); const float* gate_b = ap->in[7] + l * 16;
              const bf16_t* MC = WSP(bf16_t, WS_MC); const float* MNS = WSP(float, WS_MNS); const float* MSC = WSP(float, WS_MSC);
#define MO_LOAD(u) mlstm_out_load(P, Gt, gate_b, MC, MNS, MSC, (u) / noc, (u) % noc, tid, lane, wave)
#define MO_BODY(R, u) mlstm_out_body(lds, R, ap->in[8] + l * 256, WSP(bf16_t, WS_CAT), (u) / noc, (u) % noc, tid, lane, wave)
              UNIT_LOOP2(4 * noc, bid, MoRaw, MO_LOAD, MO_BODY); }
            { PH_CTX();
              const bf16_t* P = WSP(bf16_t, WS_P); const float* Gt = WSP(float, WS_G); const bf16_t* GS = WSP(bf16_t, WS_GS);
#define GO_LOAD(u) gla_out_load(P, Gt, GS, (u) / noc, (u) % noc, tid, lane, wave)
              LAS float* gupL = (LAS float*)(lds + 65536); LAS float* gbL = gupL + 4096;
              __syncthreads(); for (int i = tid; i < 4096; i += 512) gupL[i] = ap->in[10][(size_t)l * 4096 + i]; if (tid < 256) gbL[tid] = ap->in[11][l * 256 + tid]; __syncthreads();
#define GO_BODY(R, u) gla_out_body(lds, R, gupL, gbL, ap->in[12] + l * 256, WSP(bf16_t, WS_CAT), (u) / noc, (u) % noc, tid, lane, wave)
              UNIT_LOOP2(4 * noc, (bid + 240) % G, GoRaw, GO_LOAD, GO_BODY); }
            SEAM(pb + 3);
        }
        PHASE_REP(4) if (IN(pb + 4)) {
            PH_CTX();
            const float* modl = WSP(float, WS_MODS) + (size_t)(l * 2 + 0) * 6144;
            int tp, sp; pg8::tail_params(nrows / 256, 4, DM / 64, G, tp, sp);
            pg8::TailOrder S; S.dense(WSP(bf16_t, WS_CAT), WSP(bf16_t, WS_WOUT) + (size_t)l * DM * DM, DM, DM, nrows / 256, G, bid, tp, sp);
            pg8::EpiResid E{WSP(bf16_t, WS_Y), modl + 2 * 1024, modl + 6144 + 2 * 1024, WSP(float, WS_YP), nrows - tp * 256, tp * 256};
            pg8::gemm_phase<pg8::EpiResid, pg8::TailOrder>(lds, DM, S, E, tid);
            SEAM(pb + 4);
        }
        if (IN(pb + 5)) {
            PH_CTX();
            float* X = WSP(float, WS_X); bf16_t* H = WSP(bf16_t, WS_H); const bf16_t* Yb = WSP(bf16_t, WS_Y);
            const float* modl = WSP(float, WS_MODS) + (size_t)(l * 2 + 0) * 6144;
            unsigned* mcnt = WSP(unsigned, WS_CTL) + CW_MOE + 64 * 8 * (l >> 1);
            LAS float* RW = (LAS float*)lds;
            if (moe) { const float* rw = ap->in[18] + (size_t)(l >> 1) * DM * 8; for (int i = tid; i < 8192; i += 512) { const int e = i >> 10, c = i & 1023; RW[i] = rw[c * 8 + e]; } __syncthreads(); }
            const float* lw = ap->in[14] + (size_t)(l * 2 + 0) * DM; const float* lb = ap->in[15] + (size_t)(l * 2 + 0) * DM;
            int tp, sp; pg8::tail_params(nrows / 256, 4, DM / 64, G, tp, sp);
            const int tail0 = nrows - tp * 256; const float* YP = WSP(float, WS_YP);
            for (int r = gw; r < nrows; r += NGW) {
                const int wch = r >= SEQ; const float* md = modl + wch * 6144;
                const float* xres = (l == 0) ? (wch ? ap->in[2] + (size_t)(r - SEQ) * DM : ap->in[0] + (size_t)r * DM) : X + (size_t)r * DM;
                f32x4 v[4];
                if (r < tail0) {
#pragma unroll
                    for (int j = 0; j < 4; ++j) v[j] = *(const f32x4*)(xres + 4 * lane + 256 * j) * ALPHA + ld4bf(Yb + (size_t)r * DM + 4 * lane + 256 * j);
                } else {
#pragma unroll
                    for (int j = 0; j < 4; ++j) { const int c = 4 * lane + 256 * j; f32x4 a4 = (f32x4){0.f, 0.f, 0.f, 0.f};
                        for (int p = 0; p < sp; ++p) a4 = a4 + *(const f32x4*)(YP + ((size_t)p * tp * 256 + (r - tail0)) * DM + c);
                        v[j] = *(const f32x4*)(xres + c) * ALPHA + *(const f32x4*)(md + 2 * 1024 + c) * a4; }
                }
                ln16(v, lw, lb, lane);
#pragma unroll
                for (int j = 0; j < 4; ++j) *(f32x4*)(X + (size_t)r * DM + 4 * lane + 256 * j) = v[j];
#pragma unroll
                for (int j = 0; j < 4; ++j) { const f32x4 sh = *(const f32x4*)(md + 3 * 1024 + 4 * lane + 256 * j), sc = *(const f32x4*)(md + 4 * 1024 + 4 * lane + 256 * j); v[j] = v[j] * (sc + 1.f) + sh; }
                if (!moe) {
#pragma unroll
                    for (int j = 0; j < 4; ++j) *(unsigned*)((unsigned char*)H + (size_t)r * DM + 4 * lane + 256 * j) = pk4_fp8(v[j][0], v[j][1], v[j][2], v[j][3]);
                } else {
                    float lg[8];
#pragma unroll
                    for (int e = 0; e < 8; ++e) { float s = 0.f;
#pragma unroll
                        for (int j = 0; j < 4; ++j) { const f32x4 w = *(const LAS f32x4*)(RW + e * 1024 + 4 * lane + 256 * j); s += v[j][0] * w[0] + v[j][1] * w[1] + v[j][2] * w[2] + v[j][3] * w[3]; }
                        lg[e] = wave_sum(s) + ap->in[19][(l >> 1) * 8 + e]; }
                    int e0 = 0; float l0 = lg[0];
#pragma unroll
                    for (int e = 1; e < 8; ++e) if (lg[e] > l0) { l0 = lg[e]; e0 = e; }
                    int e1 = -1; float l1 = -INFINITY;
#pragma unroll
                    for (int e = 0; e < 8; ++e) if (e != e0 && lg[e] > l1) { l1 = lg[e]; e1 = e; }
                    int p0 = 0, p1 = 0;
                    if (lane == 0) {
                        const float w0 = 1.f / (1.f + __expf(l1 - l0));
                        p0 = (int)atomicAdd(mcnt + 64 * e0, 1u); p1 = (int)atomicAdd(mcnt + 64 * e1, 1u);
                        WSP(int2, WS_TOKE)[r] = make_int2(e0, e1); WSP(int2, WS_TOKP)[r] = make_int2(p0, p1); WSP(float2, WS_TOKW)[r] = make_float2(w0, 1.f - w0);
                    }
                    p0 = __builtin_amdgcn_readfirstlane(p0); p1 = __builtin_amdgcn_readfirstlane(p1);
                    unsigned char* x0 = WSP(unsigned char, WS_XB) + ((size_t)e0 * TT + p0) * DM; unsigned char* x1 = WSP(unsigned char, WS_XB) + ((size_t)e1 * TT + p1) * DM;
#pragma unroll
                    for (int j = 0; j < 4; ++j) { const unsigned o = pk4_fp8(v[j][0], v[j][1], v[j][2], v[j][3]); *(unsigned*)(x0 + 4 * lane + 256 * j) = o; *(unsigned*)(x1 + 4 * lane + 256 * j) = o; }
                }
            }
            SEAM(pb + 5);
        }
#define MOE_TS() int ts0 = 0, ts1, ts2, ts3, ts4, ts5, ts6, ts7, ts8; { const unsigned* mcnt = WSP(unsigned, WS_CTL) + CW_MOE + 64 * 8 * (l >> 1); \
            ts1 = ts0 + (int)((__hip_atomic_load(mcnt + 64 * 0, __ATOMIC_RELAXED, __HIP_MEMORY_SCOPE_AGENT) + 255u) >> 8); ts2 = ts1 + (int)((__hip_atomic_load(mcnt + 64 * 1, __ATOMIC_RELAXED, __HIP_MEMORY_SCOPE_AGENT) + 255u) >> 8); \
            ts3 = ts2 + (int)((__hip_atomic_load(mcnt + 64 * 2, __ATOMIC_RELAXED, __HIP_MEMORY_SCOPE_AGENT) + 255u) >> 8); ts4 = ts3 + (int)((__hip_atomic_load(mcnt + 64 * 3, __ATOMIC_RELAXED, __HIP_MEMORY_SCOPE_AGENT) + 255u) >> 8); \
            ts5 = ts4 + (int)((__hip_atomic_load(mcnt + 64 * 4, __ATOMIC_RELAXED, __HIP_MEMORY_SCOPE_AGENT) + 255u) >> 8); ts6 = ts5 + (int)((__hip_atomic_load(mcnt + 64 * 5, __ATOMIC_RELAXED, __HIP_MEMORY_SCOPE_AGENT) + 255u) >> 8); \
            ts7 = ts6 + (int)((__hip_atomic_load(mcnt + 64 * 6, __ATOMIC_RELAXED, __HIP_MEMORY_SCOPE_AGENT) + 255u) >> 8); ts8 = ts7 + (int)((__hip_atomic_load(mcnt + 64 * 7, __ATOMIC_RELAXED, __HIP_MEMORY_SCOPE_AGENT) + 255u) >> 8); \
            ts1 = __builtin_amdgcn_readfirstlane(ts1); ts2 = __builtin_amdgcn_readfirstlane(ts2); ts3 = __builtin_amdgcn_readfirstlane(ts3); ts4 = __builtin_amdgcn_readfirstlane(ts4); \
            ts5 = __builtin_amdgcn_readfirstlane(ts5); ts6 = __builtin_amdgcn_readfirstlane(ts6); ts7 = __builtin_amdgcn_readfirstlane(ts7); ts8 = __builtin_amdgcn_readfirstlane(ts8); } (void)ts0; (void)ts8
        PHASE_REP(7) if (IN(pb + 7)) {
            if (!moe) {
                PH_CTX();
                pg8::StaticOrder S; S.init(WSP(bf16_t, WS_H), WSP(unsigned char, WS_FGU) + (size_t)(l >> 1) * 2 * DFF * DM, DM / 2, nrows, 2 * DFF, G, bid);
                pg8::EpiSwiglu E{WSP(bf16_t, WS_ACT), DFF, 1.f / MGU_SCALE, 1.f};
                pg8::gemm_phase<pg8::EpiSwiglu, pg8::StaticOrder, true>(lds, DM / 2, S, E, tid);
            } else {
                PH_CTX();
                MOE_TS();
                pg8::MoeOrder S; S.A = (const char*)WSP(bf16_t, WS_XB); S.Bt = (const char*)WSP(unsigned char, WS_MGU) + (size_t)(l >> 1) * 8 * 2 * DEXP * DM; S.K = DM / 2; S.N = 2 * DEXP;     S.nN = 2 * DEXP / 256; S.ntile = ts8; S.G = G; S.c = bid;
                S.ts1 = ts1; S.ts2 = ts2; S.ts3 = ts3; S.ts4 = ts4; S.ts5 = ts5; S.ts6 = ts6; S.ts7 = ts7;
                pg8::EpiSwigluT<true> E{WSP(bf16_t, WS_ACT), DEXP, 1.f / MGU_SCALE, ACT_SCALE};
                pg8::gemm_phase<pg8::EpiSwigluT<true>, pg8::MoeOrder, true>(lds, DM / 2, S, E, tid);
            }
            SEAM(pb + 7);
        }
        PHASE_REP(8) if (IN(pb + 8)) {
            if (!moe) {
                PH_CTX();
                const float* modl = WSP(float, WS_MODS) + (size_t)(l * 2 + 0) * 6144;
                int tp, sp; pg8::tail_params(nrows / 256, 4, DFF / 64, G, tp, sp);
                pg8::TailOrder S; S.dense(WSP(bf16_t, WS_ACT), WSP(bf16_t, WS_FDN) + (size_t)(l >> 1) * DM * DFF, DFF, DM, nrows / 256, G, bid, tp, sp);
                pg8::EpiResid E{WSP(bf16_t, WS_Y), modl + 5 * 1024, modl + 6144 + 5 * 1024, WSP(float, WS_YP), nrows - tp * 256, tp * 256};
                pg8::gemm_phase<pg8::EpiResid, pg8::TailOrder>(lds, DFF, S, E, tid);
            } else {
                PH_CTX();
                MOE_TS();
                int tp, sp; pg8::tail_params(ts8, 4, DEXP / 128, G, tp, sp);
                pg8::TailOrder S; S.dense(WSP(bf16_t, WS_ACT), WSP(unsigned char, WS_MDN) + (size_t)(l >> 1) * 8 * DM * DEXP, DEXP / 2, DM, ts8, G, bid, tp, sp);
                S.ts1 = ts1; S.ts2 = ts2; S.ts3 = ts3; S.ts4 = ts4; S.ts5 = ts5; S.ts6 = ts6; S.ts7 = ts7;
                pg8::EpiRaw E{WSP(bf16_t, WS_YS), WSP(float, WS_YP), (ts8 - tp) * 256, tp * 256, 1.f / (MDN_SCALE * ACT_SCALE)};
                pg8::gemm_phase<pg8::EpiRaw, pg8::TailOrder, true>(lds, DEXP / 2, S, E, tid);
            }
            SEAM(pb + 8);
        }
        if (IN(pb + 9)) {
            PH_CTX();
            float* X = WSP(float, WS_X); bf16_t* H = WSP(bf16_t, WS_H); const bf16_t* Yb = WSP(bf16_t, WS_Y); const bf16_t* YS = WSP(bf16_t, WS_YS);
            const float* modl = WSP(float, WS_MODS) + (size_t)(l * 2 + 0) * 6144;
            const float* lw = ap->in[14] + (size_t)(l * 2 + 1) * DM; const float* lb = ap->in[15] + (size_t)(l * 2 + 1) * DM;
            int tp, sp, tail0; const float* YP = WSP(float, WS_YP);
            MOE_TS();
            if (!moe) { pg8::tail_params(nrows / 256, 4, DFF / 64, G, tp, sp); tail0 = nrows - tp * 256; }
            else { pg8::tail_params(ts8, 4, DEXP / 128, G, tp, sp); tail0 = (ts8 - tp) * 256; }
            for (int r = gw; r < nrows; r += NGW) {
                const int wch = r >= SEQ; const float* md = modl + wch * 6144;
                f32x4 v[4];
                if (!moe) {
                    if (r < tail0) {
#pragma unroll
                        for (int j = 0; j < 4; ++j) v[j] = *(const f32x4*)(X + (size_t)r * DM + 4 * lane + 256 * j) * ALPHA + ld4bf(Yb + (size_t)r * DM + 4 * lane + 256 * j);
                    } else {
#pragma unroll
                        for (int j = 0; j < 4; ++j) { const int c = 4 * lane + 256 * j; f32x4 a4 = (f32x4){0.f, 0.f, 0.f, 0.f};
                            for (int p = 0; p < sp; ++p) a4 = a4 + *(const f32x4*)(YP + ((size_t)p * tp * 256 + (r - tail0)) * DM + c);
                            v[j] = *(const f32x4*)(X + (size_t)r * DM + c) * ALPHA + *(const f32x4*)(md + 5 * 1024 + c) * a4; }
                    }
                } else {
                    const int2 ee = WSP(int2, WS_TOKE)[r], pp = WSP(int2, WS_TOKP)[r]; const float2 ww = WSP(float2, WS_TOKW)[r];
                    int2 ss;
                    ss.x = 256 * (ee.x == 0 ? ts0 : ee.x == 1 ? ts1 : ee.x == 2 ? ts2 : ee.x == 3 ? ts3 : ee.x == 4 ? ts4 : ee.x == 5 ? ts5 : ee.x == 6 ? ts6 : ts7) + pp.x;
                    ss.y = 256 * (ee.y == 0 ? ts0 : ee.y == 1 ? ts1 : ee.y == 2 ? ts2 : ee.y == 3 ? ts3 : ee.y == 4 ? ts4 : ee.y == 5 ? ts5 : ee.y == 6 ? ts6 : ts7) + pp.y;
#pragma unroll
                    for (int j = 0; j < 4; ++j) { const int c = 4 * lane + 256 * j;
                        f32x4 y0, y1;
                        if (ss.x < tail0) y0 = ld4bf(YS + (size_t)ss.x * DM + c);
                        else { y0 = (f32x4){0.f, 0.f, 0.f, 0.f}; for (int p = 0; p < sp; ++p) y0 = y0 + *(const f32x4*)(YP + ((size_t)p * tp * 256 + (ss.x - tail0)) * DM + c); }
                        if (ss.y < tail0) y1 = ld4bf(YS + (size_t)ss.y * DM + c);
                        else { y1 = (f32x4){0.f, 0.f, 0.f, 0.f}; for (int p = 0; p < sp; ++p) y1 = y1 + *(const f32x4*)(YP + ((size_t)p * tp * 256 + (ss.y - tail0)) * DM + c); }
                        const f32x4 xv = *(const f32x4*)(X + (size_t)r * DM + c), g5 = *(const f32x4*)(md + 5 * 1024 + c);
                        v[j] = xv * ALPHA + g5 * (y0 * ww.x + y1 * ww.y); }
                }
                ln16(v, lw, lb, lane);
                if (lastl) {
#pragma unroll
                    for (int j = 0; j < 4; ++j) *(f32x4*)(ap->out + (size_t)r * DM + 4 * lane + 256 * j) = v[j];
                } else {
#pragma unroll
                    for (int j = 0; j < 4; ++j) *(f32x4*)(X + (size_t)r * DM + 4 * lane + 256 * j) = v[j];
                    const float* mdn = modl + 2 * 6144 + wch * 6144;
                    mod_store(v, mdn, mdn + 1024, H + (size_t)r * DM, lane);
                }
            }
            SEAM(pb + 9);
        }
    }
#undef IN
#undef SEAM
}

extern "C" void kernel_launch(void* const* d_in, const int* in_sizes, int n_in, void* d_out, int out_size, void* d_ws, size_t ws_size, hipStream_t stream) {
    static int grid = 0;
    if (grid == 0) {
        if (n_in != 22 || ws_size < WS_END) { fprintf(stderr, "kernel_launch: unexpected n_in %d / ws %zu (need %zu)\n", n_in, ws_size, (size_t)WS_END); grid = -1; return; }
        int dev = 0, cus = 0;
        if (hipGetDevice(&dev) != hipSuccess || hipDeviceGetAttribute(&cus, hipDeviceAttributeMultiprocessorCount, dev) != hipSuccess) { grid = -1; return; }
        if (hipFuncSetAttribute((const void*)fwd, hipFuncAttributeMaxDynamicSharedMemorySize, LDS_BYTES) != hipSuccess) { fprintf(stderr, "kernel_launch: hipFuncSetAttribute failed\n"); grid = -1; return; }
        int per_cu = 0;
        if (hipOccupancyMaxActiveBlocksPerMultiprocessor(&per_cu, (const void*)fwd, 512, LDS_BYTES) != hipSuccess || per_cu < 1) fprintf(stderr, "kernel_launch: occupancy query reports %d\n", per_cu);
        (void)hipGetLastError();
        grid = cus;
    }
    if (grid < 0) return;
    (void)hipMemsetAsync((char*)d_ws + WS_CTL, 0, CTL_BYTES, stream);
    Args a{};
    for (int i = 0; i < 22; ++i) a.in[i] = (const float*)d_in[i];
    a.out = (float*)d_out; a.ws = (unsigned char*)d_ws;
#if MK_ONE_LAUNCH
    a.ph_lo = 0; a.ph_hi = NPH;
    hipLaunchKernelGGL(fwd, dim3(grid), dim3(512), LDS_BYTES, stream, a);
#else
    for (int p = 0; p < NPH; ++p) {
        if (p >= 2 && ((p - 2) % 10) == 6 && ((((p - 2) / 10) & 1) == 0)) continue;
        a.ph_lo = p; a.ph_hi = p + 1;
        hipLaunchKernelGGL(fwd, dim3(grid), dim3(512), LDS_BYTES, stream, a);
    }
#endif
}
```

```cpp
#include <hip/hip_runtime.h>
#include <cstdio>
#include <cstdint>

#ifndef MK_ONE_LAUNCH
#define MK_ONE_LAUNCH 1
#endif

#ifndef DUP_MASK
#define DUP_MASK 0
#endif
#define PHASE_REP(k) for (int rep_ = 0; rep_ < 1 + ((DUP_MASK >> (k)) & 1); ++rep_)
#define LAS __attribute__((address_space(3)))
#define GAS __attribute__((address_space(1)))
typedef unsigned short bf16_t;
typedef short bf16x8 __attribute__((ext_vector_type(8)));
typedef float f32x4 __attribute__((ext_vector_type(4)));
typedef unsigned u32x4 __attribute__((ext_vector_type(4)));
typedef unsigned u32x2_t __attribute__((ext_vector_type(2)));

constexpr int DM = 1024, SEQ = 16384, NCTX = 256, TT = SEQ + NCTX, DEPTH = 4;
constexpr int IN_COLS = 2608, NPIN = 2816, LDP = 2816;
constexpr int C_MQ = 0, C_MK = 256, C_MV = 512, C_MO = 768, C_AQ = 1024, C_AK = 1536, C_AV = 1664, C_GQ = 1792, C_GK = 1920, C_GV = 2048, C_GG = 2304, C_MG = 2560, C_GGT = 2576, C_END = 2608;
constexpr int DFF = 2816, DEXP = 3584, NEXP = 8;
constexpr int NCH = 260;
constexpr int NSLOT = 138 * 256;
constexpr float ALPHA = 1.6817928305074290f;
constexpr float LN_EPS = 1e-5f;
constexpr float MGU_SCALE = 32.f, MDN_SCALE = 256.f, ACT_SCALE = 4.f;
constexpr int NPH = 2 + 10 * DEPTH;

constexpr size_t al256(size_t x) { return (x + 255) & ~size_t(255); }
constexpr size_t WS_CTL = 0, CTL_BYTES = 2u << 20;
constexpr size_t WS_MODS = 1u << 20;
constexpr size_t WS_ROPE = CTL_BYTES;
constexpr size_t WS_TOKE = WS_ROPE + 32768;
constexpr size_t WS_TOKP = WS_TOKE + al256((size_t)TT * 8);
constexpr size_t WS_TOKW = WS_TOKP + al256((size_t)TT * 8);
constexpr size_t WS_TOKS = WS_TOKW + al256((size_t)TT * 8);
constexpr size_t WS_WIN = WS_TOKS + al256((size_t)TT * 8);
constexpr size_t WS_WOUT = WS_WIN + (size_t)DEPTH * NPIN * DM * 2;
constexpr size_t WS_FGU = WS_WOUT + (size_t)DEPTH * DM * DM * 2;
constexpr size_t WS_FDN = WS_FGU + (size_t)2 * 2 * DFF * DM * 2;
constexpr size_t WS_MGU = WS_FDN + (size_t)2 * DM * DFF * 2;
constexpr size_t WS_MDN = WS_MGU + (size_t)16 * 2 * DEXP * DM * 2;
constexpr size_t WS_X = WS_MDN + (size_t)16 * DM * DEXP * 2;
constexpr size_t WS_H = WS_X + (size_t)TT * DM * 4;
constexpr size_t WS_P = WS_H + (size_t)TT * DM * 2;
constexpr size_t WS_G = WS_P + (size_t)TT * LDP * 2;
constexpr size_t WS_CAT = WS_G + al256((size_t)TT * 48 * 4);
constexpr size_t WS_Y = WS_CAT + (size_t)TT * DM * 2;
constexpr size_t WS_ACT = WS_Y + (size_t)TT * DM * 4;
constexpr size_t WS_XB = WS_ACT + (size_t)NSLOT * DEXP * 2;
constexpr size_t WS_YS = WS_XB + (size_t)NEXP * TT * DM * 2;
constexpr size_t WS_MU = WS_YS + (size_t)NSLOT * DM * 4;
constexpr size_t WS_MC = WS_MU + (size_t)8 * NCH * 4096 * 4;
constexpr size_t WS_MNU = WS_MC + (size_t)8 * NCH * 4096 * 4;
constexpr size_t WS_MNS = WS_MNU + (size_t)8 * NCH * 64 * 4;
constexpr size_t WS_MSC = WS_MNS + (size_t)8 * NCH * 64 * 4;
constexpr size_t WS_GU = WS_MSC + al256((size_t)8 * NCH * 4 * 4);
constexpr size_t WS_GS = WS_GU + (size_t)8 * NCH * 2048 * 4;
constexpr size_t WS_GDEC = WS_GS + (size_t)8 * NCH * 2048 * 4;
constexpr size_t WS_YP = WS_GDEC + (size_t)8 * NCH * 32 * 4;
constexpr size_t WS_END = WS_YP + (size_t)256 * 256 * 256 * 4;

constexpr int CW_BAR = 4096;
constexpr int CW_MOE = 16384;

constexpr int LDS_BYTES = 147456, MISC_OFF = 147200;

__device__ __forceinline__ float bf2f(unsigned v) { return __uint_as_float(v << 16); }
__device__ __forceinline__ unsigned f2bf(float f) { unsigned u = __float_as_uint(f); return (u + 0x7fffu + ((u >> 16) & 1u)) >> 16; }
__device__ __forceinline__ unsigned pk2(float lo, float hi) { return f2bf(lo) | (f2bf(hi) << 16); }
__device__ __forceinline__ void load8bf(const bf16_t* p, float* o) {
    const uint4 v = *(const uint4*)p;
    o[0] = __uint_as_float(v.x << 16); o[1] = __uint_as_float(v.x & 0xffff0000u); o[2] = __uint_as_float(v.y << 16); o[3] = __uint_as_float(v.y & 0xffff0000u);
    o[4] = __uint_as_float(v.z << 16); o[5] = __uint_as_float(v.z & 0xffff0000u); o[6] = __uint_as_float(v.w << 16); o[7] = __uint_as_float(v.w & 0xffff0000u);
}
__device__ __forceinline__ float wave_sum(float v) {
#pragma unroll
    for (int o = 1; o < 64; o <<= 1) v += __shfl_xor(v, o);
    return v;
}
__device__ __forceinline__ float wave_max(float v) {
#pragma unroll
    for (int o = 1; o < 64; o <<= 1) v = fmaxf(v, __shfl_xor(v, o));
    return v;
}
template <int CTRL, int RM> __device__ __forceinline__ float dpp_mov(float old, float v) {
    return __uint_as_float(__builtin_amdgcn_update_dpp(__float_as_uint(old), __float_as_uint(v), CTRL, RM, 0xF, false)); }
__device__ __forceinline__ float scan_add(float v, int) {
    v += dpp_mov<0x111, 0xF>(0.f, v); v += dpp_mov<0x112, 0xF>(0.f, v); v += dpp_mov<0x114, 0xF>(0.f, v); v += dpp_mov<0x118, 0xF>(0.f, v);
    v += dpp_mov<0x142, 0xA>(0.f, v); v += dpp_mov<0x143, 0xC>(0.f, v);
    return v;
}
__device__ __forceinline__ float scan_max(float v, int) {
    v = fmaxf(v, dpp_mov<0x111, 0xF>(-INFINITY, v)); v = fmaxf(v, dpp_mov<0x112, 0xF>(-INFINITY, v)); v = fmaxf(v, dpp_mov<0x114, 0xF>(-INFINITY, v)); v = fmaxf(v, dpp_mov<0x118, 0xF>(-INFINITY, v));
    v = fmaxf(v, dpp_mov<0x142, 0xA>(-INFINITY, v)); v = fmaxf(v, dpp_mov<0x143, 0xC>(-INFINITY, v));
    return v;
}
__device__ __forceinline__ float siluf(float x) { return x * __builtin_amdgcn_rcpf(1.f + __expf(-x)); }
__device__ __forceinline__ float sigmoidf_(float x) { return __builtin_amdgcn_rcpf(1.f + __expf(-x)); }
__device__ __forceinline__ float log_sigmoidf_(float x) {
    const float t = __expf(-fabsf(x)); const float l1p = (t < 0.01f) ? t * (1.f + t * (-0.5f + t * 0.33333333f)) : __logf(1.f + t); return fminf(x, 0.f) - l1p; }
typedef short s16x4 __attribute__((ext_vector_type(4)));
typedef short v4i16_t __attribute__((ext_vector_type(4)));
typedef float f32x2_t __attribute__((ext_vector_type(2))); typedef __bf16 bf16x2_t __attribute__((ext_vector_type(2)));
__device__ __forceinline__ unsigned cvtpk(float lo, float hi) { f32x2_t v = {lo, hi}; bf16x2_t b = __builtin_convertvector(v, bf16x2_t); return __builtin_bit_cast(unsigned, b); }
__device__ __forceinline__ s16x4 ds_tr16(const LAS unsigned char* p) { return __builtin_bit_cast(s16x4, __builtin_amdgcn_ds_read_tr16_b64_v4i16((LAS v4i16_t*)p)); }
__device__ __forceinline__ bf16x8 cat44(s16x4 a, s16x4 b) { return __builtin_shufflevector(a, b, 0, 1, 2, 3, 4, 5, 6, 7); }
#define MFMA16(a, b, c) __builtin_amdgcn_mfma_f32_16x16x32_bf16(a, b, c, 0, 0, 0)
__device__ __forceinline__ float grp_max(float v) {
    const auto a = __builtin_amdgcn_permlane16_swap(__float_as_uint(v), __float_as_uint(v), false, false); v = fmaxf(__uint_as_float(a[0]), __uint_as_float(a[1]));
    const auto b = __builtin_amdgcn_permlane32_swap(__float_as_uint(v), __float_as_uint(v), false, false); return fmaxf(__uint_as_float(b[0]), __uint_as_float(b[1])); }
__device__ __forceinline__ float grp_sum(float v) {
    const auto a = __builtin_amdgcn_permlane16_swap(__float_as_uint(v), __float_as_uint(v), false, false); v = __uint_as_float(a[0]) + __uint_as_float(a[1]);
    const auto b = __builtin_amdgcn_permlane32_swap(__float_as_uint(v), __float_as_uint(v), false, false); return __uint_as_float(b[0]) + __uint_as_float(b[1]); }
__device__ __forceinline__ unsigned pk4_fp8(float a, float b, float c, float d) { int w = 0; w = __builtin_amdgcn_cvt_pk_fp8_f32(a, b, w, false); w = __builtin_amdgcn_cvt_pk_fp8_f32(c, d, w, true); return (unsigned)w; }
#define LDS_WAIT() asm volatile("s_waitcnt lgkmcnt(0)" ::: "memory")

namespace pg8 {
constexpr int BM = 256, BK = 64, HALF = 128, HTB = HALF * BK * 2, STAGE_BYTES = 8 * HTB, NXCD = 8, WGM = 8;
__host__ __device__ __forceinline__ int lds_byte(int r, int c) { const int st = (r >> 4) * 2 + (c >> 5), rr = r & 15, cc = c & 31, ob = rr * 64 + cc * 2; return st * 1024 + (ob ^ (((ob >> 9) & 1) << 5)); }
__host__ __device__ __forceinline__ void stage_rc(int b, int& R, int& C) { const int st = b / 1024, sb = b % 1024, swz = sb ^ (((sb >> 9) & 1) << 5); R = (st >> 1) * 16 + swz / 64; C = (st & 1) * 32 + (swz % 64) / 2; }
__host__ __device__ __forceinline__ int perm32(int rho) { const int n = rho >> 4, i = rho & 15; return 8 * (i >> 2) + 4 * n + (i & 3); }
struct Unit { int pm, pn, kt0, nkt, part; };

struct StaticOrder {
    const char* A; const char* Bt; int K;
    int nM, nN, nwg, G, c;
    __device__ void init(const void* A_, const void* Bt_, int K_, int M, int N, int G_, int c_) { A = (const char*)A_; Bt = (const char*)Bt_; K = K_; nM = M / BM; nN = N / BM; nwg = nM * nN; G = G_; c = c_; }
    __device__ __forceinline__ bool next(int i, Unit& u) const {
        const long L = (long)i * G + c; if (L >= nwg) return false;
        int wgid = (int)L; { const int q = nwg / NXCD, r = nwg % NXCD, xcd = wgid % NXCD, off = wgid / NXCD; wgid = (xcd < r ? xcd * (q + 1) : r * (q + 1) + (xcd - r) * q) + off; }
        const int nig = WGM * nN, gid = wgid / nig, fm = gid * WGM, gsz = (nM - fm) < WGM ? (nM - fm) : WGM;
        u.pm = fm + ((wgid % nig) % gsz); u.pn = (wgid % nig) / gsz; u.kt0 = 0; u.nkt = K / BK; u.part = -1; return true;
    }
    __device__ __forceinline__ unsigned aoff(const Unit& u) const { return (unsigned)(u.pm * BM * K * 2); }
    __device__ __forceinline__ unsigned boff(const Unit& u) const { return (unsigned)(u.pn * BM * K * 2); }
};
struct MoeOrder {
    const char* A; const char* Bt; int K, N, nN, ntile, G, c;
    int ts1, ts2, ts3, ts4, ts5, ts6, ts7;
    __device__ __forceinline__ bool next(int i, Unit& u) const {
        const int nwg = ntile * nN; const long L = (long)i * G + c; if (L >= nwg) return false;
        int wgid = (int)L; { const int q = nwg / NXCD, r = nwg % NXCD, xcd = wgid % NXCD, off = wgid / NXCD; wgid = (xcd < r ? xcd * (q + 1) : r * (q + 1) + (xcd - r) * q) + off; }
        const int nig = WGM * nN, gid = wgid / nig, fm = gid * WGM, gsz = (ntile - fm) < WGM ? (ntile - fm) : WGM;
        u.pm = fm + ((wgid % nig) % gsz); u.pn = (wgid % nig) / gsz; u.kt0 = 0; u.nkt = K / BK; u.part = -1; return true;
    }
    __device__ __forceinline__ int expert(int pm) const { return (pm >= ts1) + (pm >= ts2) + (pm >= ts3) + (pm >= ts4) + (pm >= ts5) + (pm >= ts6) + (pm >= ts7); }
    __device__ __forceinline__ unsigned aoff(const Unit& u) const {
        const int e = expert(u.pm); const int t0 = e == 0 ? 0 : e == 1 ? ts1 : e == 2 ? ts2 : e == 3 ? ts3 : e == 4 ? ts4 : e == 5 ? ts5 : e == 6 ? ts6 : ts7;
        return (unsigned)((e * TT + (u.pm - t0) * BM) * K * 2); }
    __device__ __forceinline__ unsigned boff(const Unit& u) const { return (unsigned)((expert(u.pm) * N + u.pn * BM) * K * 2); }
};
struct TailOrder {
    const char* A; const char* Bt; int K, N, nN, npan, G, c, tp, s;
    int ts1, ts2, ts3, ts4, ts5, ts6, ts7;
    __device__ __forceinline__ void dense(const void* A_, const void* Bt_, int K_, int N_, int npan_, int G_, int c_, int tp_, int s_) {
        A = (const char*)A_; Bt = (const char*)Bt_; K = K_; N = N_; nN = N_ / BM; npan = npan_; G = G_; tp = tp_; s = s_;
        c = (G_ % NXCD) == 0 ? (c_ % NXCD) * (G_ / NXCD) + c_ / NXCD : c_;
        ts1 = ts2 = ts3 = ts4 = ts5 = ts6 = ts7 = 0x7fffffff; }
    __device__ __forceinline__ bool next(int i, Unit& u) const {
        const int L = i * G + c, nfull = (npan - tp) * nN, ksub = (K / BK) / s;
        const bool tail = L >= nfull; const int j = L - nfull, tu = tp * nN, tu1 = tu > 0 ? tu : 1;
        const int part = tail ? j / tu1 : -1, r = tail ? j % tu1 : 0;
        u.part = part; u.pm = tail ? (npan - tp) + r / nN : L / nN; u.pn = tail ? r % nN : L % nN; u.kt0 = tail ? part * ksub : 0; u.nkt = tail ? ksub : K / BK;
        return tail ? (j < tu * s) : true;
    }
    __device__ __forceinline__ int expert(int pm) const { return (pm >= ts1) + (pm >= ts2) + (pm >= ts3) + (pm >= ts4) + (pm >= ts5) + (pm >= ts6) + (pm >= ts7); }
    __device__ __forceinline__ unsigned aoff(const Unit& u) const { return (unsigned)((u.pm * BM * K + u.kt0 * BK) * 2); }
    __device__ __forceinline__ unsigned boff(const Unit& u) const { return (unsigned)((((expert(u.pm) * N + u.pn * BM) * K) + u.kt0 * BK) * 2); }
};
__device__ __forceinline__ void tail_params(int npan, int nN, int nkt, int G, int& tp, int& s) {
    const int rem = (npan * nN) % G;
    tp = 0; s = 1;
    if (rem == 0 || (rem % nN) != 0) return;
    int best = 1;
    if (nkt == 16) { if (rem * 4 <= G) best = 4; else if (rem * 2 <= G) best = 2; }
    else if (nkt == 44) { if (rem * 11 <= G) best = 11; else if (rem * 2 <= G) best = 2; }
    else if (nkt == 28) { if (rem * 7 <= G) best = 7; else if (rem * 2 <= G) best = 2; }
    else if (nkt == 56) { if (rem * 14 <= G) best = 14; else if (rem * 7 <= G) best = 7; else if (rem * 4 <= G) best = 4; else if (rem * 2 <= G) best = 2; }
    if (best > 1) { tp = rem / nN; s = best; }
}

typedef int v8i32 __attribute__((ext_vector_type(8)));
typedef int i32x4 __attribute__((ext_vector_type(4)));
template <class E, class = void> struct epi_nst { static constexpr int value = 0; };
template <class E> struct epi_nst<E, decltype((void)E::NST)> { static constexpr int value = E::NST; };
template <class Epi, class Sched, bool F8 = false>
__device__ __forceinline__ void gemm_phase(LAS unsigned char* lds, const int K, const Sched& S, const Epi& E, const int tid) {
    const int wid = __builtin_amdgcn_readfirstlane(tid >> 6), lane = tid & 63, wr = wid >> 2, wc = wid & 3, fr = lane & 15, fq = lane >> 4;
    unsigned voffA[2], voffB[2];
#pragma unroll
    for (int i = 0; i < 2; ++i) { int R, C; stage_rc(tid * 16 + i * 8192, R, C); const int Rb = Epi::PERM ? ((R & ~31) + perm32(R & 31)) : R;
        voffA[i] = (unsigned)(R * K + C) * 2u; voffB[i] = (unsigned)(Rb * K + C) * 2u; }
    const unsigned kstep = (unsigned)(BK * 2);
    const unsigned hstep = (unsigned)(HALF * K * 2);
    const __amdgpu_buffer_rsrc_t rA = __builtin_amdgcn_make_buffer_rsrc((void*)S.A, 0, 0x7ffffff0, 0x00020000), rB = __builtin_amdgcn_make_buffer_rsrc((void*)S.Bt, 0, 0x7ffffff0, 0x00020000);
    const unsigned ldsw = (unsigned)wid * 1024u;
    const int aoff = lds_byte(wr * 64 + fr, fq * 8), boff = lds_byte(wc * 32 + fr, fq * 8);
#define PG8_SA(b, h) (((b) * 2 + (h)) * HTB)
#define PG8_SB(b, h) ((4 + (b) * 2 + (h)) * HTB)
#define PG8_STAGE(bufoff, rs, soff, voff) do { _Pragma("unroll") for (int _i = 0; _i < 2; ++_i) \
        __builtin_amdgcn_raw_ptr_buffer_load_lds(rs, (LAS void*)(lds + (bufoff) + ldsw + _i * 8192), 16, (int)(voff)[_i], (int)(soff), 0, 0); } while (0)
#define PG8_LDA(dst, b, h) do { _Pragma("unroll") for (int m = 0; m < 4; ++m) { const i32x4 lo_ = *(const LAS i32x4*)(lds + PG8_SA(b, h) + aoff + m * 2048), hi_ = *(const LAS i32x4*)(lds + PG8_SA(b, h) + aoff + m * 2048 + 1024); \
        dst[m] = (v8i32){lo_[0], lo_[1], lo_[2], lo_[3], hi_[0], hi_[1], hi_[2], hi_[3]}; } } while (0)
#define PG8_LDB(dst, b, h) do { _Pragma("unroll") for (int n = 0; n < 2; ++n) { const i32x4 lo_ = *(const LAS i32x4*)(lds + PG8_SB(b, h) + boff + n * 2048), hi_ = *(const LAS i32x4*)(lds + PG8_SB(b, h) + boff + n * 2048 + 1024); \
        dst[n] = (v8i32){lo_[0], lo_[1], lo_[2], lo_[3], hi_[0], hi_[1], hi_[2], hi_[3]}; } } while (0)
#define PG8_LO(v) __builtin_bit_cast(bf16x8, __builtin_shufflevector(v, v, 0, 1, 2, 3))
#define PG8_HI(v) __builtin_bit_cast(bf16x8, __builtin_shufflevector(v, v, 4, 5, 6, 7))
#define PG8_MMA(ai, bj, At, Bt) do { __builtin_amdgcn_s_setprio(1); _Pragma("unroll") for (int m = 0; m < 4; ++m) _Pragma("unroll") for (int n = 0; n < 2; ++n) { \
        if constexpr (F8) acc[ai][bj][m][n] = __builtin_amdgcn_mfma_scale_f32_16x16x128_f8f6f4(Bt[n], At[m], acc[ai][bj][m][n], 0, 0, 0, 0x7f7f7f7f, 0, 0x7f7f7f7f); \
        else { acc[ai][bj][m][n] = __builtin_amdgcn_mfma_f32_16x16x32_bf16(PG8_LO(Bt[n]), PG8_LO(At[m]), acc[ai][bj][m][n], 0, 0, 0); \
               acc[ai][bj][m][n] = __builtin_amdgcn_mfma_f32_16x16x32_bf16(PG8_HI(Bt[n]), PG8_HI(At[m]), acc[ai][bj][m][n], 0, 0, 0); } } \
        __builtin_amdgcn_s_setprio(0); } while (0)
#define PG8_WAIT_V(n) asm volatile("s_waitcnt vmcnt(" #n ")" ::: "memory")
#define PG8_WAIT_L(n) asm volatile("s_waitcnt lgkmcnt(" #n ")" ::: "memory")
#define PG8_WAIT_VF(n, nf) do { if constexpr (epi_nst<Epi>::value == 8) asm volatile("s_cmp_lg_u32 %0, 0\n\ts_cbranch_scc1 .LPG8W_%=\n\ts_waitcnt vmcnt(" #n ")\n.LPG8W_%=:\n\ts_waitcnt vmcnt(" #nf ")" :: "s"(__builtin_amdgcn_readfirstlane(first)) : "memory", "scc"); else asm volatile("s_waitcnt vmcnt(" #n ")" ::: "memory"); } while (0)
#define PG8_BAR __builtin_amdgcn_s_barrier()
#define PG8_SCHED __builtin_amdgcn_sched_barrier(0)
    Unit cur, nxt; int ui = 0;
    if (!S.next(0, cur)) return;
    f32x4 acc[2][2][4][2];
#pragma unroll
    for (int a = 0; a < 2; ++a)
#pragma unroll
        for (int b = 0; b < 2; ++b)
#pragma unroll
            for (int m = 0; m < 4; ++m)
#pragma unroll
                for (int n = 0; n < 2; ++n) acc[a][b][m][n] = (f32x4){0.f, 0.f, 0.f, 0.f};
    v8i32 At[4], B0[2], B1[2];
    unsigned cA = S.aoff(cur), cB = S.boff(cur);
    PG8_STAGE(PG8_SB(0, 0), rB, cB, voffB); PG8_STAGE(PG8_SB(0, 1), rB, cB + hstep, voffB); PG8_STAGE(PG8_SA(0, 0), rA, cA, voffA); PG8_STAGE(PG8_SA(0, 1), rA, cA + hstep, voffA);
    if (wr == 1) PG8_BAR;
    PG8_WAIT_V(2); PG8_BAR;
    PG8_STAGE(PG8_SB(1, 0), rB, cB + kstep, voffB); PG8_STAGE(PG8_SA(1, 0), rA, cA + kstep, voffA); PG8_STAGE(PG8_SB(1, 1), rB, cB + hstep + kstep, voffB);
    PG8_WAIT_V(6); PG8_BAR;
    for (;;) {
        const bool has_next = S.next(ui + 1, nxt);
        const unsigned nA = has_next ? S.aoff(nxt) : cA, nB = has_next ? S.boff(nxt) : cB;
        const int nt = cur.nkt;
        for (int t = 0; t < nt; t += 2) {
            const bool last = (t == nt - 2);
            const int first = (epi_nst<Epi>::value == 8 && t == 0 && ui > 0) ? 1 : 0;
            const unsigned a1 = cA + (unsigned)(t + 1) * kstep;
            const unsigned a2 = last ? nA : cA + (unsigned)(t + 2) * kstep, b2 = last ? nB : cB + (unsigned)(t + 2) * kstep;
            const unsigned a3 = a2 + kstep, b3 = b2 + kstep;
            PG8_LDB(B0, 0, 0); PG8_LDB(B1, 0, 1); PG8_SCHED; PG8_LDA(At, 0, 0); PG8_STAGE(PG8_SA(1, 1), rA, a1 + hstep, voffA);
            PG8_WAIT_VF(8, 16); PG8_WAIT_L(0); PG8_BAR; PG8_MMA(0, 0, At, B0); PG8_MMA(0, 1, At, B1); PG8_BAR; PG8_SCHED;
            PG8_LDA(At, 0, 1); PG8_STAGE(PG8_SB(0, 0), rB, b2, voffB); PG8_STAGE(PG8_SB(0, 1), rB, b2 + hstep, voffB); PG8_STAGE(PG8_SA(0, 0), rA, a2, voffA);
            PG8_WAIT_VF(8, 16); PG8_WAIT_L(0); PG8_BAR; PG8_MMA(1, 0, At, B0); PG8_MMA(1, 1, At, B1); PG8_BAR; PG8_SCHED;
            PG8_LDB(B0, 1, 0); PG8_LDB(B1, 1, 1); PG8_SCHED; PG8_LDA(At, 1, 0); PG8_STAGE(PG8_SA(0, 1), rA, a2 + hstep, voffA);
            PG8_WAIT_V(8); PG8_WAIT_L(0); PG8_BAR; PG8_MMA(0, 0, At, B0); PG8_MMA(0, 1, At, B1); PG8_BAR; PG8_SCHED;
            PG8_LDA(At, 1, 1); PG8_STAGE(PG8_SB(1, 0), rB, b3, voffB); PG8_STAGE(PG8_SB(1, 1), rB, b3 + hstep, voffB); PG8_STAGE(PG8_SA(1, 0), rA, a3, voffA);
            PG8_WAIT_V(8); PG8_WAIT_L(0); PG8_BAR; PG8_MMA(1, 0, At, B0); PG8_MMA(1, 1, At, B1); PG8_BAR; PG8_SCHED;
        }
        if (wr == 0) PG8_BAR;
        { unsigned on_ = ~0u; asm volatile("" : "+s"(on_)); const int l2_ = (int)__builtin_amdgcn_mbcnt_hi(on_, __builtin_amdgcn_mbcnt_lo(on_, 0u));
          E(acc, cur, wr, wc, l2_ & 15, l2_ >> 4); }
        if (!has_next) break;
#pragma unroll
        for (int a = 0; a < 2; ++a)
#pragma unroll
            for (int b = 0; b < 2; ++b)
#pragma unroll
                for (int m = 0; m < 4; ++m)
#pragma unroll
                    for (int n = 0; n < 2; ++n) acc[a][b][m][n] = (f32x4){0.f, 0.f, 0.f, 0.f};
        cur = nxt; cA = nA; cB = nB; ++ui;
        if (wr == 1) PG8_BAR;
    }
    PG8_WAIT_V(0);
    PG8_BAR;
#undef PG8_SA
#undef PG8_SB
#undef PG8_STAGE
#undef PG8_LDA
#undef PG8_LDB
#undef PG8_MMA
#undef PG8_WAIT_V
#undef PG8_WAIT_L
#undef PG8_WAIT_VF
#undef PG8_BAR
#undef PG8_SCHED
}


struct EpiInProj {
    static constexpr bool PERM = true;
    bf16_t* P; float* Gt; const float* ropeC; const float* ropeS;
    __device__ __forceinline__ void operator()(const f32x4 (&acc)[2][2][4][2], const Unit& u, int wr, int wc, int fr, int fq) const {
        const int row0 = u.pm * BM + wr * 64 + fr;
        const bool latent = u.pm < (SEQ / BM);
#pragma unroll
        for (int bj = 0; bj < 2; ++bj) {
            const int colg = u.pn * BM + bj * HALF + wc * 32;
            const bool rope = latent && colg >= C_AQ && colg < C_AV;
            const bool gate = colg >= C_MG && colg < C_END;
            const int col0 = colg + 8 * fq;
#pragma unroll
            for (int ai = 0; ai < 2; ++ai)
#pragma unroll
                for (int m = 0; m < 4; ++m) {
                    const int row = row0 + ai * HALF + m * 16;
                    f32x4 v0 = acc[ai][bj][m][0], v1 = acc[ai][bj][m][1];
                    if (rope) {
                        const int pos = ((colg >> 5) & 1) ? (row & 63) : (row >> 6);
                        const f32x4 c0 = *(const f32x4*)(ropeC + pos * 16 + 8 * (fq & 1)), c1 = *(const f32x4*)(ropeC + pos * 16 + 8 * (fq & 1) + 4);
                        const f32x4 s0 = *(const f32x4*)(ropeS + pos * 16 + 8 * (fq & 1)), s1 = *(const f32x4*)(ropeS + pos * 16 + 8 * (fq & 1) + 4);
                        const float sg = (fq < 2) ? -1.f : 1.f;
                        f32x4 p0, p1;
#pragma unroll
                        for (int i = 0; i < 4; ++i) { p0[i] = __shfl_xor(v0[i], 32); p1[i] = __shfl_xor(v1[i], 32); }
#pragma unroll
                        for (int i = 0; i < 4; ++i) { v0[i] = v0[i] * c0[i] + sg * p0[i] * s0[i]; v1[i] = v1[i] * c1[i] + sg * p1[i] * s1[i]; }
                    }
                    u32x4 w; w.x = cvtpk(v0[0], v0[1]); w.y = cvtpk(v0[2], v0[3]); w.z = cvtpk(v1[0], v1[1]); w.w = cvtpk(v1[2], v1[3]);
                    *(u32x4*)(P + (size_t)row * LDP + col0) = w;
                    if (gate && col0 < C_END) { float* g = Gt + (size_t)row * 48 + (col0 - C_MG); *(f32x4*)g = v0; *(f32x4*)(g + 4) = v1; }
                    asm volatile("" ::: "memory");
                }
        }
    }
};
struct EpiResid {
    static constexpr bool PERM = true;
    bf16_t* Yb; const float* modl; const float* modc; float* YP; int tail_row0, tail_rows;
    __device__ __forceinline__ void operator()(const f32x4 (&acc)[2][2][4][2], const Unit& u, int wr, int wc, int fr, int fq) const {
        const int row0 = u.pm * BM + wr * 64 + fr, col0 = u.pn * BM + wc * 32 + 8 * fq;
        if (u.part >= 0) {
#pragma unroll
            for (int ai = 0; ai < 2; ++ai)
#pragma unroll
                for (int m = 0; m < 4; ++m) { float* rowp = YP + ((size_t)u.part * tail_rows + (row0 + ai * HALF + m * 16 - tail_row0)) * DM + col0;
#pragma unroll
                    for (int bj = 0; bj < 2; ++bj)
#pragma unroll
                        for (int n = 0; n < 2; ++n) *(f32x4*)(rowp + bj * HALF + n * 4) = acc[ai][bj][m][n]; }
            return;
        }
        const float* md = (u.pm < SEQ / BM) ? modl : modc;
        f32x4 mv[2][2];
#pragma unroll
        for (int bj = 0; bj < 2; ++bj)
#pragma unroll
            for (int n = 0; n < 2; ++n) mv[bj][n] = *(const f32x4*)(md + col0 + bj * HALF + n * 4);
#pragma unroll
        for (int ai = 0; ai < 2; ++ai)
#pragma unroll
            for (int m = 0; m < 4; ++m) { bf16_t* rowp = Yb + (size_t)(row0 + ai * HALF + m * 16) * DM + col0;
#pragma unroll
                for (int bj = 0; bj < 2; ++bj) { const f32x4 v0 = mv[bj][0] * acc[ai][bj][m][0], v1 = mv[bj][1] * acc[ai][bj][m][1];
                    u32x4 w; w.x = cvtpk(v0[0], v0[1]); w.y = cvtpk(v0[2], v0[3]); w.z = cvtpk(v1[0], v1[1]); w.w = cvtpk(v1[2], v1[3]);
                    *(u32x4*)(rowp + bj * HALF) = w; } }
    }
};
template <bool O8 = false> struct EpiSwigluT {
    static constexpr bool PERM = true;
    static constexpr int NST = 8;
    bf16_t* O; int ld; float sc; float osc;
    __device__ __forceinline__ void operator()(const f32x4 (&acc)[2][2][4][2], const Unit& u, int wr, int wc, int fr, int fq) const {
        const int row0 = u.pm * BM + wr * 64 + fr, col0 = u.pn * HALF + wc * 32 + 8 * fq;
        const float c1 = -sc * 1.44269504f, ic2 = 1.f / (sc * sc * osc);
#pragma unroll
        for (int ai = 0; ai < 2; ++ai)
#pragma unroll
            for (int m = 0; m < 4; ++m) {
                const f32x4 g0 = acc[ai][0][m][0], g1 = acc[ai][0][m][1], u0 = acc[ai][1][m][0], u1 = acc[ai][1][m][1];
                f32x4 e0 = g0 * c1, e1 = g1 * c1;
#pragma unroll
                for (int i = 0; i < 4; ++i) { e0[i] = __builtin_amdgcn_exp2f(e0[i]); e1[i] = __builtin_amdgcn_exp2f(e1[i]); }
                e0 = e0 * ic2 + ic2; e1 = e1 * ic2 + ic2;
#pragma unroll
                for (int i = 0; i < 4; ++i) { e0[i] = __builtin_amdgcn_rcpf(e0[i]); e1[i] = __builtin_amdgcn_rcpf(e1[i]); }
                const f32x4 r0 = (g0 * u0) * e0, r1 = (g1 * u1) * e1;
                if constexpr (O8) { uint2 w; w.x = pk4_fp8(r0[0], r0[1], r0[2], r0[3]); w.y = pk4_fp8(r1[0], r1[1], r1[2], r1[3]);
                    *(uint2*)((unsigned char*)O + (size_t)(row0 + ai * HALF + m * 16) * ld + col0) = w; }
                else { u32x4 w; w.x = cvtpk(r0[0], r0[1]); w.y = cvtpk(r0[2], r0[3]); w.z = cvtpk(r1[0], r1[1]); w.w = cvtpk(r1[2], r1[3]);
                    *(u32x4*)(O + (size_t)(row0 + ai * HALF + m * 16) * ld + col0) = w; }
            }
    }
};
typedef EpiSwigluT<false> EpiSwiglu;
struct EpiRaw {
    static constexpr bool PERM = true;
    bf16_t* C; float* YP; int tail_row0, tail_rows; float sc;
    __device__ __forceinline__ void operator()(const f32x4 (&acc)[2][2][4][2], const Unit& u, int wr, int wc, int fr, int fq) const {
        const int row0 = u.pm * BM + wr * 64 + fr, col0 = u.pn * BM + wc * 32 + 8 * fq;
        if (u.part >= 0) {
#pragma unroll
            for (int ai = 0; ai < 2; ++ai)
#pragma unroll
                for (int m = 0; m < 4; ++m) { bf16_t* rowp = (bf16_t*)YP + ((size_t)u.part * tail_rows + (row0 + ai * HALF + m * 16 - tail_row0)) * DM + col0;
#pragma unroll
                    for (int bj = 0; bj < 2; ++bj) { const f32x4 v0 = acc[ai][bj][m][0] * sc, v1 = acc[ai][bj][m][1] * sc;
                        u32x4 w; w.x = cvtpk(v0[0], v0[1]); w.y = cvtpk(v0[2], v0[3]); w.z = cvtpk(v1[0], v1[1]); w.w = cvtpk(v1[2], v1[3]);
                        *(u32x4*)(rowp + bj * HALF) = w; } }
            return;
        }
#pragma unroll
        for (int ai = 0; ai < 2; ++ai)
#pragma unroll
            for (int m = 0; m < 4; ++m) { bf16_t* rowp = C + (size_t)(row0 + ai * HALF + m * 16) * DM + col0;
#pragma unroll
                for (int bj = 0; bj < 2; ++bj) { const f32x4 v0 = acc[ai][bj][m][0] * sc, v1 = acc[ai][bj][m][1] * sc;
                    u32x4 w; w.x = cvtpk(v0[0], v0[1]); w.y = cvtpk(v0[2], v0[3]); w.z = cvtpk(v1[0], v1[1]); w.w = cvtpk(v1[2], v1[3]);
                    *(u32x4*)(rowp + bj * HALF) = w; } }
    }
};
}

#define XB_TMO      128
#define XB_XCNT(j)  (256  + 64 * (j))
#define XB_XSUB(j)  (1280 + 64 * (j))
#define XB_XGEN(j)  (2304 + 64 * (j))
#define XB_TOP      3328
#define XB_TOPGEN   3392
#define XCD_BAR_WORDS 3456
#define XB_SPIN_CAP (1u << 18)
__device__ __forceinline__ unsigned xb_ld(unsigned* p)              { return __hip_atomic_load(p, __ATOMIC_RELAXED, __HIP_MEMORY_SCOPE_AGENT); }
__device__ __forceinline__ unsigned xb_add(unsigned* p, unsigned v) { return __hip_atomic_fetch_add(p, v, __ATOMIC_RELAXED, __HIP_MEMORY_SCOPE_AGENT); }
__device__ __forceinline__ unsigned xb_xcc_id() { return (unsigned)__builtin_amdgcn_s_getreg((3 << 11) | 20) & 0xFu; }
#define XB_SPIN(cond, bar) do { unsigned _sp = 0; while (cond) { __builtin_amdgcn_s_sleep(1); \
    if ((++_sp & 255u) == 0u) { if (xb_ld(&(bar)[XB_TMO])) break; if (_sp > XB_SPIN_CAP) { atomicAdd(&(bar)[XB_TMO], 1u); break; } } } } while (0)
struct XcdBarrier { unsigned* bar; unsigned x; volatile LAS unsigned* st; };
__device__ __forceinline__ XcdBarrier xcd_barrier_post(unsigned* bar, volatile LAS unsigned* st) {
    XcdBarrier b; b.bar = bar; b.x = xb_xcc_id(); b.st = st;
    if (threadIdx.x == 0) (void)xb_add(&bar[XB_XCNT(b.x)], 1u);
    return b;
}
__device__ __forceinline__ void xcd_barrier_complete(unsigned* bar, unsigned x, unsigned& nloc, unsigned& nx) {
    const unsigned G = gridDim.x * gridDim.y * gridDim.z;
    unsigned sum, cnt, mine, sp = 0u;
    for (;;) {
        sum = 0u; cnt = 0u; mine = 0u;
#pragma unroll
        for (unsigned j = 0; j < 16; ++j) { const unsigned c = xb_ld(&bar[XB_XCNT(j)]); sum += c; cnt += (c > 0u) ? 1u : 0u; mine = (j == x) ? c : mine; }
        if (sum == G) break;
        __builtin_amdgcn_s_sleep(1);
        if ((++sp & 255u) == 0u) { if (xb_ld(&bar[XB_TMO])) break; if (sp > XB_SPIN_CAP) { atomicAdd(&bar[XB_TMO], 1u); break; } }
    }
    nloc = mine > 0u ? mine : 1u; nx = cnt > 0u ? cnt : 1u;
}
__device__ __forceinline__ void xcd_barrier(const XcdBarrier& b) {
    asm volatile("s_waitcnt vmcnt(0)" ::: "memory");
    __syncthreads();
    if (threadIdx.x == 0) {
        unsigned* bar = b.bar;
        __builtin_amdgcn_s_waitcnt(0);
        unsigned nloc = b.st[0], nx = b.st[1];
        if (nloc == 0u) { xcd_barrier_complete(bar, b.x, nloc, nx); b.st[0] = nloc; b.st[1] = nx; }
        const unsigned old = xb_add(&bar[XB_XSUB(b.x)], 1u);
        const unsigned gen = old / nloc;
        if (old + 1u == (gen + 1u) * nloc) {
            __builtin_amdgcn_fence(__ATOMIC_RELEASE, "agent");
            asm volatile("s_waitcnt vmcnt(0)" ::: "memory");
            const unsigned og = xb_add(&bar[XB_TOP], 1u);
            const unsigned tg = og / nx;
            if (og + 1u == (tg + 1u) * nx) xb_add(&bar[XB_TOPGEN], 1u);
            else XB_SPIN(xb_ld(&bar[XB_TOPGEN]) == tg, bar);
            __builtin_amdgcn_fence(__ATOMIC_ACQUIRE, "agent");
            xb_add(&bar[XB_XGEN(b.x)], 1u);
            asm volatile("s_waitcnt vmcnt(0)" ::: "memory");
        } else {
            XB_SPIN(xb_ld(&bar[XB_XGEN(b.x)]) == gen, bar);
            __builtin_amdgcn_fence(__ATOMIC_ACQUIRE, "agent");
            asm volatile("s_waitcnt vmcnt(0)" ::: "memory");
        }
    }
    __syncthreads();
}

struct Args { const float* in[22]; float* out; unsigned char* ws; int ph_lo, ph_hi; };

__device__ __forceinline__ int in_srccol(int r, float& sc) {
    sc = 1.f;
    if (r < 1024) { if (r >= C_MK && r < C_MV) sc = 0.125f; return r; }
    if (r < C_MG) { if (r < C_AK) sc = 0.125f * 1.4426950408889634f; else if (r >= C_GQ && r < C_GK) sc = 0.17677669529663687f; return r + 16; }
    if (r < C_GGT) return r - C_MG + 1024;
    if (r < C_END) return r;
    return -1;
}
template <bool F8 = false>
__device__ __forceinline__ void tr_item(const float* W, int K, int N, int NP, bf16_t* WT, int mode, int half, LAS float* scr, int item, int lane, float f8scale = 1.f) {
    const int nblk = NP >> 6, kb = item / nblk, nb = item - kb * nblk, k0 = kb << 6, n0 = nb << 6;
    const int r = n0 + lane; float sc = 1.f; int src;
    if (mode == 0) src = r; else if (mode == 1) src = in_srccol(r, sc); else { const int pn = r >> 8, w = r & 255; src = (w < 128) ? (pn * 128 + w) : (half + pn * 128 + w - 128); }
    if (F8) sc = f8scale;
    const float* wp = W + (size_t)k0 * N + (src < 0 ? 0 : src);
#pragma unroll 64
    for (int i = 0; i < 64; ++i) { const float v = __builtin_nontemporal_load(wp + (size_t)i * N); scr[i * 65 + lane] = (src < 0) ? 0.f : v * sc; }
    LDS_WAIT();
    const int c = lane & 7;
#pragma unroll
    for (int j = 0; j < 8; ++j) { const int n = (lane >> 3) + 8 * j; const LAS float* s = scr + (8 * c) * 65 + n;
        if constexpr (F8) { uint2 o; o.x = pk4_fp8(s[0], s[65], s[130], s[195]); o.y = pk4_fp8(s[260], s[325], s[390], s[455]); *(uint2*)((unsigned char*)WT + (size_t)(n0 + n) * K + k0 + 8 * c) = o; }
        else { uint4 o; o.x = pk2(s[0], s[65]); o.y = pk2(s[130], s[195]); o.z = pk2(s[260], s[325]); o.w = pk2(s[390], s[455]);
        *(uint4*)(WT + (size_t)(n0 + n) * K + k0 + 8 * c) = o; } }
    LDS_WAIT();
}

__device__ __forceinline__ void tr_item_f8_wg(LAS unsigned char* lds, const float* __restrict__ W, int K, int N, int NP, unsigned char* __restrict__ WT, int mode, int half, int item, int tid, int lane, int wave, float sc) {
    constexpr int RS = 136;
    const int nblk = NP >> 8, kb = item / nblk, nb = item - kb * nblk, k0 = kb << 7, nb0 = nb << 8, n0 = nb0 + 4 * lane;
    int src = n0;
    if (mode == 2) { const int pn = n0 >> 8, w = n0 & 255; src = (w < 128) ? (pn * 128 + w) : (half + pn * 128 + w - 128); }
    f32x4 v[2][8];
#pragma unroll
    for (int q = 0; q < 2; ++q)
#pragma unroll
        for (int i = 0; i < 8; ++i) v[q][i] = __builtin_nontemporal_load((const f32x4*)(W + (size_t)(k0 + (wave * 2 + q) * 8 + i) * N + src));
    __syncthreads();
#pragma unroll
    for (int q = 0; q < 2; ++q)
#pragma unroll
        for (int e = 0; e < 4; ++e) { u32x2_t o; o.x = pk4_fp8(v[q][0][e] * sc, v[q][1][e] * sc, v[q][2][e] * sc, v[q][3][e] * sc); o.y = pk4_fp8(v[q][4][e] * sc, v[q][5][e] * sc, v[q][6][e] * sc, v[q][7][e] * sc);
            *(LAS u32x2_t*)(lds + (4 * lane + e) * RS + (wave * 2 + q) * 8) = o; }
    __syncthreads();
#pragma unroll
    for (int j = 0; j < 4; ++j) { const int idx = tid + 512 * j, r = idx >> 3, ch = idx & 7;
        *(u32x4*)(WT + (size_t)(nb0 + r) * K + k0 + ch * 16) = *(const LAS u32x4*)(lds + r * RS + ch * 16); }
}

__device__ __forceinline__ void chunk_rows(int d, int jc, int& base, int& step) {
    int oc;
    if (d == 0) oc = (jc < 4) ? 256 + jc : jc - 4; else oc = (jc < 4) ? 256 + (3 - jc) : 255 - (jc - 4);
    const int b0 = (oc < 256) ? oc * 64 : SEQ + (oc - 256) * 64;
    if (d == 0) { base = b0; step = 1; } else { base = b0 + 63; step = -1; }
}
__device__ __forceinline__ int oc_to_jc(int d, int oc) { if (d == 0) return oc < 256 ? oc + 4 : oc - 256; return oc < 256 ? 4 + (255 - oc) : 3 - (oc - 256); }

namespace at32 {
typedef float f32x16 __attribute__((ext_vector_type(16)));
constexpr int NW = 8, KVBLK = 64, NSLOT = 3, SLOTB = 8192, PQ = LDP;
constexpr int LDS_K = 0, LDS_V = NSLOT * SLOTB, LDS_WS = 2 * NSLOT * SLOTB, LDS_OST = LDS_WS + NW * 64 * 4, LDS_BYTES = LDS_OST + NW * 4096;
#define A3_SBAR() __builtin_amdgcn_sched_barrier(0)
#define A3_WAIT_BAR(N) asm volatile("s_waitcnt vmcnt(" #N ") lgkmcnt(0)\n\ts_barrier" ::: "memory")
__device__ __forceinline__ int crow(int r, int hi) { return (r & 3) + 8 * (r >> 2) + 4 * hi; }
__device__ __forceinline__ void glds16(const void* gsrc, unsigned lds_dst) { unsigned keep;
    asm volatile("s_mov_b32 %0, m0\n\ts_mov_b32 m0, %2\n\ts_nop 0\n\tglobal_load_lds_dwordx4 %1, off\n\ts_mov_b32 m0, %0" : "=&s"(keep) : "v"(gsrc), "s"(lds_dst) : "memory"); }
__device__ __forceinline__ float max3f(float a, float b, float c) { float r; asm("v_max3_f32 %0, %1, %2, %3" : "=v"(r) : "v"(a), "v"(b), "v"(c)); return r; }
__device__ __forceinline__ float max2f(float a, float b) { float r; asm("v_max_f32_e32 %0, %1, %2" : "=v"(r) : "v"(a), "v"(b)); return r; }
__device__ __forceinline__ float fadd_s(float a, float b) { float r; asm("v_add_f32_e32 %0, %1, %2" : "=v"(r) : "v"(a), "v"(b)); return r; }
__device__ __forceinline__ float fsub_s(float a, float b) { float r; asm("v_sub_f32_e32 %0, %1, %2" : "=v"(r) : "v"(a), "v"(b)); return r; }
typedef const LAS unsigned char* lds_cptr;
__device__ __forceinline__ void wmask(f32x16& p0, f32x16& p1, int s, int b, int qrel, int hi) {
    const float NEG = -INFINITY; const int e = s * (4 * hi - qrel) + b;
#pragma unroll
    for (int r = 0; r < 16; ++r) { const int c = (r & 3) + 8 * (r >> 2); if (e + s * c > 0) p0[r] = NEG; if (e + s * (c + 32) > 0) p1[r] = NEG; }
}
__device__ __forceinline__ void qkt(f32x16& p0, f32x16& p1, lds_cptr Kslot, const bf16x8* qr, const f32x16& negm, int r32, int hi) {
    lds_cptr kb = Kslot + hi * 1024 + r32 * 16;
#pragma unroll
    for (int d0 = 0; d0 < 4; ++d0) {
        const bf16x8 b0 = *(const LAS bf16x8*)(kb + d0 * 2048), b1 = *(const LAS bf16x8*)(kb + d0 * 2048 + 512);
        if (d0 == 0) { p0 = __builtin_amdgcn_mfma_f32_32x32x16_bf16(b0, qr[0], negm, 0, 0, 0); p1 = __builtin_amdgcn_mfma_f32_32x32x16_bf16(b1, qr[0], negm, 0, 0, 0); }
        else { p0 = __builtin_amdgcn_mfma_f32_32x32x16_bf16(b0, qr[d0], p0, 0, 0, 0); p1 = __builtin_amdgcn_mfma_f32_32x32x16_bf16(b1, qr[d0], p1, 0, 0, 0); } }
}
__device__ __forceinline__ void kload8(bf16x8* kf, lds_cptr kp) {
    kf[0] = *(const LAS bf16x8*)(kp);        kf[1] = *(const LAS bf16x8*)(kp + 512);  kf[2] = *(const LAS bf16x8*)(kp + 2048); kf[3] = *(const LAS bf16x8*)(kp + 2560);
    kf[4] = *(const LAS bf16x8*)(kp + 4096); kf[5] = *(const LAS bf16x8*)(kp + 4608); kf[6] = *(const LAS bf16x8*)(kp + 6144); kf[7] = *(const LAS bf16x8*)(kp + 6656);
}
__device__ __forceinline__ void kload2(bf16x8* kf, lds_cptr kp, int j) { kf[2 * j] = *(const LAS bf16x8*)(kp + j * 2048); kf[2 * j + 1] = *(const LAS bf16x8*)(kp + j * 2048 + 512); }
__device__ __forceinline__ s16x4 vtr(lds_cptr p) { return __builtin_bit_cast(s16x4, __builtin_amdgcn_ds_read_tr16_b64_v4i16((LAS v4i16_t*)p)); }
__device__ __forceinline__ float rowmax(const f32x16& p0, const f32x16& p1) {
    float a = max3f(p0[0], p0[1], p1[0]), b = max3f(p0[2], p0[3], p1[1]); a = max3f(a, p1[2], p1[3]);
#pragma unroll
    for (int r = 4; r < 16; r += 4) { a = max3f(a, p0[r], p0[r + 1]); b = max3f(b, p0[r + 2], p0[r + 3]); a = max3f(a, p1[r], p1[r + 1]); b = max3f(b, p1[r + 2], p1[r + 3]); }
    const float m = max2f(a, b);
    auto rr = __builtin_amdgcn_permlane32_swap(__float_as_uint(m), __float_as_uint(m), false, false);
    return max2f(__uint_as_float(rr[0]), __uint_as_float(rr[1]));
}
__device__ __forceinline__ void pv(f32x16* o, int vb, bf16x8 pa0, bf16x8 pa1, bf16x8 pa2, bf16x8 pa3) {
#pragma unroll
    for (int d0 = 0; d0 < 2; ++d0) { s16x4 lo[4], hi[4];
#pragma unroll
        for (int ks = 0; ks < 4; ++ks) {
            asm volatile("ds_read_b64_tr_b16 %0,%1 offset:%c2" : "=&v"(lo[ks]) : "v"(vb), "i"(d0 * 4096 + ks * 1024) : "memory");
            asm volatile("ds_read_b64_tr_b16 %0,%1 offset:%c2" : "=&v"(hi[ks]) : "v"(vb), "i"(d0 * 4096 + ks * 1024 + 512) : "memory"); }
        asm volatile("s_waitcnt lgkmcnt(0)" ::: "memory"); A3_SBAR();
#define A3_PK(k) (bf16x8){lo[k][0], lo[k][1], lo[k][2], lo[k][3], hi[k][0], hi[k][1], hi[k][2], hi[k][3]}
        o[d0] = __builtin_amdgcn_mfma_f32_32x32x16_bf16(pa0, A3_PK(0), o[d0], 0, 0, 0);
        o[d0] = __builtin_amdgcn_mfma_f32_32x32x16_bf16(pa1, A3_PK(1), o[d0], 0, 0, 0);
        o[d0] = __builtin_amdgcn_mfma_f32_32x32x16_bf16(pa2, A3_PK(2), o[d0], 0, 0, 0);
        o[d0] = __builtin_amdgcn_mfma_f32_32x32x16_bf16(pa3, A3_PK(3), o[d0], 0, 0, 0);
#undef A3_PK
    }
}
template <int THRL> __device__ __forceinline__ void attn_unit(LAS unsigned char* shm, const bf16_t* __restrict__ P, bf16_t* CAT, bool ctx, int qb, int kvh, const float* sink, int lane, int wave) {
    const int r32 = lane & 31, hi = lane >> 5; const int wid = __builtin_amdgcn_readfirstlane(wave);
    const int hq = kvh * 4 + (wid >> 1), q0 = qb * 64, qrow0 = (ctx ? SEQ : 0) + q0 + (wid & 1) * 32;
    const bf16_t* Qw = P + (size_t)qrow0 * PQ + C_AQ + hq * 64;
    const bf16_t* Kh = P + C_AK + kvh * 64; const bf16_t* Vh = P + C_AV + kvh * 64;
    const unsigned lds0 = (unsigned)(uintptr_t)shm;
    LAS float* wsf = (LAS float*)(shm + LDS_WS) + wid * 64;
    const int kb0 = ctx ? 0 : (qb - 2 < 0 ? 0 : qb - 2), kb1 = ctx ? -1 : (qb + 2 > SEQ / 64 - 1 ? SEQ / 64 - 1 : qb + 2), nl = kb1 - kb0 + 1, NT = nl + 4;
#define A3_TROW(t) (((t) < nl) ? (kb0 + (t)) * 64 : SEQ + ((t) - nl) * 64)
#define A3_MT(t) (((t) < nl) ? ((kb0 + (t) == qb - 2) ? 1 : ((kb0 + (t) == qb + 2) ? 2 : 0)) : 0)
    const bf16_t* ksrc = Kh + (size_t)lane * PQ + wid * 8;
    const bf16_t* vsrc = Vh + (size_t)(16 * (wid & 3) + (lane >> 2)) * PQ + (wid >> 2) * 32 + (lane & 3) * 8;
    const unsigned kdst = lds0 + LDS_K + wid * 1024, vdst = lds0 + LDS_V + wid * 1024;
#define A3_DMA_K(t, slot) glds16(ksrc + (size_t)A3_TROW(t) * PQ, (unsigned)__builtin_amdgcn_readfirstlane(kdst + (slot)))
#define A3_DMA_V(t, slot) glds16(vsrc + (size_t)A3_TROW(t) * PQ, (unsigned)__builtin_amdgcn_readfirstlane(vdst + (slot)))
    const int vb0 = (int)(lds0 + LDS_V) + ((lane >> 4) & 1) * 32 + (lane & 3) * 8 + (4 * hi + ((lane & 15) >> 2)) * 64;
    const lds_cptr Kbase = shm + LDS_K; bf16x8 kf[8];
    const lds_cptr kp0 = shm + LDS_K + hi * 1024 + r32 * 16; const lds_cptr vp0 = shm + LDS_V + ((lane >> 4) & 1) * 32 + (lane & 3) * 8 + (4 * hi + ((lane & 15) >> 2)) * 64;
    A3_DMA_K(0, 0); A3_DMA_V(0, 0); A3_DMA_K(1, SLOTB);
    bf16x8 qr[4];
#pragma unroll
    for (int d0 = 0; d0 < 4; ++d0) qr[d0] = *(const bf16x8*)(Qw + (size_t)r32 * PQ + d0 * 16 + hi * 8);
    float zf = 0.f; asm volatile("" : "+v"(zf));
    float mhat = 0.f, l_reg = 0.f; f32x16 o[2]; f32x16 negm;
#pragma unroll
    for (int r = 0; r < 16; ++r) { o[0][r] = zf; o[1][r] = zf; negm[r] = zf; }
    asm volatile("" : "+v"(negm));
    const int qrel = (wid & 1) * 32 + r32;
#define A3_CMASK(P0, P1, t) do { const int mt_ = A3_MT(t); if (mt_) wmask(P0, P1, (mt_ == 1) ? -1 : (mt_ == 2 ? 1 : 0), (mt_ == 3) ? 1 : 0, qrel, hi); } while (0)
    bool resc = false;
#define A3_START(P0, P1) do { const float rm = rowmax(P0, P1); resc = false; \
    { const float dl = rm; mhat = fadd_s(mhat, dl); \
      _Pragma("unroll") for (int r = 0; r < 16; ++r) { P0[r] = fsub_s(P0[r], dl); P1[r] = fsub_s(P1[r], dl); } \
      _Pragma("unroll") for (int r = 0; r < 16; ++r) negm[r] = -mhat; asm volatile("" : "+v"(negm)); } \
    _Pragma("unroll") for (int r = 0; r < 16; ++r) P0[r] = __builtin_amdgcn_exp2f(P0[r]); } while (0)
#define A3_RESC() do { if (resc) { asm volatile("s_waitcnt lgkmcnt(0)" ::: "memory"); \
      _Pragma("unroll") for (int d_ = 0; d_ < 2; ++d_) _Pragma("unroll") for (int r = 0; r < 16; ++r) o[d_][r] *= wsf[crow(r, hi)]; } } while (0)
    f32x16 pA0, pA1, pB0, pB1;
    int sl_prev = 0, sl_cur = 0, sl_next = SLOTB;
#define A3_ROT() do { sl_prev = sl_cur; sl_cur = sl_next; sl_next = (sl_next == (NSLOT - 1) * SLOTB) ? 0 : sl_next + SLOTB; } while (0)
    A3_DMA_K(2, 2 * SLOTB);
    A3_WAIT_BAR(3);
    qkt(pA0, pA1, Kbase, qr, negm, r32, hi); asm volatile("s_nop 15\n\ts_nop 7" : "+v"(pA0), "+v"(pA1)); A3_CMASK(pA0, pA1, 0);
    A3_START(pA0, pA1);
#pragma unroll
    for (int r = 0; r < 16; ++r) pA1[r] = __builtin_amdgcn_exp2f(pA1[r]);
    A3_WAIT_BAR(0);
    A3_DMA_K(3, 0); A3_DMA_V(1, SLOTB);
    A3_ROT();
    kload8(kf, kp0 + sl_cur);
    A3_WAIT_BAR(2);
    s16x4 vlo[8], vhi[8]; u32x4 pw0, pw1, pw2, pw3;
#define A3_PKW(P, B) cvtpk(P[B], P[B + 1])
#define A3_PAF(k) __builtin_bit_cast(bf16x8, pw##k)
#define A3_VFR(i) (bf16x8){vlo[i][0], vlo[i][1], vlo[i][2], vlo[i][3], vhi[i][0], vhi[i][1], vhi[i][2], vhi[i][3]}
#define A3_PIN(x) asm volatile("" : "+v"(x))
#define A3_MX3(a, b, c) __builtin_fmaxf(__builtin_fmaxf((a), (b)), (c))
#define A3_GAPA(MF, A0, A1, A2, A3, W0, W1, PW) do { MF; sacc += A0; sacc += A1; sacc += A2; sacc += A3; A3_PIN(sacc); W0; W1; A3_PIN(PW); A3_SBAR(); } while (0)
#define A3_EX(v) __builtin_amdgcn_exp2f(v)
#define A3_GAPB(MF, X, B) do { MF; X[B] = A3_EX(X[B]); X[B + 1] = A3_EX(X[B + 1]); X[B + 2] = A3_EX(X[B + 2]); X[B + 3] = A3_EX(X[B + 3]); A3_PIN(X); A3_SBAR(); } while (0)
#define A3_VRD(i) do { vlo[i] = vtr(vp_ + (((i) >> 2) * 4096 + ((i) & 3) * 1024)); vhi[i] = vtr(vp_ + (((i) >> 2) * 4096 + ((i) & 3) * 1024 + 512)); } while (0)
#define A3_KRD(G, j) do { if (G) { kload2(kf, kp0 + sl_next, j); A3_SBAR(); } } while (0)
#define A3_MF(D, A, B, C) D = __builtin_amdgcn_mfma_f32_32x32x16_bf16(A, B, C, 0, 0, 0)
#define A3_STEP(C0, C1, P0, P1, t, GK, GV, GL) do { A3_SBAR(); \
    const lds_cptr vp_ = vp0 + sl_prev; \
    A3_VRD(0); A3_SBAR(); float sacc = (P0[0] + P0[1]); \
    A3_GAPA(A3_MF(C0, kf[0], qr[0], negm), P0[2], P0[3], P0[4], P0[5],     pw0[0] = A3_PKW(P0, 0), pw0[1] = A3_PKW(P0, 2), pw0); \
    A3_VRD(4); A3_SBAR(); A3_GAPA(A3_MF(C1, kf[1], qr[0], negm), P0[6], P0[7], P0[8], P0[9],     pw0[2] = A3_PKW(P0, 4), pw0[3] = A3_PKW(P0, 6), pw0); \
    A3_VRD(1); A3_SBAR(); A3_GAPA(A3_MF(C0, kf[2], qr[1], C0),   P0[10], P0[11], P0[12], P0[13], pw1[0] = A3_PKW(P0, 8), pw1[1] = A3_PKW(P0, 10), pw1); \
    A3_VRD(5); A3_SBAR(); A3_GAPA(A3_MF(C1, kf[3], qr[1], C1),   P0[14], P0[15], P1[0], P1[1],   pw1[2] = A3_PKW(P0, 12), pw1[3] = A3_PKW(P0, 14), pw1); \
    A3_VRD(2); A3_SBAR(); A3_GAPA(A3_MF(C0, kf[4], qr[2], C0),   P1[2], P1[3], P1[4], P1[5],     pw2[0] = A3_PKW(P1, 0), pw2[1] = A3_PKW(P1, 2), pw2); \
    A3_VRD(6); A3_SBAR(); A3_GAPA(A3_MF(C1, kf[5], qr[2], C1),   P1[6], P1[7], P1[8], P1[9],     pw2[2] = A3_PKW(P1, 4), pw2[3] = A3_PKW(P1, 6), pw2); \
    A3_VRD(3); A3_SBAR(); A3_GAPA(A3_MF(C0, kf[6], qr[3], C0),   P1[10], P1[11], P1[12], P1[13], pw3[0] = A3_PKW(P1, 8), pw3[1] = A3_PKW(P1, 10), pw3); \
    A3_VRD(7); A3_SBAR(); A3_GAPA(A3_MF(C1, kf[7], qr[3], C1),   P1[14], P1[15], 0.f, 0.f,       pw3[2] = A3_PKW(P1, 12), pw3[3] = A3_PKW(P1, 14), pw3); \
    l_reg += sacc; \
    if (GK) { A3_DMA_K((t) + 3, sl_cur); } if (GV) { A3_DMA_V((t) + 1, sl_next); } \
    A3_CMASK(C0, C1, t); \
    { float a = A3_MX3(C0[0], C0[1], C1[0]), b = A3_MX3(C0[2], C0[3], C1[1]); a = A3_MX3(a, C1[2], C1[3]); \
      _Pragma("unroll") for (int r = 4; r < 16; r += 4) { a = A3_MX3(a, C0[r], C0[r + 1]); b = A3_MX3(b, C0[r + 2], C0[r + 3]); a = A3_MX3(a, C1[r], C1[r + 1]); b = A3_MX3(b, C1[r + 2], C1[r + 3]); } \
      float rm = __builtin_fmaxf(a, b); { auto rr = __builtin_amdgcn_permlane32_swap(__float_as_uint(rm), __float_as_uint(rm), false, false); rm = __builtin_fmaxf(__uint_as_float(rr[0]), __uint_as_float(rr[1])); } \
      resc = false; \
      if (__builtin_expect(__any(rm > (float)THRL), 0)) { const float dl = __builtin_fmaxf(rm, 0.f); mhat += dl; \
        _Pragma("unroll") for (int r = 0; r < 16; ++r) { C0[r] -= dl; C1[r] -= dl; } \
        _Pragma("unroll") for (int r = 0; r < 16; ++r) negm[r] = -mhat; asm volatile("" : "+v"(negm)); \
        const float f = __builtin_amdgcn_exp2f(-dl); l_reg *= f; if (hi == 0) wsf[r32] = f; resc = true; } } \
    A3_SBAR(); \
    A3_GAPB(A3_MF(o[0], A3_PAF(0), A3_VFR(0), o[0]), C0, 0); \
    A3_GAPB(A3_MF(o[1], A3_PAF(0), A3_VFR(4), o[1]), C0, 4); \
    A3_KRD(GL, 0); A3_GAPB(A3_MF(o[0], A3_PAF(1), A3_VFR(1), o[0]), C0, 8); \
    A3_KRD(GL, 1); A3_GAPB(A3_MF(o[1], A3_PAF(1), A3_VFR(5), o[1]), C0, 12); \
    A3_KRD(GL, 2); A3_GAPB(A3_MF(o[0], A3_PAF(2), A3_VFR(2), o[0]), C1, 0); \
    A3_KRD(GL, 3); A3_GAPB(A3_MF(o[1], A3_PAF(2), A3_VFR(6), o[1]), C1, 4); \
    A3_GAPB(A3_MF(o[0], A3_PAF(3), A3_VFR(3), o[0]), C1, 8); \
    A3_GAPB(A3_MF(o[1], A3_PAF(3), A3_VFR(7), o[1]), C1, 12); \
    } while (0)
#define A3_ENDW(tt) do { if ((tt) + 3 < NT) { A3_WAIT_BAR(2); } else if ((tt) + 2 < NT) { A3_WAIT_BAR(1); } else { A3_WAIT_BAR(0); } } while (0)
#define A3_DRAIN(B0, B1) do { float sacc = B0[0] + B0[1]; _Pragma("unroll") for (int r = 2; r < 16; ++r) sacc += B0[r]; _Pragma("unroll") for (int r = 0; r < 16; ++r) sacc += B1[r]; l_reg += sacc; \
    pw0 = (u32x4){A3_PKW(B0, 0), A3_PKW(B0, 2), A3_PKW(B0, 4), A3_PKW(B0, 6)}; pw1 = (u32x4){A3_PKW(B0, 8), A3_PKW(B0, 10), A3_PKW(B0, 12), A3_PKW(B0, 14)}; \
    pw2 = (u32x4){A3_PKW(B1, 0), A3_PKW(B1, 2), A3_PKW(B1, 4), A3_PKW(B1, 6)}; pw3 = (u32x4){A3_PKW(B1, 8), A3_PKW(B1, 10), A3_PKW(B1, 12), A3_PKW(B1, 14)}; \
    A3_SBAR(); pv(o, vb0 + sl_cur, A3_PAF(0), A3_PAF(1), A3_PAF(2), A3_PAF(3)); } while (0)
    int t = 1;
    if (NT & 1) {
        A3_STEP(pB0, pB1, pA0, pA1, 1, (4 < NT), (2 < NT), (2 < NT)); A3_ENDW(1); A3_RESC(); A3_ROT();
        pA0 = pB0; pA1 = pB1; t = 2;
    }
    for (; t + 2 < NT; t += 2) {
        A3_STEP(pB0, pB1, pA0, pA1, t, (t + 3 < NT), (t + 1 < NT), (t + 1 < NT));         A3_ENDW(t);     A3_RESC(); A3_ROT();
        A3_STEP(pA0, pA1, pB0, pB1, t + 1, (t + 4 < NT), (t + 2 < NT), (t + 2 < NT));     A3_ENDW(t + 1); A3_RESC(); A3_ROT();
    }
    A3_STEP(pB0, pB1, pA0, pA1, t, false, false, false); A3_RESC();
    A3_DRAIN(pB0, pB1);
    { auto rr = __builtin_amdgcn_permlane32_swap(__float_as_uint(l_reg), __float_as_uint(l_reg), false, false); l_reg = __uint_as_float(rr[0]) + __uint_as_float(rr[1]); }
    l_reg += __builtin_amdgcn_exp2f(sink[hq] * 1.4426950408889634f - mhat);
    if (hi == 0) wsf[32 + r32] = l_reg; asm volatile("s_waitcnt lgkmcnt(0)" ::: "memory");
    float rli[16];
#pragma unroll
    for (int r = 0; r < 16; ++r) rli[r] = __builtin_amdgcn_rcpf(wsf[32 + crow(r, hi)]);
    bf16_t* Ow = CAT + (size_t)qrow0 * DM + 256 + hq * 64;
    { LAS bf16_t* stg = (LAS bf16_t*)(shm + LDS_OST) + wid * 2048;
#pragma unroll
      for (int r = 0; r < 16; ++r) { const int orow = crow(r, hi);
#pragma unroll
          for (int d0 = 0; d0 < 2; ++d0) stg[orow * 64 + d0 * 32 + r32] = (bf16_t)f2bf(o[d0][r] * rli[r]); }
      asm volatile("s_waitcnt lgkmcnt(0)" ::: "memory");
#pragma unroll
      for (int i = 0; i < 4; ++i) { const int row = i * 8 + (lane >> 3), ch = lane & 7; const u32x4 v = *(const LAS u32x4*)(stg + row * 64 + ch * 8); *(u32x4*)(Ow + (size_t)row * DM + ch * 8) = v; } }
    asm volatile("s_waitcnt lgkmcnt(0)\n\ts_barrier" ::: "memory");
#undef A3_TROW
#undef A3_MT
#undef A3_DMA_K
#undef A3_DMA_V
#undef A3_CMASK
#undef A3_START
#undef A3_RESC
#undef A3_ROT
#undef A3_PKW
#undef A3_PAF
#undef A3_VFR
#undef A3_PIN
#undef A3_MX3
#undef A3_GAPA
#undef A3_EX
#undef A3_GAPB
#undef A3_VRD
#undef A3_KRD
#undef A3_MF
#undef A3_STEP
#undef A3_ENDW
#undef A3_DRAIN
}
#undef A3_SBAR
#undef A3_WAIT_BAR
}


constexpr int CH_RS = 144;
constexpr int CH_T = 64 * CH_RS;
constexpr int GL_RS = 80;
constexpr int GL_T = 64 * GL_RS;
__device__ __forceinline__ int chunk_b0(int oc) { return (oc < 256) ? oc * 64 : SEQ + (oc - 256) * 64; }
__device__ __forceinline__ bf16x8 tr_frag(const LAS unsigned char* tile, int rs, int row0, int col0, int lane) {
    const int g = lane >> 4, i = lane & 15; const LAS unsigned char* p = tile + (row0 + 8 * g + (i >> 2)) * rs + (col0 + 4 * (i & 3)) * 2;
    return cat44(ds_tr16(p), ds_tr16(p + 4 * rs));
}
__device__ __forceinline__ bf16x8 tr_frag_perm(const LAS unsigned char* tile, int rs, int row0, int col0, int lane) {
    const int g = lane >> 4, i = lane & 15; const LAS unsigned char* p = tile + (row0 + 4 * g + (i >> 2)) * rs + (col0 + 4 * (i & 3)) * 2;
    return cat44(ds_tr16(p), ds_tr16(p + 16 * rs));
}
__device__ __forceinline__ void unpack8(const u32x4 v, float* o) {
    o[0] = __uint_as_float(v.x << 16); o[1] = __uint_as_float(v.x & 0xffff0000u); o[2] = __uint_as_float(v.y << 16); o[3] = __uint_as_float(v.y & 0xffff0000u);
    o[4] = __uint_as_float(v.z << 16); o[5] = __uint_as_float(v.z & 0xffff0000u); o[6] = __uint_as_float(v.w << 16); o[7] = __uint_as_float(v.w & 0xffff0000u);
}
__device__ __forceinline__ u32x4 pack8(const float* f) { u32x4 w; w.x = cvtpk(f[0], f[1]); w.y = cvtpk(f[2], f[3]); w.z = cvtpk(f[4], f[5]); w.w = cvtpk(f[6], f[7]); return w; }

#define LBAR() do { asm volatile("s_waitcnt lgkmcnt(0)" ::: "memory"); __builtin_amdgcn_s_barrier(); asm volatile("" ::: "memory"); } while (0)

struct MsRaw { u32x4 k, v; float ig, fg, gbi, gbf; };
__device__ __forceinline__ MsRaw mlstm_summary_load(const bf16_t* P, const float* Gt, const float* gate_b, int h, int oc, int tid, int lane, int wave) {
    MsRaw R; const int b0 = chunk_b0(oc), r = tid >> 3, ch = tid & 7;
    R.k = *(const u32x4*)(P + (size_t)(b0 + r) * LDP + C_MK + h * 64 + ch * 8); R.v = *(const u32x4*)(P + (size_t)(b0 + r) * LDP + C_MV + h * 64 + ch * 8);
    { const int d = wave & 1, sp = d ? 63 - lane : lane, row = b0 + sp;
      R.ig = Gt[(size_t)row * 48 + d * 8 + h]; R.gbi = gate_b[d * 8 + h]; R.fg = Gt[(size_t)row * 48 + d * 8 + 4 + h]; R.gbf = gate_b[d * 8 + 4 + h]; }
    return R;
}
__device__ __forceinline__ void mlstm_summary_body(LAS unsigned char* lds, const MsRaw& R, float* MU, float* MNU, float* MSC, int h, int oc, int tid, int lane, int wave) {
    LAS unsigned char* Kw0 = lds; LAS unsigned char* Kw1 = lds + CH_T; LAS unsigned char* Vt = lds + 2 * CH_T; LAS float* wv = (LAS float*)(lds + 3 * CH_T);
    const int r = tid >> 3, ch = tid & 7;
    LBAR();
    if (wave < 2) {
        const int d = wave, sp = d ? 63 - lane : lane, hd = h * 2 + d, jc = oc_to_jc(d, oc);
        const float lf = log_sigmoidf_(R.fg + R.gbf);
        const float bb = scan_add(lf, lane);
        const float av = (R.ig + R.gbi) - bb;
        const float cm = wave_max(av);
        const float B = __shfl(bb, 63);
        wv[d * 64 + sp] = __expf(av - cm);
        if (lane == 0) { MSC[(size_t)(hd * NCH + jc) * 4 + 0] = cm; MSC[(size_t)(hd * NCH + jc) * 4 + 1] = B; }
    }
    *(LAS u32x4*)(Vt + r * CH_RS + ch * 16) = R.v;
    LBAR();
    { float kf[8], t0[8], t1[8]; unpack8(R.k, kf); const float w0 = wv[r], w1 = wv[64 + r];
#pragma unroll
      for (int j = 0; j < 8; ++j) { t0[j] = kf[j] * w0; t1[j] = kf[j] * w1; }
      *(LAS u32x4*)(Kw0 + r * CH_RS + ch * 16) = pack8(t0); *(LAS u32x4*)(Kw1 + r * CH_RS + ch * 16) = pack8(t1); }
    LBAR();
    { const int d = wave >> 2, dkt = wave & 3, g = lane >> 4, i = lane & 15, hd = h * 2 + d, jc = oc_to_jc(d, oc);
      const LAS unsigned char* Kw = d ? Kw1 : Kw0;
      const bf16x8 a0 = tr_frag(Kw, CH_RS, 0, 16 * dkt, lane), a1 = tr_frag(Kw, CH_RS, 32, 16 * dkt, lane);
      float* dst = MU + ((size_t)(hd * 64 + 16 * dkt + i) * NCH + jc) * 64 + 4 * g;
#pragma unroll
      for (int dvt = 0; dvt < 4; ++dvt) {
          f32x4 c = (f32x4){0.f, 0.f, 0.f, 0.f};
          c = MFMA16(tr_frag(Vt, CH_RS, 0, 16 * dvt, lane), a0, c); c = MFMA16(tr_frag(Vt, CH_RS, 32, 16 * dvt, lane), a1, c);
          *(f32x4*)(dst + 16 * dvt) = c;
      }
      const short one = (i == 0) ? (short)0x3F80 : (short)0; const bf16x8 bo = (bf16x8){one, one, one, one, one, one, one, one};
      f32x4 c1 = (f32x4){0.f, 0.f, 0.f, 0.f}; c1 = MFMA16(a0, bo, c1); c1 = MFMA16(a1, bo, c1);
      if (i == 0) *(f32x4*)(MNU + (size_t)(hd * NCH + jc) * 64 + 16 * dkt + 4 * g) = c1; }
}

struct MoRaw { u32x4 q, k, v, c0, c1; float ig, fg, gbi, gbf, mst, nv; uint2 og[4]; };
__device__ __forceinline__ MoRaw mlstm_out_load(const bf16_t* P, const float* Gt, const float* gate_b, const bf16_t* MC, const float* MNS, const float* MSC, int h, int oc, int tid, int lane, int wave) {
    MoRaw R; const int b0 = chunk_b0(oc), r = tid >> 3, ch = tid & 7;
    const size_t ro = (size_t)(b0 + r) * LDP + h * 64 + ch * 8;
    R.q = *(const u32x4*)(P + ro + C_MQ); R.k = *(const u32x4*)(P + ro + C_MK); R.v = *(const u32x4*)(P + ro + C_MV);
    const int jc0 = oc_to_jc(0, oc), jc1 = oc_to_jc(1, oc);
    R.c0 = *(const u32x4*)(MC + ((size_t)((h * 2 + 0) * 64 + r) * NCH + jc0) * 64 + ch * 8); R.c1 = *(const u32x4*)(MC + ((size_t)((h * 2 + 1) * 64 + r) * NCH + jc1) * 64 + ch * 8);
    { const int d = wave & 1, sp = d ? 63 - lane : lane, row = b0 + sp, hd = h * 2 + d, jc = d ? jc1 : jc0;
        R.ig = Gt[(size_t)row * 48 + d * 8 + h]; R.gbi = gate_b[d * 8 + h]; R.fg = Gt[(size_t)row * 48 + d * 8 + 4 + h]; R.gbf = gate_b[d * 8 + 4 + h];
        R.mst = MSC[(size_t)(hd * NCH + jc) * 4 + 2]; R.nv = MNS[(size_t)(hd * NCH + jc) * 64 + lane]; }
    { const int tt = wave & 3, g = lane >> 4, i = lane & 15, row = b0 + 16 * tt + i;
#pragma unroll
      for (int dvt = 0; dvt < 4; ++dvt) R.og[dvt] = *(const uint2*)(P + (size_t)row * LDP + C_MO + h * 64 + 16 * dvt + 4 * g); }
    return R;
}
__device__ __forceinline__ void mo_s1(LAS unsigned char* lds, const MoRaw& R, int oc, int tid, int lane, int wave, int gpair) {
    LAS unsigned char* Qt = lds; LAS unsigned char* Kt = lds + CH_T; LAS unsigned char* Vt = lds + 2 * CH_T; LAS unsigned char* Ct = lds + 3 * CH_T;
    LAS float* arr = (LAS float*)(lds + 5 * CH_T);
    LAS f32x4* hs = (LAS f32x4*)(lds + 5 * CH_T + 2 * 320 * 4);
    const int b0 = chunk_b0(oc);
    const int r = tid >> 3, ch = tid & 7;
    if ((wave >> 1) == gpair) {
        const int d = wave & 1, sp = d ? 63 - lane : lane;
        const float lf = log_sigmoidf_(R.fg + R.gbf);
        const float bb = scan_add(lf, lane);
        const float av = (R.ig + R.gbi) - bb;
        const float cm = scan_max(av, lane);
        const float mx = fmaxf(R.mst, cm);
        LAS float* A = arr + d * 320;
        A[sp] = av; A[64 + sp] = mx; A[128 + sp] = __expf(R.mst - mx); A[192 + sp] = __expf(-(bb + mx));
        A[256 + lane] = R.nv;
    }
    *(LAS u32x4*)(Qt + r * CH_RS + ch * 16) = R.q; *(LAS u32x4*)(Kt + r * CH_RS + ch * 16) = R.k; *(LAS u32x4*)(Vt + r * CH_RS + ch * 16) = R.v;
    *(LAS u32x4*)(Ct + r * CH_RS + ch * 16) = R.c0; *(LAS u32x4*)(Ct + CH_T + r * CH_RS + ch * 16) = R.c1;
    (void)hs; (void)b0;
}
__device__ __forceinline__ void mo_s2(LAS unsigned char* lds, f32x4 (&hh)[4], int oc, int tid, int lane, int wave, int pub_d) {
    LAS unsigned char* Qt = lds; LAS unsigned char* Kt = lds + CH_T; LAS unsigned char* Vt = lds + 2 * CH_T; LAS unsigned char* Ct = lds + 3 * CH_T;
    LAS float* arr = (LAS float*)(lds + 5 * CH_T);
    LAS f32x4* hs = (LAS f32x4*)(lds + 5 * CH_T + 2 * 320 * 4);
    const int b0 = chunk_b0(oc);
    const int r = tid >> 3, ch = tid & 7;
    const int d = wave >> 2, tt = wave & 3, g = lane >> 4, i = lane & 15, t = 16 * tt + i; (void)g; (void)i; (void)t; (void)d; (void)tt;
    {
        const LAS float* A = arr + d * 320;
        const float mxt = A[64 + t], wt = A[128 + t], emt = A[192 + t];
        bf16x8 bq[2], bqw[2]; float qn = 0.f;
#pragma unroll
        for (int ks = 0; ks < 2; ++ks) { const u32x4 raw = *(const LAS u32x4*)(Qt + t * CH_RS + (32 * ks + 8 * g) * 2); bq[ks] = __builtin_bit_cast(bf16x8, raw);
            float qf[8], qw[8]; unpack8(raw, qf);
            const f32x4 n0 = *(const LAS f32x4*)(A + 256 + 32 * ks + 8 * g), n1 = *(const LAS f32x4*)(A + 256 + 32 * ks + 8 * g + 4);
#pragma unroll
            for (int j = 0; j < 4; ++j) { qn += qf[j] * n0[j] + qf[4 + j] * n1[j]; }
#pragma unroll
            for (int j = 0; j < 8; ++j) qw[j] = qf[j] * wt;
            bqw[ks] = __builtin_bit_cast(bf16x8, pack8(qw)); }
        qn += __shfl_xor(qn, 16); qn += __shfl_xor(qn, 32);
        float dsum = 0.f; f32x4 sT[4];
#pragma unroll
        for (int st = 0; st < 4; ++st) {
            f32x4 c = (f32x4){0.f, 0.f, 0.f, 0.f};
#pragma unroll
            for (int ks = 0; ks < 2; ++ks) c = MFMA16(*(const LAS bf16x8*)(Kt + (16 * st + i) * CH_RS + (32 * ks + 8 * g) * 2), bq[ks], c);
            const f32x4 a4 = *(const LAS f32x4*)(A + 16 * st + 4 * g);
#pragma unroll
            for (int rr = 0; rr < 4; ++rr) { const int sidx = 16 * st + 4 * g + rr; const bool ok = d ? (sidx >= t) : (sidx <= t);
                const float val = ok ? c[rr] * __expf(a4[rr] - mxt) : 0.f; sT[st][rr] = val; dsum += val; }
        }
        dsum += __shfl_xor(dsum, 16); dsum += __shfl_xor(dsum, 32);
        const float den = dsum + wt * qn, inv = 1.f / fmaxf(fabsf(den), emt);
        bf16x8 pb[2];
#pragma unroll
        for (int gp = 0; gp < 2; ++gp) { u32x4 w; w.x = cvtpk(sT[2 * gp][0], sT[2 * gp][1]); w.y = cvtpk(sT[2 * gp][2], sT[2 * gp][3]); w.z = cvtpk(sT[2 * gp + 1][0], sT[2 * gp + 1][1]); w.w = cvtpk(sT[2 * gp + 1][2], sT[2 * gp + 1][3]); pb[gp] = __builtin_bit_cast(bf16x8, w); }
        const LAS unsigned char* Cd = Ct + d * CH_T;
#pragma unroll
        for (int dvt = 0; dvt < 4; ++dvt) {
            f32x4 c = (f32x4){0.f, 0.f, 0.f, 0.f};
            c = MFMA16(tr_frag_perm(Vt, CH_RS, 0, 16 * dvt, lane), pb[0], c); c = MFMA16(tr_frag_perm(Vt, CH_RS, 32, 16 * dvt, lane), pb[1], c);
            c = MFMA16(tr_frag(Cd, CH_RS, 0, 16 * dvt, lane), bqw[0], c); c = MFMA16(tr_frag(Cd, CH_RS, 32, 16 * dvt, lane), bqw[1], c);
            hh[dvt] = c * inv;
        }
        if (d == pub_d) {
#pragma unroll
            for (int dvt = 0; dvt < 4; ++dvt) hs[(tt * 4 + dvt) * 64 + lane] = hh[dvt];
        }
    }
    (void)b0; (void)r; (void)ch; (void)Qt;
}
__device__ __forceinline__ void mo_s3(LAS unsigned char* lds, const uint2 (&ogr)[4], f32x4 (&hh)[4], const float* normw, bf16_t* CAT, int h, int oc, int tid, int lane, int wave, int pub_d) {
    LAS unsigned char* Qt = lds; LAS unsigned char* Kt = lds + CH_T; LAS unsigned char* Vt = lds + 2 * CH_T; LAS unsigned char* Ct = lds + 3 * CH_T;
    LAS float* arr = (LAS float*)(lds + 5 * CH_T);
    LAS f32x4* hs = (LAS f32x4*)(lds + 5 * CH_T + 2 * 320 * 4);
    const int b0 = chunk_b0(oc);
    const int r = tid >> 3, ch = tid & 7;
    const int d = wave >> 2, tt = wave & 3, g = lane >> 4, i = lane & 15, t = 16 * tt + i; (void)g; (void)i; (void)t; (void)d; (void)tt;
    if (d != pub_d) {
        float s1 = 0.f;
#pragma unroll
        for (int dvt = 0; dvt < 4; ++dvt) { hh[dvt] = hh[dvt] + hs[(tt * 4 + dvt) * 64 + lane]; s1 += (hh[dvt][0] + hh[dvt][1]) + (hh[dvt][2] + hh[dvt][3]); }
        s1 += __shfl_xor(s1, 16); s1 += __shfl_xor(s1, 32);
        const float mu = s1 * (1.f / 64.f); float s2 = 0.f;
#pragma unroll
        for (int dvt = 0; dvt < 4; ++dvt) { hh[dvt] = hh[dvt] - mu; s2 += (hh[dvt][0] * hh[dvt][0] + hh[dvt][1] * hh[dvt][1]) + (hh[dvt][2] * hh[dvt][2] + hh[dvt][3] * hh[dvt][3]); }
        s2 += __shfl_xor(s2, 16); s2 += __shfl_xor(s2, 32);
        const float rstd = rsqrtf(s2 * (1.f / 64.f) + LN_EPS);
        const int row = b0 + t;
#pragma unroll
        for (int dvt = 0; dvt < 4; ++dvt) { const int col = h * 64 + 16 * dvt + 4 * g;
            const uint2 og = ogr[dvt]; const f32x4 nw = *(const f32x4*)(normw + col);
            const float o0 = hh[dvt][0] * rstd * nw[0] * sigmoidf_(__uint_as_float(og.x << 16)), o1 = hh[dvt][1] * rstd * nw[1] * sigmoidf_(__uint_as_float(og.x & 0xffff0000u));
            const float o2 = hh[dvt][2] * rstd * nw[2] * sigmoidf_(__uint_as_float(og.y << 16)), o3 = hh[dvt][3] * rstd * nw[3] * sigmoidf_(__uint_as_float(og.y & 0xffff0000u));
            uint2 o; o.x = cvtpk(o0, o1); o.y = cvtpk(o2, o3); *(uint2*)(CAT + (size_t)row * DM + col) = o; }
    }
    (void)r; (void)ch; (void)Qt; (void)Kt; (void)Vt; (void)Ct; (void)arr;
}
__device__ __forceinline__ void mlstm_out_body(LAS unsigned char* lds, const MoRaw& R, const float* normw, bf16_t* CAT, int h, int oc, int tid, int lane, int wave) {
    f32x4 hh[4];
    LBAR(); mo_s1(lds, R, oc, tid, lane, wave, 0);
    LBAR(); mo_s2(lds, hh, oc, tid, lane, wave, 1);
    LBAR(); mo_s3(lds, R.og, hh, normw, CAT, h, oc, tid, lane, wave, 1);
}
__device__ __forceinline__ void mlstm_out_pair(LAS unsigned char* lds, MoRaw& RA, MoRaw& RB, const float* normw, bf16_t* CAT, int hA, int ocA, int hB, int ocB, bool pair,
                                               const bf16_t* P, const float* Gt, const float* gate_b, const bf16_t* MC, const float* MNS, const float* MSC, int nhA, int nocA, int nhB, int nocB,
                                               int tid, int lane, int wave) {
    LAS unsigned char* ldsB = lds + 65536; f32x4 hA4[4], hB4[4];
    LBAR(); mo_s1(lds, RA, ocA, tid, lane, wave, 0); if (pair) mo_s1(ldsB, RB, ocB, tid, lane, wave, 1);
    uint2 ogA[4], ogB[4];
#pragma unroll
    for (int j = 0; j < 4; ++j) { ogA[j] = RA.og[j]; ogB[j] = RB.og[j]; }
    RA = mlstm_out_load(P, Gt, gate_b, MC, MNS, MSC, nhA, nocA, tid, lane, wave); RB = mlstm_out_load(P, Gt, gate_b, MC, MNS, MSC, nhB, nocB, tid, lane, wave);
    LBAR(); mo_s2(lds, hA4, ocA, tid, lane, wave, 1); if (pair) mo_s2(ldsB, hB4, ocB, tid, lane, wave, 0);
    LBAR(); mo_s3(lds, ogA, hA4, normw, CAT, hA, ocA, tid, lane, wave, 1); if (pair) mo_s3(ldsB, ogB, hB4, normw, CAT, hB, ocB, tid, lane, wave, 0);
}

struct GgRaw { f32x4 g0, g1, g2, g3; };
__device__ __forceinline__ GgRaw gla_gates_load(const float* Gt, int b0, int lane, int wave) {
    const int d = wave >> 2, sp = d ? 63 - lane : lane; const float* gs = Gt + (size_t)(b0 + sp) * 48 + 16 + d * 16;
    GgRaw R; R.g0 = *(const f32x4*)gs; R.g1 = *(const f32x4*)(gs + 4); R.g2 = *(const f32x4*)(gs + 8); R.g3 = *(const f32x4*)(gs + 12); return R;
}
__device__ __forceinline__ void gla_gates_wave(const GgRaw& R, const LAS float* g_up, const LAS float* g_b, int h, int lane, int wave, float (&bc)[8]) {
    const int d = wave >> 2, dk0 = 8 * (wave & 3);
    const float gv[16] = {R.g0[0], R.g0[1], R.g0[2], R.g0[3], R.g1[0], R.g1[1], R.g1[2], R.g1[3], R.g2[0], R.g2[1], R.g2[2], R.g2[3], R.g3[0], R.g3[1], R.g3[2], R.g3[3]};
    float z[8];
    { const f32x4 b0 = *(const LAS f32x4*)(g_b + d * 128 + h * 32 + dk0), b1 = *(const LAS f32x4*)(g_b + d * 128 + h * 32 + dk0 + 4);
#pragma unroll
      for (int c = 0; c < 4; ++c) { z[c] = b0[c]; z[4 + c] = b1[c]; } }
#pragma unroll
    for (int rr = 0; rr < 16; ++rr) { const f32x4 u0 = *(const LAS f32x4*)(g_up + (d * 16 + rr) * 128 + h * 32 + dk0), u1 = *(const LAS f32x4*)(g_up + (d * 16 + rr) * 128 + h * 32 + dk0 + 4);
#pragma unroll
        for (int c = 0; c < 4; ++c) { z[c] += gv[rr] * u0[c]; z[4 + c] += gv[rr] * u1[c]; } }
#pragma unroll
    for (int c = 0; c < 8; ++c) bc[c] = scan_add(log_sigmoidf_(z[c]) * (1.f / 16.f), lane);
}
struct GsRaw { u32x4 v, k; GgRaw gg; };
__device__ __forceinline__ GsRaw gla_summary_load(const bf16_t* P, const float* Gt, int h, int oc, int tid, int lane, int wave) {
    GsRaw R; const int b0 = chunk_b0(oc), r = tid >> 3, ch = tid & 7, d = wave >> 2, dk0 = 8 * (wave & 3), sp = d ? 63 - lane : lane;
    R.v = *(const u32x4*)(P + (size_t)(b0 + r) * LDP + C_GV + h * 64 + ch * 8);
    R.k = *(const u32x4*)(P + (size_t)(b0 + sp) * LDP + C_GK + h * 32 + dk0);
    R.gg = gla_gates_load(Gt, b0, lane, wave);
    return R;
}
__device__ __forceinline__ void gla_summary_body(LAS unsigned char* lds, const GsRaw& R, const LAS float* g_up, const LAS float* g_b, float* GU, float* GDEC, int h, int oc, int tid, int lane, int wave) {
    LAS unsigned char* Kd = lds; LAS unsigned char* Vt = lds + 2 * GL_T;
    { const int r = tid >> 3, ch = tid & 7;
      LBAR();
      *(LAS u32x4*)(Vt + r * CH_RS + ch * 16) = R.v; }
    { const int d = wave >> 2, dk0 = 8 * (wave & 3), hd = h * 2 + d, jc = oc_to_jc(d, oc), sp = d ? 63 - lane : lane;
      float bc[8]; gla_gates_wave(R.gg, g_up, g_b, h, lane, wave, bc);
      float kf[8]; unpack8(R.k, kf);
      float dec[8];
#pragma unroll
      for (int c = 0; c < 8; ++c) { const float bL = __shfl(bc[c], 63); kf[c] *= __expf(bL - bc[c]); dec[c] = __expf(bL); }
      *(LAS u32x4*)(Kd + d * GL_T + sp * GL_RS + dk0 * 2) = pack8(kf);
      if (lane == 0) { float* dp = GDEC + (size_t)(hd * NCH + jc) * 32 + dk0; *(f32x4*)dp = (f32x4){dec[0], dec[1], dec[2], dec[3]}; *(f32x4*)(dp + 4) = (f32x4){dec[4], dec[5], dec[6], dec[7]}; } }
    LBAR();
    { const int d = wave >> 2, dkt = (wave >> 1) & 1, dvh = wave & 1, g = lane >> 4, i = lane & 15, hd = h * 2 + d, jc = oc_to_jc(d, oc);
      const bf16x8 a0 = tr_frag(Kd + d * GL_T, GL_RS, 0, 16 * dkt, lane), a1 = tr_frag(Kd + d * GL_T, GL_RS, 32, 16 * dkt, lane);
      float* dst = GU + ((size_t)(hd * 32 + 16 * dkt + i) * NCH + jc) * 64 + 4 * g;
#pragma unroll
      for (int q = 0; q < 2; ++q) { const int dvt = 2 * dvh + q;
          f32x4 c = (f32x4){0.f, 0.f, 0.f, 0.f};
          c = MFMA16(tr_frag(Vt, CH_RS, 0, 16 * dvt, lane), a0, c); c = MFMA16(tr_frag(Vt, CH_RS, 32, 16 * dvt, lane), a1, c);
          *(f32x4*)(dst + 16 * dvt) = c; } }
}
struct GoRaw { u32x4 v, s, q, k; GgRaw gg; uint2 og[4]; };
__device__ __forceinline__ GoRaw gla_out_load(const bf16_t* P, const float* Gt, const bf16_t* GS, int h, int oc, int tid, int lane, int wave) {
    GoRaw R; const int b0 = chunk_b0(oc), r = tid >> 3, ch = tid & 7, d = wave >> 2, dk0 = 8 * (wave & 3), sp = d ? 63 - lane : lane;
    R.v = *(const u32x4*)(P + (size_t)(b0 + r) * LDP + C_GV + h * 64 + ch * 8);
    { const int dd = r >> 5, rk = r & 31; R.s = *(const u32x4*)(GS + ((size_t)((h * 2 + dd) * 32 + rk) * NCH + oc_to_jc(dd, oc)) * 64 + ch * 8); }
    R.q = *(const u32x4*)(P + (size_t)(b0 + sp) * LDP + C_GQ + h * 32 + dk0); R.k = *(const u32x4*)(P + (size_t)(b0 + sp) * LDP + C_GK + h * 32 + dk0);
    R.gg = gla_gates_load(Gt, b0, lane, wave);
    { const int tt = wave & 3, g = lane >> 4, i = lane & 15, row = b0 + 16 * tt + i;
#pragma unroll
      for (int dvt = 0; dvt < 4; ++dvt) R.og[dvt] = *(const uint2*)(P + (size_t)row * LDP + C_GG + h * 64 + 16 * dvt + 4 * g); }
    return R;
}
__device__ __forceinline__ void gla_out_body(LAS unsigned char* lds, const GoRaw& R, const LAS float* g_up, const LAS float* g_b, const float* normw, bf16_t* CAT, int h, int oc, int tid, int lane, int wave) {
    LAS unsigned char* Qs = lds; LAS unsigned char* Ks = lds + 2 * GL_T; LAS unsigned char* Vt = lds + 4 * GL_T; LAS unsigned char* St = Vt + CH_T;
    LAS f32x4* hs = (LAS f32x4*)(St + 2 * 32 * CH_RS);
    const int b0 = chunk_b0(oc);
    { const int r = tid >> 3, ch = tid & 7, dd = r >> 5, rk = r & 31;
      LBAR();
      *(LAS u32x4*)(Vt + r * CH_RS + ch * 16) = R.v; *(LAS u32x4*)(St + dd * 32 * CH_RS + rk * CH_RS + ch * 16) = R.s; }
    { const int d = wave >> 2, dk0 = 8 * (wave & 3), sp = d ? 63 - lane : lane;
      float bc[8]; gla_gates_wave(R.gg, g_up, g_b, h, lane, wave, bc);
      float qf[8], kf[8]; unpack8(R.q, qf); unpack8(R.k, kf);
#pragma unroll
      for (int c = 0; c < 8; ++c) { qf[c] *= __expf(bc[c]); kf[c] *= __expf(-bc[c]); }
      *(LAS u32x4*)(Qs + d * GL_T + sp * GL_RS + dk0 * 2) = pack8(qf); *(LAS u32x4*)(Ks + d * GL_T + sp * GL_RS + dk0 * 2) = pack8(kf); }
    LBAR();
    const int d = wave >> 2, tt = wave & 3, g = lane >> 4, i = lane & 15, t = 16 * tt + i;
    f32x4 hh[4];
    {
        const bf16x8 bq = *(const LAS bf16x8*)(Qs + d * GL_T + t * GL_RS + 16 * g);
        f32x4 sT[4];
#pragma unroll
        for (int st = 0; st < 4; ++st) {
            f32x4 c = (f32x4){0.f, 0.f, 0.f, 0.f};
            c = MFMA16(*(const LAS bf16x8*)(Ks + d * GL_T + (16 * st + i) * GL_RS + 16 * g), bq, c);
#pragma unroll
            for (int rr = 0; rr < 4; ++rr) { const int sidx = 16 * st + 4 * g + rr; const bool ok = d ? (sidx >= t) : (sidx <= t); sT[st][rr] = ok ? c[rr] : 0.f; }
        }
        bf16x8 pb[2];
#pragma unroll
        for (int gp = 0; gp < 2; ++gp) { u32x4 w; w.x = cvtpk(sT[2 * gp][0], sT[2 * gp][1]); w.y = cvtpk(sT[2 * gp][2], sT[2 * gp][3]); w.z = cvtpk(sT[2 * gp + 1][0], sT[2 * gp + 1][1]); w.w = cvtpk(sT[2 * gp + 1][2], sT[2 * gp + 1][3]); pb[gp] = __builtin_bit_cast(bf16x8, w); }
#pragma unroll
        for (int dvt = 0; dvt < 4; ++dvt) {
            f32x4 c = (f32x4){0.f, 0.f, 0.f, 0.f};
            c = MFMA16(tr_frag_perm(Vt, CH_RS, 0, 16 * dvt, lane), pb[0], c); c = MFMA16(tr_frag_perm(Vt, CH_RS, 32, 16 * dvt, lane), pb[1], c);
            c = MFMA16(tr_frag(St + d * 32 * CH_RS, CH_RS, 0, 16 * dvt, lane), bq, c);
            hh[dvt] = c;
        }
        if (d == 1) {
#pragma unroll
            for (int dvt = 0; dvt < 4; ++dvt) hs[(tt * 4 + dvt) * 64 + lane] = hh[dvt];
        }
    }
    LBAR();
    if (d == 0) {
        float s1 = 0.f;
#pragma unroll
        for (int dvt = 0; dvt < 4; ++dvt) { hh[dvt] = hh[dvt] + hs[(tt * 4 + dvt) * 64 + lane]; s1 += (hh[dvt][0] + hh[dvt][1]) + (hh[dvt][2] + hh[dvt][3]); }
        s1 += __shfl_xor(s1, 16); s1 += __shfl_xor(s1, 32);
        const float mu = s1 * (1.f / 64.f); float s2 = 0.f;
#pragma unroll
        for (int dvt = 0; dvt < 4; ++dvt) { hh[dvt] = hh[dvt] - mu; s2 += (hh[dvt][0] * hh[dvt][0] + hh[dvt][1] * hh[dvt][1]) + (hh[dvt][2] * hh[dvt][2] + hh[dvt][3] * hh[dvt][3]); }
        s2 += __shfl_xor(s2, 16); s2 += __shfl_xor(s2, 32);
        const float rstd = rsqrtf(s2 * (1.f / 64.f) + LN_EPS);
        const int row = b0 + t;
#pragma unroll
        for (int dvt = 0; dvt < 4; ++dvt) { const int col = h * 64 + 16 * dvt + 4 * g;
            const uint2 gg = R.og[dvt]; const f32x4 nw = *(const f32x4*)(normw + col);
            const float o0 = hh[dvt][0] * rstd * nw[0] * siluf(__uint_as_float(gg.x << 16)), o1 = hh[dvt][1] * rstd * nw[1] * siluf(__uint_as_float(gg.x & 0xffff0000u));
            const float o2 = hh[dvt][2] * rstd * nw[2] * siluf(__uint_as_float(gg.y << 16)), o3 = hh[dvt][3] * rstd * nw[3] * siluf(__uint_as_float(gg.y & 0xffff0000u));
            uint2 o; o.x = cvtpk(o0, o1); o.y = cvtpk(o2, o3); *(uint2*)(CAT + (size_t)row * DM + 768 + col) = o; }
    }
}

__device__ __forceinline__ f32x4 ld4bf(const bf16_t* p) { const uint2 v = *(const uint2*)p; return (f32x4){__uint_as_float(v.x << 16), __uint_as_float(v.x & 0xffff0000u), __uint_as_float(v.y << 16), __uint_as_float(v.y & 0xffff0000u)}; }
__device__ __forceinline__ void sum_partials(f32x4 (&a)[4], const float* __restrict__ base, int sp, size_t pstride) {
#pragma unroll
    for (int j = 0; j < 4; ++j) a[j] = (f32x4){0.f, 0.f, 0.f, 0.f};
    int p = 0;
    for (; p + 1 < sp; p += 2) { f32x4 t0[4], t1[4];
#pragma unroll
        for (int j = 0; j < 4; ++j) { t0[j] = *(const f32x4*)(base + (size_t)p * pstride + 256 * j); t1[j] = *(const f32x4*)(base + (size_t)(p + 1) * pstride + 256 * j); }
#pragma unroll
        for (int j = 0; j < 4; ++j) a[j] = a[j] + (t0[j] + t1[j]); }
    if (p < sp) {
#pragma unroll
        for (int j = 0; j < 4; ++j) a[j] = a[j] + *(const f32x4*)(base + (size_t)p * pstride + 256 * j); }
}
__device__ __forceinline__ void sum_partials_bf(f32x4 (&a)[4], const bf16_t* __restrict__ base, int sp, size_t pstride) {
#pragma unroll
    for (int j = 0; j < 4; ++j) a[j] = (f32x4){0.f, 0.f, 0.f, 0.f};
    int p = 0;
    for (; p + 1 < sp; p += 2) { f32x4 t0[4], t1[4];
#pragma unroll
        for (int j = 0; j < 4; ++j) { t0[j] = ld4bf(base + (size_t)p * pstride + 256 * j); t1[j] = ld4bf(base + (size_t)(p + 1) * pstride + 256 * j); }
#pragma unroll
        for (int j = 0; j < 4; ++j) a[j] = a[j] + (t0[j] + t1[j]); }
    if (p < sp) {
#pragma unroll
        for (int j = 0; j < 4; ++j) a[j] = a[j] + ld4bf(base + (size_t)p * pstride + 256 * j); }
}
__device__ __forceinline__ void ln16(f32x4 (&v)[4], const float* w, const float* b, int lane) {
    float s = 0.f;
#pragma unroll
    for (int j = 0; j < 4; ++j) s += (v[j][0] + v[j][1]) + (v[j][2] + v[j][3]);
    const float mean = wave_sum(s) * (1.f / DM); float s2 = 0.f;
#pragma unroll
    for (int j = 0; j < 4; ++j) { v[j] = v[j] - mean; s2 += (v[j][0] * v[j][0] + v[j][1] * v[j][1]) + (v[j][2] * v[j][2] + v[j][3] * v[j][3]); }
    const float rstd = rsqrtf(wave_sum(s2) * (1.f / DM) + LN_EPS);
#pragma unroll
    for (int j = 0; j < 4; ++j) { const f32x4 wv = *(const f32x4*)(w + 4 * lane + 256 * j), bv = *(const f32x4*)(b + 4 * lane + 256 * j); v[j] = v[j] * rstd * wv + bv; }
}
__device__ __forceinline__ void mod_store(f32x4 (&v)[4], const float* shift, const float* scale, bf16_t* hrow, int lane) {
#pragma unroll
    for (int j = 0; j < 4; ++j) { const f32x4 sh = *(const f32x4*)(shift + 4 * lane + 256 * j), sc = *(const f32x4*)(scale + 4 * lane + 256 * j);
        v[j] = v[j] * (sc + 1.f) + sh;
        uint2 o; o.x = cvtpk(v[j][0], v[j][1]); o.y = cvtpk(v[j][2], v[j][3]); *(uint2*)(hrow + 4 * lane + 256 * j) = o; }
}

__global__ void __launch_bounds__(512, 2) fwd(Args a_unused) {
    extern __shared__ __attribute__((aligned(16))) unsigned char lds_raw[];
    LAS unsigned char* lds = (LAS unsigned char*)lds_raw;
    const int wave0 = __builtin_amdgcn_readfirstlane(threadIdx.x >> 6);
    const int G0 = gridDim.x, bid0 = blockIdx.x;
    typedef const __attribute__((address_space(4))) Args* ArgsP;
    ArgsP ap0 = (ArgsP)__builtin_amdgcn_kernarg_segment_ptr();
#define PH_CTX() int G = G0, bid = bid0; asm volatile("" : "+s"(G), "+s"(bid)); int wave = wave0; asm volatile("" : "+s"(wave)); unsigned ones_ = ~0u; asm volatile("" : "+s"(ones_)); const int lane = (int)__builtin_amdgcn_mbcnt_hi(ones_, __builtin_amdgcn_mbcnt_lo(ones_, 0u)); const int tid = wave * 64 + lane; \
    ArgsP ap = ap0; asm volatile("" : "+s"(ap)); unsigned char* ws = ap->ws; const int gw = wave * G + bid, NGW = G * 8;     (void)lane; (void)gw; (void)NGW; (void)ws
#define WSP(T, off) ((T*)(ws + (off)))
    volatile LAS unsigned* MISC = (volatile LAS unsigned*)(lds + MISC_OFF);
    if (threadIdx.x < 32) MISC[threadIdx.x] = 0u;
    __syncthreads();
    XcdBarrier bar; bar.bar = (unsigned*)(ap0->ws + WS_CTL) + CW_BAR; bar.x = 0; bar.st = MISC + 8;
    if (MK_ONE_LAUNCH) bar = xcd_barrier_post(bar.bar, MISC + 8);
    const int lo = ap0->ph_lo, hi = ap0->ph_hi;
#define IN(k) (lo <= (k) && (k) < hi)
#define SEAM(k) do { if (MK_ONE_LAUNCH && (k) + 1 < hi) xcd_barrier(bar); } while (0)

    if (IN(0)) {
        PH_CTX();
        float* MODS = WSP(float, WS_MODS);
        LAS float* scs = (LAS float*)lds;
        for (int i = tid; i < 2048; i += 512) scs[i] = siluf(i < 1024 ? ap->in[1][i] : ap->in[3][i - 1024]);
        __syncthreads();
        for (int u = bid; u < 4 * 16 * 12; u += G) {
            const int l = u / 192, rem = u % 192, kc = rem / 12, ng = rem % 12, n = ng * 512 + tid;
            const float* w = ap->in[4] + ((size_t)l * 1024 + kc * 64) * 6144 + n;
            float a0 = 0.f, a1 = 0.f;
#pragma unroll 32
            for (int k = 0; k < 64; ++k) { const float wv = __builtin_nontemporal_load(w + (size_t)k * 6144); a0 += scs[kc * 64 + k] * wv; a1 += scs[1024 + kc * 64 + k] * wv; }
            if (kc == 0) { const float bb = ap->in[5][l * 6144 + n]; a0 += bb; a1 += bb; }
            atomicAdd(MODS + (size_t)(l * 2 + 0) * 6144 + n, a0); atomicAdd(MODS + (size_t)(l * 2 + 1) * 6144 + n, a1);
        }
        if (bid < 8) { float* ropeC = WSP(float, WS_ROPE); float* ropeS = ropeC + 256 * 16;
            const int i = bid * 512 + tid, pos = i >> 4, fi = i & 15; const float inv = powf(10000.f, -(float)fi / 16.f); const float ang = (float)pos * inv; float sn, cs; sincosf(ang, &sn, &cs); ropeC[i] = cs; ropeS[i] = sn; }
        __syncthreads();
        LAS float* scr = (LAS float*)(lds + wave * 16640);
        constexpr int I_A = 16 * 44, I_B = 16 * 16, I_C = 16 * 88, I_D = 44 * 16, I_E = 0, I_F = 0;
        constexpr int N_A = 4 * I_A, N_B = 4 * I_B, N_C = 2 * I_C, N_D = 2 * I_D, N_E = 16 * I_E, N_F = 16 * I_F;
        for (int it = gw; it < N_A + N_B + N_C + N_D; it += NGW) {
            int r = it;
            if (r < N_A) { const int mi = r / I_A; tr_item(ap->in[6] + (size_t)mi * DM * IN_COLS, DM, IN_COLS, NPIN, WSP(bf16_t, WS_WIN) + (size_t)mi * NPIN * DM, 1, 0, scr, r % I_A, lane); continue; } r -= N_A;
            if (r < N_B) { const int mi = r / I_B; tr_item(ap->in[13] + (size_t)mi * DM * DM, DM, DM, DM, WSP(bf16_t, WS_WOUT) + (size_t)mi * DM * DM, 0, 0, scr, r % I_B, lane); continue; } r -= N_B;
            if (r < N_C) { const int mi = r / I_C; tr_item<true>(ap->in[16] + (size_t)mi * DM * 2 * DFF, DM, 2 * DFF, 2 * DFF, (bf16_t*)(WSP(unsigned char, WS_FGU) + (size_t)mi * 2 * DFF * DM), 2, DFF, scr, r % I_C, lane, MGU_SCALE); continue; } r -= N_C;
            { const int mi = r / I_D; tr_item(ap->in[17] + (size_t)mi * DFF * DM, DFF, DM, DM, WSP(bf16_t, WS_FDN) + (size_t)mi * DM * DFF, 0, 0, scr, r % I_D, lane); }
        }
        __syncthreads();
        { constexpr int J_GU = 8 * 28, J_DN = 28 * 4, J_PER = J_GU + J_DN;
          for (int it = bid; it < 16 * J_PER; it += G) { const int mi = it / J_PER, r = it % J_PER;
              if (r < J_GU) tr_item_f8_wg(lds, ap->in[20] + (size_t)mi * DM * 2 * DEXP, DM, 2 * DEXP, 2 * DEXP, WSP(unsigned char, WS_MGU) + (size_t)mi * 2 * DEXP * DM, 2, DEXP, r, tid, lane, wave, MGU_SCALE);
              else tr_item_f8_wg(lds, ap->in[21] + (size_t)mi * DEXP * DM, DEXP, DM, DM, WSP(unsigned char, WS_MDN) + (size_t)mi * DM * DEXP, 0, 0, r - J_GU, tid, lane, wave, MDN_SCALE); } }
        SEAM(0);
    }
    if (IN(1)) {
        PH_CTX();
        bf16_t* H = WSP(bf16_t, WS_H); const float* MODS = WSP(float, WS_MODS);
        for (int r = gw; r < TT; r += NGW) {
            const int wch = r >= SEQ; const float* src = wch ? ap->in[2] + (size_t)(r - SEQ) * DM : ap->in[0] + (size_t)r * DM;
            f32x4 v[4];
#pragma unroll
            for (int j = 0; j < 4; ++j) v[j] = *(const f32x4*)(src + 4 * lane + 256 * j);
            const float* md = MODS + (size_t)(0 * 2 + wch) * 6144;
            mod_store(v, md, md + 1024, H + (size_t)r * DM, lane);
        }
        SEAM(1);
    }

    for (int l = 0; l < DEPTH; ++l) {
        const int pb = 2 + 10 * l;
        const bool lastl = (l == DEPTH - 1), moe = (l & 1);
        const int nrows = lastl ? SEQ : TT;

        PHASE_REP(0) if (IN(pb + 0)) {
            PH_CTX();
            pg8::StaticOrder S; S.init(WSP(bf16_t, WS_H), WSP(bf16_t, WS_WIN) + (size_t)l * NPIN * DM, DM, TT, NPIN, G, bid);
            pg8::EpiInProj E{WSP(bf16_t, WS_P), WSP(float, WS_G), WSP(float, WS_ROPE), WSP(float, WS_ROPE) + 256 * 16};
            pg8::gemm_phase<pg8::EpiInProj, pg8::StaticOrder>(lds, DM, S, E, tid);
            SEAM(pb + 0);
        }
        PHASE_REP(1) if (IN(pb + 1)) {
            if (!lastl && bid0 >= 32 && bid0 < 36) { PH_CTX(); for (int hf = 0; hf < 2; ++hf) at32::attn_unit<8>(lds, WSP(bf16_t, WS_P), WSP(bf16_t, WS_CAT), true, 2 * ((bid - 32) >> 1) + hf, bid & 1, ap->in[9] + l * 8, lane, wave); }
            { PH_CTX();
              const bf16_t* P = WSP(bf16_t, WS_P); const float* Gt = WSP(float, WS_G); const float* gate_b = ap->in[7] + l * 16;
#define UNIT_LOOP2(N_, start_, RawT, LOAD, BODY) do { int u0_ = (start_); if (u0_ < (N_)) { RawT A_ = LOAD(u0_); for (;;) { \
                  const int u1_ = u0_ + G; const RawT B_ = LOAD(u1_ < (N_) ? u1_ : u0_); BODY(A_, u0_); if (u1_ >= (N_)) break; \
                  const int u2_ = u1_ + G; A_ = LOAD(u2_ < (N_) ? u2_ : u1_); BODY(B_, u1_); if (u2_ >= (N_)) break; u0_ = u2_; } } } while (0)
#define UNIT_LOOP2S(N_, start_, S_, RawT, LOAD, BODY) do { int u0_ = (start_); if (u0_ < (N_)) { RawT A_ = LOAD(u0_); for (;;) { \
                  const int u1_ = u0_ + (S_); const RawT B_ = LOAD(u1_ < (N_) ? u1_ : u0_); BODY(A_, u0_); if (u1_ >= (N_)) break; \
                  const int u2_ = u1_ + (S_); A_ = LOAD(u2_ < (N_) ? u2_ : u1_); BODY(B_, u1_); if (u2_ >= (N_)) break; u0_ = u2_; } } } while (0)
#define MS_LOAD(u) mlstm_summary_load(P, Gt, gate_b, (u) / NCH, (u) % NCH, tid, lane, wave)
#define MS_BODY(R, u) mlstm_summary_body(lds, R, WSP(float, WS_MU), WSP(float, WS_MNU), WSP(float, WS_MSC), (u) / NCH, (u) % NCH, tid, lane, wave)
              const bool ctxb = !lastl && bid >= 32 && bid < 36; const int Gm = lastl ? G : G - 4, wm = lastl ? bid : (bid < 32 ? bid : bid - 4);
              if (!ctxb) UNIT_LOOP2S(4 * NCH, wm, Gm, MsRaw, MS_LOAD, MS_BODY); }
            { PH_CTX();
              const bf16_t* P = WSP(bf16_t, WS_P); const float* Gt = WSP(float, WS_G);
#define GS_LOAD(u) gla_summary_load(P, Gt, (u) / NCH, (u) % NCH, tid, lane, wave)
              LAS float* gupL = (LAS float*)(lds + 65536); LAS float* gbL = gupL + 4096;
              __syncthreads(); for (int i = tid; i < 4096; i += 512) gupL[i] = ap->in[10][(size_t)l * 4096 + i]; if (tid < 256) gbL[tid] = ap->in[11][l * 256 + tid]; __syncthreads();
#define GS_BODY(R, u) gla_summary_body(lds, R, gupL, gbL, WSP(float, WS_GU), WSP(float, WS_GDEC), (u) / NCH, (u) % NCH, tid, lane, wave)
              UNIT_LOOP2(4 * NCH, (bid + 200) % G, GsRaw, GS_LOAD, GS_BODY); }
            SEAM(pb + 1);
        }
        PHASE_REP(2) if (IN(pb + 2)) {
            PH_CTX();
            const int wi = wave * G + bid;
            const int e0 = wi * 64;
            LAS float* sc = (LAS float*)(lds + wave * 4096);
#define SC_LOAD(buf, b) _Pragma("unroll") for (int j = 0; j < 52; ++j) buf[j] = U[(size_t)((b) * 52 + j) * str]
            if (e0 < 32768 + 512) {
                const bool isC = e0 < 32768;
                const int hd = isC ? e0 / 4096 : (e0 - 32768) / 64, idx = isC ? (e0 % 4096) + lane : lane;
                const int dkr = (e0 % 4096) >> 6;
                const float* __restrict__ U = isC ? WSP(float, WS_MU) + (size_t)(hd * 64 + dkr) * NCH * 64 + lane : WSP(float, WS_MNU) + (size_t)hd * NCH * 64 + lane;
                bf16_t* __restrict__ StC = WSP(bf16_t, WS_MC) + (size_t)(hd * 64 + dkr) * NCH * 64 + lane; float* __restrict__ StN = WSP(float, WS_MNS) + (size_t)hd * NCH * 64 + lane;
                float* __restrict__ MSC = WSP(float, WS_MSC) + (size_t)hd * NCH * 4;
                const int str = 64;
                const bool wr_m_wave = isC && (e0 % 4096) == 0;
                float ua[52], ub[52], uc[52];
                {
                    float cmv[5], Bv[5]; float a = 0.f, b = -INFINITY;
#pragma unroll
                    for (int q = 0; q < 5; ++q) { const int n = 5 * lane + q; const bool ok = n < NCH; const float2 v = ok ? *(const float2*)(MSC + n * 4) : make_float2(-INFINITY, 0.f); cmv[q] = v.x; Bv[q] = v.y; }
                    SC_LOAD(ua, 0); SC_LOAD(ub, 1); SC_LOAD(uc, 2);
#pragma unroll
                    for (int q = 0; q < 5; ++q) { b = fmaxf(b + Bv[q], cmv[q] + Bv[q]); a += Bv[q]; }
#pragma unroll
                    for (int o = 1; o < 64; o <<= 1) { const float pa = __shfl_up(a, o), pb = __shfl_up(b, o); if (lane >= o) { b = fmaxf(pb + a, b); a = pa + a; } }
                    float ea = __shfl_up(a, 1), eb = __shfl_up(b, 1); if (lane == 0) { ea = 0.f; eb = -INFINITY; }
                    float m = fmaxf(ea, eb);
#pragma unroll
                    for (int q = 0; q < 5; ++q) { const int n = 5 * lane + q;
                        if (n < NCH) { const float mx = fmaxf(m, cmv[q]); sc[2 * n] = __expf(m - mx); sc[2 * n + 1] = __expf(cmv[q] - mx); if (wr_m_wave) MSC[n * 4 + 2] = m; m = Bv[q] + mx; } }
                }
                LDS_WAIT();
                float cval = 0.f;
#define SC_STEP_M(buf, b) _Pragma("unroll") for (int j = 0; j < 52; ++j) { const int n = (b) * 52 + j; \
                    if (isC) StC[(size_t)n * 64] = (bf16_t)f2bf(cval); else StN[(size_t)n * 64] = cval; \
                    cval = sc[2 * n] * cval + sc[2 * n + 1] * buf[j]; }
                SC_STEP_M(ua, 0); SC_LOAD(ua, 3); SC_STEP_M(ub, 1); SC_LOAD(ub, 4); SC_STEP_M(uc, 2);
                SC_STEP_M(ua, 3); SC_STEP_M(ub, 4);
#undef SC_STEP_M
            } else if (e0 < 32768 + 512 + 16384) {
                const int e2 = e0 - 33280, hd = e2 / 2048, idx = (e2 % 2048) + lane, dk = (e2 % 2048) >> 6;
                const float* __restrict__ U = WSP(float, WS_GU) + (size_t)(hd * 32 + dk) * NCH * 64 + lane; bf16_t* __restrict__ St = WSP(bf16_t, WS_GS) + (size_t)(hd * 32 + dk) * NCH * 64 + lane;
                const float* __restrict__ DC = WSP(float, WS_GDEC) + (size_t)hd * NCH * 32 + dk;
                const int str = 64;
                float ua[52], ub[52], uc[52];
                float dcv[5];
#pragma unroll
                for (int q = 0; q < 5; ++q) { const int k = lane + 64 * q; dcv[q] = k < NCH ? DC[(size_t)k * 32] : 0.f; }
                SC_LOAD(ua, 0); SC_LOAD(ub, 1); SC_LOAD(uc, 2);
#pragma unroll
                for (int q = 0; q < 5; ++q) { const int k = lane + 64 * q; if (k < NCH) sc[k] = dcv[q]; }
                LDS_WAIT();
                float sval = 0.f;
#define SC_STEP_G(buf, b) _Pragma("unroll") for (int j = 0; j < 52; ++j) { const int n = (b) * 52 + j; St[(size_t)n * 64] = (bf16_t)f2bf(sval); sval = sc[n] * sval + buf[j]; }
                SC_STEP_G(ua, 0); SC_LOAD(ua, 3); SC_STEP_G(ub, 1); SC_LOAD(ub, 4); SC_STEP_G(uc, 2);
                SC_STEP_G(ua, 3); SC_STEP_G(ub, 4);
#undef SC_STEP_G
            }
#undef SC_LOAD
            SEAM(pb + 2);
        }
        PHASE_REP(3) if (IN(pb + 3)) {
            const int noc = lastl ? 256 : 260;
            { PH_CTX();
              const int bsw = (G & 7) == 0 ? (bid & 7) * (G >> 3) + (bid >> 3) : bid;
              for (int u = bsw; u < 256; u += G)
                  for (int hf = 0; hf < 2; ++hf) at32::attn_unit<8>(lds, WSP(bf16_t, WS_P), WSP(bf16_t, WS_CAT), false, 2 * (u >> 1) + hf, u & 1, ap->in[9] + l * 8, lane, wave); }
            { PH_CTX();
              const bf16_t* P = WSP(bf16_t, WS_P); const float* Gt = WSP(float, WS_G); const float* gate_b = ap->in[7] + l * 16;
              const bf16_t* MC = WSP(bf16_t, WS_MC); const float* MNS = WSP(float, WS_MNS); const float* MSC = WSP(float, WS_MSC);
#define MO_LOAD(u) mlstm_out_load(P, Gt, gate_b, MC, MNS, MSC, (u) / noc, (u) % noc, tid, lane, wave)
#define MO_BODY(R, u) mlstm_out_body(lds, R, ap->in[8] + l * 256, WSP(bf16_t, WS_CAT), (u) / noc, (u) % noc, tid, lane, wave)
              const float* normw = ap->in[8] + l * 256; bf16_t* CATp = WSP(bf16_t, WS_CAT); const int NU = 4 * noc;
              { int u = bid;
                if (u < NU) { bool pr = u + G < NU; MoRaw RA = MO_LOAD(u), RB = MO_LOAD(pr ? u + G : u);
                  for (;;) { const int un = u + 2 * G; const bool hn = un < NU, npr = un + G < NU; const int na = hn ? un : u, nb = npr ? un + G : na;
                             mlstm_out_pair(lds, RA, RB, normw, CATp, u / noc, u % noc, (u + G) / noc, (u + G) % noc, pr, P, Gt, gate_b, MC, MNS, MSC, na / noc, na % noc, nb / noc, nb % noc, tid, lane, wave);
                             if (!hn) break; u = un; pr = npr; } } }
            }
            { PH_CTX();
              const bf16_t* P = WSP(bf16_t, WS_P); const float* Gt = WSP(float, WS_G); const bf16_t* GS = WSP(bf16_t, WS_GS);
#define GO_LOAD(u) gla_out_load(P, Gt, GS, (u) / noc, (u) % noc, tid, lane, wave)
              LAS float* gupL = (LAS float*)(lds + 65536); LAS float* gbL = gupL + 4096;
              __syncthreads(); for (int i = tid; i < 4096; i += 512) gupL[i] = ap->in[10][(size_t)l * 4096 + i]; if (tid < 256) gbL[tid] = ap->in[11][l * 256 + tid]; __syncthreads();
#define GO_BODY(R, u) gla_out_body(lds, R, gupL, gbL, ap->in[12] + l * 256, WSP(bf16_t, WS_CAT), (u) / noc, (u) % noc, tid, lane, wave)
              UNIT_LOOP2(4 * noc, (bid + 240) % G, GoRaw, GO_LOAD, GO_BODY); }
            SEAM(pb + 3);
        }
        PHASE_REP(4) if (IN(pb + 4)) {
            PH_CTX();
            const float* modl = WSP(float, WS_MODS) + (size_t)(l * 2 + 0) * 6144;
            int tp, sp; pg8::tail_params(nrows / 256, 4, DM / 64, G, tp, sp);
            pg8::TailOrder S; S.dense(WSP(bf16_t, WS_CAT), WSP(bf16_t, WS_WOUT) + (size_t)l * DM * DM, DM, DM, nrows / 256, G, bid, tp, sp);
            pg8::EpiResid E{WSP(bf16_t, WS_Y), modl + 2 * 1024, modl + 6144 + 2 * 1024, WSP(float, WS_YP), nrows - tp * 256, tp * 256};
            pg8::gemm_phase<pg8::EpiResid, pg8::TailOrder>(lds, DM, S, E, tid);
            SEAM(pb + 4);
        }
        if (IN(pb + 5)) {
            PH_CTX();
            float* X = WSP(float, WS_X); bf16_t* H = WSP(bf16_t, WS_H); const bf16_t* Yb = WSP(bf16_t, WS_Y);
            const float* modl = WSP(float, WS_MODS) + (size_t)(l * 2 + 0) * 6144;
            unsigned* mcnt = WSP(unsigned, WS_CTL) + CW_MOE + 64 * 8 * (l >> 1);
            LAS float* RW = (LAS float*)lds;
            if (moe) { const float* rw = ap->in[18] + (size_t)(l >> 1) * DM * 8; for (int i = tid; i < 8192; i += 512) { const int e = i >> 10, c = i & 1023; RW[i] = rw[c * 8 + e]; } __syncthreads(); }
            const float* lw = ap->in[14] + (size_t)(l * 2 + 0) * DM; const float* lb = ap->in[15] + (size_t)(l * 2 + 0) * DM;
            int tp, sp; pg8::tail_params(nrows / 256, 4, DM / 64, G, tp, sp);
            const int tail0 = nrows - tp * 256; const float* YP = WSP(float, WS_YP);
#define LN1_LD(r_, XR, YR) do { const int rr_ = (r_); const int wc_ = rr_ >= SEQ; \
                const float* xs_ = (l == 0) ? (wc_ ? ap->in[2] + (size_t)(rr_ - SEQ) * DM : ap->in[0] + (size_t)rr_ * DM) : X + (size_t)rr_ * DM;     \
                _Pragma("unroll") for (int j = 0; j < 4; ++j) { XR[j] = *(const f32x4*)(xs_ + 4 * lane + 256 * j); YR[j] = *(const uint2*)(Yb + (size_t)rr_ * DM + 4 * lane + 256 * j); } } while (0)
            auto ln1_row = [&](const int r, const f32x4 (&xr)[4], const uint2 (&yr)[4]) __attribute__((always_inline)) {
                const int wch = r >= SEQ; const float* md = modl + wch * 6144;
                f32x4 v[4];
                if (r < tail0) {
#pragma unroll
                    for (int j = 0; j < 4; ++j) v[j] = xr[j] * ALPHA + (f32x4){__uint_as_float(yr[j].x << 16), __uint_as_float(yr[j].x & 0xffff0000u), __uint_as_float(yr[j].y << 16), __uint_as_float(yr[j].y & 0xffff0000u)};
                } else {
                    f32x4 a4[4]; sum_partials(a4, YP + (size_t)(r - tail0) * DM + 4 * lane, sp, (size_t)tp * 256 * DM);
#pragma unroll
                    for (int j = 0; j < 4; ++j) { const int c = 4 * lane + 256 * j; v[j] = xr[j] * ALPHA + *(const f32x4*)(md + 2 * 1024 + c) * a4[j]; }
                }
                ln16(v, lw, lb, lane);
#pragma unroll
                for (int j = 0; j < 4; ++j) *(f32x4*)(X + (size_t)r * DM + 4 * lane + 256 * j) = v[j];
#pragma unroll
                for (int j = 0; j < 4; ++j) { const f32x4 sh = *(const f32x4*)(md + 3 * 1024 + 4 * lane + 256 * j), sc = *(const f32x4*)(md + 4 * 1024 + 4 * lane + 256 * j); v[j] = v[j] * (sc + 1.f) + sh; }
                if (!moe) {
#pragma unroll
                    for (int j = 0; j < 4; ++j) *(unsigned*)((unsigned char*)H + (size_t)r * DM + 4 * lane + 256 * j) = pk4_fp8(v[j][0], v[j][1], v[j][2], v[j][3]);
                } else {
                    float lg[8];
#pragma unroll
                    for (int e = 0; e < 8; ++e) { float s = 0.f;
#pragma unroll
                        for (int j = 0; j < 4; ++j) { const f32x4 w = *(const LAS f32x4*)(RW + e * 1024 + 4 * lane + 256 * j); s += v[j][0] * w[0] + v[j][1] * w[1] + v[j][2] * w[2] + v[j][3] * w[3]; }
                        lg[e] = wave_sum(s) + ap->in[19][(l >> 1) * 8 + e]; }
                    int e0 = 0; float l0 = lg[0];
#pragma unroll
                    for (int e = 1; e < 8; ++e) if (lg[e] > l0) { l0 = lg[e]; e0 = e; }
                    int e1 = -1; float l1 = -INFINITY;
#pragma unroll
                    for (int e = 0; e < 8; ++e) if (e != e0 && lg[e] > l1) { l1 = lg[e]; e1 = e; }
                    int p0 = 0, p1 = 0;
                    if (lane == 0) {
                        const float w0 = 1.f / (1.f + __expf(l1 - l0));
                        p0 = (int)atomicAdd(mcnt + 64 * e0, 1u); p1 = (int)atomicAdd(mcnt + 64 * e1, 1u);
                        WSP(int2, WS_TOKE)[r] = make_int2(e0, e1); WSP(int2, WS_TOKP)[r] = make_int2(p0, p1); WSP(float2, WS_TOKW)[r] = make_float2(w0, 1.f - w0);
                    }
                    p0 = __builtin_amdgcn_readfirstlane(p0); p1 = __builtin_amdgcn_readfirstlane(p1);
                    unsigned char* x0 = WSP(unsigned char, WS_XB) + ((size_t)e0 * TT + p0) * DM; unsigned char* x1 = WSP(unsigned char, WS_XB) + ((size_t)e1 * TT + p1) * DM;
#pragma unroll
                    for (int j = 0; j < 4; ++j) { const unsigned o = pk4_fp8(v[j][0], v[j][1], v[j][2], v[j][3]); *(unsigned*)(x0 + 4 * lane + 256 * j) = o; *(unsigned*)(x1 + 4 * lane + 256 * j) = o; }
                }
            };
            { int r = gw;
              if (r < nrows) { f32x4 xa[4], xb[4]; uint2 ya[4], yb[4]; LN1_LD(r, xa, ya);
                for (;;) { const int r1 = r + NGW; const bool h1 = r1 < nrows; LN1_LD(h1 ? r1 : r, xb, yb); ln1_row(r, xa, ya); if (!h1) break;
                           const int r2 = r1 + NGW; const bool h2 = r2 < nrows; LN1_LD(h2 ? r2 : r1, xa, ya); ln1_row(r1, xb, yb); if (!h2) break; r = r2; } } }
#undef LN1_LD
            SEAM(pb + 5);
        }
#define MOE_TS() int ts0 = 0, ts1, ts2, ts3, ts4, ts5, ts6, ts7, ts8; { const unsigned* mcnt = WSP(unsigned, WS_CTL) + CW_MOE + 64 * 8 * (l >> 1); \
            ts1 = ts0 + (int)((__hip_atomic_load(mcnt + 64 * 0, __ATOMIC_RELAXED, __HIP_MEMORY_SCOPE_AGENT) + 255u) >> 8); ts2 = ts1 + (int)((__hip_atomic_load(mcnt + 64 * 1, __ATOMIC_RELAXED, __HIP_MEMORY_SCOPE_AGENT) + 255u) >> 8); \
            ts3 = ts2 + (int)((__hip_atomic_load(mcnt + 64 * 2, __ATOMIC_RELAXED, __HIP_MEMORY_SCOPE_AGENT) + 255u) >> 8); ts4 = ts3 + (int)((__hip_atomic_load(mcnt + 64 * 3, __ATOMIC_RELAXED, __HIP_MEMORY_SCOPE_AGENT) + 255u) >> 8); \
            ts5 = ts4 + (int)((__hip_atomic_load(mcnt + 64 * 4, __ATOMIC_RELAXED, __HIP_MEMORY_SCOPE_AGENT) + 255u) >> 8); ts6 = ts5 + (int)((__hip_atomic_load(mcnt + 64 * 5, __ATOMIC_RELAXED, __HIP_MEMORY_SCOPE_AGENT) + 255u) >> 8); \
            ts7 = ts6 + (int)((__hip_atomic_load(mcnt + 64 * 6, __ATOMIC_RELAXED, __HIP_MEMORY_SCOPE_AGENT) + 255u) >> 8); ts8 = ts7 + (int)((__hip_atomic_load(mcnt + 64 * 7, __ATOMIC_RELAXED, __HIP_MEMORY_SCOPE_AGENT) + 255u) >> 8); \
            ts1 = __builtin_amdgcn_readfirstlane(ts1); ts2 = __builtin_amdgcn_readfirstlane(ts2); ts3 = __builtin_amdgcn_readfirstlane(ts3); ts4 = __builtin_amdgcn_readfirstlane(ts4); \
            ts5 = __builtin_amdgcn_readfirstlane(ts5); ts6 = __builtin_amdgcn_readfirstlane(ts6); ts7 = __builtin_amdgcn_readfirstlane(ts7); ts8 = __builtin_amdgcn_readfirstlane(ts8); } (void)ts0; (void)ts8
        PHASE_REP(7) if (IN(pb + 7)) {
            if (!moe) {
                PH_CTX();
                pg8::StaticOrder S; S.init(WSP(bf16_t, WS_H), WSP(unsigned char, WS_FGU) + (size_t)(l >> 1) * 2 * DFF * DM, DM / 2, nrows, 2 * DFF, G, bid);
                pg8::EpiSwiglu E{WSP(bf16_t, WS_ACT), DFF, 1.f / MGU_SCALE, 1.f};
                pg8::gemm_phase<pg8::EpiSwiglu, pg8::StaticOrder, true>(lds, DM / 2, S, E, tid);
            } else {
                PH_CTX();
                MOE_TS();
                pg8::MoeOrder S; S.A = (const char*)WSP(bf16_t, WS_XB); S.Bt = (const char*)WSP(unsigned char, WS_MGU) + (size_t)(l >> 1) * 8 * 2 * DEXP * DM; S.K = DM / 2; S.N = 2 * DEXP;     S.nN = 2 * DEXP / 256; S.ntile = ts8; S.G = G; S.c = bid;
                S.ts1 = ts1; S.ts2 = ts2; S.ts3 = ts3; S.ts4 = ts4; S.ts5 = ts5; S.ts6 = ts6; S.ts7 = ts7;
                pg8::EpiSwigluT<true> E{WSP(bf16_t, WS_ACT), DEXP, 1.f / MGU_SCALE, ACT_SCALE};
                pg8::gemm_phase<pg8::EpiSwigluT<true>, pg8::MoeOrder, true>(lds, DM / 2, S, E, tid);
            }
            SEAM(pb + 7);
        }
        PHASE_REP(8) if (IN(pb + 8)) {
            if (!moe) {
                PH_CTX();
                const float* modl = WSP(float, WS_MODS) + (size_t)(l * 2 + 0) * 6144;
                int tp, sp; pg8::tail_params(nrows / 256, 4, DFF / 64, G, tp, sp);
                pg8::TailOrder S; S.dense(WSP(bf16_t, WS_ACT), WSP(bf16_t, WS_FDN) + (size_t)(l >> 1) * DM * DFF, DFF, DM, nrows / 256, G, bid, tp, sp);
                pg8::EpiResid E{WSP(bf16_t, WS_Y), modl + 5 * 1024, modl + 6144 + 5 * 1024, WSP(float, WS_YP), nrows - tp * 256, tp * 256};
                pg8::gemm_phase<pg8::EpiResid, pg8::TailOrder>(lds, DFF, S, E, tid);
            } else {
                PH_CTX();
                MOE_TS();
                int tp, sp; pg8::tail_params(ts8, 4, DEXP / 128, G, tp, sp);
                pg8::TailOrder S; S.dense(WSP(bf16_t, WS_ACT), WSP(unsigned char, WS_MDN) + (size_t)(l >> 1) * 8 * DM * DEXP, DEXP / 2, DM, ts8, G, bid, tp, sp);
                S.ts1 = ts1; S.ts2 = ts2; S.ts3 = ts3; S.ts4 = ts4; S.ts5 = ts5; S.ts6 = ts6; S.ts7 = ts7;
                pg8::EpiRaw E{WSP(bf16_t, WS_YS), WSP(float, WS_YP), (ts8 - tp) * 256, tp * 256, 1.f / (MDN_SCALE * ACT_SCALE)};
                pg8::gemm_phase<pg8::EpiRaw, pg8::TailOrder, true>(lds, DEXP / 2, S, E, tid);
            }
            SEAM(pb + 8);
        }
        if (IN(pb + 9)) {
#define BF4(u_) ((f32x4){__uint_as_float((u_).x << 16), __uint_as_float((u_).x & 0xffff0000u), __uint_as_float((u_).y << 16), __uint_as_float((u_).y & 0xffff0000u)})
#define LN2_TAIL(v_, r_, wch_) do { ln16(v_, lw, lb, lane); \
                if (lastl) { _Pragma("unroll") for (int j = 0; j < 4; ++j) *(f32x4*)(ap->out + (size_t)(r_) * DM + 4 * lane + 256 * j) = v_[j]; } \
                else { _Pragma("unroll") for (int j = 0; j < 4; ++j) *(f32x4*)(X + (size_t)(r_) * DM + 4 * lane + 256 * j) = v_[j]; \
                       const float* mdn = modl + 2 * 6144 + (wch_) * 6144; mod_store(v_, mdn, mdn + 1024, H + (size_t)(r_) * DM, lane); } } while (0)
            if (!moe) {
                PH_CTX();
                float* X = WSP(float, WS_X); bf16_t* H = WSP(bf16_t, WS_H); const bf16_t* Yb = WSP(bf16_t, WS_Y); const float* YP = WSP(float, WS_YP);
                const float* modl = WSP(float, WS_MODS) + (size_t)(l * 2 + 0) * 6144;
                const float* lw = ap->in[14] + (size_t)(l * 2 + 1) * DM; const float* lb = ap->in[15] + (size_t)(l * 2 + 1) * DM;
                int tp, sp; pg8::tail_params(nrows / 256, 4, DFF / 64, G, tp, sp); const int tail0 = nrows - tp * 256;
#define LN2_LD(r_, XR, Y0) do { const int rr_ = (r_); _Pragma("unroll") for (int j = 0; j < 4; ++j) { XR[j] = *(const f32x4*)(X + (size_t)rr_ * DM + 4 * lane + 256 * j); Y0[j] = *(const uint2*)(Yb + (size_t)rr_ * DM + 4 * lane + 256 * j); } } while (0)
                auto row = [&](const int r, const f32x4 (&xr)[4], const uint2 (&y0r)[4]) __attribute__((always_inline)) {
                    const int wch = r >= SEQ; const float* md = modl + wch * 6144;
                    f32x4 v[4];
                    if (r < tail0) {
#pragma unroll
                        for (int j = 0; j < 4; ++j) v[j] = xr[j] * ALPHA + BF4(y0r[j]);
                    } else {
                        f32x4 a4[4]; sum_partials(a4, YP + (size_t)(r - tail0) * DM + 4 * lane, sp, (size_t)tp * 256 * DM);
#pragma unroll
                        for (int j = 0; j < 4; ++j) { const int c = 4 * lane + 256 * j; v[j] = xr[j] * ALPHA + *(const f32x4*)(md + 5 * 1024 + c) * a4[j]; }
                    }
                    LN2_TAIL(v, r, wch);
                };
                int r = gw;
                if (r < nrows) { f32x4 xa[4], xb[4]; uint2 ya[4], yb[4]; LN2_LD(r, xa, ya);
                  for (;;) { const int r1 = r + NGW; const bool h1 = r1 < nrows; LN2_LD(h1 ? r1 : r, xb, yb); row(r, xa, ya); if (!h1) break;
                             const int r2 = r1 + NGW; const bool h2 = r2 < nrows; LN2_LD(h2 ? r2 : r1, xa, ya); row(r1, xb, yb); if (!h2) break; r = r2; } }
#undef LN2_LD
            } else {
                PH_CTX();
                float* X = WSP(float, WS_X); bf16_t* H = WSP(bf16_t, WS_H); const bf16_t* YS = WSP(bf16_t, WS_YS); const bf16_t* YPb = WSP(bf16_t, WS_YP);
                const float* modl = WSP(float, WS_MODS) + (size_t)(l * 2 + 0) * 6144;
                const float* lw = ap->in[14] + (size_t)(l * 2 + 1) * DM; const float* lb = ap->in[15] + (size_t)(l * 2 + 1) * DM;
                MOE_TS();
                int tp, sp; pg8::tail_params(ts8, 4, DEXP / 128, G, tp, sp); const int tail0 = (ts8 - tp) * 256;
#define LN2_LD(r_, XR, Y0, Y1, S0, S1, W0, W1) do { const int rr_ = (r_); const int2 mE = WSP(int2, WS_TOKE)[rr_], mP = WSP(int2, WS_TOKP)[rr_]; const float2 mW = WSP(float2, WS_TOKW)[rr_]; \
                    S0 = 256 * (mE.x == 0 ? ts0 : mE.x == 1 ? ts1 : mE.x == 2 ? ts2 : mE.x == 3 ? ts3 : mE.x == 4 ? ts4 : mE.x == 5 ? ts5 : mE.x == 6 ? ts6 : ts7) + mP.x; \
                    S1 = 256 * (mE.y == 0 ? ts0 : mE.y == 1 ? ts1 : mE.y == 2 ? ts2 : mE.y == 3 ? ts3 : mE.y == 4 ? ts4 : mE.y == 5 ? ts5 : mE.y == 6 ? ts6 : ts7) + mP.y; W0 = mW.x; W1 = mW.y; \
                    const bf16_t* b0_ = YS + (size_t)(S0 < tail0 ? S0 : 0) * DM; const bf16_t* b1_ = YS + (size_t)(S1 < tail0 ? S1 : 0) * DM;     \
                    _Pragma("unroll") for (int j = 0; j < 4; ++j) { XR[j] = *(const f32x4*)(X + (size_t)rr_ * DM + 4 * lane + 256 * j); Y0[j] = *(const uint2*)(b0_ + 4 * lane + 256 * j); Y1[j] = *(const uint2*)(b1_ + 4 * lane + 256 * j); } } while (0)
                auto row = [&](const int r, const f32x4 (&xr)[4], const uint2 (&y0r)[4], const uint2 (&y1r)[4], const int s0, const int s1, const float w0, const float w1) __attribute__((always_inline)) {
                    const int wch = r >= SEQ; const float* md = modl + wch * 6144;
                    f32x4 v[4], y0[4], y1[4];
                    if (s0 < tail0) {
#pragma unroll
                        for (int j = 0; j < 4; ++j) y0[j] = BF4(y0r[j]);
                    } else sum_partials_bf(y0, YPb + (size_t)(s0 - tail0) * DM + 4 * lane, sp, (size_t)tp * 256 * DM);
                    if (s1 < tail0) {
#pragma unroll
                        for (int j = 0; j < 4; ++j) y1[j] = BF4(y1r[j]);
                    } else sum_partials_bf(y1, YPb + (size_t)(s1 - tail0) * DM + 4 * lane, sp, (size_t)tp * 256 * DM);
#pragma unroll
                    for (int j = 0; j < 4; ++j) { const int c = 4 * lane + 256 * j; const f32x4 g5 = *(const f32x4*)(md + 5 * 1024 + c); v[j] = xr[j] * ALPHA + g5 * (y0[j] * w0 + y1[j] * w1); }
                    LN2_TAIL(v, r, wch);
                };
                int r = gw;
                if (r < nrows) { f32x4 xa[4], xb[4]; uint2 y0a[4], y1a[4], y0b[4], y1b[4]; int s0a, s1a, s0b, s1b; float w0a, w1a, w0b, w1b;
                  LN2_LD(r, xa, y0a, y1a, s0a, s1a, w0a, w1a);
                  for (;;) { const int r1 = r + NGW; const bool h1 = r1 < nrows; LN2_LD(h1 ? r1 : r, xb, y0b, y1b, s0b, s1b, w0b, w1b); row(r, xa, y0a, y1a, s0a, s1a, w0a, w1a); if (!h1) break;
                             const int r2 = r1 + NGW; const bool h2 = r2 < nrows; LN2_LD(h2 ? r2 : r1, xa, y0a, y1a, s0a, s1a, w0a, w1a); row(r1, xb, y0b, y1b, s0b, s1b, w0b, w1b); if (!h2) break; r = r2; } }
#undef LN2_LD
            }
#undef LN2_TAIL
#undef BF4
            SEAM(pb + 9);
        }
    }
#undef IN
#undef SEAM
}

extern "C" void kernel_launch(void* const* d_in, const int* in_sizes, int n_in, void* d_out, int out_size, void* d_ws, size_t ws_size, hipStream_t stream) {
    static int grid = 0;
    if (grid == 0) {
        if (n_in != 22 || ws_size < WS_END) { fprintf(stderr, "kernel_launch: unexpected n_in %d / ws %zu (need %zu)\n", n_in, ws_size, (size_t)WS_END); grid = -1; return; }
        int dev = 0, cus = 0;
        if (hipGetDevice(&dev) != hipSuccess || hipDeviceGetAttribute(&cus, hipDeviceAttributeMultiprocessorCount, dev) != hipSuccess) { grid = -1; return; }
        if (hipFuncSetAttribute((const void*)fwd, hipFuncAttributeMaxDynamicSharedMemorySize, LDS_BYTES) != hipSuccess) { fprintf(stderr, "kernel_launch: hipFuncSetAttribute failed\n"); grid = -1; return; }
        int per_cu = 0;
        if (hipOccupancyMaxActiveBlocksPerMultiprocessor(&per_cu, (const void*)fwd, 512, LDS_BYTES) != hipSuccess || per_cu < 1) fprintf(stderr, "kernel_launch: occupancy query reports %d\n", per_cu);
        (void)hipGetLastError();
        grid = cus;
    }
    if (grid < 0) return;
    (void)hipMemsetAsync((char*)d_ws + WS_CTL, 0, CTL_BYTES, stream);
    Args a{};
    for (int i = 0; i < 22; ++i) a.in[i] = (const float*)d_in[i];
    a.out = (float*)d_out; a.ws = (unsigned char*)d_ws;
#if MK_ONE_LAUNCH
    a.ph_lo = 0; a.ph_hi = NPH;
    hipLaunchKernelGGL(fwd, dim3(grid), dim3(512), LDS_BYTES, stream, a);
#else
    for (int p = 0; p < NPH; ++p) {
        if (p >= 2 && ((p - 2) % 10) == 6 && ((((p - 2) / 10) & 1) == 0)) continue;
        a.ph_lo = p; a.ph_hi = p + 1;
        hipLaunchKernelGGL(fwd, dim3(grid), dim3(512), LDS_BYTES, stream, a);
    }
#endif
}
```

```cpp
#include <hip/hip_runtime.h>
#include <cstdio>
#include <cstdint>

#ifndef MK_ONE_LAUNCH
#define MK_ONE_LAUNCH 1
#endif

#ifndef DUP_MASK
#define DUP_MASK 0
#endif
#define PHASE_REP(k) for (int rep_ = 0; rep_ < 1 + ((DUP_MASK >> (k)) & 1); ++rep_)
#define LAS __attribute__((address_space(3)))
#define GAS __attribute__((address_space(1)))
typedef unsigned short bf16_t;
typedef short bf16x8 __attribute__((ext_vector_type(8)));
typedef float f32x4 __attribute__((ext_vector_type(4)));
typedef unsigned u32x4 __attribute__((ext_vector_type(4)));
typedef unsigned u32x2_t __attribute__((ext_vector_type(2)));

constexpr int DM = 1024, SEQ = 16384, NCTX = 256, TT = SEQ + NCTX, DEPTH = 4;
constexpr int IN_COLS = 2608, NPIN = 2816, LDP = 2816;
constexpr int C_MQ = 0, C_MK = 256, C_MV = 512, C_MO = 768, C_AQ = 1024, C_AK = 1536, C_AV = 1664, C_GQ = 1792, C_GK = 1920, C_GV = 2048, C_GG = 2304, C_MG = 2560, C_GGT = 2576, C_END = 2608;
constexpr int DFF = 2816, DEXP = 3584, NEXP = 8;
constexpr int NCH = 260;
constexpr int NSLOT = 138 * 256;
constexpr float ALPHA = 1.6817928305074290f;
constexpr float LN_EPS = 1e-5f;
constexpr float MGU_SCALE = 32.f, MDN_SCALE = 256.f, ACT_SCALE = 4.f;
constexpr int NPH = 2 + 10 * DEPTH;

constexpr size_t al256(size_t x) { return (x + 255) & ~size_t(255); }
constexpr size_t WS_CTL = 0, CTL_BYTES = 2u << 20;
constexpr size_t WS_MODS = 1u << 20;
constexpr size_t WS_ROPE = CTL_BYTES;
constexpr size_t WS_TOKE = WS_ROPE + 32768;
constexpr size_t WS_TOKP = WS_TOKE + al256((size_t)TT * 8);
constexpr size_t WS_TOKW = WS_TOKP + al256((size_t)TT * 8);
constexpr size_t WS_TOKS = WS_TOKW + al256((size_t)TT * 8);
constexpr size_t WS_WIN = WS_TOKS + al256((size_t)TT * 8);
constexpr size_t WS_WOUT = WS_WIN + (size_t)DEPTH * NPIN * DM * 2;
constexpr size_t WS_FGU = WS_WOUT + (size_t)DEPTH * DM * DM * 2;
constexpr size_t WS_FDN = WS_FGU + (size_t)2 * 2 * DFF * DM * 2;
constexpr size_t WS_MGU = WS_FDN + (size_t)2 * DM * DFF * 2;
constexpr size_t WS_MDN = WS_MGU + (size_t)16 * 2 * DEXP * DM * 2;
constexpr size_t WS_X = WS_MDN + (size_t)16 * DM * DEXP * 2;
constexpr size_t WS_H = WS_X + (size_t)TT * DM * 4;
constexpr size_t WS_P = WS_H + (size_t)TT * DM * 2;
constexpr size_t WS_G = WS_P + (size_t)TT * LDP * 2;
constexpr size_t WS_CAT = WS_G + al256((size_t)TT * 48 * 4);
constexpr size_t WS_Y = WS_CAT + (size_t)TT * DM * 2;
constexpr size_t WS_ACT = WS_Y + (size_t)TT * DM * 4;
constexpr size_t WS_XB = WS_ACT + (size_t)NSLOT * DEXP * 2;
constexpr size_t WS_YS = WS_XB + (size_t)NEXP * TT * DM * 2;
constexpr size_t WS_MU = WS_YS + (size_t)NSLOT * DM * 4;
constexpr size_t WS_MC = WS_MU + (size_t)8 * NCH * 4096 * 4;
constexpr size_t WS_MNU = WS_MC + (size_t)8 * NCH * 4096 * 4;
constexpr size_t WS_MNS = WS_MNU + (size_t)8 * NCH * 64 * 4;
constexpr size_t WS_MSC = WS_MNS + (size_t)8 * NCH * 64 * 4;
constexpr size_t WS_GU = WS_MSC + al256((size_t)8 * NCH * 4 * 4);
constexpr size_t WS_GS = WS_GU + (size_t)8 * NCH * 2048 * 4;
constexpr size_t WS_GDEC = WS_GS + (size_t)8 * NCH * 2048 * 4;
constexpr size_t WS_YP = WS_GDEC + (size_t)8 * NCH * 32 * 4;
constexpr size_t WS_END = WS_YP + (size_t)256 * 256 * 256 * 4;

constexpr int CW_BAR = 4096;
constexpr int CW_MOE = 16384;

constexpr int LDS_BYTES = 147456, MISC_OFF = 147200;

__device__ __forceinline__ float bf2f(unsigned v) { return __uint_as_float(v << 16); }
__device__ __forceinline__ unsigned f2bf(float f) { unsigned u = __float_as_uint(f); return (u + 0x7fffu + ((u >> 16) & 1u)) >> 16; }
__device__ __forceinline__ unsigned pk2(float lo, float hi) { return f2bf(lo) | (f2bf(hi) << 16); }
__device__ __forceinline__ void load8bf(const bf16_t* p, float* o) {
    const uint4 v = *(const uint4*)p;
    o[0] = __uint_as_float(v.x << 16); o[1] = __uint_as_float(v.x & 0xffff0000u); o[2] = __uint_as_float(v.y << 16); o[3] = __uint_as_float(v.y & 0xffff0000u);
    o[4] = __uint_as_float(v.z << 16); o[5] = __uint_as_float(v.z & 0xffff0000u); o[6] = __uint_as_float(v.w << 16); o[7] = __uint_as_float(v.w & 0xffff0000u);
}
__device__ __forceinline__ float wave_sum(float v) {
#pragma unroll
    for (int o = 1; o < 64; o <<= 1) v += __shfl_xor(v, o);
    return v;
}
__device__ __forceinline__ float wave_max(float v) {
#pragma unroll
    for (int o = 1; o < 64; o <<= 1) v = fmaxf(v, __shfl_xor(v, o));
    return v;
}
template <int CTRL, int RM> __device__ __forceinline__ float dpp_mov(float old, float v) {
    return __uint_as_float(__builtin_amdgcn_update_dpp(__float_as_uint(old), __float_as_uint(v), CTRL, RM, 0xF, false)); }
__device__ __forceinline__ float scan_add(float v, int) {
    v += dpp_mov<0x111, 0xF>(0.f, v); v += dpp_mov<0x112, 0xF>(0.f, v); v += dpp_mov<0x114, 0xF>(0.f, v); v += dpp_mov<0x118, 0xF>(0.f, v);
    v += dpp_mov<0x142, 0xA>(0.f, v); v += dpp_mov<0x143, 0xC>(0.f, v);
    return v;
}
__device__ __forceinline__ float scan_max(float v, int) {
    v = fmaxf(v, dpp_mov<0x111, 0xF>(-INFINITY, v)); v = fmaxf(v, dpp_mov<0x112, 0xF>(-INFINITY, v)); v = fmaxf(v, dpp_mov<0x114, 0xF>(-INFINITY, v)); v = fmaxf(v, dpp_mov<0x118, 0xF>(-INFINITY, v));
    v = fmaxf(v, dpp_mov<0x142, 0xA>(-INFINITY, v)); v = fmaxf(v, dpp_mov<0x143, 0xC>(-INFINITY, v));
    return v;
}
__device__ __forceinline__ float siluf(float x) { return x * __builtin_amdgcn_rcpf(1.f + __expf(-x)); }
__device__ __forceinline__ float sigmoidf_(float x) { return __builtin_amdgcn_rcpf(1.f + __expf(-x)); }
__device__ __forceinline__ float log_sigmoidf_(float x) {
    const float t = __expf(-fabsf(x)); const float l1p = (t < 0.01f) ? t * (1.f + t * (-0.5f + t * 0.33333333f)) : __logf(1.f + t); return fminf(x, 0.f) - l1p; }
typedef short s16x4 __attribute__((ext_vector_type(4)));
typedef short v4i16_t __attribute__((ext_vector_type(4)));
typedef float f32x2_t __attribute__((ext_vector_type(2))); typedef __bf16 bf16x2_t __attribute__((ext_vector_type(2)));
__device__ __forceinline__ unsigned cvtpk(float lo, float hi) { f32x2_t v = {lo, hi}; bf16x2_t b = __builtin_convertvector(v, bf16x2_t); return __builtin_bit_cast(unsigned, b); }
__device__ __forceinline__ s16x4 ds_tr16(const LAS unsigned char* p) { return __builtin_bit_cast(s16x4, __builtin_amdgcn_ds_read_tr16_b64_v4i16((LAS v4i16_t*)p)); }
__device__ __forceinline__ bf16x8 cat44(s16x4 a, s16x4 b) { return __builtin_shufflevector(a, b, 0, 1, 2, 3, 4, 5, 6, 7); }
#define MFMA16(a, b, c) __builtin_amdgcn_mfma_f32_16x16x32_bf16(a, b, c, 0, 0, 0)
__device__ __forceinline__ float grp_max(float v) {
    const auto a = __builtin_amdgcn_permlane16_swap(__float_as_uint(v), __float_as_uint(v), false, false); v = fmaxf(__uint_as_float(a[0]), __uint_as_float(a[1]));
    const auto b = __builtin_amdgcn_permlane32_swap(__float_as_uint(v), __float_as_uint(v), false, false); return fmaxf(__uint_as_float(b[0]), __uint_as_float(b[1])); }
__device__ __forceinline__ float grp_sum(float v) {
    const auto a = __builtin_amdgcn_permlane16_swap(__float_as_uint(v), __float_as_uint(v), false, false); v = __uint_as_float(a[0]) + __uint_as_float(a[1]);
    const auto b = __builtin_amdgcn_permlane32_swap(__float_as_uint(v), __float_as_uint(v), false, false); return __uint_as_float(b[0]) + __uint_as_float(b[1]); }
__device__ __forceinline__ unsigned pk4_fp8(float a, float b, float c, float d) { int w = 0; w = __builtin_amdgcn_cvt_pk_fp8_f32(a, b, w, false); w = __builtin_amdgcn_cvt_pk_fp8_f32(c, d, w, true); return (unsigned)w; }
#define LDS_WAIT() asm volatile("s_waitcnt lgkmcnt(0)" ::: "memory")

namespace pg8 {
constexpr int BM = 256, BK = 64, HALF = 128, HTB = HALF * BK * 2, STAGE_BYTES = 8 * HTB, NXCD = 8, WGM = 8;
__host__ __device__ __forceinline__ int lds_byte(int r, int c) { const int st = (r >> 4) * 2 + (c >> 5), rr = r & 15, cc = c & 31, ob = rr * 64 + cc * 2; return st * 1024 + (ob ^ (((ob >> 9) & 1) << 5)); }
__host__ __device__ __forceinline__ void stage_rc(int b, int& R, int& C) { const int st = b / 1024, sb = b % 1024, swz = sb ^ (((sb >> 9) & 1) << 5); R = (st >> 1) * 16 + swz / 64; C = (st & 1) * 32 + (swz % 64) / 2; }
__host__ __device__ __forceinline__ int perm32(int rho) { const int n = rho >> 4, i = rho & 15; return 8 * (i >> 2) + 4 * n + (i & 3); }
struct Unit { int pm, pn, kt0, nkt, part; };

struct StaticOrder {
    const char* A; const char* Bt; int K;
    int nM, nN, nwg, G, c;
    __device__ void init(const void* A_, const void* Bt_, int K_, int M, int N, int G_, int c_) { A = (const char*)A_; Bt = (const char*)Bt_; K = K_; nM = M / BM; nN = N / BM; nwg = nM * nN; G = G_; c = c_; }
    __device__ __forceinline__ bool next(int i, Unit& u) const {
        const long L = (long)i * G + c; if (L >= nwg) return false;
        int wgid = (int)L; { const int q = nwg / NXCD, r = nwg % NXCD, xcd = wgid % NXCD, off = wgid / NXCD; wgid = (xcd < r ? xcd * (q + 1) : r * (q + 1) + (xcd - r) * q) + off; }
        const int nig = WGM * nN, gid = wgid / nig, fm = gid * WGM, gsz = (nM - fm) < WGM ? (nM - fm) : WGM;
        u.pm = fm + ((wgid % nig) % gsz); u.pn = (wgid % nig) / gsz; u.kt0 = 0; u.nkt = K / BK; u.part = -1; return true;
    }
    __device__ __forceinline__ unsigned aoff(const Unit& u) const { return (unsigned)(u.pm * BM * K * 2); }
    __device__ __forceinline__ unsigned boff(const Unit& u) const { return (unsigned)(u.pn * BM * K * 2); }
};
struct MoeOrder {
    const char* A; const char* Bt; int K, N, nN, ntile, G, c;
    int ts1, ts2, ts3, ts4, ts5, ts6, ts7;
    __device__ __forceinline__ bool next(int i, Unit& u) const {
        const int nwg = ntile * nN; const long L = (long)i * G + c; if (L >= nwg) return false;
        int wgid = (int)L; { const int q = nwg / NXCD, r = nwg % NXCD, xcd = wgid % NXCD, off = wgid / NXCD; wgid = (xcd < r ? xcd * (q + 1) : r * (q + 1) + (xcd - r) * q) + off; }
        const int nig = WGM * nN, gid = wgid / nig, fm = gid * WGM, gsz = (ntile - fm) < WGM ? (ntile - fm) : WGM;
        u.pm = fm + ((wgid % nig) % gsz); u.pn = (wgid % nig) / gsz; u.kt0 = 0; u.nkt = K / BK; u.part = -1; return true;
    }
    __device__ __forceinline__ int expert(int pm) const { return (pm >= ts1) + (pm >= ts2) + (pm >= ts3) + (pm >= ts4) + (pm >= ts5) + (pm >= ts6) + (pm >= ts7); }
    __device__ __forceinline__ unsigned aoff(const Unit& u) const {
        const int e = expert(u.pm); const int t0 = e == 0 ? 0 : e == 1 ? ts1 : e == 2 ? ts2 : e == 3 ? ts3 : e == 4 ? ts4 : e == 5 ? ts5 : e == 6 ? ts6 : ts7;
        return (unsigned)((e * TT + (u.pm - t0) * BM) * K * 2); }
    __device__ __forceinline__ unsigned boff(const Unit& u) const { return (unsigned)((expert(u.pm) * N + u.pn * BM) * K * 2); }
};
struct TailOrder {
    const char* A; const char* Bt; int K, N, nN, npan, G, c, tp, s;
    int ts1, ts2, ts3, ts4, ts5, ts6, ts7;
    __device__ __forceinline__ void dense(const void* A_, const void* Bt_, int K_, int N_, int npan_, int G_, int c_, int tp_, int s_) {
        A = (const char*)A_; Bt = (const char*)Bt_; K = K_; N = N_; nN = N_ / BM; npan = npan_; G = G_; tp = tp_; s = s_;
        c = (G_ % NXCD) == 0 ? (c_ % NXCD) * (G_ / NXCD) + c_ / NXCD : c_;
        ts1 = ts2 = ts3 = ts4 = ts5 = ts6 = ts7 = 0x7fffffff; }
    __device__ __forceinline__ bool next(int i, Unit& u) const {
        const int L = i * G + c, nfull = (npan - tp) * nN, ksub = (K / BK) / s;
        const bool tail = L >= nfull; const int j = L - nfull, tu = tp * nN, tu1 = tu > 0 ? tu : 1;
        const int part = tail ? j / tu1 : -1, r = tail ? j % tu1 : 0;
        u.part = part; u.pm = tail ? (npan - tp) + r / nN : L / nN; u.pn = tail ? r % nN : L % nN; u.kt0 = tail ? part * ksub : 0; u.nkt = tail ? ksub : K / BK;
        return tail ? (j < tu * s) : true;
    }
    __device__ __forceinline__ int expert(int pm) const { return (pm >= ts1) + (pm >= ts2) + (pm >= ts3) + (pm >= ts4) + (pm >= ts5) + (pm >= ts6) + (pm >= ts7); }
    __device__ __forceinline__ unsigned aoff(const Unit& u) const { return (unsigned)((u.pm * BM * K + u.kt0 * BK) * 2); }
    __device__ __forceinline__ unsigned boff(const Unit& u) const { return (unsigned)((((expert(u.pm) * N + u.pn * BM) * K) + u.kt0 * BK) * 2); }
};
__device__ __forceinline__ void tail_params(int npan, int nN, int nkt, int G, int& tp, int& s) {
    const int rem = (npan * nN) % G;
    tp = 0; s = 1;
    if (rem == 0 || (rem % nN) != 0) return;
    int best = 1;
    if (nkt == 16) { if (rem * 4 <= G) best = 4; else if (rem * 2 <= G) best = 2; }
    else if (nkt == 44) { if (rem * 11 <= G) best = 11; else if (rem * 2 <= G) best = 2; }
    else if (nkt == 28) { if (rem * 7 <= G) best = 7; else if (rem * 2 <= G) best = 2; }
    else if (nkt == 56) { if (rem * 14 <= G) best = 14; else if (rem * 7 <= G) best = 7; else if (rem * 4 <= G) best = 4; else if (rem * 2 <= G) best = 2; }
    if (best > 1) { tp = rem / nN; s = best; }
}

typedef int v8i32 __attribute__((ext_vector_type(8)));
typedef int i32x4 __attribute__((ext_vector_type(4)));
template <class E, class = void> struct epi_nst { static constexpr int value = 0; };
template <class E> struct epi_nst<E, decltype((void)E::NST)> { static constexpr int value = E::NST; };
template <class Epi, class Sched, bool F8 = false>
__device__ __forceinline__ void gemm_phase(LAS unsigned char* lds, const int K, const Sched& S, const Epi& E, const int tid) {
    const int wid = __builtin_amdgcn_readfirstlane(tid >> 6), lane = tid & 63, wr = wid >> 2, wc = wid & 3, fr = lane & 15, fq = lane >> 4;
    unsigned voffA[2], voffB[2];
#pragma unroll
    for (int i = 0; i < 2; ++i) { int R, C; stage_rc(tid * 16 + i * 8192, R, C); const int Rb = Epi::PERM ? ((R & ~31) + perm32(R & 31)) : R;
        voffA[i] = (unsigned)(R * K + C) * 2u; voffB[i] = (unsigned)(Rb * K + C) * 2u; }
    const unsigned kstep = (unsigned)(BK * 2);
    const unsigned hstep = (unsigned)(HALF * K * 2);
    const __amdgpu_buffer_rsrc_t rA = __builtin_amdgcn_make_buffer_rsrc((void*)S.A, 0, 0x7ffffff0, 0x00020000), rB = __builtin_amdgcn_make_buffer_rsrc((void*)S.Bt, 0, 0x7ffffff0, 0x00020000);
    const unsigned ldsw = (unsigned)wid * 1024u;
    const int aoff = lds_byte(wr * 64 + fr, fq * 8), boff = lds_byte(wc * 32 + fr, fq * 8);
#define PG8_SA(b, h) (((b) * 2 + (h)) * HTB)
#define PG8_SB(b, h) ((4 + (b) * 2 + (h)) * HTB)
#define PG8_STAGE(bufoff, rs, soff, voff) do { _Pragma("unroll") for (int _i = 0; _i < 2; ++_i) \
        __builtin_amdgcn_raw_ptr_buffer_load_lds(rs, (LAS void*)(lds + (bufoff) + ldsw + _i * 8192), 16, (int)(voff)[_i], (int)(soff), 0, 0); } while (0)
#define PG8_LDA(dst, b, h) do { _Pragma("unroll") for (int m = 0; m < 4; ++m) { const i32x4 lo_ = *(const LAS i32x4*)(lds + PG8_SA(b, h) + aoff + m * 2048), hi_ = *(const LAS i32x4*)(lds + PG8_SA(b, h) + aoff + m * 2048 + 1024); \
        dst[m] = (v8i32){lo_[0], lo_[1], lo_[2], lo_[3], hi_[0], hi_[1], hi_[2], hi_[3]}; } } while (0)
#define PG8_LDB(dst, b, h) do { _Pragma("unroll") for (int n = 0; n < 2; ++n) { const i32x4 lo_ = *(const LAS i32x4*)(lds + PG8_SB(b, h) + boff + n * 2048), hi_ = *(const LAS i32x4*)(lds + PG8_SB(b, h) + boff + n * 2048 + 1024); \
        dst[n] = (v8i32){lo_[0], lo_[1], lo_[2], lo_[3], hi_[0], hi_[1], hi_[2], hi_[3]}; } } while (0)
#define PG8_LO(v) __builtin_bit_cast(bf16x8, __builtin_shufflevector(v, v, 0, 1, 2, 3))
#define PG8_HI(v) __builtin_bit_cast(bf16x8, __builtin_shufflevector(v, v, 4, 5, 6, 7))
#define PG8_MMA(ai, bj, At, Bt) do { __builtin_amdgcn_s_setprio(1); _Pragma("unroll") for (int m = 0; m < 4; ++m) _Pragma("unroll") for (int n = 0; n < 2; ++n) { \
        if constexpr (F8) acc[ai][bj][m][n] = __builtin_amdgcn_mfma_scale_f32_16x16x128_f8f6f4(Bt[n], At[m], acc[ai][bj][m][n], 0, 0, 0, 0x7f7f7f7f, 0, 0x7f7f7f7f); \
        else { acc[ai][bj][m][n] = __builtin_amdgcn_mfma_f32_16x16x32_bf16(PG8_LO(Bt[n]), PG8_LO(At[m]), acc[ai][bj][m][n], 0, 0, 0); \
               acc[ai][bj][m][n] = __builtin_amdgcn_mfma_f32_16x16x32_bf16(PG8_HI(Bt[n]), PG8_HI(At[m]), acc[ai][bj][m][n], 0, 0, 0); } } \
        __builtin_amdgcn_s_setprio(0); } while (0)
#define PG8_WAIT_V(n) asm volatile("s_waitcnt vmcnt(" #n ")" ::: "memory")
#define PG8_WAIT_L(n) asm volatile("s_waitcnt lgkmcnt(" #n ")" ::: "memory")
#define PG8_WAIT_VF(n, nf) do { if constexpr (epi_nst<Epi>::value == 8) asm volatile("s_cmp_lg_u32 %0, 0\n\ts_cbranch_scc1 .LPG8W_%=\n\ts_waitcnt vmcnt(" #n ")\n.LPG8W_%=:\n\ts_waitcnt vmcnt(" #nf ")" :: "s"(__builtin_amdgcn_readfirstlane(first)) : "memory", "scc"); else asm volatile("s_waitcnt vmcnt(" #n ")" ::: "memory"); } while (0)
#define PG8_BAR __builtin_amdgcn_s_barrier()
#define PG8_SCHED __builtin_amdgcn_sched_barrier(0)
    Unit cur, nxt; int ui = 0;
    if (!S.next(0, cur)) return;
    f32x4 acc[2][2][4][2];
#pragma unroll
    for (int a = 0; a < 2; ++a)
#pragma unroll
        for (int b = 0; b < 2; ++b)
#pragma unroll
            for (int m = 0; m < 4; ++m)
#pragma unroll
                for (int n = 0; n < 2; ++n) acc[a][b][m][n] = (f32x4){0.f, 0.f, 0.f, 0.f};
    v8i32 At[4], B0[2], B1[2];
    unsigned cA = S.aoff(cur), cB = S.boff(cur);
    PG8_STAGE(PG8_SB(0, 0), rB, cB, voffB); PG8_STAGE(PG8_SB(0, 1), rB, cB + hstep, voffB); PG8_STAGE(PG8_SA(0, 0), rA, cA, voffA); PG8_STAGE(PG8_SA(0, 1), rA, cA + hstep, voffA);
    if (wr == 1) PG8_BAR;
    PG8_WAIT_V(2); PG8_BAR;
    PG8_STAGE(PG8_SB(1, 0), rB, cB + kstep, voffB); PG8_STAGE(PG8_SA(1, 0), rA, cA + kstep, voffA); PG8_STAGE(PG8_SB(1, 1), rB, cB + hstep + kstep, voffB);
    PG8_WAIT_V(6); PG8_BAR;
    for (;;) {
        const bool has_next = S.next(ui + 1, nxt);
        const unsigned nA = has_next ? S.aoff(nxt) : cA, nB = has_next ? S.boff(nxt) : cB;
        const int nt = cur.nkt;
        for (int t = 0; t < nt; t += 2) {
            const bool last = (t == nt - 2);
            const int first = (epi_nst<Epi>::value == 8 && t == 0 && ui > 0) ? 1 : 0;
            const unsigned a1 = cA + (unsigned)(t + 1) * kstep;
            const unsigned a2 = last ? nA : cA + (unsigned)(t + 2) * kstep, b2 = last ? nB : cB + (unsigned)(t + 2) * kstep;
            const unsigned a3 = a2 + kstep, b3 = b2 + kstep;
            PG8_LDB(B0, 0, 0); PG8_LDB(B1, 0, 1); PG8_SCHED; PG8_LDA(At, 0, 0); PG8_STAGE(PG8_SA(1, 1), rA, a1 + hstep, voffA);
            PG8_WAIT_VF(8, 16); PG8_WAIT_L(0); PG8_BAR; PG8_MMA(0, 0, At, B0); PG8_MMA(0, 1, At, B1); PG8_BAR; PG8_SCHED;
            PG8_LDA(At, 0, 1); PG8_STAGE(PG8_SB(0, 0), rB, b2, voffB); PG8_STAGE(PG8_SB(0, 1), rB, b2 + hstep, voffB); PG8_STAGE(PG8_SA(0, 0), rA, a2, voffA);
            PG8_WAIT_VF(8, 16); PG8_WAIT_L(0); PG8_BAR; PG8_MMA(1, 0, At, B0); PG8_MMA(1, 1, At, B1); PG8_BAR; PG8_SCHED;
            PG8_LDB(B0, 1, 0); PG8_LDB(B1, 1, 1); PG8_SCHED; PG8_LDA(At, 1, 0); PG8_STAGE(PG8_SA(0, 1), rA, a2 + hstep, voffA);
            PG8_WAIT_V(8); PG8_WAIT_L(0); PG8_BAR; PG8_MMA(0, 0, At, B0); PG8_MMA(0, 1, At, B1); PG8_BAR; PG8_SCHED;
            PG8_LDA(At, 1, 1); PG8_STAGE(PG8_SB(1, 0), rB, b3, voffB); PG8_STAGE(PG8_SB(1, 1), rB, b3 + hstep, voffB); PG8_STAGE(PG8_SA(1, 0), rA, a3, voffA);
            PG8_WAIT_V(8); PG8_WAIT_L(0); PG8_BAR; PG8_MMA(1, 0, At, B0); PG8_MMA(1, 1, At, B1); PG8_BAR; PG8_SCHED;
        }
        if (wr == 0) PG8_BAR;
        { unsigned on_ = ~0u; asm volatile("" : "+s"(on_)); const int l2_ = (int)__builtin_amdgcn_mbcnt_hi(on_, __builtin_amdgcn_mbcnt_lo(on_, 0u));
          E(acc, cur, wr, wc, l2_ & 15, l2_ >> 4); }
        if (!has_next) break;
#pragma unroll
        for (int a = 0; a < 2; ++a)
#pragma unroll
            for (int b = 0; b < 2; ++b)
#pragma unroll
                for (int m = 0; m < 4; ++m)
#pragma unroll
                    for (int n = 0; n < 2; ++n) acc[a][b][m][n] = (f32x4){0.f, 0.f, 0.f, 0.f};
        cur = nxt; cA = nA; cB = nB; ++ui;
        if (wr == 1) PG8_BAR;
    }
    PG8_WAIT_V(0);
    PG8_BAR;
#undef PG8_SA
#undef PG8_SB
#undef PG8_STAGE
#undef PG8_LDA
#undef PG8_LDB
#undef PG8_MMA
#undef PG8_WAIT_V
#undef PG8_WAIT_L
#undef PG8_WAIT_VF
#undef PG8_BAR
#undef PG8_SCHED
}


struct EpiInProj {
    static constexpr bool PERM = true;
    bf16_t* P; float* Gt; const float* ropeC; const float* ropeS;
    __device__ __forceinline__ void operator()(const f32x4 (&acc)[2][2][4][2], const Unit& u, int wr, int wc, int fr, int fq) const {
        const int row0 = u.pm * BM + wr * 64 + fr;
        const bool latent = u.pm < (SEQ / BM);
#pragma unroll
        for (int bj = 0; bj < 2; ++bj) {
            const int colg = u.pn * BM + bj * HALF + wc * 32;
            const bool rope = latent && colg >= C_AQ && colg < C_AV;
            const bool gate = colg >= C_MG && colg < C_END;
            const int col0 = colg + 8 * fq;
#pragma unroll
            for (int ai = 0; ai < 2; ++ai)
#pragma unroll
                for (int m = 0; m < 4; ++m) {
                    const int row = row0 + ai * HALF + m * 16;
                    f32x4 v0 = acc[ai][bj][m][0], v1 = acc[ai][bj][m][1];
                    if (rope) {
                        const int pos = ((colg >> 5) & 1) ? (row & 63) : (row >> 6);
                        const f32x4 c0 = *(const f32x4*)(ropeC + pos * 16 + 8 * (fq & 1)), c1 = *(const f32x4*)(ropeC + pos * 16 + 8 * (fq & 1) + 4);
                        const f32x4 s0 = *(const f32x4*)(ropeS + pos * 16 + 8 * (fq & 1)), s1 = *(const f32x4*)(ropeS + pos * 16 + 8 * (fq & 1) + 4);
                        const float sg = (fq < 2) ? -1.f : 1.f;
                        f32x4 p0, p1;
#pragma unroll
                        for (int i = 0; i < 4; ++i) { p0[i] = __shfl_xor(v0[i], 32); p1[i] = __shfl_xor(v1[i], 32); }
#pragma unroll
                        for (int i = 0; i < 4; ++i) { v0[i] = v0[i] * c0[i] + sg * p0[i] * s0[i]; v1[i] = v1[i] * c1[i] + sg * p1[i] * s1[i]; }
                    }
                    u32x4 w; w.x = cvtpk(v0[0], v0[1]); w.y = cvtpk(v0[2], v0[3]); w.z = cvtpk(v1[0], v1[1]); w.w = cvtpk(v1[2], v1[3]);
                    *(u32x4*)(P + (size_t)row * LDP + col0) = w;
                    if (gate && col0 < C_END) { float* g = Gt + (size_t)row * 48 + (col0 - C_MG); *(f32x4*)g = v0; *(f32x4*)(g + 4) = v1; }
                    asm volatile("" ::: "memory");
                }
        }
    }
};
struct EpiResid {
    static constexpr bool PERM = true;
    bf16_t* Yb; const float* modl; const float* modc; float* YP; int tail_row0, tail_rows;
    __device__ __forceinline__ void operator()(const f32x4 (&acc)[2][2][4][2], const Unit& u, int wr, int wc, int fr, int fq) const {
        const int row0 = u.pm * BM + wr * 64 + fr, col0 = u.pn * BM + wc * 32 + 8 * fq;
        if (u.part >= 0) {
#pragma unroll
            for (int ai = 0; ai < 2; ++ai)
#pragma unroll
                for (int m = 0; m < 4; ++m) { float* rowp = YP + ((size_t)u.part * tail_rows + (row0 + ai * HALF + m * 16 - tail_row0)) * DM + col0;
#pragma unroll
                    for (int bj = 0; bj < 2; ++bj)
#pragma unroll
                        for (int n = 0; n < 2; ++n) *(f32x4*)(rowp + bj * HALF + n * 4) = acc[ai][bj][m][n]; }
            return;
        }
        const float* md = (u.pm < SEQ / BM) ? modl : modc;
        f32x4 mv[2][2];
#pragma unroll
        for (int bj = 0; bj < 2; ++bj)
#pragma unroll
            for (int n = 0; n < 2; ++n) mv[bj][n] = *(const f32x4*)(md + col0 + bj * HALF + n * 4);
#pragma unroll
        for (int ai = 0; ai < 2; ++ai)
#pragma unroll
            for (int m = 0; m < 4; ++m) { bf16_t* rowp = Yb + (size_t)(row0 + ai * HALF + m * 16) * DM + col0;
#pragma unroll
                for (int bj = 0; bj < 2; ++bj) { const f32x4 v0 = mv[bj][0] * acc[ai][bj][m][0], v1 = mv[bj][1] * acc[ai][bj][m][1];
                    u32x4 w; w.x = cvtpk(v0[0], v0[1]); w.y = cvtpk(v0[2], v0[3]); w.z = cvtpk(v1[0], v1[1]); w.w = cvtpk(v1[2], v1[3]);
                    *(u32x4*)(rowp + bj * HALF) = w; } }
    }
};
template <bool O8 = false> struct EpiSwigluT {
    static constexpr bool PERM = true;
    static constexpr int NST = 8;
    bf16_t* O; int ld; float sc; float osc;
    __device__ __forceinline__ void operator()(const f32x4 (&acc)[2][2][4][2], const Unit& u, int wr, int wc, int fr, int fq) const {
        const int row0 = u.pm * BM + wr * 64 + fr, col0 = u.pn * HALF + wc * 32 + 8 * fq;
        const float c1 = -sc * 1.44269504f, ic2 = 1.f / (sc * sc * osc);
#pragma unroll
        for (int ai = 0; ai < 2; ++ai)
#pragma unroll
            for (int m = 0; m < 4; ++m) {
                const f32x4 g0 = acc[ai][0][m][0], g1 = acc[ai][0][m][1], u0 = acc[ai][1][m][0], u1 = acc[ai][1][m][1];
                f32x4 e0 = g0 * c1, e1 = g1 * c1;
#pragma unroll
                for (int i = 0; i < 4; ++i) { e0[i] = __builtin_amdgcn_exp2f(e0[i]); e1[i] = __builtin_amdgcn_exp2f(e1[i]); }
                e0 = e0 * ic2 + ic2; e1 = e1 * ic2 + ic2;
#pragma unroll
                for (int i = 0; i < 4; ++i) { e0[i] = __builtin_amdgcn_rcpf(e0[i]); e1[i] = __builtin_amdgcn_rcpf(e1[i]); }
                const f32x4 r0 = (g0 * u0) * e0, r1 = (g1 * u1) * e1;
                if constexpr (O8) { uint2 w; w.x = pk4_fp8(r0[0], r0[1], r0[2], r0[3]); w.y = pk4_fp8(r1[0], r1[1], r1[2], r1[3]);
                    *(uint2*)((unsigned char*)O + (size_t)(row0 + ai * HALF + m * 16) * ld + col0) = w; }
                else { u32x4 w; w.x = cvtpk(r0[0], r0[1]); w.y = cvtpk(r0[2], r0[3]); w.z = cvtpk(r1[0], r1[1]); w.w = cvtpk(r1[2], r1[3]);
                    *(u32x4*)(O + (size_t)(row0 + ai * HALF + m * 16) * ld + col0) = w; }
            }
    }
};
typedef EpiSwigluT<false> EpiSwiglu;
struct EpiRaw {
    static constexpr bool PERM = true;
    bf16_t* C; float* YP; int tail_row0, tail_rows; float sc;
    __device__ __forceinline__ void operator()(const f32x4 (&acc)[2][2][4][2], const Unit& u, int wr, int wc, int fr, int fq) const {
        const int row0 = u.pm * BM + wr * 64 + fr, col0 = u.pn * BM + wc * 32 + 8 * fq;
        if (u.part >= 0) {
#pragma unroll
            for (int ai = 0; ai < 2; ++ai)
#pragma unroll
                for (int m = 0; m < 4; ++m) { bf16_t* rowp = (bf16_t*)YP + ((size_t)u.part * tail_rows + (row0 + ai * HALF + m * 16 - tail_row0)) * DM + col0;
#pragma unroll
                    for (int bj = 0; bj < 2; ++bj) { const f32x4 v0 = acc[ai][bj][m][0] * sc, v1 = acc[ai][bj][m][1] * sc;
                        u32x4 w; w.x = cvtpk(v0[0], v0[1]); w.y = cvtpk(v0[2], v0[3]); w.z = cvtpk(v1[0], v1[1]); w.w = cvtpk(v1[2], v1[3]);
                        *(u32x4*)(rowp + bj * HALF) = w; } }
            return;
        }
#pragma unroll
        for (int ai = 0; ai < 2; ++ai)
#pragma unroll
            for (int m = 0; m < 4; ++m) { bf16_t* rowp = C + (size_t)(row0 + ai * HALF + m * 16) * DM + col0;
#pragma unroll
                for (int bj = 0; bj < 2; ++bj) { const f32x4 v0 = acc[ai][bj][m][0] * sc, v1 = acc[ai][bj][m][1] * sc;
                    u32x4 w; w.x = cvtpk(v0[0], v0[1]); w.y = cvtpk(v0[2], v0[3]); w.z = cvtpk(v1[0], v1[1]); w.w = cvtpk(v1[2], v1[3]);
                    *(u32x4*)(rowp + bj * HALF) = w; } }
    }
};
}

#define XB_TMO      128
#define XB_XCNT(j)  (256  + 64 * (j))
#define XB_XSUB(j)  (1280 + 64 * (j))
#define XB_XGEN(j)  (2304 + 64 * (j))
#define XB_TOP      3328
#define XB_TOPGEN   3392
#define XCD_BAR_WORDS 3456
#define XB_SPIN_CAP (1u << 18)
__device__ __forceinline__ unsigned xb_ld(unsigned* p)              { return __hip_atomic_load(p, __ATOMIC_RELAXED, __HIP_MEMORY_SCOPE_AGENT); }
__device__ __forceinline__ unsigned xb_add(unsigned* p, unsigned v) { return __hip_atomic_fetch_add(p, v, __ATOMIC_RELAXED, __HIP_MEMORY_SCOPE_AGENT); }
__device__ __forceinline__ unsigned xb_xcc_id() { return (unsigned)__builtin_amdgcn_s_getreg((3 << 11) | 20) & 0xFu; }
#define XB_SPIN(cond, bar) do { unsigned _sp = 0; while (cond) { __builtin_amdgcn_s_sleep(1); \
    if ((++_sp & 255u) == 0u) { if (xb_ld(&(bar)[XB_TMO])) break; if (_sp > XB_SPIN_CAP) { atomicAdd(&(bar)[XB_TMO], 1u); break; } } } } while (0)
struct XcdBarrier { unsigned* bar; unsigned x; volatile LAS unsigned* st; };
__device__ __forceinline__ XcdBarrier xcd_barrier_post(unsigned* bar, volatile LAS unsigned* st) {
    XcdBarrier b; b.bar = bar; b.x = xb_xcc_id(); b.st = st;
    if (threadIdx.x == 0) (void)xb_add(&bar[XB_XCNT(b.x)], 1u);
    return b;
}
__device__ __forceinline__ void xcd_barrier_complete(unsigned* bar, unsigned x, unsigned& nloc, unsigned& nx) {
    const unsigned G = gridDim.x * gridDim.y * gridDim.z;
    unsigned sum, cnt, mine, sp = 0u;
    for (;;) {
        sum = 0u; cnt = 0u; mine = 0u;
#pragma unroll
        for (unsigned j = 0; j < 16; ++j) { const unsigned c = xb_ld(&bar[XB_XCNT(j)]); sum += c; cnt += (c > 0u) ? 1u : 0u; mine = (j == x) ? c : mine; }
        if (sum == G) break;
        __builtin_amdgcn_s_sleep(1);
        if ((++sp & 255u) == 0u) { if (xb_ld(&bar[XB_TMO])) break; if (sp > XB_SPIN_CAP) { atomicAdd(&bar[XB_TMO], 1u); break; } }
    }
    nloc = mine > 0u ? mine : 1u; nx = cnt > 0u ? cnt : 1u;
}
__device__ __forceinline__ void xcd_barrier(const XcdBarrier& b) {
    asm volatile("s_waitcnt vmcnt(0)" ::: "memory");
    __syncthreads();
    if (threadIdx.x == 0) {
        unsigned* bar = b.bar;
        __builtin_amdgcn_s_waitcnt(0);
        unsigned nloc = b.st[0], nx = b.st[1];
        if (nloc == 0u) { xcd_barrier_complete(bar, b.x, nloc, nx); b.st[0] = nloc; b.st[1] = nx; }
        const unsigned old = xb_add(&bar[XB_XSUB(b.x)], 1u);
        const unsigned gen = old / nloc;
        if (old + 1u == (gen + 1u) * nloc) {
            __builtin_amdgcn_fence(__ATOMIC_RELEASE, "agent");
            asm volatile("s_waitcnt vmcnt(0)" ::: "memory");
            const unsigned og = xb_add(&bar[XB_TOP], 1u);
            const unsigned tg = og / nx;
            if (og + 1u == (tg + 1u) * nx) xb_add(&bar[XB_TOPGEN], 1u);
            else XB_SPIN(xb_ld(&bar[XB_TOPGEN]) == tg, bar);
            __builtin_amdgcn_fence(__ATOMIC_ACQUIRE, "agent");
            xb_add(&bar[XB_XGEN(b.x)], 1u);
            asm volatile("s_waitcnt vmcnt(0)" ::: "memory");
        } else {
            XB_SPIN(xb_ld(&bar[XB_XGEN(b.x)]) == gen, bar);
            __builtin_amdgcn_fence(__ATOMIC_ACQUIRE, "agent");
            asm volatile("s_waitcnt vmcnt(0)" ::: "memory");
        }
    }
    __syncthreads();
}

struct Args { const float* in[22]; float* out; unsigned char* ws; int ph_lo, ph_hi; };

__device__ __forceinline__ int in_srccol(int r, float& sc) {
    sc = 1.f;
    if (r < 1024) { if (r >= C_MK && r < C_MV) sc = 0.125f; return r; }
    if (r < C_MG) { if (r < C_AK) sc = 0.125f * 1.4426950408889634f; else if (r >= C_GQ && r < C_GK) sc = 0.17677669529663687f; return r + 16; }
    if (r < C_GGT) return r - C_MG + 1024;
    if (r < C_END) return r;
    return -1;
}
template <bool F8 = false>
__device__ __forceinline__ void tr_item(const float* W, int K, int N, int NP, bf16_t* WT, int mode, int half, LAS float* scr, int item, int lane, float f8scale = 1.f) {
    const int nblk = NP >> 6, kb = item / nblk, nb = item - kb * nblk, k0 = kb << 6, n0 = nb << 6;
    const int r = n0 + lane; float sc = 1.f; int src;
    if (mode == 0) src = r; else if (mode == 1) src = in_srccol(r, sc); else { const int pn = r >> 8, w = r & 255; src = (w < 128) ? (pn * 128 + w) : (half + pn * 128 + w - 128); }
    if (F8) sc = f8scale;
    const float* wp = W + (size_t)k0 * N + (src < 0 ? 0 : src);
#pragma unroll 64
    for (int i = 0; i < 64; ++i) { const float v = __builtin_nontemporal_load(wp + (size_t)i * N); scr[i * 65 + lane] = (src < 0) ? 0.f : v * sc; }
    LDS_WAIT();
    const int c = lane & 7;
#pragma unroll
    for (int j = 0; j < 8; ++j) { const int n = (lane >> 3) + 8 * j; const LAS float* s = scr + (8 * c) * 65 + n;
        if constexpr (F8) { uint2 o; o.x = pk4_fp8(s[0], s[65], s[130], s[195]); o.y = pk4_fp8(s[260], s[325], s[390], s[455]); *(uint2*)((unsigned char*)WT + (size_t)(n0 + n) * K + k0 + 8 * c) = o; }
        else { uint4 o; o.x = pk2(s[0], s[65]); o.y = pk2(s[130], s[195]); o.z = pk2(s[260], s[325]); o.w = pk2(s[390], s[455]);
        *(uint4*)(WT + (size_t)(n0 + n) * K + k0 + 8 * c) = o; } }
    LDS_WAIT();
}

__device__ __forceinline__ void tr_item_f8_wg(LAS unsigned char* lds, const float* __restrict__ W, int K, int N, int NP, unsigned char* __restrict__ WT, int mode, int half, int item, int tid, int lane, int wave, float sc) {
    constexpr int RS = 136;
    const int nblk = NP >> 8, kb = item / nblk, nb = item - kb * nblk, k0 = kb << 7, nb0 = nb << 8, n0 = nb0 + 4 * lane;
    int src = n0;
    if (mode == 2) { const int pn = n0 >> 8, w = n0 & 255; src = (w < 128) ? (pn * 128 + w) : (half + pn * 128 + w - 128); }
    f32x4 v[2][8];
#pragma unroll
    for (int q = 0; q < 2; ++q)
#pragma unroll
        for (int i = 0; i < 8; ++i) v[q][i] = __builtin_nontemporal_load((const f32x4*)(W + (size_t)(k0 + (wave * 2 + q) * 8 + i) * N + src));
    __syncthreads();
#pragma unroll
    for (int q = 0; q < 2; ++q)
#pragma unroll
        for (int e = 0; e < 4; ++e) { u32x2_t o; o.x = pk4_fp8(v[q][0][e] * sc, v[q][1][e] * sc, v[q][2][e] * sc, v[q][3][e] * sc); o.y = pk4_fp8(v[q][4][e] * sc, v[q][5][e] * sc, v[q][6][e] * sc, v[q][7][e] * sc);
            *(LAS u32x2_t*)(lds + (4 * lane + e) * RS + (wave * 2 + q) * 8) = o; }
    __syncthreads();
#pragma unroll
    for (int j = 0; j < 4; ++j) { const int idx = tid + 512 * j, r = idx >> 3, ch = idx & 7;
        *(u32x4*)(WT + (size_t)(nb0 + r) * K + k0 + ch * 16) = *(const LAS u32x4*)(lds + r * RS + ch * 16); }
}

__device__ __forceinline__ void chunk_rows(int d, int jc, int& base, int& step) {
    int oc;
    if (d == 0) oc = (jc < 4) ? 256 + jc : jc - 4; else oc = (jc < 4) ? 256 + (3 - jc) : 255 - (jc - 4);
    const int b0 = (oc < 256) ? oc * 64 : SEQ + (oc - 256) * 64;
    if (d == 0) { base = b0; step = 1; } else { base = b0 + 63; step = -1; }
}
__device__ __forceinline__ int oc_to_jc(int d, int oc) { if (d == 0) return oc < 256 ? oc + 4 : oc - 256; return oc < 256 ? 4 + (255 - oc) : 3 - (oc - 256); }

namespace at32 {
typedef float f32x16 __attribute__((ext_vector_type(16)));
constexpr int NW = 8, KVBLK = 64, NSLOT = 3, SLOTB = 8192, PQ = LDP;
constexpr int LDS_K = 0, LDS_V = NSLOT * SLOTB, LDS_WS = 2 * NSLOT * SLOTB, LDS_OST = LDS_WS + NW * 64 * 4, LDS_BYTES = LDS_OST + NW * 4096;
#define A3_SBAR() __builtin_amdgcn_sched_barrier(0)
#define A3_WAIT_BAR(N) asm volatile("s_waitcnt vmcnt(" #N ") lgkmcnt(0)\n\ts_barrier" ::: "memory")
__device__ __forceinline__ int crow(int r, int hi) { return (r & 3) + 8 * (r >> 2) + 4 * hi; }
__device__ __forceinline__ void glds16(const void* gsrc, unsigned lds_dst) { unsigned keep;
    asm volatile("s_mov_b32 %0, m0\n\ts_mov_b32 m0, %2\n\ts_nop 0\n\tglobal_load_lds_dwordx4 %1, off\n\ts_mov_b32 m0, %0" : "=&s"(keep) : "v"(gsrc), "s"(lds_dst) : "memory"); }
__device__ __forceinline__ float max3f(float a, float b, float c) { float r; asm("v_max3_f32 %0, %1, %2, %3" : "=v"(r) : "v"(a), "v"(b), "v"(c)); return r; }
__device__ __forceinline__ float max2f(float a, float b) { float r; asm("v_max_f32_e32 %0, %1, %2" : "=v"(r) : "v"(a), "v"(b)); return r; }
__device__ __forceinline__ float fadd_s(float a, float b) { float r; asm("v_add_f32_e32 %0, %1, %2" : "=v"(r) : "v"(a), "v"(b)); return r; }
__device__ __forceinline__ float fsub_s(float a, float b) { float r; asm("v_sub_f32_e32 %0, %1, %2" : "=v"(r) : "v"(a), "v"(b)); return r; }
typedef const LAS unsigned char* lds_cptr;
__device__ __forceinline__ void wmask(f32x16& p0, f32x16& p1, int s, int b, int qrel, int hi) {
    const float NEG = -INFINITY; const int e = s * (4 * hi - qrel) + b;
#pragma unroll
    for (int r = 0; r < 16; ++r) { const int c = (r & 3) + 8 * (r >> 2); if (e + s * c > 0) p0[r] = NEG; if (e + s * (c + 32) > 0) p1[r] = NEG; }
}
__device__ __forceinline__ void qkt(f32x16& p0, f32x16& p1, lds_cptr Kslot, const bf16x8* qr, const f32x16& negm, int r32, int hi) {
    lds_cptr kb = Kslot + hi * 1024 + r32 * 16;
#pragma unroll
    for (int d0 = 0; d0 < 4; ++d0) {
        const bf16x8 b0 = *(const LAS bf16x8*)(kb + d0 * 2048), b1 = *(const LAS bf16x8*)(kb + d0 * 2048 + 512);
        if (d0 == 0) { p0 = __builtin_amdgcn_mfma_f32_32x32x16_bf16(b0, qr[0], negm, 0, 0, 0); p1 = __builtin_amdgcn_mfma_f32_32x32x16_bf16(b1, qr[0], negm, 0, 0, 0); }
        else { p0 = __builtin_amdgcn_mfma_f32_32x32x16_bf16(b0, qr[d0], p0, 0, 0, 0); p1 = __builtin_amdgcn_mfma_f32_32x32x16_bf16(b1, qr[d0], p1, 0, 0, 0); } }
}
__device__ __forceinline__ void kload8(bf16x8* kf, lds_cptr kp) {
    kf[0] = *(const LAS bf16x8*)(kp);        kf[1] = *(const LAS bf16x8*)(kp + 512);  kf[2] = *(const LAS bf16x8*)(kp + 2048); kf[3] = *(const LAS bf16x8*)(kp + 2560);
    kf[4] = *(const LAS bf16x8*)(kp + 4096); kf[5] = *(const LAS bf16x8*)(kp + 4608); kf[6] = *(const LAS bf16x8*)(kp + 6144); kf[7] = *(const LAS bf16x8*)(kp + 6656);
}
__device__ __forceinline__ void kload2(bf16x8* kf, lds_cptr kp, int j) { kf[2 * j] = *(const LAS bf16x8*)(kp + j * 2048); kf[2 * j + 1] = *(const LAS bf16x8*)(kp + j * 2048 + 512); }
__device__ __forceinline__ s16x4 vtr(lds_cptr p) { return __builtin_bit_cast(s16x4, __builtin_amdgcn_ds_read_tr16_b64_v4i16((LAS v4i16_t*)p)); }
__device__ __forceinline__ float rowmax(const f32x16& p0, const f32x16& p1) {
    float a = max3f(p0[0], p0[1], p1[0]), b = max3f(p0[2], p0[3], p1[1]); a = max3f(a, p1[2], p1[3]);
#pragma unroll
    for (int r = 4; r < 16; r += 4) { a = max3f(a, p0[r], p0[r + 1]); b = max3f(b, p0[r + 2], p0[r + 3]); a = max3f(a, p1[r], p1[r + 1]); b = max3f(b, p1[r + 2], p1[r + 3]); }
    const float m = max2f(a, b);
    auto rr = __builtin_amdgcn_permlane32_swap(__float_as_uint(m), __float_as_uint(m), false, false);
    return max2f(__uint_as_float(rr[0]), __uint_as_float(rr[1]));
}
__device__ __forceinline__ void pv(f32x16* o, int vb, bf16x8 pa0, bf16x8 pa1, bf16x8 pa2, bf16x8 pa3) {
#pragma unroll
    for (int d0 = 0; d0 < 2; ++d0) { s16x4 lo[4], hi[4];
#pragma unroll
        for (int ks = 0; ks < 4; ++ks) {
            asm volatile("ds_read_b64_tr_b16 %0,%1 offset:%c2" : "=&v"(lo[ks]) : "v"(vb), "i"(d0 * 4096 + ks * 1024) : "memory");
            asm volatile("ds_read_b64_tr_b16 %0,%1 offset:%c2" : "=&v"(hi[ks]) : "v"(vb), "i"(d0 * 4096 + ks * 1024 + 512) : "memory"); }
        asm volatile("s_waitcnt lgkmcnt(0)" ::: "memory"); A3_SBAR();
#define A3_PK(k) (bf16x8){lo[k][0], lo[k][1], lo[k][2], lo[k][3], hi[k][0], hi[k][1], hi[k][2], hi[k][3]}
        o[d0] = __builtin_amdgcn_mfma_f32_32x32x16_bf16(pa0, A3_PK(0), o[d0], 0, 0, 0);
        o[d0] = __builtin_amdgcn_mfma_f32_32x32x16_bf16(pa1, A3_PK(1), o[d0], 0, 0, 0);
        o[d0] = __builtin_amdgcn_mfma_f32_32x32x16_bf16(pa2, A3_PK(2), o[d0], 0, 0, 0);
        o[d0] = __builtin_amdgcn_mfma_f32_32x32x16_bf16(pa3, A3_PK(3), o[d0], 0, 0, 0);
#undef A3_PK
    }
}
template <int THRL> __device__ __forceinline__ void attn_unit(LAS unsigned char* shm, const bf16_t* __restrict__ P, bf16_t* CAT, bool ctx, int qb, int kvh, const float* sink, int lane, int wave) {
    const int r32 = lane & 31, hi = lane >> 5; const int wid = __builtin_amdgcn_readfirstlane(wave);
    const int hq = kvh * 4 + (wid >> 1), q0 = qb * 64, qrow0 = (ctx ? SEQ : 0) + q0 + (wid & 1) * 32;
    const bf16_t* Qw = P + (size_t)qrow0 * PQ + C_AQ + hq * 64;
    const bf16_t* Kh = P + C_AK + kvh * 64; const bf16_t* Vh = P + C_AV + kvh * 64;
    const unsigned lds0 = (unsigned)(uintptr_t)shm;
    LAS float* wsf = (LAS float*)(shm + LDS_WS) + wid * 64;
    const int kb0 = ctx ? 0 : (qb - 2 < 0 ? 0 : qb - 2), kb1 = ctx ? -1 : (qb + 2 > SEQ / 64 - 1 ? SEQ / 64 - 1 : qb + 2), nl = kb1 - kb0 + 1, NT = nl + 4;
#define A3_TROW(t) (((t) < nl) ? (kb0 + (t)) * 64 : SEQ + ((t) - nl) * 64)
#define A3_MT(t) (((t) < nl) ? ((kb0 + (t) == qb - 2) ? 1 : ((kb0 + (t) == qb + 2) ? 2 : 0)) : 0)
    const bf16_t* ksrc = Kh + (size_t)lane * PQ + wid * 8;
    const bf16_t* vsrc = Vh + (size_t)(16 * (wid & 3) + (lane >> 2)) * PQ + (wid >> 2) * 32 + (lane & 3) * 8;
    const unsigned kdst = lds0 + LDS_K + wid * 1024, vdst = lds0 + LDS_V + wid * 1024;
#define A3_DMA_K(t, slot) glds16(ksrc + (size_t)A3_TROW(t) * PQ, (unsigned)__builtin_amdgcn_readfirstlane(kdst + (slot)))
#define A3_DMA_V(t, slot) glds16(vsrc + (size_t)A3_TROW(t) * PQ, (unsigned)__builtin_amdgcn_readfirstlane(vdst + (slot)))
    const int vb0 = (int)(lds0 + LDS_V) + ((lane >> 4) & 1) * 32 + (lane & 3) * 8 + (4 * hi + ((lane & 15) >> 2)) * 64;
    const lds_cptr Kbase = shm + LDS_K; bf16x8 kf[8];
    const lds_cptr kp0 = shm + LDS_K + hi * 1024 + r32 * 16; const lds_cptr vp0 = shm + LDS_V + ((lane >> 4) & 1) * 32 + (lane & 3) * 8 + (4 * hi + ((lane & 15) >> 2)) * 64;
    A3_DMA_K(0, 0); A3_DMA_V(0, 0); A3_DMA_K(1, SLOTB);
    bf16x8 qr[4];
#pragma unroll
    for (int d0 = 0; d0 < 4; ++d0) qr[d0] = *(const bf16x8*)(Qw + (size_t)r32 * PQ + d0 * 16 + hi * 8);
    float zf = 0.f; asm volatile("" : "+v"(zf));
    float mhat = 0.f, l_reg = 0.f; f32x16 o[2]; f32x16 negm;
#pragma unroll
    for (int r = 0; r < 16; ++r) { o[0][r] = zf; o[1][r] = zf; negm[r] = zf; }
    asm volatile("" : "+v"(negm));
    const int qrel = (wid & 1) * 32 + r32;
#define A3_CMASK(P0, P1, t) do { const int mt_ = A3_MT(t); if (mt_) wmask(P0, P1, (mt_ == 1) ? -1 : (mt_ == 2 ? 1 : 0), (mt_ == 3) ? 1 : 0, qrel, hi); } while (0)
    bool resc = false;
#define A3_START(P0, P1) do { const float rm = rowmax(P0, P1); resc = false; \
    { const float dl = rm; mhat = fadd_s(mhat, dl); \
      _Pragma("unroll") for (int r = 0; r < 16; ++r) { P0[r] = fsub_s(P0[r], dl); P1[r] = fsub_s(P1[r], dl); } \
      _Pragma("unroll") for (int r = 0; r < 16; ++r) negm[r] = -mhat; asm volatile("" : "+v"(negm)); } \
    _Pragma("unroll") for (int r = 0; r < 16; ++r) P0[r] = __builtin_amdgcn_exp2f(P0[r]); } while (0)
#define A3_RESC() do { if (resc) { asm volatile("s_waitcnt lgkmcnt(0)" ::: "memory"); \
      _Pragma("unroll") for (int d_ = 0; d_ < 2; ++d_) _Pragma("unroll") for (int r = 0; r < 16; ++r) o[d_][r] *= wsf[crow(r, hi)]; } } while (0)
    f32x16 pA0, pA1, pB0, pB1;
    int sl_prev = 0, sl_cur = 0, sl_next = SLOTB;
#define A3_ROT() do { sl_prev = sl_cur; sl_cur = sl_next; sl_next = (sl_next == (NSLOT - 1) * SLOTB) ? 0 : sl_next + SLOTB; } while (0)
    A3_DMA_K(2, 2 * SLOTB);
    A3_WAIT_BAR(3);
    qkt(pA0, pA1, Kbase, qr, negm, r32, hi); asm volatile("s_nop 15\n\ts_nop 7" : "+v"(pA0), "+v"(pA1)); A3_CMASK(pA0, pA1, 0);
    A3_START(pA0, pA1);
#pragma unroll
    for (int r = 0; r < 16; ++r) pA1[r] = __builtin_amdgcn_exp2f(pA1[r]);
    A3_WAIT_BAR(0);
    A3_DMA_K(3, 0); A3_DMA_V(1, SLOTB);
    A3_ROT();
    kload8(kf, kp0 + sl_cur);
    A3_WAIT_BAR(2);
    s16x4 vlo[8], vhi[8]; u32x4 pw0, pw1, pw2, pw3;
#define A3_PKW(P, B) cvtpk(P[B], P[B + 1])
#define A3_PAF(k) __builtin_bit_cast(bf16x8, pw##k)
#define A3_VFR(i) (bf16x8){vlo[i][0], vlo[i][1], vlo[i][2], vlo[i][3], vhi[i][0], vhi[i][1], vhi[i][2], vhi[i][3]}
#define A3_PIN(x) asm volatile("" : "+v"(x))
#define A3_MX3(a, b, c) __builtin_fmaxf(__builtin_fmaxf((a), (b)), (c))
#define A3_GAPA(MF, A0, A1, A2, A3, W0, W1, PW) do { MF; sacc += A0; sacc += A1; sacc += A2; sacc += A3; A3_PIN(sacc); W0; W1; A3_PIN(PW); A3_SBAR(); } while (0)
#define A3_EX(v) __builtin_amdgcn_exp2f(v)
#define A3_GAPB(MF, X, B) do { MF; X[B] = A3_EX(X[B]); X[B + 1] = A3_EX(X[B + 1]); X[B + 2] = A3_EX(X[B + 2]); X[B + 3] = A3_EX(X[B + 3]); A3_PIN(X); A3_SBAR(); } while (0)
#define A3_VRD(i) do { vlo[i] = vtr(vp_ + (((i) >> 2) * 4096 + ((i) & 3) * 1024)); vhi[i] = vtr(vp_ + (((i) >> 2) * 4096 + ((i) & 3) * 1024 + 512)); } while (0)
#define A3_KRD(G, j) do { if (G) { kload2(kf, kp0 + sl_next, j); A3_SBAR(); } } while (0)
#define A3_MF(D, A, B, C) D = __builtin_amdgcn_mfma_f32_32x32x16_bf16(A, B, C, 0, 0, 0)
#define A3_STEP(C0, C1, P0, P1, t, GK, GV, GL) do { A3_SBAR(); \
    const lds_cptr vp_ = vp0 + sl_prev; \
    A3_VRD(0); A3_SBAR(); float sacc = (P0[0] + P0[1]); \
    A3_GAPA(A3_MF(C0, kf[0], qr[0], negm), P0[2], P0[3], P0[4], P0[5],     pw0[0] = A3_PKW(P0, 0), pw0[1] = A3_PKW(P0, 2), pw0); \
    A3_VRD(4); A3_SBAR(); A3_GAPA(A3_MF(C1, kf[1], qr[0], negm), P0[6], P0[7], P0[8], P0[9],     pw0[2] = A3_PKW(P0, 4), pw0[3] = A3_PKW(P0, 6), pw0); \
    A3_VRD(1); A3_SBAR(); A3_GAPA(A3_MF(C0, kf[2], qr[1], C0),   P0[10], P0[11], P0[12], P0[13], pw1[0] = A3_PKW(P0, 8), pw1[1] = A3_PKW(P0, 10), pw1); \
    A3_VRD(5); A3_SBAR(); A3_GAPA(A3_MF(C1, kf[3], qr[1], C1),   P0[14], P0[15], P1[0], P1[1],   pw1[2] = A3_PKW(P0, 12), pw1[3] = A3_PKW(P0, 14), pw1); \
    A3_VRD(2); A3_SBAR(); A3_GAPA(A3_MF(C0, kf[4], qr[2], C0),   P1[2], P1[3], P1[4], P1[5],     pw2[0] = A3_PKW(P1, 0), pw2[1] = A3_PKW(P1, 2), pw2); \
    A3_VRD(6); A3_SBAR(); A3_GAPA(A3_MF(C1, kf[5], qr[2], C1),   P1[6], P1[7], P1[8], P1[9],     pw2[2] = A3_PKW(P1, 4), pw2[3] = A3_PKW(P1, 6), pw2); \
    A3_VRD(3); A3_SBAR(); A3_GAPA(A3_MF(C0, kf[6], qr[3], C0),   P1[10], P1[11], P1[12], P1[13], pw3[0] = A3_PKW(P1, 8), pw3[1] = A3_PKW(P1, 10), pw3); \
    A3_VRD(7); A3_SBAR(); A3_GAPA(A3_MF(C1, kf[7], qr[3], C1),   P1[14], P1[15], 0.f, 0.f,       pw3[2] = A3_PKW(P1, 12), pw3[3] = A3_PKW(P1, 14), pw3); \
    l_reg += sacc; \
    if (GK) { A3_DMA_K((t) + 3, sl_cur); } if (GV) { A3_DMA_V((t) + 1, sl_next); } \
    A3_CMASK(C0, C1, t); \
    { float a = A3_MX3(C0[0], C0[1], C1[0]), b = A3_MX3(C0[2], C0[3], C1[1]); a = A3_MX3(a, C1[2], C1[3]); \
      _Pragma("unroll") for (int r = 4; r < 16; r += 4) { a = A3_MX3(a, C0[r], C0[r + 1]); b = A3_MX3(b, C0[r + 2], C0[r + 3]); a = A3_MX3(a, C1[r], C1[r + 1]); b = A3_MX3(b, C1[r + 2], C1[r + 3]); } \
      float rm = __builtin_fmaxf(a, b); { auto rr = __builtin_amdgcn_permlane32_swap(__float_as_uint(rm), __float_as_uint(rm), false, false); rm = __builtin_fmaxf(__uint_as_float(rr[0]), __uint_as_float(rr[1])); } \
      resc = false; \
      if (__builtin_expect(__any(rm > (float)THRL), 0)) { const float dl = __builtin_fmaxf(rm, 0.f); mhat += dl; \
        _Pragma("unroll") for (int r = 0; r < 16; ++r) { C0[r] -= dl; C1[r] -= dl; } \
        _Pragma("unroll") for (int r = 0; r < 16; ++r) negm[r] = -mhat; asm volatile("" : "+v"(negm)); \
        const float f = __builtin_amdgcn_exp2f(-dl); l_reg *= f; if (hi == 0) wsf[r32] = f; resc = true; } } \
    A3_SBAR(); \
    A3_GAPB(A3_MF(o[0], A3_PAF(0), A3_VFR(0), o[0]), C0, 0); \
    A3_GAPB(A3_MF(o[1], A3_PAF(0), A3_VFR(4), o[1]), C0, 4); \
    A3_KRD(GL, 0); A3_GAPB(A3_MF(o[0], A3_PAF(1), A3_VFR(1), o[0]), C0, 8); \
    A3_KRD(GL, 1); A3_GAPB(A3_MF(o[1], A3_PAF(1), A3_VFR(5), o[1]), C0, 12); \
    A3_KRD(GL, 2); A3_GAPB(A3_MF(o[0], A3_PAF(2), A3_VFR(2), o[0]), C1, 0); \
    A3_KRD(GL, 3); A3_GAPB(A3_MF(o[1], A3_PAF(2), A3_VFR(6), o[1]), C1, 4); \
    A3_GAPB(A3_MF(o[0], A3_PAF(3), A3_VFR(3), o[0]), C1, 8); \
    A3_GAPB(A3_MF(o[1], A3_PAF(3), A3_VFR(7), o[1]), C1, 12); \
    } while (0)
#define A3_ENDW(tt) do { if ((tt) + 3 < NT) { A3_WAIT_BAR(2); } else if ((tt) + 2 < NT) { A3_WAIT_BAR(1); } else { A3_WAIT_BAR(0); } } while (0)
#define A3_DRAIN(B0, B1) do { float sacc = B0[0] + B0[1]; _Pragma("unroll") for (int r = 2; r < 16; ++r) sacc += B0[r]; _Pragma("unroll") for (int r = 0; r < 16; ++r) sacc += B1[r]; l_reg += sacc; \
    pw0 = (u32x4){A3_PKW(B0, 0), A3_PKW(B0, 2), A3_PKW(B0, 4), A3_PKW(B0, 6)}; pw1 = (u32x4){A3_PKW(B0, 8), A3_PKW(B0, 10), A3_PKW(B0, 12), A3_PKW(B0, 14)}; \
    pw2 = (u32x4){A3_PKW(B1, 0), A3_PKW(B1, 2), A3_PKW(B1, 4), A3_PKW(B1, 6)}; pw3 = (u32x4){A3_PKW(B1, 8), A3_PKW(B1, 10), A3_PKW(B1, 12), A3_PKW(B1, 14)}; \
    A3_SBAR(); pv(o, vb0 + sl_cur, A3_PAF(0), A3_PAF(1), A3_PAF(2), A3_PAF(3)); } while (0)
    int t = 1;
    if (NT & 1) {
        A3_STEP(pB0, pB1, pA0, pA1, 1, (4 < NT), (2 < NT), (2 < NT)); A3_ENDW(1); A3_RESC(); A3_ROT();
        pA0 = pB0; pA1 = pB1; t = 2;
    }
    for (; t + 2 < NT; t += 2) {
        A3_STEP(pB0, pB1, pA0, pA1, t, (t + 3 < NT), (t + 1 < NT), (t + 1 < NT));         A3_ENDW(t);     A3_RESC(); A3_ROT();
        A3_STEP(pA0, pA1, pB0, pB1, t + 1, (t + 4 < NT), (t + 2 < NT), (t + 2 < NT));     A3_ENDW(t + 1); A3_RESC(); A3_ROT();
    }
    A3_STEP(pB0, pB1, pA0, pA1, t, false, false, false); A3_RESC();
    A3_DRAIN(pB0, pB1);
    { auto rr = __builtin_amdgcn_permlane32_swap(__float_as_uint(l_reg), __float_as_uint(l_reg), false, false); l_reg = __uint_as_float(rr[0]) + __uint_as_float(rr[1]); }
    l_reg += __builtin_amdgcn_exp2f(sink[hq] * 1.4426950408889634f - mhat);
    if (hi == 0) wsf[32 + r32] = l_reg; asm volatile("s_waitcnt lgkmcnt(0)" ::: "memory");
    float rli[16];
#pragma unroll
    for (int r = 0; r < 16; ++r) rli[r] = __builtin_amdgcn_rcpf(wsf[32 + crow(r, hi)]);
    bf16_t* Ow = CAT + (size_t)qrow0 * DM + 256 + hq * 64;
    { LAS bf16_t* stg = (LAS bf16_t*)(shm + LDS_OST) + wid * 2048;
#pragma unroll
      for (int r = 0; r < 16; ++r) { const int orow = crow(r, hi);
#pragma unroll
          for (int d0 = 0; d0 < 2; ++d0) stg[orow * 64 + d0 * 32 + r32] = (bf16_t)f2bf(o[d0][r] * rli[r]); }
      asm volatile("s_waitcnt lgkmcnt(0)" ::: "memory");
#pragma unroll
      for (int i = 0; i < 4; ++i) { const int row = i * 8 + (lane >> 3), ch = lane & 7; const u32x4 v = *(const LAS u32x4*)(stg + row * 64 + ch * 8); *(u32x4*)(Ow + (size_t)row * DM + ch * 8) = v; } }
    asm volatile("s_waitcnt lgkmcnt(0)\n\ts_barrier" ::: "memory");
#undef A3_TROW
#undef A3_MT
#undef A3_DMA_K
#undef A3_DMA_V
#undef A3_CMASK
#undef A3_START
#undef A3_RESC
#undef A3_ROT
#undef A3_PKW
#undef A3_PAF
#undef A3_VFR
#undef A3_PIN
#undef A3_MX3
#undef A3_GAPA
#undef A3_EX
#undef A3_GAPB
#undef A3_VRD
#undef A3_KRD
#undef A3_MF
#undef A3_STEP
#undef A3_ENDW
#undef A3_DRAIN
}
#undef A3_SBAR
#undef A3_WAIT_BAR
}


constexpr int CH_RS = 144;
constexpr int CH_T = 64 * CH_RS;
constexpr int GL_RS = 80;
constexpr int GL_T = 64 * GL_RS;
__device__ __forceinline__ int chunk_b0(int oc) { return (oc < 256) ? oc * 64 : SEQ + (oc - 256) * 64; }
__device__ __forceinline__ bf16x8 tr_frag(const LAS unsigned char* tile, int rs, int row0, int col0, int lane) {
    const int g = lane >> 4, i = lane & 15; const LAS unsigned char* p = tile + (row0 + 8 * g + (i >> 2)) * rs + (col0 + 4 * (i & 3)) * 2;
    return cat44(ds_tr16(p), ds_tr16(p + 4 * rs));
}
__device__ __forceinline__ bf16x8 tr_frag_perm(const LAS unsigned char* tile, int rs, int row0, int col0, int lane) {
    const int g = lane >> 4, i = lane & 15; const LAS unsigned char* p = tile + (row0 + 4 * g + (i >> 2)) * rs + (col0 + 4 * (i & 3)) * 2;
    return cat44(ds_tr16(p), ds_tr16(p + 16 * rs));
}
__device__ __forceinline__ void unpack8(const u32x4 v, float* o) {
    o[0] = __uint_as_float(v.x << 16); o[1] = __uint_as_float(v.x & 0xffff0000u); o[2] = __uint_as_float(v.y << 16); o[3] = __uint_as_float(v.y & 0xffff0000u);
    o[4] = __uint_as_float(v.z << 16); o[5] = __uint_as_float(v.z & 0xffff0000u); o[6] = __uint_as_float(v.w << 16); o[7] = __uint_as_float(v.w & 0xffff0000u);
}
__device__ __forceinline__ u32x4 pack8(const float* f) { u32x4 w; w.x = cvtpk(f[0], f[1]); w.y = cvtpk(f[2], f[3]); w.z = cvtpk(f[4], f[5]); w.w = cvtpk(f[6], f[7]); return w; }

#define LBAR() do { asm volatile("s_waitcnt lgkmcnt(0)" ::: "memory"); __builtin_amdgcn_s_barrier(); asm volatile("" ::: "memory"); } while (0)

struct MsRaw { u32x4 k, v; float ig, fg, gbi, gbf; };
__device__ __forceinline__ MsRaw mlstm_summary_load(const bf16_t* P, const float* Gt, const float* gate_b, int h, int oc, int tid, int lane, int wave) {
    MsRaw R; const int b0 = chunk_b0(oc), r = tid >> 3, ch = tid & 7;
    R.k = *(const u32x4*)(P + (size_t)(b0 + r) * LDP + C_MK + h * 64 + ch * 8); R.v = *(const u32x4*)(P + (size_t)(b0 + r) * LDP + C_MV + h * 64 + ch * 8);
    { const int d = wave & 1, sp = d ? 63 - lane : lane, row = b0 + sp;
      R.ig = Gt[(size_t)row * 48 + d * 8 + h]; R.gbi = gate_b[d * 8 + h]; R.fg = Gt[(size_t)row * 48 + d * 8 + 4 + h]; R.gbf = gate_b[d * 8 + 4 + h]; }
    return R;
}
__device__ __forceinline__ void mlstm_summary_body(LAS unsigned char* lds, const MsRaw& R, float* MU, float* MNU, float* MSC, int h, int oc, int tid, int lane, int wave) {
    LAS unsigned char* Kw0 = lds; LAS unsigned char* Kw1 = lds + CH_T; LAS unsigned char* Vt = lds + 2 * CH_T; LAS float* wv = (LAS float*)(lds + 3 * CH_T);
    const int r = tid >> 3, ch = tid & 7;
    LBAR();
    if (wave < 2) {
        const int d = wave, sp = d ? 63 - lane : lane, hd = h * 2 + d, jc = oc_to_jc(d, oc);
        const float lf = log_sigmoidf_(R.fg + R.gbf);
        const float bb = scan_add(lf, lane);
        const float av = (R.ig + R.gbi) - bb;
        const float cm = wave_max(av);
        const float B = __shfl(bb, 63);
        wv[d * 64 + sp] = __expf(av - cm);
        if (lane == 0) { MSC[(size_t)(hd * NCH + jc) * 4 + 0] = cm; MSC[(size_t)(hd * NCH + jc) * 4 + 1] = B; }
    }
    *(LAS u32x4*)(Vt + r * CH_RS + ch * 16) = R.v;
    LBAR();
    { float kf[8], t0[8], t1[8]; unpack8(R.k, kf); const float w0 = wv[r], w1 = wv[64 + r];
#pragma unroll
      for (int j = 0; j < 8; ++j) { t0[j] = kf[j] * w0; t1[j] = kf[j] * w1; }
      *(LAS u32x4*)(Kw0 + r * CH_RS + ch * 16) = pack8(t0); *(LAS u32x4*)(Kw1 + r * CH_RS + ch * 16) = pack8(t1); }
    LBAR();
    { const int d = wave >> 2, dkt = wave & 3, g = lane >> 4, i = lane & 15, hd = h * 2 + d, jc = oc_to_jc(d, oc);
      const LAS unsigned char* Kw = d ? Kw1 : Kw0;
      const bf16x8 a0 = tr_frag(Kw, CH_RS, 0, 16 * dkt, lane), a1 = tr_frag(Kw, CH_RS, 32, 16 * dkt, lane);
      float* dst = MU + ((size_t)(hd * 64 + 16 * dkt + i) * NCH + jc) * 64 + 4 * g;
#pragma unroll
      for (int dvt = 0; dvt < 4; ++dvt) {
          f32x4 c = (f32x4){0.f, 0.f, 0.f, 0.f};
          c = MFMA16(tr_frag(Vt, CH_RS, 0, 16 * dvt, lane), a0, c); c = MFMA16(tr_frag(Vt, CH_RS, 32, 16 * dvt, lane), a1, c);
          *(f32x4*)(dst + 16 * dvt) = c;
      }
      const short one = (i == 0) ? (short)0x3F80 : (short)0; const bf16x8 bo = (bf16x8){one, one, one, one, one, one, one, one};
      f32x4 c1 = (f32x4){0.f, 0.f, 0.f, 0.f}; c1 = MFMA16(a0, bo, c1); c1 = MFMA16(a1, bo, c1);
      if (i == 0) *(f32x4*)(MNU + (size_t)(hd * NCH + jc) * 64 + 16 * dkt + 4 * g) = c1; }
}

struct MoRaw { u32x4 q, k, v, c0, c1; float ig, fg, gbi, gbf, mst, nv; uint2 og[4]; };
__device__ __forceinline__ MoRaw mlstm_out_load(const bf16_t* P, const float* Gt, const float* gate_b, const bf16_t* MC, const float* MNS, const float* MSC, int h, int oc, int tid, int lane, int wave) {
    MoRaw R; const int b0 = chunk_b0(oc), r = tid >> 3, ch = tid & 7;
    const size_t ro = (size_t)(b0 + r) * LDP + h * 64 + ch * 8;
    R.q = *(const u32x4*)(P + ro + C_MQ); R.k = *(const u32x4*)(P + ro + C_MK); R.v = *(const u32x4*)(P + ro + C_MV);
    const int jc0 = oc_to_jc(0, oc), jc1 = oc_to_jc(1, oc);
    R.c0 = *(const u32x4*)(MC + ((size_t)((h * 2 + 0) * 64 + r) * NCH + jc0) * 64 + ch * 8); R.c1 = *(const u32x4*)(MC + ((size_t)((h * 2 + 1) * 64 + r) * NCH + jc1) * 64 + ch * 8);
    { const int d = wave & 1, sp = d ? 63 - lane : lane, row = b0 + sp, hd = h * 2 + d, jc = d ? jc1 : jc0;
        R.ig = Gt[(size_t)row * 48 + d * 8 + h]; R.gbi = gate_b[d * 8 + h]; R.fg = Gt[(size_t)row * 48 + d * 8 + 4 + h]; R.gbf = gate_b[d * 8 + 4 + h];
        R.mst = MSC[(size_t)(hd * NCH + jc) * 4 + 2]; R.nv = MNS[(size_t)(hd * NCH + jc) * 64 + lane]; }
    { const int tt = wave & 3, g = lane >> 4, i = lane & 15, row = b0 + 16 * tt + i;
#pragma unroll
      for (int dvt = 0; dvt < 4; ++dvt) R.og[dvt] = *(const uint2*)(P + (size_t)row * LDP + C_MO + h * 64 + 16 * dvt + 4 * g); }
    return R;
}
__device__ __forceinline__ void mlstm_out_body(LAS unsigned char* lds, const MoRaw& R, const float* normw, bf16_t* CAT, int h, int oc, int tid, int lane, int wave) {
    LAS unsigned char* Qt = lds; LAS unsigned char* Kt = lds + CH_T; LAS unsigned char* Vt = lds + 2 * CH_T; LAS unsigned char* Ct = lds + 3 * CH_T;
    LAS float* arr = (LAS float*)(lds + 5 * CH_T);
    LAS f32x4* hs = (LAS f32x4*)(lds + 5 * CH_T + 2 * 320 * 4);
    const int b0 = chunk_b0(oc);
    const int r = tid >> 3, ch = tid & 7;
    LBAR();
    if (wave < 2) {
        const int d = wave, sp = d ? 63 - lane : lane;
        const float lf = log_sigmoidf_(R.fg + R.gbf);
        const float bb = scan_add(lf, lane);
        const float av = (R.ig + R.gbi) - bb;
        const float cm = scan_max(av, lane);
        const float mx = fmaxf(R.mst, cm);
        LAS float* A = arr + d * 320;
        A[sp] = av; A[64 + sp] = mx; A[128 + sp] = __expf(R.mst - mx); A[192 + sp] = __expf(-(bb + mx));
        A[256 + lane] = R.nv;
    }
    *(LAS u32x4*)(Qt + r * CH_RS + ch * 16) = R.q; *(LAS u32x4*)(Kt + r * CH_RS + ch * 16) = R.k; *(LAS u32x4*)(Vt + r * CH_RS + ch * 16) = R.v;
    *(LAS u32x4*)(Ct + r * CH_RS + ch * 16) = R.c0; *(LAS u32x4*)(Ct + CH_T + r * CH_RS + ch * 16) = R.c1;
    LBAR();
    const int d = wave >> 2, tt = wave & 3, g = lane >> 4, i = lane & 15, t = 16 * tt + i;
    f32x4 hh[4];
    {
        const LAS float* A = arr + d * 320;
        const float mxt = A[64 + t], wt = A[128 + t], emt = A[192 + t];
        bf16x8 bq[2], bqw[2]; float qn = 0.f;
#pragma unroll
        for (int ks = 0; ks < 2; ++ks) { const u32x4 raw = *(const LAS u32x4*)(Qt + t * CH_RS + (32 * ks + 8 * g) * 2); bq[ks] = __builtin_bit_cast(bf16x8, raw);
            float qf[8], qw[8]; unpack8(raw, qf);
            const f32x4 n0 = *(const LAS f32x4*)(A + 256 + 32 * ks + 8 * g), n1 = *(const LAS f32x4*)(A + 256 + 32 * ks + 8 * g + 4);
#pragma unroll
            for (int j = 0; j < 4; ++j) { qn += qf[j] * n0[j] + qf[4 + j] * n1[j]; }
#pragma unroll
            for (int j = 0; j < 8; ++j) qw[j] = qf[j] * wt;
            bqw[ks] = __builtin_bit_cast(bf16x8, pack8(qw)); }
        qn += __shfl_xor(qn, 16); qn += __shfl_xor(qn, 32);
        float dsum = 0.f; f32x4 sT[4];
#pragma unroll
        for (int st = 0; st < 4; ++st) {
            f32x4 c = (f32x4){0.f, 0.f, 0.f, 0.f};
#pragma unroll
            for (int ks = 0; ks < 2; ++ks) c = MFMA16(*(const LAS bf16x8*)(Kt + (16 * st + i) * CH_RS + (32 * ks + 8 * g) * 2), bq[ks], c);
            const f32x4 a4 = *(const LAS f32x4*)(A + 16 * st + 4 * g);
#pragma unroll
            for (int rr = 0; rr < 4; ++rr) { const int sidx = 16 * st + 4 * g + rr; const bool ok = d ? (sidx >= t) : (sidx <= t);
                const float val = ok ? c[rr] * __expf(a4[rr] - mxt) : 0.f; sT[st][rr] = val; dsum += val; }
        }
        dsum += __shfl_xor(dsum, 16); dsum += __shfl_xor(dsum, 32);
        const float den = dsum + wt * qn, inv = 1.f / fmaxf(fabsf(den), emt);
        bf16x8 pb[2];
#pragma unroll
        for (int gp = 0; gp < 2; ++gp) { u32x4 w; w.x = cvtpk(sT[2 * gp][0], sT[2 * gp][1]); w.y = cvtpk(sT[2 * gp][2], sT[2 * gp][3]); w.z = cvtpk(sT[2 * gp + 1][0], sT[2 * gp + 1][1]); w.w = cvtpk(sT[2 * gp + 1][2], sT[2 * gp + 1][3]); pb[gp] = __builtin_bit_cast(bf16x8, w); }
        const LAS unsigned char* Cd = Ct + d * CH_T;
#pragma unroll
        for (int dvt = 0; dvt < 4; ++dvt) {
            f32x4 c = (f32x4){0.f, 0.f, 0.f, 0.f};
            c = MFMA16(tr_frag_perm(Vt, CH_RS, 0, 16 * dvt, lane), pb[0], c); c = MFMA16(tr_frag_perm(Vt, CH_RS, 32, 16 * dvt, lane), pb[1], c);
            c = MFMA16(tr_frag(Cd, CH_RS, 0, 16 * dvt, lane), bqw[0], c); c = MFMA16(tr_frag(Cd, CH_RS, 32, 16 * dvt, lane), bqw[1], c);
            hh[dvt] = c * inv;
        }
        if (d == 1) {
#pragma unroll
            for (int dvt = 0; dvt < 4; ++dvt) hs[(tt * 4 + dvt) * 64 + lane] = hh[dvt];
        }
    }
    LBAR();
    if (d == 0) {
        float s1 = 0.f;
#pragma unroll
        for (int dvt = 0; dvt < 4; ++dvt) { hh[dvt] = hh[dvt] + hs[(tt * 4 + dvt) * 64 + lane]; s1 += (hh[dvt][0] + hh[dvt][1]) + (hh[dvt][2] + hh[dvt][3]); }
        s1 += __shfl_xor(s1, 16); s1 += __shfl_xor(s1, 32);
        const float mu = s1 * (1.f / 64.f); float s2 = 0.f;
#pragma unroll
        for (int dvt = 0; dvt < 4; ++dvt) { hh[dvt] = hh[dvt] - mu; s2 += (hh[dvt][0] * hh[dvt][0] + hh[dvt][1] * hh[dvt][1]) + (hh[dvt][2] * hh[dvt][2] + hh[dvt][3] * hh[dvt][3]); }
        s2 += __shfl_xor(s2, 16); s2 += __shfl_xor(s2, 32);
        const float rstd = rsqrtf(s2 * (1.f / 64.f) + LN_EPS);
        const int row = b0 + t;
#pragma unroll
        for (int dvt = 0; dvt < 4; ++dvt) { const int col = h * 64 + 16 * dvt + 4 * g;
            const uint2 og = R.og[dvt]; const f32x4 nw = *(const f32x4*)(normw + col);
            const float o0 = hh[dvt][0] * rstd * nw[0] * sigmoidf_(__uint_as_float(og.x << 16)), o1 = hh[dvt][1] * rstd * nw[1] * sigmoidf_(__uint_as_float(og.x & 0xffff0000u));
            const float o2 = hh[dvt][2] * rstd * nw[2] * sigmoidf_(__uint_as_float(og.y << 16)), o3 = hh[dvt][3] * rstd * nw[3] * sigmoidf_(__uint_as_float(og.y & 0xffff0000u));
            uint2 o; o.x = cvtpk(o0, o1); o.y = cvtpk(o2, o3); *(uint2*)(CAT + (size_t)row * DM + col) = o; }
    }
}

struct GgRaw { f32x4 g0, g1, g2, g3; };
__device__ __forceinline__ GgRaw gla_gates_load(const float* Gt, int b0, int lane, int wave) {
    const int d = wave >> 2, sp = d ? 63 - lane : lane; const float* gs = Gt + (size_t)(b0 + sp) * 48 + 16 + d * 16;
    GgRaw R; R.g0 = *(const f32x4*)gs; R.g1 = *(const f32x4*)(gs + 4); R.g2 = *(const f32x4*)(gs + 8); R.g3 = *(const f32x4*)(gs + 12); return R;
}
__device__ __forceinline__ void gla_gates_wave(const GgRaw& R, const LAS float* g_up, const LAS float* g_b, int h, int lane, int wave, float (&bc)[8]) {
    const int d = wave >> 2, dk0 = 8 * (wave & 3);
    const float gv[16] = {R.g0[0], R.g0[1], R.g0[2], R.g0[3], R.g1[0], R.g1[1], R.g1[2], R.g1[3], R.g2[0], R.g2[1], R.g2[2], R.g2[3], R.g3[0], R.g3[1], R.g3[2], R.g3[3]};
    float z[8];
    { const f32x4 b0 = *(const LAS f32x4*)(g_b + d * 128 + h * 32 + dk0), b1 = *(const LAS f32x4*)(g_b + d * 128 + h * 32 + dk0 + 4);
#pragma unroll
      for (int c = 0; c < 4; ++c) { z[c] = b0[c]; z[4 + c] = b1[c]; } }
#pragma unroll
    for (int rr = 0; rr < 16; ++rr) { const f32x4 u0 = *(const LAS f32x4*)(g_up + (d * 16 + rr) * 128 + h * 32 + dk0), u1 = *(const LAS f32x4*)(g_up + (d * 16 + rr) * 128 + h * 32 + dk0 + 4);
#pragma unroll
        for (int c = 0; c < 4; ++c) { z[c] += gv[rr] * u0[c]; z[4 + c] += gv[rr] * u1[c]; } }
#pragma unroll
    for (int c = 0; c < 8; ++c) bc[c] = scan_add(log_sigmoidf_(z[c]) * (1.f / 16.f), lane);
}
struct GsRaw { u32x4 v, k; GgRaw gg; };
__device__ __forceinline__ GsRaw gla_summary_load(const bf16_t* P, const float* Gt, int h, int oc, int tid, int lane, int wave) {
    GsRaw R; const int b0 = chunk_b0(oc), r = tid >> 3, ch = tid & 7, d = wave >> 2, dk0 = 8 * (wave & 3), sp = d ? 63 - lane : lane;
    R.v = *(const u32x4*)(P + (size_t)(b0 + r) * LDP + C_GV + h * 64 + ch * 8);
    R.k = *(const u32x4*)(P + (size_t)(b0 + sp) * LDP + C_GK + h * 32 + dk0);
    R.gg = gla_gates_load(Gt, b0, lane, wave);
    return R;
}
__device__ __forceinline__ void gla_summary_body(LAS unsigned char* lds, const GsRaw& R, const LAS float* g_up, const LAS float* g_b, float* GU, float* GDEC, int h, int oc, int tid, int lane, int wave) {
    LAS unsigned char* Kd = lds; LAS unsigned char* Vt = lds + 2 * GL_T;
    { const int r = tid >> 3, ch = tid & 7;
      LBAR();
      *(LAS u32x4*)(Vt + r * CH_RS + ch * 16) = R.v; }
    { const int d = wave >> 2, dk0 = 8 * (wave & 3), hd = h * 2 + d, jc = oc_to_jc(d, oc), sp = d ? 63 - lane : lane;
      float bc[8]; gla_gates_wave(R.gg, g_up, g_b, h, lane, wave, bc);
      float kf[8]; unpack8(R.k, kf);
      float dec[8];
#pragma unroll
      for (int c = 0; c < 8; ++c) { const float bL = __shfl(bc[c], 63); kf[c] *= __expf(bL - bc[c]); dec[c] = __expf(bL); }
      *(LAS u32x4*)(Kd + d * GL_T + sp * GL_RS + dk0 * 2) = pack8(kf);
      if (lane == 0) { float* dp = GDEC + (size_t)(hd * NCH + jc) * 32 + dk0; *(f32x4*)dp = (f32x4){dec[0], dec[1], dec[2], dec[3]}; *(f32x4*)(dp + 4) = (f32x4){dec[4], dec[5], dec[6], dec[7]}; } }
    LBAR();
    { const int d = wave >> 2, dkt = (wave >> 1) & 1, dvh = wave & 1, g = lane >> 4, i = lane & 15, hd = h * 2 + d, jc = oc_to_jc(d, oc);
      const bf16x8 a0 = tr_frag(Kd + d * GL_T, GL_RS, 0, 16 * dkt, lane), a1 = tr_frag(Kd + d * GL_T, GL_RS, 32, 16 * dkt, lane);
      float* dst = GU + ((size_t)(hd * 32 + 16 * dkt + i) * NCH + jc) * 64 + 4 * g;
#pragma unroll
      for (int q = 0; q < 2; ++q) { const int dvt = 2 * dvh + q;
          f32x4 c = (f32x4){0.f, 0.f, 0.f, 0.f};
          c = MFMA16(tr_frag(Vt, CH_RS, 0, 16 * dvt, lane), a0, c); c = MFMA16(tr_frag(Vt, CH_RS, 32, 16 * dvt, lane), a1, c);
          *(f32x4*)(dst + 16 * dvt) = c; } }
}
struct GoRaw { u32x4 v, s, q, k; GgRaw gg; uint2 og[4]; };
__device__ __forceinline__ GoRaw gla_out_load(const bf16_t* P, const float* Gt, const bf16_t* GS, int h, int oc, int tid, int lane, int wave) {
    GoRaw R; const int b0 = chunk_b0(oc), r = tid >> 3, ch = tid & 7, d = wave >> 2, dk0 = 8 * (wave & 3), sp = d ? 63 - lane : lane;
    R.v = *(const u32x4*)(P + (size_t)(b0 + r) * LDP + C_GV + h * 64 + ch * 8);
    { const int dd = r >> 5, rk = r & 31; R.s = *(const u32x4*)(GS + ((size_t)((h * 2 + dd) * 32 + rk) * NCH + oc_to_jc(dd, oc)) * 64 + ch * 8); }
    R.q = *(const u32x4*)(P + (size_t)(b0 + sp) * LDP + C_GQ + h * 32 + dk0); R.k = *(const u32x4*)(P + (size_t)(b0 + sp) * LDP + C_GK + h * 32 + dk0);
    R.gg = gla_gates_load(Gt, b0, lane, wave);
    { const int tt = wave & 3, g = lane >> 4, i = lane & 15, row = b0 + 16 * tt + i;
#pragma unroll
      for (int dvt = 0; dvt < 4; ++dvt) R.og[dvt] = *(const uint2*)(P + (size_t)row * LDP + C_GG + h * 64 + 16 * dvt + 4 * g); }
    return R;
}
__device__ __forceinline__ void gla_out_body(LAS unsigned char* lds, const GoRaw& R, const LAS float* g_up, const LAS float* g_b, const float* normw, bf16_t* CAT, int h, int oc, int tid, int lane, int wave) {
    LAS unsigned char* Qs = lds; LAS unsigned char* Ks = lds + 2 * GL_T; LAS unsigned char* Vt = lds + 4 * GL_T; LAS unsigned char* St = Vt + CH_T;
    LAS f32x4* hs = (LAS f32x4*)(St + 2 * 32 * CH_RS);
    const int b0 = chunk_b0(oc);
    { const int r = tid >> 3, ch = tid & 7, dd = r >> 5, rk = r & 31;
      LBAR();
      *(LAS u32x4*)(Vt + r * CH_RS + ch * 16) = R.v; *(LAS u32x4*)(St + dd * 32 * CH_RS + rk * CH_RS + ch * 16) = R.s; }
    { const int d = wave >> 2, dk0 = 8 * (wave & 3), sp = d ? 63 - lane : lane;
      float bc[8]; gla_gates_wave(R.gg, g_up, g_b, h, lane, wave, bc);
      float qf[8], kf[8]; unpack8(R.q, qf); unpack8(R.k, kf);
#pragma unroll
      for (int c = 0; c < 8; ++c) { qf[c] *= __expf(bc[c]); kf[c] *= __expf(-bc[c]); }
      *(LAS u32x4*)(Qs + d * GL_T + sp * GL_RS + dk0 * 2) = pack8(qf); *(LAS u32x4*)(Ks + d * GL_T + sp * GL_RS + dk0 * 2) = pack8(kf); }
    LBAR();
    const int d = wave >> 2, tt = wave & 3, g = lane >> 4, i = lane & 15, t = 16 * tt + i;
    f32x4 hh[4];
    {
        const bf16x8 bq = *(const LAS bf16x8*)(Qs + d * GL_T + t * GL_RS + 16 * g);
        f32x4 sT[4];
#pragma unroll
        for (int st = 0; st < 4; ++st) {
            f32x4 c = (f32x4){0.f, 0.f, 0.f, 0.f};
            c = MFMA16(*(const LAS bf16x8*)(Ks + d * GL_T + (16 * st + i) * GL_RS + 16 * g), bq, c);
#pragma unroll
            for (int rr = 0; rr < 4; ++rr) { const int sidx = 16 * st + 4 * g + rr; const bool ok = d ? (sidx >= t) : (sidx <= t); sT[st][rr] = ok ? c[rr] : 0.f; }
        }
        bf16x8 pb[2];
#pragma unroll
        for (int gp = 0; gp < 2; ++gp) { u32x4 w; w.x = cvtpk(sT[2 * gp][0], sT[2 * gp][1]); w.y = cvtpk(sT[2 * gp][2], sT[2 * gp][3]); w.z = cvtpk(sT[2 * gp + 1][0], sT[2 * gp + 1][1]); w.w = cvtpk(sT[2 * gp + 1][2], sT[2 * gp + 1][3]); pb[gp] = __builtin_bit_cast(bf16x8, w); }
#pragma unroll
        for (int dvt = 0; dvt < 4; ++dvt) {
            f32x4 c = (f32x4){0.f, 0.f, 0.f, 0.f};
            c = MFMA16(tr_frag_perm(Vt, CH_RS, 0, 16 * dvt, lane), pb[0], c); c = MFMA16(tr_frag_perm(Vt, CH_RS, 32, 16 * dvt, lane), pb[1], c);
            c = MFMA16(tr_frag(St + d * 32 * CH_RS, CH_RS, 0, 16 * dvt, lane), bq, c);
            hh[dvt] = c;
        }
        if (d == 1) {
#pragma unroll
            for (int dvt = 0; dvt < 4; ++dvt) hs[(tt * 4 + dvt) * 64 + lane] = hh[dvt];
        }
    }
    LBAR();
    if (d == 0) {
        float s1 = 0.f;
#pragma unroll
        for (int dvt = 0; dvt < 4; ++dvt) { hh[dvt] = hh[dvt] + hs[(tt * 4 + dvt) * 64 + lane]; s1 += (hh[dvt][0] + hh[dvt][1]) + (hh[dvt][2] + hh[dvt][3]); }
        s1 += __shfl_xor(s1, 16); s1 += __shfl_xor(s1, 32);
        const float mu = s1 * (1.f / 64.f); float s2 = 0.f;
#pragma unroll
        for (int dvt = 0; dvt < 4; ++dvt) { hh[dvt] = hh[dvt] - mu; s2 += (hh[dvt][0] * hh[dvt][0] + hh[dvt][1] * hh[dvt][1]) + (hh[dvt][2] * hh[dvt][2] + hh[dvt][3] * hh[dvt][3]); }
        s2 += __shfl_xor(s2, 16); s2 += __shfl_xor(s2, 32);
        const float rstd = rsqrtf(s2 * (1.f / 64.f) + LN_EPS);
        const int row = b0 + t;
#pragma unroll
        for (int dvt = 0; dvt < 4; ++dvt) { const int col = h * 64 + 16 * dvt + 4 * g;
            const uint2 gg = R.og[dvt]; const f32x4 nw = *(const f32x4*)(normw + col);
            const float o0 = hh[dvt][0] * rstd * nw[0] * siluf(__uint_as_float(gg.x << 16)), o1 = hh[dvt][1] * rstd * nw[1] * siluf(__uint_as_float(gg.x & 0xffff0000u));
            const float o2 = hh[dvt][2] * rstd * nw[2] * siluf(__uint_as_float(gg.y << 16)), o3 = hh[dvt][3] * rstd * nw[3] * siluf(__uint_as_float(gg.y & 0xffff0000u));
            uint2 o; o.x = cvtpk(o0, o1); o.y = cvtpk(o2, o3); *(uint2*)(CAT + (size_t)row * DM + 768 + col) = o; }
    }
}

__device__ __forceinline__ f32x4 ld4bf(const bf16_t* p) { const uint2 v = *(const uint2*)p; return (f32x4){__uint_as_float(v.x << 16), __uint_as_float(v.x & 0xffff0000u), __uint_as_float(v.y << 16), __uint_as_float(v.y & 0xffff0000u)}; }
__device__ __forceinline__ void sum_partials(f32x4 (&a)[4], const float* __restrict__ base, int sp, size_t pstride) {
#pragma unroll
    for (int j = 0; j < 4; ++j) a[j] = (f32x4){0.f, 0.f, 0.f, 0.f};
    int p = 0;
    for (; p + 1 < sp; p += 2) { f32x4 t0[4], t1[4];
#pragma unroll
        for (int j = 0; j < 4; ++j) { t0[j] = *(const f32x4*)(base + (size_t)p * pstride + 256 * j); t1[j] = *(const f32x4*)(base + (size_t)(p + 1) * pstride + 256 * j); }
#pragma unroll
        for (int j = 0; j < 4; ++j) a[j] = a[j] + (t0[j] + t1[j]); }
    if (p < sp) {
#pragma unroll
        for (int j = 0; j < 4; ++j) a[j] = a[j] + *(const f32x4*)(base + (size_t)p * pstride + 256 * j); }
}
__device__ __forceinline__ void sum_partials_bf(f32x4 (&a)[4], const bf16_t* __restrict__ base, int sp, size_t pstride) {
#pragma unroll
    for (int j = 0; j < 4; ++j) a[j] = (f32x4){0.f, 0.f, 0.f, 0.f};
    int p = 0;
    for (; p + 1 < sp; p += 2) { f32x4 t0[4], t1[4];
#pragma unroll
        for (int j = 0; j < 4; ++j) { t0[j] = ld4bf(base + (size_t)p * pstride + 256 * j); t1[j] = ld4bf(base + (size_t)(p + 1) * pstride + 256 * j); }
#pragma unroll
        for (int j = 0; j < 4; ++j) a[j] = a[j] + (t0[j] + t1[j]); }
    if (p < sp) {
#pragma unroll
        for (int j = 0; j < 4; ++j) a[j] = a[j] + ld4bf(base + (size_t)p * pstride + 256 * j); }
}
__device__ __forceinline__ void ln16(f32x4 (&v)[4], const float* w, const float* b, int lane) {
    float s = 0.f;
#pragma unroll
    for (int j = 0; j < 4; ++j) s += (v[j][0] + v[j][1]) + (v[j][2] + v[j][3]);
    const float mean = wave_sum(s) * (1.f / DM); float s2 = 0.f;
#pragma unroll
    for (int j = 0; j < 4; ++j) { v[j] = v[j] - mean; s2 += (v[j][0] * v[j][0] + v[j][1] * v[j][1]) + (v[j][2] * v[j][2] + v[j][3] * v[j][3]); }
    const float rstd = rsqrtf(wave_sum(s2) * (1.f / DM) + LN_EPS);
#pragma unroll
    for (int j = 0; j < 4; ++j) { const f32x4 wv = *(const f32x4*)(w + 4 * lane + 256 * j), bv = *(const f32x4*)(b + 4 * lane + 256 * j); v[j] = v[j] * rstd * wv + bv; }
}
__device__ __forceinline__ void mod_store(f32x4 (&v)[4], const float* shift, const float* scale, bf16_t* hrow, int lane) {
#pragma unroll
    for (int j = 0; j < 4; ++j) { const f32x4 sh = *(const f32x4*)(shift + 4 * lane + 256 * j), sc = *(const f32x4*)(scale + 4 * lane + 256 * j);
        v[j] = v[j] * (sc + 1.f) + sh;
        uint2 o; o.x = cvtpk(v[j][0], v[j][1]); o.y = cvtpk(v[j][2], v[j][3]); *(uint2*)(hrow + 4 * lane + 256 * j) = o; }
}
__device__ __forceinline__ void ln16L(f32x4 (&v)[4], const LAS float* w, const LAS float* b, int lane) {
    float s = 0.f;
#pragma unroll
    for (int j = 0; j < 4; ++j) s += (v[j][0] + v[j][1]) + (v[j][2] + v[j][3]);
    const float mean = wave_sum(s) * (1.f / DM); float s2 = 0.f;
#pragma unroll
    for (int j = 0; j < 4; ++j) { v[j] = v[j] - mean; s2 += (v[j][0] * v[j][0] + v[j][1] * v[j][1]) + (v[j][2] * v[j][2] + v[j][3] * v[j][3]); }
    const float rstd = rsqrtf(wave_sum(s2) * (1.f / DM) + LN_EPS);
#pragma unroll
    for (int j = 0; j < 4; ++j) { const f32x4 wv = *(const LAS f32x4*)(w + 4 * lane + 256 * j), bv = *(const LAS f32x4*)(b + 4 * lane + 256 * j); v[j] = v[j] * rstd * wv + bv; }
}
__device__ __forceinline__ void mod_storeL(f32x4 (&v)[4], const LAS float* shift, const LAS float* scale, bf16_t* hrow, int lane) {
#pragma unroll
    for (int j = 0; j < 4; ++j) { const f32x4 sh = *(const LAS f32x4*)(shift + 4 * lane + 256 * j), sc = *(const LAS f32x4*)(scale + 4 * lane + 256 * j);
        v[j] = v[j] * (sc + 1.f) + sh;
        uint2 o; o.x = cvtpk(v[j][0], v[j][1]); o.y = cvtpk(v[j][2], v[j][3]); *(uint2*)(hrow + 4 * lane + 256 * j) = o; }
}
#define LN_STAGE8(vl, p0, p1, p2, p3, p4, p5, p6, p7) do { const float* ps_[8] = {p0, p1, p2, p3, p4, p5, p6, p7}; \
        _Pragma("unroll") for (int q_ = 0; q_ < 8; ++q_) { (vl)[q_ * 1024 + tid] = ps_[q_][tid]; (vl)[q_ * 1024 + 512 + tid] = ps_[q_][512 + tid]; } __syncthreads(); } while (0)

__global__ void __launch_bounds__(512, 2) fwd(Args a_unused) {
    extern __shared__ __attribute__((aligned(16))) unsigned char lds_raw[];
    LAS unsigned char* lds = (LAS unsigned char*)lds_raw;
    const int wave0 = __builtin_amdgcn_readfirstlane(threadIdx.x >> 6);
    const int G0 = gridDim.x, bid0 = blockIdx.x;
    typedef const __attribute__((address_space(4))) Args* ArgsP;
    ArgsP ap0 = (ArgsP)__builtin_amdgcn_kernarg_segment_ptr();
#define PH_CTX() int G = G0, bid = bid0; asm volatile("" : "+s"(G), "+s"(bid)); int wave = wave0; asm volatile("" : "+s"(wave)); unsigned ones_ = ~0u; asm volatile("" : "+s"(ones_)); const int lane = (int)__builtin_amdgcn_mbcnt_hi(ones_, __builtin_amdgcn_mbcnt_lo(ones_, 0u)); const int tid = wave * 64 + lane; \
    ArgsP ap = ap0; asm volatile("" : "+s"(ap)); unsigned char* ws = ap->ws; const int gw = wave * G + bid, NGW = G * 8;     (void)lane; (void)gw; (void)NGW; (void)ws
#define WSP(T, off) ((T*)(ws + (off)))
    volatile LAS unsigned* MISC = (volatile LAS unsigned*)(lds + MISC_OFF);
    if (threadIdx.x < 32) MISC[threadIdx.x] = 0u;
    __syncthreads();
    XcdBarrier bar; bar.bar = (unsigned*)(ap0->ws + WS_CTL) + CW_BAR; bar.x = 0; bar.st = MISC + 8;
    if (MK_ONE_LAUNCH) bar = xcd_barrier_post(bar.bar, MISC + 8);
    const int lo = ap0->ph_lo, hi = ap0->ph_hi;
#define IN(k) (lo <= (k) && (k) < hi)
#define SEAM(k) do { if (MK_ONE_LAUNCH && (k) + 1 < hi) xcd_barrier(bar); } while (0)

    if (IN(0)) {
        PH_CTX();
        float* MODS = WSP(float, WS_MODS);
        LAS float* scs = (LAS float*)lds;
        for (int i = tid; i < 2048; i += 512) scs[i] = siluf(i < 1024 ? ap->in[1][i] : ap->in[3][i - 1024]);
        __syncthreads();
        for (int u = bid; u < 4 * 16 * 12; u += G) {
            const int l = u / 192, rem = u % 192, kc = rem / 12, ng = rem % 12, n = ng * 512 + tid;
            const float* w = ap->in[4] + ((size_t)l * 1024 + kc * 64) * 6144 + n;
            float a0 = 0.f, a1 = 0.f;
#pragma unroll 32
            for (int k = 0; k < 64; ++k) { const float wv = __builtin_nontemporal_load(w + (size_t)k * 6144); a0 += scs[kc * 64 + k] * wv; a1 += scs[1024 + kc * 64 + k] * wv; }
            if (kc == 0) { const float bb = ap->in[5][l * 6144 + n]; a0 += bb; a1 += bb; }
            atomicAdd(MODS + (size_t)(l * 2 + 0) * 6144 + n, a0); atomicAdd(MODS + (size_t)(l * 2 + 1) * 6144 + n, a1);
        }
        if (bid < 8) { float* ropeC = WSP(float, WS_ROPE); float* ropeS = ropeC + 256 * 16;
            const int i = bid * 512 + tid, pos = i >> 4, fi = i & 15; const float inv = powf(10000.f, -(float)fi / 16.f); const float ang = (float)pos * inv; float sn, cs; sincosf(ang, &sn, &cs); ropeC[i] = cs; ropeS[i] = sn; }
        __syncthreads();
        LAS float* scr = (LAS float*)(lds + wave * 16640);
        constexpr int I_A = 16 * 44, I_B = 16 * 16, I_C = 16 * 88, I_D = 44 * 16, I_E = 0, I_F = 0;
        constexpr int N_A = 4 * I_A, N_B = 4 * I_B, N_C = 2 * I_C, N_D = 2 * I_D, N_E = 16 * I_E, N_F = 16 * I_F;
        for (int it = gw; it < N_A + N_B + N_C + N_D; it += NGW) {
            int r = it;
            if (r < N_A) { const int mi = r / I_A; tr_item(ap->in[6] + (size_t)mi * DM * IN_COLS, DM, IN_COLS, NPIN, WSP(bf16_t, WS_WIN) + (size_t)mi * NPIN * DM, 1, 0, scr, r % I_A, lane); continue; } r -= N_A;
            if (r < N_B) { const int mi = r / I_B; tr_item(ap->in[13] + (size_t)mi * DM * DM, DM, DM, DM, WSP(bf16_t, WS_WOUT) + (size_t)mi * DM * DM, 0, 0, scr, r % I_B, lane); continue; } r -= N_B;
            if (r < N_C) { const int mi = r / I_C; tr_item<true>(ap->in[16] + (size_t)mi * DM * 2 * DFF, DM, 2 * DFF, 2 * DFF, (bf16_t*)(WSP(unsigned char, WS_FGU) + (size_t)mi * 2 * DFF * DM), 2, DFF, scr, r % I_C, lane, MGU_SCALE); continue; } r -= N_C;
            { const int mi = r / I_D; tr_item(ap->in[17] + (size_t)mi * DFF * DM, DFF, DM, DM, WSP(bf16_t, WS_FDN) + (size_t)mi * DM * DFF, 0, 0, scr, r % I_D, lane); }
        }
        __syncthreads();
        { constexpr int J_GU = 8 * 28, J_DN = 28 * 4, J_PER = J_GU + J_DN;
          for (int it = bid; it < 16 * J_PER; it += G) { const int mi = it / J_PER, r = it % J_PER;
              if (r < J_GU) tr_item_f8_wg(lds, ap->in[20] + (size_t)mi * DM * 2 * DEXP, DM, 2 * DEXP, 2 * DEXP, WSP(unsigned char, WS_MGU) + (size_t)mi * 2 * DEXP * DM, 2, DEXP, r, tid, lane, wave, MGU_SCALE);
              else tr_item_f8_wg(lds, ap->in[21] + (size_t)mi * DEXP * DM, DEXP, DM, DM, WSP(unsigned char, WS_MDN) + (size_t)mi * DM * DEXP, 0, 0, r - J_GU, tid, lane, wave, MDN_SCALE); } }
        SEAM(0);
    }
    if (IN(1)) {
        PH_CTX();
        bf16_t* H = WSP(bf16_t, WS_H); const float* MODS = WSP(float, WS_MODS);
        for (int r = gw; r < TT; r += NGW) {
            const int wch = r >= SEQ; const float* src = wch ? ap->in[2] + (size_t)(r - SEQ) * DM : ap->in[0] + (size_t)r * DM;
            f32x4 v[4];
#pragma unroll
            for (int j = 0; j < 4; ++j) v[j] = *(const f32x4*)(src + 4 * lane + 256 * j);
            const float* md = MODS + (size_t)(0 * 2 + wch) * 6144;
            mod_store(v, md, md + 1024, H + (size_t)r * DM, lane);
        }
        SEAM(1);
    }

    for (int l = 0; l < DEPTH; ++l) {
        const int pb = 2 + 10 * l;
        const bool lastl = (l == DEPTH - 1), moe = (l & 1);
        const int nrows = lastl ? SEQ : TT;

        PHASE_REP(0) if (IN(pb + 0)) {
            PH_CTX();
            pg8::StaticOrder S; S.init(WSP(bf16_t, WS_H), WSP(bf16_t, WS_WIN) + (size_t)l * NPIN * DM, DM, TT, NPIN, G, bid);
            pg8::EpiInProj E{WSP(bf16_t, WS_P), WSP(float, WS_G), WSP(float, WS_ROPE), WSP(float, WS_ROPE) + 256 * 16};
            pg8::gemm_phase<pg8::EpiInProj, pg8::StaticOrder>(lds, DM, S, E, tid);
            SEAM(pb + 0);
        }
        PHASE_REP(1) if (IN(pb + 1)) {
            if (!lastl && bid0 >= 32 && bid0 < 36) { PH_CTX(); for (int hf = 0; hf < 2; ++hf) at32::attn_unit<8>(lds, WSP(bf16_t, WS_P), WSP(bf16_t, WS_CAT), true, 2 * ((bid - 32) >> 1) + hf, bid & 1, ap->in[9] + l * 8, lane, wave); }
            { PH_CTX();
              const bf16_t* P = WSP(bf16_t, WS_P); const float* Gt = WSP(float, WS_G); const float* gate_b = ap->in[7] + l * 16;
#define UNIT_LOOP2(N_, start_, RawT, LOAD, BODY) do { int u0_ = (start_); if (u0_ < (N_)) { RawT A_ = LOAD(u0_); for (;;) { \
                  const int u1_ = u0_ + G; const RawT B_ = LOAD(u1_ < (N_) ? u1_ : u0_); BODY(A_, u0_); if (u1_ >= (N_)) break; \
                  const int u2_ = u1_ + G; A_ = LOAD(u2_ < (N_) ? u2_ : u1_); BODY(B_, u1_); if (u2_ >= (N_)) break; u0_ = u2_; } } } while (0)
#define UNIT_LOOP2S(N_, start_, S_, RawT, LOAD, BODY) do { int u0_ = (start_); if (u0_ < (N_)) { RawT A_ = LOAD(u0_); for (;;) { \
                  const int u1_ = u0_ + (S_); const RawT B_ = LOAD(u1_ < (N_) ? u1_ : u0_); BODY(A_, u0_); if (u1_ >= (N_)) break; \
                  const int u2_ = u1_ + (S_); A_ = LOAD(u2_ < (N_) ? u2_ : u1_); BODY(B_, u1_); if (u2_ >= (N_)) break; u0_ = u2_; } } } while (0)
#define MS_LOAD(u) mlstm_summary_load(P, Gt, gate_b, (u) / NCH, (u) % NCH, tid, lane, wave)
#define MS_BODY(R, u) mlstm_summary_body(lds, R, WSP(float, WS_MU), WSP(float, WS_MNU), WSP(float, WS_MSC), (u) / NCH, (u) % NCH, tid, lane, wave)
              const bool ctxb = !lastl && bid >= 32 && bid < 36; const int Gm = lastl ? G : G - 4, wm = lastl ? bid : (bid < 32 ? bid : bid - 4);
              if (!ctxb) UNIT_LOOP2S(4 * NCH, wm, Gm, MsRaw, MS_LOAD, MS_BODY); }
            { PH_CTX();
              const bf16_t* P = WSP(bf16_t, WS_P); const float* Gt = WSP(float, WS_G);
#define GS_LOAD(u) gla_summary_load(P, Gt, (u) / NCH, (u) % NCH, tid, lane, wave)
              LAS float* gupL = (LAS float*)(lds + 65536); LAS float* gbL = gupL + 4096;
              __syncthreads(); for (int i = tid; i < 4096; i += 512) gupL[i] = ap->in[10][(size_t)l * 4096 + i]; if (tid < 256) gbL[tid] = ap->in[11][l * 256 + tid]; __syncthreads();
#define GS_BODY(R, u) gla_summary_body(lds, R, gupL, gbL, WSP(float, WS_GU), WSP(float, WS_GDEC), (u) / NCH, (u) % NCH, tid, lane, wave)
              UNIT_LOOP2(4 * NCH, (bid + 200) % G, GsRaw, GS_LOAD, GS_BODY); }
            SEAM(pb + 1);
        }
        PHASE_REP(2) if (IN(pb + 2)) {
            PH_CTX();
            const int wi = wave * G + bid;
            const int e0 = wi * 64;
            LAS float* sc = (LAS float*)(lds + wave * 4096);
#define SC_LOAD(buf, b) _Pragma("unroll") for (int j = 0; j < 52; ++j) buf[j] = U[(size_t)((b) * 52 + j) * str]
            if (e0 < 32768 + 512) {
                const bool isC = e0 < 32768;
                const int hd = isC ? e0 / 4096 : (e0 - 32768) / 64, idx = isC ? (e0 % 4096) + lane : lane;
                const int dkr = (e0 % 4096) >> 6;
                const float* __restrict__ U = isC ? WSP(float, WS_MU) + (size_t)(hd * 64 + dkr) * NCH * 64 + lane : WSP(float, WS_MNU) + (size_t)hd * NCH * 64 + lane;
                bf16_t* __restrict__ StC = WSP(bf16_t, WS_MC) + (size_t)(hd * 64 + dkr) * NCH * 64 + lane; float* __restrict__ StN = WSP(float, WS_MNS) + (size_t)hd * NCH * 64 + lane;
                float* __restrict__ MSC = WSP(float, WS_MSC) + (size_t)hd * NCH * 4;
                const int str = 64;
                const bool wr_m_wave = isC && (e0 % 4096) == 0;
                float ua[52], ub[52], uc[52];
                {
                    float cmv[5], Bv[5]; float a = 0.f, b = -INFINITY;
#pragma unroll
                    for (int q = 0; q < 5; ++q) { const int n = 5 * lane + q; const bool ok = n < NCH; const float2 v = ok ? *(const float2*)(MSC + n * 4) : make_float2(-INFINITY, 0.f); cmv[q] = v.x; Bv[q] = v.y; }
                    SC_LOAD(ua, 0); SC_LOAD(ub, 1); SC_LOAD(uc, 2);
#pragma unroll
                    for (int q = 0; q < 5; ++q) { b = fmaxf(b + Bv[q], cmv[q] + Bv[q]); a += Bv[q]; }
#pragma unroll
                    for (int o = 1; o < 64; o <<= 1) { const float pa = __shfl_up(a, o), pb = __shfl_up(b, o); if (lane >= o) { b = fmaxf(pb + a, b); a = pa + a; } }
                    float ea = __shfl_up(a, 1), eb = __shfl_up(b, 1); if (lane == 0) { ea = 0.f; eb = -INFINITY; }
                    float m = fmaxf(ea, eb);
#pragma unroll
                    for (int q = 0; q < 5; ++q) { const int n = 5 * lane + q;
                        if (n < NCH) { const float mx = fmaxf(m, cmv[q]); sc[2 * n] = __expf(m - mx); sc[2 * n + 1] = __expf(cmv[q] - mx); if (wr_m_wave) MSC[n * 4 + 2] = m; m = Bv[q] + mx; } }
                }
                LDS_WAIT();
                float cval = 0.f;
#define SC_STEP_M(buf, b) _Pragma("unroll") for (int j = 0; j < 52; ++j) { const int n = (b) * 52 + j; \
                    if (isC) StC[(size_t)n * 64] = (bf16_t)f2bf(cval); else StN[(size_t)n * 64] = cval; \
                    cval = sc[2 * n] * cval + sc[2 * n + 1] * buf[j]; }
                SC_STEP_M(ua, 0); SC_LOAD(ua, 3); SC_STEP_M(ub, 1); SC_LOAD(ub, 4); SC_STEP_M(uc, 2);
                SC_STEP_M(ua, 3); SC_STEP_M(ub, 4);
#undef SC_STEP_M
            } else if (e0 < 32768 + 512 + 16384) {
                const int e2 = e0 - 33280, hd = e2 / 2048, idx = (e2 % 2048) + lane, dk = (e2 % 2048) >> 6;
                const float* __restrict__ U = WSP(float, WS_GU) + (size_t)(hd * 32 + dk) * NCH * 64 + lane; bf16_t* __restrict__ St = WSP(bf16_t, WS_GS) + (size_t)(hd * 32 + dk) * NCH * 64 + lane;
                const float* __restrict__ DC = WSP(float, WS_GDEC) + (size_t)hd * NCH * 32 + dk;
                const int str = 64;
                float ua[52], ub[52], uc[52];
                float dcv[5];
#pragma unroll
                for (int q = 0; q < 5; ++q) { const int k = lane + 64 * q; dcv[q] = k < NCH ? DC[(size_t)k * 32] : 0.f; }
                SC_LOAD(ua, 0); SC_LOAD(ub, 1); SC_LOAD(uc, 2);
#pragma unroll
                for (int q = 0; q < 5; ++q) { const int k = lane + 64 * q; if (k < NCH) sc[k] = dcv[q]; }
                LDS_WAIT();
                float sval = 0.f;
#define SC_STEP_G(buf, b) _Pragma("unroll") for (int j = 0; j < 52; ++j) { const int n = (b) * 52 + j; St[(size_t)n * 64] = (bf16_t)f2bf(sval); sval = sc[n] * sval + buf[j]; }
                SC_STEP_G(ua, 0); SC_LOAD(ua, 3); SC_STEP_G(ub, 1); SC_LOAD(ub, 4); SC_STEP_G(uc, 2);
                SC_STEP_G(ua, 3); SC_STEP_G(ub, 4);
#undef SC_STEP_G
            }
#undef SC_LOAD
            SEAM(pb + 2);
        }
        PHASE_REP(3) if (IN(pb + 3)) {
            const int noc = lastl ? 256 : 260;
            { PH_CTX();
              const int bsw = (G & 7) == 0 ? (bid & 7) * (G >> 3) + (bid >> 3) : bid;
              for (int u = bsw; u < 256; u += G)
                  for (int hf = 0; hf < 2; ++hf) at32::attn_unit<8>(lds, WSP(bf16_t, WS_P), WSP(bf16_t, WS_CAT), false, 2 * (u >> 1) + hf, u & 1, ap->in[9] + l * 8, lane, wave); }
            { PH_CTX();
              const bf16_t* P = WSP(bf16_t, WS_P); const float* Gt = WSP(float, WS_G); const float* gate_b = ap->in[7] + l * 16;
              const bf16_t* MC = WSP(bf16_t, WS_MC); const float* MNS = WSP(float, WS_MNS); const float* MSC = WSP(float, WS_MSC);
#define MO_LOAD(u) mlstm_out_load(P, Gt, gate_b, MC, MNS, MSC, (u) / noc, (u) % noc, tid, lane, wave)
#define MO_BODY(R, u) mlstm_out_body(lds, R, ap->in[8] + l * 256, WSP(bf16_t, WS_CAT), (u) / noc, (u) % noc, tid, lane, wave)
              UNIT_LOOP2(4 * noc, bid, MoRaw, MO_LOAD, MO_BODY); }
            { PH_CTX();
              const bf16_t* P = WSP(bf16_t, WS_P); const float* Gt = WSP(float, WS_G); const bf16_t* GS = WSP(bf16_t, WS_GS);
#define GO_LOAD(u) gla_out_load(P, Gt, GS, (u) / noc, (u) % noc, tid, lane, wave)
              LAS float* gupL = (LAS float*)(lds + 65536); LAS float* gbL = gupL + 4096;
              __syncthreads(); for (int i = tid; i < 4096; i += 512) gupL[i] = ap->in[10][(size_t)l * 4096 + i]; if (tid < 256) gbL[tid] = ap->in[11][l * 256 + tid]; __syncthreads();
#define GO_BODY(R, u) gla_out_body(lds, R, gupL, gbL, ap->in[12] + l * 256, WSP(bf16_t, WS_CAT), (u) / noc, (u) % noc, tid, lane, wave)
              UNIT_LOOP2(4 * noc, (bid + 240) % G, GoRaw, GO_LOAD, GO_BODY); }
            SEAM(pb + 3);
        }
        PHASE_REP(4) if (IN(pb + 4)) {
            PH_CTX();
            const float* modl = WSP(float, WS_MODS) + (size_t)(l * 2 + 0) * 6144;
            int tp, sp; pg8::tail_params(nrows / 256, 4, DM / 64, G, tp, sp);
            pg8::TailOrder S; S.dense(WSP(bf16_t, WS_CAT), WSP(bf16_t, WS_WOUT) + (size_t)l * DM * DM, DM, DM, nrows / 256, G, bid, tp, sp);
            pg8::EpiResid E{WSP(bf16_t, WS_Y), modl + 2 * 1024, modl + 6144 + 2 * 1024, WSP(float, WS_YP), nrows - tp * 256, tp * 256};
            pg8::gemm_phase<pg8::EpiResid, pg8::TailOrder>(lds, DM, S, E, tid);
            SEAM(pb + 4);
        }
        if (IN(pb + 5)) {
            PH_CTX();
            float* X = WSP(float, WS_X); bf16_t* H = WSP(bf16_t, WS_H); const bf16_t* Yb = WSP(bf16_t, WS_Y);
            const float* modl = WSP(float, WS_MODS) + (size_t)(l * 2 + 0) * 6144;
            unsigned* mcnt = WSP(unsigned, WS_CTL) + CW_MOE + 64 * 8 * (l >> 1);
            LAS float* RW = (LAS float*)lds;
            if (moe) { const float* rw = ap->in[18] + (size_t)(l >> 1) * DM * 8; for (int i = tid; i < 8192; i += 512) { const int e = i >> 10, c = i & 1023; RW[i] = rw[c * 8 + e]; } __syncthreads(); }
            LAS float* VL = (LAS float*)(lds + 65536);
            LN_STAGE8(VL, ap->in[14] + (size_t)(l * 2 + 0) * DM, ap->in[15] + (size_t)(l * 2 + 0) * DM, modl + 3 * 1024, modl + 4 * 1024, modl + 6144 + 3 * 1024, modl + 6144 + 4 * 1024, modl + 2 * 1024, modl + 6144 + 2 * 1024);
            float rbias[8];
#pragma unroll
            for (int e = 0; e < 8; ++e) rbias[e] = moe ? ap->in[19][(l >> 1) * 8 + e] : 0.f;
            int tp, sp; pg8::tail_params(nrows / 256, 4, DM / 64, G, tp, sp);
            const int tail0 = nrows - tp * 256; const float* YP = WSP(float, WS_YP);
#define LN1_LD(r_, XR, YR) do { const int rr_ = (r_); const int wc_ = rr_ >= SEQ; \
                const float* xs_ = (l == 0) ? (wc_ ? ap->in[2] + (size_t)(rr_ - SEQ) * DM : ap->in[0] + (size_t)rr_ * DM) : X + (size_t)rr_ * DM;     \
                _Pragma("unroll") for (int j = 0; j < 4; ++j) { XR[j] = *(const f32x4*)(xs_ + 4 * lane + 256 * j); YR[j] = *(const uint2*)(Yb + (size_t)rr_ * DM + 4 * lane + 256 * j); } } while (0)
            auto ln1_row = [&](const int r, const f32x4 (&xr)[4], const uint2 (&yr)[4]) __attribute__((always_inline)) {
                const int wch = r >= SEQ;
                f32x4 v[4];
                if (r < tail0) {
#pragma unroll
                    for (int j = 0; j < 4; ++j) v[j] = xr[j] * ALPHA + (f32x4){__uint_as_float(yr[j].x << 16), __uint_as_float(yr[j].x & 0xffff0000u), __uint_as_float(yr[j].y << 16), __uint_as_float(yr[j].y & 0xffff0000u)};
                } else {
                    f32x4 a4[4]; sum_partials(a4, YP + (size_t)(r - tail0) * DM + 4 * lane, sp, (size_t)tp * 256 * DM);
#pragma unroll
                    for (int j = 0; j < 4; ++j) { const int c = 4 * lane + 256 * j; v[j] = xr[j] * ALPHA + *(const LAS f32x4*)(VL + (6 + wch) * 1024 + c) * a4[j]; }
                }
                ln16L(v, VL, VL + 1024, lane);
#pragma unroll
                for (int j = 0; j < 4; ++j) *(f32x4*)(X + (size_t)r * DM + 4 * lane + 256 * j) = v[j];
#pragma unroll
                for (int j = 0; j < 4; ++j) { const f32x4 sh = *(const LAS f32x4*)(VL + (2 + 2 * wch) * 1024 + 4 * lane + 256 * j), sc = *(const LAS f32x4*)(VL + (3 + 2 * wch) * 1024 + 4 * lane + 256 * j); v[j] = v[j] * (sc + 1.f) + sh; }
                if (!moe) {
#pragma unroll
                    for (int j = 0; j < 4; ++j) *(unsigned*)((unsigned char*)H + (size_t)r * DM + 4 * lane + 256 * j) = pk4_fp8(v[j][0], v[j][1], v[j][2], v[j][3]);
                } else {
                    float lg[8];
#pragma unroll
                    for (int e = 0; e < 8; ++e) { float s = 0.f;
#pragma unroll
                        for (int j = 0; j < 4; ++j) { const f32x4 w = *(const LAS f32x4*)(RW + e * 1024 + 4 * lane + 256 * j); s += v[j][0] * w[0] + v[j][1] * w[1] + v[j][2] * w[2] + v[j][3] * w[3]; }
                        lg[e] = wave_sum(s) + rbias[e]; }
                    int e0 = 0; float l0 = lg[0];
#pragma unroll
                    for (int e = 1; e < 8; ++e) if (lg[e] > l0) { l0 = lg[e]; e0 = e; }
                    int e1 = -1; float l1 = -INFINITY;
#pragma unroll
                    for (int e = 0; e < 8; ++e) if (e != e0 && lg[e] > l1) { l1 = lg[e]; e1 = e; }
                    int p0 = 0, p1 = 0;
                    if (lane == 0) {
                        const float w0 = 1.f / (1.f + __expf(l1 - l0));
                        p0 = (int)atomicAdd(mcnt + 64 * e0, 1u); p1 = (int)atomicAdd(mcnt + 64 * e1, 1u);
                        WSP(int2, WS_TOKE)[r] = make_int2(e0, e1); WSP(int2, WS_TOKP)[r] = make_int2(p0, p1); WSP(float2, WS_TOKW)[r] = make_float2(w0, 1.f - w0);
                    }
                    p0 = __builtin_amdgcn_readfirstlane(p0); p1 = __builtin_amdgcn_readfirstlane(p1);
                    unsigned char* x0 = WSP(unsigned char, WS_XB) + ((size_t)e0 * TT + p0) * DM; unsigned char* x1 = WSP(unsigned char, WS_XB) + ((size_t)e1 * TT + p1) * DM;
#pragma unroll
                    for (int j = 0; j < 4; ++j) { const unsigned o = pk4_fp8(v[j][0], v[j][1], v[j][2], v[j][3]); *(unsigned*)(x0 + 4 * lane + 256 * j) = o; *(unsigned*)(x1 + 4 * lane + 256 * j) = o; }
                }
            };
            { int r = gw;
              if (r < nrows) { f32x4 xa[4], xb[4]; uint2 ya[4], yb[4]; LN1_LD(r, xa, ya);
                for (;;) { const int r1 = r + NGW; const bool h1 = r1 < nrows; LN1_LD(h1 ? r1 : r, xb, yb); ln1_row(r, xa, ya); if (!h1) break;
                           const int r2 = r1 + NGW; const bool h2 = r2 < nrows; LN1_LD(h2 ? r2 : r1, xa, ya); ln1_row(r1, xb, yb); if (!h2) break; r = r2; } } }
#undef LN1_LD
            SEAM(pb + 5);
        }
#define MOE_TS() int ts0 = 0, ts1, ts2, ts3, ts4, ts5, ts6, ts7, ts8; { const unsigned* mcnt = WSP(unsigned, WS_CTL) + CW_MOE + 64 * 8 * (l >> 1); \
            ts1 = ts0 + (int)((__hip_atomic_load(mcnt + 64 * 0, __ATOMIC_RELAXED, __HIP_MEMORY_SCOPE_AGENT) + 255u) >> 8); ts2 = ts1 + (int)((__hip_atomic_load(mcnt + 64 * 1, __ATOMIC_RELAXED, __HIP_MEMORY_SCOPE_AGENT) + 255u) >> 8); \
            ts3 = ts2 + (int)((__hip_atomic_load(mcnt + 64 * 2, __ATOMIC_RELAXED, __HIP_MEMORY_SCOPE_AGENT) + 255u) >> 8); ts4 = ts3 + (int)((__hip_atomic_load(mcnt + 64 * 3, __ATOMIC_RELAXED, __HIP_MEMORY_SCOPE_AGENT) + 255u) >> 8); \
            ts5 = ts4 + (int)((__hip_atomic_load(mcnt + 64 * 4, __ATOMIC_RELAXED, __HIP_MEMORY_SCOPE_AGENT) + 255u) >> 8); ts6 = ts5 + (int)((__hip_atomic_load(mcnt + 64 * 5, __ATOMIC_RELAXED, __HIP_MEMORY_SCOPE_AGENT) + 255u) >> 8); \
            ts7 = ts6 + (int)((__hip_atomic_load(mcnt + 64 * 6, __ATOMIC_RELAXED, __HIP_MEMORY_SCOPE_AGENT) + 255u) >> 8); ts8 = ts7 + (int)((__hip_atomic_load(mcnt + 64 * 7, __ATOMIC_RELAXED, __HIP_MEMORY_SCOPE_AGENT) + 255u) >> 8); \
            ts1 = __builtin_amdgcn_readfirstlane(ts1); ts2 = __builtin_amdgcn_readfirstlane(ts2); ts3 = __builtin_amdgcn_readfirstlane(ts3); ts4 = __builtin_amdgcn_readfirstlane(ts4); \
            ts5 = __builtin_amdgcn_readfirstlane(ts5); ts6 = __builtin_amdgcn_readfirstlane(ts6); ts7 = __builtin_amdgcn_readfirstlane(ts7); ts8 = __builtin_amdgcn_readfirstlane(ts8); } (void)ts0; (void)ts8
        PHASE_REP(7) if (IN(pb + 7)) {
            if (!moe) {
                PH_CTX();
                pg8::StaticOrder S; S.init(WSP(bf16_t, WS_H), WSP(unsigned char, WS_FGU) + (size_t)(l >> 1) * 2 * DFF * DM, DM / 2, nrows, 2 * DFF, G, bid);
                pg8::EpiSwiglu E{WSP(bf16_t, WS_ACT), DFF, 1.f / MGU_SCALE, 1.f};
                pg8::gemm_phase<pg8::EpiSwiglu, pg8::StaticOrder, true>(lds, DM / 2, S, E, tid);
            } else {
                PH_CTX();
                MOE_TS();
                pg8::MoeOrder S; S.A = (const char*)WSP(bf16_t, WS_XB); S.Bt = (const char*)WSP(unsigned char, WS_MGU) + (size_t)(l >> 1) * 8 * 2 * DEXP * DM; S.K = DM / 2; S.N = 2 * DEXP;     S.nN = 2 * DEXP / 256; S.ntile = ts8; S.G = G; S.c = bid;
                S.ts1 = ts1; S.ts2 = ts2; S.ts3 = ts3; S.ts4 = ts4; S.ts5 = ts5; S.ts6 = ts6; S.ts7 = ts7;
                pg8::EpiSwigluT<true> E{WSP(bf16_t, WS_ACT), DEXP, 1.f / MGU_SCALE, ACT_SCALE};
                pg8::gemm_phase<pg8::EpiSwigluT<true>, pg8::MoeOrder, true>(lds, DM / 2, S, E, tid);
            }
            SEAM(pb + 7);
        }
        PHASE_REP(8) if (IN(pb + 8)) {
            if (!moe) {
                PH_CTX();
                const float* modl = WSP(float, WS_MODS) + (size_t)(l * 2 + 0) * 6144;
                int tp, sp; pg8::tail_params(nrows / 256, 4, DFF / 64, G, tp, sp);
                pg8::TailOrder S; S.dense(WSP(bf16_t, WS_ACT), WSP(bf16_t, WS_FDN) + (size_t)(l >> 1) * DM * DFF, DFF, DM, nrows / 256, G, bid, tp, sp);
                pg8::EpiResid E{WSP(bf16_t, WS_Y), modl + 5 * 1024, modl + 6144 + 5 * 1024, WSP(float, WS_YP), nrows - tp * 256, tp * 256};
                pg8::gemm_phase<pg8::EpiResid, pg8::TailOrder>(lds, DFF, S, E, tid);
            } else {
                PH_CTX();
                MOE_TS();
                int tp, sp; pg8::tail_params(ts8, 4, DEXP / 128, G, tp, sp);
                pg8::TailOrder S; S.dense(WSP(bf16_t, WS_ACT), WSP(unsigned char, WS_MDN) + (size_t)(l >> 1) * 8 * DM * DEXP, DEXP / 2, DM, ts8, G, bid, tp, sp);
                S.ts1 = ts1; S.ts2 = ts2; S.ts3 = ts3; S.ts4 = ts4; S.ts5 = ts5; S.ts6 = ts6; S.ts7 = ts7;
                pg8::EpiRaw E{WSP(bf16_t, WS_YS), WSP(float, WS_YP), (ts8 - tp) * 256, tp * 256, 1.f / (MDN_SCALE * ACT_SCALE)};
                pg8::gemm_phase<pg8::EpiRaw, pg8::TailOrder, true>(lds, DEXP / 2, S, E, tid);
            }
            SEAM(pb + 8);
        }
        if (IN(pb + 9)) {
#define BF4(u_) ((f32x4){__uint_as_float((u_).x << 16), __uint_as_float((u_).x & 0xffff0000u), __uint_as_float((u_).y << 16), __uint_as_float((u_).y & 0xffff0000u)})
#define LN2_TAIL(v_, r_, wch_) do { ln16L(v_, VL, VL + 1024, lane); \
                if (lastl) { _Pragma("unroll") for (int j = 0; j < 4; ++j) *(f32x4*)(ap->out + (size_t)(r_) * DM + 4 * lane + 256 * j) = v_[j]; } \
                else { _Pragma("unroll") for (int j = 0; j < 4; ++j) *(f32x4*)(X + (size_t)(r_) * DM + 4 * lane + 256 * j) = v_[j]; \
                       mod_storeL(v_, VL + (2 + 2 * (wch_)) * 1024, VL + (3 + 2 * (wch_)) * 1024, H + (size_t)(r_) * DM, lane); } } while (0)
            if (!moe) {
                PH_CTX();
                float* X = WSP(float, WS_X); bf16_t* H = WSP(bf16_t, WS_H); const bf16_t* Yb = WSP(bf16_t, WS_Y); const float* YP = WSP(float, WS_YP);
                const float* modl = WSP(float, WS_MODS) + (size_t)(l * 2 + 0) * 6144;
                LAS float* VL = (LAS float*)(lds + 65536);
                LN_STAGE8(VL, ap->in[14] + (size_t)(l * 2 + 1) * DM, ap->in[15] + (size_t)(l * 2 + 1) * DM, modl + 2 * 6144, modl + 2 * 6144 + 1024, modl + 3 * 6144, modl + 3 * 6144 + 1024, modl + 5 * 1024, modl + 6144 + 5 * 1024);
                int tp, sp; pg8::tail_params(nrows / 256, 4, DFF / 64, G, tp, sp); const int tail0 = nrows - tp * 256;
#define LN2_LD(r_, XR, Y0) do { const int rr_ = (r_); _Pragma("unroll") for (int j = 0; j < 4; ++j) { XR[j] = *(const f32x4*)(X + (size_t)rr_ * DM + 4 * lane + 256 * j); Y0[j] = *(const uint2*)(Yb + (size_t)rr_ * DM + 4 * lane + 256 * j); } } while (0)
                auto row = [&](const int r, const f32x4 (&xr)[4], const uint2 (&y0r)[4]) __attribute__((always_inline)) {
                    const int wch = r >= SEQ;
                    f32x4 v[4];
                    if (r < tail0) {
#pragma unroll
                        for (int j = 0; j < 4; ++j) v[j] = xr[j] * ALPHA + BF4(y0r[j]);
                    } else {
                        f32x4 a4[4]; sum_partials(a4, YP + (size_t)(r - tail0) * DM + 4 * lane, sp, (size_t)tp * 256 * DM);
#pragma unroll
                        for (int j = 0; j < 4; ++j) { const int c = 4 * lane + 256 * j; v[j] = xr[j] * ALPHA + *(const LAS f32x4*)(VL + (6 + wch) * 1024 + c) * a4[j]; }
                    }
                    LN2_TAIL(v, r, wch);
                };
                int r = gw;
                if (r < nrows) { f32x4 xa[4], xb[4]; uint2 ya[4], yb[4]; LN2_LD(r, xa, ya);
                  for (;;) { const int r1 = r + NGW; const bool h1 = r1 < nrows; LN2_LD(h1 ? r1 : r, xb, yb); row(r, xa, ya); if (!h1) break;
                             const int r2 = r1 + NGW; const bool h2 = r2 < nrows; LN2_LD(h2 ? r2 : r1, xa, ya); row(r1, xb, yb); if (!h2) break; r = r2; } }
#undef LN2_LD
            } else {
                PH_CTX();
                float* X = WSP(float, WS_X); bf16_t* H = WSP(bf16_t, WS_H); const bf16_t* YS = WSP(bf16_t, WS_YS); const bf16_t* YPb = WSP(bf16_t, WS_YP);
                const float* modl = WSP(float, WS_MODS) + (size_t)(l * 2 + 0) * 6144;
                LAS float* VL = (LAS float*)(lds + 65536);
                LN_STAGE8(VL, ap->in[14] + (size_t)(l * 2 + 1) * DM, ap->in[15] + (size_t)(l * 2 + 1) * DM, modl + 2 * 6144, modl + 2 * 6144 + 1024, modl + 3 * 6144, modl + 3 * 6144 + 1024, modl + 5 * 1024, modl + 6144 + 5 * 1024);
                MOE_TS();
                int tp, sp; pg8::tail_params(ts8, 4, DEXP / 128, G, tp, sp); const int tail0 = (ts8 - tp) * 256;
#define LN2_LD(r_, XR, Y0, Y1, S0, S1, W0, W1) do { const int rr_ = (r_); const int2 mE = WSP(int2, WS_TOKE)[rr_], mP = WSP(int2, WS_TOKP)[rr_]; const float2 mW = WSP(float2, WS_TOKW)[rr_]; \
                    S0 = 256 * (mE.x == 0 ? ts0 : mE.x == 1 ? ts1 : mE.x == 2 ? ts2 : mE.x == 3 ? ts3 : mE.x == 4 ? ts4 : mE.x == 5 ? ts5 : mE.x == 6 ? ts6 : ts7) + mP.x; \
                    S1 = 256 * (mE.y == 0 ? ts0 : mE.y == 1 ? ts1 : mE.y == 2 ? ts2 : mE.y == 3 ? ts3 : mE.y == 4 ? ts4 : mE.y == 5 ? ts5 : mE.y == 6 ? ts6 : ts7) + mP.y; W0 = mW.x; W1 = mW.y; \
                    const bf16_t* b0_ = YS + (size_t)(S0 < tail0 ? S0 : 0) * DM; const bf16_t* b1_ = YS + (size_t)(S1 < tail0 ? S1 : 0) * DM;     \
                    _Pragma("unroll") for (int j = 0; j < 4; ++j) { XR[j] = *(const f32x4*)(X + (size_t)rr_ * DM + 4 * lane + 256 * j); Y0[j] = *(const uint2*)(b0_ + 4 * lane + 256 * j); Y1[j] = *(const uint2*)(b1_ + 4 * lane + 256 * j); } } while (0)
                auto row = [&](const int r, const f32x4 (&xr)[4], const uint2 (&y0r)[4], const uint2 (&y1r)[4], const int s0, const int s1, const float w0, const float w1) __attribute__((always_inline)) {
                    const int wch = r >= SEQ;
                    f32x4 v[4], y0[4], y1[4];
                    if (s0 < tail0) {
#pragma unroll
                        for (int j = 0; j < 4; ++j) y0[j] = BF4(y0r[j]);
                    } else sum_partials_bf(y0, YPb + (size_t)(s0 - tail0) * DM + 4 * lane, sp, (size_t)tp * 256 * DM);
                    if (s1 < tail0) {
#pragma unroll
                        for (int j = 0; j < 4; ++j) y1[j] = BF4(y1r[j]);
                    } else sum_partials_bf(y1, YPb + (size_t)(s1 - tail0) * DM + 4 * lane, sp, (size_t)tp * 256 * DM);
#pragma unroll
                    for (int j = 0; j < 4; ++j) { const int c = 4 * lane + 256 * j; const f32x4 g5 = *(const LAS f32x4*)(VL + (6 + wch) * 1024 + c); v[j] = xr[j] * ALPHA + g5 * (y0[j] * w0 + y1[j] * w1); }
                    LN2_TAIL(v, r, wch);
                };
                int r = gw;
                if (r < nrows) { f32x4 xa[4], xb[4]; uint2 y0a[4], y1a[4], y0b[4], y1b[4]; int s0a, s1a, s0b, s1b; float w0a, w1a, w0b, w1b;
                  LN2_LD(r, xa, y0a, y1a, s0a, s1a, w0a, w1a);
                  for (;;) { const int r1 = r + NGW; const bool h1 = r1 < nrows; LN2_LD(h1 ? r1 : r, xb, y0b, y1b, s0b, s1b, w0b, w1b); row(r, xa, y0a, y1a, s0a, s1a, w0a, w1a); if (!h1) break;
                             const int r2 = r1 + NGW; const bool h2 = r2 < nrows; LN2_LD(h2 ? r2 : r1, xa, y0a, y1a, s0a, s1a, w0a, w1a); row(r1, xb, y0b, y1b, s0b, s1b, w0b, w1b); if (!h2) break; r = r2; } }
#undef LN2_LD
            }
#undef LN2_TAIL
#undef BF4
            SEAM(pb + 9);
        }
    }
#undef IN
#undef SEAM
}

extern "C" void kernel_launch(void* const* d_in, const int* in_sizes, int n_in, void* d_out, int out_size, void* d_ws, size_t ws_size, hipStream_t stream) {
    static int grid = 0;
    if (grid == 0) {
        if (n_in != 22 || ws_size < WS_END) { fprintf(stderr, "kernel_launch: unexpected n_in %d / ws %zu (need %zu)\n", n_in, ws_size, (size_t)WS_END); grid = -1; return; }
        int dev = 0, cus = 0;
        if (hipGetDevice(&dev) != hipSuccess || hipDeviceGetAttribute(&cus, hipDeviceAttributeMultiprocessorCount, dev) != hipSuccess) { grid = -1; return; }
        if (hipFuncSetAttribute((const void*)fwd, hipFuncAttributeMaxDynamicSharedMemorySize, LDS_BYTES) != hipSuccess) { fprintf(stderr, "kernel_launch: hipFuncSetAttribute failed\n"); grid = -1; return; }
        int per_cu = 0;
        if (hipOccupancyMaxActiveBlocksPerMultiprocessor(&per_cu, (const void*)fwd, 512, LDS_BYTES) != hipSuccess || per_cu < 1) fprintf(stderr, "kernel_launch: occupancy query reports %d\n", per_cu);
        (void)hipGetLastError();
        grid = cus;
    }
    if (grid < 0) return;
    (void)hipMemsetAsync((char*)d_ws + WS_CTL, 0, CTL_BYTES, stream);
    Args a{};
    for (int i = 0; i < 22; ++i) a.in[i] = (const float*)d_in[i];
    a.out = (float*)d_out; a.ws = (unsigned char*)d_ws;
#if MK_ONE_LAUNCH
    a.ph_lo = 0; a.ph_hi = NPH;
    hipLaunchKernelGGL(fwd, dim3(grid), dim3(512), LDS_BYTES, stream, a);
#else
    for (int p = 0; p < NPH; ++p) {
        if (p >= 2 && ((p - 2) % 10) == 6 && ((((p - 2) / 10) & 1) == 0)) continue;
        a.ph_lo = p; a.ph_hi = p + 1;
        hipLaunchKernelGGL(fwd, dim3(grid), dim3(512), LDS_BYTES, stream, a);
    }
#endif
}
```
